# Optimizing an MI355X kernel written in HIP

```python
import jax
import jax.numpy as jnp
from jax import lax
import numpy as np

D_MODEL = 2048
BATCH = 1
SEQ = 8192
DEPTH = 2

GRID_W = 64
CTX_LEN = 256
EPS = 1e-6
D_FF = 5632
N_MOD = 9
N_BRANCH = 4
BR_W = 512

HG_HEADS = 4
HG_DK = 128
HG_DV = 128
HG_CHUNK = 64

RW_HEADS = 8
RW_HD = 64
RW_W = RW_HEADS * RW_HD
RW_DECAY_LORA = 64
RW_AAA_LORA = 64
RW_GN_EPS = 64e-5

NA_HEADS = 8
NA_HD = 64
NA_WIN_R = 8
NA_WIN_C = 16

WA_HEADS = 8
WA_KV_HEADS = 2
WA_HD = 64
WA_WINDOW = 128
WA_BLOCK = 128
ROPE_BASE = 10000.0

HG_SPLIT = (HG_HEADS * HG_DK,) * 3 + (HG_HEADS * HG_DV,) * 2
RW_SPLIT = (RW_W,) * 4 + (RW_DECAY_LORA,) * 2 + (RW_AAA_LORA,) * 2
NA_SPLIT = (NA_HEADS * NA_HD,) * 3
WA_SPLIT = (WA_HEADS * WA_HD, WA_KV_HEADS * WA_HD, WA_KV_HEADS * WA_HD)
RW_COLS = sum(RW_SPLIT)
MIX_SPLIT = (sum(HG_SPLIT), RW_COLS, sum(NA_SPLIT), sum(WA_SPLIT), N_BRANCH * D_MODEL)
P_TOTAL = sum(MIX_SPLIT)

kernel_name = 'hybrid_gated_parallel_mixer_dit'


def split_cols(t, widths):
    out, start = [], 0
    for w in widths:
        out.append(t[..., start:start + w])
        start += w
    return out


def rmsnorm(x, g):
    x32 = x.astype(jnp.float32)
    y = x32 * lax.rsqrt(jnp.mean(x32 * x32, axis=-1, keepdims=True) + EPS)
    return (y * g.astype(jnp.float32)).astype(x.dtype)


def modulate(x, g, shift, scale):
    return rmsnorm(x, g) * (1.0 + scale[:, None]) + shift[:, None]


def swiglu_half(x, g, shift, scale, gate, wi, wo):
    a, b = split_cols(modulate(x, g, shift, scale) @ wi, (D_FF, D_FF))
    return x + 0.5 * gate[:, None] * ((jax.nn.silu(a) * b) @ wo)


def rope_half(t, pos):
    n = t.shape[-1] // 2
    inv = ROPE_BASE ** (-jnp.arange(n, dtype=jnp.float32) / n)
    ang = pos.astype(jnp.float32)[:, None] * inv[None, :]
    cos, sin = jnp.cos(ang)[None, :, None, :], jnp.sin(ang)[None, :, None, :]
    t32 = t.astype(jnp.float32)
    t1, t2 = t32[..., :n], t32[..., n:]
    return jnp.concatenate([t1 * cos - t2 * sin, t1 * sin + t2 * cos], -1).astype(t.dtype)


def axial_rope(t, rows, cols):
    h = t.shape[-1] // 2
    return jnp.concatenate([rope_half(t[..., :h], rows), rope_half(t[..., h:], cols)], -1)


def context_attention(qc, kc, vc, sink):
    L = kc.shape[1]
    s = jnp.einsum('blkgd,bmkd->bkglm', qc, kc).astype(jnp.float32)
    if sink is not None:
        s_sink = jnp.broadcast_to(sink.astype(jnp.float32)[None, :, :, None, None], s.shape[:-1] + (1,))
        s = jnp.concatenate([s, s_sink], -1)
    p = jax.nn.softmax(s, axis=-1)[..., :L].astype(vc.dtype)
    return jnp.einsum('bkglm,bmkd->blkgd', p, vc)


def gla_chunk_scan(S0, q, logf, k, v, reverse):
    if reverse:
        q, logf, k, v = [jnp.flip(t, axis=1) for t in (q, logf, k, v)]
    B, T, H, K = q.shape
    V = v.shape[-1]
    n = T // HG_CHUNK

    def to_chunks(t):
        return t.reshape(B, n, HG_CHUNK, H, t.shape[-1]).transpose(1, 0, 3, 2, 4)

    lower = jnp.tril(jnp.ones((HG_CHUNK, HG_CHUNK), dtype=bool))[:, :, None]

    def step(S, inp):
        qc, gc, kc, vc = inp
        b = jnp.cumsum(gc, axis=2)
        diff = b[:, :, :, None, :] - b[:, :, None, :, :]
        dec = jnp.exp(jnp.where(lower, diff, -jnp.inf))
        att = jnp.einsum('bhtk,bhsk,bhtsk->bhts', qc, kc, dec)
        o = jnp.einsum('bhts,bhsv->bhtv', att, vc) + jnp.einsum('bhtk,bhkv->bhtv', qc * jnp.exp(b), S)
        b_end = b[:, :, -1]
        S = jnp.exp(b_end)[..., None] * S + jnp.einsum('bhsk,bhsv->bhkv', kc * jnp.exp(b_end[:, :, None] - b), vc)
        return S, o

    S, o = lax.scan(step, S0, tuple(to_chunks(t) for t in (q, logf, k, v)))
    o = o.transpose(1, 0, 3, 2, 4).reshape(B, T, H, V)
    if reverse:
        o = jnp.flip(o, axis=1)
    return S, o


def hgrn2_branch(u, uc, lb_logits, layer, norm_w, need_ctx):
    lbs = []
    for d in range(2):
        cum = jnp.cumsum(jax.nn.softmax(lb_logits[d].astype(jnp.float32), axis=0), axis=0)
        lbs.append(cum[layer] - cum[0])

    def prep(t):
        B, T = t.shape[:2]
        q, f_fw, f_bw, i, g = split_cols(t.astype(jnp.float32), HG_SPLIT)
        heads = lambda a: a.reshape(B, T, HG_HEADS, -1)
        gates = []
        for fr, lb in ((f_fw, lbs[0]), (f_bw, lbs[1])):
            f = lb + (1.0 - lb) * jax.nn.sigmoid(fr)
            gates.append((heads(jnp.log(f)), heads(1.0 - f)))
        return heads(q), heads(i), g, gates

    def finish(o, g, dtype):
        B, T = g.shape[:2]
        o = rmsnorm(o, norm_w.reshape(HG_HEADS, HG_DV)).reshape(B, T, -1)
        return (o * jax.nn.silu(g)).astype(dtype)

    q_l, i_l, g_l, gates_l = prep(u)
    q_c, i_c, g_c, gates_c = prep(uc)
    S0 = jnp.zeros((u.shape[0], HG_HEADS, HG_DK, HG_DV), jnp.float32)
    outs_l, outs_c = [], []
    for d, reverse in enumerate((False, True)):
        S_c, o_c = gla_chunk_scan(S0, q_c, gates_c[d][0], gates_c[d][1], i_c, reverse)
        _, o_l = gla_chunk_scan(S_c, q_l, gates_l[d][0], gates_l[d][1], i_l, reverse)
        outs_l.append(o_l)
        outs_c.append(o_c)
    y = finish(outs_l[0] + outs_l[1], g_l, u.dtype)
    yc = finish(outs_c[0] + outs_c[1], g_c, uc.dtype) if need_ctx else None
    return y, yc


def token_shift(u, taps):
    up = jnp.pad(u, ((0, 0), (1, 1), (0, 0)))
    return taps[0] * up[:, :-2] + taps[1] * up[:, 1:-1] + taps[2] * up[:, 2:]


def rwkv7_prep(t, taps, w0, w2, a0, a2, k_k, k_a):
    B, T = t.shape[:2]
    t = token_shift(t, taps).astype(jnp.float32)
    r, k, v, g, wd_f, wd_b, ad_f, ad_b = split_cols(t, RW_SPLIT)
    heads = lambda a: a.reshape(B, T, RW_HEADS, RW_HD)
    kk = heads(k * k_k)
    kk = kk * lax.rsqrt(jnp.sum(kk * kk, axis=-1, keepdims=True) + EPS)
    dirs = []
    for d, (wd, ad) in enumerate(((wd_f, ad_f), (wd_b, ad_b))):
        log_w = -jax.nn.softplus(-(w0[d] + jnp.tanh(wd) @ w2[d])) - 0.5
        a = jax.nn.sigmoid(a0[d] + ad @ a2[d])
        k_d = k * (1.0 + (a - 1.0) * k_a)
        dirs.append((heads(jnp.exp(-jnp.exp(log_w))), heads(a) * kk, heads(k_d)))
    return heads(r), kk, heads(v), jax.nn.sigmoid(g), dirs


def rwkv7_scan(S0, r, decay, kk, akk, v, kd, reverse):
    def step(S, inp):
        r_t, w_t, kk_t, akk_t, v_t, k_t = inp
        sk = jnp.einsum('bhvk,bhk->bhv', S, kk_t)
        S = S * w_t[:, :, None, :] - sk[..., None] * akk_t[:, :, None, :] + v_t[..., None] * k_t[:, :, None, :]
        return S, jnp.einsum('bhvk,bhk->bhv', S, r_t)

    xs = tuple(jnp.swapaxes(t, 0, 1) for t in (r, decay, kk, akk, v, kd))
    S, o = lax.scan(step, S0, xs, reverse=reverse)
    return S, jnp.swapaxes(o, 0, 1)


def rwkv7_finish(o, prep, r_k, ln_w, ln_b, dtype):
    r, kk, v, g, dirs = prep
    B, T = g.shape[:2]
    mu = jnp.mean(o, axis=-1, keepdims=True)
    var = jnp.mean(jnp.square(o - mu), axis=-1, keepdims=True)
    o = (o - mu) * lax.rsqrt(var + RW_GN_EPS) * ln_w.reshape(RW_HEADS, RW_HD) + ln_b.reshape(RW_HEADS, RW_HD)
    kd_sum = dirs[0][2] + dirs[1][2]
    bonus = jnp.sum(r * kd_sum * r_k, axis=-1, keepdims=True) * v
    return ((o + bonus).reshape(B, T, -1) * g).astype(dtype)


def rwkv7_branch(u, uc, taps, w0, w2, a0, a2, k_k, k_a, r_k, ln_w, ln_b, need_ctx):
    p_l = rwkv7_prep(u, taps, w0, w2, a0, a2, k_k, k_a)
    p_c = rwkv7_prep(uc, taps, w0, w2, a0, a2, k_k, k_a)
    S0 = jnp.zeros((u.shape[0], RW_HEADS, RW_HD, RW_HD), jnp.float32)
    outs_l, outs_c = [], []
    for d, reverse in enumerate((False, True)):
        dec_c, akk_c, kd_c = p_c[4][d]
        dec_l, akk_l, kd_l = p_l[4][d]
        S_c, o_c = rwkv7_scan(S0, p_c[0], dec_c, p_c[1], akk_c, p_c[2], kd_c, reverse)
        _, o_l = rwkv7_scan(S_c, p_l[0], dec_l, p_l[1], akk_l, p_l[2], kd_l, reverse)
        outs_l.append(o_l)
        outs_c.append(o_c)
    y = rwkv7_finish(outs_l[0] + outs_l[1], p_l, r_k, ln_w, ln_b, u.dtype)
    yc = rwkv7_finish(outs_c[0] + outs_c[1], p_c, r_k, ln_w, ln_b, uc.dtype) if need_ctx else None
    return y, yc


def neighborhood_attention(q, k, v, kc, vc, rpb):
    B, T, H, d = q.shape
    rows = T // GRID_W
    wr = min(NA_WIN_R, rows)
    wc = NA_WIN_C
    qg = q.reshape(B, rows, GRID_W, H, d)
    kg = k.reshape(B, rows, GRID_W, H, d)
    vg = v.reshape(B, rows, GRID_W, H, d)
    col = jnp.arange(GRID_W)
    col_idx = jnp.clip(col - wc // 2, 0, GRID_W - wc)[:, None] + jnp.arange(wc)[None, :]
    col_bias_idx = col_idx - col[:, None] + (NA_WIN_C - 1)

    def one_row(i):
        rs = jnp.clip(i - wr // 2, 0, rows - wr)
        row_bias_idx = rs + jnp.arange(wr) - i + (NA_WIN_R - 1)
        kr = lax.dynamic_slice_in_dim(kg, rs, wr, axis=1)[:, :, col_idx]
        vr = lax.dynamic_slice_in_dim(vg, rs, wr, axis=1)[:, :, col_idx]
        qi = lax.dynamic_index_in_dim(qg, i, axis=1, keepdims=False)
        bias = rpb[:, row_bias_idx[:, None, None], col_bias_idx[None]]
        s_loc = jnp.einsum('bjhd,bajchd->bhjac', qi, kr) + bias.transpose(0, 2, 1, 3)[None]
        s_ctx = jnp.einsum('bjhd,blhd->bhjl', qi, kc)
        s = jnp.concatenate([s_loc.reshape(B, H, GRID_W, wr * wc), s_ctx], -1).astype(jnp.float32)
        p = jax.nn.softmax(s, axis=-1).astype(v.dtype)
        p_loc = p[..., :wr * wc].reshape(B, H, GRID_W, wr, wc)
        return jnp.einsum('bhjac,bajchd->bjhd', p_loc, vr) + jnp.einsum('bhjl,blhd->bjhd', p[..., wr * wc:], vc)

    out = lax.map(one_row, jnp.arange(rows))
    return out.transpose(1, 0, 2, 3, 4).reshape(B, T, H, d)


def na_branch(u, uc, qn, kn, rpb, need_ctx):
    def qkv(t):
        B, T = t.shape[:2]
        q, k, v = [a.reshape(B, T, NA_HEADS, NA_HD) for a in split_cols(t, NA_SPLIT)]
        return rmsnorm(q, qn) * NA_HD ** -0.5, rmsnorm(k, kn), v

    q, k, v = qkv(u)
    qc, kc, vc = qkv(uc)
    B, T = u.shape[:2]
    y = neighborhood_attention(q, k, v, kc, vc, rpb).reshape(B, T, -1)
    yc = context_attention(qc[:, :, :, None], kc, vc, None).reshape(B, uc.shape[1], -1) if need_ctx else None
    return y, yc


def window_attention(q, k, v, kc, vc, sink):
    B, T, Hkv, G, d = q.shape
    nb = T // WA_BLOCK
    qb = q.reshape(B, nb, WA_BLOCK, Hkv, G, d)

    def band(t):
        tp = jnp.pad(t, ((0, 0), (WA_BLOCK, WA_BLOCK), (0, 0), (0, 0))).reshape(B, nb + 2, WA_BLOCK, Hkv, d)
        return jnp.concatenate([tp[:, :-2], tp[:, 1:-1], tp[:, 2:]], axis=2)

    kb, vb = band(k), band(v)
    blk = jnp.arange(nb)[:, None, None] * WA_BLOCK
    qpos = blk + jnp.arange(WA_BLOCK)[None, :, None]
    kpos = blk - WA_BLOCK + jnp.arange(3 * WA_BLOCK)[None, None, :]
    valid = (jnp.abs(qpos - kpos) <= WA_WINDOW) & (kpos >= 0) & (kpos < T)
    s_loc = jnp.einsum('bnqkgd,bnskd->bnkgqs', qb, kb).astype(jnp.float32)
    s_loc = jnp.where(valid[None, :, None, None], s_loc, -jnp.inf)
    s_ctx = jnp.einsum('bnqkgd,blkd->bnkgql', qb, kc).astype(jnp.float32)
    s_sink = jnp.broadcast_to(sink.astype(jnp.float32)[None, None, :, :, None, None], s_loc.shape[:-1] + (1,))
    p = jax.nn.softmax(jnp.concatenate([s_loc, s_ctx, s_sink], -1), axis=-1).astype(v.dtype)
    n_loc = 3 * WA_BLOCK
    L = kc.shape[1]
    o = (jnp.einsum('bnkgqs,bnskd->bnqkgd', p[..., :n_loc], vb)
         + jnp.einsum('bnkgql,blkd->bnqkgd', p[..., n_loc:n_loc + L], vc))
    return o.reshape(B, T, Hkv, G, d)


def wa_branch(u, uc, qn, kn, sink, need_ctx):
    G = WA_HEADS // WA_KV_HEADS

    def qkv(t):
        B, T = t.shape[:2]
        q, k, v = split_cols(t, WA_SPLIT)
        q = rmsnorm(q.reshape(B, T, WA_HEADS, WA_HD), qn) * WA_HD ** -0.5
        k = rmsnorm(k.reshape(B, T, WA_KV_HEADS, WA_HD), kn)
        return q, k, v.reshape(B, T, WA_KV_HEADS, WA_HD)

    q, k, v = qkv(u)
    qc, kc, vc = qkv(uc)
    B, T = u.shape[:2]
    pos = jnp.arange(T)
    rows, cols = pos // GRID_W, pos % GRID_W
    q = axial_rope(q, rows, cols)
    k = axial_rope(k, rows, cols)
    sink_g = sink.reshape(WA_KV_HEADS, G)
    y = window_attention(q.reshape(B, T, WA_KV_HEADS, G, WA_HD), k, v, kc, vc, sink_g).reshape(B, T, -1)
    yc = None
    if need_ctx:
        L = uc.shape[1]
        yc = context_attention(qc.reshape(B, L, WA_KV_HEADS, G, WA_HD), kc, vc, sink_g).reshape(B, L, -1)
    return y, yc


def merge_branches(ys, gate_logits, w_branch, w_out):
    B, T = gate_logits.shape[:2]
    yb = jnp.stack(ys, axis=2)
    proj = jnp.einsum('btnw,nwd->btnd', yb, w_branch)
    gates = jax.nn.sigmoid(gate_logits.reshape(B, T, N_BRANCH, D_MODEL))
    return jnp.sum(gates * proj, axis=2) @ w_out


def token_mixing(p, pc, layer, hg_lb, hg_norm, rw_shift, rw_w0, rw_w2, rw_a0, rw_a2, rw_kk, rw_ka, rw_rk,
                 rw_ln_w, rw_ln_b, na_qn, na_kn, na_rpb, wa_qn, wa_kn, wa_sink, w_branch, w_out, need_ctx):
    hg, rw, na, wa, gl = split_cols(p, MIX_SPLIT)
    hg_c, rw_c, na_c, wa_c, gl_c = split_cols(pc, MIX_SPLIT)
    y_a, yc_a = hgrn2_branch(hg, hg_c, hg_lb, layer, hg_norm, need_ctx)
    y_b, yc_b = rwkv7_branch(rw, rw_c, rw_shift, rw_w0, rw_w2, rw_a0, rw_a2, rw_kk, rw_ka, rw_rk,
                             rw_ln_w, rw_ln_b, need_ctx)
    y_c, yc_c = na_branch(na, na_c, na_qn, na_kn, na_rpb, need_ctx)
    y_d, yc_d = wa_branch(wa, wa_c, wa_qn, wa_kn, wa_sink, need_ctx)
    y = merge_branches((y_a, y_b, y_c, y_d), gl, w_branch, w_out)
    yc = merge_branches((yc_a, yc_b, yc_c, yc_d), gl_c, w_branch, w_out) if need_ctx else None
    return y, yc


def setup_inputs(seed: int = 0) -> dict:
    key = jax.random.key(seed)
    ks = iter(jax.random.split(key, 40))
    nrm = lambda shape, s=1.0: s * jax.random.normal(next(ks), shape, jnp.float32)
    L, D = DEPTH, D_MODEL
    shift_base = jnp.array([0.25, 0.5, 0.25], dtype=jnp.float32)[None, :, None]
    return {
        'x': nrm((BATCH, SEQ, D)),
        'c': nrm((BATCH, D)),
        'ctx': nrm((BATCH, CTX_LEN, D)),
        'c_ctx': nrm((D,)),
        'ada_w': nrm((L, D, N_MOD * D), D ** -0.5),
        'ada_b': nrm((L, N_MOD * D), 0.02),
        'norm_ffn1': 1.0 + nrm((L, D), 0.1),
        'norm_mix': 1.0 + nrm((L, D), 0.1),
        'norm_ffn2': 1.0 + nrm((L, D), 0.1),
        'ffn1_wi': nrm((L, D, 2 * D_FF), D ** -0.5),
        'ffn1_wo': nrm((L, D_FF, D), D_FF ** -0.5),
        'ffn2_wi': nrm((L, D, 2 * D_FF), D ** -0.5),
        'ffn2_wo': nrm((L, D_FF, D), D_FF ** -0.5),
        'w_in': nrm((L, D, P_TOTAL), D ** -0.5),
        'hg_lb': nrm((2, L, HG_HEADS * HG_DK)),
        'hg_norm': 1.0 + nrm((L, HG_HEADS * HG_DV), 0.1),
        'rw_shift': shift_base + nrm((L, 3, RW_COLS), 0.05),
        'rw_w0': nrm((L, 2, RW_W), 0.5),
        'rw_w2': nrm((L, 2, RW_DECAY_LORA, RW_W), RW_DECAY_LORA ** -0.5),
        'rw_a0': nrm((L, 2, RW_W), 0.5),
        'rw_a2': nrm((L, 2, RW_AAA_LORA, RW_W), RW_AAA_LORA ** -0.5),
        'rw_kk': 0.85 + nrm((L, RW_W), 0.05),
        'rw_ka': 1.0 + nrm((L, RW_W), 0.05),
        'rw_rk': nrm((L, RW_HEADS, RW_HD), 0.1),
        'rw_ln_w': 1.0 + nrm((L, RW_W), 0.1),
        'rw_ln_b': nrm((L, RW_W), 0.02),
        'na_qn': 1.0 + nrm((L, NA_HD), 0.1),
        'na_kn': 1.0 + nrm((L, NA_HD), 0.1),
        'na_rpb': nrm((L, NA_HEADS, 2 * NA_WIN_R - 1, 2 * NA_WIN_C - 1), 0.1),
        'wa_qn': 1.0 + nrm((L, WA_HD), 0.1),
        'wa_kn': 1.0 + nrm((L, WA_HD), 0.1),
        'wa_sink': nrm((L, WA_HEADS)),
        'w_branch': nrm((L, N_BRANCH, BR_W, D), BR_W ** -0.5),
        'w_out': nrm((L, D, D), D ** -0.5),
    }


def reference(x, c, ctx, c_ctx, ada_w, ada_b, norm_ffn1, norm_mix, norm_ffn2, ffn1_wi, ffn1_wo, ffn2_wi,
              ffn2_wo, w_in, hg_lb, hg_norm, rw_shift, rw_w0, rw_w2, rw_a0, rw_a2, rw_kk, rw_ka, rw_rk,
              rw_ln_w, rw_ln_b, na_qn, na_kn, na_rpb, wa_qn, wa_kn, wa_sink, w_branch, w_out):
    xc = ctx
    mod_splits = (D_MODEL,) * N_MOD
    for l in range(DEPTH):
        need_ctx = l < DEPTH - 1
        m = split_cols(jax.nn.silu(c) @ ada_w[l] + ada_b[l], mod_splits)
        mc = split_cols((jax.nn.silu(c_ctx) @ ada_w[l] + ada_b[l])[None], mod_splits)
        x = swiglu_half(x, norm_ffn1[l], m[0], m[1], m[2], ffn1_wi[l], ffn1_wo[l])
        xc = swiglu_half(xc, norm_ffn1[l], mc[0], mc[1], mc[2], ffn1_wi[l], ffn1_wo[l])
        p = modulate(x, norm_mix[l], m[3], m[4]) @ w_in[l]
        pc = modulate(xc, norm_mix[l], mc[3], mc[4]) @ w_in[l]
        y, yc = token_mixing(p, pc, l, hg_lb, hg_norm[l], rw_shift[l], rw_w0[l], rw_w2[l], rw_a0[l], rw_a2[l],
                             rw_kk[l], rw_ka[l], rw_rk[l], rw_ln_w[l], rw_ln_b[l], na_qn[l], na_kn[l], na_rpb[l],
                             wa_qn[l], wa_kn[l], wa_sink[l], w_branch[l], w_out[l], need_ctx)
        x = x + m[5][:, None] * y
        x = swiglu_half(x, norm_ffn2[l], m[6], m[7], m[8], ffn2_wi[l], ffn2_wo[l])
        if need_ctx:
            xc = xc + mc[5][:, None] * yc
            xc = swiglu_half(xc, norm_ffn2[l], mc[6], mc[7], mc[8], ffn2_wi[l], ffn2_wo[l])
    return x
```

```cpp
#include <hip/hip_runtime.h>
#include <cstdio>
#include <cstdint>

#ifndef MK_ONE_LAUNCH
#define MK_ONE_LAUNCH 0
#endif

#define LAS __attribute__((address_space(3)))
#define GAS __attribute__((address_space(1)))
typedef unsigned short bf16_t;
typedef short bf16x8 __attribute__((ext_vector_type(8)));
typedef float f32x4 __attribute__((ext_vector_type(4)));
typedef float f32x2 __attribute__((ext_vector_type(2)));
typedef unsigned u32x4 __attribute__((ext_vector_type(4)));
typedef unsigned u32x2 __attribute__((ext_vector_type(2)));

constexpr int D = 2048, SEQ = 8192, CTX = 256, MT = SEQ + CTX, DEPTH = 2, DFF = 5632, NMOD = 9, MODW = NMOD * D;
constexpr int GRID_W = 64;
constexpr int PTOT = 15360, P32W = 4864, PAW = 2304, GLW = 8192;
constexpr int HG_OFF = 0, RW_OFF = 2560, RWC = 2304;
constexpr int NCH = MT / 64;
constexpr int NWAVES = 8, NT = 512;
constexpr float EPS = 1e-6f, RW_GN_EPS = 64e-5f;

constexpr size_t MiB = 1u << 20;
constexpr size_t OFF_CTL = 0, CTL_BYTES = 1 * MiB;
constexpr size_t OFF_MOD = 1 * MiB;
constexpr size_t OFF_MODP = 2 * MiB;
constexpr size_t OFF_WI1 = 11 * MiB, OFF_WO1 = 55 * MiB, OFF_WIN = 77 * MiB, OFF_WBR = 137 * MiB, OFF_WOUT = 145 * MiB, OFF_WI2 = 153 * MiB, OFF_WO2 = 197 * MiB;
constexpr size_t OFF_X = 219 * MiB;
constexpr size_t OFF_H = 285 * MiB;
constexpr size_t OFF_G = 318 * MiB;
constexpr size_t OFF_P32 = 409 * MiB;
constexpr size_t OFF_PA = 566 * MiB;
constexpr size_t OFF_GL = 604 * MiB;
constexpr size_t OFF_HGL = 736 * MiB;
constexpr size_t OFF_HGD = 802 * MiB;
constexpr size_t OFF_SCN = 803 * MiB;
constexpr size_t OFF_VV = 968 * MiB;
constexpr size_t OFF_GS = 985 * MiB;
constexpr size_t OFF_RO = 1002 * MiB;
constexpr size_t OFF_YB = 1035 * MiB;
constexpr size_t WS_END = 1068 * MiB;
constexpr int KSPLIT = 32;

constexpr int LDS_BYTES = 147456;
constexpr int RING_BYTES = 131072;
constexpr int MISC_OFF = RING_BYTES + 320;

__device__ __forceinline__ float bf2f(unsigned b) { return __uint_as_float(b << 16); }
__device__ __forceinline__ unsigned f2bf(float f) { unsigned u = __float_as_uint(f); return (u + 0x7fffu + ((u >> 16) & 1u)) >> 16; }
__device__ __forceinline__ unsigned pk2(float lo, float hi) { return f2bf(lo) | (f2bf(hi) << 16); }
__device__ __forceinline__ float wave_sum(float v) {
#pragma unroll
    for (int o = 1; o < 64; o <<= 1) v += __shfl_xor(v, o);
    return v;
}
__device__ __forceinline__ float wave_max(float v) {
#pragma unroll
    for (int o = 1; o < 64; o <<= 1) v = fmaxf(v, __shfl_xor(v, o));
    return v;
}
__device__ __forceinline__ float sigmoidf_(float x) { return 1.0f / (1.0f + expf(-x)); }
__device__ __forceinline__ float siluf_(float x) { return x / (1.0f + expf(-x)); }
#define LDS_WAIT() asm volatile("s_waitcnt lgkmcnt(0)" ::: "memory")

__device__ __forceinline__ int seq_row(int d, int j) { return d == 0 ? (j < CTX ? SEQ + j : j - CTX) : (MT - 1 - j); }
__device__ __forceinline__ int row_seq(int d, int r) { return d == 0 ? (r >= SEQ ? r - SEQ : r + CTX) : (MT - 1 - r); }

#define XB_TMO      128
#define XB_XCNT(j)  (256  + 64 * (j))
#define XB_XSUB(j)  (1280 + 64 * (j))
#define XB_XGEN(j)  (2304 + 64 * (j))
#define XB_TOP      3328
#define XB_TOPGEN   3392
#define XCD_BAR_WORDS 3456
#define XB_SPIN_CAP (1u << 18)
__device__ __forceinline__ unsigned xb_ld(unsigned* p)              { return __hip_atomic_load(p, __ATOMIC_RELAXED, __HIP_MEMORY_SCOPE_AGENT); }
__device__ __forceinline__ unsigned xb_add(unsigned* p, unsigned v) { return __hip_atomic_fetch_add(p, v, __ATOMIC_RELAXED, __HIP_MEMORY_SCOPE_AGENT); }
__device__ __forceinline__ unsigned xb_xcc_id() { return (unsigned)__builtin_amdgcn_s_getreg((3 << 11) | 20) & 0xFu; }
#define XB_SPIN(cond, bar) do { unsigned _sp = 0; while (cond) { __builtin_amdgcn_s_sleep(1); \
    if ((++_sp & 255u) == 0u) { if (xb_ld(&(bar)[XB_TMO])) break; if (_sp > XB_SPIN_CAP) { atomicAdd(&(bar)[XB_TMO], 1u); break; } } } } while (0)
struct XcdBarrier { unsigned* bar; unsigned x; volatile LAS unsigned* st; };
__device__ __forceinline__ XcdBarrier xcd_barrier_post(unsigned* bar, volatile LAS unsigned* st) {
    XcdBarrier b; b.bar = bar; b.x = xb_xcc_id(); b.st = st;
    if (threadIdx.x == 0) (void)xb_add(&bar[XB_XCNT(b.x)], 1u);
    return b;
}
__device__ __forceinline__ void xcd_barrier_complete(unsigned* bar, unsigned x, unsigned& nloc, unsigned& nx) {
    const unsigned G = gridDim.x * gridDim.y * gridDim.z;
    unsigned sum, cnt, mine, sp = 0u;
    for (;;) {
        sum = 0u; cnt = 0u; mine = 0u;
#pragma unroll
        for (unsigned j = 0; j < 16; ++j) { const unsigned c = xb_ld(&bar[XB_XCNT(j)]); sum += c; cnt += (c > 0u) ? 1u : 0u; mine = (j == x) ? c : mine; }
        if (sum == G) break;
        __builtin_amdgcn_s_sleep(1);
        if ((++sp & 255u) == 0u) { if (xb_ld(&bar[XB_TMO])) break; if (sp > XB_SPIN_CAP) { atomicAdd(&bar[XB_TMO], 1u); break; } }
    }
    nloc = mine > 0u ? mine : 1u; nx = cnt > 0u ? cnt : 1u;
}
__device__ __forceinline__ void xcd_barrier(const XcdBarrier& b) {
    asm volatile("s_waitcnt vmcnt(0)" ::: "memory");
    __syncthreads();
    if (threadIdx.x == 0) {
        unsigned* bar = b.bar;
        __builtin_amdgcn_s_waitcnt(0);
        unsigned nloc = b.st[0], nx = b.st[1];
        if (nloc == 0u) { xcd_barrier_complete(bar, b.x, nloc, nx); b.st[0] = nloc; b.st[1] = nx; }
        const unsigned old = xb_add(&bar[XB_XSUB(b.x)], 1u);
        const unsigned gen = old / nloc;
        if (old + 1u == (gen + 1u) * nloc) {
            __builtin_amdgcn_fence(__ATOMIC_RELEASE, "agent");
            asm volatile("s_waitcnt vmcnt(0)" ::: "memory");
            const unsigned og = xb_add(&bar[XB_TOP], 1u);
            const unsigned tg = og / nx;
            if (og + 1u == (tg + 1u) * nx) xb_add(&bar[XB_TOPGEN], 1u);
            else XB_SPIN(xb_ld(&bar[XB_TOPGEN]) == tg, bar);
            __builtin_amdgcn_fence(__ATOMIC_ACQUIRE, "agent");
            xb_add(&bar[XB_XGEN(b.x)], 1u);
            asm volatile("s_waitcnt vmcnt(0)" ::: "memory");
        } else {
            XB_SPIN(xb_ld(&bar[XB_XGEN(b.x)]) == gen, bar);
            __builtin_amdgcn_fence(__ATOMIC_ACQUIRE, "agent");
            asm volatile("s_waitcnt vmcnt(0)" ::: "memory");
        }
    }
    __syncthreads();
}

namespace pg8 {
constexpr int BM = 256, BK = 64, HALF = 128, HTB = HALF * BK * 2, STAGE_BYTES = 8 * HTB, NXCD = 8, WGM = 8;
__host__ __device__ __forceinline__ int lds_byte(int r, int c) { const int st = (r >> 4) * 2 + (c >> 5), rr = r & 15, cc = c & 31, ob = rr * 64 + cc * 2; return st * 1024 + (ob ^ (((ob >> 9) & 1) << 5)); }
__host__ __device__ __forceinline__ void stage_rc(int b, int& R, int& C) { const int st = b / 1024, sb = b % 1024, swz = sb ^ (((sb >> 9) & 1) << 5); R = (st >> 1) * 16 + swz / 64; C = (st & 1) * 32 + (swz % 64) / 2; }
__host__ __device__ __forceinline__ int perm32(int rho) { const int n = rho >> 4, i = rho & 15; return 8 * (i >> 2) + 4 * n + (i & 3); }
struct Unit { int pm, pn; };
struct Gemm { const bf16_t* A; const bf16_t* Bt; int M, N, K; int a_div; size_t a_gstride; };
struct StaticOrder {
    int nM, nN, nwg, G, c;
    __host__ __device__ void init(int M, int N, int G_, int c_) { nM = M / BM; nN = N / BM; nwg = nM * nN; G = G_; c = c_; }
    __host__ __device__ bool next(int i, Unit& u) const {
        const long L = (long)i * G + c; if (L >= nwg) return false;
        int wgid = (int)L; { const int q = nwg / NXCD, r = nwg % NXCD, xcd = wgid % NXCD, off = wgid / NXCD; wgid = (xcd < r ? xcd * (q + 1) : r * (q + 1) + (xcd - r) * q) + off; }
        const int nig = WGM * nN, gid = wgid / nig, fm = gid * WGM, gsz = (nM - fm) < WGM ? (nM - fm) : WGM;
        u.pm = fm + ((wgid % nig) % gsz); u.pn = (wgid % nig) / gsz; return true;
    }
};
__device__ __forceinline__ unsigned cvt_pk_bf16(float lo, float hi) { unsigned r; asm volatile("v_cvt_pk_bf16_f32 %0, %1, %2" : "=v"(r) : "v"(lo), "v"(hi)); return r; }

template <class Epi, bool ALIGN_EPI, bool SP2>
__device__ __forceinline__ void gemm_phase(LAS unsigned char* lds, const Gemm g, const StaticOrder& S, const Epi& E, const int tid) {
    const int wid = __builtin_amdgcn_readfirstlane(tid >> 6), lane = tid & 63, wr = wid >> 2, wc = wid & 3, fr = lane & 15, fq = lane >> 4;
    const int K = g.K, nt = K / BK;
    unsigned voffA[2], voffB[2];
#pragma unroll
    for (int i = 0; i < 2; ++i) { int R, C; stage_rc(tid * 16 + i * 8192, R, C); const int Rb = Epi::PERM ? ((R & ~31) + perm32(R & 31)) : R;
        voffA[i] = (unsigned)(R * K + C) * 2u; voffB[i] = (unsigned)(Rb * K + C) * 2u; }
    const size_t kstep = (size_t)(BK * 2);
    const size_t hstep = (size_t)HALF * K * 2;
    const size_t tstep = 2 * hstep;
    const unsigned ldsw = (unsigned)wid * 1024u;
    const int aoff = lds_byte(wr * 64 + fr, fq * 8), boff = lds_byte(wc * 32 + fr, fq * 8);
#define PG8_SA(b, h) (((b) * 2 + (h)) * HTB)
#define PG8_SB(b, h) ((4 + (b) * 2 + (h)) * HTB)
#define PG8_STAGE(bufoff, gbase, voff) do { _Pragma("unroll") for (int _i = 0; _i < 2; ++_i) \
        __builtin_amdgcn_global_load_lds((const unsigned*)((const char*)(gbase) + (voff)[_i]), (LAS unsigned*)(lds + (bufoff) + ldsw + _i * 8192), 16, 0, 0); } while (0)
#define PG8_LDA(dst, b, h) do { _Pragma("unroll") for (int m = 0; m < 4; ++m) _Pragma("unroll") for (int k = 0; k < 2; ++k) dst[m][k] = *(const LAS bf16x8*)(lds + PG8_SA(b, h) + aoff + m * 2048 + k * 1024); } while (0)
#define PG8_LDB(dst, b, h) do { _Pragma("unroll") for (int n = 0; n < 2; ++n) _Pragma("unroll") for (int k = 0; k < 2; ++k) dst[n][k] = *(const LAS bf16x8*)(lds + PG8_SB(b, h) + boff + n * 2048 + k * 1024); } while (0)
#define PG8_MMA(ai, bj, At, Bt) do { __builtin_amdgcn_s_setprio(1); _Pragma("unroll") for (int m = 0; m < 4; ++m) _Pragma("unroll") for (int n = 0; n < 2; ++n) _Pragma("unroll") for (int k = 0; k < 2; ++k) \
        acc[ai][bj][m][n] = __builtin_amdgcn_mfma_f32_16x16x32_bf16(Bt[n][k], At[m][k], acc[ai][bj][m][n], 0, 0, 0); __builtin_amdgcn_s_setprio(0); } while (0)
#define PG8_WAIT_V(n) asm volatile("s_waitcnt vmcnt(" #n ")" ::: "memory")
#define PG8_WAIT_L(n) asm volatile("s_waitcnt lgkmcnt(" #n ")" ::: "memory")
#define PG8_BAR __builtin_amdgcn_s_barrier()
#define PG8_SCHED __builtin_amdgcn_sched_barrier(0)
#define PG8_ABASE(u) ((const char*)g.A + ((size_t)((u).pn / g.a_div) * g.a_gstride) * 2 + (size_t)(u).pm * tstep)
    Unit cur, nxt; int ui = 0;
    if (!S.next(0, cur)) return;
    f32x4 acc[2][2][4][2];
#pragma unroll
    for (int a = 0; a < 2; ++a)
#pragma unroll
        for (int b = 0; b < 2; ++b)
#pragma unroll
            for (int m = 0; m < 4; ++m)
#pragma unroll
                for (int n = 0; n < 2; ++n) acc[a][b][m][n] = (f32x4){0.f, 0.f, 0.f, 0.f};
    bf16x8 At[4][2], B0[2][2], B1[2][2];
    const char* cA = PG8_ABASE(cur); const char* cB = (const char*)g.Bt + (size_t)cur.pn * tstep;
    if constexpr (SP2) {
        PG8_STAGE(PG8_SB(0, 0), cB, voffB); PG8_STAGE(PG8_SB(0, 1), cB + hstep, voffB); PG8_STAGE(PG8_SA(0, 0), cA, voffA); PG8_STAGE(PG8_SA(0, 1), cA + hstep, voffA);
        if (wr == 1) PG8_BAR;
        PG8_WAIT_V(2); PG8_BAR;
        PG8_STAGE(PG8_SB(1, 0), cB + kstep, voffB); PG8_STAGE(PG8_SA(1, 0), cA + kstep, voffA); PG8_STAGE(PG8_SB(1, 1), cB + hstep + kstep, voffB);
        PG8_WAIT_V(6); PG8_BAR;
    } else {
        PG8_STAGE(PG8_SB(0, 0), cB, voffB); PG8_STAGE(PG8_SA(0, 0), cA, voffA); PG8_STAGE(PG8_SB(0, 1), cB + hstep, voffB); PG8_STAGE(PG8_SA(0, 1), cA + hstep, voffA);
        if (wr == 1) PG8_BAR;
        PG8_WAIT_V(4); PG8_BAR;
        PG8_STAGE(PG8_SB(1, 0), cB + kstep, voffB); PG8_STAGE(PG8_SA(1, 0), cA + kstep, voffA); PG8_STAGE(PG8_SB(1, 1), cB + hstep + kstep, voffB);
        PG8_WAIT_V(6); PG8_BAR;
    }
    for (;;) {
        const bool has_next = S.next(ui + 1, nxt);
        const char* nA = has_next ? PG8_ABASE(nxt) : cA; const char* nB = has_next ? (const char*)g.Bt + (size_t)nxt.pn * tstep : cB;
        for (int t = 0; t < nt; t += 2) {
            const bool last = (t == nt - 2);
            const char* a1 = cA + (size_t)(t + 1) * kstep;
            const char* a2 = last ? nA : cA + (size_t)(t + 2) * kstep; const char* b2 = last ? nB : cB + (size_t)(t + 2) * kstep;
            const char* a3 = a2 + kstep; const char* b3 = b2 + kstep;
            if constexpr (SP2) {
            PG8_LDB(B0, 0, 0); PG8_LDB(B1, 0, 1); PG8_SCHED; PG8_LDA(At, 0, 0); PG8_STAGE(PG8_SA(1, 1), a1 + hstep, voffA);
            PG8_WAIT_V(8); PG8_WAIT_L(0); PG8_BAR; PG8_MMA(0, 0, At, B0); PG8_MMA(0, 1, At, B1); PG8_BAR; PG8_SCHED;
            PG8_LDA(At, 0, 1); PG8_STAGE(PG8_SB(0, 0), b2, voffB); PG8_STAGE(PG8_SB(0, 1), b2 + hstep, voffB); PG8_STAGE(PG8_SA(0, 0), a2, voffA);
            PG8_WAIT_V(8); PG8_WAIT_L(0); PG8_BAR; PG8_MMA(1, 0, At, B0); PG8_MMA(1, 1, At, B1); PG8_BAR; PG8_SCHED;
            PG8_LDB(B0, 1, 0); PG8_LDB(B1, 1, 1); PG8_SCHED; PG8_LDA(At, 1, 0); PG8_STAGE(PG8_SA(0, 1), a2 + hstep, voffA);
            PG8_WAIT_V(8); PG8_WAIT_L(0); PG8_BAR; PG8_MMA(0, 0, At, B0); PG8_MMA(0, 1, At, B1); PG8_BAR; PG8_SCHED;
            PG8_LDA(At, 1, 1); PG8_STAGE(PG8_SB(1, 0), b3, voffB); PG8_STAGE(PG8_SB(1, 1), b3 + hstep, voffB); PG8_STAGE(PG8_SA(1, 0), a3, voffA);
            PG8_WAIT_V(8); PG8_WAIT_L(0); PG8_BAR; PG8_MMA(1, 0, At, B0); PG8_MMA(1, 1, At, B1); PG8_BAR; PG8_SCHED;
            } else {
            PG8_LDB(B0, 0, 0); PG8_SCHED; PG8_LDA(At, 0, 0); PG8_STAGE(PG8_SA(1, 1), a1 + hstep, voffA);
            PG8_WAIT_L(8); PG8_BAR; PG8_WAIT_L(0); PG8_MMA(0, 0, At, B0); PG8_BAR; PG8_SCHED;
            PG8_LDB(B1, 0, 1); PG8_STAGE(PG8_SB(0, 0), b2, voffB);
            PG8_BAR; PG8_WAIT_L(0); PG8_MMA(0, 1, At, B1); PG8_BAR;
            PG8_LDA(At, 0, 1); PG8_STAGE(PG8_SA(0, 0), a2, voffA);
            PG8_BAR; PG8_WAIT_L(0); PG8_MMA(1, 0, At, B0); PG8_BAR; PG8_SCHED;
            PG8_STAGE(PG8_SB(0, 1), b2 + hstep, voffB);
            PG8_WAIT_V(6); PG8_BAR; PG8_MMA(1, 1, At, B1); PG8_BAR;
            PG8_LDB(B0, 1, 0); PG8_SCHED; PG8_LDA(At, 1, 0); PG8_STAGE(PG8_SA(0, 1), a2 + hstep, voffA);
            PG8_WAIT_L(8); PG8_BAR; PG8_WAIT_L(0); PG8_MMA(0, 0, At, B0); PG8_BAR; PG8_SCHED;
            PG8_LDB(B1, 1, 1); PG8_STAGE(PG8_SB(1, 0), b3, voffB);
            PG8_BAR; PG8_WAIT_L(0); PG8_MMA(0, 1, At, B1); PG8_BAR;
            PG8_LDA(At, 1, 1); PG8_STAGE(PG8_SA(1, 0), a3, voffA);
            PG8_BAR; PG8_WAIT_L(0); PG8_MMA(1, 0, At, B0); PG8_BAR; PG8_SCHED;
            PG8_STAGE(PG8_SB(1, 1), b3 + hstep, voffB);
            PG8_WAIT_V(6); PG8_BAR; PG8_MMA(1, 1, At, B1); PG8_BAR;
            }
        }
        if constexpr (ALIGN_EPI) { if (wr == 0) PG8_BAR; }
        E(acc, cur, wr, wc, fr, fq);
        if (!has_next) break;
#pragma unroll
        for (int a = 0; a < 2; ++a)
#pragma unroll
            for (int b = 0; b < 2; ++b)
#pragma unroll
                for (int m = 0; m < 4; ++m)
#pragma unroll
                    for (int n = 0; n < 2; ++n) acc[a][b][m][n] = (f32x4){0.f, 0.f, 0.f, 0.f};
        cur = nxt; cA = nA; cB = nB; ++ui;
        if constexpr (ALIGN_EPI) { if (wr == 1) PG8_BAR; }
    }
    PG8_WAIT_V(0);
    if constexpr (!ALIGN_EPI) { if (wr == 0) PG8_BAR; }
    PG8_BAR;
#undef PG8_SA
#undef PG8_SB
#undef PG8_STAGE
#undef PG8_LDA
#undef PG8_LDB
#undef PG8_MMA
#undef PG8_WAIT_V
#undef PG8_WAIT_L
#undef PG8_BAR
#undef PG8_SCHED
#undef PG8_ABASE
}

struct EpiSwiGLU {
    static constexpr bool PERM = true;
    bf16_t* O;
    __device__ __forceinline__ void operator()(const f32x4 (&acc)[2][2][4][2], const Unit& u, int wr, int wc, int fr, int fq) const {
        const int row0 = u.pm * BM + wr * 64 + fr, col0 = u.pn * HALF + wc * 32 + 8 * fq;
#pragma unroll
        for (int ai = 0; ai < 2; ++ai)
#pragma unroll
            for (int m = 0; m < 4; ++m) {
                bf16_t* rowp = O + (size_t)(row0 + ai * HALF + m * 16) * DFF + col0;
                float o[8];
#pragma unroll
                for (int n = 0; n < 2; ++n)
#pragma unroll
                    for (int j = 0; j < 4; ++j) { const float a = acc[ai][0][m][n][j], b = acc[ai][1][m][n][j]; o[n * 4 + j] = a / (1.0f + __expf(-a)) * b; }
                u32x4 w; w.x = cvt_pk_bf16(o[0], o[1]); w.y = cvt_pk_bf16(o[2], o[3]); w.z = cvt_pk_bf16(o[4], o[5]); w.w = cvt_pk_bf16(o[6], o[7]);
                *(u32x4*)rowp = w;
            }
    }
};
template <bool HALFGATE> struct EpiResid {
    static constexpr bool PERM = false;
    float* X; const float* gate_lat; const float* gate_ctx; float* out;
    __device__ __forceinline__ void operator()(const f32x4 (&acc)[2][2][4][2], const Unit& u, int wr, int wc, int fr, int fq) const {
        const int row0 = u.pm * BM + wr * 64 + fr, col0 = u.pn * BM + wc * 32 + 4 * fq;
        const float* gp = (u.pm * BM >= SEQ) ? gate_ctx : gate_lat;
        f32x4 gv[2][2];
#pragma unroll
        for (int bj = 0; bj < 2; ++bj)
#pragma unroll
            for (int n = 0; n < 2; ++n) gv[bj][n] = *(const f32x4*)(gp + col0 + bj * HALF + n * 16) * (HALFGATE ? 0.5f : 1.0f);
#pragma unroll
        for (int ai = 0; ai < 2; ++ai)
#pragma unroll
            for (int m = 0; m < 4; ++m) {
                const int row = row0 + ai * HALF + m * 16;
                float* rowp = X + (size_t)row * D + col0;
#pragma unroll
                for (int bj = 0; bj < 2; ++bj)
#pragma unroll
                    for (int n = 0; n < 2; ++n) {
                        f32x4 v = *(const f32x4*)(rowp + bj * HALF + n * 16) + gv[bj][n] * acc[ai][bj][m][n];
                        *(f32x4*)(rowp + bj * HALF + n * 16) = v;
                        if (out != nullptr && row < SEQ) *(f32x4*)(out + (size_t)row * D + col0 + bj * HALF + n * 16) = v;
                    }
            }
    }
};
struct EpiWin {
    static constexpr bool PERM = true;
    float* P32; bf16_t* PA; bf16_t* GL;
    __device__ __forceinline__ void operator()(const f32x4 (&acc)[2][2][4][2], const Unit& u, int wr, int wc, int fr, int fq) const {
        const int row0 = u.pm * BM + wr * 64 + fr, cin = wc * 32 + 8 * fq;
        if (u.pn < 19) {
#pragma unroll
            for (int ai = 0; ai < 2; ++ai)
#pragma unroll
                for (int m = 0; m < 4; ++m) { float* rowp = P32 + (size_t)(row0 + ai * HALF + m * 16) * P32W + u.pn * BM + cin;
#pragma unroll
                    for (int bj = 0; bj < 2; ++bj) { *(f32x4*)(rowp + bj * HALF) = acc[ai][bj][m][0]; *(f32x4*)(rowp + bj * HALF + 4) = acc[ai][bj][m][1]; } }
        } else {
            bf16_t* base; int ld, colt;
            if (u.pn < 28) { base = PA; ld = PAW; colt = (u.pn - 19) * BM; } else { base = GL; ld = GLW; colt = (u.pn - 28) * BM; }
#pragma unroll
            for (int ai = 0; ai < 2; ++ai)
#pragma unroll
                for (int m = 0; m < 4; ++m) { bf16_t* rowp = base + (size_t)(row0 + ai * HALF + m * 16) * ld + colt + cin;
#pragma unroll
                    for (int bj = 0; bj < 2; ++bj) { const f32x4 v0 = acc[ai][bj][m][0], v1 = acc[ai][bj][m][1];
                        u32x4 w; w.x = cvt_pk_bf16(v0[0], v0[1]); w.y = cvt_pk_bf16(v0[2], v0[3]); w.z = cvt_pk_bf16(v1[0], v1[1]); w.w = cvt_pk_bf16(v1[2], v1[3]);
                        *(u32x4*)(rowp + bj * HALF) = w; } }
        }
    }
};
struct EpiMerge {
    static constexpr bool PERM = true;
    const bf16_t* GL; bf16_t* PROJ;
    __device__ __forceinline__ void operator()(const f32x4 (&acc)[2][2][4][2], const Unit& u, int wr, int wc, int fr, int fq) const {
        const int row0 = u.pm * BM + wr * 64 + fr, col0 = u.pn * BM + wc * 32 + 8 * fq;
#pragma unroll
        for (int ai = 0; ai < 2; ++ai)
#pragma unroll
            for (int m = 0; m < 4; ++m) { const size_t ro = (size_t)(row0 + ai * HALF + m * 16) * GLW + col0;
#pragma unroll
                for (int bj = 0; bj < 2; ++bj) {
                    const u32x4 gw = *(const u32x4*)(GL + ro + bj * HALF);
                    const f32x4 v0 = acc[ai][bj][m][0], v1 = acc[ai][bj][m][1];
                    float o[8];
                    o[0] = v0[0] / (1.0f + __expf(-bf2f(gw.x & 0xffffu))); o[1] = v0[1] / (1.0f + __expf(-bf2f(gw.x >> 16)));
                    o[2] = v0[2] / (1.0f + __expf(-bf2f(gw.y & 0xffffu))); o[3] = v0[3] / (1.0f + __expf(-bf2f(gw.y >> 16)));
                    o[4] = v1[0] / (1.0f + __expf(-bf2f(gw.z & 0xffffu))); o[5] = v1[1] / (1.0f + __expf(-bf2f(gw.z >> 16)));
                    o[6] = v1[2] / (1.0f + __expf(-bf2f(gw.w & 0xffffu))); o[7] = v1[3] / (1.0f + __expf(-bf2f(gw.w >> 16)));
                    u32x4 w; w.x = cvt_pk_bf16(o[0], o[1]); w.y = cvt_pk_bf16(o[2], o[3]); w.z = cvt_pk_bf16(o[4], o[5]); w.w = cvt_pk_bf16(o[6], o[7]);
                    *(u32x4*)(PROJ + ro + bj * HALF) = w; } }
    }
};
}

enum { I_X = 0, I_C, I_CTX, I_CCTX, I_ADAW, I_ADAB, I_NF1, I_NMIX, I_NF2, I_F1WI, I_F1WO, I_F2WI, I_F2WO, I_WIN, I_HGLB, I_HGNORM, I_RWSHIFT, I_RWW0, I_RWW2, I_RWA0, I_RWA2,
       I_RWKK, I_RWKA, I_RWRK, I_RWLNW, I_RWLNB, I_NAQN, I_NAKN, I_NARPB, I_WAQN, I_WAKN, I_WASINK, I_WBR, I_WOUT, N_IN };
struct Args { const float* in[N_IN]; float* out; unsigned char* ws; int ph_lo, ph_hi; };
struct Ctx {
    LAS unsigned char* lds;
    int tid, lane, wave, bid, G;
    const Args __attribute__((address_space(4)))* ka; float* out; unsigned char* ws;
};
#define WSP(T, off) ((T*)(C.ws + (off)))
__device__ __forceinline__ void relaunder(Ctx& C) {
    int t = C.tid, b = C.bid, g = C.G;
    asm volatile("" : "+v"(t), "+v"(b), "+v"(g));
    C.tid = t; C.lane = t & 63; C.wave = __builtin_amdgcn_readfirstlane(t >> 6); C.bid = __builtin_amdgcn_readfirstlane(b); C.G = __builtin_amdgcn_readfirstlane(g);
}

__device__ __forceinline__ void transpose_item(const float* W, int K, int N, bf16_t* WT, int mode, LAS float* scr, int item, int lane) {
    const int nblk = N / 32, kb = item / nblk, nb = item % nblk, k0 = 64 * kb, n0 = 32 * nb;
    int drow0 = n0;
    if (mode == 1) { const int half = n0 / DFF, j0 = n0 % DFF; drow0 = 256 * (j0 / 128) + 128 * half + (j0 % 128); }
#pragma unroll 8
    for (int i = 0; i < 32; ++i) { const int kk = 2 * i + (lane >> 5); scr[kk * 33 + (lane & 31)] = W[(size_t)(k0 + kk) * N + n0 + (lane & 31)]; }
    LDS_WAIT(); asm volatile("" ::: "memory");
    const int c = lane & 7;
#pragma unroll
    for (int j = 0; j < 4; ++j) { const int n = (lane >> 3) + 8 * j; const LAS float* s = scr + (8 * c) * 33 + n;
        u32x4 o; o.x = pk2(s[0 * 33], s[1 * 33]); o.y = pk2(s[2 * 33], s[3 * 33]); o.z = pk2(s[4 * 33], s[5 * 33]); o.w = pk2(s[6 * 33], s[7 * 33]);
        *(u32x4*)(WT + (size_t)(drow0 + n) * K + k0 + 8 * c) = o; }
    LDS_WAIT(); asm volatile("" ::: "memory");
}
__device__ __forceinline__ void phase_convert(Ctx& C, int l) {
    LAS float* scr = (LAS float*)(C.lds + C.wave * 16384);
    const int gw = C.bid * NWAVES + C.wave, NGW = C.G * NWAVES;
    constexpr int I_WI = (D / 64) * (2 * DFF / 32), I_WO = (DFF / 64) * (D / 32), I_IN = (D / 64) * (PTOT / 32), I_BR = (512 / 64) * (D / 32), I_OUT = (D / 64) * (D / 32);
    constexpr int NITEMS = 2 * I_WI + 2 * I_WO + I_IN + 4 * I_BR + I_OUT;
    for (int it = gw; it < NITEMS; it += NGW) {
        int r = it;
        if (r < I_WI) { transpose_item(C.ka->in[I_F1WI] + (size_t)l * D * 2 * DFF, D, 2 * DFF, WSP(bf16_t, OFF_WI1), 1, scr, r, C.lane); continue; } r -= I_WI;
        if (r < I_WI) { transpose_item(C.ka->in[I_F2WI] + (size_t)l * D * 2 * DFF, D, 2 * DFF, WSP(bf16_t, OFF_WI2), 1, scr, r, C.lane); continue; } r -= I_WI;
        if (r < I_WO) { transpose_item(C.ka->in[I_F1WO] + (size_t)l * DFF * D, DFF, D, WSP(bf16_t, OFF_WO1), 0, scr, r, C.lane); continue; } r -= I_WO;
        if (r < I_WO) { transpose_item(C.ka->in[I_F2WO] + (size_t)l * DFF * D, DFF, D, WSP(bf16_t, OFF_WO2), 0, scr, r, C.lane); continue; } r -= I_WO;
        if (r < I_IN) { transpose_item(C.ka->in[I_WIN] + (size_t)l * D * PTOT, D, PTOT, WSP(bf16_t, OFF_WIN), 0, scr, r, C.lane); continue; } r -= I_IN;
        if (r < 4 * I_BR) { const int g = r / I_BR; transpose_item(C.ka->in[I_WBR] + ((size_t)l * 4 + g) * 512 * D, 512, D, WSP(bf16_t, OFF_WBR) + (size_t)g * D * 512, 0, scr, r % I_BR, C.lane); continue; } r -= 4 * I_BR;
        transpose_item(C.ka->in[I_WOUT] + (size_t)l * D * D, D, D, WSP(bf16_t, OFF_WOUT), 0, scr, r, C.lane);
    }
}

__device__ __forceinline__ void phase_ada_partial(Ctx& C) {
    float* modp = WSP(float, OFF_MODP);
    for (int u = C.bid; u < DEPTH * 9 * KSPLIT; u += C.G) {
        const int l = u / (9 * KSPLIT), rem = u % (9 * KSPLIT), cg = rem / KSPLIT, ks = rem % KSPLIT;
        const int col = cg * 2048 + C.tid * 4;
        const float* W = C.ka->in[I_ADAW] + (size_t)l * D * MODW;
        f32x4 a0 = {0.f, 0.f, 0.f, 0.f}, a1 = {0.f, 0.f, 0.f, 0.f};
        for (int i = ks * 64; i < ks * 64 + 64; ++i) {
            const float c0 = C.ka->in[I_C][i], c1 = C.ka->in[I_CCTX][i];
            const float s0 = siluf_(c0), s1 = siluf_(c1);
            const f32x4 w = *(const f32x4*)(W + (size_t)i * MODW + col);
            a0 += w * s0; a1 += w * s1;
        }
        *(f32x4*)(modp + ((size_t)(l * KSPLIT + ks) * 2 + 0) * MODW + col) = a0;
        *(f32x4*)(modp + ((size_t)(l * KSPLIT + ks) * 2 + 1) * MODW + col) = a1;
    }
    f32x4* X = WSP(f32x4, OFF_X);
    const f32x4* xs = (const f32x4*)C.ka->in[I_X]; const f32x4* cs = (const f32x4*)C.ka->in[I_CTX];
    const size_t n_lat = (size_t)SEQ * D / 4, n_all = (size_t)MT * D / 4;
    for (size_t i = (size_t)C.bid * NT + C.tid; i < n_all; i += (size_t)C.G * NT) X[i] = i < n_lat ? xs[i] : cs[i - n_lat];
}
__device__ __forceinline__ void phase_ada_reduce(Ctx& C) {
    const float* modp = WSP(float, OFF_MODP); float* mod = WSP(float, OFF_MOD);
    for (int e = C.bid * NT + C.tid; e < DEPTH * 2 * MODW; e += C.G * NT) {
        const int l = e / (2 * MODW), s = (e / MODW) % 2, j = e % MODW;
        float a = C.ka->in[I_ADAB][(size_t)l * MODW + j];
        for (int ks = 0; ks < KSPLIT; ++ks) a += modp[((size_t)(l * KSPLIT + ks) * 2 + s) * MODW + j];
        mod[e] = a;
    }
}
__device__ __forceinline__ const float* mod_ptr(Ctx& C, int l, int s, int idx) { return WSP(float, OFF_MOD) + ((size_t)(l * 2 + s) * NMOD + idx) * D; }

__device__ __forceinline__ void phase_norm(Ctx& C, int l, const float* gw  , int shift_idx) {
    const int gwv = C.bid * NWAVES + C.wave, NGW = C.G * NWAVES;
    const float* X = WSP(float, OFF_X); bf16_t* H = WSP(bf16_t, OFF_H);
    for (int r = gwv; r < MT; r += NGW) {
        const int s = r >= SEQ ? 1 : 0;
        const float* sh = mod_ptr(C, l, s, shift_idx); const float* sc = mod_ptr(C, l, s, shift_idx + 1);
        const f32x4* xr = (const f32x4*)(X + (size_t)r * D) + C.lane;
        f32x4 v[8]; float ss = 0.f;
#pragma unroll
        for (int j = 0; j < 8; ++j) { v[j] = xr[64 * j]; ss += (v[j].x * v[j].x + v[j].y * v[j].y) + (v[j].z * v[j].z + v[j].w * v[j].w); }
        const float rstd = rsqrtf(wave_sum(ss) * (1.0f / D) + EPS);
        u32x2* o8 = (u32x2*)(H + (size_t)r * D) + C.lane;
#pragma unroll
        for (int j = 0; j < 8; ++j) {
            const int c = (64 * j + C.lane) * 4;
            const f32x4 g4 = *(const f32x4*)(gw + c), s4 = *(const f32x4*)(sc + c), h4 = *(const f32x4*)(sh + c);
            const f32x4 y = (v[j] * rstd) * g4 * (s4 + 1.0f) + h4;
            u32x2 w; w.x = pk2(y.x, y.y); w.y = pk2(y.z, y.w); o8[64 * j] = w;
        }
    }
}

__device__ __forceinline__ void phase_rw_prep(Ctx& C, int l, int b0, int nb) {
    const float* P = WSP(float, OFF_P32); float* SCN = WSP(float, OFF_SCN); float* VV = WSP(float, OFF_VV); float* GS = WSP(float, OFF_GS);
    LAS float* lin = (LAS float*)C.lds;
    const float* taps = C.ka->in[I_RWSHIFT] + (size_t)l * 3 * RWC;
    const int c = C.tid, h = c >> 6, e = c & 63;
    const float kkw = C.ka->in[I_RWKK][l * 512 + c], kaw = C.ka->in[I_RWKA][l * 512 + c];
    for (int r = b0; r < MT; r += nb) {
        const bool hp = (r != 0 && r != SEQ), hn = (r != SEQ - 1 && r != MT - 1);
        const float* p0 = P + (size_t)r * P32W + RW_OFF;
        float xs[5];
#pragma unroll
        for (int q = 0; q < 5; ++q) {
            const int col = q * 512 + c;
            float v = 0.f;
            if (q < 4 || c < 256) {
                v = taps[RWC + col] * p0[col];
                if (hp) v += taps[col] * p0[col - P32W];
                if (hn) v += taps[2 * RWC + col] * p0[col + P32W];
            }
            xs[q] = v;
        }
        __syncthreads();
        if (c < 256) lin[c] = c < 128 ? tanhf(xs[4]) : xs[4];
        __syncthreads();
        const float rr = xs[0], kk_raw = xs[1], vv = xs[2], gg = xs[3];
        const float kk0 = kk_raw * kkw;
        const float kkn = kk0 * rsqrtf(wave_sum(kk0 * kk0) + EPS);
        VV[(size_t)r * 512 + c] = vv; GS[(size_t)r * 512 + c] = sigmoidf_(gg);
#pragma unroll
        for (int d = 0; d < 2; ++d) {
            const float* w2 = C.ka->in[I_RWW2] + ((size_t)(l * 2 + d) * 64) * 512 + c;
            const float* a2 = C.ka->in[I_RWA2] + ((size_t)(l * 2 + d) * 64) * 512 + c;
            float z = C.ka->in[I_RWW0][(l * 2 + d) * 512 + c], az = C.ka->in[I_RWA0][(l * 2 + d) * 512 + c];
#pragma unroll 8
            for (int j = 0; j < 64; ++j) { z += lin[d * 64 + j] * w2[(size_t)j * 512]; az += lin[128 + d * 64 + j] * a2[(size_t)j * 512]; }
            const float y = -z; const float sp = fmaxf(y, 0.f) + log1pf(expf(-fabsf(y)));
            const float lw = -sp - 0.5f;
            const float decay = expf(-expf(lw));
            const float a = sigmoidf_(az);
            const float kd = kk_raw * (1.0f + (a - 1.0f) * kaw);
            float* o = SCN + ((size_t)((d * 8 + h) * MT + row_seq(d, r))) * 320 + e;
            o[0] = decay; o[64] = kkn; o[128] = a * kkn; o[192] = kd; o[256] = rr;
        }
    }
}

__device__ __forceinline__ void phase_attn_prep(Ctx& C, int l, int w0, int nw) {
    bf16_t* PA = WSP(bf16_t, OFF_PA);
    const int e = C.lane;
    const float na_qn = C.ka->in[I_NAQN][l * 64 + e], na_kn = C.ka->in[I_NAKN][l * 64 + e], wa_qn = C.ka->in[I_WAQN][l * 64 + e], wa_kn = C.ka->in[I_WAKN][l * 64 + e];
    const int m16 = e & 15;
    const float inv = powf(10000.0f, -(float)m16 / 16.0f);
    for (long uidx = w0; uidx < (long)MT * 26; uidx += nw) {
        const int r = (int)(uidx / 26), v = (int)(uidx % 26);
        int col; float nwt, scl; bool rope;
        if (v < 8) { col = v * 64; nwt = na_qn; scl = 0.125f; rope = false; }
        else if (v < 16) { col = 512 + (v - 8) * 64; nwt = na_kn; scl = 1.0f; rope = false; }
        else if (v < 24) { col = 1536 + (v - 16) * 64; nwt = wa_qn; scl = 0.125f; rope = true; }
        else { col = 2048 + (v - 24) * 64; nwt = wa_kn; scl = 1.0f; rope = true; }
        bf16_t* p = PA + (size_t)r * PAW + col + e;
        const float x = bf2f(*p);
        const float ss = wave_sum(x * x);
        float y = x * rsqrtf(ss * (1.0f / 64.0f) + EPS) * nwt * scl;
        if (rope && r < SEQ) {
            const int pos = (e >> 5) ? (r & 63) : (r >> 6);
            const float ang = (float)pos * inv;
            float sn, cs; sincosf(ang, &sn, &cs);
            const bool lo = (e & 31) < 16;
            const float yp = __shfl(y, lo ? e + 16 : e - 16);
            y = lo ? (y * cs - yp * sn) : (yp * sn + y * cs);
        }
        *p = (bf16_t)f2bf(y);
    }
}

__device__ __forceinline__ float hg_lb(Ctx& C, int l, int d, int c) {
    if (l == 0) return 0.f;
    const float a0 = C.ka->in[I_HGLB][(size_t)(d * DEPTH + 0) * 512 + c], a1 = C.ka->in[I_HGLB][(size_t)(d * DEPTH + 1) * 512 + c];
    const float m = fmaxf(a0, a1); const float e0 = expf(a0 - m), e1 = expf(a1 - m);
    return e1 / (e0 + e1);
}
__device__ __forceinline__ void phase_hg_A(Ctx& C, int l, int b0, int nb) {
    const float* P = WSP(float, OFF_P32); float* HGL = WSP(float, OFF_HGL); float* HGD = WSP(float, OFF_HGD);
    LAS float* Ii = (LAS float*)C.lds;
    LAS float* LF = Ii + 64 * 128;
    LAS float* KD = LF + 64 * 128;
    const int k = C.tid & 127, vq = C.tid >> 7;
    for (int u = b0; u < 2 * 4 * NCH; u += nb) {
        const int d = u / (4 * NCH), h = (u / NCH) % 4, c = u % NCH;
        const float lb = hg_lb(C, l, d, h * 128 + k);
        __syncthreads();
#pragma unroll 4
        for (int i = 0; i < 16; ++i) {
            const int s = 16 * vq + i; const int row = seq_row(d, 64 * c + s);
            const float* pr = P + (size_t)row * P32W;
            Ii[s * 128 + k] = pr[1536 + h * 128 + k];
            const float fr = pr[512 + d * 512 + h * 128 + k];
            const float f = lb + (1.0f - lb) * sigmoidf_(fr);
            LF[s * 128 + k] = logf(f); KD[s * 128 + k] = 1.0f - f;
        }
        __syncthreads();
        float bend = 0.f;
        for (int s = 0; s < 64; ++s) bend += LF[s * 128 + k];
        float acc[32];
#pragma unroll
        for (int j = 0; j < 32; ++j) acc[j] = 0.f;
        float b = 0.f;
        for (int s = 0; s < 64; ++s) {
            b += LF[s * 128 + k];
            const float w = KD[s * 128 + k] * expf(bend - b);
            const LAS f32x4* iv = (const LAS f32x4*)(Ii + s * 128 + 32 * vq);
#pragma unroll
            for (int j = 0; j < 8; ++j) { const f32x4 x = iv[j]; acc[4 * j] += w * x.x; acc[4 * j + 1] += w * x.y; acc[4 * j + 2] += w * x.z; acc[4 * j + 3] += w * x.w; }
        }
        float* o = HGL + ((size_t)((d * 4 + h) * NCH + c) * 128 + k) * 128 + 32 * vq;
#pragma unroll
        for (int j = 0; j < 8; ++j) *(f32x4*)(o + 4 * j) = (f32x4){acc[4 * j], acc[4 * j + 1], acc[4 * j + 2], acc[4 * j + 3]};
        if (vq == 0) HGD[(size_t)((d * 4 + h) * NCH + c) * 128 + k] = expf(bend);
    }
}
__device__ __forceinline__ void phase_hg_B(Ctx& C, int b0, int nb) {
    float* HGL = WSP(float, OFF_HGL); const float* HGD = WSP(float, OFF_HGD);
    for (int e = b0 * NT + C.tid; e < 8 * 16384; e += nb * NT) {
        const int dh = e >> 14, kv = e & 16383, k = kv >> 7;
        float st = 0.f;
        float* p = HGL + (size_t)dh * NCH * 16384 + kv; const float* dp = HGD + (size_t)dh * NCH * 128 + k;
#pragma unroll 4
        for (int c = 0; c < NCH; ++c) { const float Lc = p[(size_t)c * 16384], Dc = dp[c * 128]; p[(size_t)c * 16384] = st; st = Dc * st + Lc; }
    }
}
__device__ __forceinline__ void phase_hg_C(Ctx& C, int l, int b0, int nb) {
    const float* P = WSP(float, OFF_P32); const float* HGL = WSP(float, OFF_HGL); bf16_t* YB = WSP(bf16_t, OFF_YB);
    constexpr int LDP = 132, LDA = 68;
    LAS float* Q = (LAS float*)C.lds;
    LAS float* B = Q + 64 * LDP;
    LAS float* KD = B + 64 * LDP;
    LAS float* ATT = KD + 64 * LDP;
    LAS float* RED = ATT + 64 * LDA;
    const int k = C.tid & 127, tq = C.tid >> 7;
    for (int u = b0; u < 4 * NCH; u += nb) {
        const int h = u / NCH, tc = u % NCH;
        float o[16];
#pragma unroll
        for (int j = 0; j < 16; ++j) o[j] = 0.f;
#pragma unroll 1
        for (int d = 0; d < 2; ++d) {
            const float lb = hg_lb(C, l, d, h * 128 + k);
            const int cd = d == 0 ? (tc + 4) % NCH : (NCH - 1 - tc);
            __syncthreads();
#pragma unroll 4
            for (int i = 0; i < 16; ++i) {
                const int rl = 16 * tq + i; const float* pr = P + (size_t)(64 * tc + rl) * P32W;
                Q[rl * LDP + k] = pr[h * 128 + k];
                const float fr = pr[512 + d * 512 + h * 128 + k];
                const float f = lb + (1.0f - lb) * sigmoidf_(fr);
                B[rl * LDP + k] = logf(f); KD[rl * LDP + k] = 1.0f - f;
            }
            __syncthreads();
            if (C.tid < 128) {
                float b = 0.f;
                if (d == 0) { for (int rl = 0; rl < 64; ++rl) { b += B[rl * LDP + k]; B[rl * LDP + k] = b; } }
                else { for (int rl = 63; rl >= 0; --rl) { b += B[rl * LDP + k]; B[rl * LDP + k] = b; } }
            }
            __syncthreads();
            {
                const int t = C.tid >> 3, sg = C.tid & 7;
                float a[8];
#pragma unroll
                for (int i = 0; i < 8; ++i) a[i] = 0.f;
                for (int kk = 0; kk < 128; kk += 4) {
                    const f32x4 qt = *(const LAS f32x4*)(Q + t * LDP + kk), bt = *(const LAS f32x4*)(B + t * LDP + kk);
#pragma unroll
                    for (int i = 0; i < 8; ++i) {
                        const int s = sg + 8 * i;
                        const f32x4 ks = *(const LAS f32x4*)(KD + s * LDP + kk), bs = *(const LAS f32x4*)(B + s * LDP + kk);
                        a[i] += qt.x * ks.x * __expf(fminf(bt.x - bs.x, 0.f)) + qt.y * ks.y * __expf(fminf(bt.y - bs.y, 0.f))
                              + qt.z * ks.z * __expf(fminf(bt.z - bs.z, 0.f)) + qt.w * ks.w * __expf(fminf(bt.w - bs.w, 0.f));
                    }
                }
#pragma unroll
                for (int i = 0; i < 8; ++i) { const int s = sg + 8 * i; const bool valid = d == 0 ? (s <= t) : (s >= t); ATT[t * LDA + s] = valid ? a[i] : 0.f; }
            }
            __syncthreads();
            LAS float* Iv = KD;
#pragma unroll 4
            for (int i = 0; i < 16; ++i) {
                const int rl = 16 * tq + i;
                Iv[rl * 128 + k] = P[(size_t)(64 * tc + rl) * P32W + 1536 + h * 128 + k];
                Q[rl * LDP + k] = Q[rl * LDP + k] * __expf(B[rl * LDP + k]);
            }
            __syncthreads();
            for (int s = 0; s < 64; s += 4) {
                const float i0 = Iv[(s + 0) * 128 + k], i1 = Iv[(s + 1) * 128 + k], i2 = Iv[(s + 2) * 128 + k], i3 = Iv[(s + 3) * 128 + k];
#pragma unroll
                for (int j = 0; j < 16; ++j) { const f32x4 a4 = *(const LAS f32x4*)(ATT + (16 * tq + j) * LDA + s); o[j] += a4.x * i0 + a4.y * i1 + a4.z * i2 + a4.w * i3; }
            }
            const float* Sp = HGL + (size_t)((d * 4 + h) * NCH + cd) * 16384 + k;
            for (int kk = 0; kk < 128; kk += 4) {
                const float s0 = Sp[(size_t)(kk + 0) * 128], s1 = Sp[(size_t)(kk + 1) * 128], s2 = Sp[(size_t)(kk + 2) * 128], s3 = Sp[(size_t)(kk + 3) * 128];
#pragma unroll
                for (int j = 0; j < 16; ++j) { const f32x4 q4 = *(const LAS f32x4*)(Q + (16 * tq + j) * LDP + kk); o[j] += q4.x * s0 + q4.y * s1 + q4.z * s2 + q4.w * s3; }
            }
        }
        __syncthreads();
#pragma unroll
        for (int j = 0; j < 16; ++j) { const float ss = wave_sum(o[j] * o[j]); if (C.lane == 0) RED[C.wave * 16 + j] = ss; }
        __syncthreads();
        const float nw = C.ka->in[I_HGNORM][l * 512 + h * 128 + k];
#pragma unroll
        for (int j = 0; j < 16; ++j) {
            const int row = 64 * tc + 16 * tq + j;
            const float tot = RED[(2 * tq) * 16 + j] + RED[(2 * tq + 1) * 16 + j];
            const float g = P[(size_t)row * P32W + 2048 + h * 128 + k];
            const float y = o[j] * rsqrtf(tot * (1.0f / 128.0f) + EPS) * nw * siluf_(g);
            YB[(size_t)row * 512 + h * 128 + k] = (bf16_t)f2bf(y);
        }
    }
}

__device__ __forceinline__ void phase_rw_scan(Ctx& C, int b0, int nb) {
    const float* SCN = WSP(float, OFF_SCN); const float* VV = WSP(float, OFF_VV); float* RO = WSP(float, OFF_RO);
    constexpr int STEPS = 32, SW = 384;
    LAS float* buf = (LAS float*)C.lds;
    for (int job = b0; job < 128; job += nb) {
        const int d = job >> 6, h = (job >> 3) & 7, rg = job & 7;
        const float* src = SCN + (size_t)((d * 8 + h) * MT) * 320;
        f32x4 regs[6];
#define load_chunk(ci) do { _Pragma("unroll") for (int i = 0; i < 6; ++i) { \
                const int q = C.tid + NT * i, st = q / 96, w = q % 96, j = STEPS * (ci) + st; \
                regs[i] = w < 80 ? *(const f32x4*)(src + (size_t)j * 320 + w * 4) : *(const f32x4*)(VV + (size_t)seq_row(d, j) * 512 + h * 64 + (w - 80) * 4); } } while (0)
#define store_chunk(bi) do { _Pragma("unroll") for (int i = 0; i < 6; ++i) { const int q = C.tid + NT * i; *(LAS f32x4*)(buf + (bi) * STEPS * SW + q * 4) = regs[i]; } } while (0)
        __syncthreads();
        load_chunk(0); store_chunk(0);
        __syncthreads();
        float S[8];
#pragma unroll
        for (int i = 0; i < 8; ++i) S[i] = 0.f;
        const int rr = C.lane >> 3, ks = C.lane & 7;
        constexpr int NCHK = MT / STEPS;
        for (int ci = 0; ci < NCHK; ++ci) {
            if (ci + 1 < NCHK) load_chunk(ci + 1);
            if (C.wave == 0) {
                const LAS float* bb = buf + (ci & 1) * STEPS * SW;
                for (int st = 0; st < STEPS; ++st) {
                    const LAS float* sp = bb + st * SW + 8 * ks;
                    const f32x4 w0 = *(const LAS f32x4*)(sp), w1 = *(const LAS f32x4*)(sp + 4);
                    const f32x4 k0 = *(const LAS f32x4*)(sp + 64), k1 = *(const LAS f32x4*)(sp + 68);
                    const f32x4 a0 = *(const LAS f32x4*)(sp + 128), a1 = *(const LAS f32x4*)(sp + 132);
                    const f32x4 d0 = *(const LAS f32x4*)(sp + 192), d1 = *(const LAS f32x4*)(sp + 196);
                    const f32x4 r0 = *(const LAS f32x4*)(sp + 256), r1 = *(const LAS f32x4*)(sp + 260);
                    const float vv = bb[st * SW + 320 + rg * 8 + rr];
                    float dot = (S[0] * k0.x + S[1] * k0.y) + (S[2] * k0.z + S[3] * k0.w) + (S[4] * k1.x + S[5] * k1.y) + (S[6] * k1.z + S[7] * k1.w);
                    dot += __shfl_xor(dot, 1); dot += __shfl_xor(dot, 2); dot += __shfl_xor(dot, 4);
                    S[0] = S[0] * w0.x - dot * a0.x + vv * d0.x; S[1] = S[1] * w0.y - dot * a0.y + vv * d0.y;
                    S[2] = S[2] * w0.z - dot * a0.z + vv * d0.z; S[3] = S[3] * w0.w - dot * a0.w + vv * d0.w;
                    S[4] = S[4] * w1.x - dot * a1.x + vv * d1.x; S[5] = S[5] * w1.y - dot * a1.y + vv * d1.y;
                    S[6] = S[6] * w1.z - dot * a1.z + vv * d1.z; S[7] = S[7] * w1.w - dot * a1.w + vv * d1.w;
                    float od = (S[0] * r0.x + S[1] * r0.y) + (S[2] * r0.z + S[3] * r0.w) + (S[4] * r1.x + S[5] * r1.y) + (S[6] * r1.z + S[7] * r1.w);
                    od += __shfl_xor(od, 1); od += __shfl_xor(od, 2); od += __shfl_xor(od, 4);
                    if (ks == 0) RO[((size_t)d * MT + seq_row(d, STEPS * ci + st)) * 512 + h * 64 + rg * 8 + rr] = od;
                }
            }
            if (ci + 1 < NCHK) store_chunk((ci + 1) & 1);
            __syncthreads();
        }
    }
#undef load_chunk
#undef store_chunk
}
__device__ __forceinline__ void phase_rw_finish(Ctx& C, int l, int w0, int nw) {
    const float* SCN = WSP(float, OFF_SCN); const float* VV = WSP(float, OFF_VV); const float* GS = WSP(float, OFF_GS); const float* RO = WSP(float, OFF_RO);
    bf16_t* YB = WSP(bf16_t, OFF_YB) + (size_t)1 * MT * 512;
    const int e = C.lane;
    for (int uidx = w0; uidx < MT * 8; uidx += nw) {
        const int r = uidx >> 3, h = uidx & 7, c = h * 64 + e;
        const float o = RO[(size_t)r * 512 + c] + RO[((size_t)MT + r) * 512 + c];
        const float mu = wave_sum(o) * (1.0f / 64.0f);
        const float dv = o - mu;
        const float var = wave_sum(dv * dv) * (1.0f / 64.0f);
        const float on = dv * rsqrtf(var + RW_GN_EPS) * C.ka->in[I_RWLNW][l * 512 + c] + C.ka->in[I_RWLNB][l * 512 + c];
        const float* s0 = SCN + ((size_t)((0 * 8 + h) * MT + row_seq(0, r))) * 320 + e;
        const float* s1 = SCN + ((size_t)((1 * 8 + h) * MT + row_seq(1, r))) * 320 + e;
        const float kdsum = s0[192] + s1[192], rr = s0[256];
        const float bonus = wave_sum(rr * kdsum * C.ka->in[I_RWRK][l * 512 + c]);
        const float y = (on + bonus * VV[(size_t)r * 512 + c]) * GS[(size_t)r * 512 + c];
        YB[(size_t)r * 512 + c] = (bf16_t)f2bf(y);
    }
}

__device__ __forceinline__ float dot64_bf16(const float (&q)[64], const bf16_t* kp) {
    float s = 0.f;
#pragma unroll
    for (int j = 0; j < 8; ++j) {
        const u32x4 w = *(const u32x4*)(kp + 8 * j);
        s += q[8 * j + 0] * bf2f(w.x & 0xffffu) + q[8 * j + 1] * bf2f(w.x >> 16) + q[8 * j + 2] * bf2f(w.y & 0xffffu) + q[8 * j + 3] * bf2f(w.y >> 16)
           + q[8 * j + 4] * bf2f(w.z & 0xffffu) + q[8 * j + 5] * bf2f(w.z >> 16) + q[8 * j + 6] * bf2f(w.w & 0xffffu) + q[8 * j + 7] * bf2f(w.w >> 16);
    }
    return s;
}
__device__ __forceinline__ void load_q64(float (&q)[64], const bf16_t* qp) {
#pragma unroll
    for (int j = 0; j < 8; ++j) {
        const u32x4 w = *(const u32x4*)(qp + 8 * j);
        q[8 * j + 0] = bf2f(w.x & 0xffffu); q[8 * j + 1] = bf2f(w.x >> 16); q[8 * j + 2] = bf2f(w.y & 0xffffu); q[8 * j + 3] = bf2f(w.y >> 16);
        q[8 * j + 4] = bf2f(w.z & 0xffffu); q[8 * j + 5] = bf2f(w.z >> 16); q[8 * j + 6] = bf2f(w.w & 0xffffu); q[8 * j + 7] = bf2f(w.w >> 16);
    }
}
__device__ __forceinline__ void phase_na(Ctx& C, int l, int w0, int nw) {
    const bf16_t* PA = WSP(bf16_t, OFF_PA); bf16_t* YB = WSP(bf16_t, OFF_YB) + (size_t)2 * MT * 512;
    const float* rpb = C.ka->in[I_NARPB] + (size_t)l * 8 * 15 * 31;
    const int lane = C.lane;
    for (int uidx = w0; uidx < MT * 8; uidx += nw) {
        const int r = __builtin_amdgcn_readfirstlane(uidx >> 3), h = __builtin_amdgcn_readfirstlane(uidx & 7);
        float q[64]; load_q64(q, PA + (size_t)r * PAW + h * 64);
        const bool lat = r < SEQ;
        const int i = r >> 6, j = r & 63;
        int rs = i - 4; rs = rs < 0 ? 0 : (rs > 120 ? 120 : rs);
        int cs = j - 8; cs = cs < 0 ? 0 : (cs > 48 ? 48 : cs);
        float sc[6]; int kt[6];
#pragma unroll
        for (int it = 0; it < 2; ++it) {
            const int idx = lane + 64 * it, a = idx >> 4, cc = idx & 15;
            kt[it] = (rs + a) * 64 + cs + cc;
            if (lat) sc[it] = dot64_bf16(q, PA + (size_t)kt[it] * PAW + 512 + h * 64) + rpb[(h * 15 + (rs + a - i + 7)) * 31 + (cs + cc - j + 15)];
            else sc[it] = -INFINITY;
        }
#pragma unroll
        for (int it = 2; it < 6; ++it) { kt[it] = SEQ + lane + 64 * (it - 2); sc[it] = dot64_bf16(q, PA + (size_t)kt[it] * PAW + 512 + h * 64); }
        float mx = sc[0];
#pragma unroll
        for (int it = 1; it < 6; ++it) mx = fmaxf(mx, sc[it]);
        mx = wave_max(mx);
        float sum = 0.f;
#pragma unroll
        for (int it = 0; it < 6; ++it) { sc[it] = __expf(sc[it] - mx); sum += sc[it]; }
        sum = wave_sum(sum);
        const float rinv = 1.0f / sum;
        float o = 0.f;
#pragma unroll
        for (int it = 0; it < 6; ++it) {
            if (it < 2 && !lat) continue;
            for (int src = 0; src < 64; ++src) {
                const float p = __shfl(sc[it], src); const int kk = __shfl(kt[it], src);
                o += p * bf2f(PA[(size_t)kk * PAW + 1024 + h * 64 + lane]);
            }
        }
        YB[(size_t)r * 512 + h * 64 + lane] = (bf16_t)f2bf(o * rinv);
    }
}
__device__ __forceinline__ void phase_wa(Ctx& C, int l, int w0, int nw) {
    const bf16_t* PA = WSP(bf16_t, OFF_PA); bf16_t* YB = WSP(bf16_t, OFF_YB) + (size_t)3 * MT * 512;
    const int lane = C.lane;
    for (int uidx = w0; uidx < MT * 8; uidx += nw) {
        const int r = __builtin_amdgcn_readfirstlane(uidx >> 3), hq = __builtin_amdgcn_readfirstlane(uidx & 7), kvh = hq >> 2;
        float q[64]; load_q64(q, PA + (size_t)r * PAW + 1536 + hq * 64);
        const bool lat = r < SEQ;
        const float sink = C.ka->in[I_WASINK][l * 8 + hq];
        float sc[9]; int kt[9];
#pragma unroll
        for (int it = 0; it < 5; ++it) {
            const int idx = lane + 64 * it, kp = r - 128 + idx;
            const bool valid = lat && idx <= 256 && kp >= 0 && kp < SEQ;
            kt[it] = valid ? kp : 0;
            sc[it] = valid ? dot64_bf16(q, PA + (size_t)kp * PAW + 2048 + kvh * 64) : -INFINITY;
        }
#pragma unroll
        for (int it = 5; it < 9; ++it) { kt[it] = SEQ + lane + 64 * (it - 5); sc[it] = dot64_bf16(q, PA + (size_t)kt[it] * PAW + 2048 + kvh * 64); }
        float mx = sink;
#pragma unroll
        for (int it = 0; it < 9; ++it) mx = fmaxf(mx, sc[it]);
        mx = wave_max(mx);
        float sum = 0.f;
#pragma unroll
        for (int it = 0; it < 9; ++it) { sc[it] = __expf(sc[it] - mx); sum += sc[it]; }
        sum = wave_sum(sum) + __expf(sink - mx);
        const float rinv = 1.0f / sum;
        float o = 0.f;
#pragma unroll
        for (int it = 0; it < 9; ++it) {
            if (it < 5 && !lat) continue;
            for (int src = 0; src < 64; ++src) {
                const float p = __shfl(sc[it], src); const int kk = __shfl(kt[it], src);
                o += p * bf2f(PA[(size_t)kk * PAW + 2176 + kvh * 64 + lane]);
            }
        }
        YB[(size_t)r * 512 + hq * 64 + lane] = (bf16_t)f2bf(o * rinv);
    }
}

__device__ __forceinline__ void phase_combine(Ctx& C) {
    const bf16_t* PROJ = WSP(bf16_t, OFF_P32); bf16_t* MG = WSP(bf16_t, OFF_H);
    const size_t n8 = (size_t)MT * D / 8;
    for (size_t i = (size_t)C.bid * NT + C.tid; i < n8; i += (size_t)C.G * NT) {
        const size_t r = i / (D / 8), c8 = i % (D / 8);
        float a[8];
#pragma unroll
        for (int j = 0; j < 8; ++j) a[j] = 0.f;
#pragma unroll
        for (int g = 0; g < 4; ++g) {
            const u32x4 w = *(const u32x4*)(PROJ + r * GLW + g * D + c8 * 8);
            a[0] += bf2f(w.x & 0xffffu); a[1] += bf2f(w.x >> 16); a[2] += bf2f(w.y & 0xffffu); a[3] += bf2f(w.y >> 16);
            a[4] += bf2f(w.z & 0xffffu); a[5] += bf2f(w.z >> 16); a[6] += bf2f(w.w & 0xffffu); a[7] += bf2f(w.w >> 16);
        }
        u32x4 o; o.x = pk2(a[0], a[1]); o.y = pk2(a[2], a[3]); o.z = pk2(a[4], a[5]); o.w = pk2(a[6], a[7]);
        *(u32x4*)(MG + r * D + c8 * 8) = o;
    }
}

constexpr int PH_PRO = 2, PH_PER_LAYER = 14, N_PHASES = PH_PRO + DEPTH * PH_PER_LAYER;

__global__ void __launch_bounds__(NT, 2) mk_fwd(Args args) {
    extern __shared__ __attribute__((aligned(16))) unsigned char lds_raw[];
    Ctx C;
    C.lds = (LAS unsigned char*)lds_raw;
    C.tid = threadIdx.x; C.lane = C.tid & 63; C.wave = __builtin_amdgcn_readfirstlane(C.tid >> 6);
    C.bid = blockIdx.x; C.G = gridDim.x;
    C.ka = (const Args __attribute__((address_space(4)))*)__builtin_amdgcn_kernarg_segment_ptr(); C.out = args.out; C.ws = args.ws;
    volatile LAS unsigned* MISC = (volatile LAS unsigned*)(C.lds + MISC_OFF);
    for (int u = C.tid; u < (LDS_BYTES - RING_BYTES) / 4; u += NT) ((LAS unsigned*)(C.lds + RING_BYTES))[u] = 0u;
    __syncthreads();
    const int lo = args.ph_lo, hi = args.ph_hi;
    XcdBarrier bar; bar.bar = WSP(unsigned, OFF_CTL) + 4096; bar.x = 0; bar.st = nullptr;
    const bool multi = (hi - lo) > 1;
    if (multi) bar = xcd_barrier_post(WSP(unsigned, OFF_CTL) + 4096, MISC + 8);
#ifndef PH_MASK
#define PH_MASK 0xFFFF
#endif
#ifndef PRO_MASK
#define PRO_MASK 3
#endif
#define IN(k) (lo <= (k) && (k) < hi)
#define LEN(j) (((PH_MASK) >> (j)) & 1)
#define SEAM(k) do { if (IN(k) && IN((k) + 1)) xcd_barrier(bar); } while (0)

    if ((PRO_MASK & 1) && IN(0)) { relaunder(C); phase_convert(C, 0); phase_ada_partial(C); } SEAM(0);
    if ((PRO_MASK & 2) && IN(1)) { relaunder(C); phase_ada_reduce(C); } SEAM(1);

#pragma unroll
    for (int l = 0; l < DEPTH; ++l) {
        const int pb = PH_PRO + l * PH_PER_LAYER;
        if (LEN(0) && IN(pb + 0)) { relaunder(C); if (l > 0) phase_convert(C, l); phase_norm(C, l, C.ka->in[I_NF1] + (size_t)l * D, 0); } SEAM(pb + 0);
        if (LEN(1) && IN(pb + 1)) { relaunder(C);
            pg8::Gemm g{WSP(bf16_t, OFF_H), WSP(bf16_t, OFF_WI1), MT, 2 * DFF, D, 1 << 20, 0};
            pg8::StaticOrder S; S.init(MT, 2 * DFF, C.G, C.bid);
            pg8::EpiSwiGLU E{WSP(bf16_t, OFF_G)};
            pg8::gemm_phase<pg8::EpiSwiGLU, true, false>(C.lds, g, S, E, C.tid);
        } SEAM(pb + 1);
        if (LEN(2) && IN(pb + 2)) { relaunder(C);
            pg8::Gemm g{WSP(bf16_t, OFF_G), WSP(bf16_t, OFF_WO1), MT, D, DFF, 1 << 20, 0};
            pg8::StaticOrder S; S.init(MT, D, C.G, C.bid);
            pg8::EpiResid<true> E{WSP(float, OFF_X), mod_ptr(C, l, 0, 2), mod_ptr(C, l, 1, 2), nullptr};
            pg8::gemm_phase<pg8::EpiResid<true>, true, false>(C.lds, g, S, E, C.tid);
        } SEAM(pb + 2);
        if (LEN(3) && IN(pb + 3)) { relaunder(C); phase_norm(C, l, C.ka->in[I_NMIX] + (size_t)l * D, 3); } SEAM(pb + 3);
        if (LEN(4) && IN(pb + 4)) { relaunder(C);
            pg8::Gemm g{WSP(bf16_t, OFF_H), WSP(bf16_t, OFF_WIN), MT, PTOT, D, 1 << 20, 0};
            pg8::StaticOrder S; S.init(MT, PTOT, C.G, C.bid);
            pg8::EpiWin E{WSP(float, OFF_P32), WSP(bf16_t, OFF_PA), WSP(bf16_t, OFF_GL)};
            pg8::gemm_phase<pg8::EpiWin, true, false>(C.lds, g, S, E, C.tid);
        } SEAM(pb + 4);
        if (LEN(5) && IN(pb + 5)) { relaunder(C);
            phase_rw_prep(C, l, C.bid, C.G);
            __syncthreads();
            phase_attn_prep(C, l, C.bid * NWAVES + C.wave, C.G * NWAVES);
            __syncthreads();
            phase_hg_A(C, l, C.bid, C.G);
        } SEAM(pb + 5);
        if (LEN(6) && IN(pb + 6)) { relaunder(C);
            if (C.G >= 256) {
                if (C.bid < 128) phase_rw_scan(C, C.bid, 128);
                else { const int b = C.bid - 128, n = C.G - 128; phase_hg_B(C, b, n); phase_na(C, l, b * NWAVES + C.wave, n * NWAVES); phase_wa(C, l, b * NWAVES + C.wave, n * NWAVES); }
            } else {
                phase_rw_scan(C, C.bid, C.G); phase_hg_B(C, C.bid, C.G); phase_na(C, l, C.bid * NWAVES + C.wave, C.G * NWAVES); phase_wa(C, l, C.bid * NWAVES + C.wave, C.G * NWAVES);
            }
        } SEAM(pb + 6);
        if (LEN(7) && IN(pb + 7)) { relaunder(C); phase_hg_C(C, l, C.bid, C.G); phase_rw_finish(C, l, C.bid * NWAVES + C.wave, C.G * NWAVES); } SEAM(pb + 7);
        if (LEN(8) && IN(pb + 8)) { relaunder(C);
            pg8::Gemm g{WSP(bf16_t, OFF_YB), WSP(bf16_t, OFF_WBR), MT, 4 * D, 512, 8, (size_t)MT * 512};
            pg8::StaticOrder S; S.init(MT, 4 * D, C.G, C.bid);
            pg8::EpiMerge E{WSP(bf16_t, OFF_GL), WSP(bf16_t, OFF_P32)};
            pg8::gemm_phase<pg8::EpiMerge, true, false>(C.lds, g, S, E, C.tid);
        } SEAM(pb + 8);
        if (LEN(9) && IN(pb + 9)) { relaunder(C); phase_combine(C); } SEAM(pb + 9);
        if (LEN(10) && IN(pb + 10)) { relaunder(C);
            pg8::Gemm g{WSP(bf16_t, OFF_H), WSP(bf16_t, OFF_WOUT), MT, D, D, 1 << 20, 0};
            pg8::StaticOrder S; S.init(MT, D, C.G, C.bid);
            pg8::EpiResid<false> E{WSP(float, OFF_X), mod_ptr(C, l, 0, 5), mod_ptr(C, l, 1, 5), nullptr};
            pg8::gemm_phase<pg8::EpiResid<false>, true, false>(C.lds, g, S, E, C.tid);
        } SEAM(pb + 10);
        if (LEN(11) && IN(pb + 11)) { relaunder(C); phase_norm(C, l, C.ka->in[I_NF2] + (size_t)l * D, 6); } SEAM(pb + 11);
        if (LEN(12) && IN(pb + 12)) { relaunder(C);
            pg8::Gemm g{WSP(bf16_t, OFF_H), WSP(bf16_t, OFF_WI2), MT, 2 * DFF, D, 1 << 20, 0};
            pg8::StaticOrder S; S.init(MT, 2 * DFF, C.G, C.bid);
            pg8::EpiSwiGLU E{WSP(bf16_t, OFF_G)};
            pg8::gemm_phase<pg8::EpiSwiGLU, true, false>(C.lds, g, S, E, C.tid);
        } SEAM(pb + 12);
        if (LEN(13) && IN(pb + 13)) { relaunder(C);
            pg8::Gemm g{WSP(bf16_t, OFF_G), WSP(bf16_t, OFF_WO2), MT, D, DFF, 1 << 20, 0};
            pg8::StaticOrder S; S.init(MT, D, C.G, C.bid);
            pg8::EpiResid<true> E{WSP(float, OFF_X), mod_ptr(C, l, 0, 8), mod_ptr(C, l, 1, 8), l == DEPTH - 1 ? C.out : nullptr};
            pg8::gemm_phase<pg8::EpiResid<true>, true, false>(C.lds, g, S, E, C.tid);
        } SEAM(pb + 13);
    }
#undef IN
#undef SEAM
}

extern "C" void kernel_launch(void* const* d_in, const int* in_sizes, int n_in, void* d_out, int out_size, void* d_ws, size_t ws_size, hipStream_t stream) {
    static int grid = 0;
    if (grid == 0) {
        if (n_in != N_IN || out_size != SEQ * D || ws_size < WS_END) { fprintf(stderr, "kernel_launch: unexpected shapes (n_in %d out %d ws %zu)\n", n_in, out_size, ws_size); grid = -1; return; }
        int dev = 0, cus = 0;
        if (hipGetDevice(&dev) != hipSuccess || hipDeviceGetAttribute(&cus, hipDeviceAttributeMultiprocessorCount, dev) != hipSuccess) { grid = -1; return; }
        if (hipFuncSetAttribute((const void*)mk_fwd, hipFuncAttributeMaxDynamicSharedMemorySize, LDS_BYTES) != hipSuccess) { fprintf(stderr, "kernel_launch: hipFuncSetAttribute failed\n"); grid = -1; return; }
        (void)hipGetLastError();
        grid = cus;
    }
    if (grid < 0) return;
    (void)hipMemsetAsync((char*)d_ws + OFF_CTL, 0, CTL_BYTES, stream);
    Args a{};
    for (int i = 0; i < N_IN; ++i) a.in[i] = (const float*)d_in[i];
    a.out = (float*)d_out; a.ws = (unsigned char*)d_ws;
#if MK_ONE_LAUNCH
    a.ph_lo = 0; a.ph_hi = N_PHASES;
    hipLaunchKernelGGL(mk_fwd, dim3(grid), dim3(NT), LDS_BYTES, stream, a);
#else
    for (int ph = 0; ph < N_PHASES; ++ph) {
        a.ph_lo = ph; a.ph_hi = ph + 1;
        hipLaunchKernelGGL(mk_fwd, dim3(grid), dim3(NT), LDS_BYTES, stream, a);
    }
#endif
}
```

```cpp
#include <hip/hip_runtime.h>
#include <cstdio>
#include <cstdint>

#ifndef MK_ONE_LAUNCH
#define MK_ONE_LAUNCH 1
#endif

#define LAS __attribute__((address_space(3)))
#define GAS __attribute__((address_space(1)))
typedef unsigned short bf16_t;
typedef short bf16x8 __attribute__((ext_vector_type(8)));
typedef float f32x4 __attribute__((ext_vector_type(4)));
typedef float f32x2 __attribute__((ext_vector_type(2)));
typedef unsigned u32x4 __attribute__((ext_vector_type(4)));
typedef unsigned u32x2 __attribute__((ext_vector_type(2)));

constexpr int D = 2048, SEQ = 8192, CTX = 256, MT = SEQ + CTX, DEPTH = 2, DFF = 5632, NMOD = 9, MODW = NMOD * D;
constexpr int GRID_W = 64;
constexpr int PTOT = 15360, P32W = 4864, PAW = 2304, GLW = 8192;
constexpr int HG_OFF = 0, RW_OFF = 2560, RWC = 2304;
constexpr int NCH = MT / 64;
constexpr int NWAVES = 8, NT = 512;
constexpr float EPS = 1e-6f, RW_GN_EPS = 64e-5f;

constexpr size_t MiB = 1u << 20;
constexpr size_t OFF_CTL = 0, CTL_BYTES = 1 * MiB;
constexpr size_t OFF_MOD = 1 * MiB;
constexpr size_t OFF_MODP = 2 * MiB;
constexpr size_t OFF_WI1 = 11 * MiB, OFF_WO1 = 55 * MiB, OFF_WIN = 77 * MiB, OFF_WBR = 137 * MiB, OFF_WOUT = 145 * MiB, OFF_WI2 = 153 * MiB, OFF_WO2 = 197 * MiB;
constexpr size_t OFF_X = 219 * MiB;
constexpr size_t OFF_H = 285 * MiB;
constexpr size_t OFF_G = 318 * MiB;
constexpr size_t OFF_P32 = 409 * MiB;
constexpr size_t OFF_PA = 566 * MiB;
constexpr size_t OFF_GL = 604 * MiB;
constexpr size_t OFF_HGL = 736 * MiB;
constexpr size_t OFF_HGD = 802 * MiB;
constexpr size_t OFF_SCN = 803 * MiB;
constexpr size_t OFF_VV = 968 * MiB;
constexpr size_t OFF_GS = 985 * MiB;
constexpr size_t OFF_RO = 1002 * MiB;
constexpr size_t OFF_YB = 1035 * MiB;
constexpr size_t WS_END = 1068 * MiB;
constexpr int KSPLIT = 32;

constexpr int LDS_BYTES = 147456;
constexpr int RING_BYTES = 131072;
constexpr int MISC_OFF = RING_BYTES + 320;

__device__ __forceinline__ float bf2f(unsigned b) { return __uint_as_float(b << 16); }
__device__ __forceinline__ unsigned f2bf(float f) { unsigned u = __float_as_uint(f); return (u + 0x7fffu + ((u >> 16) & 1u)) >> 16; }
__device__ __forceinline__ unsigned pk2(float lo, float hi) { return f2bf(lo) | (f2bf(hi) << 16); }
__device__ __forceinline__ float wave_sum(float v) {
#pragma unroll
    for (int o = 1; o < 64; o <<= 1) v += __shfl_xor(v, o);
    return v;
}
__device__ __forceinline__ float wave_max(float v) {
#pragma unroll
    for (int o = 1; o < 64; o <<= 1) v = fmaxf(v, __shfl_xor(v, o));
    return v;
}
__device__ __forceinline__ float sigmoidf_(float x) { return 1.0f / (1.0f + expf(-x)); }
__device__ __forceinline__ float siluf_(float x) { return x / (1.0f + expf(-x)); }
#define LDS_WAIT() asm volatile("s_waitcnt lgkmcnt(0)" ::: "memory")

__device__ __forceinline__ int seq_row(int d, int j) { return d == 0 ? (j < CTX ? SEQ + j : j - CTX) : (MT - 1 - j); }
__device__ __forceinline__ int row_seq(int d, int r) { return d == 0 ? (r >= SEQ ? r - SEQ : r + CTX) : (MT - 1 - r); }

#define XB_TMO      128
#define XB_XCNT(j)  (256  + 64 * (j))
#define XB_XSUB(j)  (1280 + 64 * (j))
#define XB_XGEN(j)  (2304 + 64 * (j))
#define XB_TOP      3328
#define XB_TOPGEN   3392
#define XCD_BAR_WORDS 3456
#define XB_SPIN_CAP (1u << 18)
__device__ __forceinline__ unsigned xb_ld(unsigned* p)              { return __hip_atomic_load(p, __ATOMIC_RELAXED, __HIP_MEMORY_SCOPE_AGENT); }
__device__ __forceinline__ unsigned xb_add(unsigned* p, unsigned v) { return __hip_atomic_fetch_add(p, v, __ATOMIC_RELAXED, __HIP_MEMORY_SCOPE_AGENT); }
__device__ __forceinline__ unsigned xb_xcc_id() { return (unsigned)__builtin_amdgcn_s_getreg((3 << 11) | 20) & 0xFu; }
#define XB_SPIN(cond, bar) do { unsigned _sp = 0; while (cond) { __builtin_amdgcn_s_sleep(1); \
    if ((++_sp & 255u) == 0u) { if (xb_ld(&(bar)[XB_TMO])) break; if (_sp > XB_SPIN_CAP) { atomicAdd(&(bar)[XB_TMO], 1u); break; } } } } while (0)
struct XcdBarrier { unsigned* bar; unsigned x; volatile LAS unsigned* st; };
__device__ __forceinline__ XcdBarrier xcd_barrier_post(unsigned* bar, volatile LAS unsigned* st) {
    XcdBarrier b; b.bar = bar; b.x = xb_xcc_id(); b.st = st;
    if (threadIdx.x == 0) (void)xb_add(&bar[XB_XCNT(b.x)], 1u);
    return b;
}
__device__ __forceinline__ void xcd_barrier_complete(unsigned* bar, unsigned x, unsigned& nloc, unsigned& nx) {
    const unsigned G = gridDim.x * gridDim.y * gridDim.z;
    unsigned sum, cnt, mine, sp = 0u;
    for (;;) {
        sum = 0u; cnt = 0u; mine = 0u;
#pragma unroll
        for (unsigned j = 0; j < 16; ++j) { const unsigned c = xb_ld(&bar[XB_XCNT(j)]); sum += c; cnt += (c > 0u) ? 1u : 0u; mine = (j == x) ? c : mine; }
        if (sum == G) break;
        __builtin_amdgcn_s_sleep(1);
        if ((++sp & 255u) == 0u) { if (xb_ld(&bar[XB_TMO])) break; if (sp > XB_SPIN_CAP) { atomicAdd(&bar[XB_TMO], 1u); break; } }
    }
    nloc = mine > 0u ? mine : 1u; nx = cnt > 0u ? cnt : 1u;
}
__device__ __forceinline__ void xcd_barrier(const XcdBarrier& b) {
    asm volatile("s_waitcnt vmcnt(0)" ::: "memory");
    __syncthreads();
    if (threadIdx.x == 0) {
        unsigned* bar = b.bar;
        __builtin_amdgcn_s_waitcnt(0);
        unsigned nloc = b.st[0], nx = b.st[1];
        if (nloc == 0u) { xcd_barrier_complete(bar, b.x, nloc, nx); b.st[0] = nloc; b.st[1] = nx; }
        const unsigned old = xb_add(&bar[XB_XSUB(b.x)], 1u);
        const unsigned gen = old / nloc;
        if (old + 1u == (gen + 1u) * nloc) {
            __builtin_amdgcn_fence(__ATOMIC_RELEASE, "agent");
            asm volatile("s_waitcnt vmcnt(0)" ::: "memory");
            const unsigned og = xb_add(&bar[XB_TOP], 1u);
            const unsigned tg = og / nx;
            if (og + 1u == (tg + 1u) * nx) xb_add(&bar[XB_TOPGEN], 1u);
            else XB_SPIN(xb_ld(&bar[XB_TOPGEN]) == tg, bar);
            __builtin_amdgcn_fence(__ATOMIC_ACQUIRE, "agent");
            xb_add(&bar[XB_XGEN(b.x)], 1u);
            asm volatile("s_waitcnt vmcnt(0)" ::: "memory");
        } else {
            XB_SPIN(xb_ld(&bar[XB_XGEN(b.x)]) == gen, bar);
            __builtin_amdgcn_fence(__ATOMIC_ACQUIRE, "agent");
            asm volatile("s_waitcnt vmcnt(0)" ::: "memory");
        }
    }
    __syncthreads();
}

namespace pg8 {
constexpr int BM = 256, BK = 64, HALF = 128, HTB = HALF * BK * 2, STAGE_BYTES = 8 * HTB, NXCD = 8, WGM = 8;
__host__ __device__ __forceinline__ int lds_byte(int r, int c) { const int st = (r >> 4) * 2 + (c >> 5), rr = r & 15, cc = c & 31, ob = rr * 64 + cc * 2; return st * 1024 + (ob ^ (((ob >> 9) & 1) << 5)); }
__host__ __device__ __forceinline__ void stage_rc(int b, int& R, int& C) { const int st = b / 1024, sb = b % 1024, swz = sb ^ (((sb >> 9) & 1) << 5); R = (st >> 1) * 16 + swz / 64; C = (st & 1) * 32 + (swz % 64) / 2; }
__host__ __device__ __forceinline__ int perm32(int rho) { const int n = rho >> 4, i = rho & 15; return 8 * (i >> 2) + 4 * n + (i & 3); }
struct Unit { int pm, pn; };
struct Gemm { const bf16_t* A; const bf16_t* Bt; int M, N, K; int a_div; size_t a_gstride; };
struct StaticOrder {
    int nM, nN, nwg, G, c;
    __host__ __device__ void init(int M, int N, int G_, int c_) { nM = M / BM; nN = N / BM; nwg = nM * nN; G = G_; c = c_; }
    __host__ __device__ bool next(int i, Unit& u) const {
        const long L = (long)i * G + c; if (L >= nwg) return false;
        int wgid = (int)L; { const int q = nwg / NXCD, r = nwg % NXCD, xcd = wgid % NXCD, off = wgid / NXCD; wgid = (xcd < r ? xcd * (q + 1) : r * (q + 1) + (xcd - r) * q) + off; }
        const int nig = WGM * nN, gid = wgid / nig, fm = gid * WGM, gsz = (nM - fm) < WGM ? (nM - fm) : WGM;
        u.pm = fm + ((wgid % nig) % gsz); u.pn = (wgid % nig) / gsz; return true;
    }
};
__device__ __forceinline__ unsigned cvt_pk_bf16(float lo, float hi) { unsigned r; asm volatile("v_cvt_pk_bf16_f32 %0, %1, %2" : "=v"(r) : "v"(lo), "v"(hi)); return r; }

template <class Epi, bool ALIGN_EPI, bool SP2>
__device__ __forceinline__ void gemm_phase(LAS unsigned char* lds, const Gemm g, const StaticOrder& S, const Epi& E, const int tid) {
    const int wid = __builtin_amdgcn_readfirstlane(tid >> 6), lane = tid & 63, wr = wid >> 2, wc = wid & 3, fr = lane & 15, fq = lane >> 4;
    const int K = g.K, nt = K / BK;
    unsigned voffA[2], voffB[2];
#pragma unroll
    for (int i = 0; i < 2; ++i) { int R, C; stage_rc(tid * 16 + i * 8192, R, C); const int Rb = Epi::PERM ? ((R & ~31) + perm32(R & 31)) : R;
        voffA[i] = (unsigned)(R * K + C) * 2u; voffB[i] = (unsigned)(Rb * K + C) * 2u; }
    const size_t kstep = (size_t)(BK * 2);
    const size_t hstep = (size_t)HALF * K * 2;
    const size_t tstep = 2 * hstep;
    const unsigned ldsw = (unsigned)wid * 1024u;
    const int aoff = lds_byte(wr * 64 + fr, fq * 8), boff = lds_byte(wc * 32 + fr, fq * 8);
#define PG8_SA(b, h) (((b) * 2 + (h)) * HTB)
#define PG8_SB(b, h) ((4 + (b) * 2 + (h)) * HTB)
#define PG8_STAGE(bufoff, gbase, voff) do { _Pragma("unroll") for (int _i = 0; _i < 2; ++_i) \
        __builtin_amdgcn_global_load_lds((const unsigned*)((const char*)(gbase) + (voff)[_i]), (LAS unsigned*)(lds + (bufoff) + ldsw + _i * 8192), 16, 0, 0); } while (0)
#define PG8_LDA(dst, b, h) do { _Pragma("unroll") for (int m = 0; m < 4; ++m) _Pragma("unroll") for (int k = 0; k < 2; ++k) dst[m][k] = *(const LAS bf16x8*)(lds + PG8_SA(b, h) + aoff + m * 2048 + k * 1024); } while (0)
#define PG8_LDB(dst, b, h) do { _Pragma("unroll") for (int n = 0; n < 2; ++n) _Pragma("unroll") for (int k = 0; k < 2; ++k) dst[n][k] = *(const LAS bf16x8*)(lds + PG8_SB(b, h) + boff + n * 2048 + k * 1024); } while (0)
#define PG8_MMA(ai, bj, At, Bt) do { __builtin_amdgcn_s_setprio(1); _Pragma("unroll") for (int m = 0; m < 4; ++m) _Pragma("unroll") for (int n = 0; n < 2; ++n) _Pragma("unroll") for (int k = 0; k < 2; ++k) \
        acc[ai][bj][m][n] = __builtin_amdgcn_mfma_f32_16x16x32_bf16(Bt[n][k], At[m][k], acc[ai][bj][m][n], 0, 0, 0); __builtin_amdgcn_s_setprio(0); } while (0)
#define PG8_WAIT_V(n) asm volatile("s_waitcnt vmcnt(" #n ")" ::: "memory")
#define PG8_WAIT_L(n) asm volatile("s_waitcnt lgkmcnt(" #n ")" ::: "memory")
#define PG8_BAR __builtin_amdgcn_s_barrier()
#define PG8_SCHED __builtin_amdgcn_sched_barrier(0)
#define PG8_ABASE(u) ((const char*)g.A + ((size_t)((u).pn / g.a_div) * g.a_gstride) * 2 + (size_t)(u).pm * tstep)
    Unit cur, nxt; int ui = 0;
    if (!S.next(0, cur)) return;
    f32x4 acc[2][2][4][2];
#pragma unroll
    for (int a = 0; a < 2; ++a)
#pragma unroll
        for (int b = 0; b < 2; ++b)
#pragma unroll
            for (int m = 0; m < 4; ++m)
#pragma unroll
                for (int n = 0; n < 2; ++n) acc[a][b][m][n] = (f32x4){0.f, 0.f, 0.f, 0.f};
    bf16x8 At[4][2], B0[2][2], B1[2][2];
    const char* cA = PG8_ABASE(cur); const char* cB = (const char*)g.Bt + (size_t)cur.pn * tstep;
    if constexpr (SP2) {
        PG8_STAGE(PG8_SB(0, 0), cB, voffB); PG8_STAGE(PG8_SB(0, 1), cB + hstep, voffB); PG8_STAGE(PG8_SA(0, 0), cA, voffA); PG8_STAGE(PG8_SA(0, 1), cA + hstep, voffA);
        if (wr == 1) PG8_BAR;
        PG8_WAIT_V(2); PG8_BAR;
        PG8_STAGE(PG8_SB(1, 0), cB + kstep, voffB); PG8_STAGE(PG8_SA(1, 0), cA + kstep, voffA); PG8_STAGE(PG8_SB(1, 1), cB + hstep + kstep, voffB);
        PG8_WAIT_V(6); PG8_BAR;
    } else {
        PG8_STAGE(PG8_SB(0, 0), cB, voffB); PG8_STAGE(PG8_SA(0, 0), cA, voffA); PG8_STAGE(PG8_SB(0, 1), cB + hstep, voffB); PG8_STAGE(PG8_SA(0, 1), cA + hstep, voffA);
        if (wr == 1) PG8_BAR;
        PG8_WAIT_V(4); PG8_BAR;
        PG8_STAGE(PG8_SB(1, 0), cB + kstep, voffB); PG8_STAGE(PG8_SA(1, 0), cA + kstep, voffA); PG8_STAGE(PG8_SB(1, 1), cB + hstep + kstep, voffB);
        PG8_WAIT_V(6); PG8_BAR;
    }
    for (;;) {
        const bool has_next = S.next(ui + 1, nxt);
        const char* nA = has_next ? PG8_ABASE(nxt) : cA; const char* nB = has_next ? (const char*)g.Bt + (size_t)nxt.pn * tstep : cB;
        for (int t = 0; t < nt; t += 2) {
            const bool last = (t == nt - 2);
            const char* a1 = cA + (size_t)(t + 1) * kstep;
            const char* a2 = last ? nA : cA + (size_t)(t + 2) * kstep; const char* b2 = last ? nB : cB + (size_t)(t + 2) * kstep;
            const char* a3 = a2 + kstep; const char* b3 = b2 + kstep;
            if constexpr (SP2) {
            PG8_LDB(B0, 0, 0); PG8_LDB(B1, 0, 1); PG8_SCHED; PG8_LDA(At, 0, 0); PG8_STAGE(PG8_SA(1, 1), a1 + hstep, voffA);
            PG8_WAIT_V(8); PG8_WAIT_L(0); PG8_BAR; PG8_MMA(0, 0, At, B0); PG8_MMA(0, 1, At, B1); PG8_BAR; PG8_SCHED;
            PG8_LDA(At, 0, 1); PG8_STAGE(PG8_SB(0, 0), b2, voffB); PG8_STAGE(PG8_SB(0, 1), b2 + hstep, voffB); PG8_STAGE(PG8_SA(0, 0), a2, voffA);
            PG8_WAIT_V(8); PG8_WAIT_L(0); PG8_BAR; PG8_MMA(1, 0, At, B0); PG8_MMA(1, 1, At, B1); PG8_BAR; PG8_SCHED;
            PG8_LDB(B0, 1, 0); PG8_LDB(B1, 1, 1); PG8_SCHED; PG8_LDA(At, 1, 0); PG8_STAGE(PG8_SA(0, 1), a2 + hstep, voffA);
            PG8_WAIT_V(8); PG8_WAIT_L(0); PG8_BAR; PG8_MMA(0, 0, At, B0); PG8_MMA(0, 1, At, B1); PG8_BAR; PG8_SCHED;
            PG8_LDA(At, 1, 1); PG8_STAGE(PG8_SB(1, 0), b3, voffB); PG8_STAGE(PG8_SB(1, 1), b3 + hstep, voffB); PG8_STAGE(PG8_SA(1, 0), a3, voffA);
            PG8_WAIT_V(8); PG8_WAIT_L(0); PG8_BAR; PG8_MMA(1, 0, At, B0); PG8_MMA(1, 1, At, B1); PG8_BAR; PG8_SCHED;
            } else {
            PG8_LDB(B0, 0, 0); PG8_SCHED; PG8_LDA(At, 0, 0); PG8_STAGE(PG8_SA(1, 1), a1 + hstep, voffA);
            PG8_WAIT_L(8); PG8_BAR; PG8_WAIT_L(0); PG8_MMA(0, 0, At, B0); PG8_BAR; PG8_SCHED;
            PG8_LDB(B1, 0, 1); PG8_STAGE(PG8_SB(0, 0), b2, voffB);
            PG8_BAR; PG8_WAIT_L(0); PG8_MMA(0, 1, At, B1); PG8_BAR;
            PG8_LDA(At, 0, 1); PG8_STAGE(PG8_SA(0, 0), a2, voffA);
            PG8_BAR; PG8_WAIT_L(0); PG8_MMA(1, 0, At, B0); PG8_BAR; PG8_SCHED;
            PG8_STAGE(PG8_SB(0, 1), b2 + hstep, voffB);
            PG8_WAIT_V(6); PG8_BAR; PG8_MMA(1, 1, At, B1); PG8_BAR;
            PG8_LDB(B0, 1, 0); PG8_SCHED; PG8_LDA(At, 1, 0); PG8_STAGE(PG8_SA(0, 1), a2 + hstep, voffA);
            PG8_WAIT_L(8); PG8_BAR; PG8_WAIT_L(0); PG8_MMA(0, 0, At, B0); PG8_BAR; PG8_SCHED;
            PG8_LDB(B1, 1, 1); PG8_STAGE(PG8_SB(1, 0), b3, voffB);
            PG8_BAR; PG8_WAIT_L(0); PG8_MMA(0, 1, At, B1); PG8_BAR;
            PG8_LDA(At, 1, 1); PG8_STAGE(PG8_SA(1, 0), a3, voffA);
            PG8_BAR; PG8_WAIT_L(0); PG8_MMA(1, 0, At, B0); PG8_BAR; PG8_SCHED;
            PG8_STAGE(PG8_SB(1, 1), b3 + hstep, voffB);
            PG8_WAIT_V(6); PG8_BAR; PG8_MMA(1, 1, At, B1); PG8_BAR;
            }
        }
        if constexpr (ALIGN_EPI) { if (wr == 0) PG8_BAR; }
        E(acc, cur, wr, wc, fr, fq);
        if (!has_next) break;
#pragma unroll
        for (int a = 0; a < 2; ++a)
#pragma unroll
            for (int b = 0; b < 2; ++b)
#pragma unroll
                for (int m = 0; m < 4; ++m)
#pragma unroll
                    for (int n = 0; n < 2; ++n) acc[a][b][m][n] = (f32x4){0.f, 0.f, 0.f, 0.f};
        cur = nxt; cA = nA; cB = nB; ++ui;
        if constexpr (ALIGN_EPI) { if (wr == 1) PG8_BAR; }
    }
    PG8_WAIT_V(0);
    if constexpr (!ALIGN_EPI) { if (wr == 0) PG8_BAR; }
    PG8_BAR;
#undef PG8_SA
#undef PG8_SB
#undef PG8_STAGE
#undef PG8_LDA
#undef PG8_LDB
#undef PG8_MMA
#undef PG8_WAIT_V
#undef PG8_WAIT_L
#undef PG8_BAR
#undef PG8_SCHED
#undef PG8_ABASE
}

struct EpiSwiGLU {
    static constexpr bool PERM = true;
    bf16_t* O;
    __device__ __forceinline__ void operator()(const f32x4 (&acc)[2][2][4][2], const Unit& u, int wr, int wc, int fr, int fq) const {
        const int row0 = u.pm * BM + wr * 64 + fr, col0 = u.pn * HALF + wc * 32 + 8 * fq;
#pragma unroll
        for (int ai = 0; ai < 2; ++ai)
#pragma unroll
            for (int m = 0; m < 4; ++m) {
                bf16_t* rowp = O + (size_t)(row0 + ai * HALF + m * 16) * DFF + col0;
                float o[8];
#pragma unroll
                for (int n = 0; n < 2; ++n)
#pragma unroll
                    for (int j = 0; j < 4; ++j) { const float a = acc[ai][0][m][n][j], b = acc[ai][1][m][n][j]; o[n * 4 + j] = a / (1.0f + __expf(-a)) * b; }
                u32x4 w; w.x = cvt_pk_bf16(o[0], o[1]); w.y = cvt_pk_bf16(o[2], o[3]); w.z = cvt_pk_bf16(o[4], o[5]); w.w = cvt_pk_bf16(o[6], o[7]);
                *(u32x4*)rowp = w;
            }
    }
};
template <bool HALFGATE> struct EpiResid {
    static constexpr bool PERM = false;
    float* X; const float* gate_lat; const float* gate_ctx; float* out;
    __device__ __forceinline__ void operator()(const f32x4 (&acc)[2][2][4][2], const Unit& u, int wr, int wc, int fr, int fq) const {
        const int row0 = u.pm * BM + wr * 64 + fr, col0 = u.pn * BM + wc * 32 + 4 * fq;
        const float* gp = (u.pm * BM >= SEQ) ? gate_ctx : gate_lat;
        f32x4 gv[2][2];
#pragma unroll
        for (int bj = 0; bj < 2; ++bj)
#pragma unroll
            for (int n = 0; n < 2; ++n) gv[bj][n] = *(const f32x4*)(gp + col0 + bj * HALF + n * 16) * (HALFGATE ? 0.5f : 1.0f);
#pragma unroll
        for (int ai = 0; ai < 2; ++ai)
#pragma unroll
            for (int m = 0; m < 4; ++m) {
                const int row = row0 + ai * HALF + m * 16;
                float* rowp = X + (size_t)row * D + col0;
#pragma unroll
                for (int bj = 0; bj < 2; ++bj)
#pragma unroll
                    for (int n = 0; n < 2; ++n) {
                        f32x4 v = *(const f32x4*)(rowp + bj * HALF + n * 16) + gv[bj][n] * acc[ai][bj][m][n];
                        *(f32x4*)(rowp + bj * HALF + n * 16) = v;
                        if (out != nullptr && row < SEQ) *(f32x4*)(out + (size_t)row * D + col0 + bj * HALF + n * 16) = v;
                    }
            }
    }
};
struct EpiWin {
    static constexpr bool PERM = true;
    float* P32; bf16_t* PA; bf16_t* GL;
    __device__ __forceinline__ void operator()(const f32x4 (&acc)[2][2][4][2], const Unit& u, int wr, int wc, int fr, int fq) const {
        const int row0 = u.pm * BM + wr * 64 + fr, cin = wc * 32 + 8 * fq;
        if (u.pn < 19) {
#pragma unroll
            for (int ai = 0; ai < 2; ++ai)
#pragma unroll
                for (int m = 0; m < 4; ++m) { float* rowp = P32 + (size_t)(row0 + ai * HALF + m * 16) * P32W + u.pn * BM + cin;
#pragma unroll
                    for (int bj = 0; bj < 2; ++bj) { *(f32x4*)(rowp + bj * HALF) = acc[ai][bj][m][0]; *(f32x4*)(rowp + bj * HALF + 4) = acc[ai][bj][m][1]; } }
        } else {
            bf16_t* base; int ld, colt;
            if (u.pn < 28) { base = PA; ld = PAW; colt = (u.pn - 19) * BM; } else { base = GL; ld = GLW; colt = (u.pn - 28) * BM; }
#pragma unroll
            for (int ai = 0; ai < 2; ++ai)
#pragma unroll
                for (int m = 0; m < 4; ++m) { bf16_t* rowp = base + (size_t)(row0 + ai * HALF + m * 16) * ld + colt + cin;
#pragma unroll
                    for (int bj = 0; bj < 2; ++bj) { const f32x4 v0 = acc[ai][bj][m][0], v1 = acc[ai][bj][m][1];
                        u32x4 w; w.x = cvt_pk_bf16(v0[0], v0[1]); w.y = cvt_pk_bf16(v0[2], v0[3]); w.z = cvt_pk_bf16(v1[0], v1[1]); w.w = cvt_pk_bf16(v1[2], v1[3]);
                        *(u32x4*)(rowp + bj * HALF) = w; } }
        }
    }
};
struct EpiMerge {
    static constexpr bool PERM = true;
    const bf16_t* GL; bf16_t* PROJ;
    __device__ __forceinline__ void operator()(const f32x4 (&acc)[2][2][4][2], const Unit& u, int wr, int wc, int fr, int fq) const {
        const int row0 = u.pm * BM + wr * 64 + fr, col0 = u.pn * BM + wc * 32 + 8 * fq;
#pragma unroll
        for (int ai = 0; ai < 2; ++ai)
#pragma unroll
            for (int m = 0; m < 4; ++m) { const size_t ro = (size_t)(row0 + ai * HALF + m * 16) * GLW + col0;
#pragma unroll
                for (int bj = 0; bj < 2; ++bj) {
                    const u32x4 gw = *(const u32x4*)(GL + ro + bj * HALF);
                    const f32x4 v0 = acc[ai][bj][m][0], v1 = acc[ai][bj][m][1];
                    float o[8];
                    o[0] = v0[0] / (1.0f + __expf(-bf2f(gw.x & 0xffffu))); o[1] = v0[1] / (1.0f + __expf(-bf2f(gw.x >> 16)));
                    o[2] = v0[2] / (1.0f + __expf(-bf2f(gw.y & 0xffffu))); o[3] = v0[3] / (1.0f + __expf(-bf2f(gw.y >> 16)));
                    o[4] = v1[0] / (1.0f + __expf(-bf2f(gw.z & 0xffffu))); o[5] = v1[1] / (1.0f + __expf(-bf2f(gw.z >> 16)));
                    o[6] = v1[2] / (1.0f + __expf(-bf2f(gw.w & 0xffffu))); o[7] = v1[3] / (1.0f + __expf(-bf2f(gw.w >> 16)));
                    u32x4 w; w.x = cvt_pk_bf16(o[0], o[1]); w.y = cvt_pk_bf16(o[2], o[3]); w.z = cvt_pk_bf16(o[4], o[5]); w.w = cvt_pk_bf16(o[6], o[7]);
                    *(u32x4*)(PROJ + ro + bj * HALF) = w; } }
    }
};
}

enum { I_X = 0, I_C, I_CTX, I_CCTX, I_ADAW, I_ADAB, I_NF1, I_NMIX, I_NF2, I_F1WI, I_F1WO, I_F2WI, I_F2WO, I_WIN, I_HGLB, I_HGNORM, I_RWSHIFT, I_RWW0, I_RWW2, I_RWA0, I_RWA2,
       I_RWKK, I_RWKA, I_RWRK, I_RWLNW, I_RWLNB, I_NAQN, I_NAKN, I_NARPB, I_WAQN, I_WAKN, I_WASINK, I_WBR, I_WOUT, N_IN };
struct Args { const float* in[N_IN]; float* out; unsigned char* ws; int ph_lo, ph_hi; };
struct Ctx {
    LAS unsigned char* lds;
    int tid, lane, wave, bid, G;
    const Args __attribute__((address_space(4)))* ka; float* out; unsigned char* ws;
};
#define WSP(T, off) ((T*)(C.ws + (off)))
__device__ __forceinline__ void relaunder(Ctx& C) {
    int t = C.tid, b = C.bid, g = C.G;
    asm volatile("" : "+v"(t), "+v"(b), "+v"(g));
    C.tid = t; C.lane = t & 63; C.wave = __builtin_amdgcn_readfirstlane(t >> 6); C.bid = __builtin_amdgcn_readfirstlane(b); C.G = __builtin_amdgcn_readfirstlane(g);
}

__device__ __forceinline__ void transpose_item(const float* W, int K, int N, bf16_t* WT, int mode, LAS float* scr, int item, int lane) {
    const int nblk = N / 32, kb = item / nblk, nb = item % nblk, k0 = 64 * kb, n0 = 32 * nb;
    int drow0 = n0;
    if (mode == 1) { const int half = n0 / DFF, j0 = n0 % DFF; drow0 = 256 * (j0 / 128) + 128 * half + (j0 % 128); }
#pragma unroll 8
    for (int i = 0; i < 32; ++i) { const int kk = 2 * i + (lane >> 5); scr[kk * 33 + (lane & 31)] = W[(size_t)(k0 + kk) * N + n0 + (lane & 31)]; }
    LDS_WAIT(); asm volatile("" ::: "memory");
    const int c = lane & 7;
#pragma unroll
    for (int j = 0; j < 4; ++j) { const int n = (lane >> 3) + 8 * j; const LAS float* s = scr + (8 * c) * 33 + n;
        u32x4 o; o.x = pk2(s[0 * 33], s[1 * 33]); o.y = pk2(s[2 * 33], s[3 * 33]); o.z = pk2(s[4 * 33], s[5 * 33]); o.w = pk2(s[6 * 33], s[7 * 33]);
        *(u32x4*)(WT + (size_t)(drow0 + n) * K + k0 + 8 * c) = o; }
    LDS_WAIT(); asm volatile("" ::: "memory");
}
__device__ __forceinline__ void phase_convert(Ctx& C, int l) {
    LAS float* scr = (LAS float*)(C.lds + C.wave * 16384);
    const int gw = C.bid * NWAVES + C.wave, NGW = C.G * NWAVES;
    constexpr int I_WI = (D / 64) * (2 * DFF / 32), I_WO = (DFF / 64) * (D / 32), I_IN = (D / 64) * (PTOT / 32), I_BR = (512 / 64) * (D / 32), I_OUT = (D / 64) * (D / 32);
    constexpr int NITEMS = 2 * I_WI + 2 * I_WO + I_IN + 4 * I_BR + I_OUT;
    for (int it = gw; it < NITEMS; it += NGW) {
        int r = it;
        if (r < I_WI) { transpose_item(C.ka->in[I_F1WI] + (size_t)l * D * 2 * DFF, D, 2 * DFF, WSP(bf16_t, OFF_WI1), 1, scr, r, C.lane); continue; } r -= I_WI;
        if (r < I_WI) { transpose_item(C.ka->in[I_F2WI] + (size_t)l * D * 2 * DFF, D, 2 * DFF, WSP(bf16_t, OFF_WI2), 1, scr, r, C.lane); continue; } r -= I_WI;
        if (r < I_WO) { transpose_item(C.ka->in[I_F1WO] + (size_t)l * DFF * D, DFF, D, WSP(bf16_t, OFF_WO1), 0, scr, r, C.lane); continue; } r -= I_WO;
        if (r < I_WO) { transpose_item(C.ka->in[I_F2WO] + (size_t)l * DFF * D, DFF, D, WSP(bf16_t, OFF_WO2), 0, scr, r, C.lane); continue; } r -= I_WO;
        if (r < I_IN) { transpose_item(C.ka->in[I_WIN] + (size_t)l * D * PTOT, D, PTOT, WSP(bf16_t, OFF_WIN), 0, scr, r, C.lane); continue; } r -= I_IN;
        if (r < 4 * I_BR) { const int g = r / I_BR; transpose_item(C.ka->in[I_WBR] + ((size_t)l * 4 + g) * 512 * D, 512, D, WSP(bf16_t, OFF_WBR) + (size_t)g * D * 512, 0, scr, r % I_BR, C.lane); continue; } r -= 4 * I_BR;
        transpose_item(C.ka->in[I_WOUT] + (size_t)l * D * D, D, D, WSP(bf16_t, OFF_WOUT), 0, scr, r, C.lane);
    }
}

__device__ __forceinline__ void phase_ada_partial(Ctx& C) {
    float* modp = WSP(float, OFF_MODP);
    for (int u = C.bid; u < DEPTH * 9 * KSPLIT; u += C.G) {
        const int l = u / (9 * KSPLIT), rem = u % (9 * KSPLIT), cg = rem / KSPLIT, ks = rem % KSPLIT;
        const int col = cg * 2048 + C.tid * 4;
        const float* W = C.ka->in[I_ADAW] + (size_t)l * D * MODW;
        f32x4 a0 = {0.f, 0.f, 0.f, 0.f}, a1 = {0.f, 0.f, 0.f, 0.f};
        for (int i = ks * 64; i < ks * 64 + 64; ++i) {
            const float c0 = C.ka->in[I_C][i], c1 = C.ka->in[I_CCTX][i];
            const float s0 = siluf_(c0), s1 = siluf_(c1);
            const f32x4 w = *(const f32x4*)(W + (size_t)i * MODW + col);
            a0 += w * s0; a1 += w * s1;
        }
        *(f32x4*)(modp + ((size_t)(l * KSPLIT + ks) * 2 + 0) * MODW + col) = a0;
        *(f32x4*)(modp + ((size_t)(l * KSPLIT + ks) * 2 + 1) * MODW + col) = a1;
    }
    f32x4* X = WSP(f32x4, OFF_X);
    const f32x4* xs = (const f32x4*)C.ka->in[I_X]; const f32x4* cs = (const f32x4*)C.ka->in[I_CTX];
    const size_t n_lat = (size_t)SEQ * D / 4, n_all = (size_t)MT * D / 4;
    for (size_t i = (size_t)C.bid * NT + C.tid; i < n_all; i += (size_t)C.G * NT) X[i] = i < n_lat ? xs[i] : cs[i - n_lat];
}
__device__ __forceinline__ void phase_ada_reduce(Ctx& C) {
    const float* modp = WSP(float, OFF_MODP); float* mod = WSP(float, OFF_MOD);
    for (int e = C.bid * NT + C.tid; e < DEPTH * 2 * MODW; e += C.G * NT) {
        const int l = e / (2 * MODW), s = (e / MODW) % 2, j = e % MODW;
        float a = C.ka->in[I_ADAB][(size_t)l * MODW + j];
        for (int ks = 0; ks < KSPLIT; ++ks) a += modp[((size_t)(l * KSPLIT + ks) * 2 + s) * MODW + j];
        mod[e] = a;
    }
}
__device__ __forceinline__ const float* mod_ptr(Ctx& C, int l, int s, int idx) { return WSP(float, OFF_MOD) + ((size_t)(l * 2 + s) * NMOD + idx) * D; }

__device__ __forceinline__ void phase_norm(Ctx& C, int l, const float* gw  , int shift_idx) {
    const int gwv = C.bid * NWAVES + C.wave, NGW = C.G * NWAVES;
    const float* X = WSP(float, OFF_X); bf16_t* H = WSP(bf16_t, OFF_H);
    for (int r = gwv; r < MT; r += NGW) {
        const int s = r >= SEQ ? 1 : 0;
        const float* sh = mod_ptr(C, l, s, shift_idx); const float* sc = mod_ptr(C, l, s, shift_idx + 1);
        const f32x4* xr = (const f32x4*)(X + (size_t)r * D) + C.lane;
        f32x4 v[8]; float ss = 0.f;
#pragma unroll
        for (int j = 0; j < 8; ++j) { v[j] = xr[64 * j]; ss += (v[j].x * v[j].x + v[j].y * v[j].y) + (v[j].z * v[j].z + v[j].w * v[j].w); }
        const float rstd = rsqrtf(wave_sum(ss) * (1.0f / D) + EPS);
        u32x2* o8 = (u32x2*)(H + (size_t)r * D) + C.lane;
#pragma unroll
        for (int j = 0; j < 8; ++j) {
            const int c = (64 * j + C.lane) * 4;
            const f32x4 g4 = *(const f32x4*)(gw + c), s4 = *(const f32x4*)(sc + c), h4 = *(const f32x4*)(sh + c);
            const f32x4 y = (v[j] * rstd) * g4 * (s4 + 1.0f) + h4;
            u32x2 w; w.x = pk2(y.x, y.y); w.y = pk2(y.z, y.w); o8[64 * j] = w;
        }
    }
}

__device__ __forceinline__ void phase_rw_prep(Ctx& C, int l, int b0, int nb) {
    const float* P = WSP(float, OFF_P32); float* SCN = WSP(float, OFF_SCN); float* VV = WSP(float, OFF_VV); float* GS = WSP(float, OFF_GS);
    LAS float* lin = (LAS float*)C.lds;
    const float* taps = C.ka->in[I_RWSHIFT] + (size_t)l * 3 * RWC;
    const int c = C.tid, h = c >> 6, e = c & 63;
    const float kkw = C.ka->in[I_RWKK][l * 512 + c], kaw = C.ka->in[I_RWKA][l * 512 + c];
    for (int r = b0; r < MT; r += nb) {
        const bool hp = (r != 0 && r != SEQ), hn = (r != SEQ - 1 && r != MT - 1);
        const float* p0 = P + (size_t)r * P32W + RW_OFF;
        float xs[5];
#pragma unroll
        for (int q = 0; q < 5; ++q) {
            const int col = q * 512 + c;
            float v = 0.f;
            if (q < 4 || c < 256) {
                v = taps[RWC + col] * p0[col];
                if (hp) v += taps[col] * p0[col - P32W];
                if (hn) v += taps[2 * RWC + col] * p0[col + P32W];
            }
            xs[q] = v;
        }
        __syncthreads();
        if (c < 256) lin[c] = c < 128 ? tanhf(xs[4]) : xs[4];
        __syncthreads();
        const float rr = xs[0], kk_raw = xs[1], vv = xs[2], gg = xs[3];
        const float kk0 = kk_raw * kkw;
        const float kkn = kk0 * rsqrtf(wave_sum(kk0 * kk0) + EPS);
        VV[(size_t)r * 512 + c] = vv; GS[(size_t)r * 512 + c] = sigmoidf_(gg);
#pragma unroll
        for (int d = 0; d < 2; ++d) {
            const float* w2 = C.ka->in[I_RWW2] + ((size_t)(l * 2 + d) * 64) * 512 + c;
            const float* a2 = C.ka->in[I_RWA2] + ((size_t)(l * 2 + d) * 64) * 512 + c;
            float z = C.ka->in[I_RWW0][(l * 2 + d) * 512 + c], az = C.ka->in[I_RWA0][(l * 2 + d) * 512 + c];
#pragma unroll 8
            for (int j = 0; j < 64; ++j) { z += lin[d * 64 + j] * w2[(size_t)j * 512]; az += lin[128 + d * 64 + j] * a2[(size_t)j * 512]; }
            const float y = -z; const float sp = fmaxf(y, 0.f) + log1pf(expf(-fabsf(y)));
            const float lw = -sp - 0.5f;
            const float decay = expf(-expf(lw));
            const float a = sigmoidf_(az);
            const float kd = kk_raw * (1.0f + (a - 1.0f) * kaw);
            float* o = SCN + ((size_t)((d * 8 + h) * MT + row_seq(d, r))) * 320 + e;
            o[0] = decay; o[64] = kkn; o[128] = a * kkn; o[192] = kd; o[256] = rr;
        }
    }
}

__device__ __forceinline__ void phase_attn_prep(Ctx& C, int l, int w0, int nw) {
    bf16_t* PA = WSP(bf16_t, OFF_PA);
    const int e = C.lane;
    const float na_qn = C.ka->in[I_NAQN][l * 64 + e], na_kn = C.ka->in[I_NAKN][l * 64 + e], wa_qn = C.ka->in[I_WAQN][l * 64 + e], wa_kn = C.ka->in[I_WAKN][l * 64 + e];
    const int m16 = e & 15;
    const float inv = powf(10000.0f, -(float)m16 / 16.0f);
    for (long uidx = w0; uidx < (long)MT * 26; uidx += nw) {
        const int r = (int)(uidx / 26), v = (int)(uidx % 26);
        int col; float nwt, scl; bool rope;
        if (v < 8) { col = v * 64; nwt = na_qn; scl = 0.125f; rope = false; }
        else if (v < 16) { col = 512 + (v - 8) * 64; nwt = na_kn; scl = 1.0f; rope = false; }
        else if (v < 24) { col = 1536 + (v - 16) * 64; nwt = wa_qn; scl = 0.125f; rope = true; }
        else { col = 2048 + (v - 24) * 64; nwt = wa_kn; scl = 1.0f; rope = true; }
        bf16_t* p = PA + (size_t)r * PAW + col + e;
        const float x = bf2f(*p);
        const float ss = wave_sum(x * x);
        float y = x * rsqrtf(ss * (1.0f / 64.0f) + EPS) * nwt * scl;
        if (rope && r < SEQ) {
            const int pos = (e >> 5) ? (r & 63) : (r >> 6);
            const float ang = (float)pos * inv;
            float sn, cs; sincosf(ang, &sn, &cs);
            const bool lo = (e & 31) < 16;
            const float yp = __shfl(y, lo ? e + 16 : e - 16);
            y = lo ? (y * cs - yp * sn) : (yp * sn + y * cs);
        }
        *p = (bf16_t)f2bf(y);
    }
}

__device__ __forceinline__ float hg_lb(Ctx& C, int l, int d, int c) {
    if (l == 0) return 0.f;
    const float a0 = C.ka->in[I_HGLB][(size_t)(d * DEPTH + 0) * 512 + c], a1 = C.ka->in[I_HGLB][(size_t)(d * DEPTH + 1) * 512 + c];
    const float m = fmaxf(a0, a1); const float e0 = expf(a0 - m), e1 = expf(a1 - m);
    return e1 / (e0 + e1);
}
__device__ __forceinline__ void phase_hg_A(Ctx& C, int l, int b0, int nb) {
    const float* P = WSP(float, OFF_P32); float* HGL = WSP(float, OFF_HGL); float* HGD = WSP(float, OFF_HGD);
    LAS float* Ii = (LAS float*)C.lds;
    LAS float* LF = Ii + 64 * 128;
    LAS float* KD = LF + 64 * 128;
    const int k = C.tid & 127, vq = C.tid >> 7;
    for (int u = b0; u < 2 * 4 * NCH; u += nb) {
        const int d = u / (4 * NCH), h = (u / NCH) % 4, c = u % NCH;
        const float lb = hg_lb(C, l, d, h * 128 + k);
        __syncthreads();
#pragma unroll 4
        for (int i = 0; i < 16; ++i) {
            const int s = 16 * vq + i; const int row = seq_row(d, 64 * c + s);
            const float* pr = P + (size_t)row * P32W;
            Ii[s * 128 + k] = pr[1536 + h * 128 + k];
            const float fr = pr[512 + d * 512 + h * 128 + k];
            const float f = lb + (1.0f - lb) * sigmoidf_(fr);
            LF[s * 128 + k] = logf(f); KD[s * 128 + k] = 1.0f - f;
        }
        __syncthreads();
        float bend = 0.f;
        for (int s = 0; s < 64; ++s) bend += LF[s * 128 + k];
        float acc[32];
#pragma unroll
        for (int j = 0; j < 32; ++j) acc[j] = 0.f;
        float b = 0.f;
        for (int s = 0; s < 64; ++s) {
            b += LF[s * 128 + k];
            const float w = KD[s * 128 + k] * expf(bend - b);
            const LAS f32x4* iv = (const LAS f32x4*)(Ii + s * 128 + 32 * vq);
#pragma unroll
            for (int j = 0; j < 8; ++j) { const f32x4 x = iv[j]; acc[4 * j] += w * x.x; acc[4 * j + 1] += w * x.y; acc[4 * j + 2] += w * x.z; acc[4 * j + 3] += w * x.w; }
        }
        float* o = HGL + ((size_t)((d * 4 + h) * NCH + c) * 128 + k) * 128 + 32 * vq;
#pragma unroll
        for (int j = 0; j < 8; ++j) *(f32x4*)(o + 4 * j) = (f32x4){acc[4 * j], acc[4 * j + 1], acc[4 * j + 2], acc[4 * j + 3]};
        if (vq == 0) HGD[(size_t)((d * 4 + h) * NCH + c) * 128 + k] = expf(bend);
    }
}
__device__ __forceinline__ void phase_hg_B(Ctx& C, int b0, int nb) {
    float* HGL = WSP(float, OFF_HGL); const float* HGD = WSP(float, OFF_HGD);
    for (int e = b0 * NT + C.tid; e < 8 * 16384; e += nb * NT) {
        const int dh = e >> 14, kv = e & 16383, k = kv >> 7;
        float st = 0.f;
        float* p = HGL + (size_t)dh * NCH * 16384 + kv; const float* dp = HGD + (size_t)dh * NCH * 128 + k;
#pragma unroll 4
        for (int c = 0; c < NCH; ++c) { const float Lc = p[(size_t)c * 16384], Dc = dp[c * 128]; p[(size_t)c * 16384] = st; st = Dc * st + Lc; }
    }
}
__device__ __forceinline__ void phase_hg_C(Ctx& C, int l, int b0, int nb) {
    const float* P = WSP(float, OFF_P32); const float* HGL = WSP(float, OFF_HGL); bf16_t* YB = WSP(bf16_t, OFF_YB);
    constexpr int LDP = 132, LDA = 68;
    LAS float* Q = (LAS float*)C.lds;
    LAS float* B = Q + 64 * LDP;
    LAS float* KD = B + 64 * LDP;
    LAS float* ATT = KD + 64 * LDP;
    LAS float* RED = ATT + 64 * LDA;
    const int k = C.tid & 127, tq = C.tid >> 7;
    for (int u = b0; u < 4 * NCH; u += nb) {
        const int h = u / NCH, tc = u % NCH;
        float o[16];
#pragma unroll
        for (int j = 0; j < 16; ++j) o[j] = 0.f;
#pragma unroll 1
        for (int d = 0; d < 2; ++d) {
            const float lb = hg_lb(C, l, d, h * 128 + k);
            const int cd = d == 0 ? (tc + 4) % NCH : (NCH - 1 - tc);
            __syncthreads();
#pragma unroll 4
            for (int i = 0; i < 16; ++i) {
                const int rl = 16 * tq + i; const float* pr = P + (size_t)(64 * tc + rl) * P32W;
                Q[rl * LDP + k] = pr[h * 128 + k];
                const float fr = pr[512 + d * 512 + h * 128 + k];
                const float f = lb + (1.0f - lb) * sigmoidf_(fr);
                B[rl * LDP + k] = logf(f); KD[rl * LDP + k] = 1.0f - f;
            }
            __syncthreads();
            if (C.tid < 128) {
                float b = 0.f;
                if (d == 0) { for (int rl = 0; rl < 64; ++rl) { b += B[rl * LDP + k]; B[rl * LDP + k] = b; } }
                else { for (int rl = 63; rl >= 0; --rl) { b += B[rl * LDP + k]; B[rl * LDP + k] = b; } }
            }
            __syncthreads();
            {
                const int t = C.tid >> 3, sg = C.tid & 7;
                float a[8];
#pragma unroll
                for (int i = 0; i < 8; ++i) a[i] = 0.f;
                for (int kk = 0; kk < 128; kk += 4) {
                    const f32x4 qt = *(const LAS f32x4*)(Q + t * LDP + kk), bt = *(const LAS f32x4*)(B + t * LDP + kk);
#pragma unroll
                    for (int i = 0; i < 8; ++i) {
                        const int s = sg + 8 * i;
                        const f32x4 ks = *(const LAS f32x4*)(KD + s * LDP + kk), bs = *(const LAS f32x4*)(B + s * LDP + kk);
                        a[i] += qt.x * ks.x * __expf(fminf(bt.x - bs.x, 0.f)) + qt.y * ks.y * __expf(fminf(bt.y - bs.y, 0.f))
                              + qt.z * ks.z * __expf(fminf(bt.z - bs.z, 0.f)) + qt.w * ks.w * __expf(fminf(bt.w - bs.w, 0.f));
                    }
                }
#pragma unroll
                for (int i = 0; i < 8; ++i) { const int s = sg + 8 * i; const bool valid = d == 0 ? (s <= t) : (s >= t); ATT[t * LDA + s] = valid ? a[i] : 0.f; }
            }
            __syncthreads();
            LAS float* Iv = KD;
#pragma unroll 4
            for (int i = 0; i < 16; ++i) {
                const int rl = 16 * tq + i;
                Iv[rl * 128 + k] = P[(size_t)(64 * tc + rl) * P32W + 1536 + h * 128 + k];
                Q[rl * LDP + k] = Q[rl * LDP + k] * __expf(B[rl * LDP + k]);
            }
            __syncthreads();
            for (int s = 0; s < 64; s += 4) {
                const float i0 = Iv[(s + 0) * 128 + k], i1 = Iv[(s + 1) * 128 + k], i2 = Iv[(s + 2) * 128 + k], i3 = Iv[(s + 3) * 128 + k];
#pragma unroll
                for (int j = 0; j < 16; ++j) { const f32x4 a4 = *(const LAS f32x4*)(ATT + (16 * tq + j) * LDA + s); o[j] += a4.x * i0 + a4.y * i1 + a4.z * i2 + a4.w * i3; }
            }
            const float* Sp = HGL + (size_t)((d * 4 + h) * NCH + cd) * 16384 + k;
            for (int kk = 0; kk < 128; kk += 4) {
                const float s0 = Sp[(size_t)(kk + 0) * 128], s1 = Sp[(size_t)(kk + 1) * 128], s2 = Sp[(size_t)(kk + 2) * 128], s3 = Sp[(size_t)(kk + 3) * 128];
#pragma unroll
                for (int j = 0; j < 16; ++j) { const f32x4 q4 = *(const LAS f32x4*)(Q + (16 * tq + j) * LDP + kk); o[j] += q4.x * s0 + q4.y * s1 + q4.z * s2 + q4.w * s3; }
            }
        }
        __syncthreads();
#pragma unroll
        for (int j = 0; j < 16; ++j) { const float ss = wave_sum(o[j] * o[j]); if (C.lane == 0) RED[C.wave * 16 + j] = ss; }
        __syncthreads();
        const float nw = C.ka->in[I_HGNORM][l * 512 + h * 128 + k];
#pragma unroll
        for (int j = 0; j < 16; ++j) {
            const int row = 64 * tc + 16 * tq + j;
            const float tot = RED[(2 * tq) * 16 + j] + RED[(2 * tq + 1) * 16 + j];
            const float g = P[(size_t)row * P32W + 2048 + h * 128 + k];
            const float y = o[j] * rsqrtf(tot * (1.0f / 128.0f) + EPS) * nw * siluf_(g);
            YB[(size_t)row * 512 + h * 128 + k] = (bf16_t)f2bf(y);
        }
    }
}

__device__ __forceinline__ void phase_rw_scan(Ctx& C, int b0, int nb) {
    const float* SCN = WSP(float, OFF_SCN); const float* VV = WSP(float, OFF_VV); float* RO = WSP(float, OFF_RO);
    constexpr int STEPS = 32, SW = 384;
    LAS float* buf = (LAS float*)C.lds;
    for (int job = b0; job < 128; job += nb) {
        const int d = job >> 6, h = (job >> 3) & 7, rg = job & 7;
        const float* src = SCN + (size_t)((d * 8 + h) * MT) * 320;
        f32x4 regs[6];
#define load_chunk(ci) do { _Pragma("unroll") for (int i = 0; i < 6; ++i) { \
                const int q = C.tid + NT * i, st = q / 96, w = q % 96, j = STEPS * (ci) + st; \
                regs[i] = w < 80 ? *(const f32x4*)(src + (size_t)j * 320 + w * 4) : *(const f32x4*)(VV + (size_t)seq_row(d, j) * 512 + h * 64 + (w - 80) * 4); } } while (0)
#define store_chunk(bi) do { _Pragma("unroll") for (int i = 0; i < 6; ++i) { const int q = C.tid + NT * i; *(LAS f32x4*)(buf + (bi) * STEPS * SW + q * 4) = regs[i]; } } while (0)
        __syncthreads();
        load_chunk(0); store_chunk(0);
        __syncthreads();
        float S[8];
#pragma unroll
        for (int i = 0; i < 8; ++i) S[i] = 0.f;
        const int rr = C.lane >> 3, ks = C.lane & 7;
        constexpr int NCHK = MT / STEPS;
        for (int ci = 0; ci < NCHK; ++ci) {
            if (ci + 1 < NCHK) load_chunk(ci + 1);
            if (C.wave == 0) {
                const LAS float* bb = buf + (ci & 1) * STEPS * SW;
                for (int st = 0; st < STEPS; ++st) {
                    const LAS float* sp = bb + st * SW + 8 * ks;
                    const f32x4 w0 = *(const LAS f32x4*)(sp), w1 = *(const LAS f32x4*)(sp + 4);
                    const f32x4 k0 = *(const LAS f32x4*)(sp + 64), k1 = *(const LAS f32x4*)(sp + 68);
                    const f32x4 a0 = *(const LAS f32x4*)(sp + 128), a1 = *(const LAS f32x4*)(sp + 132);
                    const f32x4 d0 = *(const LAS f32x4*)(sp + 192), d1 = *(const LAS f32x4*)(sp + 196);
                    const f32x4 r0 = *(const LAS f32x4*)(sp + 256), r1 = *(const LAS f32x4*)(sp + 260);
                    const float vv = bb[st * SW + 320 + rg * 8 + rr];
                    float dot = (S[0] * k0.x + S[1] * k0.y) + (S[2] * k0.z + S[3] * k0.w) + (S[4] * k1.x + S[5] * k1.y) + (S[6] * k1.z + S[7] * k1.w);
                    dot += __shfl_xor(dot, 1); dot += __shfl_xor(dot, 2); dot += __shfl_xor(dot, 4);
                    S[0] = S[0] * w0.x - dot * a0.x + vv * d0.x; S[1] = S[1] * w0.y - dot * a0.y + vv * d0.y;
                    S[2] = S[2] * w0.z - dot * a0.z + vv * d0.z; S[3] = S[3] * w0.w - dot * a0.w + vv * d0.w;
                    S[4] = S[4] * w1.x - dot * a1.x + vv * d1.x; S[5] = S[5] * w1.y - dot * a1.y + vv * d1.y;
                    S[6] = S[6] * w1.z - dot * a1.z + vv * d1.z; S[7] = S[7] * w1.w - dot * a1.w + vv * d1.w;
                    float od = (S[0] * r0.x + S[1] * r0.y) + (S[2] * r0.z + S[3] * r0.w) + (S[4] * r1.x + S[5] * r1.y) + (S[6] * r1.z + S[7] * r1.w);
                    od += __shfl_xor(od, 1); od += __shfl_xor(od, 2); od += __shfl_xor(od, 4);
                    if (ks == 0) RO[((size_t)d * MT + seq_row(d, STEPS * ci + st)) * 512 + h * 64 + rg * 8 + rr] = od;
                }
            }
            if (ci + 1 < NCHK) store_chunk((ci + 1) & 1);
            __syncthreads();
        }
    }
#undef load_chunk
#undef store_chunk
}
__device__ __forceinline__ void phase_rw_finish(Ctx& C, int l, int w0, int nw) {
    const float* SCN = WSP(float, OFF_SCN); const float* VV = WSP(float, OFF_VV); const float* GS = WSP(float, OFF_GS); const float* RO = WSP(float, OFF_RO);
    bf16_t* YB = WSP(bf16_t, OFF_YB) + (size_t)1 * MT * 512;
    const int e = C.lane;
    for (int uidx = w0; uidx < MT * 8; uidx += nw) {
        const int r = uidx >> 3, h = uidx & 7, c = h * 64 + e;
        const float o = RO[(size_t)r * 512 + c] + RO[((size_t)MT + r) * 512 + c];
        const float mu = wave_sum(o) * (1.0f / 64.0f);
        const float dv = o - mu;
        const float var = wave_sum(dv * dv) * (1.0f / 64.0f);
        const float on = dv * rsqrtf(var + RW_GN_EPS) * C.ka->in[I_RWLNW][l * 512 + c] + C.ka->in[I_RWLNB][l * 512 + c];
        const float* s0 = SCN + ((size_t)((0 * 8 + h) * MT + row_seq(0, r))) * 320 + e;
        const float* s1 = SCN + ((size_t)((1 * 8 + h) * MT + row_seq(1, r))) * 320 + e;
        const float kdsum = s0[192] + s1[192], rr = s0[256];
        const float bonus = wave_sum(rr * kdsum * C.ka->in[I_RWRK][l * 512 + c]);
        const float y = (on + bonus * VV[(size_t)r * 512 + c]) * GS[(size_t)r * 512 + c];
        YB[(size_t)r * 512 + c] = (bf16_t)f2bf(y);
    }
}

__device__ __forceinline__ float dot64_bf16(const float (&q)[64], const bf16_t* kp) {
    float s = 0.f;
#pragma unroll
    for (int j = 0; j < 8; ++j) {
        const u32x4 w = *(const u32x4*)(kp + 8 * j);
        s += q[8 * j + 0] * bf2f(w.x & 0xffffu) + q[8 * j + 1] * bf2f(w.x >> 16) + q[8 * j + 2] * bf2f(w.y & 0xffffu) + q[8 * j + 3] * bf2f(w.y >> 16)
           + q[8 * j + 4] * bf2f(w.z & 0xffffu) + q[8 * j + 5] * bf2f(w.z >> 16) + q[8 * j + 6] * bf2f(w.w & 0xffffu) + q[8 * j + 7] * bf2f(w.w >> 16);
    }
    return s;
}
__device__ __forceinline__ void load_q64(float (&q)[64], const bf16_t* qp) {
#pragma unroll
    for (int j = 0; j < 8; ++j) {
        const u32x4 w = *(const u32x4*)(qp + 8 * j);
        q[8 * j + 0] = bf2f(w.x & 0xffffu); q[8 * j + 1] = bf2f(w.x >> 16); q[8 * j + 2] = bf2f(w.y & 0xffffu); q[8 * j + 3] = bf2f(w.y >> 16);
        q[8 * j + 4] = bf2f(w.z & 0xffffu); q[8 * j + 5] = bf2f(w.z >> 16); q[8 * j + 6] = bf2f(w.w & 0xffffu); q[8 * j + 7] = bf2f(w.w >> 16);
    }
}
__device__ __forceinline__ void phase_na(Ctx& C, int l, int w0, int nw) {
    const bf16_t* PA = WSP(bf16_t, OFF_PA); bf16_t* YB = WSP(bf16_t, OFF_YB) + (size_t)2 * MT * 512;
    const float* rpb = C.ka->in[I_NARPB] + (size_t)l * 8 * 15 * 31;
    const int lane = C.lane;
    for (int uidx = w0; uidx < MT * 8; uidx += nw) {
        const int r = __builtin_amdgcn_readfirstlane(uidx >> 3), h = __builtin_amdgcn_readfirstlane(uidx & 7);
        float q[64]; load_q64(q, PA + (size_t)r * PAW + h * 64);
        const bool lat = r < SEQ;
        const int i = r >> 6, j = r & 63;
        int rs = i - 4; rs = rs < 0 ? 0 : (rs > 120 ? 120 : rs);
        int cs = j - 8; cs = cs < 0 ? 0 : (cs > 48 ? 48 : cs);
        float sc[6]; int kt[6];
#pragma unroll
        for (int it = 0; it < 2; ++it) {
            const int idx = lane + 64 * it, a = idx >> 4, cc = idx & 15;
            kt[it] = (rs + a) * 64 + cs + cc;
            if (lat) sc[it] = dot64_bf16(q, PA + (size_t)kt[it] * PAW + 512 + h * 64) + rpb[(h * 15 + (rs + a - i + 7)) * 31 + (cs + cc - j + 15)];
            else sc[it] = -INFINITY;
        }
#pragma unroll
        for (int it = 2; it < 6; ++it) { kt[it] = SEQ + lane + 64 * (it - 2); sc[it] = dot64_bf16(q, PA + (size_t)kt[it] * PAW + 512 + h * 64); }
        float mx = sc[0];
#pragma unroll
        for (int it = 1; it < 6; ++it) mx = fmaxf(mx, sc[it]);
        mx = wave_max(mx);
        float sum = 0.f;
#pragma unroll
        for (int it = 0; it < 6; ++it) { sc[it] = __expf(sc[it] - mx); sum += sc[it]; }
        sum = wave_sum(sum);
        const float rinv = 1.0f / sum;
        float o = 0.f;
#pragma unroll
        for (int it = 0; it < 6; ++it) {
            if (it < 2 && !lat) continue;
            for (int src = 0; src < 64; ++src) {
                const float p = __shfl(sc[it], src); const int kk = __shfl(kt[it], src);
                o += p * bf2f(PA[(size_t)kk * PAW + 1024 + h * 64 + lane]);
            }
        }
        YB[(size_t)r * 512 + h * 64 + lane] = (bf16_t)f2bf(o * rinv);
    }
}
__device__ __forceinline__ void phase_wa(Ctx& C, int l, int w0, int nw) {
    const bf16_t* PA = WSP(bf16_t, OFF_PA); bf16_t* YB = WSP(bf16_t, OFF_YB) + (size_t)3 * MT * 512;
    const int lane = C.lane;
    for (int uidx = w0; uidx < MT * 8; uidx += nw) {
        const int r = __builtin_amdgcn_readfirstlane(uidx >> 3), hq = __builtin_amdgcn_readfirstlane(uidx & 7), kvh = hq >> 2;
        float q[64]; load_q64(q, PA + (size_t)r * PAW + 1536 + hq * 64);
        const bool lat = r < SEQ;
        const float sink = C.ka->in[I_WASINK][l * 8 + hq];
        float sc[9]; int kt[9];
#pragma unroll
        for (int it = 0; it < 5; ++it) {
            const int idx = lane + 64 * it, kp = r - 128 + idx;
            const bool valid = lat && idx <= 256 && kp >= 0 && kp < SEQ;
            kt[it] = valid ? kp : 0;
            sc[it] = valid ? dot64_bf16(q, PA + (size_t)kp * PAW + 2048 + kvh * 64) : -INFINITY;
        }
#pragma unroll
        for (int it = 5; it < 9; ++it) { kt[it] = SEQ + lane + 64 * (it - 5); sc[it] = dot64_bf16(q, PA + (size_t)kt[it] * PAW + 2048 + kvh * 64); }
        float mx = sink;
#pragma unroll
        for (int it = 0; it < 9; ++it) mx = fmaxf(mx, sc[it]);
        mx = wave_max(mx);
        float sum = 0.f;
#pragma unroll
        for (int it = 0; it < 9; ++it) { sc[it] = __expf(sc[it] - mx); sum += sc[it]; }
        sum = wave_sum(sum) + __expf(sink - mx);
        const float rinv = 1.0f / sum;
        float o = 0.f;
#pragma unroll
        for (int it = 0; it < 9; ++it) {
            if (it < 5 && !lat) continue;
            for (int src = 0; src < 64; ++src) {
                const float p = __shfl(sc[it], src); const int kk = __shfl(kt[it], src);
                o += p * bf2f(PA[(size_t)kk * PAW + 2176 + kvh * 64 + lane]);
            }
        }
        YB[(size_t)r * 512 + hq * 64 + lane] = (bf16_t)f2bf(o * rinv);
    }
}

__device__ __forceinline__ void phase_combine(Ctx& C) {
    const bf16_t* PROJ = WSP(bf16_t, OFF_P32); bf16_t* MG = WSP(bf16_t, OFF_H);
    const size_t n8 = (size_t)MT * D / 8;
    for (size_t i = (size_t)C.bid * NT + C.tid; i < n8; i += (size_t)C.G * NT) {
        const size_t r = i / (D / 8), c8 = i % (D / 8);
        float a[8];
#pragma unroll
        for (int j = 0; j < 8; ++j) a[j] = 0.f;
#pragma unroll
        for (int g = 0; g < 4; ++g) {
            const u32x4 w = *(const u32x4*)(PROJ + r * GLW + g * D + c8 * 8);
            a[0] += bf2f(w.x & 0xffffu); a[1] += bf2f(w.x >> 16); a[2] += bf2f(w.y & 0xffffu); a[3] += bf2f(w.y >> 16);
            a[4] += bf2f(w.z & 0xffffu); a[5] += bf2f(w.z >> 16); a[6] += bf2f(w.w & 0xffffu); a[7] += bf2f(w.w >> 16);
        }
        u32x4 o; o.x = pk2(a[0], a[1]); o.y = pk2(a[2], a[3]); o.z = pk2(a[4], a[5]); o.w = pk2(a[6], a[7]);
        *(u32x4*)(MG + r * D + c8 * 8) = o;
    }
}

constexpr int PH_PRO = 2, PH_PER_LAYER = 14, N_PHASES = PH_PRO + DEPTH * PH_PER_LAYER;

__global__ void __launch_bounds__(NT, 2) mk_fwd(Args args) {
    extern __shared__ __attribute__((aligned(16))) unsigned char lds_raw[];
    Ctx C;
    C.lds = (LAS unsigned char*)lds_raw;
    C.tid = threadIdx.x; C.lane = C.tid & 63; C.wave = __builtin_amdgcn_readfirstlane(C.tid >> 6);
    C.bid = blockIdx.x; C.G = gridDim.x;
    C.ka = (const Args __attribute__((address_space(4)))*)__builtin_amdgcn_kernarg_segment_ptr(); C.out = args.out; C.ws = args.ws;
    volatile LAS unsigned* MISC = (volatile LAS unsigned*)(C.lds + MISC_OFF);
    for (int u = C.tid; u < (LDS_BYTES - RING_BYTES) / 4; u += NT) ((LAS unsigned*)(C.lds + RING_BYTES))[u] = 0u;
    __syncthreads();
    const int lo = args.ph_lo, hi = args.ph_hi;
    XcdBarrier bar; bar.bar = WSP(unsigned, OFF_CTL) + 4096; bar.x = 0; bar.st = nullptr;
    const bool multi = (hi - lo) > 1;
    if (multi) bar = xcd_barrier_post(WSP(unsigned, OFF_CTL) + 4096, MISC + 8);
#ifndef PH_MASK
#define PH_MASK 0xFFFF
#endif
#ifndef PRO_MASK
#define PRO_MASK 3
#endif
#define IN(k) (lo <= (k) && (k) < hi)
#define LEN(j) (((PH_MASK) >> (j)) & 1)
#define SEAM(k) do { if (IN(k) && IN((k) + 1)) xcd_barrier(bar); } while (0)

    if ((PRO_MASK & 1) && IN(0)) { relaunder(C); phase_convert(C, 0); phase_ada_partial(C); } SEAM(0);
    if ((PRO_MASK & 2) && IN(1)) { relaunder(C); phase_ada_reduce(C); } SEAM(1);

#pragma unroll
    for (int l = 0; l < DEPTH; ++l) {
        const int pb = PH_PRO + l * PH_PER_LAYER;
        if (LEN(0) && IN(pb + 0)) { relaunder(C); if (l > 0) phase_convert(C, l); phase_norm(C, l, C.ka->in[I_NF1] + (size_t)l * D, 0); } SEAM(pb + 0);
        if (LEN(1) && IN(pb + 1)) { relaunder(C);
            pg8::Gemm g{WSP(bf16_t, OFF_H), WSP(bf16_t, OFF_WI1), MT, 2 * DFF, D, 1 << 20, 0};
            pg8::StaticOrder S; S.init(MT, 2 * DFF, C.G, C.bid);
            pg8::EpiSwiGLU E{WSP(bf16_t, OFF_G)};
            pg8::gemm_phase<pg8::EpiSwiGLU, true, false>(C.lds, g, S, E, C.tid);
        } SEAM(pb + 1);
        if (LEN(2) && IN(pb + 2)) { relaunder(C);
            pg8::Gemm g{WSP(bf16_t, OFF_G), WSP(bf16_t, OFF_WO1), MT, D, DFF, 1 << 20, 0};
            pg8::StaticOrder S; S.init(MT, D, C.G, C.bid);
            pg8::EpiResid<true> E{WSP(float, OFF_X), mod_ptr(C, l, 0, 2), mod_ptr(C, l, 1, 2), nullptr};
            pg8::gemm_phase<pg8::EpiResid<true>, true, false>(C.lds, g, S, E, C.tid);
        } SEAM(pb + 2);
        if (LEN(3) && IN(pb + 3)) { relaunder(C); phase_norm(C, l, C.ka->in[I_NMIX] + (size_t)l * D, 3); } SEAM(pb + 3);
        if (LEN(4) && IN(pb + 4)) { relaunder(C);
            pg8::Gemm g{WSP(bf16_t, OFF_H), WSP(bf16_t, OFF_WIN), MT, PTOT, D, 1 << 20, 0};
            pg8::StaticOrder S; S.init(MT, PTOT, C.G, C.bid);
            pg8::EpiWin E{WSP(float, OFF_P32), WSP(bf16_t, OFF_PA), WSP(bf16_t, OFF_GL)};
            pg8::gemm_phase<pg8::EpiWin, true, false>(C.lds, g, S, E, C.tid);
        } SEAM(pb + 4);
        if (LEN(5) && IN(pb + 5)) { relaunder(C);
            phase_rw_prep(C, l, C.bid, C.G);
            __syncthreads();
            phase_attn_prep(C, l, C.bid * NWAVES + C.wave, C.G * NWAVES);
            __syncthreads();
            phase_hg_A(C, l, C.bid, C.G);
        } SEAM(pb + 5);
        if (LEN(6) && IN(pb + 6)) { relaunder(C);
            if (C.G >= 256) {
                if (C.bid < 128) phase_rw_scan(C, C.bid, 128);
                else { const int b = C.bid - 128, n = C.G - 128; phase_hg_B(C, b, n); phase_na(C, l, b * NWAVES + C.wave, n * NWAVES); phase_wa(C, l, b * NWAVES + C.wave, n * NWAVES); }
            } else {
                phase_rw_scan(C, C.bid, C.G); phase_hg_B(C, C.bid, C.G); phase_na(C, l, C.bid * NWAVES + C.wave, C.G * NWAVES); phase_wa(C, l, C.bid * NWAVES + C.wave, C.G * NWAVES);
            }
        } SEAM(pb + 6);
        if (LEN(7) && IN(pb + 7)) { relaunder(C); phase_hg_C(C, l, C.bid, C.G); phase_rw_finish(C, l, C.bid * NWAVES + C.wave, C.G * NWAVES); } SEAM(pb + 7);
        if (LEN(8) && IN(pb + 8)) { relaunder(C);
            pg8::Gemm g{WSP(bf16_t, OFF_YB), WSP(bf16_t, OFF_WBR), MT, 4 * D, 512, 8, (size_t)MT * 512};
            pg8::StaticOrder S; S.init(MT, 4 * D, C.G, C.bid);
            pg8::EpiMerge E{WSP(bf16_t, OFF_GL), WSP(bf16_t, OFF_P32)};
            pg8::gemm_phase<pg8::EpiMerge, true, false>(C.lds, g, S, E, C.tid);
        } SEAM(pb + 8);
        if (LEN(9) && IN(pb + 9)) { relaunder(C); phase_combine(C); } SEAM(pb + 9);
        if (LEN(10) && IN(pb + 10)) { relaunder(C);
            pg8::Gemm g{WSP(bf16_t, OFF_H), WSP(bf16_t, OFF_WOUT), MT, D, D, 1 << 20, 0};
            pg8::StaticOrder S; S.init(MT, D, C.G, C.bid);
            pg8::EpiResid<false> E{WSP(float, OFF_X), mod_ptr(C, l, 0, 5), mod_ptr(C, l, 1, 5), nullptr};
            pg8::gemm_phase<pg8::EpiResid<false>, true, false>(C.lds, g, S, E, C.tid);
        } SEAM(pb + 10);
        if (LEN(11) && IN(pb + 11)) { relaunder(C); phase_norm(C, l, C.ka->in[I_NF2] + (size_t)l * D, 6); } SEAM(pb + 11);
        if (LEN(12) && IN(pb + 12)) { relaunder(C);
            pg8::Gemm g{WSP(bf16_t, OFF_H), WSP(bf16_t, OFF_WI2), MT, 2 * DFF, D, 1 << 20, 0};
            pg8::StaticOrder S; S.init(MT, 2 * DFF, C.G, C.bid);
            pg8::EpiSwiGLU E{WSP(bf16_t, OFF_G)};
            pg8::gemm_phase<pg8::EpiSwiGLU, true, false>(C.lds, g, S, E, C.tid);
        } SEAM(pb + 12);
        if (LEN(13) && IN(pb + 13)) { relaunder(C);
            pg8::Gemm g{WSP(bf16_t, OFF_G), WSP(bf16_t, OFF_WO2), MT, D, DFF, 1 << 20, 0};
            pg8::StaticOrder S; S.init(MT, D, C.G, C.bid);
            pg8::EpiResid<true> E{WSP(float, OFF_X), mod_ptr(C, l, 0, 8), mod_ptr(C, l, 1, 8), l == DEPTH - 1 ? C.out : nullptr};
            pg8::gemm_phase<pg8::EpiResid<true>, true, false>(C.lds, g, S, E, C.tid);
        } SEAM(pb + 13);
    }
#undef IN
#undef SEAM
}

extern "C" void kernel_launch(void* const* d_in, const int* in_sizes, int n_in, void* d_out, int out_size, void* d_ws, size_t ws_size, hipStream_t stream) {
    static int grid = 0;
    if (grid == 0) {
        if (n_in != N_IN || out_size != SEQ * D || ws_size < WS_END) { fprintf(stderr, "kernel_launch: unexpected shapes (n_in %d out %d ws %zu)\n", n_in, out_size, ws_size); grid = -1; return; }
        int dev = 0, cus = 0;
        if (hipGetDevice(&dev) != hipSuccess || hipDeviceGetAttribute(&cus, hipDeviceAttributeMultiprocessorCount, dev) != hipSuccess) { grid = -1; return; }
        if (hipFuncSetAttribute((const void*)mk_fwd, hipFuncAttributeMaxDynamicSharedMemorySize, LDS_BYTES) != hipSuccess) { fprintf(stderr, "kernel_launch: hipFuncSetAttribute failed\n"); grid = -1; return; }
        (void)hipGetLastError();
        grid = cus;
    }
    if (grid < 0) return;
    (void)hipMemsetAsync((char*)d_ws + OFF_CTL, 0, CTL_BYTES, stream);
    Args a{};
    for (int i = 0; i < N_IN; ++i) a.in[i] = (const float*)d_in[i];
    a.out = (float*)d_out; a.ws = (unsigned char*)d_ws;
#if MK_ONE_LAUNCH
    a.ph_lo = 0; a.ph_hi = N_PHASES;
    hipLaunchKernelGGL(mk_fwd, dim3(grid), dim3(NT), LDS_BYTES, stream, a);
#else
    for (int ph = 0; ph < N_PHASES; ++ph) {
        a.ph_lo = ph; a.ph_hi = ph + 1;
        hipLaunchKernelGGL(mk_fwd, dim3(grid), dim3(NT), LDS_BYTES, stream, a);
    }
#endif
}
```

```cpp
#include <hip/hip_runtime.h>
#include <cstdio>
#include <cstdint>

#ifndef MK_ONE_LAUNCH
#define MK_ONE_LAUNCH 1
#endif

#define LAS __attribute__((address_space(3)))
#define GAS __attribute__((address_space(1)))
typedef unsigned short bf16_t;
typedef short bf16x8 __attribute__((ext_vector_type(8)));
typedef float f32x4 __attribute__((ext_vector_type(4)));
typedef float f32x2 __attribute__((ext_vector_type(2)));
typedef unsigned u32x4 __attribute__((ext_vector_type(4)));
typedef unsigned u32x2 __attribute__((ext_vector_type(2)));

constexpr int D = 2048, SEQ = 8192, CTX = 256, MT = SEQ + CTX, DEPTH = 2, DFF = 5632, NMOD = 9, MODW = NMOD * D;
constexpr int GRID_W = 64;
constexpr int PTOT = 15360, P32W = 4864, PAW = 2304, GLW = 8192;
constexpr int HG_OFF = 0, RW_OFF = 2560, RWC = 2304;
constexpr int NCH = MT / 64;
constexpr int NWAVES = 8, NT = 512;
constexpr float EPS = 1e-6f, RW_GN_EPS = 64e-5f;

constexpr size_t MiB = 1u << 20;
constexpr size_t OFF_CTL = 0, CTL_BYTES = 1 * MiB;
constexpr size_t OFF_MOD = 1 * MiB;
constexpr size_t OFF_MODP = 2 * MiB;
constexpr size_t OFF_WI1 = 11 * MiB, OFF_WO1 = 55 * MiB, OFF_WIN = 77 * MiB, OFF_WBR = 137 * MiB, OFF_WOUT = 145 * MiB, OFF_WI2 = 153 * MiB, OFF_WO2 = 197 * MiB;
constexpr size_t OFF_X = 219 * MiB;
constexpr size_t OFF_H = 285 * MiB;
constexpr size_t OFF_G = 318 * MiB;
constexpr size_t OFF_P32 = 409 * MiB;
constexpr size_t OFF_PA = 566 * MiB;
constexpr size_t OFF_GL = 604 * MiB;
constexpr size_t OFF_HGL = 736 * MiB;
constexpr size_t OFF_HGD = 802 * MiB;
constexpr size_t OFF_SCN = 803 * MiB;
constexpr size_t OFF_VV = 968 * MiB;
constexpr size_t OFF_GS = 985 * MiB;
constexpr size_t OFF_RO = 1002 * MiB;
constexpr size_t OFF_YB = 1035 * MiB;
constexpr size_t OFF_VTN = 1068 * MiB;
constexpr size_t OFF_VTW = 1077 * MiB;
constexpr size_t OFF_PB = 1080 * MiB;
constexpr size_t OFF_MREF = OFF_PB + 65536;
constexpr size_t WS_END = 1081 * MiB;
constexpr int KSPLIT = 32;

constexpr int LDS_BYTES = 147456;
constexpr int RING_BYTES = 131072;
constexpr int MISC_OFF = RING_BYTES + 320;

__device__ __forceinline__ float bf2f(unsigned b) { return __uint_as_float(b << 16); }
__device__ __forceinline__ unsigned f2bf(float f) { unsigned u = __float_as_uint(f); return (u + 0x7fffu + ((u >> 16) & 1u)) >> 16; }
__device__ __forceinline__ unsigned pk2(float lo, float hi) { return f2bf(lo) | (f2bf(hi) << 16); }
__device__ __forceinline__ float wave_sum(float v) {
#pragma unroll
    for (int o = 1; o < 64; o <<= 1) v += __shfl_xor(v, o);
    return v;
}
__device__ __forceinline__ float wave_max(float v) {
#pragma unroll
    for (int o = 1; o < 64; o <<= 1) v = fmaxf(v, __shfl_xor(v, o));
    return v;
}
__device__ __forceinline__ float sigmoidf_(float x) { return 1.0f / (1.0f + expf(-x)); }
__device__ __forceinline__ float siluf_(float x) { return x / (1.0f + expf(-x)); }
#define LDS_WAIT() asm volatile("s_waitcnt lgkmcnt(0)" ::: "memory")

__device__ __forceinline__ int seq_row(int d, int j) { return d == 0 ? (j < CTX ? SEQ + j : j - CTX) : (MT - 1 - j); }
__device__ __forceinline__ int row_seq(int d, int r) { return d == 0 ? (r >= SEQ ? r - SEQ : r + CTX) : (MT - 1 - r); }

#define XB_TMO      128
#define XB_XCNT(j)  (256  + 64 * (j))
#define XB_XSUB(j)  (1280 + 64 * (j))
#define XB_XGEN(j)  (2304 + 64 * (j))
#define XB_TOP      3328
#define XB_TOPGEN   3392
#define XCD_BAR_WORDS 3456
#define XB_SPIN_CAP (1u << 18)
__device__ __forceinline__ unsigned xb_ld(unsigned* p)              { return __hip_atomic_load(p, __ATOMIC_RELAXED, __HIP_MEMORY_SCOPE_AGENT); }
__device__ __forceinline__ unsigned xb_add(unsigned* p, unsigned v) { return __hip_atomic_fetch_add(p, v, __ATOMIC_RELAXED, __HIP_MEMORY_SCOPE_AGENT); }
__device__ __forceinline__ unsigned xb_xcc_id() { return (unsigned)__builtin_amdgcn_s_getreg((3 << 11) | 20) & 0xFu; }
#define XB_SPIN(cond, bar) do { unsigned _sp = 0; while (cond) { __builtin_amdgcn_s_sleep(1); \
    if ((++_sp & 255u) == 0u) { if (xb_ld(&(bar)[XB_TMO])) break; if (_sp > XB_SPIN_CAP) { atomicAdd(&(bar)[XB_TMO], 1u); break; } } } } while (0)
struct XcdBarrier { unsigned* bar; unsigned x; volatile LAS unsigned* st; };
__device__ __forceinline__ XcdBarrier xcd_barrier_post(unsigned* bar, volatile LAS unsigned* st) {
    XcdBarrier b; b.bar = bar; b.x = xb_xcc_id(); b.st = st;
    if (threadIdx.x == 0) (void)xb_add(&bar[XB_XCNT(b.x)], 1u);
    return b;
}
__device__ __forceinline__ void xcd_barrier_complete(unsigned* bar, unsigned x, unsigned& nloc, unsigned& nx) {
    const unsigned G = gridDim.x * gridDim.y * gridDim.z;
    unsigned sum, cnt, mine, sp = 0u;
    for (;;) {
        sum = 0u; cnt = 0u; mine = 0u;
#pragma unroll
        for (unsigned j = 0; j < 16; ++j) { const unsigned c = xb_ld(&bar[XB_XCNT(j)]); sum += c; cnt += (c > 0u) ? 1u : 0u; mine = (j == x) ? c : mine; }
        if (sum == G) break;
        __builtin_amdgcn_s_sleep(1);
        if ((++sp & 255u) == 0u) { if (xb_ld(&bar[XB_TMO])) break; if (sp > XB_SPIN_CAP) { atomicAdd(&bar[XB_TMO], 1u); break; } }
    }
    nloc = mine > 0u ? mine : 1u; nx = cnt > 0u ? cnt : 1u;
}
__device__ __forceinline__ void xcd_barrier(const XcdBarrier& b) {
    asm volatile("s_waitcnt vmcnt(0)" ::: "memory");
    __syncthreads();
    if (threadIdx.x == 0) {
        unsigned* bar = b.bar;
        __builtin_amdgcn_s_waitcnt(0);
        unsigned nloc = b.st[0], nx = b.st[1];
        if (nloc == 0u) { xcd_barrier_complete(bar, b.x, nloc, nx); b.st[0] = nloc; b.st[1] = nx; }
        const unsigned old = xb_add(&bar[XB_XSUB(b.x)], 1u);
        const unsigned gen = old / nloc;
        if (old + 1u == (gen + 1u) * nloc) {
            __builtin_amdgcn_fence(__ATOMIC_RELEASE, "agent");
            asm volatile("s_waitcnt vmcnt(0)" ::: "memory");
            const unsigned og = xb_add(&bar[XB_TOP], 1u);
            const unsigned tg = og / nx;
            if (og + 1u == (tg + 1u) * nx) xb_add(&bar[XB_TOPGEN], 1u);
            else XB_SPIN(xb_ld(&bar[XB_TOPGEN]) == tg, bar);
            __builtin_amdgcn_fence(__ATOMIC_ACQUIRE, "agent");
            xb_add(&bar[XB_XGEN(b.x)], 1u);
            asm volatile("s_waitcnt vmcnt(0)" ::: "memory");
        } else {
            XB_SPIN(xb_ld(&bar[XB_XGEN(b.x)]) == gen, bar);
            __builtin_amdgcn_fence(__ATOMIC_ACQUIRE, "agent");
            asm volatile("s_waitcnt vmcnt(0)" ::: "memory");
        }
    }
    __syncthreads();
}

namespace pg8 {
constexpr int BM = 256, BK = 64, HALF = 128, HTB = HALF * BK * 2, STAGE_BYTES = 8 * HTB, NXCD = 8, WGM = 8;
__host__ __device__ __forceinline__ int lds_byte(int r, int c) { const int st = (r >> 4) * 2 + (c >> 5), rr = r & 15, cc = c & 31, ob = rr * 64 + cc * 2; return st * 1024 + (ob ^ (((ob >> 9) & 1) << 5)); }
__host__ __device__ __forceinline__ void stage_rc(int b, int& R, int& C) { const int st = b / 1024, sb = b % 1024, swz = sb ^ (((sb >> 9) & 1) << 5); R = (st >> 1) * 16 + swz / 64; C = (st & 1) * 32 + (swz % 64) / 2; }
__host__ __device__ __forceinline__ int perm32(int rho) { const int n = rho >> 4, i = rho & 15; return 8 * (i >> 2) + 4 * n + (i & 3); }
struct Unit { int pm, pn; };
struct Gemm { const bf16_t* A; const bf16_t* Bt; int M, N, K; int a_div; size_t a_gstride; };
struct StaticOrder {
    int nM, nN, nwg, G, c;
    __host__ __device__ void init(int M, int N, int G_, int c_) { nM = M / BM; nN = N / BM; nwg = nM * nN; G = G_; c = c_; }
    __host__ __device__ bool next(int i, Unit& u) const {
        const long L = (long)i * G + c; if (L >= nwg) return false;
        int wgid = (int)L; { const int q = nwg / NXCD, r = nwg % NXCD, xcd = wgid % NXCD, off = wgid / NXCD; wgid = (xcd < r ? xcd * (q + 1) : r * (q + 1) + (xcd - r) * q) + off; }
        const int nig = WGM * nN, gid = wgid / nig, fm = gid * WGM, gsz = (nM - fm) < WGM ? (nM - fm) : WGM;
        u.pm = fm + ((wgid % nig) % gsz); u.pn = (wgid % nig) / gsz; return true;
    }
};
__device__ __forceinline__ unsigned cvt_pk_bf16(float lo, float hi) { unsigned r; asm volatile("v_cvt_pk_bf16_f32 %0, %1, %2" : "=v"(r) : "v"(lo), "v"(hi)); return r; }

template <class Epi, bool ALIGN_EPI, bool SP2>
__device__ __forceinline__ void gemm_phase(LAS unsigned char* lds, const Gemm g, const StaticOrder& S, const Epi& E, const int tid) {
    const int wid = __builtin_amdgcn_readfirstlane(tid >> 6), lane = tid & 63, wr = wid >> 2, wc = wid & 3, fr = lane & 15, fq = lane >> 4;
    const int K = g.K, nt = K / BK;
    unsigned voffA[2], voffB[2];
#pragma unroll
    for (int i = 0; i < 2; ++i) { int R, C; stage_rc(tid * 16 + i * 8192, R, C); const int Rb = Epi::PERM ? ((R & ~31) + perm32(R & 31)) : R;
        voffA[i] = (unsigned)(R * K + C) * 2u; voffB[i] = (unsigned)(Rb * K + C) * 2u; }
    const size_t kstep = (size_t)(BK * 2);
    const size_t hstep = (size_t)HALF * K * 2;
    const size_t tstep = 2 * hstep;
    const unsigned ldsw = (unsigned)wid * 1024u;
    const int aoff = lds_byte(wr * 64 + fr, fq * 8), boff = lds_byte(wc * 32 + fr, fq * 8);
#define PG8_SA(b, h) (((b) * 2 + (h)) * HTB)
#define PG8_SB(b, h) ((4 + (b) * 2 + (h)) * HTB)
#define PG8_STAGE(bufoff, gbase, voff) do { _Pragma("unroll") for (int _i = 0; _i < 2; ++_i) \
        __builtin_amdgcn_global_load_lds((const unsigned*)((const char*)(gbase) + (voff)[_i]), (LAS unsigned*)(lds + (bufoff) + ldsw + _i * 8192), 16, 0, 0); } while (0)
#define PG8_LDA(dst, b, h) do { _Pragma("unroll") for (int m = 0; m < 4; ++m) _Pragma("unroll") for (int k = 0; k < 2; ++k) dst[m][k] = *(const LAS bf16x8*)(lds + PG8_SA(b, h) + aoff + m * 2048 + k * 1024); } while (0)
#define PG8_LDB(dst, b, h) do { _Pragma("unroll") for (int n = 0; n < 2; ++n) _Pragma("unroll") for (int k = 0; k < 2; ++k) dst[n][k] = *(const LAS bf16x8*)(lds + PG8_SB(b, h) + boff + n * 2048 + k * 1024); } while (0)
#define PG8_MMA(ai, bj, At, Bt) do { __builtin_amdgcn_s_setprio(1); _Pragma("unroll") for (int m = 0; m < 4; ++m) _Pragma("unroll") for (int n = 0; n < 2; ++n) _Pragma("unroll") for (int k = 0; k < 2; ++k) \
        acc[ai][bj][m][n] = __builtin_amdgcn_mfma_f32_16x16x32_bf16(Bt[n][k], At[m][k], acc[ai][bj][m][n], 0, 0, 0); __builtin_amdgcn_s_setprio(0); } while (0)
#define PG8_WAIT_V(n) asm volatile("s_waitcnt vmcnt(" #n ")" ::: "memory")
#define PG8_WAIT_L(n) asm volatile("s_waitcnt lgkmcnt(" #n ")" ::: "memory")
#define PG8_BAR __builtin_amdgcn_s_barrier()
#define PG8_SCHED __builtin_amdgcn_sched_barrier(0)
#define PG8_ABASE(u) ((const char*)g.A + ((size_t)((u).pn / g.a_div) * g.a_gstride) * 2 + (size_t)(u).pm * tstep)
    Unit cur, nxt; int ui = 0;
    if (!S.next(0, cur)) return;
    f32x4 acc[2][2][4][2];
#pragma unroll
    for (int a = 0; a < 2; ++a)
#pragma unroll
        for (int b = 0; b < 2; ++b)
#pragma unroll
            for (int m = 0; m < 4; ++m)
#pragma unroll
                for (int n = 0; n < 2; ++n) acc[a][b][m][n] = (f32x4){0.f, 0.f, 0.f, 0.f};
    bf16x8 At[4][2], B0[2][2], B1[2][2];
    const char* cA = PG8_ABASE(cur); const char* cB = (const char*)g.Bt + (size_t)cur.pn * tstep;
    if constexpr (SP2) {
        PG8_STAGE(PG8_SB(0, 0), cB, voffB); PG8_STAGE(PG8_SB(0, 1), cB + hstep, voffB); PG8_STAGE(PG8_SA(0, 0), cA, voffA); PG8_STAGE(PG8_SA(0, 1), cA + hstep, voffA);
        if (wr == 1) PG8_BAR;
        PG8_WAIT_V(2); PG8_BAR;
        PG8_STAGE(PG8_SB(1, 0), cB + kstep, voffB); PG8_STAGE(PG8_SA(1, 0), cA + kstep, voffA); PG8_STAGE(PG8_SB(1, 1), cB + hstep + kstep, voffB);
        PG8_WAIT_V(6); PG8_BAR;
    } else {
        PG8_STAGE(PG8_SB(0, 0), cB, voffB); PG8_STAGE(PG8_SA(0, 0), cA, voffA); PG8_STAGE(PG8_SB(0, 1), cB + hstep, voffB); PG8_STAGE(PG8_SA(0, 1), cA + hstep, voffA);
        if (wr == 1) PG8_BAR;
        PG8_WAIT_V(4); PG8_BAR;
        PG8_STAGE(PG8_SB(1, 0), cB + kstep, voffB); PG8_STAGE(PG8_SA(1, 0), cA + kstep, voffA); PG8_STAGE(PG8_SB(1, 1), cB + hstep + kstep, voffB);
        PG8_WAIT_V(6); PG8_BAR;
    }
    for (;;) {
        const bool has_next = S.next(ui + 1, nxt);
        const char* nA = has_next ? PG8_ABASE(nxt) : cA; const char* nB = has_next ? (const char*)g.Bt + (size_t)nxt.pn * tstep : cB;
        for (int t = 0; t < nt; t += 2) {
            const bool last = (t == nt - 2);
            const char* a1 = cA + (size_t)(t + 1) * kstep;
            const char* a2 = last ? nA : cA + (size_t)(t + 2) * kstep; const char* b2 = last ? nB : cB + (size_t)(t + 2) * kstep;
            const char* a3 = a2 + kstep; const char* b3 = b2 + kstep;
            if constexpr (SP2) {
            PG8_LDB(B0, 0, 0); PG8_LDB(B1, 0, 1); PG8_SCHED; PG8_LDA(At, 0, 0); PG8_STAGE(PG8_SA(1, 1), a1 + hstep, voffA);
            PG8_WAIT_V(8); PG8_WAIT_L(0); PG8_BAR; PG8_MMA(0, 0, At, B0); PG8_MMA(0, 1, At, B1); PG8_BAR; PG8_SCHED;
            PG8_LDA(At, 0, 1); PG8_STAGE(PG8_SB(0, 0), b2, voffB); PG8_STAGE(PG8_SB(0, 1), b2 + hstep, voffB); PG8_STAGE(PG8_SA(0, 0), a2, voffA);
            PG8_WAIT_V(8); PG8_WAIT_L(0); PG8_BAR; PG8_MMA(1, 0, At, B0); PG8_MMA(1, 1, At, B1); PG8_BAR; PG8_SCHED;
            PG8_LDB(B0, 1, 0); PG8_LDB(B1, 1, 1); PG8_SCHED; PG8_LDA(At, 1, 0); PG8_STAGE(PG8_SA(0, 1), a2 + hstep, voffA);
            PG8_WAIT_V(8); PG8_WAIT_L(0); PG8_BAR; PG8_MMA(0, 0, At, B0); PG8_MMA(0, 1, At, B1); PG8_BAR; PG8_SCHED;
            PG8_LDA(At, 1, 1); PG8_STAGE(PG8_SB(1, 0), b3, voffB); PG8_STAGE(PG8_SB(1, 1), b3 + hstep, voffB); PG8_STAGE(PG8_SA(1, 0), a3, voffA);
            PG8_WAIT_V(8); PG8_WAIT_L(0); PG8_BAR; PG8_MMA(1, 0, At, B0); PG8_MMA(1, 1, At, B1); PG8_BAR; PG8_SCHED;
            } else {
            PG8_LDB(B0, 0, 0); PG8_SCHED; PG8_LDA(At, 0, 0); PG8_STAGE(PG8_SA(1, 1), a1 + hstep, voffA);
            PG8_WAIT_L(8); PG8_BAR; PG8_WAIT_L(0); PG8_MMA(0, 0, At, B0); PG8_BAR; PG8_SCHED;
            PG8_LDB(B1, 0, 1); PG8_STAGE(PG8_SB(0, 0), b2, voffB);
            PG8_BAR; PG8_WAIT_L(0); PG8_MMA(0, 1, At, B1); PG8_BAR;
            PG8_LDA(At, 0, 1); PG8_STAGE(PG8_SA(0, 0), a2, voffA);
            PG8_BAR; PG8_WAIT_L(0); PG8_MMA(1, 0, At, B0); PG8_BAR; PG8_SCHED;
            PG8_STAGE(PG8_SB(0, 1), b2 + hstep, voffB);
            PG8_WAIT_V(6); PG8_BAR; PG8_MMA(1, 1, At, B1); PG8_BAR;
            PG8_LDB(B0, 1, 0); PG8_SCHED; PG8_LDA(At, 1, 0); PG8_STAGE(PG8_SA(0, 1), a2 + hstep, voffA);
            PG8_WAIT_L(8); PG8_BAR; PG8_WAIT_L(0); PG8_MMA(0, 0, At, B0); PG8_BAR; PG8_SCHED;
            PG8_LDB(B1, 1, 1); PG8_STAGE(PG8_SB(1, 0), b3, voffB);
            PG8_BAR; PG8_WAIT_L(0); PG8_MMA(0, 1, At, B1); PG8_BAR;
            PG8_LDA(At, 1, 1); PG8_STAGE(PG8_SA(1, 0), a3, voffA);
            PG8_BAR; PG8_WAIT_L(0); PG8_MMA(1, 0, At, B0); PG8_BAR; PG8_SCHED;
            PG8_STAGE(PG8_SB(1, 1), b3 + hstep, voffB);
            PG8_WAIT_V(6); PG8_BAR; PG8_MMA(1, 1, At, B1); PG8_BAR;
            }
        }
        if constexpr (ALIGN_EPI) { if (wr == 0) PG8_BAR; }
        E(acc, cur, wr, wc, fr, fq);
        if (!has_next) break;
#pragma unroll
        for (int a = 0; a < 2; ++a)
#pragma unroll
            for (int b = 0; b < 2; ++b)
#pragma unroll
                for (int m = 0; m < 4; ++m)
#pragma unroll
                    for (int n = 0; n < 2; ++n) acc[a][b][m][n] = (f32x4){0.f, 0.f, 0.f, 0.f};
        cur = nxt; cA = nA; cB = nB; ++ui;
        if constexpr (ALIGN_EPI) { if (wr == 1) PG8_BAR; }
    }
    PG8_WAIT_V(0);
    if constexpr (!ALIGN_EPI) { if (wr == 0) PG8_BAR; }
    PG8_BAR;
#undef PG8_SA
#undef PG8_SB
#undef PG8_STAGE
#undef PG8_LDA
#undef PG8_LDB
#undef PG8_MMA
#undef PG8_WAIT_V
#undef PG8_WAIT_L
#undef PG8_BAR
#undef PG8_SCHED
#undef PG8_ABASE
}

struct EpiSwiGLU {
    static constexpr bool PERM = true;
    bf16_t* O;
    __device__ __forceinline__ void operator()(const f32x4 (&acc)[2][2][4][2], const Unit& u, int wr, int wc, int fr, int fq) const {
        const int row0 = u.pm * BM + wr * 64 + fr, col0 = u.pn * HALF + wc * 32 + 8 * fq;
#pragma unroll
        for (int ai = 0; ai < 2; ++ai)
#pragma unroll
            for (int m = 0; m < 4; ++m) {
                bf16_t* rowp = O + (size_t)(row0 + ai * HALF + m * 16) * DFF + col0;
                float o[8];
#pragma unroll
                for (int n = 0; n < 2; ++n)
#pragma unroll
                    for (int j = 0; j < 4; ++j) { const float a = acc[ai][0][m][n][j], b = acc[ai][1][m][n][j]; o[n * 4 + j] = a / (1.0f + __expf(-a)) * b; }
                u32x4 w; w.x = cvt_pk_bf16(o[0], o[1]); w.y = cvt_pk_bf16(o[2], o[3]); w.z = cvt_pk_bf16(o[4], o[5]); w.w = cvt_pk_bf16(o[6], o[7]);
                *(u32x4*)rowp = w;
            }
    }
};
template <bool HALFGATE> struct EpiResid {
    static constexpr bool PERM = false;
    float* X; const float* gate_lat; const float* gate_ctx; float* out;
    __device__ __forceinline__ void operator()(const f32x4 (&acc)[2][2][4][2], const Unit& u, int wr, int wc, int fr, int fq) const {
        const int row0 = u.pm * BM + wr * 64 + fr, col0 = u.pn * BM + wc * 32 + 4 * fq;
        const float* gp = (u.pm * BM >= SEQ) ? gate_ctx : gate_lat;
        f32x4 gv[2][2];
#pragma unroll
        for (int bj = 0; bj < 2; ++bj)
#pragma unroll
            for (int n = 0; n < 2; ++n) gv[bj][n] = *(const f32x4*)(gp + col0 + bj * HALF + n * 16) * (HALFGATE ? 0.5f : 1.0f);
#pragma unroll
        for (int ai = 0; ai < 2; ++ai)
#pragma unroll
            for (int m = 0; m < 4; ++m) {
                const int row = row0 + ai * HALF + m * 16;
                float* rowp = X + (size_t)row * D + col0;
#pragma unroll
                for (int bj = 0; bj < 2; ++bj)
#pragma unroll
                    for (int n = 0; n < 2; ++n) {
                        f32x4 v = *(const f32x4*)(rowp + bj * HALF + n * 16) + gv[bj][n] * acc[ai][bj][m][n];
                        *(f32x4*)(rowp + bj * HALF + n * 16) = v;
                        if (out != nullptr && row < SEQ) *(f32x4*)(out + (size_t)row * D + col0 + bj * HALF + n * 16) = v;
                    }
            }
    }
};
struct EpiWin {
    static constexpr bool PERM = true;
    float* P32; bf16_t* PA; bf16_t* GL;
    __device__ __forceinline__ void operator()(const f32x4 (&acc)[2][2][4][2], const Unit& u, int wr, int wc, int fr, int fq) const {
        const int row0 = u.pm * BM + wr * 64 + fr, cin = wc * 32 + 8 * fq;
        if (u.pn < 19) {
#pragma unroll
            for (int ai = 0; ai < 2; ++ai)
#pragma unroll
                for (int m = 0; m < 4; ++m) { float* rowp = P32 + (size_t)(row0 + ai * HALF + m * 16) * P32W + u.pn * BM + cin;
#pragma unroll
                    for (int bj = 0; bj < 2; ++bj) { *(f32x4*)(rowp + bj * HALF) = acc[ai][bj][m][0]; *(f32x4*)(rowp + bj * HALF + 4) = acc[ai][bj][m][1]; } }
        } else {
            bf16_t* base; int ld, colt;
            if (u.pn < 28) { base = PA; ld = PAW; colt = (u.pn - 19) * BM; } else { base = GL; ld = GLW; colt = (u.pn - 28) * BM; }
#pragma unroll
            for (int ai = 0; ai < 2; ++ai)
#pragma unroll
                for (int m = 0; m < 4; ++m) { bf16_t* rowp = base + (size_t)(row0 + ai * HALF + m * 16) * ld + colt + cin;
#pragma unroll
                    for (int bj = 0; bj < 2; ++bj) { const f32x4 v0 = acc[ai][bj][m][0], v1 = acc[ai][bj][m][1];
                        u32x4 w; w.x = cvt_pk_bf16(v0[0], v0[1]); w.y = cvt_pk_bf16(v0[2], v0[3]); w.z = cvt_pk_bf16(v1[0], v1[1]); w.w = cvt_pk_bf16(v1[2], v1[3]);
                        *(u32x4*)(rowp + bj * HALF) = w; } }
        }
    }
};
struct EpiMerge {
    static constexpr bool PERM = true;
    const bf16_t* GL; bf16_t* PROJ;
    __device__ __forceinline__ void operator()(const f32x4 (&acc)[2][2][4][2], const Unit& u, int wr, int wc, int fr, int fq) const {
        const int row0 = u.pm * BM + wr * 64 + fr, col0 = u.pn * BM + wc * 32 + 8 * fq;
#pragma unroll
        for (int ai = 0; ai < 2; ++ai)
#pragma unroll
            for (int m = 0; m < 4; ++m) { const size_t ro = (size_t)(row0 + ai * HALF + m * 16) * GLW + col0;
#pragma unroll
                for (int bj = 0; bj < 2; ++bj) {
                    const u32x4 gw = *(const u32x4*)(GL + ro + bj * HALF);
                    const f32x4 v0 = acc[ai][bj][m][0], v1 = acc[ai][bj][m][1];
                    float o[8];
                    o[0] = v0[0] / (1.0f + __expf(-bf2f(gw.x & 0xffffu))); o[1] = v0[1] / (1.0f + __expf(-bf2f(gw.x >> 16)));
                    o[2] = v0[2] / (1.0f + __expf(-bf2f(gw.y & 0xffffu))); o[3] = v0[3] / (1.0f + __expf(-bf2f(gw.y >> 16)));
                    o[4] = v1[0] / (1.0f + __expf(-bf2f(gw.z & 0xffffu))); o[5] = v1[1] / (1.0f + __expf(-bf2f(gw.z >> 16)));
                    o[6] = v1[2] / (1.0f + __expf(-bf2f(gw.w & 0xffffu))); o[7] = v1[3] / (1.0f + __expf(-bf2f(gw.w >> 16)));
                    u32x4 w; w.x = cvt_pk_bf16(o[0], o[1]); w.y = cvt_pk_bf16(o[2], o[3]); w.z = cvt_pk_bf16(o[4], o[5]); w.w = cvt_pk_bf16(o[6], o[7]);
                    *(u32x4*)(PROJ + ro + bj * HALF) = w; } }
    }
};
}

enum { I_X = 0, I_C, I_CTX, I_CCTX, I_ADAW, I_ADAB, I_NF1, I_NMIX, I_NF2, I_F1WI, I_F1WO, I_F2WI, I_F2WO, I_WIN, I_HGLB, I_HGNORM, I_RWSHIFT, I_RWW0, I_RWW2, I_RWA0, I_RWA2,
       I_RWKK, I_RWKA, I_RWRK, I_RWLNW, I_RWLNB, I_NAQN, I_NAKN, I_NARPB, I_WAQN, I_WAKN, I_WASINK, I_WBR, I_WOUT, N_IN };
struct Args { const float* in[N_IN]; float* out; unsigned char* ws; int ph_lo, ph_hi; };
struct Ctx {
    LAS unsigned char* lds;
    int tid, lane, wave, bid, G;
    const Args __attribute__((address_space(4)))* ka; float* out; unsigned char* ws;
};
#define WSP(T, off) ((T*)(C.ws + (off)))
__device__ __forceinline__ void relaunder(Ctx& C) {
    int t = C.tid, b = C.bid, g = C.G;
    asm volatile("" : "+v"(t), "+v"(b), "+v"(g));
    C.tid = t; C.lane = t & 63; C.wave = __builtin_amdgcn_readfirstlane(t >> 6); C.bid = __builtin_amdgcn_readfirstlane(b); C.G = __builtin_amdgcn_readfirstlane(g);
}

__device__ __forceinline__ void transpose_item(const float* W, int K, int N, bf16_t* WT, int mode, LAS float* scr, int item, int lane) {
    const int nblk = N / 32, kb = item / nblk, nb = item % nblk, k0 = 64 * kb, n0 = 32 * nb;
    int drow0 = n0;
    if (mode == 1) { const int half = n0 / DFF, j0 = n0 % DFF; drow0 = 256 * (j0 / 128) + 128 * half + (j0 % 128); }
#pragma unroll 8
    for (int i = 0; i < 32; ++i) { const int kk = 2 * i + (lane >> 5); scr[kk * 33 + (lane & 31)] = W[(size_t)(k0 + kk) * N + n0 + (lane & 31)]; }
    LDS_WAIT(); asm volatile("" ::: "memory");
    const int c = lane & 7;
#pragma unroll
    for (int j = 0; j < 4; ++j) { const int n = (lane >> 3) + 8 * j; const LAS float* s = scr + (8 * c) * 33 + n;
        u32x4 o; o.x = pk2(s[0 * 33], s[1 * 33]); o.y = pk2(s[2 * 33], s[3 * 33]); o.z = pk2(s[4 * 33], s[5 * 33]); o.w = pk2(s[6 * 33], s[7 * 33]);
        *(u32x4*)(WT + (size_t)(drow0 + n) * K + k0 + 8 * c) = o; }
    LDS_WAIT(); asm volatile("" ::: "memory");
}
__device__ __forceinline__ void phase_convert(Ctx& C, int l) {
    LAS float* scr = (LAS float*)(C.lds + C.wave * 16384);
    const int gw = C.bid * NWAVES + C.wave, NGW = C.G * NWAVES;
    constexpr int I_WI = (D / 64) * (2 * DFF / 32), I_WO = (DFF / 64) * (D / 32), I_IN = (D / 64) * (PTOT / 32), I_BR = (512 / 64) * (D / 32), I_OUT = (D / 64) * (D / 32);
    constexpr int NITEMS = 2 * I_WI + 2 * I_WO + I_IN + 4 * I_BR + I_OUT;
    for (int it = gw; it < NITEMS; it += NGW) {
        int r = it;
        if (r < I_WI) { transpose_item(C.ka->in[I_F1WI] + (size_t)l * D * 2 * DFF, D, 2 * DFF, WSP(bf16_t, OFF_WI1), 1, scr, r, C.lane); continue; } r -= I_WI;
        if (r < I_WI) { transpose_item(C.ka->in[I_F2WI] + (size_t)l * D * 2 * DFF, D, 2 * DFF, WSP(bf16_t, OFF_WI2), 1, scr, r, C.lane); continue; } r -= I_WI;
        if (r < I_WO) { transpose_item(C.ka->in[I_F1WO] + (size_t)l * DFF * D, DFF, D, WSP(bf16_t, OFF_WO1), 0, scr, r, C.lane); continue; } r -= I_WO;
        if (r < I_WO) { transpose_item(C.ka->in[I_F2WO] + (size_t)l * DFF * D, DFF, D, WSP(bf16_t, OFF_WO2), 0, scr, r, C.lane); continue; } r -= I_WO;
        if (r < I_IN) { transpose_item(C.ka->in[I_WIN] + (size_t)l * D * PTOT, D, PTOT, WSP(bf16_t, OFF_WIN), 0, scr, r, C.lane); continue; } r -= I_IN;
        if (r < 4 * I_BR) { const int g = r / I_BR; transpose_item(C.ka->in[I_WBR] + ((size_t)l * 4 + g) * 512 * D, 512, D, WSP(bf16_t, OFF_WBR) + (size_t)g * D * 512, 0, scr, r % I_BR, C.lane); continue; } r -= 4 * I_BR;
        transpose_item(C.ka->in[I_WOUT] + (size_t)l * D * D, D, D, WSP(bf16_t, OFF_WOUT), 0, scr, r, C.lane);
    }
}

__device__ __forceinline__ void phase_ada_partial(Ctx& C) {
    float* modp = WSP(float, OFF_MODP);
    for (int u = C.bid; u < DEPTH * 9 * KSPLIT; u += C.G) {
        const int l = u / (9 * KSPLIT), rem = u % (9 * KSPLIT), cg = rem / KSPLIT, ks = rem % KSPLIT;
        const int col = cg * 2048 + C.tid * 4;
        const float* W = C.ka->in[I_ADAW] + (size_t)l * D * MODW;
        f32x4 a0 = {0.f, 0.f, 0.f, 0.f}, a1 = {0.f, 0.f, 0.f, 0.f};
        for (int i = ks * 64; i < ks * 64 + 64; ++i) {
            const float c0 = C.ka->in[I_C][i], c1 = C.ka->in[I_CCTX][i];
            const float s0 = siluf_(c0), s1 = siluf_(c1);
            const f32x4 w = *(const f32x4*)(W + (size_t)i * MODW + col);
            a0 += w * s0; a1 += w * s1;
        }
        *(f32x4*)(modp + ((size_t)(l * KSPLIT + ks) * 2 + 0) * MODW + col) = a0;
        *(f32x4*)(modp + ((size_t)(l * KSPLIT + ks) * 2 + 1) * MODW + col) = a1;
    }
    f32x4* X = WSP(f32x4, OFF_X);
    const f32x4* xs = (const f32x4*)C.ka->in[I_X]; const f32x4* cs = (const f32x4*)C.ka->in[I_CTX];
    const size_t n_lat = (size_t)SEQ * D / 4, n_all = (size_t)MT * D / 4;
    for (size_t i = (size_t)C.bid * NT + C.tid; i < n_all; i += (size_t)C.G * NT) X[i] = i < n_lat ? xs[i] : cs[i - n_lat];
}
__device__ __forceinline__ void phase_ada_reduce(Ctx& C) {
    const float* modp = WSP(float, OFF_MODP); float* mod = WSP(float, OFF_MOD);
    for (int e = C.bid * NT + C.tid; e < DEPTH * 2 * MODW; e += C.G * NT) {
        const int l = e / (2 * MODW), s = (e / MODW) % 2, j = e % MODW;
        float a = C.ka->in[I_ADAB][(size_t)l * MODW + j];
        for (int ks = 0; ks < KSPLIT; ++ks) a += modp[((size_t)(l * KSPLIT + ks) * 2 + s) * MODW + j];
        mod[e] = a;
    }
}
__device__ __forceinline__ const float* mod_ptr(Ctx& C, int l, int s, int idx) { return WSP(float, OFF_MOD) + ((size_t)(l * 2 + s) * NMOD + idx) * D; }

__device__ __forceinline__ void phase_norm(Ctx& C, int l, const float* gw  , int shift_idx) {
    const int gwv = C.bid * NWAVES + C.wave, NGW = C.G * NWAVES;
    const float* X = WSP(float, OFF_X); bf16_t* H = WSP(bf16_t, OFF_H);
    for (int r = gwv; r < MT; r += NGW) {
        const int s = r >= SEQ ? 1 : 0;
        const float* sh = mod_ptr(C, l, s, shift_idx); const float* sc = mod_ptr(C, l, s, shift_idx + 1);
        const f32x4* xr = (const f32x4*)(X + (size_t)r * D) + C.lane;
        f32x4 v[8]; float ss = 0.f;
#pragma unroll
        for (int j = 0; j < 8; ++j) { v[j] = xr[64 * j]; ss += (v[j].x * v[j].x + v[j].y * v[j].y) + (v[j].z * v[j].z + v[j].w * v[j].w); }
        const float rstd = rsqrtf(wave_sum(ss) * (1.0f / D) + EPS);
        u32x2* o8 = (u32x2*)(H + (size_t)r * D) + C.lane;
#pragma unroll
        for (int j = 0; j < 8; ++j) {
            const int c = (64 * j + C.lane) * 4;
            const f32x4 g4 = *(const f32x4*)(gw + c), s4 = *(const f32x4*)(sc + c), h4 = *(const f32x4*)(sh + c);
            const f32x4 y = (v[j] * rstd) * g4 * (s4 + 1.0f) + h4;
            u32x2 w; w.x = pk2(y.x, y.y); w.y = pk2(y.z, y.w); o8[64 * j] = w;
        }
    }
}

__device__ __forceinline__ void phase_rw_prep(Ctx& C, int l, int b0, int nb) {
    const float* P = WSP(float, OFF_P32); float* SCN = WSP(float, OFF_SCN); float* VV = WSP(float, OFF_VV); float* GS = WSP(float, OFF_GS);
    LAS float* lin = (LAS float*)C.lds;
    const float* taps = C.ka->in[I_RWSHIFT] + (size_t)l * 3 * RWC;
    const int c = C.tid, h = c >> 6, e = c & 63;
    const float kkw = C.ka->in[I_RWKK][l * 512 + c], kaw = C.ka->in[I_RWKA][l * 512 + c];
    for (int r = b0; r < MT; r += nb) {
        const bool hp = (r != 0 && r != SEQ), hn = (r != SEQ - 1 && r != MT - 1);
        const float* p0 = P + (size_t)r * P32W + RW_OFF;
        float xs[5];
#pragma unroll
        for (int q = 0; q < 5; ++q) {
            const int col = q * 512 + c;
            float v = 0.f;
            if (q < 4 || c < 256) {
                v = taps[RWC + col] * p0[col];
                if (hp) v += taps[col] * p0[col - P32W];
                if (hn) v += taps[2 * RWC + col] * p0[col + P32W];
            }
            xs[q] = v;
        }
        __syncthreads();
        if (c < 256) lin[c] = c < 128 ? tanhf(xs[4]) : xs[4];
        __syncthreads();
        const float rr = xs[0], kk_raw = xs[1], vv = xs[2], gg = xs[3];
        const float kk0 = kk_raw * kkw;
        const float kkn = kk0 * rsqrtf(wave_sum(kk0 * kk0) + EPS);
        VV[(size_t)r * 512 + c] = vv; GS[(size_t)r * 512 + c] = sigmoidf_(gg);
#pragma unroll
        for (int d = 0; d < 2; ++d) {
            const float* w2 = C.ka->in[I_RWW2] + ((size_t)(l * 2 + d) * 64) * 512 + c;
            const float* a2 = C.ka->in[I_RWA2] + ((size_t)(l * 2 + d) * 64) * 512 + c;
            float z = C.ka->in[I_RWW0][(l * 2 + d) * 512 + c], az = C.ka->in[I_RWA0][(l * 2 + d) * 512 + c];
#pragma unroll 8
            for (int j = 0; j < 64; ++j) { z += lin[d * 64 + j] * w2[(size_t)j * 512]; az += lin[128 + d * 64 + j] * a2[(size_t)j * 512]; }
            const float y = -z; const float sp = fmaxf(y, 0.f) + log1pf(expf(-fabsf(y)));
            const float lw = -sp - 0.5f;
            const float decay = expf(-expf(lw));
            const float a = sigmoidf_(az);
            const float kd = kk_raw * (1.0f + (a - 1.0f) * kaw);
            float* o = SCN + ((size_t)((d * 8 + h) * MT + row_seq(d, r))) * 320 + e;
            o[0] = decay; o[64] = kkn; o[128] = a * kkn; o[192] = kd; o[256] = rr;
        }
    }
}

__device__ __forceinline__ void phase_attn_prep(Ctx& C, int l, int w0, int nw) {
    bf16_t* PA = WSP(bf16_t, OFF_PA);
    const int e = C.lane;
    const float na_qn = C.ka->in[I_NAQN][l * 64 + e], na_kn = C.ka->in[I_NAKN][l * 64 + e], wa_qn = C.ka->in[I_WAQN][l * 64 + e], wa_kn = C.ka->in[I_WAKN][l * 64 + e];
    const int m16 = e & 15;
    const float inv = powf(10000.0f, -(float)m16 / 16.0f);
    for (long uidx = w0; uidx < (long)MT * 26; uidx += nw) {
        const int r = (int)(uidx / 26), v = (int)(uidx % 26);
        int col; float nwt, scl; bool rope;
        if (v < 8) { col = v * 64; nwt = na_qn; scl = 0.125f; rope = false; }
        else if (v < 16) { col = 512 + (v - 8) * 64; nwt = na_kn; scl = 1.0f; rope = false; }
        else if (v < 24) { col = 1536 + (v - 16) * 64; nwt = wa_qn; scl = 0.125f; rope = true; }
        else { col = 2048 + (v - 24) * 64; nwt = wa_kn; scl = 1.0f; rope = true; }
        bf16_t* p = PA + (size_t)r * PAW + col + e;
        const float x = bf2f(*p);
        const float ss = wave_sum(x * x);
        float y = x * rsqrtf(ss * (1.0f / 64.0f) + EPS) * nwt * scl;
        if (rope && r < SEQ) {
            const int pos = (e >> 5) ? (r & 63) : (r >> 6);
            const float ang = (float)pos * inv;
            float sn, cs; sincosf(ang, &sn, &cs);
            const bool lo = (e & 31) < 16;
            const float yp = __shfl(y, lo ? e + 16 : e - 16);
            y = lo ? (y * cs - yp * sn) : (yp * sn + y * cs);
        }
        *p = (bf16_t)f2bf(y);
    }
}

__device__ __forceinline__ float hg_lb(Ctx& C, int l, int d, int c) {
    if (l == 0) return 0.f;
    const float a0 = C.ka->in[I_HGLB][(size_t)(d * DEPTH + 0) * 512 + c], a1 = C.ka->in[I_HGLB][(size_t)(d * DEPTH + 1) * 512 + c];
    const float m = fmaxf(a0, a1); const float e0 = expf(a0 - m), e1 = expf(a1 - m);
    return e1 / (e0 + e1);
}
__device__ __forceinline__ void phase_hg_A(Ctx& C, int l, int b0, int nb) {
    const float* P = WSP(float, OFF_P32); float* HGL = WSP(float, OFF_HGL); float* HGD = WSP(float, OFF_HGD);
    LAS float* Ii = (LAS float*)C.lds;
    LAS float* LF = Ii + 64 * 128;
    LAS float* KD = LF + 64 * 128;
    const int k = C.tid & 127, vq = C.tid >> 7;
    for (int u = b0; u < 2 * 4 * NCH; u += nb) {
        const int d = u / (4 * NCH), h = (u / NCH) % 4, c = u % NCH;
        const float lb = hg_lb(C, l, d, h * 128 + k);
        __syncthreads();
#pragma unroll 4
        for (int i = 0; i < 16; ++i) {
            const int s = 16 * vq + i; const int row = seq_row(d, 64 * c + s);
            const float* pr = P + (size_t)row * P32W;
            Ii[s * 128 + k] = pr[1536 + h * 128 + k];
            const float fr = pr[512 + d * 512 + h * 128 + k];
            const float f = lb + (1.0f - lb) * sigmoidf_(fr);
            LF[s * 128 + k] = logf(f); KD[s * 128 + k] = 1.0f - f;
        }
        __syncthreads();
        float bend = 0.f;
        for (int s = 0; s < 64; ++s) bend += LF[s * 128 + k];
        float acc[32];
#pragma unroll
        for (int j = 0; j < 32; ++j) acc[j] = 0.f;
        float b = 0.f;
        for (int s = 0; s < 64; ++s) {
            b += LF[s * 128 + k];
            const float w = KD[s * 128 + k] * expf(bend - b);
            const LAS f32x4* iv = (const LAS f32x4*)(Ii + s * 128 + 32 * vq);
#pragma unroll
            for (int j = 0; j < 8; ++j) { const f32x4 x = iv[j]; acc[4 * j] += w * x.x; acc[4 * j + 1] += w * x.y; acc[4 * j + 2] += w * x.z; acc[4 * j + 3] += w * x.w; }
        }
        float* o = HGL + ((size_t)((d * 4 + h) * NCH + c) * 128 + k) * 128 + 32 * vq;
#pragma unroll
        for (int j = 0; j < 8; ++j) *(f32x4*)(o + 4 * j) = (f32x4){acc[4 * j], acc[4 * j + 1], acc[4 * j + 2], acc[4 * j + 3]};
        if (vq == 0) HGD[(size_t)((d * 4 + h) * NCH + c) * 128 + k] = expf(bend);
    }
}
__device__ __forceinline__ void phase_hg_B(Ctx& C, int b0, int nb) {
    float* HGL = WSP(float, OFF_HGL); const float* HGD = WSP(float, OFF_HGD);
    for (int e = b0 * NT + C.tid; e < 8 * 16384; e += nb * NT) {
        const int dh = e >> 14, kv = e & 16383, k = kv >> 7;
        float st = 0.f;
        float* p = HGL + (size_t)dh * NCH * 16384 + kv; const float* dp = HGD + (size_t)dh * NCH * 128 + k;
#pragma unroll 4
        for (int c = 0; c < NCH; ++c) { const float Lc = p[(size_t)c * 16384], Dc = dp[c * 128]; p[(size_t)c * 16384] = st; st = Dc * st + Lc; }
    }
}
__device__ __forceinline__ void phase_hg_C(Ctx& C, int l, int b0, int nb) {
    const float* P = WSP(float, OFF_P32); const float* HGL = WSP(float, OFF_HGL); bf16_t* YB = WSP(bf16_t, OFF_YB);
    constexpr int LDP = 132, LDA = 68;
    LAS float* Q = (LAS float*)C.lds;
    LAS float* B = Q + 64 * LDP;
    LAS float* KD = B + 64 * LDP;
    LAS float* ATT = KD + 64 * LDP;
    LAS float* RED = ATT + 64 * LDA;
    const int k = C.tid & 127, tq = C.tid >> 7;
    for (int u = b0; u < 4 * NCH; u += nb) {
        const int h = u / NCH, tc = u % NCH;
        float o[16];
#pragma unroll
        for (int j = 0; j < 16; ++j) o[j] = 0.f;
#pragma unroll 1
        for (int d = 0; d < 2; ++d) {
            const float lb = hg_lb(C, l, d, h * 128 + k);
            const int cd = d == 0 ? (tc + 4) % NCH : (NCH - 1 - tc);
            __syncthreads();
#pragma unroll 4
            for (int i = 0; i < 16; ++i) {
                const int rl = 16 * tq + i; const float* pr = P + (size_t)(64 * tc + rl) * P32W;
                Q[rl * LDP + k] = pr[h * 128 + k];
                const float fr = pr[512 + d * 512 + h * 128 + k];
                const float f = lb + (1.0f - lb) * sigmoidf_(fr);
                B[rl * LDP + k] = logf(f); KD[rl * LDP + k] = 1.0f - f;
            }
            __syncthreads();
            if (C.tid < 128) {
                float b = 0.f;
                if (d == 0) { for (int rl = 0; rl < 64; ++rl) { b += B[rl * LDP + k]; B[rl * LDP + k] = b; } }
                else { for (int rl = 63; rl >= 0; --rl) { b += B[rl * LDP + k]; B[rl * LDP + k] = b; } }
            }
            __syncthreads();
            {
                const int t = C.tid >> 3, sg = C.tid & 7;
                float a[8];
#pragma unroll
                for (int i = 0; i < 8; ++i) a[i] = 0.f;
                for (int kk = 0; kk < 128; kk += 4) {
                    const f32x4 qt = *(const LAS f32x4*)(Q + t * LDP + kk), bt = *(const LAS f32x4*)(B + t * LDP + kk);
#pragma unroll
                    for (int i = 0; i < 8; ++i) {
                        const int s = sg + 8 * i;
                        const f32x4 ks = *(const LAS f32x4*)(KD + s * LDP + kk), bs = *(const LAS f32x4*)(B + s * LDP + kk);
                        a[i] += qt.x * ks.x * __expf(fminf(bt.x - bs.x, 0.f)) + qt.y * ks.y * __expf(fminf(bt.y - bs.y, 0.f))
                              + qt.z * ks.z * __expf(fminf(bt.z - bs.z, 0.f)) + qt.w * ks.w * __expf(fminf(bt.w - bs.w, 0.f));
                    }
                }
#pragma unroll
                for (int i = 0; i < 8; ++i) { const int s = sg + 8 * i; const bool valid = d == 0 ? (s <= t) : (s >= t); ATT[t * LDA + s] = valid ? a[i] : 0.f; }
            }
            __syncthreads();
            LAS float* Iv = KD;
#pragma unroll 4
            for (int i = 0; i < 16; ++i) {
                const int rl = 16 * tq + i;
                Iv[rl * 128 + k] = P[(size_t)(64 * tc + rl) * P32W + 1536 + h * 128 + k];
                Q[rl * LDP + k] = Q[rl * LDP + k] * __expf(B[rl * LDP + k]);
            }
            __syncthreads();
            for (int s = 0; s < 64; s += 4) {
                const float i0 = Iv[(s + 0) * 128 + k], i1 = Iv[(s + 1) * 128 + k], i2 = Iv[(s + 2) * 128 + k], i3 = Iv[(s + 3) * 128 + k];
#pragma unroll
                for (int j = 0; j < 16; ++j) { const f32x4 a4 = *(const LAS f32x4*)(ATT + (16 * tq + j) * LDA + s); o[j] += a4.x * i0 + a4.y * i1 + a4.z * i2 + a4.w * i3; }
            }
            const float* Sp = HGL + (size_t)((d * 4 + h) * NCH + cd) * 16384 + k;
            for (int kk = 0; kk < 128; kk += 4) {
                const float s0 = Sp[(size_t)(kk + 0) * 128], s1 = Sp[(size_t)(kk + 1) * 128], s2 = Sp[(size_t)(kk + 2) * 128], s3 = Sp[(size_t)(kk + 3) * 128];
#pragma unroll
                for (int j = 0; j < 16; ++j) { const f32x4 q4 = *(const LAS f32x4*)(Q + (16 * tq + j) * LDP + kk); o[j] += q4.x * s0 + q4.y * s1 + q4.z * s2 + q4.w * s3; }
            }
        }
        __syncthreads();
#pragma unroll
        for (int j = 0; j < 16; ++j) { const float ss = wave_sum(o[j] * o[j]); if (C.lane == 0) RED[C.wave * 16 + j] = ss; }
        __syncthreads();
        const float nw = C.ka->in[I_HGNORM][l * 512 + h * 128 + k];
#pragma unroll
        for (int j = 0; j < 16; ++j) {
            const int row = 64 * tc + 16 * tq + j;
            const float tot = RED[(2 * tq) * 16 + j] + RED[(2 * tq + 1) * 16 + j];
            const float g = P[(size_t)row * P32W + 2048 + h * 128 + k];
            const float y = o[j] * rsqrtf(tot * (1.0f / 128.0f) + EPS) * nw * siluf_(g);
            YB[(size_t)row * 512 + h * 128 + k] = (bf16_t)f2bf(y);
        }
    }
}

__device__ __forceinline__ void phase_rw_scan(Ctx& C, int b0, int nb) {
    const float* SCN = WSP(float, OFF_SCN); const float* VV = WSP(float, OFF_VV); float* RO = WSP(float, OFF_RO);
    constexpr int STEPS = 32, SW = 384;
    LAS float* buf = (LAS float*)C.lds;
    for (int job = b0; job < 128; job += nb) {
        const int d = job >> 6, h = (job >> 3) & 7, rg = job & 7;
        const float* src = SCN + (size_t)((d * 8 + h) * MT) * 320;
        f32x4 regs[6];
#define load_chunk(ci) do { _Pragma("unroll") for (int i = 0; i < 6; ++i) { \
                const int q = C.tid + NT * i, st = q / 96, w = q % 96, j = STEPS * (ci) + st; \
                regs[i] = w < 80 ? *(const f32x4*)(src + (size_t)j * 320 + w * 4) : *(const f32x4*)(VV + (size_t)seq_row(d, j) * 512 + h * 64 + (w - 80) * 4); } } while (0)
#define store_chunk(bi) do { _Pragma("unroll") for (int i = 0; i < 6; ++i) { const int q = C.tid + NT * i; *(LAS f32x4*)(buf + (bi) * STEPS * SW + q * 4) = regs[i]; } } while (0)
        __syncthreads();
        load_chunk(0); store_chunk(0);
        __syncthreads();
        float S[8];
#pragma unroll
        for (int i = 0; i < 8; ++i) S[i] = 0.f;
        const int rr = C.lane >> 3, ks = C.lane & 7;
        constexpr int NCHK = MT / STEPS;
        for (int ci = 0; ci < NCHK; ++ci) {
            if (ci + 1 < NCHK) load_chunk(ci + 1);
            if (C.wave == 0) {
                const LAS float* bb = buf + (ci & 1) * STEPS * SW;
                for (int st = 0; st < STEPS; ++st) {
                    const LAS float* sp = bb + st * SW + 8 * ks;
                    const f32x4 w0 = *(const LAS f32x4*)(sp), w1 = *(const LAS f32x4*)(sp + 4);
                    const f32x4 k0 = *(const LAS f32x4*)(sp + 64), k1 = *(const LAS f32x4*)(sp + 68);
                    const f32x4 a0 = *(const LAS f32x4*)(sp + 128), a1 = *(const LAS f32x4*)(sp + 132);
                    const f32x4 d0 = *(const LAS f32x4*)(sp + 192), d1 = *(const LAS f32x4*)(sp + 196);
                    const f32x4 r0 = *(const LAS f32x4*)(sp + 256), r1 = *(const LAS f32x4*)(sp + 260);
                    const float vv = bb[st * SW + 320 + rg * 8 + rr];
                    float dot = (S[0] * k0.x + S[1] * k0.y) + (S[2] * k0.z + S[3] * k0.w) + (S[4] * k1.x + S[5] * k1.y) + (S[6] * k1.z + S[7] * k1.w);
                    dot += __shfl_xor(dot, 1); dot += __shfl_xor(dot, 2); dot += __shfl_xor(dot, 4);
                    S[0] = S[0] * w0.x - dot * a0.x + vv * d0.x; S[1] = S[1] * w0.y - dot * a0.y + vv * d0.y;
                    S[2] = S[2] * w0.z - dot * a0.z + vv * d0.z; S[3] = S[3] * w0.w - dot * a0.w + vv * d0.w;
                    S[4] = S[4] * w1.x - dot * a1.x + vv * d1.x; S[5] = S[5] * w1.y - dot * a1.y + vv * d1.y;
                    S[6] = S[6] * w1.z - dot * a1.z + vv * d1.z; S[7] = S[7] * w1.w - dot * a1.w + vv * d1.w;
                    float od = (S[0] * r0.x + S[1] * r0.y) + (S[2] * r0.z + S[3] * r0.w) + (S[4] * r1.x + S[5] * r1.y) + (S[6] * r1.z + S[7] * r1.w);
                    od += __shfl_xor(od, 1); od += __shfl_xor(od, 2); od += __shfl_xor(od, 4);
                    if (ks == 0) RO[((size_t)d * MT + seq_row(d, STEPS * ci + st)) * 512 + h * 64 + rg * 8 + rr] = od;
                }
            }
            if (ci + 1 < NCHK) store_chunk((ci + 1) & 1);
            __syncthreads();
        }
    }
#undef load_chunk
#undef store_chunk
}
__device__ __forceinline__ void phase_rw_finish(Ctx& C, int l, int w0, int nw) {
    const float* SCN = WSP(float, OFF_SCN); const float* VV = WSP(float, OFF_VV); const float* GS = WSP(float, OFF_GS); const float* RO = WSP(float, OFF_RO);
    bf16_t* YB = WSP(bf16_t, OFF_YB) + (size_t)1 * MT * 512;
    const int e = C.lane;
    for (int uidx = w0; uidx < MT * 8; uidx += nw) {
        const int r = uidx >> 3, h = uidx & 7, c = h * 64 + e;
        const float o = RO[(size_t)r * 512 + c] + RO[((size_t)MT + r) * 512 + c];
        const float mu = wave_sum(o) * (1.0f / 64.0f);
        const float dv = o - mu;
        const float var = wave_sum(dv * dv) * (1.0f / 64.0f);
        const float on = dv * rsqrtf(var + RW_GN_EPS) * C.ka->in[I_RWLNW][l * 512 + c] + C.ka->in[I_RWLNB][l * 512 + c];
        const float* s0 = SCN + ((size_t)((0 * 8 + h) * MT + row_seq(0, r))) * 320 + e;
        const float* s1 = SCN + ((size_t)((1 * 8 + h) * MT + row_seq(1, r))) * 320 + e;
        const float kdsum = s0[192] + s1[192], rr = s0[256];
        const float bonus = wave_sum(rr * kdsum * C.ka->in[I_RWRK][l * 512 + c]);
        const float y = (on + bonus * VV[(size_t)r * 512 + c]) * GS[(size_t)r * 512 + c];
        YB[(size_t)r * 512 + c] = (bf16_t)f2bf(y);
    }
}

typedef float f32x16 __attribute__((ext_vector_type(16)));
typedef float f32x4u __attribute__((ext_vector_type(4), aligned(4)));
#define MFMA32(a, b, c) __builtin_amdgcn_mfma_f32_32x32x16_bf16((a), (b), (c), 0, 0, 0)
__device__ __forceinline__ float swap32_sum(float x) { auto t = __builtin_amdgcn_permlane32_swap(__float_as_uint(x), __float_as_uint(x), false, false); return __uint_as_float(t[0]) + __uint_as_float(t[1]); }
__device__ __forceinline__ f32x16 qk_tile(const bf16_t* Kp  , const bf16x8 (&qf)[4], int r, int h) {
    f32x16 acc;
#pragma unroll
    for (int i = 0; i < 16; ++i) acc[i] = 0.f;
    const bf16_t* p = Kp + (size_t)r * PAW + 8 * h;
#pragma unroll
    for (int s = 0; s < 4; ++s) { const bf16x8 kf = *(const bf16x8*)(p + 16 * s); acc = MFMA32(kf, qf[s], acc); }
    return acc;
}
__device__ __forceinline__ void pv_tile(f32x16 (&o)[2], const bf16_t* VTp  , const f32x16& p, int r, int h) {
#pragma unroll
    for (int s = 0; s < 2; ++s) {
        u32x4 pw; pw.x = pg8::cvt_pk_bf16(p[8 * s + 0], p[8 * s + 1]); pw.y = pg8::cvt_pk_bf16(p[8 * s + 2], p[8 * s + 3]); pw.z = pg8::cvt_pk_bf16(p[8 * s + 4], p[8 * s + 5]); pw.w = pg8::cvt_pk_bf16(p[8 * s + 6], p[8 * s + 7]);
        const bf16x8 pb = __builtin_bit_cast(bf16x8, pw);
#pragma unroll
        for (int blk = 0; blk < 2; ++blk) {
            const bf16_t* vp = VTp + (size_t)(32 * blk + r) * MT + 16 * s + 4 * h;
            const u32x2 lo = *(const u32x2*)vp, hi = *(const u32x2*)(vp + 8);
            u32x4 vw; vw.x = lo.x; vw.y = lo.y; vw.z = hi.x; vw.w = hi.y;
            o[blk] = MFMA32(__builtin_bit_cast(bf16x8, vw), pb, o[blk]);
        }
    }
}
#define KOFF(reg) (((reg) & 3) + 8 * ((reg) >> 2))
__device__ __forceinline__ void phase_attn(Ctx& C, int l, int w0, int nw) {
    const bf16_t* PA = WSP(bf16_t, OFF_PA); bf16_t* YB = WSP(bf16_t, OFF_YB);
    const bf16_t* VTN = WSP(bf16_t, OFF_VTN); const bf16_t* VTW = WSP(bf16_t, OFF_VTW);
    const float* PB = WSP(float, OFF_PB); const float* MREF = WSP(float, OFF_MREF);
    const int r = C.lane & 31, h = C.lane >> 5;
    constexpr int NJT = 2048 + 64;
    for (int job = w0; job < 2 * NJT; job += nw) {
        const int type = __builtin_amdgcn_readfirstlane(job / NJT), jj = __builtin_amdgcn_readfirstlane(job % NJT), qt = jj >> 3, hd = jj & 7;
        const int q0 = qt * 32;
        const bool lat = qt < 256;
        const float Mr = MREF[type];
        bf16x8 qf[4];
        { const bf16_t* qp = PA + (size_t)(q0 + r) * PAW + (type == 0 ? 0 : 1536) + hd * 64 + 8 * h;
#pragma unroll
          for (int s = 0; s < 4; ++s) qf[s] = *(const bf16x8*)(qp + 16 * s); }
        f32x16 o[2];
#pragma unroll
        for (int i = 0; i < 16; ++i) { o[0][i] = 0.f; o[1][i] = 0.f; }
        float lsum = 0.f;
        const int kcol = type == 0 ? 512 + hd * 64 : 2048 + (hd >> 2) * 64;
        const bf16_t* VT = type == 0 ? VTN + (size_t)(hd * 64) * MT : VTW + (size_t)((hd >> 2) * 64) * MT;
        if (type == 0) {
            if (lat) {
                const int i = qt >> 1, j = (qt & 1) * 32 + r;
                int rs = i - 4; rs = rs < 0 ? 0 : (rs > 120 ? 120 : rs);
                int cs = j - 8; cs = cs < 0 ? 0 : (cs > 48 ? 48 : cs);
#pragma unroll 1
                for (int t = 0; t < 16; ++t) {
                    const int a = t >> 1, cc = t & 1;
                    const int key0 = (rs + a) * 64 + 32 * cc;
                    const f32x16 acc = qk_tile(PA + (size_t)key0 * PAW + kcol, qf, r, h);
                    const float* brow = PB + (size_t)(hd * 15 + (rs + a - i + 7)) * 128 + (32 * cc + 4 * h - j + 63);
                    const int lo = cs - 32 * cc - 4 * h;
                    f32x16 p;
#pragma unroll
                    for (int g = 0; g < 4; ++g) {
                        const f32x4u b4 = *(const f32x4u*)(brow + 8 * g);
#pragma unroll
                        for (int q = 0; q < 4; ++q) { const int reg = 4 * g + q; const bool valid = (unsigned)(KOFF(reg) - lo) < 16u;
                            const float e = __expf(acc[reg] + b4[q] - Mr); p[reg] = valid ? e : 0.f; lsum += p[reg]; }
                    }
                    pv_tile(o, VT + key0, p, r, h);
                }
            }
        } else {
            if (lat) {
#pragma unroll 1
                for (int dl = -4; dl <= 4; ++dl) {
                    const int kt = qt + dl;
                    if (kt < 0 || kt > 255) continue;
                    const int key0 = kt * 32;
                    const f32x16 acc = qk_tile(PA + (size_t)key0 * PAW + kcol, qf, r, h);
                    f32x16 p;
#pragma unroll
                    for (int reg = 0; reg < 16; ++reg) { const int kr = KOFF(reg) + 4 * h; const bool valid = dl == -4 ? (kr >= r) : (dl == 4 ? (kr <= r) : true);
                        const float e = __expf(acc[reg] - Mr); p[reg] = valid ? e : 0.f; lsum += p[reg]; }
                    pv_tile(o, VT + key0, p, r, h);
                }
            }
        }
#pragma unroll 1
        for (int t = 0; t < CTX / 32; ++t) {
            const int key0 = SEQ + 32 * t;
            const f32x16 acc = qk_tile(PA + (size_t)key0 * PAW + kcol, qf, r, h);
            f32x16 p;
#pragma unroll
            for (int reg = 0; reg < 16; ++reg) { p[reg] = __expf(acc[reg] - Mr); lsum += p[reg]; }
            pv_tile(o, VT + key0, p, r, h);
        }
        float ltot = swap32_sum(lsum);
        if (type == 1) ltot += __expf(C.ka->in[I_WASINK][l * 8 + hd] - Mr);
        const float inv = 1.0f / ltot;
        bf16_t* yp = YB + (size_t)(2 + type) * MT * 512 + (size_t)(q0 + r) * 512 + hd * 64 + 4 * h;
#pragma unroll
        for (int blk = 0; blk < 2; ++blk)
#pragma unroll
            for (int g = 0; g < 4; ++g) {
                u32x2 w; w.x = pg8::cvt_pk_bf16(o[blk][4 * g] * inv, o[blk][4 * g + 1] * inv); w.y = pg8::cvt_pk_bf16(o[blk][4 * g + 2] * inv, o[blk][4 * g + 3] * inv);
                *(u32x2*)(yp + 32 * blk + 8 * g) = w;
            }
    }
}
__device__ __forceinline__ void phase_attn_tables(Ctx& C, int l, int w0, int nw) {
    const bf16_t* PA = WSP(bf16_t, OFF_PA); bf16_t* VTN = WSP(bf16_t, OFF_VTN); bf16_t* VTW = WSP(bf16_t, OFF_VTW);
    LAS unsigned char* tile = C.lds + C.wave * 9216;
    const int lane = C.lane;
    for (int u = w0; u < 10 * NCH; u += nw) {
        const int hd = u / NCH, tt = u % NCH, t0 = tt * 64;
        const int vcol = hd < 8 ? 1024 + hd * 64 : 2176 + (hd - 8) * 64;
#pragma unroll
        for (int it = 0; it < 8; ++it) { const int row = 8 * it + (lane >> 3), ch = lane & 7;
            *(LAS u32x4*)(tile + row * 144 + ch * 16) = *(const u32x4*)(PA + (size_t)(t0 + row) * PAW + vcol + ch * 8); }
        LDS_WAIT(); asm volatile("" ::: "memory");
        bf16_t* dst = (hd < 8 ? VTN + (size_t)(hd * 64 + lane) * MT : VTW + (size_t)((hd - 8) * 64 + lane) * MT) + t0;
#pragma unroll
        for (int it = 0; it < 8; ++it) {
            unsigned e[8];
#pragma unroll
            for (int j = 0; j < 8; ++j) e[j] = *(const LAS bf16_t*)(tile + (8 * it + j) * 144 + 2 * lane);
            u32x4 w; w.x = e[0] | (e[1] << 16); w.y = e[2] | (e[3] << 16); w.z = e[4] | (e[5] << 16); w.w = e[6] | (e[7] << 16);
            *(u32x4*)(dst + 8 * it) = w;
        }
        LDS_WAIT(); asm volatile("" ::: "memory");
    }
    float* PB = WSP(float, OFF_PB);
    const float* rpb = C.ka->in[I_NARPB] + (size_t)l * 8 * 15 * 31;
    for (int idx = w0 * 64 + lane; idx < 8 * 15 * 128; idx += nw * 64) { const int x = idx & 127, hr = idx >> 7; PB[idx] = (x >= 48 && x < 79) ? rpb[hr * 31 + x - 48] : 0.f; }
    if (w0 == 0) {
        float mb = 0.f;
        for (int i = lane; i < 8 * 15 * 31; i += 64) mb = fmaxf(mb, fabsf(rpb[i]));
        mb = wave_max(mb);
        const float nq = wave_max(fabsf(C.ka->in[I_NAQN][l * 64 + lane])), nk = wave_max(fabsf(C.ka->in[I_NAKN][l * 64 + lane]));
        const float wq = wave_max(fabsf(C.ka->in[I_WAQN][l * 64 + lane])), wk = wave_max(fabsf(C.ka->in[I_WAKN][l * 64 + lane]));
        const float sk = wave_max(lane < 8 ? C.ka->in[I_WASINK][l * 8 + lane] : -1e30f);
        if (lane == 0) { float* M = WSP(float, OFF_MREF); M[0] = 8.08f * nq * nk + mb; M[1] = fmaxf(8.08f * wq * wk, sk); }
    }
}

__device__ __forceinline__ void phase_combine(Ctx& C) {
    const bf16_t* PROJ = WSP(bf16_t, OFF_P32); bf16_t* MG = WSP(bf16_t, OFF_H);
    const size_t n8 = (size_t)MT * D / 8;
    for (size_t i = (size_t)C.bid * NT + C.tid; i < n8; i += (size_t)C.G * NT) {
        const size_t r = i / (D / 8), c8 = i % (D / 8);
        float a[8];
#pragma unroll
        for (int j = 0; j < 8; ++j) a[j] = 0.f;
#pragma unroll
        for (int g = 0; g < 4; ++g) {
            const u32x4 w = *(const u32x4*)(PROJ + r * GLW + g * D + c8 * 8);
            a[0] += bf2f(w.x & 0xffffu); a[1] += bf2f(w.x >> 16); a[2] += bf2f(w.y & 0xffffu); a[3] += bf2f(w.y >> 16);
            a[4] += bf2f(w.z & 0xffffu); a[5] += bf2f(w.z >> 16); a[6] += bf2f(w.w & 0xffffu); a[7] += bf2f(w.w >> 16);
        }
        u32x4 o; o.x = pk2(a[0], a[1]); o.y = pk2(a[2], a[3]); o.z = pk2(a[4], a[5]); o.w = pk2(a[6], a[7]);
        *(u32x4*)(MG + r * D + c8 * 8) = o;
    }
}

constexpr int PH_PRO = 2, PH_PER_LAYER = 14, N_PHASES = PH_PRO + DEPTH * PH_PER_LAYER;

__global__ void __launch_bounds__(NT, 2) mk_fwd(Args args) {
    extern __shared__ __attribute__((aligned(16))) unsigned char lds_raw[];
    Ctx C;
    C.lds = (LAS unsigned char*)lds_raw;
    C.tid = threadIdx.x; C.lane = C.tid & 63; C.wave = __builtin_amdgcn_readfirstlane(C.tid >> 6);
    C.bid = blockIdx.x; C.G = gridDim.x;
    C.ka = (const Args __attribute__((address_space(4)))*)__builtin_amdgcn_kernarg_segment_ptr(); C.out = args.out; C.ws = args.ws;
    volatile LAS unsigned* MISC = (volatile LAS unsigned*)(C.lds + MISC_OFF);
    for (int u = C.tid; u < (LDS_BYTES - RING_BYTES) / 4; u += NT) ((LAS unsigned*)(C.lds + RING_BYTES))[u] = 0u;
    __syncthreads();
    const int lo = args.ph_lo, hi = args.ph_hi;
    XcdBarrier bar; bar.bar = WSP(unsigned, OFF_CTL) + 4096; bar.x = 0; bar.st = nullptr;
    const bool multi = (hi - lo) > 1;
    if (multi) bar = xcd_barrier_post(WSP(unsigned, OFF_CTL) + 4096, MISC + 8);
#ifndef PH_MASK
#define PH_MASK 0xFFFF
#endif
#ifndef PRO_MASK
#define PRO_MASK 3
#endif
#define IN(k) (lo <= (k) && (k) < hi)
#define LEN(j) (((PH_MASK) >> (j)) & 1)
#define SEAM(k) do { if (IN(k) && IN((k) + 1)) xcd_barrier(bar); } while (0)

    if ((PRO_MASK & 1) && IN(0)) { relaunder(C); phase_convert(C, 0); phase_ada_partial(C); } SEAM(0);
    if ((PRO_MASK & 2) && IN(1)) { relaunder(C); phase_ada_reduce(C); } SEAM(1);

#pragma unroll
    for (int l = 0; l < DEPTH; ++l) {
        const int pb = PH_PRO + l * PH_PER_LAYER;
        if (LEN(0) && IN(pb + 0)) { relaunder(C); if (l > 0) phase_convert(C, l); phase_norm(C, l, C.ka->in[I_NF1] + (size_t)l * D, 0); } SEAM(pb + 0);
        if (LEN(1) && IN(pb + 1)) { relaunder(C);
            pg8::Gemm g{WSP(bf16_t, OFF_H), WSP(bf16_t, OFF_WI1), MT, 2 * DFF, D, 1 << 20, 0};
            pg8::StaticOrder S; S.init(MT, 2 * DFF, C.G, C.bid);
            pg8::EpiSwiGLU E{WSP(bf16_t, OFF_G)};
            pg8::gemm_phase<pg8::EpiSwiGLU, true, false>(C.lds, g, S, E, C.tid);
        } SEAM(pb + 1);
        if (LEN(2) && IN(pb + 2)) { relaunder(C);
            pg8::Gemm g{WSP(bf16_t, OFF_G), WSP(bf16_t, OFF_WO1), MT, D, DFF, 1 << 20, 0};
            pg8::StaticOrder S; S.init(MT, D, C.G, C.bid);
            pg8::EpiResid<true> E{WSP(float, OFF_X), mod_ptr(C, l, 0, 2), mod_ptr(C, l, 1, 2), nullptr};
            pg8::gemm_phase<pg8::EpiResid<true>, true, false>(C.lds, g, S, E, C.tid);
        } SEAM(pb + 2);
        if (LEN(3) && IN(pb + 3)) { relaunder(C); phase_norm(C, l, C.ka->in[I_NMIX] + (size_t)l * D, 3); } SEAM(pb + 3);
        if (LEN(4) && IN(pb + 4)) { relaunder(C);
            pg8::Gemm g{WSP(bf16_t, OFF_H), WSP(bf16_t, OFF_WIN), MT, PTOT, D, 1 << 20, 0};
            pg8::StaticOrder S; S.init(MT, PTOT, C.G, C.bid);
            pg8::EpiWin E{WSP(float, OFF_P32), WSP(bf16_t, OFF_PA), WSP(bf16_t, OFF_GL)};
            pg8::gemm_phase<pg8::EpiWin, true, false>(C.lds, g, S, E, C.tid);
        } SEAM(pb + 4);
        if (LEN(5) && IN(pb + 5)) { relaunder(C);
            phase_rw_prep(C, l, C.bid, C.G);
            __syncthreads();
            phase_attn_prep(C, l, C.bid * NWAVES + C.wave, C.G * NWAVES);
            phase_attn_tables(C, l, C.bid * NWAVES + C.wave, C.G * NWAVES);
            __syncthreads();
            phase_hg_A(C, l, C.bid, C.G);
        } SEAM(pb + 5);
        if (LEN(6) && IN(pb + 6)) { relaunder(C);
            if (C.G >= 256) {
                if (C.bid < 128) phase_rw_scan(C, C.bid, 128);
                else { const int b = C.bid - 128, n = C.G - 128; phase_hg_B(C, b, n); phase_attn(C, l, b * NWAVES + C.wave, n * NWAVES); }
            } else {
                phase_rw_scan(C, C.bid, C.G); phase_hg_B(C, C.bid, C.G); phase_attn(C, l, C.bid * NWAVES + C.wave, C.G * NWAVES);
            }
        } SEAM(pb + 6);
        if (LEN(7) && IN(pb + 7)) { relaunder(C); phase_hg_C(C, l, C.bid, C.G); phase_rw_finish(C, l, C.bid * NWAVES + C.wave, C.G * NWAVES); } SEAM(pb + 7);
        if (LEN(8) && IN(pb + 8)) { relaunder(C);
            pg8::Gemm g{WSP(bf16_t, OFF_YB), WSP(bf16_t, OFF_WBR), MT, 4 * D, 512, 8, (size_t)MT * 512};
            pg8::StaticOrder S; S.init(MT, 4 * D, C.G, C.bid);
            pg8::EpiMerge E{WSP(bf16_t, OFF_GL), WSP(bf16_t, OFF_P32)};
            pg8::gemm_phase<pg8::EpiMerge, true, false>(C.lds, g, S, E, C.tid);
        } SEAM(pb + 8);
        if (LEN(9) && IN(pb + 9)) { relaunder(C); phase_combine(C); } SEAM(pb + 9);
        if (LEN(10) && IN(pb + 10)) { relaunder(C);
            pg8::Gemm g{WSP(bf16_t, OFF_H), WSP(bf16_t, OFF_WOUT), MT, D, D, 1 << 20, 0};
            pg8::StaticOrder S; S.init(MT, D, C.G, C.bid);
            pg8::EpiResid<false> E{WSP(float, OFF_X), mod_ptr(C, l, 0, 5), mod_ptr(C, l, 1, 5), nullptr};
            pg8::gemm_phase<pg8::EpiResid<false>, true, false>(C.lds, g, S, E, C.tid);
        } SEAM(pb + 10);
        if (LEN(11) && IN(pb + 11)) { relaunder(C); phase_norm(C, l, C.ka->in[I_NF2] + (size_t)l * D, 6); } SEAM(pb + 11);
        if (LEN(12) && IN(pb + 12)) { relaunder(C);
            pg8::Gemm g{WSP(bf16_t, OFF_H), WSP(bf16_t, OFF_WI2), MT, 2 * DFF, D, 1 << 20, 0};
            pg8::StaticOrder S; S.init(MT, 2 * DFF, C.G, C.bid);
            pg8::EpiSwiGLU E{WSP(bf16_t, OFF_G)};
            pg8::gemm_phase<pg8::EpiSwiGLU, true, false>(C.lds, g, S, E, C.tid);
        } SEAM(pb + 12);
        if (LEN(13) && IN(pb + 13)) { relaunder(C);
            pg8::Gemm g{WSP(bf16_t, OFF_G), WSP(bf16_t, OFF_WO2), MT, D, DFF, 1 << 20, 0};
            pg8::StaticOrder S; S.init(MT, D, C.G, C.bid);
            pg8::EpiResid<true> E{WSP(float, OFF_X), mod_ptr(C, l, 0, 8), mod_ptr(C, l, 1, 8), l == DEPTH - 1 ? C.out : nullptr};
            pg8::gemm_phase<pg8::EpiResid<true>, true, false>(C.lds, g, S, E, C.tid);
        } SEAM(pb + 13);
    }
#undef IN
#undef SEAM
}

extern "C" void kernel_launch(void* const* d_in, const int* in_sizes, int n_in, void* d_out, int out_size, void* d_ws, size_t ws_size, hipStream_t stream) {
    static int grid = 0;
    if (grid == 0) {
        if (n_in != N_IN || out_size != SEQ * D || ws_size < WS_END) { fprintf(stderr, "kernel_launch: unexpected shapes (n_in %d out %d ws %zu)\n", n_in, out_size, ws_size); grid = -1; return; }
        int dev = 0, cus = 0;
        if (hipGetDevice(&dev) != hipSuccess || hipDeviceGetAttribute(&cus, hipDeviceAttributeMultiprocessorCount, dev) != hipSuccess) { grid = -1; return; }
        if (hipFuncSetAttribute((const void*)mk_fwd, hipFuncAttributeMaxDynamicSharedMemorySize, LDS_BYTES) != hipSuccess) { fprintf(stderr, "kernel_launch: hipFuncSetAttribute failed\n"); grid = -1; return; }
        (void)hipGetLastError();
        grid = cus;
    }
    if (grid < 0) return;
    (void)hipMemsetAsync((char*)d_ws + OFF_CTL, 0, CTL_BYTES, stream);
    Args a{};
    for (int i = 0; i < N_IN; ++i) a.in[i] = (const float*)d_in[i];
    a.out = (float*)d_out; a.ws = (unsigned char*)d_ws;
#if MK_ONE_LAUNCH
    a.ph_lo = 0; a.ph_hi = N_PHASES;
    hipLaunchKernelGGL(mk_fwd, dim3(grid), dim3(NT), LDS_BYTES, stream, a);
#else
    for (int ph = 0; ph < N_PHASES; ++ph) {
        a.ph_lo = ph; a.ph_hi = ph + 1;
        hipLaunchKernelGGL(mk_fwd, dim3(grid), dim3(NT), LDS_BYTES, stream, a);
    }
#endif
}
```

```cpp
#include <hip/hip_runtime.h>
#include <cstdio>
#include <cstdint>

#ifndef MK_ONE_LAUNCH
#define MK_ONE_LAUNCH 1
#endif

#define LAS __attribute__((address_space(3)))
#define GAS __attribute__((address_space(1)))
typedef unsigned short bf16_t;
typedef short bf16x8 __attribute__((ext_vector_type(8)));
typedef float f32x4 __attribute__((ext_vector_type(4)));
typedef float f32x2 __attribute__((ext_vector_type(2)));
typedef unsigned u32x4 __attribute__((ext_vector_type(4)));
typedef unsigned u32x2 __attribute__((ext_vector_type(2)));

constexpr int D = 2048, SEQ = 8192, CTX = 256, MT = SEQ + CTX, DEPTH = 2, DFF = 5632, NMOD = 9, MODW = NMOD * D;
constexpr int GRID_W = 64;
constexpr int PTOT = 15360, P32W = 4864, PAW = 2304, GLW = 8192;
constexpr int HG_OFF = 0, RW_OFF = 2560, RWC = 2304;
constexpr int NCH = MT / 64;
constexpr int NWAVES = 8, NT = 512;
constexpr float EPS = 1e-6f, RW_GN_EPS = 64e-5f;

constexpr size_t MiB = 1u << 20;
constexpr size_t OFF_CTL = 0, CTL_BYTES = 1 * MiB;
constexpr size_t OFF_MOD = 1 * MiB;
constexpr size_t OFF_MODP = 2 * MiB;
constexpr size_t OFF_WI1 = 11 * MiB, OFF_WO1 = 55 * MiB, OFF_WIN = 77 * MiB, OFF_WBR = 137 * MiB, OFF_WOUT = 145 * MiB, OFF_WI2 = 153 * MiB, OFF_WO2 = 197 * MiB;
constexpr size_t OFF_X = 219 * MiB;
constexpr size_t OFF_H = 285 * MiB;
constexpr size_t OFF_G = 318 * MiB;
constexpr size_t OFF_P32 = 409 * MiB;
constexpr size_t OFF_PA = 566 * MiB;
constexpr size_t OFF_GL = 604 * MiB;
constexpr size_t OFF_HGL = 736 * MiB;
constexpr size_t OFF_HGD = 802 * MiB;
constexpr size_t OFF_SCN = 803 * MiB;
constexpr size_t OFF_VV = 968 * MiB;
constexpr size_t OFF_GS = 985 * MiB;
constexpr size_t OFF_RO = 1002 * MiB;
constexpr size_t OFF_YB = 1035 * MiB;
constexpr size_t OFF_VTN = 1068 * MiB;
constexpr size_t OFF_VTW = 1077 * MiB;
constexpr size_t OFF_PB = 1080 * MiB;
constexpr size_t OFF_MREF = OFF_PB + 65536;
constexpr size_t WS_END = 1081 * MiB;
constexpr int KSPLIT = 32;

constexpr int LDS_BYTES = 147456;
constexpr int RING_BYTES = 131072;
constexpr int MISC_OFF = RING_BYTES + 320;

__device__ __forceinline__ float bf2f(unsigned b) { return __uint_as_float(b << 16); }
__device__ __forceinline__ unsigned f2bf(float f) { unsigned u = __float_as_uint(f); return (u + 0x7fffu + ((u >> 16) & 1u)) >> 16; }
__device__ __forceinline__ unsigned pk2(float lo, float hi) { return f2bf(lo) | (f2bf(hi) << 16); }
__device__ __forceinline__ float wave_sum(float v) {
#pragma unroll
    for (int o = 1; o < 64; o <<= 1) v += __shfl_xor(v, o);
    return v;
}
__device__ __forceinline__ float wave_max(float v) {
#pragma unroll
    for (int o = 1; o < 64; o <<= 1) v = fmaxf(v, __shfl_xor(v, o));
    return v;
}
__device__ __forceinline__ float sigmoidf_(float x) { return 1.0f / (1.0f + expf(-x)); }
__device__ __forceinline__ float siluf_(float x) { return x / (1.0f + expf(-x)); }
#define LDS_WAIT() asm volatile("s_waitcnt lgkmcnt(0)" ::: "memory")

__device__ __forceinline__ int seq_row(int d, int j) { return d == 0 ? (j < CTX ? SEQ + j : j - CTX) : (MT - 1 - j); }
__device__ __forceinline__ int row_seq(int d, int r) { return d == 0 ? (r >= SEQ ? r - SEQ : r + CTX) : (MT - 1 - r); }

#define XB_TMO      128
#define XB_XCNT(j)  (256  + 64 * (j))
#define XB_XSUB(j)  (1280 + 64 * (j))
#define XB_XGEN(j)  (2304 + 64 * (j))
#define XB_TOP      3328
#define XB_TOPGEN   3392
#define XCD_BAR_WORDS 3456
#define XB_SPIN_CAP (1u << 18)
__device__ __forceinline__ unsigned xb_ld(unsigned* p)              { return __hip_atomic_load(p, __ATOMIC_RELAXED, __HIP_MEMORY_SCOPE_AGENT); }
__device__ __forceinline__ unsigned xb_add(unsigned* p, unsigned v) { return __hip_atomic_fetch_add(p, v, __ATOMIC_RELAXED, __HIP_MEMORY_SCOPE_AGENT); }
__device__ __forceinline__ unsigned xb_xcc_id() { return (unsigned)__builtin_amdgcn_s_getreg((3 << 11) | 20) & 0xFu; }
#define XB_SPIN(cond, bar) do { unsigned _sp = 0; while (cond) { __builtin_amdgcn_s_sleep(1); \
    if ((++_sp & 255u) == 0u) { if (xb_ld(&(bar)[XB_TMO])) break; if (_sp > XB_SPIN_CAP) { atomicAdd(&(bar)[XB_TMO], 1u); break; } } } } while (0)
struct XcdBarrier { unsigned* bar; unsigned x; volatile LAS unsigned* st; };
__device__ __forceinline__ XcdBarrier xcd_barrier_post(unsigned* bar, volatile LAS unsigned* st) {
    XcdBarrier b; b.bar = bar; b.x = xb_xcc_id(); b.st = st;
    if (threadIdx.x == 0) (void)xb_add(&bar[XB_XCNT(b.x)], 1u);
    return b;
}
__device__ __forceinline__ void xcd_barrier_complete(unsigned* bar, unsigned x, unsigned& nloc, unsigned& nx) {
    const unsigned G = gridDim.x * gridDim.y * gridDim.z;
    unsigned sum, cnt, mine, sp = 0u;
    for (;;) {
        sum = 0u; cnt = 0u; mine = 0u;
#pragma unroll
        for (unsigned j = 0; j < 16; ++j) { const unsigned c = xb_ld(&bar[XB_XCNT(j)]); sum += c; cnt += (c > 0u) ? 1u : 0u; mine = (j == x) ? c : mine; }
        if (sum == G) break;
        __builtin_amdgcn_s_sleep(1);
        if ((++sp & 255u) == 0u) { if (xb_ld(&bar[XB_TMO])) break; if (sp > XB_SPIN_CAP) { atomicAdd(&bar[XB_TMO], 1u); break; } }
    }
    nloc = mine > 0u ? mine : 1u; nx = cnt > 0u ? cnt : 1u;
}
__device__ __forceinline__ void xcd_barrier(const XcdBarrier& b) {
    asm volatile("s_waitcnt vmcnt(0)" ::: "memory");
    __syncthreads();
    if (threadIdx.x == 0) {
        unsigned* bar = b.bar;
        __builtin_amdgcn_s_waitcnt(0);
        unsigned nloc = b.st[0], nx = b.st[1];
        if (nloc == 0u) { xcd_barrier_complete(bar, b.x, nloc, nx); b.st[0] = nloc; b.st[1] = nx; }
        const unsigned old = xb_add(&bar[XB_XSUB(b.x)], 1u);
        const unsigned gen = old / nloc;
        if (old + 1u == (gen + 1u) * nloc) {
            __builtin_amdgcn_fence(__ATOMIC_RELEASE, "agent");
            asm volatile("s_waitcnt vmcnt(0)" ::: "memory");
            const unsigned og = xb_add(&bar[XB_TOP], 1u);
            const unsigned tg = og / nx;
            if (og + 1u == (tg + 1u) * nx) xb_add(&bar[XB_TOPGEN], 1u);
            else XB_SPIN(xb_ld(&bar[XB_TOPGEN]) == tg, bar);
            __builtin_amdgcn_fence(__ATOMIC_ACQUIRE, "agent");
            xb_add(&bar[XB_XGEN(b.x)], 1u);
            asm volatile("s_waitcnt vmcnt(0)" ::: "memory");
        } else {
            XB_SPIN(xb_ld(&bar[XB_XGEN(b.x)]) == gen, bar);
            __builtin_amdgcn_fence(__ATOMIC_ACQUIRE, "agent");
            asm volatile("s_waitcnt vmcnt(0)" ::: "memory");
        }
    }
    __syncthreads();
}

namespace pg8 {
constexpr int BM = 256, BK = 64, HALF = 128, HTB = HALF * BK * 2, STAGE_BYTES = 8 * HTB, NXCD = 8, WGM = 8;
__host__ __device__ __forceinline__ int lds_byte(int r, int c) { const int st = (r >> 4) * 2 + (c >> 5), rr = r & 15, cc = c & 31, ob = rr * 64 + cc * 2; return st * 1024 + (ob ^ (((ob >> 9) & 1) << 5)); }
__host__ __device__ __forceinline__ void stage_rc(int b, int& R, int& C) { const int st = b / 1024, sb = b % 1024, swz = sb ^ (((sb >> 9) & 1) << 5); R = (st >> 1) * 16 + swz / 64; C = (st & 1) * 32 + (swz % 64) / 2; }
__host__ __device__ __forceinline__ int perm32(int rho) { const int n = rho >> 4, i = rho & 15; return 8 * (i >> 2) + 4 * n + (i & 3); }
struct Unit { int pm, pn; };
struct Gemm { const bf16_t* A; const bf16_t* Bt; int M, N, K; int a_div; size_t a_gstride; };
struct StaticOrder {
    int nM, nN, nwg, G, c;
    __host__ __device__ void init(int M, int N, int G_, int c_) { nM = M / BM; nN = N / BM; nwg = nM * nN; G = G_; c = c_; }
    __host__ __device__ bool next(int i, Unit& u) const {
        const long L = (long)i * G + c; if (L >= nwg) return false;
        int wgid = (int)L; { const int q = nwg / NXCD, r = nwg % NXCD, xcd = wgid % NXCD, off = wgid / NXCD; wgid = (xcd < r ? xcd * (q + 1) : r * (q + 1) + (xcd - r) * q) + off; }
        const int nig = WGM * nN, gid = wgid / nig, fm = gid * WGM, gsz = (nM - fm) < WGM ? (nM - fm) : WGM;
        u.pm = fm + ((wgid % nig) % gsz); u.pn = (wgid % nig) / gsz; return true;
    }
};
__device__ __forceinline__ unsigned cvt_pk_bf16(float lo, float hi) { unsigned r; asm volatile("v_cvt_pk_bf16_f32 %0, %1, %2" : "=v"(r) : "v"(lo), "v"(hi)); return r; }

template <class Epi, bool ALIGN_EPI, bool SP2>
__device__ __forceinline__ void gemm_phase(LAS unsigned char* lds, const Gemm g, const StaticOrder& S, const Epi& E, const int tid) {
    const int wid = __builtin_amdgcn_readfirstlane(tid >> 6), lane = tid & 63, wr = wid >> 2, wc = wid & 3, fr = lane & 15, fq = lane >> 4;
    const int K = g.K, nt = K / BK;
    unsigned voffA[2], voffB[2];
#pragma unroll
    for (int i = 0; i < 2; ++i) { int R, C; stage_rc(tid * 16 + i * 8192, R, C); const int Rb = Epi::PERM ? ((R & ~31) + perm32(R & 31)) : R;
        voffA[i] = (unsigned)(R * K + C) * 2u; voffB[i] = (unsigned)(Rb * K + C) * 2u; }
    const size_t kstep = (size_t)(BK * 2);
    const size_t hstep = (size_t)HALF * K * 2;
    const size_t tstep = 2 * hstep;
    const unsigned ldsw = (unsigned)wid * 1024u;
    const int aoff = lds_byte(wr * 64 + fr, fq * 8), boff = lds_byte(wc * 32 + fr, fq * 8);
#define PG8_SA(b, h) (((b) * 2 + (h)) * HTB)
#define PG8_SB(b, h) ((4 + (b) * 2 + (h)) * HTB)
#define PG8_STAGE(bufoff, gbase, voff) do { _Pragma("unroll") for (int _i = 0; _i < 2; ++_i) \
        __builtin_amdgcn_global_load_lds((const unsigned*)((const char*)(gbase) + (voff)[_i]), (LAS unsigned*)(lds + (bufoff) + ldsw + _i * 8192), 16, 0, 0); } while (0)
#define PG8_LDA(dst, b, h) do { _Pragma("unroll") for (int m = 0; m < 4; ++m) _Pragma("unroll") for (int k = 0; k < 2; ++k) dst[m][k] = *(const LAS bf16x8*)(lds + PG8_SA(b, h) + aoff + m * 2048 + k * 1024); } while (0)
#define PG8_LDB(dst, b, h) do { _Pragma("unroll") for (int n = 0; n < 2; ++n) _Pragma("unroll") for (int k = 0; k < 2; ++k) dst[n][k] = *(const LAS bf16x8*)(lds + PG8_SB(b, h) + boff + n * 2048 + k * 1024); } while (0)
#define PG8_MMA(ai, bj, At, Bt) do { __builtin_amdgcn_s_setprio(1); _Pragma("unroll") for (int m = 0; m < 4; ++m) _Pragma("unroll") for (int n = 0; n < 2; ++n) _Pragma("unroll") for (int k = 0; k < 2; ++k) \
        acc[ai][bj][m][n] = __builtin_amdgcn_mfma_f32_16x16x32_bf16(Bt[n][k], At[m][k], acc[ai][bj][m][n], 0, 0, 0); __builtin_amdgcn_s_setprio(0); } while (0)
#define PG8_WAIT_V(n) asm volatile("s_waitcnt vmcnt(" #n ")" ::: "memory")
#define PG8_WAIT_L(n) asm volatile("s_waitcnt lgkmcnt(" #n ")" ::: "memory")
#define PG8_BAR __builtin_amdgcn_s_barrier()
#define PG8_SCHED __builtin_amdgcn_sched_barrier(0)
#define PG8_ABASE(u) ((const char*)g.A + ((size_t)((u).pn / g.a_div) * g.a_gstride) * 2 + (size_t)(u).pm * tstep)
    Unit cur, nxt; int ui = 0;
    if (!S.next(0, cur)) return;
    f32x4 acc[2][2][4][2];
#pragma unroll
    for (int a = 0; a < 2; ++a)
#pragma unroll
        for (int b = 0; b < 2; ++b)
#pragma unroll
            for (int m = 0; m < 4; ++m)
#pragma unroll
                for (int n = 0; n < 2; ++n) acc[a][b][m][n] = (f32x4){0.f, 0.f, 0.f, 0.f};
    bf16x8 At[4][2], B0[2][2], B1[2][2];
    const char* cA = PG8_ABASE(cur); const char* cB = (const char*)g.Bt + (size_t)cur.pn * tstep;
    if constexpr (SP2) {
        PG8_STAGE(PG8_SB(0, 0), cB, voffB); PG8_STAGE(PG8_SB(0, 1), cB + hstep, voffB); PG8_STAGE(PG8_SA(0, 0), cA, voffA); PG8_STAGE(PG8_SA(0, 1), cA + hstep, voffA);
        if (wr == 1) PG8_BAR;
        PG8_WAIT_V(2); PG8_BAR;
        PG8_STAGE(PG8_SB(1, 0), cB + kstep, voffB); PG8_STAGE(PG8_SA(1, 0), cA + kstep, voffA); PG8_STAGE(PG8_SB(1, 1), cB + hstep + kstep, voffB);
        PG8_WAIT_V(6); PG8_BAR;
    } else {
        PG8_STAGE(PG8_SB(0, 0), cB, voffB); PG8_STAGE(PG8_SA(0, 0), cA, voffA); PG8_STAGE(PG8_SB(0, 1), cB + hstep, voffB); PG8_STAGE(PG8_SA(0, 1), cA + hstep, voffA);
        if (wr == 1) PG8_BAR;
        PG8_WAIT_V(4); PG8_BAR;
        PG8_STAGE(PG8_SB(1, 0), cB + kstep, voffB); PG8_STAGE(PG8_SA(1, 0), cA + kstep, voffA); PG8_STAGE(PG8_SB(1, 1), cB + hstep + kstep, voffB);
        PG8_WAIT_V(6); PG8_BAR;
    }
    for (;;) {
        const bool has_next = S.next(ui + 1, nxt);
        const char* nA = has_next ? PG8_ABASE(nxt) : cA; const char* nB = has_next ? (const char*)g.Bt + (size_t)nxt.pn * tstep : cB;
        for (int t = 0; t < nt; t += 2) {
            const bool last = (t == nt - 2);
            const char* a1 = cA + (size_t)(t + 1) * kstep;
            const char* a2 = last ? nA : cA + (size_t)(t + 2) * kstep; const char* b2 = last ? nB : cB + (size_t)(t + 2) * kstep;
            const char* a3 = a2 + kstep; const char* b3 = b2 + kstep;
            if constexpr (SP2) {
            PG8_LDB(B0, 0, 0); PG8_LDB(B1, 0, 1); PG8_SCHED; PG8_LDA(At, 0, 0); PG8_STAGE(PG8_SA(1, 1), a1 + hstep, voffA);
            PG8_WAIT_V(8); PG8_WAIT_L(0); PG8_BAR; PG8_MMA(0, 0, At, B0); PG8_MMA(0, 1, At, B1); PG8_BAR; PG8_SCHED;
            PG8_LDA(At, 0, 1); PG8_STAGE(PG8_SB(0, 0), b2, voffB); PG8_STAGE(PG8_SB(0, 1), b2 + hstep, voffB); PG8_STAGE(PG8_SA(0, 0), a2, voffA);
            PG8_WAIT_V(8); PG8_WAIT_L(0); PG8_BAR; PG8_MMA(1, 0, At, B0); PG8_MMA(1, 1, At, B1); PG8_BAR; PG8_SCHED;
            PG8_LDB(B0, 1, 0); PG8_LDB(B1, 1, 1); PG8_SCHED; PG8_LDA(At, 1, 0); PG8_STAGE(PG8_SA(0, 1), a2 + hstep, voffA);
            PG8_WAIT_V(8); PG8_WAIT_L(0); PG8_BAR; PG8_MMA(0, 0, At, B0); PG8_MMA(0, 1, At, B1); PG8_BAR; PG8_SCHED;
            PG8_LDA(At, 1, 1); PG8_STAGE(PG8_SB(1, 0), b3, voffB); PG8_STAGE(PG8_SB(1, 1), b3 + hstep, voffB); PG8_STAGE(PG8_SA(1, 0), a3, voffA);
            PG8_WAIT_V(8); PG8_WAIT_L(0); PG8_BAR; PG8_MMA(1, 0, At, B0); PG8_MMA(1, 1, At, B1); PG8_BAR; PG8_SCHED;
            } else {
            PG8_LDB(B0, 0, 0); PG8_SCHED; PG8_LDA(At, 0, 0); PG8_STAGE(PG8_SA(1, 1), a1 + hstep, voffA);
            PG8_WAIT_L(8); PG8_BAR; PG8_WAIT_L(0); PG8_MMA(0, 0, At, B0); PG8_BAR; PG8_SCHED;
            PG8_LDB(B1, 0, 1); PG8_STAGE(PG8_SB(0, 0), b2, voffB);
            PG8_BAR; PG8_WAIT_L(0); PG8_MMA(0, 1, At, B1); PG8_BAR;
            PG8_LDA(At, 0, 1); PG8_STAGE(PG8_SA(0, 0), a2, voffA);
            PG8_BAR; PG8_WAIT_L(0); PG8_MMA(1, 0, At, B0); PG8_BAR; PG8_SCHED;
            PG8_STAGE(PG8_SB(0, 1), b2 + hstep, voffB);
            PG8_WAIT_V(6); PG8_BAR; PG8_MMA(1, 1, At, B1); PG8_BAR;
            PG8_LDB(B0, 1, 0); PG8_SCHED; PG8_LDA(At, 1, 0); PG8_STAGE(PG8_SA(0, 1), a2 + hstep, voffA);
            PG8_WAIT_L(8); PG8_BAR; PG8_WAIT_L(0); PG8_MMA(0, 0, At, B0); PG8_BAR; PG8_SCHED;
            PG8_LDB(B1, 1, 1); PG8_STAGE(PG8_SB(1, 0), b3, voffB);
            PG8_BAR; PG8_WAIT_L(0); PG8_MMA(0, 1, At, B1); PG8_BAR;
            PG8_LDA(At, 1, 1); PG8_STAGE(PG8_SA(1, 0), a3, voffA);
            PG8_BAR; PG8_WAIT_L(0); PG8_MMA(1, 0, At, B0); PG8_BAR; PG8_SCHED;
            PG8_STAGE(PG8_SB(1, 1), b3 + hstep, voffB);
            PG8_WAIT_V(6); PG8_BAR; PG8_MMA(1, 1, At, B1); PG8_BAR;
            }
        }
        if constexpr (ALIGN_EPI) { if (wr == 0) PG8_BAR; }
        E(acc, cur, wr, wc, fr, fq);
        if (!has_next) break;
#pragma unroll
        for (int a = 0; a < 2; ++a)
#pragma unroll
            for (int b = 0; b < 2; ++b)
#pragma unroll
                for (int m = 0; m < 4; ++m)
#pragma unroll
                    for (int n = 0; n < 2; ++n) acc[a][b][m][n] = (f32x4){0.f, 0.f, 0.f, 0.f};
        cur = nxt; cA = nA; cB = nB; ++ui;
        if constexpr (ALIGN_EPI) { if (wr == 1) PG8_BAR; }
    }
    PG8_WAIT_V(0);
    if constexpr (!ALIGN_EPI) { if (wr == 0) PG8_BAR; }
    PG8_BAR;
#undef PG8_SA
#undef PG8_SB
#undef PG8_STAGE
#undef PG8_LDA
#undef PG8_LDB
#undef PG8_MMA
#undef PG8_WAIT_V
#undef PG8_WAIT_L
#undef PG8_BAR
#undef PG8_SCHED
#undef PG8_ABASE
}

struct EpiSwiGLU {
    static constexpr bool PERM = true;
    bf16_t* O;
    __device__ __forceinline__ void operator()(const f32x4 (&acc)[2][2][4][2], const Unit& u, int wr, int wc, int fr, int fq) const {
        const int row0 = u.pm * BM + wr * 64 + fr, col0 = u.pn * HALF + wc * 32 + 8 * fq;
#pragma unroll
        for (int ai = 0; ai < 2; ++ai)
#pragma unroll
            for (int m = 0; m < 4; ++m) {
                bf16_t* rowp = O + (size_t)(row0 + ai * HALF + m * 16) * DFF + col0;
                float o[8];
#pragma unroll
                for (int n = 0; n < 2; ++n)
#pragma unroll
                    for (int j = 0; j < 4; ++j) { const float a = acc[ai][0][m][n][j], b = acc[ai][1][m][n][j]; o[n * 4 + j] = a / (1.0f + __expf(-a)) * b; }
                u32x4 w; w.x = cvt_pk_bf16(o[0], o[1]); w.y = cvt_pk_bf16(o[2], o[3]); w.z = cvt_pk_bf16(o[4], o[5]); w.w = cvt_pk_bf16(o[6], o[7]);
                *(u32x4*)rowp = w;
            }
    }
};
template <bool HALFGATE> struct EpiResid {
    static constexpr bool PERM = false;
    float* X; const float* gate_lat; const float* gate_ctx; float* out;
    __device__ __forceinline__ void operator()(const f32x4 (&acc)[2][2][4][2], const Unit& u, int wr, int wc, int fr, int fq) const {
        const int row0 = u.pm * BM + wr * 64 + fr, col0 = u.pn * BM + wc * 32 + 4 * fq;
        const float* gp = (u.pm * BM >= SEQ) ? gate_ctx : gate_lat;
        f32x4 gv[2][2];
#pragma unroll
        for (int bj = 0; bj < 2; ++bj)
#pragma unroll
            for (int n = 0; n < 2; ++n) gv[bj][n] = *(const f32x4*)(gp + col0 + bj * HALF + n * 16) * (HALFGATE ? 0.5f : 1.0f);
#pragma unroll
        for (int ai = 0; ai < 2; ++ai)
#pragma unroll
            for (int m = 0; m < 4; ++m) {
                const int row = row0 + ai * HALF + m * 16;
                float* rowp = X + (size_t)row * D + col0;
#pragma unroll
                for (int bj = 0; bj < 2; ++bj)
#pragma unroll
                    for (int n = 0; n < 2; ++n) {
                        f32x4 v = *(const f32x4*)(rowp + bj * HALF + n * 16) + gv[bj][n] * acc[ai][bj][m][n];
                        *(f32x4*)(rowp + bj * HALF + n * 16) = v;
                        if (out != nullptr && row < SEQ) *(f32x4*)(out + (size_t)row * D + col0 + bj * HALF + n * 16) = v;
                    }
            }
    }
};
struct EpiWin {
    static constexpr bool PERM = true;
    float* P32; bf16_t* PA; bf16_t* GL; long pn_off;
    __device__ __forceinline__ void operator()(const f32x4 (&acc)[2][2][4][2], const Unit& u0, int wr, int wc, int fr, int fq) const {
        Unit u; u.pm = u0.pm; u.pn = u0.pn + (int)pn_off;
        const int row0 = u.pm * BM + wr * 64 + fr, cin = wc * 32 + 8 * fq;
        if (u.pn < 19) {
#pragma unroll
            for (int ai = 0; ai < 2; ++ai)
#pragma unroll
                for (int m = 0; m < 4; ++m) { float* rowp = P32 + (size_t)(row0 + ai * HALF + m * 16) * P32W + u.pn * BM + cin;
#pragma unroll
                    for (int bj = 0; bj < 2; ++bj) { *(f32x4*)(rowp + bj * HALF) = acc[ai][bj][m][0]; *(f32x4*)(rowp + bj * HALF + 4) = acc[ai][bj][m][1]; } }
        } else {
            bf16_t* base; int ld, colt;
            if (u.pn < 28) { base = PA; ld = PAW; colt = (u.pn - 19) * BM; } else { base = GL; ld = GLW; colt = (u.pn - 28) * BM; }
#pragma unroll
            for (int ai = 0; ai < 2; ++ai)
#pragma unroll
                for (int m = 0; m < 4; ++m) { bf16_t* rowp = base + (size_t)(row0 + ai * HALF + m * 16) * ld + colt + cin;
#pragma unroll
                    for (int bj = 0; bj < 2; ++bj) { const f32x4 v0 = acc[ai][bj][m][0], v1 = acc[ai][bj][m][1];
                        u32x4 w; w.x = cvt_pk_bf16(v0[0], v0[1]); w.y = cvt_pk_bf16(v0[2], v0[3]); w.z = cvt_pk_bf16(v1[0], v1[1]); w.w = cvt_pk_bf16(v1[2], v1[3]);
                        *(u32x4*)(rowp + bj * HALF) = w; } }
        }
    }
};
struct EpiMerge {
    static constexpr bool PERM = true;
    const bf16_t* GL; bf16_t* PROJ;
    __device__ __forceinline__ void operator()(const f32x4 (&acc)[2][2][4][2], const Unit& u, int wr, int wc, int fr, int fq) const {
        const int row0 = u.pm * BM + wr * 64 + fr, col0 = u.pn * BM + wc * 32 + 8 * fq;
#pragma unroll
        for (int ai = 0; ai < 2; ++ai)
#pragma unroll
            for (int m = 0; m < 4; ++m) { const size_t ro = (size_t)(row0 + ai * HALF + m * 16) * GLW + col0;
#pragma unroll
                for (int bj = 0; bj < 2; ++bj) {
                    const u32x4 gw = *(const u32x4*)(GL + ro + bj * HALF);
                    const f32x4 v0 = acc[ai][bj][m][0], v1 = acc[ai][bj][m][1];
                    float o[8];
                    o[0] = v0[0] / (1.0f + __expf(-bf2f(gw.x & 0xffffu))); o[1] = v0[1] / (1.0f + __expf(-bf2f(gw.x >> 16)));
                    o[2] = v0[2] / (1.0f + __expf(-bf2f(gw.y & 0xffffu))); o[3] = v0[3] / (1.0f + __expf(-bf2f(gw.y >> 16)));
                    o[4] = v1[0] / (1.0f + __expf(-bf2f(gw.z & 0xffffu))); o[5] = v1[1] / (1.0f + __expf(-bf2f(gw.z >> 16)));
                    o[6] = v1[2] / (1.0f + __expf(-bf2f(gw.w & 0xffffu))); o[7] = v1[3] / (1.0f + __expf(-bf2f(gw.w >> 16)));
                    u32x4 w; w.x = cvt_pk_bf16(o[0], o[1]); w.y = cvt_pk_bf16(o[2], o[3]); w.z = cvt_pk_bf16(o[4], o[5]); w.w = cvt_pk_bf16(o[6], o[7]);
                    *(u32x4*)(PROJ + ro + bj * HALF) = w; } }
    }
};
}

enum { I_X = 0, I_C, I_CTX, I_CCTX, I_ADAW, I_ADAB, I_NF1, I_NMIX, I_NF2, I_F1WI, I_F1WO, I_F2WI, I_F2WO, I_WIN, I_HGLB, I_HGNORM, I_RWSHIFT, I_RWW0, I_RWW2, I_RWA0, I_RWA2,
       I_RWKK, I_RWKA, I_RWRK, I_RWLNW, I_RWLNB, I_NAQN, I_NAKN, I_NARPB, I_WAQN, I_WAKN, I_WASINK, I_WBR, I_WOUT, N_IN };
struct Args { const float* in[N_IN]; float* out; unsigned char* ws; int ph_lo, ph_hi; };
struct Ctx {
    LAS unsigned char* lds;
    int tid, lane, wave, bid, G;
    const Args __attribute__((address_space(4)))* ka; float* out; unsigned char* ws;
};
#define WSP(T, off) ((T*)(C.ws + (off)))
__device__ __forceinline__ void relaunder(Ctx& C) {
    int t = C.tid, b = C.bid, g = C.G;
    asm volatile("" : "+v"(t), "+v"(b), "+v"(g));
    C.tid = t; C.lane = t & 63; C.wave = __builtin_amdgcn_readfirstlane(t >> 6); C.bid = __builtin_amdgcn_readfirstlane(b); C.G = __builtin_amdgcn_readfirstlane(g);
}

__device__ __forceinline__ void transpose_item(const float* W, int K, int N, bf16_t* WT, int mode, LAS float* scr, int item, int lane) {
    const int nblk = N / 32, kb = item / nblk, nb = item % nblk, k0 = 64 * kb, n0 = 32 * nb;
    int drow0 = n0;
    if (mode == 1) { const int half = n0 / DFF, j0 = n0 % DFF; drow0 = 256 * (j0 / 128) + 128 * half + (j0 % 128); }
#pragma unroll 8
    for (int i = 0; i < 32; ++i) { const int kk = 2 * i + (lane >> 5); scr[kk * 33 + (lane & 31)] = W[(size_t)(k0 + kk) * N + n0 + (lane & 31)]; }
    LDS_WAIT(); asm volatile("" ::: "memory");
    const int c = lane & 7;
#pragma unroll
    for (int j = 0; j < 4; ++j) { const int n = (lane >> 3) + 8 * j; const LAS float* s = scr + (8 * c) * 33 + n;
        u32x4 o; o.x = pk2(s[0 * 33], s[1 * 33]); o.y = pk2(s[2 * 33], s[3 * 33]); o.z = pk2(s[4 * 33], s[5 * 33]); o.w = pk2(s[6 * 33], s[7 * 33]);
        *(u32x4*)(WT + (size_t)(drow0 + n) * K + k0 + 8 * c) = o; }
    LDS_WAIT(); asm volatile("" ::: "memory");
}
__device__ __forceinline__ void phase_convert(Ctx& C, int l) {
    LAS float* scr = (LAS float*)(C.lds + C.wave * 16384);
    const int gw = C.bid * NWAVES + C.wave, NGW = C.G * NWAVES;
    constexpr int I_WI = (D / 64) * (2 * DFF / 32), I_WO = (DFF / 64) * (D / 32), I_IN = (D / 64) * (PTOT / 32), I_BR = (512 / 64) * (D / 32), I_OUT = (D / 64) * (D / 32);
    constexpr int NITEMS = 2 * I_WI + 2 * I_WO + I_IN + 4 * I_BR + I_OUT;
    for (int it = gw; it < NITEMS; it += NGW) {
        int r = it;
        if (r < I_WI) { transpose_item(C.ka->in[I_F1WI] + (size_t)l * D * 2 * DFF, D, 2 * DFF, WSP(bf16_t, OFF_WI1), 1, scr, r, C.lane); continue; } r -= I_WI;
        if (r < I_WI) { transpose_item(C.ka->in[I_F2WI] + (size_t)l * D * 2 * DFF, D, 2 * DFF, WSP(bf16_t, OFF_WI2), 1, scr, r, C.lane); continue; } r -= I_WI;
        if (r < I_WO) { transpose_item(C.ka->in[I_F1WO] + (size_t)l * DFF * D, DFF, D, WSP(bf16_t, OFF_WO1), 0, scr, r, C.lane); continue; } r -= I_WO;
        if (r < I_WO) { transpose_item(C.ka->in[I_F2WO] + (size_t)l * DFF * D, DFF, D, WSP(bf16_t, OFF_WO2), 0, scr, r, C.lane); continue; } r -= I_WO;
        if (r < I_IN) { transpose_item(C.ka->in[I_WIN] + (size_t)l * D * PTOT, D, PTOT, WSP(bf16_t, OFF_WIN), 0, scr, r, C.lane); continue; } r -= I_IN;
        if (r < 4 * I_BR) { const int g = r / I_BR; transpose_item(C.ka->in[I_WBR] + ((size_t)l * 4 + g) * 512 * D, 512, D, WSP(bf16_t, OFF_WBR) + (size_t)g * D * 512, 0, scr, r % I_BR, C.lane); continue; } r -= 4 * I_BR;
        transpose_item(C.ka->in[I_WOUT] + (size_t)l * D * D, D, D, WSP(bf16_t, OFF_WOUT), 0, scr, r, C.lane);
    }
}

__device__ __forceinline__ void phase_ada_partial(Ctx& C) {
    float* modp = WSP(float, OFF_MODP);
    for (int u = C.bid; u < DEPTH * 9 * KSPLIT; u += C.G) {
        const int l = u / (9 * KSPLIT), rem = u % (9 * KSPLIT), cg = rem / KSPLIT, ks = rem % KSPLIT;
        const int col = cg * 2048 + C.tid * 4;
        const float* W = C.ka->in[I_ADAW] + (size_t)l * D * MODW;
        f32x4 a0 = {0.f, 0.f, 0.f, 0.f}, a1 = {0.f, 0.f, 0.f, 0.f};
        for (int i = ks * 64; i < ks * 64 + 64; ++i) {
            const float c0 = C.ka->in[I_C][i], c1 = C.ka->in[I_CCTX][i];
            const float s0 = siluf_(c0), s1 = siluf_(c1);
            const f32x4 w = *(const f32x4*)(W + (size_t)i * MODW + col);
            a0 += w * s0; a1 += w * s1;
        }
        *(f32x4*)(modp + ((size_t)(l * KSPLIT + ks) * 2 + 0) * MODW + col) = a0;
        *(f32x4*)(modp + ((size_t)(l * KSPLIT + ks) * 2 + 1) * MODW + col) = a1;
    }
    f32x4* X = WSP(f32x4, OFF_X);
    const f32x4* xs = (const f32x4*)C.ka->in[I_X]; const f32x4* cs = (const f32x4*)C.ka->in[I_CTX];
    const size_t n_lat = (size_t)SEQ * D / 4, n_all = (size_t)MT * D / 4;
    for (size_t i = (size_t)C.bid * NT + C.tid; i < n_all; i += (size_t)C.G * NT) X[i] = i < n_lat ? xs[i] : cs[i - n_lat];
}
__device__ __forceinline__ void phase_ada_reduce(Ctx& C) {
    const float* modp = WSP(float, OFF_MODP); float* mod = WSP(float, OFF_MOD);
    for (int e = C.bid * NT + C.tid; e < DEPTH * 2 * MODW; e += C.G * NT) {
        const int l = e / (2 * MODW), s = (e / MODW) % 2, j = e % MODW;
        float a = C.ka->in[I_ADAB][(size_t)l * MODW + j];
        for (int ks = 0; ks < KSPLIT; ++ks) a += modp[((size_t)(l * KSPLIT + ks) * 2 + s) * MODW + j];
        mod[e] = a;
    }
}
__device__ __forceinline__ const float* mod_ptr(Ctx& C, int l, int s, int idx) { return WSP(float, OFF_MOD) + ((size_t)(l * 2 + s) * NMOD + idx) * D; }

__device__ __forceinline__ void phase_norm(Ctx& C, int l, const float* gw  , int shift_idx) {
    const int gwv = C.bid * NWAVES + C.wave, NGW = C.G * NWAVES;
    const float* X = WSP(float, OFF_X); bf16_t* H = WSP(bf16_t, OFF_H);
    for (int r = gwv; r < MT; r += NGW) {
        const int s = r >= SEQ ? 1 : 0;
        const float* sh = mod_ptr(C, l, s, shift_idx); const float* sc = mod_ptr(C, l, s, shift_idx + 1);
        const f32x4* xr = (const f32x4*)(X + (size_t)r * D) + C.lane;
        f32x4 v[8]; float ss = 0.f;
#pragma unroll
        for (int j = 0; j < 8; ++j) { v[j] = xr[64 * j]; ss += (v[j].x * v[j].x + v[j].y * v[j].y) + (v[j].z * v[j].z + v[j].w * v[j].w); }
        const float rstd = rsqrtf(wave_sum(ss) * (1.0f / D) + EPS);
        u32x2* o8 = (u32x2*)(H + (size_t)r * D) + C.lane;
#pragma unroll
        for (int j = 0; j < 8; ++j) {
            const int c = (64 * j + C.lane) * 4;
            const f32x4 g4 = *(const f32x4*)(gw + c), s4 = *(const f32x4*)(sc + c), h4 = *(const f32x4*)(sh + c);
            const f32x4 y = (v[j] * rstd) * g4 * (s4 + 1.0f) + h4;
            u32x2 w; w.x = pk2(y.x, y.y); w.y = pk2(y.z, y.w); o8[64 * j] = w;
        }
    }
}

__device__ __forceinline__ void phase_rw_prep(Ctx& C, int l, int b0, int nb) {
    const float* P = WSP(float, OFF_P32); float* SCN = WSP(float, OFF_SCN); float* VV = WSP(float, OFF_VV); float* GS = WSP(float, OFF_GS);
    LAS float* lin = (LAS float*)C.lds;
    const float* taps = C.ka->in[I_RWSHIFT] + (size_t)l * 3 * RWC;
    const int c = C.tid, h = c >> 6, e = c & 63;
    const float kkw = C.ka->in[I_RWKK][l * 512 + c], kaw = C.ka->in[I_RWKA][l * 512 + c];
    for (int r = b0; r < MT; r += nb) {
        const bool hp = (r != 0 && r != SEQ), hn = (r != SEQ - 1 && r != MT - 1);
        const float* p0 = P + (size_t)r * P32W + RW_OFF;
        float xs[5];
#pragma unroll
        for (int q = 0; q < 5; ++q) {
            const int col = q * 512 + c;
            float v = 0.f;
            if (q < 4 || c < 256) {
                v = taps[RWC + col] * p0[col];
                if (hp) v += taps[col] * p0[col - P32W];
                if (hn) v += taps[2 * RWC + col] * p0[col + P32W];
            }
            xs[q] = v;
        }
        __syncthreads();
        if (c < 256) lin[c] = c < 128 ? tanhf(xs[4]) : xs[4];
        __syncthreads();
        const float rr = xs[0], kk_raw = xs[1], vv = xs[2], gg = xs[3];
        const float kk0 = kk_raw * kkw;
        const float kkn = kk0 * rsqrtf(wave_sum(kk0 * kk0) + EPS);
        VV[(size_t)r * 512 + c] = vv; GS[(size_t)r * 512 + c] = sigmoidf_(gg);
#pragma unroll
        for (int d = 0; d < 2; ++d) {
            const float* w2 = C.ka->in[I_RWW2] + ((size_t)(l * 2 + d) * 64) * 512 + c;
            const float* a2 = C.ka->in[I_RWA2] + ((size_t)(l * 2 + d) * 64) * 512 + c;
            float z = C.ka->in[I_RWW0][(l * 2 + d) * 512 + c], az = C.ka->in[I_RWA0][(l * 2 + d) * 512 + c];
#pragma unroll 8
            for (int j = 0; j < 64; ++j) { z += lin[d * 64 + j] * w2[(size_t)j * 512]; az += lin[128 + d * 64 + j] * a2[(size_t)j * 512]; }
            const float y = -z; const float sp = fmaxf(y, 0.f) + log1pf(expf(-fabsf(y)));
            const float lw = -sp - 0.5f;
            const float decay = expf(-expf(lw));
            const float a = sigmoidf_(az);
            const float kd = kk_raw * (1.0f + (a - 1.0f) * kaw);
            float* o = SCN + ((size_t)((d * 8 + h) * MT + row_seq(d, r))) * 320 + e;
            o[0] = decay; o[64] = kkn; o[128] = a * kkn; o[192] = kd; o[256] = rr;
        }
    }
}

__device__ __forceinline__ void phase_attn_prep(Ctx& C, int l, int w0, int nw) {
    bf16_t* PA = WSP(bf16_t, OFF_PA);
    const int e = C.lane;
    const float na_qn = C.ka->in[I_NAQN][l * 64 + e], na_kn = C.ka->in[I_NAKN][l * 64 + e], wa_qn = C.ka->in[I_WAQN][l * 64 + e], wa_kn = C.ka->in[I_WAKN][l * 64 + e];
    const int m16 = e & 15;
    const float inv = powf(10000.0f, -(float)m16 / 16.0f);
    for (long uidx = w0; uidx < (long)MT * 26; uidx += nw) {
        const int r = (int)(uidx / 26), v = (int)(uidx % 26);
        int col; float nwt, scl; bool rope;
        if (v < 8) { col = v * 64; nwt = na_qn; scl = 0.125f; rope = false; }
        else if (v < 16) { col = 512 + (v - 8) * 64; nwt = na_kn; scl = 1.0f; rope = false; }
        else if (v < 24) { col = 1536 + (v - 16) * 64; nwt = wa_qn; scl = 0.125f; rope = true; }
        else { col = 2048 + (v - 24) * 64; nwt = wa_kn; scl = 1.0f; rope = true; }
        bf16_t* p = PA + (size_t)r * PAW + col + e;
        const float x = bf2f(*p);
        const float ss = wave_sum(x * x);
        float y = x * rsqrtf(ss * (1.0f / 64.0f) + EPS) * nwt * scl;
        if (rope && r < SEQ) {
            const int pos = (e >> 5) ? (r & 63) : (r >> 6);
            const float ang = (float)pos * inv;
            float sn, cs; sincosf(ang, &sn, &cs);
            const bool lo = (e & 31) < 16;
            const float yp = __shfl(y, lo ? e + 16 : e - 16);
            y = lo ? (y * cs - yp * sn) : (yp * sn + y * cs);
        }
        *p = (bf16_t)f2bf(y);
    }
}

__device__ __forceinline__ float hg_lb(Ctx& C, int l, int d, int c) {
    if (l == 0) return 0.f;
    const float a0 = C.ka->in[I_HGLB][(size_t)(d * DEPTH + 0) * 512 + c], a1 = C.ka->in[I_HGLB][(size_t)(d * DEPTH + 1) * 512 + c];
    const float m = fmaxf(a0, a1); const float e0 = expf(a0 - m), e1 = expf(a1 - m);
    return e1 / (e0 + e1);
}
__device__ __forceinline__ void phase_hg_A(Ctx& C, int l, int b0, int nb) {
    const float* P = WSP(float, OFF_P32); float* HGL = WSP(float, OFF_HGL); float* HGD = WSP(float, OFF_HGD);
    LAS float* Ii = (LAS float*)C.lds;
    LAS float* LF = Ii + 64 * 128;
    LAS float* KD = LF + 64 * 128;
    const int k = C.tid & 127, vq = C.tid >> 7;
    for (int u = b0; u < 2 * 4 * NCH; u += nb) {
        const int d = u / (4 * NCH), h = (u / NCH) % 4, c = u % NCH;
        const float lb = hg_lb(C, l, d, h * 128 + k);
        __syncthreads();
#pragma unroll 4
        for (int i = 0; i < 16; ++i) {
            const int s = 16 * vq + i; const int row = seq_row(d, 64 * c + s);
            const float* pr = P + (size_t)row * P32W;
            Ii[s * 128 + k] = pr[1536 + h * 128 + k];
            const float fr = pr[512 + d * 512 + h * 128 + k];
            const float f = lb + (1.0f - lb) * sigmoidf_(fr);
            LF[s * 128 + k] = logf(f); KD[s * 128 + k] = 1.0f - f;
        }
        __syncthreads();
        float bend = 0.f;
        for (int s = 0; s < 64; ++s) bend += LF[s * 128 + k];
        float acc[32];
#pragma unroll
        for (int j = 0; j < 32; ++j) acc[j] = 0.f;
        float b = 0.f;
        for (int s = 0; s < 64; ++s) {
            b += LF[s * 128 + k];
            const float w = KD[s * 128 + k] * expf(bend - b);
            const LAS f32x4* iv = (const LAS f32x4*)(Ii + s * 128 + 32 * vq);
#pragma unroll
            for (int j = 0; j < 8; ++j) { const f32x4 x = iv[j]; acc[4 * j] += w * x.x; acc[4 * j + 1] += w * x.y; acc[4 * j + 2] += w * x.z; acc[4 * j + 3] += w * x.w; }
        }
        float* o = HGL + ((size_t)((d * 4 + h) * NCH + c) * 128 + k) * 128 + 32 * vq;
#pragma unroll
        for (int j = 0; j < 8; ++j) *(f32x4*)(o + 4 * j) = (f32x4){acc[4 * j], acc[4 * j + 1], acc[4 * j + 2], acc[4 * j + 3]};
        if (vq == 0) HGD[(size_t)((d * 4 + h) * NCH + c) * 128 + k] = expf(bend);
    }
}
__device__ __forceinline__ void phase_hg_B(Ctx& C, int b0, int nb) {
    float* HGL = WSP(float, OFF_HGL); const float* HGD = WSP(float, OFF_HGD);
    for (int e = b0 * NT + C.tid; e < 8 * 16384; e += nb * NT) {
        const int dh = e >> 14, kv = e & 16383, k = kv >> 7;
        float st = 0.f;
        float* p = HGL + (size_t)dh * NCH * 16384 + kv; const float* dp = HGD + (size_t)dh * NCH * 128 + k;
#pragma unroll 4
        for (int c = 0; c < NCH; ++c) { const float Lc = p[(size_t)c * 16384], Dc = dp[c * 128]; p[(size_t)c * 16384] = st; st = Dc * st + Lc; }
    }
}
__device__ __forceinline__ void phase_hg_C(Ctx& C, int l, int b0, int nb) {
    const float* P = WSP(float, OFF_P32); const float* HGL = WSP(float, OFF_HGL); bf16_t* YB = WSP(bf16_t, OFF_YB);
    constexpr int LDP = 132, LDA = 68;
    LAS float* Q = (LAS float*)C.lds;
    LAS float* B = Q + 64 * LDP;
    LAS float* KD = B + 64 * LDP;
    LAS float* ATT = KD + 64 * LDP;
    LAS float* RED = ATT + 64 * LDA;
    const int k = C.tid & 127, tq = C.tid >> 7;
    for (int u = b0; u < 4 * NCH; u += nb) {
        const int h = u / NCH, tc = u % NCH;
        float o[16];
#pragma unroll
        for (int j = 0; j < 16; ++j) o[j] = 0.f;
#pragma unroll 1
        for (int d = 0; d < 2; ++d) {
            const float lb = hg_lb(C, l, d, h * 128 + k);
            const int cd = d == 0 ? (tc + 4) % NCH : (NCH - 1 - tc);
            __syncthreads();
#pragma unroll 4
            for (int i = 0; i < 16; ++i) {
                const int rl = 16 * tq + i; const float* pr = P + (size_t)(64 * tc + rl) * P32W;
                Q[rl * LDP + k] = pr[h * 128 + k];
                const float fr = pr[512 + d * 512 + h * 128 + k];
                const float f = lb + (1.0f - lb) * sigmoidf_(fr);
                B[rl * LDP + k] = logf(f); KD[rl * LDP + k] = 1.0f - f;
            }
            __syncthreads();
            if (C.tid < 128) {
                float b = 0.f;
                if (d == 0) { for (int rl = 0; rl < 64; ++rl) { b += B[rl * LDP + k]; B[rl * LDP + k] = b; } }
                else { for (int rl = 63; rl >= 0; --rl) { b += B[rl * LDP + k]; B[rl * LDP + k] = b; } }
            }
            __syncthreads();
            {
                const int t = C.tid >> 3, sg = C.tid & 7;
                float a[8];
#pragma unroll
                for (int i = 0; i < 8; ++i) a[i] = 0.f;
                for (int kk = 0; kk < 128; kk += 4) {
                    const f32x4 qt = *(const LAS f32x4*)(Q + t * LDP + kk), bt = *(const LAS f32x4*)(B + t * LDP + kk);
#pragma unroll
                    for (int i = 0; i < 8; ++i) {
                        const int s = sg + 8 * i;
                        const f32x4 ks = *(const LAS f32x4*)(KD + s * LDP + kk), bs = *(const LAS f32x4*)(B + s * LDP + kk);
                        a[i] += qt.x * ks.x * __expf(fminf(bt.x - bs.x, 0.f)) + qt.y * ks.y * __expf(fminf(bt.y - bs.y, 0.f))
                              + qt.z * ks.z * __expf(fminf(bt.z - bs.z, 0.f)) + qt.w * ks.w * __expf(fminf(bt.w - bs.w, 0.f));
                    }
                }
#pragma unroll
                for (int i = 0; i < 8; ++i) { const int s = sg + 8 * i; const bool valid = d == 0 ? (s <= t) : (s >= t); ATT[t * LDA + s] = valid ? a[i] : 0.f; }
            }
            __syncthreads();
            LAS float* Iv = KD;
#pragma unroll 4
            for (int i = 0; i < 16; ++i) {
                const int rl = 16 * tq + i;
                Iv[rl * 128 + k] = P[(size_t)(64 * tc + rl) * P32W + 1536 + h * 128 + k];
                Q[rl * LDP + k] = Q[rl * LDP + k] * __expf(B[rl * LDP + k]);
            }
            __syncthreads();
            for (int s = 0; s < 64; s += 4) {
                const float i0 = Iv[(s + 0) * 128 + k], i1 = Iv[(s + 1) * 128 + k], i2 = Iv[(s + 2) * 128 + k], i3 = Iv[(s + 3) * 128 + k];
#pragma unroll
                for (int j = 0; j < 16; ++j) { const f32x4 a4 = *(const LAS f32x4*)(ATT + (16 * tq + j) * LDA + s); o[j] += a4.x * i0 + a4.y * i1 + a4.z * i2 + a4.w * i3; }
            }
            const float* Sp = HGL + (size_t)((d * 4 + h) * NCH + cd) * 16384 + k;
            for (int kk = 0; kk < 128; kk += 4) {
                const float s0 = Sp[(size_t)(kk + 0) * 128], s1 = Sp[(size_t)(kk + 1) * 128], s2 = Sp[(size_t)(kk + 2) * 128], s3 = Sp[(size_t)(kk + 3) * 128];
#pragma unroll
                for (int j = 0; j < 16; ++j) { const f32x4 q4 = *(const LAS f32x4*)(Q + (16 * tq + j) * LDP + kk); o[j] += q4.x * s0 + q4.y * s1 + q4.z * s2 + q4.w * s3; }
            }
        }
        __syncthreads();
#pragma unroll
        for (int j = 0; j < 16; ++j) { const float ss = wave_sum(o[j] * o[j]); if (C.lane == 0) RED[C.wave * 16 + j] = ss; }
        __syncthreads();
        const float nw = C.ka->in[I_HGNORM][l * 512 + h * 128 + k];
#pragma unroll
        for (int j = 0; j < 16; ++j) {
            const int row = 64 * tc + 16 * tq + j;
            const float tot = RED[(2 * tq) * 16 + j] + RED[(2 * tq + 1) * 16 + j];
            const float g = P[(size_t)row * P32W + 2048 + h * 128 + k];
            const float y = o[j] * rsqrtf(tot * (1.0f / 128.0f) + EPS) * nw * siluf_(g);
            YB[(size_t)row * 512 + h * 128 + k] = (bf16_t)f2bf(y);
        }
    }
}

template <int CTRL> __device__ __forceinline__ float dppf(float x) { return __builtin_bit_cast(float, __builtin_amdgcn_mov_dpp(__builtin_bit_cast(int, x), CTRL, 0xf, 0xf, true)); }
__device__ __forceinline__ float row16_sum(float x) { x += dppf<0xB1>(x); x += dppf<0x4E>(x); x += dppf<0x124>(x); x += dppf<0x128>(x); return x; }
constexpr int RW_NJOBS = 64;
__device__ __forceinline__ void phase_rw_scan(Ctx& C, int b0, int nb) {
    const float* SCN = WSP(float, OFF_SCN); const float* VV = WSP(float, OFF_VV); float* RO = WSP(float, OFF_RO);
    constexpr int STEPS = 32, SW = 384, NCHK = MT / STEPS;
    LAS float* buf = (LAS float*)C.lds;
    for (int job = b0; job < RW_NJOBS; job += nb) {
        const int d = job >> 5, h = (job >> 2) & 7, rq = job & 3;
        const float* src = SCN + (size_t)((d * 8 + h) * MT) * 320;
        const int lt = C.tid - 256;
        __syncthreads();
        if (C.wave >= 4) {
#pragma unroll
            for (int i = 0; i < 12; ++i) { const int q = lt + 256 * i, st = q / 96, w = q % 96;
                const f32x4 v = w < 80 ? *(const f32x4*)(src + (size_t)st * 320 + w * 4) : *(const f32x4*)(VV + (size_t)seq_row(d, st) * 512 + h * 64 + (w - 80) * 4);
                *(LAS f32x4*)(buf + q * 4) = v; }
        }
        __syncthreads();
        float S0 = 0.f, S1 = 0.f, S2 = 0.f, S3 = 0.f;
        const int rw = C.lane >> 4, ks = C.lane & 15, srow = rq * 16 + C.wave * 4 + rw;
#pragma unroll 1
        for (int ci = 0; ci < NCHK; ++ci) {
            if (C.wave >= 4) {
                if (ci + 1 < NCHK) {
                    f32x4 regs[12];
#pragma unroll
                    for (int i = 0; i < 12; ++i) { const int q = lt + 256 * i, st = q / 96, w = q % 96, j = STEPS * (ci + 1) + st;
                        regs[i] = w < 80 ? *(const f32x4*)(src + (size_t)j * 320 + w * 4) : *(const f32x4*)(VV + (size_t)seq_row(d, j) * 512 + h * 64 + (w - 80) * 4); }
#pragma unroll
                    for (int i = 0; i < 12; ++i) { const int q = lt + 256 * i; *(LAS f32x4*)(buf + ((ci + 1) & 1) * STEPS * SW + q * 4) = regs[i]; }
                }
            } else {
                const LAS float* bb = buf + (ci & 1) * STEPS * SW;
                const LAS float* sp = bb + 4 * ks;
                f32x4 w = *(const LAS f32x4*)(sp), kk = *(const LAS f32x4*)(sp + 64), ak = *(const LAS f32x4*)(sp + 128), kd = *(const LAS f32x4*)(sp + 192), rr = *(const LAS f32x4*)(sp + 256);
                float vv = bb[320 + srow];
#pragma unroll 1
                for (int hs = 0; hs < 2; ++hs) {
                    float ocol = 0.f;
#pragma unroll 4
                    for (int s16 = 0; s16 < 16; ++s16) {
                        const int stn = (hs * 16 + s16 + 1) & 31;
                        const LAS float* spn = bb + stn * SW + 4 * ks;
                        const f32x4 wn = *(const LAS f32x4*)(spn), kkn = *(const LAS f32x4*)(spn + 64), akn = *(const LAS f32x4*)(spn + 128), kdn = *(const LAS f32x4*)(spn + 192), rrn = *(const LAS f32x4*)(spn + 256);
                        const float vvn = bb[stn * SW + 320 + srow];
                        __builtin_amdgcn_sched_barrier(0);
                        const float dot = row16_sum((S0 * kk.x + S1 * kk.y) + (S2 * kk.z + S3 * kk.w));
                        S0 = S0 * w.x + (vv * kd.x - dot * ak.x); S1 = S1 * w.y + (vv * kd.y - dot * ak.y);
                        S2 = S2 * w.z + (vv * kd.z - dot * ak.z); S3 = S3 * w.w + (vv * kd.w - dot * ak.w);
                        const float od = row16_sum((S0 * rr.x + S1 * rr.y) + (S2 * rr.z + S3 * rr.w));
                        ocol = (ks == s16) ? od : ocol;
                        w = wn; kk = kkn; ak = akn; kd = kdn; rr = rrn; vv = vvn;
                    }
                    RO[((size_t)d * MT + seq_row(d, STEPS * ci + hs * 16 + ks)) * 512 + h * 64 + srow] = ocol;
                }
            }
            __syncthreads();
        }
    }
}
__device__ __forceinline__ void phase_rw_finish(Ctx& C, int l, int w0, int nw) {
    const float* SCN = WSP(float, OFF_SCN); const float* VV = WSP(float, OFF_VV); const float* GS = WSP(float, OFF_GS); const float* RO = WSP(float, OFF_RO);
    bf16_t* YB = WSP(bf16_t, OFF_YB) + (size_t)1 * MT * 512;
    const int e = C.lane;
    for (int uidx = w0; uidx < MT * 8; uidx += nw) {
        const int r = uidx >> 3, h = uidx & 7, c = h * 64 + e;
        const float o = RO[(size_t)r * 512 + c] + RO[((size_t)MT + r) * 512 + c];
        const float mu = wave_sum(o) * (1.0f / 64.0f);
        const float dv = o - mu;
        const float var = wave_sum(dv * dv) * (1.0f / 64.0f);
        const float on = dv * rsqrtf(var + RW_GN_EPS) * C.ka->in[I_RWLNW][l * 512 + c] + C.ka->in[I_RWLNB][l * 512 + c];
        const float* s0 = SCN + ((size_t)((0 * 8 + h) * MT + row_seq(0, r))) * 320 + e;
        const float* s1 = SCN + ((size_t)((1 * 8 + h) * MT + row_seq(1, r))) * 320 + e;
        const float kdsum = s0[192] + s1[192], rr = s0[256];
        const float bonus = wave_sum(rr * kdsum * C.ka->in[I_RWRK][l * 512 + c]);
        const float y = (on + bonus * VV[(size_t)r * 512 + c]) * GS[(size_t)r * 512 + c];
        YB[(size_t)r * 512 + c] = (bf16_t)f2bf(y);
    }
}

typedef float f32x16 __attribute__((ext_vector_type(16)));
typedef float f32x4u __attribute__((ext_vector_type(4), aligned(4)));
#define MFMA32(a, b, c) __builtin_amdgcn_mfma_f32_32x32x16_bf16((a), (b), (c), 0, 0, 0)
__device__ __forceinline__ float swap32_sum(float x) { auto t = __builtin_amdgcn_permlane32_swap(__float_as_uint(x), __float_as_uint(x), false, false); return __uint_as_float(t[0]) + __uint_as_float(t[1]); }
__device__ __forceinline__ f32x16 qk_tile(const bf16_t* Kp  , const bf16x8 (&qf)[4], int r, int h) {
    f32x16 acc;
#pragma unroll
    for (int i = 0; i < 16; ++i) acc[i] = 0.f;
    const bf16_t* p = Kp + (size_t)r * PAW + 8 * h;
#pragma unroll
    for (int s = 0; s < 4; ++s) { const bf16x8 kf = *(const bf16x8*)(p + 16 * s); acc = MFMA32(kf, qf[s], acc); }
    return acc;
}
__device__ __forceinline__ void pv_tile(f32x16 (&o)[2], const bf16_t* VTp  , const f32x16& p, int r, int h) {
#pragma unroll
    for (int s = 0; s < 2; ++s) {
        u32x4 pw; pw.x = pg8::cvt_pk_bf16(p[8 * s + 0], p[8 * s + 1]); pw.y = pg8::cvt_pk_bf16(p[8 * s + 2], p[8 * s + 3]); pw.z = pg8::cvt_pk_bf16(p[8 * s + 4], p[8 * s + 5]); pw.w = pg8::cvt_pk_bf16(p[8 * s + 6], p[8 * s + 7]);
        const bf16x8 pb = __builtin_bit_cast(bf16x8, pw);
#pragma unroll
        for (int blk = 0; blk < 2; ++blk) {
            const bf16_t* vp = VTp + (size_t)(32 * blk + r) * MT + 16 * s + 4 * h;
            const u32x2 lo = *(const u32x2*)vp, hi = *(const u32x2*)(vp + 8);
            u32x4 vw; vw.x = lo.x; vw.y = lo.y; vw.z = hi.x; vw.w = hi.y;
            o[blk] = MFMA32(__builtin_bit_cast(bf16x8, vw), pb, o[blk]);
        }
    }
}
#define KOFF(reg) (((reg) & 3) + 8 * ((reg) >> 2))
__device__ __forceinline__ void phase_attn(Ctx& C, int l, int w0, int nw) {
    const bf16_t* PA = WSP(bf16_t, OFF_PA); bf16_t* YB = WSP(bf16_t, OFF_YB);
    const bf16_t* VTN = WSP(bf16_t, OFF_VTN); const bf16_t* VTW = WSP(bf16_t, OFF_VTW);
    const float* PB = WSP(float, OFF_PB); const float* MREF = WSP(float, OFF_MREF);
    const int r = C.lane & 31, h = C.lane >> 5;
    constexpr int NJT = 2048 + 64;
    for (int job = w0; job < 2 * NJT; job += nw) {
        const int type = __builtin_amdgcn_readfirstlane(job / NJT), jj = __builtin_amdgcn_readfirstlane(job % NJT), qt = jj >> 3, hd = jj & 7;
        const int q0 = qt * 32;
        const bool lat = qt < 256;
        const float Mr = MREF[type];
        bf16x8 qf[4];
        { const bf16_t* qp = PA + (size_t)(q0 + r) * PAW + (type == 0 ? 0 : 1536) + hd * 64 + 8 * h;
#pragma unroll
          for (int s = 0; s < 4; ++s) qf[s] = *(const bf16x8*)(qp + 16 * s); }
        f32x16 o[2];
#pragma unroll
        for (int i = 0; i < 16; ++i) { o[0][i] = 0.f; o[1][i] = 0.f; }
        float lsum = 0.f;
        const int kcol = type == 0 ? 512 + hd * 64 : 2048 + (hd >> 2) * 64;
        const bf16_t* VT = type == 0 ? VTN + (size_t)(hd * 64) * MT : VTW + (size_t)((hd >> 2) * 64) * MT;
        if (type == 0) {
            if (lat) {
                const int i = qt >> 1, j = (qt & 1) * 32 + r;
                int rs = i - 4; rs = rs < 0 ? 0 : (rs > 120 ? 120 : rs);
                int cs = j - 8; cs = cs < 0 ? 0 : (cs > 48 ? 48 : cs);
#pragma unroll 1
                for (int t = 0; t < 16; ++t) {
                    const int a = t >> 1, cc = t & 1;
                    const int key0 = (rs + a) * 64 + 32 * cc;
                    const f32x16 acc = qk_tile(PA + (size_t)key0 * PAW + kcol, qf, r, h);
                    const float* brow = PB + (size_t)(hd * 15 + (rs + a - i + 7)) * 128 + (32 * cc + 4 * h - j + 63);
                    const int lo = cs - 32 * cc - 4 * h;
                    f32x16 p;
#pragma unroll
                    for (int g = 0; g < 4; ++g) {
                        const f32x4u b4 = *(const f32x4u*)(brow + 8 * g);
#pragma unroll
                        for (int q = 0; q < 4; ++q) { const int reg = 4 * g + q; const bool valid = (unsigned)(KOFF(reg) - lo) < 16u;
                            const float e = __expf(acc[reg] + b4[q] - Mr); p[reg] = valid ? e : 0.f; lsum += p[reg]; }
                    }
                    pv_tile(o, VT + key0, p, r, h);
                }
            }
        } else {
            if (lat) {
#pragma unroll 1
                for (int dl = -4; dl <= 4; ++dl) {
                    const int kt = qt + dl;
                    if (kt < 0 || kt > 255) continue;
                    const int key0 = kt * 32;
                    const f32x16 acc = qk_tile(PA + (size_t)key0 * PAW + kcol, qf, r, h);
                    f32x16 p;
#pragma unroll
                    for (int reg = 0; reg < 16; ++reg) { const int kr = KOFF(reg) + 4 * h; const bool valid = dl == -4 ? (kr >= r) : (dl == 4 ? (kr <= r) : true);
                        const float e = __expf(acc[reg] - Mr); p[reg] = valid ? e : 0.f; lsum += p[reg]; }
                    pv_tile(o, VT + key0, p, r, h);
                }
            }
        }
#pragma unroll 1
        for (int t = 0; t < CTX / 32; ++t) {
            const int key0 = SEQ + 32 * t;
            const f32x16 acc = qk_tile(PA + (size_t)key0 * PAW + kcol, qf, r, h);
            f32x16 p;
#pragma unroll
            for (int reg = 0; reg < 16; ++reg) { p[reg] = __expf(acc[reg] - Mr); lsum += p[reg]; }
            pv_tile(o, VT + key0, p, r, h);
        }
        float ltot = swap32_sum(lsum);
        if (type == 1) ltot += __expf(C.ka->in[I_WASINK][l * 8 + hd] - Mr);
        const float inv = 1.0f / ltot;
        bf16_t* yp = YB + (size_t)(2 + type) * MT * 512 + (size_t)(q0 + r) * 512 + hd * 64 + 4 * h;
#pragma unroll
        for (int blk = 0; blk < 2; ++blk)
#pragma unroll
            for (int g = 0; g < 4; ++g) {
                u32x2 w; w.x = pg8::cvt_pk_bf16(o[blk][4 * g] * inv, o[blk][4 * g + 1] * inv); w.y = pg8::cvt_pk_bf16(o[blk][4 * g + 2] * inv, o[blk][4 * g + 3] * inv);
                *(u32x2*)(yp + 32 * blk + 8 * g) = w;
            }
    }
}
__device__ __forceinline__ void phase_attn_tables(Ctx& C, int l, int w0, int nw) {
    const bf16_t* PA = WSP(bf16_t, OFF_PA); bf16_t* VTN = WSP(bf16_t, OFF_VTN); bf16_t* VTW = WSP(bf16_t, OFF_VTW);
    LAS unsigned char* tile = C.lds + C.wave * 9216;
    const int lane = C.lane;
    for (int u = w0; u < 10 * NCH; u += nw) {
        const int hd = u / NCH, tt = u % NCH, t0 = tt * 64;
        const int vcol = hd < 8 ? 1024 + hd * 64 : 2176 + (hd - 8) * 64;
#pragma unroll
        for (int it = 0; it < 8; ++it) { const int row = 8 * it + (lane >> 3), ch = lane & 7;
            *(LAS u32x4*)(tile + row * 144 + ch * 16) = *(const u32x4*)(PA + (size_t)(t0 + row) * PAW + vcol + ch * 8); }
        LDS_WAIT(); asm volatile("" ::: "memory");
        bf16_t* dst = (hd < 8 ? VTN + (size_t)(hd * 64 + lane) * MT : VTW + (size_t)((hd - 8) * 64 + lane) * MT) + t0;
#pragma unroll
        for (int it = 0; it < 8; ++it) {
            unsigned e[8];
#pragma unroll
            for (int j = 0; j < 8; ++j) e[j] = *(const LAS bf16_t*)(tile + (8 * it + j) * 144 + 2 * lane);
            u32x4 w; w.x = e[0] | (e[1] << 16); w.y = e[2] | (e[3] << 16); w.z = e[4] | (e[5] << 16); w.w = e[6] | (e[7] << 16);
            *(u32x4*)(dst + 8 * it) = w;
        }
        LDS_WAIT(); asm volatile("" ::: "memory");
    }
    float* PB = WSP(float, OFF_PB);
    const float* rpb = C.ka->in[I_NARPB] + (size_t)l * 8 * 15 * 31;
    for (int idx = w0 * 64 + lane; idx < 8 * 15 * 128; idx += nw * 64) { const int x = idx & 127, hr = idx >> 7; PB[idx] = (x >= 48 && x < 79) ? rpb[hr * 31 + x - 48] : 0.f; }
    if (w0 == 0) {
        float mb = 0.f;
        for (int i = lane; i < 8 * 15 * 31; i += 64) mb = fmaxf(mb, fabsf(rpb[i]));
        mb = wave_max(mb);
        const float nq = wave_max(fabsf(C.ka->in[I_NAQN][l * 64 + lane])), nk = wave_max(fabsf(C.ka->in[I_NAKN][l * 64 + lane]));
        const float wq = wave_max(fabsf(C.ka->in[I_WAQN][l * 64 + lane])), wk = wave_max(fabsf(C.ka->in[I_WAKN][l * 64 + lane]));
        const float sk = wave_max(lane < 8 ? C.ka->in[I_WASINK][l * 8 + lane] : -1e30f);
        if (lane == 0) { float* M = WSP(float, OFF_MREF); M[0] = 8.08f * nq * nk + mb; M[1] = fmaxf(8.08f * wq * wk, sk); }
    }
}

__device__ __forceinline__ void phase_combine(Ctx& C) {
    const bf16_t* PROJ = WSP(bf16_t, OFF_P32); bf16_t* MG = WSP(bf16_t, OFF_H);
    const size_t n8 = (size_t)MT * D / 8;
    for (size_t i = (size_t)C.bid * NT + C.tid; i < n8; i += (size_t)C.G * NT) {
        const size_t r = i / (D / 8), c8 = i % (D / 8);
        float a[8];
#pragma unroll
        for (int j = 0; j < 8; ++j) a[j] = 0.f;
#pragma unroll
        for (int g = 0; g < 4; ++g) {
            const u32x4 w = *(const u32x4*)(PROJ + r * GLW + g * D + c8 * 8);
            a[0] += bf2f(w.x & 0xffffu); a[1] += bf2f(w.x >> 16); a[2] += bf2f(w.y & 0xffffu); a[3] += bf2f(w.y >> 16);
            a[4] += bf2f(w.z & 0xffffu); a[5] += bf2f(w.z >> 16); a[6] += bf2f(w.w & 0xffffu); a[7] += bf2f(w.w >> 16);
        }
        u32x4 o; o.x = pk2(a[0], a[1]); o.y = pk2(a[2], a[3]); o.z = pk2(a[4], a[5]); o.w = pk2(a[6], a[7]);
        *(u32x4*)(MG + r * D + c8 * 8) = o;
    }
}

constexpr int PH_PRO = 2, PH_PER_LAYER = 14, N_PHASES = PH_PRO + DEPTH * PH_PER_LAYER;

__global__ void __launch_bounds__(NT, 2) mk_fwd(Args args) {
    extern __shared__ __attribute__((aligned(16))) unsigned char lds_raw[];
    Ctx C;
    C.lds = (LAS unsigned char*)lds_raw;
    C.tid = threadIdx.x; C.lane = C.tid & 63; C.wave = __builtin_amdgcn_readfirstlane(C.tid >> 6);
    C.bid = blockIdx.x; C.G = gridDim.x;
    C.ka = (const Args __attribute__((address_space(4)))*)__builtin_amdgcn_kernarg_segment_ptr(); C.out = args.out; C.ws = args.ws;
    volatile LAS unsigned* MISC = (volatile LAS unsigned*)(C.lds + MISC_OFF);
    for (int u = C.tid; u < (LDS_BYTES - RING_BYTES) / 4; u += NT) ((LAS unsigned*)(C.lds + RING_BYTES))[u] = 0u;
    __syncthreads();
    const int lo = args.ph_lo, hi = args.ph_hi;
    XcdBarrier bar; bar.bar = WSP(unsigned, OFF_CTL) + 4096; bar.x = 0; bar.st = nullptr;
    const bool multi = (hi - lo) > 1;
    if (multi) bar = xcd_barrier_post(WSP(unsigned, OFF_CTL) + 4096, MISC + 8);
#ifndef PH_MASK
#define PH_MASK 0xFFFF
#endif
#ifndef PRO_MASK
#define PRO_MASK 3
#endif
#define IN(k) (lo <= (k) && (k) < hi)
#define LEN(j) (((PH_MASK) >> (j)) & 1)
#define SEAM(k) do { if (IN(k) && IN((k) + 1)) xcd_barrier(bar); } while (0)

    if ((PRO_MASK & 1) && IN(0)) { relaunder(C); phase_convert(C, 0); phase_ada_partial(C); } SEAM(0);
    if ((PRO_MASK & 2) && IN(1)) { relaunder(C); phase_ada_reduce(C); } SEAM(1);

#pragma unroll
    for (int l = 0; l < DEPTH; ++l) {
        const int pb = PH_PRO + l * PH_PER_LAYER;
        if (LEN(0) && IN(pb + 0)) { relaunder(C); if (l > 0) phase_convert(C, l); phase_norm(C, l, C.ka->in[I_NF1] + (size_t)l * D, 0); } SEAM(pb + 0);
        if (LEN(1) && IN(pb + 1)) { relaunder(C);
            pg8::Gemm g{WSP(bf16_t, OFF_H), WSP(bf16_t, OFF_WI1), MT, 2 * DFF, D, 1 << 20, 0};
            pg8::StaticOrder S; S.init(MT, 2 * DFF, C.G, C.bid);
            pg8::EpiSwiGLU E{WSP(bf16_t, OFF_G)};
            pg8::gemm_phase<pg8::EpiSwiGLU, true, false>(C.lds, g, S, E, C.tid);
        } SEAM(pb + 1);
        if (LEN(2) && IN(pb + 2)) { relaunder(C);
            pg8::Gemm g{WSP(bf16_t, OFF_G), WSP(bf16_t, OFF_WO1), MT, D, DFF, 1 << 20, 0};
            pg8::StaticOrder S; S.init(MT, D, C.G, C.bid);
            pg8::EpiResid<true> E{WSP(float, OFF_X), mod_ptr(C, l, 0, 2), mod_ptr(C, l, 1, 2), nullptr};
            pg8::gemm_phase<pg8::EpiResid<true>, true, false>(C.lds, g, S, E, C.tid);
        } SEAM(pb + 2);
        if (LEN(3) && IN(pb + 3)) { relaunder(C); phase_norm(C, l, C.ka->in[I_NMIX] + (size_t)l * D, 3); } SEAM(pb + 3);
        if (LEN(4) && IN(pb + 4)) { relaunder(C);
            pg8::Gemm g{WSP(bf16_t, OFF_H), WSP(bf16_t, OFF_WIN), MT, P32W + PAW, D, 1 << 20, 0};
            pg8::StaticOrder S; S.init(MT, P32W + PAW, C.G, C.bid);
            pg8::EpiWin E{WSP(float, OFF_P32), WSP(bf16_t, OFF_PA), WSP(bf16_t, OFF_GL), 0};
            pg8::gemm_phase<pg8::EpiWin, true, false>(C.lds, g, S, E, C.tid);
        } SEAM(pb + 4);
        if (LEN(5) && IN(pb + 5)) { relaunder(C);
            phase_rw_prep(C, l, C.bid, C.G);
            __syncthreads();
            phase_attn_prep(C, l, C.bid * NWAVES + C.wave, C.G * NWAVES);
            phase_attn_tables(C, l, C.bid * NWAVES + C.wave, C.G * NWAVES);
            __syncthreads();
            phase_hg_A(C, l, C.bid, C.G);
        } SEAM(pb + 5);
        if (LEN(6) && IN(pb + 6)) { relaunder(C);
            if (C.G >= 256) {
                if (C.bid < RW_NJOBS) phase_rw_scan(C, C.bid, RW_NJOBS);
                else { const int b = C.bid - RW_NJOBS, n = C.G - RW_NJOBS; phase_hg_B(C, b, n); phase_attn(C, l, b * NWAVES + C.wave, n * NWAVES);
                    __syncthreads();
                    pg8::Gemm g{WSP(bf16_t, OFF_H), WSP(bf16_t, OFF_WIN) + (size_t)(P32W + PAW) * D, MT, GLW, D, 1 << 20, 0};
                    pg8::StaticOrder S; S.init(MT, GLW, n, b);
                    pg8::EpiWin E{WSP(float, OFF_P32), WSP(bf16_t, OFF_PA), WSP(bf16_t, OFF_GL), 28};
                    pg8::gemm_phase<pg8::EpiWin, true, false>(C.lds, g, S, E, C.tid); }
            } else {
                phase_rw_scan(C, C.bid, C.G); phase_hg_B(C, C.bid, C.G); phase_attn(C, l, C.bid * NWAVES + C.wave, C.G * NWAVES);
                __syncthreads();
                pg8::Gemm g{WSP(bf16_t, OFF_H), WSP(bf16_t, OFF_WIN) + (size_t)(P32W + PAW) * D, MT, GLW, D, 1 << 20, 0};
                pg8::StaticOrder S; S.init(MT, GLW, C.G, C.bid);
                pg8::EpiWin E{WSP(float, OFF_P32), WSP(bf16_t, OFF_PA), WSP(bf16_t, OFF_GL), 28};
                pg8::gemm_phase<pg8::EpiWin, true, false>(C.lds, g, S, E, C.tid);
            }
        } SEAM(pb + 6);
        if (LEN(7) && IN(pb + 7)) { relaunder(C); phase_hg_C(C, l, C.bid, C.G); phase_rw_finish(C, l, C.bid * NWAVES + C.wave, C.G * NWAVES); } SEAM(pb + 7);
        if (LEN(8) && IN(pb + 8)) { relaunder(C);
            pg8::Gemm g{WSP(bf16_t, OFF_YB), WSP(bf16_t, OFF_WBR), MT, 4 * D, 512, 8, (size_t)MT * 512};
            pg8::StaticOrder S; S.init(MT, 4 * D, C.G, C.bid);
            pg8::EpiMerge E{WSP(bf16_t, OFF_GL), WSP(bf16_t, OFF_P32)};
            pg8::gemm_phase<pg8::EpiMerge, true, false>(C.lds, g, S, E, C.tid);
        } SEAM(pb + 8);
        if (LEN(9) && IN(pb + 9)) { relaunder(C); phase_combine(C); } SEAM(pb + 9);
        if (LEN(10) && IN(pb + 10)) { relaunder(C);
            pg8::Gemm g{WSP(bf16_t, OFF_H), WSP(bf16_t, OFF_WOUT), MT, D, D, 1 << 20, 0};
            pg8::StaticOrder S; S.init(MT, D, C.G, C.bid);
            pg8::EpiResid<false> E{WSP(float, OFF_X), mod_ptr(C, l, 0, 5), mod_ptr(C, l, 1, 5), nullptr};
            pg8::gemm_phase<pg8::EpiResid<false>, true, false>(C.lds, g, S, E, C.tid);
        } SEAM(pb + 10);
        if (LEN(11) && IN(pb + 11)) { relaunder(C); phase_norm(C, l, C.ka->in[I_NF2] + (size_t)l * D, 6); } SEAM(pb + 11);
        if (LEN(12) && IN(pb + 12)) { relaunder(C);
            pg8::Gemm g{WSP(bf16_t, OFF_H), WSP(bf16_t, OFF_WI2), MT, 2 * DFF, D, 1 << 20, 0};
            pg8::StaticOrder S; S.init(MT, 2 * DFF, C.G, C.bid);
            pg8::EpiSwiGLU E{WSP(bf16_t, OFF_G)};
            pg8::gemm_phase<pg8::EpiSwiGLU, true, false>(C.lds, g, S, E, C.tid);
        } SEAM(pb + 12);
        if (LEN(13) && IN(pb + 13)) { relaunder(C);
            pg8::Gemm g{WSP(bf16_t, OFF_G), WSP(bf16_t, OFF_WO2), MT, D, DFF, 1 << 20, 0};
            pg8::StaticOrder S; S.init(MT, D, C.G, C.bid);
            pg8::EpiResid<true> E{WSP(float, OFF_X), mod_ptr(C, l, 0, 8), mod_ptr(C, l, 1, 8), l == DEPTH - 1 ? C.out : nullptr};
            pg8::gemm_phase<pg8::EpiResid<true>, true, false>(C.lds, g, S, E, C.tid);
        } SEAM(pb + 13);
    }
#undef IN
#undef SEAM
}

extern "C" void kernel_launch(void* const* d_in, const int* in_sizes, int n_in, void* d_out, int out_size, void* d_ws, size_t ws_size, hipStream_t stream) {
    static int grid = 0;
    if (grid == 0) {
        if (n_in != N_IN || out_size != SEQ * D || ws_size < WS_END) { fprintf(stderr, "kernel_launch: unexpected shapes (n_in %d out %d ws %zu)\n", n_in, out_size, ws_size); grid = -1; return; }
        int dev = 0, cus = 0;
        if (hipGetDevice(&dev) != hipSuccess || hipDeviceGetAttribute(&cus, hipDeviceAttributeMultiprocessorCount, dev) != hipSuccess) { grid = -1; return; }
        if (hipFuncSetAttribute((const void*)mk_fwd, hipFuncAttributeMaxDynamicSharedMemorySize, LDS_BYTES) != hipSuccess) { fprintf(stderr, "kernel_launch: hipFuncSetAttribute failed\n"); grid = -1; return; }
        (void)hipGetLastError();
        grid = cus;
    }
    if (grid < 0) return;
    (void)hipMemsetAsync((char*)d_ws + OFF_CTL, 0, CTL_BYTES, stream);
    Args a{};
    for (int i = 0; i < N_IN; ++i) a.in[i] = (const float*)d_in[i];
    a.out = (float*)d_out; a.ws = (unsigned char*)d_ws;
#if MK_ONE_LAUNCH
    a.ph_lo = 0; a.ph_hi = N_PHASES;
    hipLaunchKernelGGL(mk_fwd, dim3(grid), dim3(NT), LDS_BYTES, stream, a);
#else
    for (int ph = 0; ph < N_PHASES; ++ph) {
        a.ph_lo = ph; a.ph_hi = ph + 1;
        hipLaunchKernelGGL(mk_fwd, dim3(grid), dim3(NT), LDS_BYTES, stream, a);
    }
#endif
}
```

```cpp
#include <hip/hip_runtime.h>
#include <cstdio>
#include <cstdint>

#ifndef PROBE_MODE
#define PROBE_MODE 0
#endif
#ifndef MK_ONE_LAUNCH
#define MK_ONE_LAUNCH 1
#endif

#define LAS __attribute__((address_space(3)))
#define GAS __attribute__((address_space(1)))
typedef unsigned short bf16_t;
typedef short bf16x8 __attribute__((ext_vector_type(8)));
typedef float f32x4 __attribute__((ext_vector_type(4)));
typedef float f32x2 __attribute__((ext_vector_type(2)));
typedef unsigned u32x4 __attribute__((ext_vector_type(4)));
typedef unsigned u32x2 __attribute__((ext_vector_type(2)));

constexpr int D = 2048, SEQ = 8192, CTX = 256, MT = SEQ + CTX, DEPTH = 2, DFF = 5632, NMOD = 9, MODW = NMOD * D;
constexpr int GRID_W = 64;
constexpr int PTOT = 15360, P32W = 4864, PAW = 2304, GLW = 8192;
constexpr int HG_OFF = 0, RW_OFF = 2560, RWC = 2304;
constexpr int NCH = MT / 64;
constexpr int NWAVES = 8, NT = 512;
constexpr float EPS = 1e-6f, RW_GN_EPS = 64e-5f;

constexpr size_t MiB = 1u << 20;
constexpr size_t OFF_CTL = 0, CTL_BYTES = 1 * MiB;
constexpr size_t OFF_MOD = 1 * MiB;
constexpr size_t OFF_MODP = 2 * MiB;
constexpr size_t OFF_WI1 = 11 * MiB, OFF_WO1 = 55 * MiB, OFF_WIN = 77 * MiB, OFF_WBR = 137 * MiB, OFF_WOUT = 145 * MiB, OFF_WI2 = 153 * MiB, OFF_WO2 = 197 * MiB;
constexpr size_t OFF_X = 219 * MiB;
constexpr size_t OFF_H = 285 * MiB;
constexpr size_t OFF_G = 318 * MiB;
constexpr size_t OFF_P32 = 409 * MiB;
constexpr size_t OFF_PA = 566 * MiB;
constexpr size_t OFF_GL = 604 * MiB;
constexpr size_t OFF_HGL = 736 * MiB;
constexpr size_t OFF_HGD = 802 * MiB;
constexpr size_t OFF_SCN = 803 * MiB;
constexpr size_t OFF_VV = 968 * MiB;
constexpr size_t OFF_GS = 985 * MiB;
constexpr size_t OFF_RO = 1002 * MiB;
constexpr size_t OFF_YB = 1035 * MiB;
constexpr size_t OFF_VTN = 1068 * MiB;
constexpr size_t OFF_VTW = 1077 * MiB;
constexpr size_t OFF_PB = 1080 * MiB;
constexpr size_t OFF_MREF = OFF_PB + 65536;
constexpr size_t OFF_SPT = 1081 * MiB;
constexpr size_t WS_END = 1114 * MiB;
constexpr int KSPLIT = 32;

constexpr int LDS_BYTES = 147456;
constexpr int RING_BYTES = 131072;
constexpr int MISC_OFF = RING_BYTES + 320;

__device__ __forceinline__ float bf2f(unsigned b) { return __uint_as_float(b << 16); }
__device__ __forceinline__ unsigned f2bf(float f) { unsigned u = __float_as_uint(f); return (u + 0x7fffu + ((u >> 16) & 1u)) >> 16; }
__device__ __forceinline__ unsigned pk2(float lo, float hi) { return f2bf(lo) | (f2bf(hi) << 16); }
__device__ __forceinline__ float wave_sum(float v) {
#pragma unroll
    for (int o = 1; o < 64; o <<= 1) v += __shfl_xor(v, o);
    return v;
}
__device__ __forceinline__ float wave_max(float v) {
#pragma unroll
    for (int o = 1; o < 64; o <<= 1) v = fmaxf(v, __shfl_xor(v, o));
    return v;
}
__device__ __forceinline__ float sigmoidf_(float x) { return 1.0f / (1.0f + expf(-x)); }
__device__ __forceinline__ float siluf_(float x) { return x / (1.0f + expf(-x)); }
typedef float f32x16 __attribute__((ext_vector_type(16)));
#define MFMA32(a, b, c) __builtin_amdgcn_mfma_f32_32x32x16_bf16((a), (b), (c), 0, 0, 0)
#define KOFF(reg) (((reg) & 3) + 8 * ((reg) >> 2))
#define LDS_WAIT() asm volatile("s_waitcnt lgkmcnt(0)" ::: "memory")

__device__ __forceinline__ int seq_row(int d, int j) { return d == 0 ? (j < CTX ? SEQ + j : j - CTX) : (MT - 1 - j); }
__device__ __forceinline__ int row_seq(int d, int r) { return d == 0 ? (r >= SEQ ? r - SEQ : r + CTX) : (MT - 1 - r); }

#define XB_TMO      128
#define XB_XCNT(j)  (256  + 64 * (j))
#define XB_XSUB(j)  (1280 + 64 * (j))
#define XB_XGEN(j)  (2304 + 64 * (j))
#define XB_TOP      3328
#define XB_TOPGEN   3392
#define XCD_BAR_WORDS 3456
#define XB_SPIN_CAP (1u << 18)
__device__ __forceinline__ unsigned xb_ld(unsigned* p)              { return __hip_atomic_load(p, __ATOMIC_RELAXED, __HIP_MEMORY_SCOPE_AGENT); }
__device__ __forceinline__ unsigned xb_add(unsigned* p, unsigned v) { return __hip_atomic_fetch_add(p, v, __ATOMIC_RELAXED, __HIP_MEMORY_SCOPE_AGENT); }
__device__ __forceinline__ unsigned xb_xcc_id() { return (unsigned)__builtin_amdgcn_s_getreg((3 << 11) | 20) & 0xFu; }
#define XB_SPIN(cond, bar) do { unsigned _sp = 0; while (cond) { __builtin_amdgcn_s_sleep(1); \
    if ((++_sp & 255u) == 0u) { if (xb_ld(&(bar)[XB_TMO])) break; if (_sp > XB_SPIN_CAP) { atomicAdd(&(bar)[XB_TMO], 1u); break; } } } } while (0)
struct XcdBarrier { unsigned* bar; unsigned x; volatile LAS unsigned* st; };
__device__ __forceinline__ XcdBarrier xcd_barrier_post(unsigned* bar, volatile LAS unsigned* st) {
    XcdBarrier b; b.bar = bar; b.x = xb_xcc_id(); b.st = st;
    if (threadIdx.x == 0) (void)xb_add(&bar[XB_XCNT(b.x)], 1u);
    return b;
}
__device__ __forceinline__ void xcd_barrier_complete(unsigned* bar, unsigned x, unsigned& nloc, unsigned& nx) {
    const unsigned G = gridDim.x * gridDim.y * gridDim.z;
    unsigned sum, cnt, mine, sp = 0u;
    for (;;) {
        sum = 0u; cnt = 0u; mine = 0u;
#pragma unroll
        for (unsigned j = 0; j < 16; ++j) { const unsigned c = xb_ld(&bar[XB_XCNT(j)]); sum += c; cnt += (c > 0u) ? 1u : 0u; mine = (j == x) ? c : mine; }
        if (sum == G) break;
        __builtin_amdgcn_s_sleep(1);
        if ((++sp & 255u) == 0u) { if (xb_ld(&bar[XB_TMO])) break; if (sp > XB_SPIN_CAP) { atomicAdd(&bar[XB_TMO], 1u); break; } }
    }
    nloc = mine > 0u ? mine : 1u; nx = cnt > 0u ? cnt : 1u;
}
__device__ __forceinline__ void xcd_barrier(const XcdBarrier& b) {
    asm volatile("s_waitcnt vmcnt(0)" ::: "memory");
    __syncthreads();
    if (threadIdx.x == 0) {
        unsigned* bar = b.bar;
        __builtin_amdgcn_s_waitcnt(0);
        unsigned nloc = b.st[0], nx = b.st[1];
        if (nloc == 0u) { xcd_barrier_complete(bar, b.x, nloc, nx); b.st[0] = nloc; b.st[1] = nx; }
        const unsigned old = xb_add(&bar[XB_XSUB(b.x)], 1u);
        const unsigned gen = old / nloc;
        if (old + 1u == (gen + 1u) * nloc) {
            __builtin_amdgcn_fence(__ATOMIC_RELEASE, "agent");
            asm volatile("s_waitcnt vmcnt(0)" ::: "memory");
            const unsigned og = xb_add(&bar[XB_TOP], 1u);
            const unsigned tg = og / nx;
            if (og + 1u == (tg + 1u) * nx) xb_add(&bar[XB_TOPGEN], 1u);
            else XB_SPIN(xb_ld(&bar[XB_TOPGEN]) == tg, bar);
            __builtin_amdgcn_fence(__ATOMIC_ACQUIRE, "agent");
            xb_add(&bar[XB_XGEN(b.x)], 1u);
            asm volatile("s_waitcnt vmcnt(0)" ::: "memory");
        } else {
            XB_SPIN(xb_ld(&bar[XB_XGEN(b.x)]) == gen, bar);
            __builtin_amdgcn_fence(__ATOMIC_ACQUIRE, "agent");
            asm volatile("s_waitcnt vmcnt(0)" ::: "memory");
        }
    }
    __syncthreads();
}

namespace pg8 {
constexpr int BM = 256, BK = 64, HALF = 128, HTB = HALF * BK * 2, STAGE_BYTES = 8 * HTB, NXCD = 8, WGM = 8;
__host__ __device__ __forceinline__ int lds_byte(int r, int c) { const int st = (r >> 4) * 2 + (c >> 5), rr = r & 15, cc = c & 31, ob = rr * 64 + cc * 2; return st * 1024 + (ob ^ (((ob >> 9) & 1) << 5)); }
__host__ __device__ __forceinline__ void stage_rc(int b, int& R, int& C) { const int st = b / 1024, sb = b % 1024, swz = sb ^ (((sb >> 9) & 1) << 5); R = (st >> 1) * 16 + swz / 64; C = (st & 1) * 32 + (swz % 64) / 2; }
__host__ __device__ __forceinline__ int perm32(int rho) { const int n = rho >> 4, i = rho & 15; return 8 * (i >> 2) + 4 * n + (i & 3); }
struct Unit { int pm, pn; };
struct Gemm { const bf16_t* A; const bf16_t* Bt; int M, N, K; int a_div; size_t a_gstride; };
struct StaticOrder {
    int nM, nN, nwg, G, c;
    __host__ __device__ void init(int M, int N, int G_, int c_) { nM = M / BM; nN = N / BM; nwg = nM * nN; G = G_; c = c_; }
    __host__ __device__ bool next(int i, Unit& u) const {
        const long L = (long)i * G + c; if (L >= nwg) return false;
        int wgid = (int)L; { const int q = nwg / NXCD, r = nwg % NXCD, xcd = wgid % NXCD, off = wgid / NXCD; wgid = (xcd < r ? xcd * (q + 1) : r * (q + 1) + (xcd - r) * q) + off; }
        const int nig = WGM * nN, gid = wgid / nig, fm = gid * WGM, gsz = (nM - fm) < WGM ? (nM - fm) : WGM;
        u.pm = fm + ((wgid % nig) % gsz); u.pn = (wgid % nig) / gsz; return true;
    }
};
__device__ __forceinline__ unsigned cvt_pk_bf16(float lo, float hi) { unsigned r; asm volatile("v_cvt_pk_bf16_f32 %0, %1, %2" : "=v"(r) : "v"(lo), "v"(hi)); return r; }

template <class Epi, bool ALIGN_EPI, bool SP2>
__device__ __forceinline__ void gemm_phase(LAS unsigned char* lds, const Gemm g, const StaticOrder& S, const Epi& E, const int tid) {
    const int wid = __builtin_amdgcn_readfirstlane(tid >> 6), lane = tid & 63, wr = wid >> 2, wc = wid & 3, fr = lane & 15, fq = lane >> 4;
    const int K = g.K, nt = K / BK;
    unsigned voffA[2], voffB[2];
#pragma unroll
    for (int i = 0; i < 2; ++i) { int R, C; stage_rc(tid * 16 + i * 8192, R, C); const int Rb = Epi::PERM ? ((R & ~31) + perm32(R & 31)) : R;
        voffA[i] = (unsigned)(R * K + C) * 2u; voffB[i] = (unsigned)(Rb * K + C) * 2u; }
    const size_t kstep = (size_t)(BK * 2);
    const size_t hstep = (size_t)HALF * K * 2;
    const size_t tstep = 2 * hstep;
    const unsigned ldsw = (unsigned)wid * 1024u;
    const int aoff = lds_byte(wr * 64 + fr, fq * 8), boff = lds_byte(wc * 32 + fr, fq * 8);
#define PG8_SA(b, h) (((b) * 2 + (h)) * HTB)
#define PG8_SB(b, h) ((4 + (b) * 2 + (h)) * HTB)
#define PG8_STAGE(bufoff, gbase, voff) do { _Pragma("unroll") for (int _i = 0; _i < 2; ++_i) \
        __builtin_amdgcn_global_load_lds((const unsigned*)((const char*)(gbase) + (voff)[_i]), (LAS unsigned*)(lds + (bufoff) + ldsw + _i * 8192), 16, 0, 0); } while (0)
#define PG8_LDA(dst, b, h) do { _Pragma("unroll") for (int m = 0; m < 4; ++m) _Pragma("unroll") for (int k = 0; k < 2; ++k) dst[m][k] = *(const LAS bf16x8*)(lds + PG8_SA(b, h) + aoff + m * 2048 + k * 1024); } while (0)
#define PG8_LDB(dst, b, h) do { _Pragma("unroll") for (int n = 0; n < 2; ++n) _Pragma("unroll") for (int k = 0; k < 2; ++k) dst[n][k] = *(const LAS bf16x8*)(lds + PG8_SB(b, h) + boff + n * 2048 + k * 1024); } while (0)
#define PG8_MMA(ai, bj, At, Bt) do { __builtin_amdgcn_s_setprio(1); _Pragma("unroll") for (int m = 0; m < 4; ++m) _Pragma("unroll") for (int n = 0; n < 2; ++n) _Pragma("unroll") for (int k = 0; k < 2; ++k) \
        acc[ai][bj][m][n] = __builtin_amdgcn_mfma_f32_16x16x32_bf16(Bt[n][k], At[m][k], acc[ai][bj][m][n], 0, 0, 0); __builtin_amdgcn_s_setprio(0); } while (0)
#define PG8_WAIT_V(n) asm volatile("s_waitcnt vmcnt(" #n ")" ::: "memory")
#define PG8_WAIT_L(n) asm volatile("s_waitcnt lgkmcnt(" #n ")" ::: "memory")
#define PG8_BAR __builtin_amdgcn_s_barrier()
#define PG8_SCHED __builtin_amdgcn_sched_barrier(0)
#define PG8_ABASE(u) ((const char*)g.A + ((size_t)((u).pn / g.a_div) * g.a_gstride) * 2 + (size_t)(u).pm * tstep)
    Unit cur, nxt; int ui = 0;
    if (!S.next(0, cur)) return;
    f32x4 acc[2][2][4][2];
#pragma unroll
    for (int a = 0; a < 2; ++a)
#pragma unroll
        for (int b = 0; b < 2; ++b)
#pragma unroll
            for (int m = 0; m < 4; ++m)
#pragma unroll
                for (int n = 0; n < 2; ++n) acc[a][b][m][n] = (f32x4){0.f, 0.f, 0.f, 0.f};
    bf16x8 At[4][2], B0[2][2], B1[2][2];
    const char* cA = PG8_ABASE(cur); const char* cB = (const char*)g.Bt + (size_t)cur.pn * tstep;
    if constexpr (SP2) {
        PG8_STAGE(PG8_SB(0, 0), cB, voffB); PG8_STAGE(PG8_SB(0, 1), cB + hstep, voffB); PG8_STAGE(PG8_SA(0, 0), cA, voffA); PG8_STAGE(PG8_SA(0, 1), cA + hstep, voffA);
        if (wr == 1) PG8_BAR;
        PG8_WAIT_V(2); PG8_BAR;
        PG8_STAGE(PG8_SB(1, 0), cB + kstep, voffB); PG8_STAGE(PG8_SA(1, 0), cA + kstep, voffA); PG8_STAGE(PG8_SB(1, 1), cB + hstep + kstep, voffB);
        PG8_WAIT_V(6); PG8_BAR;
    } else {
        PG8_STAGE(PG8_SB(0, 0), cB, voffB); PG8_STAGE(PG8_SA(0, 0), cA, voffA); PG8_STAGE(PG8_SB(0, 1), cB + hstep, voffB); PG8_STAGE(PG8_SA(0, 1), cA + hstep, voffA);
        if (wr == 1) PG8_BAR;
        PG8_WAIT_V(4); PG8_BAR;
        PG8_STAGE(PG8_SB(1, 0), cB + kstep, voffB); PG8_STAGE(PG8_SA(1, 0), cA + kstep, voffA); PG8_STAGE(PG8_SB(1, 1), cB + hstep + kstep, voffB);
        PG8_WAIT_V(6); PG8_BAR;
    }
    for (;;) {
        const bool has_next = S.next(ui + 1, nxt);
        const char* nA = has_next ? PG8_ABASE(nxt) : cA; const char* nB = has_next ? (const char*)g.Bt + (size_t)nxt.pn * tstep : cB;
        for (int t = 0; t < nt; t += 2) {
            const bool last = (t == nt - 2);
            const char* a1 = cA + (size_t)(t + 1) * kstep;
            const char* a2 = last ? nA : cA + (size_t)(t + 2) * kstep; const char* b2 = last ? nB : cB + (size_t)(t + 2) * kstep;
            const char* a3 = a2 + kstep; const char* b3 = b2 + kstep;
            if constexpr (SP2) {
            PG8_LDB(B0, 0, 0); PG8_LDB(B1, 0, 1); PG8_SCHED; PG8_LDA(At, 0, 0); PG8_STAGE(PG8_SA(1, 1), a1 + hstep, voffA);
            PG8_WAIT_V(8); PG8_WAIT_L(0); PG8_BAR; PG8_MMA(0, 0, At, B0); PG8_MMA(0, 1, At, B1); PG8_BAR; PG8_SCHED;
            PG8_LDA(At, 0, 1); PG8_STAGE(PG8_SB(0, 0), b2, voffB); PG8_STAGE(PG8_SB(0, 1), b2 + hstep, voffB); PG8_STAGE(PG8_SA(0, 0), a2, voffA);
            PG8_WAIT_V(8); PG8_WAIT_L(0); PG8_BAR; PG8_MMA(1, 0, At, B0); PG8_MMA(1, 1, At, B1); PG8_BAR; PG8_SCHED;
            PG8_LDB(B0, 1, 0); PG8_LDB(B1, 1, 1); PG8_SCHED; PG8_LDA(At, 1, 0); PG8_STAGE(PG8_SA(0, 1), a2 + hstep, voffA);
            PG8_WAIT_V(8); PG8_WAIT_L(0); PG8_BAR; PG8_MMA(0, 0, At, B0); PG8_MMA(0, 1, At, B1); PG8_BAR; PG8_SCHED;
            PG8_LDA(At, 1, 1); PG8_STAGE(PG8_SB(1, 0), b3, voffB); PG8_STAGE(PG8_SB(1, 1), b3 + hstep, voffB); PG8_STAGE(PG8_SA(1, 0), a3, voffA);
            PG8_WAIT_V(8); PG8_WAIT_L(0); PG8_BAR; PG8_MMA(1, 0, At, B0); PG8_MMA(1, 1, At, B1); PG8_BAR; PG8_SCHED;
            } else {
            PG8_LDB(B0, 0, 0); PG8_SCHED; PG8_LDA(At, 0, 0); PG8_STAGE(PG8_SA(1, 1), a1 + hstep, voffA);
            PG8_WAIT_L(8); PG8_BAR; PG8_WAIT_L(0); PG8_MMA(0, 0, At, B0); PG8_BAR; PG8_SCHED;
            PG8_LDB(B1, 0, 1); PG8_STAGE(PG8_SB(0, 0), b2, voffB);
            PG8_BAR; PG8_WAIT_L(0); PG8_MMA(0, 1, At, B1); PG8_BAR;
            PG8_LDA(At, 0, 1); PG8_STAGE(PG8_SA(0, 0), a2, voffA);
            PG8_BAR; PG8_WAIT_L(0); PG8_MMA(1, 0, At, B0); PG8_BAR; PG8_SCHED;
            PG8_STAGE(PG8_SB(0, 1), b2 + hstep, voffB);
            PG8_WAIT_V(6); PG8_BAR; PG8_MMA(1, 1, At, B1); PG8_BAR;
            PG8_LDB(B0, 1, 0); PG8_SCHED; PG8_LDA(At, 1, 0); PG8_STAGE(PG8_SA(0, 1), a2 + hstep, voffA);
            PG8_WAIT_L(8); PG8_BAR; PG8_WAIT_L(0); PG8_MMA(0, 0, At, B0); PG8_BAR; PG8_SCHED;
            PG8_LDB(B1, 1, 1); PG8_STAGE(PG8_SB(1, 0), b3, voffB);
            PG8_BAR; PG8_WAIT_L(0); PG8_MMA(0, 1, At, B1); PG8_BAR;
            PG8_LDA(At, 1, 1); PG8_STAGE(PG8_SA(1, 0), a3, voffA);
            PG8_BAR; PG8_WAIT_L(0); PG8_MMA(1, 0, At, B0); PG8_BAR; PG8_SCHED;
            PG8_STAGE(PG8_SB(1, 1), b3 + hstep, voffB);
            PG8_WAIT_V(6); PG8_BAR; PG8_MMA(1, 1, At, B1); PG8_BAR;
            }
        }
        if constexpr (ALIGN_EPI) { if (wr == 0) PG8_BAR; }
        E(acc, cur, wr, wc, fr, fq);
        if (!has_next) break;
#pragma unroll
        for (int a = 0; a < 2; ++a)
#pragma unroll
            for (int b = 0; b < 2; ++b)
#pragma unroll
                for (int m = 0; m < 4; ++m)
#pragma unroll
                    for (int n = 0; n < 2; ++n) acc[a][b][m][n] = (f32x4){0.f, 0.f, 0.f, 0.f};
        cur = nxt; cA = nA; cB = nB; ++ui;
        if constexpr (ALIGN_EPI) { if (wr == 1) PG8_BAR; }
    }
    PG8_WAIT_V(0);
    if constexpr (!ALIGN_EPI) { if (wr == 0) PG8_BAR; }
    PG8_BAR;
#undef PG8_SA
#undef PG8_SB
#undef PG8_STAGE
#undef PG8_LDA
#undef PG8_LDB
#undef PG8_MMA
#undef PG8_WAIT_V
#undef PG8_WAIT_L
#undef PG8_BAR
#undef PG8_SCHED
#undef PG8_ABASE
}

struct EpiSwiGLU {
    static constexpr bool PERM = true;
    bf16_t* O;
    __device__ __forceinline__ void operator()(const f32x4 (&acc)[2][2][4][2], const Unit& u, int wr, int wc, int fr, int fq) const {
        const int row0 = u.pm * BM + wr * 64 + fr, col0 = u.pn * HALF + wc * 32 + 8 * fq;
#pragma unroll
        for (int ai = 0; ai < 2; ++ai)
#pragma unroll
            for (int m = 0; m < 4; ++m) {
                bf16_t* rowp = O + (size_t)(row0 + ai * HALF + m * 16) * DFF + col0;
                float o[8];
#pragma unroll
                for (int n = 0; n < 2; ++n)
#pragma unroll
                    for (int j = 0; j < 4; ++j) { const float a = acc[ai][0][m][n][j], b = acc[ai][1][m][n][j]; o[n * 4 + j] = a / (1.0f + __expf(-a)) * b; }
                u32x4 w; w.x = cvt_pk_bf16(o[0], o[1]); w.y = cvt_pk_bf16(o[2], o[3]); w.z = cvt_pk_bf16(o[4], o[5]); w.w = cvt_pk_bf16(o[6], o[7]);
                *(u32x4*)rowp = w;
            }
    }
};
template <bool HALFGATE> struct EpiResid {
    static constexpr bool PERM = false;
    float* X; const float* gate_lat; const float* gate_ctx; float* out;
    __device__ __forceinline__ void operator()(const f32x4 (&acc)[2][2][4][2], const Unit& u, int wr, int wc, int fr, int fq) const {
        const int row0 = u.pm * BM + wr * 64 + fr, col0 = u.pn * BM + wc * 32 + 4 * fq;
        const float* gp = (u.pm * BM >= SEQ) ? gate_ctx : gate_lat;
        f32x4 gv[2][2];
#pragma unroll
        for (int bj = 0; bj < 2; ++bj)
#pragma unroll
            for (int n = 0; n < 2; ++n) gv[bj][n] = *(const f32x4*)(gp + col0 + bj * HALF + n * 16) * (HALFGATE ? 0.5f : 1.0f);
#pragma unroll
        for (int ai = 0; ai < 2; ++ai)
#pragma unroll
            for (int m = 0; m < 4; ++m) {
                const int row = row0 + ai * HALF + m * 16;
                float* rowp = X + (size_t)row * D + col0;
#pragma unroll
                for (int bj = 0; bj < 2; ++bj)
#pragma unroll
                    for (int n = 0; n < 2; ++n) {
                        f32x4 v = *(const f32x4*)(rowp + bj * HALF + n * 16) + gv[bj][n] * acc[ai][bj][m][n];
                        *(f32x4*)(rowp + bj * HALF + n * 16) = v;
                        if (out != nullptr && row < SEQ) *(f32x4*)(out + (size_t)row * D + col0 + bj * HALF + n * 16) = v;
                    }
            }
    }
};
struct EpiWin {
    static constexpr bool PERM = true;
    float* P32; bf16_t* PA; bf16_t* GL; long pn_off;
    __device__ __forceinline__ void operator()(const f32x4 (&acc)[2][2][4][2], const Unit& u0, int wr, int wc, int fr, int fq) const {
        Unit u; u.pm = u0.pm; u.pn = u0.pn + (int)pn_off;
        const int row0 = u.pm * BM + wr * 64 + fr, cin = wc * 32 + 8 * fq;
        if (u.pn < 19) {
#pragma unroll
            for (int ai = 0; ai < 2; ++ai)
#pragma unroll
                for (int m = 0; m < 4; ++m) { float* rowp = P32 + (size_t)(row0 + ai * HALF + m * 16) * P32W + u.pn * BM + cin;
#pragma unroll
                    for (int bj = 0; bj < 2; ++bj) { *(f32x4*)(rowp + bj * HALF) = acc[ai][bj][m][0]; *(f32x4*)(rowp + bj * HALF + 4) = acc[ai][bj][m][1]; } }
        } else {
            bf16_t* base; int ld, colt;
            if (u.pn < 28) { base = PA; ld = PAW; colt = (u.pn - 19) * BM; } else { base = GL; ld = GLW; colt = (u.pn - 28) * BM; }
#pragma unroll
            for (int ai = 0; ai < 2; ++ai)
#pragma unroll
                for (int m = 0; m < 4; ++m) { bf16_t* rowp = base + (size_t)(row0 + ai * HALF + m * 16) * ld + colt + cin;
#pragma unroll
                    for (int bj = 0; bj < 2; ++bj) { const f32x4 v0 = acc[ai][bj][m][0], v1 = acc[ai][bj][m][1];
                        u32x4 w; w.x = cvt_pk_bf16(v0[0], v0[1]); w.y = cvt_pk_bf16(v0[2], v0[3]); w.z = cvt_pk_bf16(v1[0], v1[1]); w.w = cvt_pk_bf16(v1[2], v1[3]);
                        *(u32x4*)(rowp + bj * HALF) = w; } }
        }
    }
};
struct EpiMerge {
    static constexpr bool PERM = true;
    const bf16_t* GL; bf16_t* PROJ;
    __device__ __forceinline__ void operator()(const f32x4 (&acc)[2][2][4][2], const Unit& u, int wr, int wc, int fr, int fq) const {
        const int row0 = u.pm * BM + wr * 64 + fr, col0 = u.pn * BM + wc * 32 + 8 * fq;
#pragma unroll
        for (int ai = 0; ai < 2; ++ai)
#pragma unroll
            for (int m = 0; m < 4; ++m) { const size_t ro = (size_t)(row0 + ai * HALF + m * 16) * GLW + col0;
#pragma unroll
                for (int bj = 0; bj < 2; ++bj) {
                    const u32x4 gw = *(const u32x4*)(GL + ro + bj * HALF);
                    const f32x4 v0 = acc[ai][bj][m][0], v1 = acc[ai][bj][m][1];
                    float o[8];
                    o[0] = v0[0] / (1.0f + __expf(-bf2f(gw.x & 0xffffu))); o[1] = v0[1] / (1.0f + __expf(-bf2f(gw.x >> 16)));
                    o[2] = v0[2] / (1.0f + __expf(-bf2f(gw.y & 0xffffu))); o[3] = v0[3] / (1.0f + __expf(-bf2f(gw.y >> 16)));
                    o[4] = v1[0] / (1.0f + __expf(-bf2f(gw.z & 0xffffu))); o[5] = v1[1] / (1.0f + __expf(-bf2f(gw.z >> 16)));
                    o[6] = v1[2] / (1.0f + __expf(-bf2f(gw.w & 0xffffu))); o[7] = v1[3] / (1.0f + __expf(-bf2f(gw.w >> 16)));
                    u32x4 w; w.x = cvt_pk_bf16(o[0], o[1]); w.y = cvt_pk_bf16(o[2], o[3]); w.z = cvt_pk_bf16(o[4], o[5]); w.w = cvt_pk_bf16(o[6], o[7]);
                    *(u32x4*)(PROJ + ro + bj * HALF) = w; } }
    }
};
}

enum { I_X = 0, I_C, I_CTX, I_CCTX, I_ADAW, I_ADAB, I_NF1, I_NMIX, I_NF2, I_F1WI, I_F1WO, I_F2WI, I_F2WO, I_WIN, I_HGLB, I_HGNORM, I_RWSHIFT, I_RWW0, I_RWW2, I_RWA0, I_RWA2,
       I_RWKK, I_RWKA, I_RWRK, I_RWLNW, I_RWLNB, I_NAQN, I_NAKN, I_NARPB, I_WAQN, I_WAKN, I_WASINK, I_WBR, I_WOUT, N_IN };
struct Args { const float* in[N_IN]; float* out; unsigned char* ws; int ph_lo, ph_hi; };
struct Ctx {
    LAS unsigned char* lds;
    int tid, lane, wave, bid, G;
    const Args __attribute__((address_space(4)))* ka; float* out; unsigned char* ws;
};
#define WSP(T, off) ((T*)(C.ws + (off)))
__device__ __forceinline__ void relaunder(Ctx& C) {
    int t = C.tid, b = C.bid, g = C.G;
    asm volatile("" : "+v"(t), "+v"(b), "+v"(g));
    C.tid = t; C.lane = t & 63; C.wave = __builtin_amdgcn_readfirstlane(t >> 6); C.bid = __builtin_amdgcn_readfirstlane(b); C.G = __builtin_amdgcn_readfirstlane(g);
}

__device__ __forceinline__ void transpose_item(const float* W, int K, int N, bf16_t* WT, int mode, LAS float* scr, int item, int lane) {
    const int nblk = N / 32, kb = item / nblk, nb = item % nblk, k0 = 64 * kb, n0 = 32 * nb;
    int drow0 = n0;
    if (mode == 1) { const int half = n0 / DFF, j0 = n0 % DFF; drow0 = 256 * (j0 / 128) + 128 * half + (j0 % 128); }
#pragma unroll 8
    for (int i = 0; i < 32; ++i) { const int kk = 2 * i + (lane >> 5); scr[kk * 33 + (lane & 31)] = W[(size_t)(k0 + kk) * N + n0 + (lane & 31)]; }
    LDS_WAIT(); asm volatile("" ::: "memory");
    const int c = lane & 7;
#pragma unroll
    for (int j = 0; j < 4; ++j) { const int n = (lane >> 3) + 8 * j; const LAS float* s = scr + (8 * c) * 33 + n;
        u32x4 o; o.x = pk2(s[0 * 33], s[1 * 33]); o.y = pk2(s[2 * 33], s[3 * 33]); o.z = pk2(s[4 * 33], s[5 * 33]); o.w = pk2(s[6 * 33], s[7 * 33]);
        *(u32x4*)(WT + (size_t)(drow0 + n) * K + k0 + 8 * c) = o; }
    LDS_WAIT(); asm volatile("" ::: "memory");
}
__device__ __forceinline__ void phase_convert(Ctx& C, int l) {
    LAS float* scr = (LAS float*)(C.lds + C.wave * 16384);
    const int gw = C.bid * NWAVES + C.wave, NGW = C.G * NWAVES;
    constexpr int I_WI = (D / 64) * (2 * DFF / 32), I_WO = (DFF / 64) * (D / 32), I_IN = (D / 64) * (PTOT / 32), I_BR = (512 / 64) * (D / 32), I_OUT = (D / 64) * (D / 32);
    constexpr int NITEMS = 2 * I_WI + 2 * I_WO + I_IN + 4 * I_BR + I_OUT;
    for (int it = gw; it < NITEMS; it += NGW) {
        int r = it;
        if (r < I_WI) { transpose_item(C.ka->in[I_F1WI] + (size_t)l * D * 2 * DFF, D, 2 * DFF, WSP(bf16_t, OFF_WI1), 1, scr, r, C.lane); continue; } r -= I_WI;
        if (r < I_WI) { transpose_item(C.ka->in[I_F2WI] + (size_t)l * D * 2 * DFF, D, 2 * DFF, WSP(bf16_t, OFF_WI2), 1, scr, r, C.lane); continue; } r -= I_WI;
        if (r < I_WO) { transpose_item(C.ka->in[I_F1WO] + (size_t)l * DFF * D, DFF, D, WSP(bf16_t, OFF_WO1), 0, scr, r, C.lane); continue; } r -= I_WO;
        if (r < I_WO) { transpose_item(C.ka->in[I_F2WO] + (size_t)l * DFF * D, DFF, D, WSP(bf16_t, OFF_WO2), 0, scr, r, C.lane); continue; } r -= I_WO;
        if (r < I_IN) { transpose_item(C.ka->in[I_WIN] + (size_t)l * D * PTOT, D, PTOT, WSP(bf16_t, OFF_WIN), 0, scr, r, C.lane); continue; } r -= I_IN;
        if (r < 4 * I_BR) { const int g = r / I_BR; transpose_item(C.ka->in[I_WBR] + ((size_t)l * 4 + g) * 512 * D, 512, D, WSP(bf16_t, OFF_WBR) + (size_t)g * D * 512, 0, scr, r % I_BR, C.lane); continue; } r -= 4 * I_BR;
        transpose_item(C.ka->in[I_WOUT] + (size_t)l * D * D, D, D, WSP(bf16_t, OFF_WOUT), 0, scr, r, C.lane);
    }
}

__device__ __forceinline__ void phase_ada_partial(Ctx& C) {
    float* modp = WSP(float, OFF_MODP);
    for (int u = C.bid; u < DEPTH * 9 * KSPLIT; u += C.G) {
        const int l = u / (9 * KSPLIT), rem = u % (9 * KSPLIT), cg = rem / KSPLIT, ks = rem % KSPLIT;
        const int col = cg * 2048 + C.tid * 4;
        const float* W = C.ka->in[I_ADAW] + (size_t)l * D * MODW;
        f32x4 a0 = {0.f, 0.f, 0.f, 0.f}, a1 = {0.f, 0.f, 0.f, 0.f};
#pragma unroll 16
        for (int i = ks * 64; i < ks * 64 + 64; ++i) {
            const float c0 = C.ka->in[I_C][i], c1 = C.ka->in[I_CCTX][i];
            const float s0 = siluf_(c0), s1 = siluf_(c1);
            const f32x4 w = *(const f32x4*)(W + (size_t)i * MODW + col);
            a0 += w * s0; a1 += w * s1;
        }
        *(f32x4*)(modp + ((size_t)(l * KSPLIT + ks) * 2 + 0) * MODW + col) = a0;
        *(f32x4*)(modp + ((size_t)(l * KSPLIT + ks) * 2 + 1) * MODW + col) = a1;
    }
    f32x4* X = WSP(f32x4, OFF_X);
    const f32x4* xs = (const f32x4*)C.ka->in[I_X]; const f32x4* cs = (const f32x4*)C.ka->in[I_CTX];
    const size_t n_lat = (size_t)SEQ * D / 4, n_all = (size_t)MT * D / 4;
    for (size_t i = (size_t)C.bid * NT + C.tid; i < n_all; i += (size_t)C.G * NT) X[i] = i < n_lat ? xs[i] : cs[i - n_lat];
}
__device__ __forceinline__ void phase_ada_reduce(Ctx& C) {
    const float* modp = WSP(float, OFF_MODP); float* mod = WSP(float, OFF_MOD);
    for (int e = C.bid * NT + C.tid; e < DEPTH * 2 * MODW; e += C.G * NT) {
        const int l = e / (2 * MODW), s = (e / MODW) % 2, j = e % MODW;
        float a = C.ka->in[I_ADAB][(size_t)l * MODW + j];
        for (int ks = 0; ks < KSPLIT; ++ks) a += modp[((size_t)(l * KSPLIT + ks) * 2 + s) * MODW + j];
        mod[e] = a;
    }
}
__device__ __forceinline__ const float* mod_ptr(Ctx& C, int l, int s, int idx) { return WSP(float, OFF_MOD) + ((size_t)(l * 2 + s) * NMOD + idx) * D; }

__device__ __forceinline__ void phase_norm(Ctx& C, int l, const float* gw  , int shift_idx) {
    const int gwv = C.bid * NWAVES + C.wave, NGW = C.G * NWAVES;
    const float* X = WSP(float, OFF_X); bf16_t* H = WSP(bf16_t, OFF_H);
    for (int r = gwv; r < MT; r += NGW) {
        const int s = r >= SEQ ? 1 : 0;
        const float* sh = mod_ptr(C, l, s, shift_idx); const float* sc = mod_ptr(C, l, s, shift_idx + 1);
        const f32x4* xr = (const f32x4*)(X + (size_t)r * D) + C.lane;
        f32x4 v[8]; float ss = 0.f;
#pragma unroll
        for (int j = 0; j < 8; ++j) { v[j] = xr[64 * j]; ss += (v[j].x * v[j].x + v[j].y * v[j].y) + (v[j].z * v[j].z + v[j].w * v[j].w); }
        const float rstd = rsqrtf(wave_sum(ss) * (1.0f / D) + EPS);
        u32x2* o8 = (u32x2*)(H + (size_t)r * D) + C.lane;
#pragma unroll
        for (int j = 0; j < 8; ++j) {
            const int c = (64 * j + C.lane) * 4;
            const f32x4 g4 = *(const f32x4*)(gw + c), s4 = *(const f32x4*)(sc + c), h4 = *(const f32x4*)(sh + c);
            const f32x4 y = (v[j] * rstd) * g4 * (s4 + 1.0f) + h4;
            u32x2 w; w.x = pk2(y.x, y.y); w.y = pk2(y.z, y.w); o8[64 * j] = w;
        }
    }
}

__device__ __forceinline__ void phase_rw_prep(Ctx& C, int l, int b0, int nb) {
    constexpr int TB = 8;
    const float* P = WSP(float, OFF_P32); float* SCN = WSP(float, OFF_SCN); float* VV = WSP(float, OFF_VV); float* GS = WSP(float, OFF_GS);
    LAS float* lin = (LAS float*)C.lds;
    const float* taps = C.ka->in[I_RWSHIFT] + (size_t)l * 3 * RWC;
    const int c = C.tid, h = c >> 6, e = c & 63;
    const float kkw = C.ka->in[I_RWKK][l * 512 + c], kaw = C.ka->in[I_RWKA][l * 512 + c];
    for (int grp = b0; grp < MT / TB; grp += nb) {
        const int r0 = grp * TB;
        const bool hp0 = (r0 != 0 && r0 != SEQ), hnl = (r0 + TB != SEQ && r0 + TB != MT);
        float xs[TB][4];
        __syncthreads();
#pragma unroll
        for (int q = 0; q < 5; ++q) {
            if (q == 4 && c >= 256) break;
            const int col = q * 512 + c;
            const float t0 = taps[col], t1 = taps[RWC + col], t2 = taps[2 * RWC + col];
            const float* pc = P + (size_t)r0 * P32W + RW_OFF + col;
            float prev = hp0 ? pc[-(long)P32W] : 0.f, cur = pc[0];
#pragma unroll
            for (int t = 0; t < TB; ++t) {
                const float nxt = (t + 1 < TB || hnl) ? pc[(size_t)(t + 1) * P32W] : 0.f;
                const float v = t0 * prev + t1 * cur + t2 * nxt;
                if (q < 4) xs[t][q] = v; else lin[t * 256 + c] = c < 128 ? tanhf(v) : v;
                prev = cur; cur = nxt;
            }
        }
        __syncthreads();
        float kkn[TB];
#pragma unroll
        for (int t = 0; t < TB; ++t) {
            const float kk0 = xs[t][1] * kkw;
            kkn[t] = kk0 * rsqrtf(wave_sum(kk0 * kk0) + EPS);
            VV[(size_t)(r0 + t) * 512 + c] = xs[t][2]; GS[(size_t)(r0 + t) * 512 + c] = sigmoidf_(xs[t][3]);
        }
#pragma unroll 1
        for (int d = 0; d < 2; ++d) {
            const float* w2 = C.ka->in[I_RWW2] + ((size_t)(l * 2 + d) * 64) * 512 + c;
            const float* a2 = C.ka->in[I_RWA2] + ((size_t)(l * 2 + d) * 64) * 512 + c;
            float z[TB], az[TB];
            const float zb = C.ka->in[I_RWW0][(l * 2 + d) * 512 + c], ab = C.ka->in[I_RWA0][(l * 2 + d) * 512 + c];
#pragma unroll
            for (int t = 0; t < TB; ++t) { z[t] = zb; az[t] = ab; }
#pragma unroll 2
            for (int j = 0; j < 64; j += 4) {
                const float w0 = w2[(size_t)(j + 0) * 512], w1 = w2[(size_t)(j + 1) * 512], w2v = w2[(size_t)(j + 2) * 512], w3 = w2[(size_t)(j + 3) * 512];
                const float b0v = a2[(size_t)(j + 0) * 512], b1 = a2[(size_t)(j + 1) * 512], b2 = a2[(size_t)(j + 2) * 512], b3 = a2[(size_t)(j + 3) * 512];
#pragma unroll
                for (int t = 0; t < TB; ++t) {
                    const f32x4 lw = *(const LAS f32x4*)(lin + t * 256 + d * 64 + j), la = *(const LAS f32x4*)(lin + t * 256 + 128 + d * 64 + j);
                    z[t] += (lw.x * w0 + lw.y * w1) + (lw.z * w2v + lw.w * w3);
                    az[t] += (la.x * b0v + la.y * b1) + (la.z * b2 + la.w * b3);
                }
            }
#pragma unroll
            for (int t = 0; t < TB; ++t) {
                const float y = -z[t]; const float sp = fmaxf(y, 0.f) + log1pf(expf(-fabsf(y)));
                const float decay = expf(-expf(-sp - 0.5f));
                const float a = sigmoidf_(az[t]);
                const float kd = xs[t][1] * (1.0f + (a - 1.0f) * kaw);
                float* o = SCN + ((size_t)((d * 8 + h) * MT + row_seq(d, r0 + t))) * 320 + e;
                o[0] = decay; o[64] = kkn[t]; o[128] = a * kkn[t]; o[192] = kd; o[256] = xs[t][0];
            }
        }
    }
}

__device__ __forceinline__ void phase_attn_prep(Ctx& C, int l, int w0, int nw) {
    bf16_t* PA = WSP(bf16_t, OFF_PA);
    const int e = C.lane;
    const float na_qn = C.ka->in[I_NAQN][l * 64 + e], na_kn = C.ka->in[I_NAKN][l * 64 + e], wa_qn = C.ka->in[I_WAQN][l * 64 + e], wa_kn = C.ka->in[I_WAKN][l * 64 + e];
    const int m16 = e & 15;
    const float inv = powf(10000.0f, -(float)m16 / 16.0f);
    for (long uidx = w0; uidx < (long)MT * 26; uidx += nw) {
        const int r = (int)(uidx / 26), v = (int)(uidx % 26);
        int col; float nwt, scl; bool rope;
        if (v < 8) { col = v * 64; nwt = na_qn; scl = 0.125f; rope = false; }
        else if (v < 16) { col = 512 + (v - 8) * 64; nwt = na_kn; scl = 1.0f; rope = false; }
        else if (v < 24) { col = 1536 + (v - 16) * 64; nwt = wa_qn; scl = 0.125f; rope = true; }
        else { col = 2048 + (v - 24) * 64; nwt = wa_kn; scl = 1.0f; rope = true; }
        bf16_t* p = PA + (size_t)r * PAW + col + e;
        const float x = bf2f(*p);
        const float ss = wave_sum(x * x);
        float y = x * rsqrtf(ss * (1.0f / 64.0f) + EPS) * nwt * scl;
        if (rope && r < SEQ) {
            const int pos = (e >> 5) ? (r & 63) : (r >> 6);
            const float ang = (float)pos * inv;
            float sn, cs; sincosf(ang, &sn, &cs);
            const bool lo = (e & 31) < 16;
            const float yp = __shfl(y, lo ? e + 16 : e - 16);
            y = lo ? (y * cs - yp * sn) : (yp * sn + y * cs);
        }
        *p = (bf16_t)f2bf(y);
    }
}

__device__ __forceinline__ float hg_lb(Ctx& C, int l, int d, int c) {
    if (l == 0) return 0.f;
    const float a0 = C.ka->in[I_HGLB][(size_t)(d * DEPTH + 0) * 512 + c], a1 = C.ka->in[I_HGLB][(size_t)(d * DEPTH + 1) * 512 + c];
    const float m = fmaxf(a0, a1); const float e0 = expf(a0 - m), e1 = expf(a1 - m);
    return e1 / (e0 + e1);
}
#define MFMA16(a, b, c) __builtin_amdgcn_mfma_f32_16x16x32_bf16((a), (b), (c), 0, 0, 0)
struct HgThread { float lc[16], kd[16]; float tot[4]; };
__device__ __forceinline__ void hg_gates(Ctx& C, int l, int d, int h, int tc, int k, int J, LAS float* TOT, HgThread& T) {
    const float* P = WSP(float, OFF_P32);
    const float lb = hg_lb(C, l, d, h * 128 + k);
    float gg[16];
#pragma unroll
    for (int i = 0; i < 16; ++i) {
        const float fr = P[(size_t)(64 * tc + 16 * J + i) * P32W + 512 + d * 512 + h * 128 + k];
        const float f = lb + (1.0f - lb) * sigmoidf_(fr);
        gg[i] = __logf(f); T.kd[i] = 1.0f - f;
    }
    if (d == 0) { float a = 0.f;
#pragma unroll
        for (int i = 0; i < 16; ++i) { a += gg[i]; T.lc[i] = a; }
        TOT[J * 128 + k] = a;
    } else { float a = 0.f;
#pragma unroll
        for (int i = 15; i >= 0; --i) { a += gg[i]; T.lc[i] = a; }
        TOT[J * 128 + k] = a;
    }
    __syncthreads();
#pragma unroll
    for (int m = 0; m < 4; ++m) T.tot[m] = TOT[m * 128 + k];
}
__device__ __forceinline__ void hg_it(Ctx& C, int h, int tc, int v, int J, LAS unsigned char* IT) {
    const float* P = WSP(float, OFF_P32);
    float x[16];
#pragma unroll
    for (int i = 0; i < 16; ++i) x[i] = P[(size_t)(64 * tc + 16 * J + i) * P32W + 1536 + h * 128 + v];
    u32x4 w0, w1;
    w0.x = pk2(x[0], x[1]); w0.y = pk2(x[2], x[3]); w0.z = pk2(x[4], x[5]); w0.w = pk2(x[6], x[7]);
    w1.x = pk2(x[8], x[9]); w1.y = pk2(x[10], x[11]); w1.z = pk2(x[12], x[13]); w1.w = pk2(x[14], x[15]);
    *(LAS u32x4*)(IT + v * 144 + J * 32) = w0; *(LAS u32x4*)(IT + v * 144 + J * 32 + 16) = w1;
}
__device__ __forceinline__ void phase_hg_A(Ctx& C, int l, int b0, int nb) {
    float* HGL = WSP(float, OFF_HGL); float* HGD = WSP(float, OFF_HGD);
    LAS unsigned char* KT = C.lds;
    LAS unsigned char* IT = C.lds + 18432;
    LAS float* TOT = (LAS float*)(C.lds + 36864);
    const int k = C.tid & 127, J = C.tid >> 7;
    for (int u = b0; u < 2 * 4 * NCH; u += nb) {
        const int d = u / (4 * NCH), h = (u / NCH) % 4, c = u % NCH;
        const int tc = d == 0 ? (c + NCH - 4) % NCH : NCH - 1 - c;
        __syncthreads();
        HgThread T; hg_gates(C, l, d, h, tc, k, J, TOT, T);
        float rest = 0.f;
#pragma unroll
        for (int m = 0; m < 4; ++m) if (d == 0 ? (m >= J) : (m <= J)) rest += T.tot[m];
        float kh[16];
#pragma unroll
        for (int i = 0; i < 16; ++i) kh[i] = T.kd[i] * __expf(rest - T.lc[i]);
        { u32x4 w0, w1;
          w0.x = pk2(kh[0], kh[1]); w0.y = pk2(kh[2], kh[3]); w0.z = pk2(kh[4], kh[5]); w0.w = pk2(kh[6], kh[7]);
          w1.x = pk2(kh[8], kh[9]); w1.y = pk2(kh[10], kh[11]); w1.z = pk2(kh[12], kh[13]); w1.w = pk2(kh[14], kh[15]);
          *(LAS u32x4*)(KT + k * 144 + J * 32) = w0; *(LAS u32x4*)(KT + k * 144 + J * 32 + 16) = w1; }
        hg_it(C, h, tc, k, J, IT);
        if (J == 0) HGD[(size_t)((d * 4 + h) * NCH + c) * 128 + k] = __expf((T.tot[0] + T.tot[1]) + (T.tot[2] + T.tot[3]));
        __syncthreads();
        const int r = C.lane & 31, hh = C.lane >> 5, vb = C.wave >> 1;
        float* outp = HGL + (size_t)((d * 4 + h) * NCH + c) * 16384;
#pragma unroll
        for (int t2 = 0; t2 < 2; ++t2) {
            const int kb = 2 * (C.wave & 1) + t2;
            f32x16 acc;
#pragma unroll
            for (int i = 0; i < 16; ++i) acc[i] = 0.f;
#pragma unroll
            for (int st = 0; st < 4; ++st) {
                const bf16x8 af = *(const LAS bf16x8*)(IT + (32 * vb + r) * 144 + st * 32 + hh * 16);
                const bf16x8 bf = *(const LAS bf16x8*)(KT + (32 * kb + r) * 144 + st * 32 + hh * 16);
                acc = MFMA32(af, bf, acc);
            }
#pragma unroll
            for (int reg = 0; reg < 16; ++reg) outp[(size_t)(32 * vb + KOFF(reg) + 4 * hh) * 128 + 32 * kb + r] = acc[reg];
        }
    }
}
__device__ __forceinline__ void phase_hg_B(Ctx& C, int b0, int nb) {
    const float* HGL = WSP(float, OFF_HGL); const float* HGD = WSP(float, OFF_HGD); bf16_t* SPT = WSP(bf16_t, OFF_SPT);
    for (int e = b0 * NT + C.tid; e < 8 * 16384; e += nb * NT) {
        const int dh = e >> 14, vk = e & 16383, k = vk & 127;
        float st = 0.f;
        const float* p = HGL + (size_t)dh * NCH * 16384 + vk; const float* dp = HGD + (size_t)dh * NCH * 128 + k; bf16_t* o = SPT + (size_t)dh * NCH * 16384 + vk;
#pragma unroll 4
        for (int c = 0; c < NCH; ++c) { const float Lc = p[(size_t)c * 16384], Dc = dp[c * 128]; o[(size_t)c * 16384] = (bf16_t)f2bf(st); st = Dc * st + Lc; }
    }
}
__device__ __forceinline__ void phase_hg_C(Ctx& C, int l, int b0, int nb) {
    const float* P = WSP(float, OFF_P32); const bf16_t* SPT = WSP(bf16_t, OFF_SPT); bf16_t* YB = WSP(bf16_t, OFF_YB);
    LAS unsigned char* KS = C.lds;
    LAS unsigned char* QJ = C.lds + 17408;
    LAS unsigned char* IT = C.lds + 17408 + 69632;
    LAS float* TOT = (LAS float*)(C.lds + 105472);
    LAS float* RED = (LAS float*)(C.lds + 107520);
    const int k = C.tid & 127, J = C.tid >> 7;
    const int tl = C.lane & 15, qd = C.lane >> 4, I = C.wave >> 1, vh = C.wave & 1;
    for (int u = b0; u < 4 * NCH; u += nb) {
        const int h = u / NCH, tc = u % NCH;
        f32x4 oT[4];
#pragma unroll
        for (int i = 0; i < 4; ++i) oT[i] = (f32x4){0.f, 0.f, 0.f, 0.f};
#pragma unroll 1
        for (int d = 0; d < 2; ++d) {
            const int cd = d == 0 ? (tc + 4) % NCH : NCH - 1 - tc;
            __syncthreads();
            {
                HgThread T; hg_gates(C, l, d, h, tc, k, J, TOT, T);
                float qv[16];
#pragma unroll
                for (int i = 0; i < 16; ++i) qv[i] = P[(size_t)(64 * tc + 16 * J + i) * P32W + h * 128 + k];
#pragma unroll
                for (int i = 0; i < 16; ++i) *(LAS bf16_t*)(KS + (16 * J + i) * 272 + 2 * k) = (bf16_t)f2bf(T.kd[i] * __expf(fminf(-T.lc[i], 80.f)));
#pragma unroll
                for (int Jp = 0; Jp < 4; ++Jp) {
                    if (d == 0 ? (Jp > J) : (Jp < J)) continue;
                    float Pj = 0.f;
#pragma unroll
                    for (int m = 0; m < 4; ++m) if (d == 0 ? (m >= Jp && m < J) : (m > J && m <= Jp)) Pj += T.tot[m];
#pragma unroll
                    for (int i = 0; i < 16; ++i) *(LAS bf16_t*)(QJ + (Jp * 64 + 16 * J + i) * 272 + 2 * k) = (bf16_t)f2bf(qv[i] * __expf(T.lc[i] + Pj));
                }
                hg_it(C, h, tc, k, J, IT);
            }
            __syncthreads();
            u32x2 att[4];
#pragma unroll
            for (int Jb = 0; Jb < 4; ++Jb) {
                att[Jb] = (u32x2){0u, 0u};
                if (d == 0 ? (Jb > I) : (Jb < I)) continue;
                f32x4 acc = {0.f, 0.f, 0.f, 0.f};
#pragma unroll
                for (int ks = 0; ks < 4; ++ks) {
                    const bf16x8 af = *(const LAS bf16x8*)(KS + (16 * Jb + tl) * 272 + ks * 64 + qd * 16);
                    const bf16x8 bf = *(const LAS bf16x8*)(QJ + (Jb * 64 + 16 * I + tl) * 272 + ks * 64 + qd * 16);
                    acc = MFMA16(af, bf, acc);
                }
                if (Jb == I) {
#pragma unroll
                    for (int reg = 0; reg < 4; ++reg) { const int sl = 4 * qd + reg; const bool valid = d == 0 ? (sl <= tl) : (sl >= tl); acc[reg] = valid ? acc[reg] : 0.f; }
                }
                att[Jb].x = pk2(acc[0], acc[1]); att[Jb].y = pk2(acc[2], acc[3]);
            }
#pragma unroll
            for (int pr = 0; pr < 2; ++pr) {
                const int Ja = 2 * pr, Jc = 2 * pr + 1;
                const bool anyv = d == 0 ? (Ja <= I) : (Jc >= I);
                if (!anyv) continue;
                u32x4 bw; bw.x = att[Ja].x; bw.y = att[Ja].y; bw.z = att[Jc].x; bw.w = att[Jc].y;
                const bf16x8 bf = __builtin_bit_cast(bf16x8, bw);
#pragma unroll
                for (int vb = 0; vb < 4; ++vb) {
                    const int v = 16 * (4 * vh + vb) + tl;
                    const u32x2 a0 = *(const LAS u32x2*)(IT + v * 144 + Ja * 32 + qd * 8), a1 = *(const LAS u32x2*)(IT + v * 144 + Jc * 32 + qd * 8);
                    u32x4 aw; aw.x = a0.x; aw.y = a0.y; aw.z = a1.x; aw.w = a1.y;
                    oT[vb] = MFMA16(__builtin_bit_cast(bf16x8, aw), bf, oT[vb]);
                }
            }
            const bf16_t* sp = SPT + (size_t)((d * 4 + h) * NCH + cd) * 16384;
            const int Je = d == 0 ? 0 : 3;
#pragma unroll
            for (int ks = 0; ks < 4; ++ks) {
                const bf16x8 bf = *(const LAS bf16x8*)(QJ + (Je * 64 + 16 * I + tl) * 272 + ks * 64 + qd * 16);
#pragma unroll
                for (int vb = 0; vb < 4; ++vb) {
                    const bf16x8 af = *(const bf16x8*)(sp + (size_t)(16 * (4 * vh + vb) + tl) * 128 + ks * 32 + qd * 8);
                    oT[vb] = MFMA16(af, bf, oT[vb]);
                }
            }
        }
        float ss = 0.f;
#pragma unroll
        for (int vb = 0; vb < 4; ++vb) ss += (oT[vb][0] * oT[vb][0] + oT[vb][1] * oT[vb][1]) + (oT[vb][2] * oT[vb][2] + oT[vb][3] * oT[vb][3]);
        ss += __shfl_xor(ss, 16); ss += __shfl_xor(ss, 32);
        __syncthreads();
        if (qd == 0) RED[C.wave * 16 + tl] = ss;
        __syncthreads();
        const float rstd = rsqrtf((RED[(2 * I) * 16 + tl] + RED[(2 * I + 1) * 16 + tl]) * (1.0f / 128.0f) + EPS);
        const int row = 64 * tc + 16 * I + tl;
#pragma unroll
        for (int vb = 0; vb < 4; ++vb) {
            const int v0 = 16 * (4 * vh + vb) + 4 * qd;
            const f32x4 nw = *(const f32x4*)(C.ka->in[I_HGNORM] + l * 512 + h * 128 + v0);
            const f32x4 gv = *(const f32x4*)(P + (size_t)row * P32W + 2048 + h * 128 + v0);
            u32x2 w; w.x = pg8::cvt_pk_bf16(oT[vb][0] * rstd * nw.x * siluf_(gv.x), oT[vb][1] * rstd * nw.y * siluf_(gv.y));
            w.y = pg8::cvt_pk_bf16(oT[vb][2] * rstd * nw.z * siluf_(gv.z), oT[vb][3] * rstd * nw.w * siluf_(gv.w));
            *(u32x2*)(YB + (size_t)row * 512 + h * 128 + v0) = w;
        }
    }
}

template <int CTRL> __device__ __forceinline__ float dppf(float x) { return __builtin_bit_cast(float, __builtin_amdgcn_mov_dpp(__builtin_bit_cast(int, x), CTRL, 0xf, 0xf, true)); }
__device__ __forceinline__ float row16_sum(float x) { x += dppf<0xB1>(x); x += dppf<0x4E>(x); x += dppf<0x124>(x); x += dppf<0x128>(x); return x; }
constexpr int RW_NJOBS = 64;
__device__ __forceinline__ void phase_rw_scan(Ctx& C, int b0, int nb) {
    const float* SCN = WSP(float, OFF_SCN); const float* VV = WSP(float, OFF_VV); float* RO = WSP(float, OFF_RO);
    constexpr int STEPS = 32, SW = 384, NCHK = MT / STEPS;
    LAS float* buf = (LAS float*)C.lds;
    for (int job = b0; job < RW_NJOBS; job += nb) {
        const int d = job >> 5, h = (job >> 2) & 7, rq = job & 3;
        const float* src = SCN + (size_t)((d * 8 + h) * MT) * 320;
        const int lt = C.tid - 256;
        __syncthreads();
        if (C.wave >= 4) {
#pragma unroll
            for (int i = 0; i < 12; ++i) { const int q = lt + 256 * i, st = q / 96, w = q % 96;
                const f32x4 v = w < 80 ? *(const f32x4*)(src + (size_t)st * 320 + w * 4) : *(const f32x4*)(VV + (size_t)seq_row(d, st) * 512 + h * 64 + (w - 80) * 4);
                *(LAS f32x4*)(buf + q * 4) = v; }
        }
        __syncthreads();
        float S0 = 0.f, S1 = 0.f, S2 = 0.f, S3 = 0.f;
        const int rw = C.lane >> 4, ks = C.lane & 15, srow = rq * 16 + C.wave * 4 + rw;
#pragma unroll 1
        for (int ci = 0; ci < NCHK; ++ci) {
            if (C.wave >= 4) {
                if (ci + 1 < NCHK) {
                    f32x4 regs[12];
#pragma unroll
                    for (int i = 0; i < 12; ++i) { const int q = lt + 256 * i, st = q / 96, w = q % 96, j = STEPS * (ci + 1) + st;
                        regs[i] = w < 80 ? *(const f32x4*)(src + (size_t)j * 320 + w * 4) : *(const f32x4*)(VV + (size_t)seq_row(d, j) * 512 + h * 64 + (w - 80) * 4); }
#pragma unroll
                    for (int i = 0; i < 12; ++i) { const int q = lt + 256 * i; *(LAS f32x4*)(buf + ((ci + 1) & 1) * STEPS * SW + q * 4) = regs[i]; }
                }
            } else {
                const LAS float* bb = buf + (ci & 1) * STEPS * SW;
                const LAS float* sp = bb + 4 * ks;
                f32x4 w = *(const LAS f32x4*)(sp), kk = *(const LAS f32x4*)(sp + 64), ak = *(const LAS f32x4*)(sp + 128), kd = *(const LAS f32x4*)(sp + 192), rr = *(const LAS f32x4*)(sp + 256);
                float vv = bb[320 + srow];
#pragma unroll 1
                for (int hs = 0; hs < 2; ++hs) {
                    float ocol = 0.f;
#pragma unroll 4
                    for (int s16 = 0; s16 < 16; ++s16) {
                        const int stn = (hs * 16 + s16 + 1) & 31;
                        const LAS float* spn = bb + stn * SW + 4 * ks;
                        const f32x4 wn = *(const LAS f32x4*)(spn), kkn = *(const LAS f32x4*)(spn + 64), akn = *(const LAS f32x4*)(spn + 128), kdn = *(const LAS f32x4*)(spn + 192), rrn = *(const LAS f32x4*)(spn + 256);
                        const float vvn = bb[stn * SW + 320 + srow];
                        __builtin_amdgcn_sched_barrier(0);
                        const float dot = row16_sum((S0 * kk.x + S1 * kk.y) + (S2 * kk.z + S3 * kk.w));
                        S0 = S0 * w.x + (vv * kd.x - dot * ak.x); S1 = S1 * w.y + (vv * kd.y - dot * ak.y);
                        S2 = S2 * w.z + (vv * kd.z - dot * ak.z); S3 = S3 * w.w + (vv * kd.w - dot * ak.w);
                        const float od = row16_sum((S0 * rr.x + S1 * rr.y) + (S2 * rr.z + S3 * rr.w));
                        ocol = (ks == s16) ? od : ocol;
                        w = wn; kk = kkn; ak = akn; kd = kdn; rr = rrn; vv = vvn;
                    }
                    RO[((size_t)d * MT + seq_row(d, STEPS * ci + hs * 16 + ks)) * 512 + h * 64 + srow] = ocol;
                }
            }
            __syncthreads();
        }
    }
}
__device__ __forceinline__ void phase_rw_finish(Ctx& C, int l, int w0, int nw) {
    const float* SCN = WSP(float, OFF_SCN); const float* VV = WSP(float, OFF_VV); const float* GS = WSP(float, OFF_GS); const float* RO = WSP(float, OFF_RO);
    bf16_t* YB = WSP(bf16_t, OFF_YB) + (size_t)1 * MT * 512;
    const int e = C.lane;
    for (int uidx = w0; uidx < MT * 8; uidx += nw) {
        const int r = uidx >> 3, h = uidx & 7, c = h * 64 + e;
        const float o = RO[(size_t)r * 512 + c] + RO[((size_t)MT + r) * 512 + c];
        const float mu = wave_sum(o) * (1.0f / 64.0f);
        const float dv = o - mu;
        const float var = wave_sum(dv * dv) * (1.0f / 64.0f);
        const float on = dv * rsqrtf(var + RW_GN_EPS) * C.ka->in[I_RWLNW][l * 512 + c] + C.ka->in[I_RWLNB][l * 512 + c];
        const float* s0 = SCN + ((size_t)((0 * 8 + h) * MT + row_seq(0, r))) * 320 + e;
        const float* s1 = SCN + ((size_t)((1 * 8 + h) * MT + row_seq(1, r))) * 320 + e;
        const float kdsum = s0[192] + s1[192], rr = s0[256];
        const float bonus = wave_sum(rr * kdsum * C.ka->in[I_RWRK][l * 512 + c]);
        const float y = (on + bonus * VV[(size_t)r * 512 + c]) * GS[(size_t)r * 512 + c];
        YB[(size_t)r * 512 + c] = (bf16_t)f2bf(y);
    }
}

typedef float f32x4u __attribute__((ext_vector_type(4), aligned(4)));
__device__ __forceinline__ float swap32_sum(float x) { auto t = __builtin_amdgcn_permlane32_swap(__float_as_uint(x), __float_as_uint(x), false, false); return __uint_as_float(t[0]) + __uint_as_float(t[1]); }
__device__ __forceinline__ f32x16 qk_tile(const bf16_t* Kp  , const bf16x8 (&qf)[4], int r, int h) {
    f32x16 acc;
#pragma unroll
    for (int i = 0; i < 16; ++i) acc[i] = 0.f;
    const bf16_t* p = Kp + (size_t)r * PAW + 8 * h;
#pragma unroll
    for (int s = 0; s < 4; ++s) { const bf16x8 kf = *(const bf16x8*)(p + 16 * s); acc = MFMA32(kf, qf[s], acc); }
    return acc;
}
__device__ __forceinline__ void pv_tile(f32x16 (&o)[2], const bf16_t* VTp  , const f32x16& p, int r, int h) {
#pragma unroll
    for (int s = 0; s < 2; ++s) {
        u32x4 pw; pw.x = pg8::cvt_pk_bf16(p[8 * s + 0], p[8 * s + 1]); pw.y = pg8::cvt_pk_bf16(p[8 * s + 2], p[8 * s + 3]); pw.z = pg8::cvt_pk_bf16(p[8 * s + 4], p[8 * s + 5]); pw.w = pg8::cvt_pk_bf16(p[8 * s + 6], p[8 * s + 7]);
        const bf16x8 pb = __builtin_bit_cast(bf16x8, pw);
#pragma unroll
        for (int blk = 0; blk < 2; ++blk) {
            const bf16_t* vp = VTp + (size_t)(32 * blk + r) * MT + 16 * s + 4 * h;
            const u32x2 lo = *(const u32x2*)vp, hi = *(const u32x2*)(vp + 8);
            u32x4 vw; vw.x = lo.x; vw.y = lo.y; vw.z = hi.x; vw.w = hi.y;
            o[blk] = MFMA32(__builtin_bit_cast(bf16x8, vw), pb, o[blk]);
        }
    }
}
__device__ __forceinline__ void phase_attn(Ctx& C, int l, int w0, int nw) {
    const bf16_t* PA = WSP(bf16_t, OFF_PA); bf16_t* YB = WSP(bf16_t, OFF_YB);
    const bf16_t* VTN = WSP(bf16_t, OFF_VTN); const bf16_t* VTW = WSP(bf16_t, OFF_VTW);
    const float* PB = WSP(float, OFF_PB); const float* MREF = WSP(float, OFF_MREF);
    const int r = C.lane & 31, h = C.lane >> 5;
    constexpr int NJT = 2048 + 64;
    for (int job = w0; job < 2 * NJT; job += nw) {
        const int type = __builtin_amdgcn_readfirstlane(job / NJT), jj = __builtin_amdgcn_readfirstlane(job % NJT), qt = jj >> 3, hd = jj & 7;
        const int q0 = qt * 32;
        const bool lat = qt < 256;
        const float Mr = MREF[type];
        bf16x8 qf[4];
        { const bf16_t* qp = PA + (size_t)(q0 + r) * PAW + (type == 0 ? 0 : 1536) + hd * 64 + 8 * h;
#pragma unroll
          for (int s = 0; s < 4; ++s) qf[s] = *(const bf16x8*)(qp + 16 * s); }
        f32x16 o[2];
#pragma unroll
        for (int i = 0; i < 16; ++i) { o[0][i] = 0.f; o[1][i] = 0.f; }
        float lsum = 0.f;
        const int kcol = type == 0 ? 512 + hd * 64 : 2048 + (hd >> 2) * 64;
        const bf16_t* VT = type == 0 ? VTN + (size_t)(hd * 64) * MT : VTW + (size_t)((hd >> 2) * 64) * MT;
        if (type == 0) {
            if (lat) {
                const int i = qt >> 1, j = (qt & 1) * 32 + r;
                int rs = i - 4; rs = rs < 0 ? 0 : (rs > 120 ? 120 : rs);
                int cs = j - 8; cs = cs < 0 ? 0 : (cs > 48 ? 48 : cs);
#pragma unroll 1
                for (int t = 0; t < 16; ++t) {
                    const int a = t >> 1, cc = t & 1;
                    const int key0 = (rs + a) * 64 + 32 * cc;
                    const f32x16 acc = qk_tile(PA + (size_t)key0 * PAW + kcol, qf, r, h);
                    const float* brow = PB + (size_t)(hd * 15 + (rs + a - i + 7)) * 128 + (32 * cc + 4 * h - j + 63);
                    const int lo = cs - 32 * cc - 4 * h;
                    f32x16 p;
#pragma unroll
                    for (int g = 0; g < 4; ++g) {
                        const f32x4u b4 = *(const f32x4u*)(brow + 8 * g);
#pragma unroll
                        for (int q = 0; q < 4; ++q) { const int reg = 4 * g + q; const bool valid = (unsigned)(KOFF(reg) - lo) < 16u;
                            const float e = __expf(acc[reg] + b4[q] - Mr); p[reg] = valid ? e : 0.f; lsum += p[reg]; }
                    }
                    pv_tile(o, VT + key0, p, r, h);
                }
            }
        } else {
            if (lat) {
#pragma unroll 1
                for (int dl = -4; dl <= 4; ++dl) {
                    const int kt = qt + dl;
                    if (kt < 0 || kt > 255) continue;
                    const int key0 = kt * 32;
                    const f32x16 acc = qk_tile(PA + (size_t)key0 * PAW + kcol, qf, r, h);
                    f32x16 p;
#pragma unroll
                    for (int reg = 0; reg < 16; ++reg) { const int kr = KOFF(reg) + 4 * h; const bool valid = dl == -4 ? (kr >= r) : (dl == 4 ? (kr <= r) : true);
                        const float e = __expf(acc[reg] - Mr); p[reg] = valid ? e : 0.f; lsum += p[reg]; }
                    pv_tile(o, VT + key0, p, r, h);
                }
            }
        }
#pragma unroll 1
        for (int t = 0; t < CTX / 32; ++t) {
            const int key0 = SEQ + 32 * t;
            const f32x16 acc = qk_tile(PA + (size_t)key0 * PAW + kcol, qf, r, h);
            f32x16 p;
#pragma unroll
            for (int reg = 0; reg < 16; ++reg) { p[reg] = __expf(acc[reg] - Mr); lsum += p[reg]; }
            pv_tile(o, VT + key0, p, r, h);
        }
        float ltot = swap32_sum(lsum);
        if (type == 1) ltot += __expf(C.ka->in[I_WASINK][l * 8 + hd] - Mr);
        const float inv = 1.0f / ltot;
        bf16_t* yp = YB + (size_t)(2 + type) * MT * 512 + (size_t)(q0 + r) * 512 + hd * 64 + 4 * h;
#pragma unroll
        for (int blk = 0; blk < 2; ++blk)
#pragma unroll
            for (int g = 0; g < 4; ++g) {
                u32x2 w; w.x = pg8::cvt_pk_bf16(o[blk][4 * g] * inv, o[blk][4 * g + 1] * inv); w.y = pg8::cvt_pk_bf16(o[blk][4 * g + 2] * inv, o[blk][4 * g + 3] * inv);
                *(u32x2*)(yp + 32 * blk + 8 * g) = w;
            }
    }
}
__device__ __forceinline__ void phase_attn_tables(Ctx& C, int l, int w0, int nw) {
    const bf16_t* PA = WSP(bf16_t, OFF_PA); bf16_t* VTN = WSP(bf16_t, OFF_VTN); bf16_t* VTW = WSP(bf16_t, OFF_VTW);
    LAS unsigned char* tile = C.lds + C.wave * 9216;
    const int lane = C.lane;
    for (int u = w0; u < 10 * NCH; u += nw) {
        const int hd = u / NCH, tt = u % NCH, t0 = tt * 64;
        const int vcol = hd < 8 ? 1024 + hd * 64 : 2176 + (hd - 8) * 64;
#pragma unroll
        for (int it = 0; it < 8; ++it) { const int row = 8 * it + (lane >> 3), ch = lane & 7;
            *(LAS u32x4*)(tile + row * 144 + ch * 16) = *(const u32x4*)(PA + (size_t)(t0 + row) * PAW + vcol + ch * 8); }
        LDS_WAIT(); asm volatile("" ::: "memory");
        bf16_t* dst = (hd < 8 ? VTN + (size_t)(hd * 64 + lane) * MT : VTW + (size_t)((hd - 8) * 64 + lane) * MT) + t0;
#pragma unroll
        for (int it = 0; it < 8; ++it) {
            unsigned e[8];
#pragma unroll
            for (int j = 0; j < 8; ++j) e[j] = *(const LAS bf16_t*)(tile + (8 * it + j) * 144 + 2 * lane);
            u32x4 w; w.x = e[0] | (e[1] << 16); w.y = e[2] | (e[3] << 16); w.z = e[4] | (e[5] << 16); w.w = e[6] | (e[7] << 16);
            *(u32x4*)(dst + 8 * it) = w;
        }
        LDS_WAIT(); asm volatile("" ::: "memory");
    }
    float* PB = WSP(float, OFF_PB);
    const float* rpb = C.ka->in[I_NARPB] + (size_t)l * 8 * 15 * 31;
    for (int idx = w0 * 64 + lane; idx < 8 * 15 * 128; idx += nw * 64) { const int x = idx & 127, hr = idx >> 7; PB[idx] = (x >= 48 && x < 79) ? rpb[hr * 31 + x - 48] : 0.f; }
    if (w0 == 0) {
        float mb = 0.f;
        for (int i = lane; i < 8 * 15 * 31; i += 64) mb = fmaxf(mb, fabsf(rpb[i]));
        mb = wave_max(mb);
        const float nq = wave_max(fabsf(C.ka->in[I_NAQN][l * 64 + lane])), nk = wave_max(fabsf(C.ka->in[I_NAKN][l * 64 + lane]));
        const float wq = wave_max(fabsf(C.ka->in[I_WAQN][l * 64 + lane])), wk = wave_max(fabsf(C.ka->in[I_WAKN][l * 64 + lane]));
        const float sk = wave_max(lane < 8 ? C.ka->in[I_WASINK][l * 8 + lane] : -1e30f);
        if (lane == 0) { float* M = WSP(float, OFF_MREF); M[0] = 8.08f * nq * nk + mb; M[1] = fmaxf(8.08f * wq * wk, sk); }
    }
}

__device__ __forceinline__ void phase_combine(Ctx& C) {
    const bf16_t* PROJ = WSP(bf16_t, OFF_P32); bf16_t* MG = WSP(bf16_t, OFF_H);
    const size_t n8 = (size_t)MT * D / 8;
    for (size_t i = (size_t)C.bid * NT + C.tid; i < n8; i += (size_t)C.G * NT) {
        const size_t r = i / (D / 8), c8 = i % (D / 8);
        float a[8];
#pragma unroll
        for (int j = 0; j < 8; ++j) a[j] = 0.f;
#pragma unroll
        for (int g = 0; g < 4; ++g) {
            const u32x4 w = *(const u32x4*)(PROJ + r * GLW + g * D + c8 * 8);
            a[0] += bf2f(w.x & 0xffffu); a[1] += bf2f(w.x >> 16); a[2] += bf2f(w.y & 0xffffu); a[3] += bf2f(w.y >> 16);
            a[4] += bf2f(w.z & 0xffffu); a[5] += bf2f(w.z >> 16); a[6] += bf2f(w.w & 0xffffu); a[7] += bf2f(w.w >> 16);
        }
        u32x4 o; o.x = pk2(a[0], a[1]); o.y = pk2(a[2], a[3]); o.z = pk2(a[4], a[5]); o.w = pk2(a[6], a[7]);
        *(u32x4*)(MG + r * D + c8 * 8) = o;
    }
}

constexpr int PH_PRO = 2, PH_PER_LAYER = 14, N_PHASES = PH_PRO + DEPTH * PH_PER_LAYER;

__global__ void __launch_bounds__(NT, 2) mk_fwd(Args args) {
    extern __shared__ __attribute__((aligned(16))) unsigned char lds_raw[];
    Ctx C;
    C.lds = (LAS unsigned char*)lds_raw;
    C.tid = threadIdx.x; C.lane = C.tid & 63; C.wave = __builtin_amdgcn_readfirstlane(C.tid >> 6);
    C.bid = blockIdx.x; C.G = gridDim.x;
    C.ka = (const Args __attribute__((address_space(4)))*)__builtin_amdgcn_kernarg_segment_ptr(); C.out = args.out; C.ws = args.ws;
    volatile LAS unsigned* MISC = (volatile LAS unsigned*)(C.lds + MISC_OFF);
    for (int u = C.tid; u < (LDS_BYTES - RING_BYTES) / 4; u += NT) ((LAS unsigned*)(C.lds + RING_BYTES))[u] = 0u;
    __syncthreads();
    const int lo = args.ph_lo, hi = args.ph_hi;
    XcdBarrier bar; bar.bar = WSP(unsigned, OFF_CTL) + 4096; bar.x = 0; bar.st = nullptr;
    const bool multi = (hi - lo) > 1;
    if (multi) bar = xcd_barrier_post(WSP(unsigned, OFF_CTL) + 4096, MISC + 8);
#ifndef PH_MASK
#define PH_MASK 0xFFFF
#endif
#ifndef PRO_MASK
#define PRO_MASK 3
#endif
#define IN(k) (lo <= (k) && (k) < hi)
#define LEN(j) (((PH_MASK) >> (j)) & 1)
#define SEAM(k) do { if (IN(k) && IN((k) + 1)) xcd_barrier(bar); } while (0)

    if ((PRO_MASK & 1) && IN(0)) { relaunder(C); phase_convert(C, 0); phase_ada_partial(C); } SEAM(0);
    if ((PRO_MASK & 2) && IN(1)) { relaunder(C); phase_ada_reduce(C); } SEAM(1);

#pragma unroll
    for (int l = 0; l < DEPTH; ++l) {
        const int pb = PH_PRO + l * PH_PER_LAYER;
        if (LEN(0) && IN(pb + 0)) { relaunder(C); if (l > 0) phase_convert(C, l); phase_norm(C, l, C.ka->in[I_NF1] + (size_t)l * D, 0); } SEAM(pb + 0);
        if (LEN(1) && IN(pb + 1)) { relaunder(C);
            pg8::Gemm g{WSP(bf16_t, OFF_H), WSP(bf16_t, OFF_WI1), MT, 2 * DFF, D, 1 << 20, 0};
            pg8::StaticOrder S; S.init(MT, 2 * DFF, C.G, C.bid);
            pg8::EpiSwiGLU E{WSP(bf16_t, OFF_G)};
            pg8::gemm_phase<pg8::EpiSwiGLU, true, false>(C.lds, g, S, E, C.tid);
        } SEAM(pb + 1);
        if (LEN(2) && IN(pb + 2)) { relaunder(C);
            pg8::Gemm g{WSP(bf16_t, OFF_G), WSP(bf16_t, OFF_WO1), MT, D, DFF, 1 << 20, 0};
            pg8::StaticOrder S; S.init(MT, D, C.G, C.bid);
            pg8::EpiResid<true> E{WSP(float, OFF_X), mod_ptr(C, l, 0, 2), mod_ptr(C, l, 1, 2), nullptr};
            pg8::gemm_phase<pg8::EpiResid<true>, true, false>(C.lds, g, S, E, C.tid);
        } SEAM(pb + 2);
        if (LEN(3) && IN(pb + 3)) { relaunder(C); phase_norm(C, l, C.ka->in[I_NMIX] + (size_t)l * D, 3); if (PROBE_MODE == 2) phase_norm(C, l, C.ka->in[I_NMIX] + (size_t)l * D, 3); } SEAM(pb + 3);
        if (LEN(4) && IN(pb + 4)) { relaunder(C);
            pg8::Gemm g{WSP(bf16_t, OFF_H), WSP(bf16_t, OFF_WIN), MT, P32W + PAW, D, 1 << 20, 0};
            pg8::StaticOrder S; S.init(MT, P32W + PAW, C.G, C.bid);
            pg8::EpiWin E{WSP(float, OFF_P32), WSP(bf16_t, OFF_PA), WSP(bf16_t, OFF_GL), 0};
            pg8::gemm_phase<pg8::EpiWin, true, false>(C.lds, g, S, E, C.tid);
        } SEAM(pb + 4);
        if (LEN(5) && IN(pb + 5)) { relaunder(C);
            phase_rw_prep(C, l, C.bid, C.G);
            if (PROBE_MODE == 1) { __syncthreads(); phase_rw_prep(C, l, C.bid, C.G); }
            __syncthreads();
            phase_attn_prep(C, l, C.bid * NWAVES + C.wave, C.G * NWAVES);
            phase_attn_tables(C, l, C.bid * NWAVES + C.wave, C.G * NWAVES);
            if (PROBE_MODE == 1) phase_attn_tables(C, l, C.bid * NWAVES + C.wave, C.G * NWAVES);
            __syncthreads();
            phase_hg_A(C, l, C.bid, C.G);
            if (PROBE_MODE == 1) phase_hg_A(C, l, C.bid, C.G);
        } SEAM(pb + 5);
        if (LEN(6) && IN(pb + 6)) { relaunder(C);
            if (C.G >= 256) {
                if (C.bid < RW_NJOBS) phase_rw_scan(C, C.bid, RW_NJOBS);
                else { const int b = C.bid - RW_NJOBS, n = C.G - RW_NJOBS; phase_hg_B(C, b, n); phase_attn(C, l, b * NWAVES + C.wave, n * NWAVES);
                    __syncthreads();
                    pg8::Gemm g{WSP(bf16_t, OFF_H), WSP(bf16_t, OFF_WIN) + (size_t)(P32W + PAW) * D, MT, GLW, D, 1 << 20, 0};
                    pg8::StaticOrder S; S.init(MT, GLW, n, b);
                    pg8::EpiWin E{WSP(float, OFF_P32), WSP(bf16_t, OFF_PA), WSP(bf16_t, OFF_GL), 28};
                    pg8::gemm_phase<pg8::EpiWin, true, false>(C.lds, g, S, E, C.tid); }
            } else {
                phase_rw_scan(C, C.bid, C.G); phase_hg_B(C, C.bid, C.G); phase_attn(C, l, C.bid * NWAVES + C.wave, C.G * NWAVES);
                __syncthreads();
                pg8::Gemm g{WSP(bf16_t, OFF_H), WSP(bf16_t, OFF_WIN) + (size_t)(P32W + PAW) * D, MT, GLW, D, 1 << 20, 0};
                pg8::StaticOrder S; S.init(MT, GLW, C.G, C.bid);
                pg8::EpiWin E{WSP(float, OFF_P32), WSP(bf16_t, OFF_PA), WSP(bf16_t, OFF_GL), 28};
                pg8::gemm_phase<pg8::EpiWin, true, false>(C.lds, g, S, E, C.tid);
            }
        } SEAM(pb + 6);
        if (LEN(7) && IN(pb + 7)) { relaunder(C); phase_hg_C(C, l, C.bid, C.G); phase_rw_finish(C, l, C.bid * NWAVES + C.wave, C.G * NWAVES);
            if (PROBE_MODE == 2) { phase_hg_C(C, l, C.bid, C.G); phase_rw_finish(C, l, C.bid * NWAVES + C.wave, C.G * NWAVES); } } SEAM(pb + 7);
        if (LEN(8) && IN(pb + 8)) { relaunder(C);
            pg8::Gemm g{WSP(bf16_t, OFF_YB), WSP(bf16_t, OFF_WBR), MT, 4 * D, 512, 8, (size_t)MT * 512};
            pg8::StaticOrder S; S.init(MT, 4 * D, C.G, C.bid);
            pg8::EpiMerge E{WSP(bf16_t, OFF_GL), WSP(bf16_t, OFF_P32)};
            pg8::gemm_phase<pg8::EpiMerge, true, false>(C.lds, g, S, E, C.tid);
        } SEAM(pb + 8);
        if (LEN(9) && IN(pb + 9)) { relaunder(C); phase_combine(C); if (PROBE_MODE == 2) phase_combine(C); } SEAM(pb + 9);
        if (LEN(10) && IN(pb + 10)) { relaunder(C);
            pg8::Gemm g{WSP(bf16_t, OFF_H), WSP(bf16_t, OFF_WOUT), MT, D, D, 1 << 20, 0};
            pg8::StaticOrder S; S.init(MT, D, C.G, C.bid);
            pg8::EpiResid<false> E{WSP(float, OFF_X), mod_ptr(C, l, 0, 5), mod_ptr(C, l, 1, 5), nullptr};
            pg8::gemm_phase<pg8::EpiResid<false>, true, false>(C.lds, g, S, E, C.tid);
        } SEAM(pb + 10);
        if (LEN(11) && IN(pb + 11)) { relaunder(C); phase_norm(C, l, C.ka->in[I_NF2] + (size_t)l * D, 6); if (PROBE_MODE == 2) phase_norm(C, l, C.ka->in[I_NF2] + (size_t)l * D, 6); } SEAM(pb + 11);
        if (LEN(12) && IN(pb + 12)) { relaunder(C);
            pg8::Gemm g{WSP(bf16_t, OFF_H), WSP(bf16_t, OFF_WI2), MT, 2 * DFF, D, 1 << 20, 0};
            pg8::StaticOrder S; S.init(MT, 2 * DFF, C.G, C.bid);
            pg8::EpiSwiGLU E{WSP(bf16_t, OFF_G)};
            pg8::gemm_phase<pg8::EpiSwiGLU, true, false>(C.lds, g, S, E, C.tid);
        } SEAM(pb + 12);
        if (LEN(13) && IN(pb + 13)) { relaunder(C);
            pg8::Gemm g{WSP(bf16_t, OFF_G), WSP(bf16_t, OFF_WO2), MT, D, DFF, 1 << 20, 0};
            pg8::StaticOrder S; S.init(MT, D, C.G, C.bid);
            pg8::EpiResid<true> E{WSP(float, OFF_X), mod_ptr(C, l, 0, 8), mod_ptr(C, l, 1, 8), l == DEPTH - 1 ? C.out : nullptr};
            pg8::gemm_phase<pg8::EpiResid<true>, true, false>(C.lds, g, S, E, C.tid);
        } SEAM(pb + 13);
    }
#undef IN
#undef SEAM
}

extern "C" void kernel_launch(void* const* d_in, const int* in_sizes, int n_in, void* d_out, int out_size, void* d_ws, size_t ws_size, hipStream_t stream) {
    static int grid = 0;
    if (grid == 0) {
        if (n_in != N_IN || out_size != SEQ * D || ws_size < WS_END) { fprintf(stderr, "kernel_launch: unexpected shapes (n_in %d out %d ws %zu)\n", n_in, out_size, ws_size); grid = -1; return; }
        int dev = 0, cus = 0;
        if (hipGetDevice(&dev) != hipSuccess || hipDeviceGetAttribute(&cus, hipDeviceAttributeMultiprocessorCount, dev) != hipSuccess) { grid = -1; return; }
        if (hipFuncSetAttribute((const void*)mk_fwd, hipFuncAttributeMaxDynamicSharedMemorySize, LDS_BYTES) != hipSuccess) { fprintf(stderr, "kernel_launch: hipFuncSetAttribute failed\n"); grid = -1; return; }
        (void)hipGetLastError();
        grid = cus;
    }
    if (grid < 0) return;
    (void)hipMemsetAsync((char*)d_ws + OFF_CTL, 0, CTL_BYTES, stream);
    Args a{};
    for (int i = 0; i < N_IN; ++i) a.in[i] = (const float*)d_in[i];
    a.out = (float*)d_out; a.ws = (unsigned char*)d_ws;
#if MK_ONE_LAUNCH
    a.ph_lo = 0; a.ph_hi = N_PHASES;
    hipLaunchKernelGGL(mk_fwd, dim3(grid), dim3(NT), LDS_BYTES, stream, a);
#else
    for (int ph = 0; ph < N_PHASES; ++ph) {
        a.ph_lo = ph; a.ph_hi = ph + 1;
        hipLaunchKernelGGL(mk_fwd, dim3(grid), dim3(NT), LDS_BYTES, stream, a);
    }
#endif
}
```

```cpp
#include <hip/hip_runtime.h>
#include <cstdio>
#include <cstdint>

#ifndef PROBE_MODE
#define PROBE_MODE 0
#endif
#ifndef MK_ONE_LAUNCH
#define MK_ONE_LAUNCH 1
#endif

#define LAS __attribute__((address_space(3)))
#define GAS __attribute__((address_space(1)))
typedef unsigned short bf16_t;
typedef short bf16x8 __attribute__((ext_vector_type(8)));
typedef float f32x4 __attribute__((ext_vector_type(4)));
typedef float f32x2 __attribute__((ext_vector_type(2)));
typedef unsigned u32x4 __attribute__((ext_vector_type(4)));
typedef unsigned u32x2 __attribute__((ext_vector_type(2)));

constexpr int D = 2048, SEQ = 8192, CTX = 256, MT = SEQ + CTX, DEPTH = 2, DFF = 5632, NMOD = 9, MODW = NMOD * D;
constexpr int GRID_W = 64;
constexpr int PTOT = 15360, P32W = 4864, PAW = 2304, GLW = 8192;
constexpr int HG_OFF = 0, RW_OFF = 2560, RWC = 2304;
constexpr int NCH = MT / 64;
constexpr int NWAVES = 8, NT = 512;
constexpr float EPS = 1e-6f, RW_GN_EPS = 64e-5f;

constexpr size_t MiB = 1u << 20;
constexpr size_t OFF_CTL = 0, CTL_BYTES = 1 * MiB;
constexpr size_t OFF_MOD = 1 * MiB;
constexpr size_t OFF_MODP = 2 * MiB;
constexpr size_t OFF_WI1 = 11 * MiB, OFF_WO1 = 55 * MiB, OFF_WIN = 77 * MiB, OFF_WBR = 137 * MiB, OFF_WOUT = 145 * MiB, OFF_WI2 = 153 * MiB, OFF_WO2 = 197 * MiB;
constexpr size_t OFF_X = 219 * MiB;
constexpr size_t OFF_H = 285 * MiB;
constexpr size_t OFF_G = 318 * MiB;
constexpr size_t OFF_P32 = 409 * MiB;
constexpr size_t OFF_PA = 566 * MiB;
constexpr size_t OFF_GL = 604 * MiB;
constexpr size_t OFF_HGL = 736 * MiB;
constexpr size_t OFF_HGD = 802 * MiB;
constexpr size_t OFF_SCN = 803 * MiB;
constexpr size_t OFF_VV = 968 * MiB;
constexpr size_t OFF_GS = 985 * MiB;
constexpr size_t OFF_RO = 1002 * MiB;
constexpr size_t OFF_YB = 1035 * MiB;
constexpr size_t OFF_VTN = 1068 * MiB;
constexpr size_t OFF_VTW = 1077 * MiB;
constexpr size_t OFF_PB = 1080 * MiB;
constexpr size_t OFF_MREF = OFF_PB + 65536;
constexpr size_t OFF_SPT = 1081 * MiB;
constexpr size_t OFF_BON = 1114 * MiB;
constexpr size_t WS_END = 1115 * MiB;
constexpr int RW_NCK = MT / 16;
constexpr size_t OFF_RWMG = OFF_G, RWMG_REC = 8192 + 2048;
constexpr size_t OFF_RWH = OFF_SCN, RWH_REC = 16384;
static_assert(16 * (size_t)RW_NCK * RWMG_REC <= 91 * MiB && 16 * (size_t)RW_NCK * RWH_REC <= 165 * MiB, "rwkv chunk records fit their regions");
constexpr int KSPLIT = 32;

constexpr int LDS_BYTES = 147456;
constexpr int RING_BYTES = 131072;
constexpr int MISC_OFF = RING_BYTES + 320;

__device__ __forceinline__ float bf2f(unsigned b) { return __uint_as_float(b << 16); }
__device__ __forceinline__ unsigned f2bf(float f) { unsigned u = __float_as_uint(f); return (u + 0x7fffu + ((u >> 16) & 1u)) >> 16; }
__device__ __forceinline__ unsigned pk2(float lo, float hi) { return f2bf(lo) | (f2bf(hi) << 16); }
__device__ __forceinline__ float wave_sum(float v) {
#pragma unroll
    for (int o = 1; o < 64; o <<= 1) v += __shfl_xor(v, o);
    return v;
}
__device__ __forceinline__ float wave_max(float v) {
#pragma unroll
    for (int o = 1; o < 64; o <<= 1) v = fmaxf(v, __shfl_xor(v, o));
    return v;
}
__device__ __forceinline__ float sigmoidf_(float x) { return 1.0f / (1.0f + expf(-x)); }
__device__ __forceinline__ float siluf_(float x) { return x / (1.0f + expf(-x)); }
typedef float f32x16 __attribute__((ext_vector_type(16)));
#define MFMA32(a, b, c) __builtin_amdgcn_mfma_f32_32x32x16_bf16((a), (b), (c), 0, 0, 0)
#define KOFF(reg) (((reg) & 3) + 8 * ((reg) >> 2))
#define MFMA16(a, b, c) __builtin_amdgcn_mfma_f32_16x16x32_bf16((a), (b), (c), 0, 0, 0)
#define LDS_WAIT() asm volatile("s_waitcnt lgkmcnt(0)" ::: "memory")

__device__ __forceinline__ int seq_row(int d, int j) { return d == 0 ? (j < CTX ? SEQ + j : j - CTX) : (MT - 1 - j); }
__device__ __forceinline__ int row_seq(int d, int r) { return d == 0 ? (r >= SEQ ? r - SEQ : r + CTX) : (MT - 1 - r); }

#define XB_TMO      128
#define XB_XCNT(j)  (256  + 64 * (j))
#define XB_XSUB(j)  (1280 + 64 * (j))
#define XB_XGEN(j)  (2304 + 64 * (j))
#define XB_TOP      3328
#define XB_TOPGEN   3392
#define XCD_BAR_WORDS 3456
#define XB_SPIN_CAP (1u << 18)
__device__ __forceinline__ unsigned xb_ld(unsigned* p)              { return __hip_atomic_load(p, __ATOMIC_RELAXED, __HIP_MEMORY_SCOPE_AGENT); }
__device__ __forceinline__ unsigned xb_add(unsigned* p, unsigned v) { return __hip_atomic_fetch_add(p, v, __ATOMIC_RELAXED, __HIP_MEMORY_SCOPE_AGENT); }
__device__ __forceinline__ unsigned xb_xcc_id() { return (unsigned)__builtin_amdgcn_s_getreg((3 << 11) | 20) & 0xFu; }
#define XB_SPIN(cond, bar) do { unsigned _sp = 0; while (cond) { __builtin_amdgcn_s_sleep(1); \
    if ((++_sp & 255u) == 0u) { if (xb_ld(&(bar)[XB_TMO])) break; if (_sp > XB_SPIN_CAP) { atomicAdd(&(bar)[XB_TMO], 1u); break; } } } } while (0)
struct XcdBarrier { unsigned* bar; unsigned x; volatile LAS unsigned* st; };
__device__ __forceinline__ XcdBarrier xcd_barrier_post(unsigned* bar, volatile LAS unsigned* st) {
    XcdBarrier b; b.bar = bar; b.x = xb_xcc_id(); b.st = st;
    if (threadIdx.x == 0) (void)xb_add(&bar[XB_XCNT(b.x)], 1u);
    return b;
}
__device__ __forceinline__ void xcd_barrier_complete(unsigned* bar, unsigned x, unsigned& nloc, unsigned& nx) {
    const unsigned G = gridDim.x * gridDim.y * gridDim.z;
    unsigned sum, cnt, mine, sp = 0u;
    for (;;) {
        sum = 0u; cnt = 0u; mine = 0u;
#pragma unroll
        for (unsigned j = 0; j < 16; ++j) { const unsigned c = xb_ld(&bar[XB_XCNT(j)]); sum += c; cnt += (c > 0u) ? 1u : 0u; mine = (j == x) ? c : mine; }
        if (sum == G) break;
        __builtin_amdgcn_s_sleep(1);
        if ((++sp & 255u) == 0u) { if (xb_ld(&bar[XB_TMO])) break; if (sp > XB_SPIN_CAP) { atomicAdd(&bar[XB_TMO], 1u); break; } }
    }
    nloc = mine > 0u ? mine : 1u; nx = cnt > 0u ? cnt : 1u;
}
__device__ __forceinline__ void xcd_barrier(const XcdBarrier& b) {
    asm volatile("s_waitcnt vmcnt(0)" ::: "memory");
    __syncthreads();
    if (threadIdx.x == 0) {
        unsigned* bar = b.bar;
        __builtin_amdgcn_s_waitcnt(0);
        unsigned nloc = b.st[0], nx = b.st[1];
        if (nloc == 0u) { xcd_barrier_complete(bar, b.x, nloc, nx); b.st[0] = nloc; b.st[1] = nx; }
        const unsigned old = xb_add(&bar[XB_XSUB(b.x)], 1u);
        const unsigned gen = old / nloc;
        if (old + 1u == (gen + 1u) * nloc) {
            __builtin_amdgcn_fence(__ATOMIC_RELEASE, "agent");
            asm volatile("s_waitcnt vmcnt(0)" ::: "memory");
            const unsigned og = xb_add(&bar[XB_TOP], 1u);
            const unsigned tg = og / nx;
            if (og + 1u == (tg + 1u) * nx) xb_add(&bar[XB_TOPGEN], 1u);
            else XB_SPIN(xb_ld(&bar[XB_TOPGEN]) == tg, bar);
            __builtin_amdgcn_fence(__ATOMIC_ACQUIRE, "agent");
            xb_add(&bar[XB_XGEN(b.x)], 1u);
            asm volatile("s_waitcnt vmcnt(0)" ::: "memory");
        } else {
            XB_SPIN(xb_ld(&bar[XB_XGEN(b.x)]) == gen, bar);
            __builtin_amdgcn_fence(__ATOMIC_ACQUIRE, "agent");
            asm volatile("s_waitcnt vmcnt(0)" ::: "memory");
        }
    }
    __syncthreads();
}

namespace pg8 {
constexpr int BM = 256, BK = 64, HALF = 128, HTB = HALF * BK * 2, STAGE_BYTES = 8 * HTB, NXCD = 8, WGM = 8;
__host__ __device__ __forceinline__ int lds_byte(int r, int c) { const int st = (r >> 4) * 2 + (c >> 5), rr = r & 15, cc = c & 31, ob = rr * 64 + cc * 2; return st * 1024 + (ob ^ (((ob >> 9) & 1) << 5)); }
__host__ __device__ __forceinline__ void stage_rc(int b, int& R, int& C) { const int st = b / 1024, sb = b % 1024, swz = sb ^ (((sb >> 9) & 1) << 5); R = (st >> 1) * 16 + swz / 64; C = (st & 1) * 32 + (swz % 64) / 2; }
__host__ __device__ __forceinline__ int perm32(int rho) { const int n = rho >> 4, i = rho & 15; return 8 * (i >> 2) + 4 * n + (i & 3); }
struct Unit { int pm, pn, ks; };
struct Gemm { const bf16_t* A; const bf16_t* Bt; int a_div; size_t a_gstride; };
struct StaticOrder {
    int nM, nN, nwg, G, c;
    __host__ __device__ void init(int M, int N, int G_, int c_) { nM = M / BM; nN = N / BM; nwg = nM * nN; G = G_; c = c_; }
    __host__ __device__ bool next(int i, Unit& u) const {
        const long L = (long)i * G + c; if (L >= nwg) return false;
        int wgid = (int)L; { const int q = nwg / NXCD, r = nwg % NXCD, xcd = wgid % NXCD, off = wgid / NXCD; wgid = (xcd < r ? xcd * (q + 1) : r * (q + 1) + (xcd - r) * q) + off; }
        const int nig = WGM * nN, gid = wgid / nig, fm = gid * WGM, gsz = (nM - fm) < WGM ? (nM - fm) : WGM;
        u.pm = fm + ((wgid % nig) % gsz); u.pn = (wgid % nig) / gsz; u.ks = 0; return true;
    }
};
struct SplitOrder {
    int pm, nN, KS, G, c;
    __host__ __device__ bool next(int i, Unit& u) const { const int L = i * G + c; if (L >= nN * KS) return false; u.pm = pm; u.pn = L / KS; u.ks = L % KS; return true; }
};
__device__ __forceinline__ unsigned cvt_pk_bf16(float lo, float hi) { unsigned r; asm volatile("v_cvt_pk_bf16_f32 %0, %1, %2" : "=v"(r) : "v"(lo), "v"(hi)); return r; }

template <class Epi, bool ALIGN_EPI, bool SP2, class Sched, int KE, int LDA, int LDB, int KSS>
__device__ __forceinline__ void gemm_phase(LAS unsigned char* lds, const Gemm g, const Sched& S, const Epi& E, const int tid) {
    const int wid = __builtin_amdgcn_readfirstlane(tid >> 6), lane = tid & 63, wr = wid >> 2, wc = wid & 3, fr = lane & 15, fq = lane >> 4;
    constexpr int nt = KE / BK;
    unsigned voffA[2], voffB[2];
#pragma unroll
    for (int i = 0; i < 2; ++i) { int R, C; stage_rc(tid * 16 + i * 8192, R, C); const int Rb = Epi::PERM ? ((R & ~31) + perm32(R & 31)) : R;
        voffA[i] = (unsigned)(R * LDA + C) * 2u; voffB[i] = (unsigned)(Rb * LDB + C) * 2u; }
    const size_t kstep = (size_t)(BK * 2);
    constexpr size_t hstepA = (size_t)HALF * LDA * 2, hstepB = (size_t)HALF * LDB * 2;
    const unsigned ldsw = (unsigned)wid * 1024u;
    const int aoff = lds_byte(wr * 64 + fr, fq * 8), boff = lds_byte(wc * 32 + fr, fq * 8);
#define PG8_SA(b, h) (((b) * 2 + (h)) * HTB)
#define PG8_SB(b, h) ((4 + (b) * 2 + (h)) * HTB)
#define PG8_STAGE(bufoff, gbase, voff) do { _Pragma("unroll") for (int _i = 0; _i < 2; ++_i) \
        __builtin_amdgcn_global_load_lds((const unsigned*)((const char*)(gbase) + (voff)[_i]), (LAS unsigned*)(lds + (bufoff) + ldsw + _i * 8192), 16, 0, 0); } while (0)
#define PG8_LDA(dst, b, h) do { _Pragma("unroll") for (int m = 0; m < 4; ++m) _Pragma("unroll") for (int k = 0; k < 2; ++k) dst[m][k] = *(const LAS bf16x8*)(lds + PG8_SA(b, h) + aoff + m * 2048 + k * 1024); } while (0)
#define PG8_LDB(dst, b, h) do { _Pragma("unroll") for (int n = 0; n < 2; ++n) _Pragma("unroll") for (int k = 0; k < 2; ++k) dst[n][k] = *(const LAS bf16x8*)(lds + PG8_SB(b, h) + boff + n * 2048 + k * 1024); } while (0)
#define PG8_MMA(ai, bj, At, Bt) do { __builtin_amdgcn_s_setprio(1); _Pragma("unroll") for (int m = 0; m < 4; ++m) _Pragma("unroll") for (int n = 0; n < 2; ++n) _Pragma("unroll") for (int k = 0; k < 2; ++k) \
        acc[ai][bj][m][n] = __builtin_amdgcn_mfma_f32_16x16x32_bf16(Bt[n][k], At[m][k], acc[ai][bj][m][n], 0, 0, 0); __builtin_amdgcn_s_setprio(0); } while (0)
#define PG8_WAIT_V(n) asm volatile("s_waitcnt vmcnt(" #n ")" ::: "memory")
#define PG8_WAIT_L(n) asm volatile("s_waitcnt lgkmcnt(" #n ")" ::: "memory")
#define PG8_BAR __builtin_amdgcn_s_barrier()
#define PG8_SCHED __builtin_amdgcn_sched_barrier(0)
#define PG8_ABASE(u) ((const char*)g.A + ((size_t)((u).pn / g.a_div) * g.a_gstride) * 2 + (size_t)(u).pm * 2 * hstepA + (size_t)(u).ks * KSS * 2)
#define PG8_BBASE(u) ((const char*)g.Bt + (size_t)(u).pn * 2 * hstepB + (size_t)(u).ks * KSS * 2)
    Unit cur, nxt; int ui = 0;
    if (!S.next(0, cur)) return;
    f32x4 acc[2][2][4][2];
#pragma unroll
    for (int a = 0; a < 2; ++a)
#pragma unroll
        for (int b = 0; b < 2; ++b)
#pragma unroll
            for (int m = 0; m < 4; ++m)
#pragma unroll
                for (int n = 0; n < 2; ++n) acc[a][b][m][n] = (f32x4){0.f, 0.f, 0.f, 0.f};
    bf16x8 At[4][2], B0[2][2], B1[2][2];
    const char* cA = PG8_ABASE(cur); const char* cB = PG8_BBASE(cur);
    if constexpr (SP2) {
        PG8_STAGE(PG8_SB(0, 0), cB, voffB); PG8_STAGE(PG8_SB(0, 1), cB + hstepB, voffB); PG8_STAGE(PG8_SA(0, 0), cA, voffA); PG8_STAGE(PG8_SA(0, 1), cA + hstepA, voffA);
        if (wr == 1) PG8_BAR;
        PG8_WAIT_V(2); PG8_BAR;
        PG8_STAGE(PG8_SB(1, 0), cB + kstep, voffB); PG8_STAGE(PG8_SA(1, 0), cA + kstep, voffA); PG8_STAGE(PG8_SB(1, 1), cB + hstepB + kstep, voffB);
        PG8_WAIT_V(6); PG8_BAR;
    } else {
        PG8_STAGE(PG8_SB(0, 0), cB, voffB); PG8_STAGE(PG8_SA(0, 0), cA, voffA); PG8_STAGE(PG8_SB(0, 1), cB + hstepB, voffB); PG8_STAGE(PG8_SA(0, 1), cA + hstepA, voffA);
        if (wr == 1) PG8_BAR;
        PG8_WAIT_V(4); PG8_BAR;
        PG8_STAGE(PG8_SB(1, 0), cB + kstep, voffB); PG8_STAGE(PG8_SA(1, 0), cA + kstep, voffA); PG8_STAGE(PG8_SB(1, 1), cB + hstepB + kstep, voffB);
        PG8_WAIT_V(6); PG8_BAR;
    }
    for (;;) {
        const bool has_next = S.next(ui + 1, nxt);
        const char* nA = has_next ? PG8_ABASE(nxt) : cA; const char* nB = has_next ? PG8_BBASE(nxt) : cB;
#pragma unroll 1
        for (int t = 0; t < nt; t += 2) {
            const bool last = (t == nt - 2);
            const char* a1 = cA + (size_t)(t + 1) * kstep;
            const char* a2 = last ? nA : cA + (size_t)(t + 2) * kstep; const char* b2 = last ? nB : cB + (size_t)(t + 2) * kstep;
            const char* a3 = a2 + kstep; const char* b3 = b2 + kstep;
            if constexpr (SP2) {
            PG8_LDB(B0, 0, 0); PG8_LDB(B1, 0, 1); PG8_SCHED; PG8_LDA(At, 0, 0); PG8_STAGE(PG8_SA(1, 1), a1 + hstepA, voffA);
            PG8_WAIT_V(8); PG8_WAIT_L(0); PG8_BAR; PG8_MMA(0, 0, At, B0); PG8_MMA(0, 1, At, B1); PG8_BAR; PG8_SCHED;
            PG8_LDA(At, 0, 1); PG8_STAGE(PG8_SB(0, 0), b2, voffB); PG8_STAGE(PG8_SB(0, 1), b2 + hstepB, voffB); PG8_STAGE(PG8_SA(0, 0), a2, voffA);
            PG8_WAIT_V(8); PG8_WAIT_L(0); PG8_BAR; PG8_MMA(1, 0, At, B0); PG8_MMA(1, 1, At, B1); PG8_BAR; PG8_SCHED;
            PG8_LDB(B0, 1, 0); PG8_LDB(B1, 1, 1); PG8_SCHED; PG8_LDA(At, 1, 0); PG8_STAGE(PG8_SA(0, 1), a2 + hstepA, voffA);
            PG8_WAIT_V(8); PG8_WAIT_L(0); PG8_BAR; PG8_MMA(0, 0, At, B0); PG8_MMA(0, 1, At, B1); PG8_BAR; PG8_SCHED;
            PG8_LDA(At, 1, 1); PG8_STAGE(PG8_SB(1, 0), b3, voffB); PG8_STAGE(PG8_SB(1, 1), b3 + hstepB, voffB); PG8_STAGE(PG8_SA(1, 0), a3, voffA);
            PG8_WAIT_V(8); PG8_WAIT_L(0); PG8_BAR; PG8_MMA(1, 0, At, B0); PG8_MMA(1, 1, At, B1); PG8_BAR; PG8_SCHED;
            } else {
            PG8_LDB(B0, 0, 0); PG8_SCHED; PG8_LDA(At, 0, 0); PG8_STAGE(PG8_SA(1, 1), a1 + hstepA, voffA);
            PG8_WAIT_L(8); PG8_BAR; PG8_WAIT_L(0); PG8_MMA(0, 0, At, B0); PG8_BAR; PG8_SCHED;
            PG8_LDB(B1, 0, 1); PG8_STAGE(PG8_SB(0, 0), b2, voffB);
            PG8_BAR; PG8_WAIT_L(0); PG8_MMA(0, 1, At, B1); PG8_BAR;
            PG8_LDA(At, 0, 1); PG8_STAGE(PG8_SA(0, 0), a2, voffA);
            PG8_BAR; PG8_WAIT_L(0); PG8_MMA(1, 0, At, B0); PG8_BAR; PG8_SCHED;
            PG8_STAGE(PG8_SB(0, 1), b2 + hstepB, voffB);
            PG8_WAIT_V(6); PG8_BAR; PG8_MMA(1, 1, At, B1); PG8_BAR;
            PG8_LDB(B0, 1, 0); PG8_SCHED; PG8_LDA(At, 1, 0); PG8_STAGE(PG8_SA(0, 1), a2 + hstepA, voffA);
            PG8_WAIT_L(8); PG8_BAR; PG8_WAIT_L(0); PG8_MMA(0, 0, At, B0); PG8_BAR; PG8_SCHED;
            PG8_LDB(B1, 1, 1); PG8_STAGE(PG8_SB(1, 0), b3, voffB);
            PG8_BAR; PG8_WAIT_L(0); PG8_MMA(0, 1, At, B1); PG8_BAR;
            PG8_LDA(At, 1, 1); PG8_STAGE(PG8_SA(1, 0), a3, voffA);
            PG8_BAR; PG8_WAIT_L(0); PG8_MMA(1, 0, At, B0); PG8_BAR; PG8_SCHED;
            PG8_STAGE(PG8_SB(1, 1), b3 + hstepB, voffB);
            PG8_WAIT_V(6); PG8_BAR; PG8_MMA(1, 1, At, B1); PG8_BAR;
            }
        }
        if constexpr (ALIGN_EPI) { if (wr == 0) PG8_BAR; }
        { int fr2 = fr, fq2 = fq; asm volatile("" : "+v"(fr2), "+v"(fq2));
          E(acc, cur, wr, wc, fr2, fq2); }
        if (!has_next) break;
#pragma unroll
        for (int a = 0; a < 2; ++a)
#pragma unroll
            for (int b = 0; b < 2; ++b)
#pragma unroll
                for (int m = 0; m < 4; ++m)
#pragma unroll
                    for (int n = 0; n < 2; ++n) acc[a][b][m][n] = (f32x4){0.f, 0.f, 0.f, 0.f};
        cur = nxt; cA = nA; cB = nB; ++ui;
        if constexpr (ALIGN_EPI) { if (wr == 1) PG8_BAR; }
    }
    PG8_WAIT_V(0);
    if constexpr (!ALIGN_EPI) { if (wr == 0) PG8_BAR; }
    PG8_BAR;
#undef PG8_SA
#undef PG8_SB
#undef PG8_STAGE
#undef PG8_LDA
#undef PG8_LDB
#undef PG8_MMA
#undef PG8_WAIT_V
#undef PG8_WAIT_L
#undef PG8_BAR
#undef PG8_SCHED
#undef PG8_ABASE
#undef PG8_BBASE
}

struct EpiSwiGLU {
    static constexpr bool PERM = true;
    bf16_t* O;
    __device__ __forceinline__ void operator()(const f32x4 (&acc)[2][2][4][2], const Unit& u, int wr, int wc, int fr, int fq) const {
        const int row0 = u.pm * BM + wr * 64 + fr, col0 = u.pn * HALF + wc * 32 + 8 * fq;
#pragma unroll
        for (int ai = 0; ai < 2; ++ai)
#pragma unroll
            for (int m = 0; m < 4; ++m) {
                bf16_t* rowp = O + (size_t)(row0 + ai * HALF + m * 16) * DFF + col0;
                float o[8];
#pragma unroll
                for (int n = 0; n < 2; ++n)
#pragma unroll
                    for (int j = 0; j < 4; ++j) { const float a = acc[ai][0][m][n][j], b = acc[ai][1][m][n][j]; o[n * 4 + j] = a / (1.0f + __expf(-a)) * b; }
                u32x4 w; w.x = cvt_pk_bf16(o[0], o[1]); w.y = cvt_pk_bf16(o[2], o[3]); w.z = cvt_pk_bf16(o[4], o[5]); w.w = cvt_pk_bf16(o[6], o[7]);
                *(u32x4*)rowp = w;
            }
    }
};
template <bool HALFGATE> struct EpiResid {
    static constexpr bool PERM = false;
    float* X; const float* gate_lat; const float* gate_ctx; float* out;
    __device__ __forceinline__ void operator()(const f32x4 (&acc)[2][2][4][2], const Unit& u, int wr, int wc, int fr, int fq) const {
        const int row0 = u.pm * BM + wr * 64 + fr, col0 = u.pn * BM + wc * 32 + 4 * fq;
        const float* gp = (u.pm * BM >= SEQ) ? gate_ctx : gate_lat;
#pragma unroll
        for (int bj = 0; bj < 2; ++bj)
#pragma unroll
            for (int n = 0; n < 2; ++n) {
                const f32x4 gv = *(const f32x4*)(gp + col0 + bj * HALF + n * 16) * (HALFGATE ? 0.5f : 1.0f);
#pragma unroll
                for (int ai = 0; ai < 2; ++ai)
#pragma unroll
                    for (int m = 0; m < 4; ++m) {
                        const int row = row0 + ai * HALF + m * 16;
                        float* p = X + (size_t)row * D + col0 + bj * HALF + n * 16;
                        const f32x4 v = *(const f32x4*)p + gv * acc[ai][bj][m][n];
                        *(f32x4*)p = v;
                        if (out != nullptr && row < SEQ) *(f32x4*)(out + (size_t)row * D + col0 + bj * HALF + n * 16) = v;
                    }
            }
    }
};
template <bool HALFGATE> struct EpiPart {
    static constexpr bool PERM = false;
    float* PART; const float* gate_ctx;
    __device__ __forceinline__ void operator()(const f32x4 (&acc)[2][2][4][2], const Unit& u, int wr, int wc, int fr, int fq) const {
        const int row0 = wr * 64 + fr, col0 = u.pn * BM + wc * 32 + 4 * fq;
        f32x4 gv[2][2];
#pragma unroll
        for (int bj = 0; bj < 2; ++bj)
#pragma unroll
            for (int n = 0; n < 2; ++n) gv[bj][n] = *(const f32x4*)(gate_ctx + col0 + bj * HALF + n * 16) * (HALFGATE ? 0.5f : 1.0f);
#pragma unroll
        for (int ai = 0; ai < 2; ++ai)
#pragma unroll
            for (int m = 0; m < 4; ++m) {
                float* rowp = PART + ((size_t)u.ks * BM + row0 + ai * HALF + m * 16) * D + col0;
#pragma unroll
                for (int bj = 0; bj < 2; ++bj)
#pragma unroll
                    for (int n = 0; n < 2; ++n) *(f32x4*)(rowp + bj * HALF + n * 16) = gv[bj][n] * acc[ai][bj][m][n];
            }
    }
};
struct EpiWin {
    static constexpr bool PERM = true;
    float* P32; bf16_t* PA; bf16_t* GL; long pn_off;
    __device__ __forceinline__ void operator()(const f32x4 (&acc)[2][2][4][2], const Unit& u0, int wr, int wc, int fr, int fq) const {
        Unit u; u.pm = u0.pm; u.pn = u0.pn + (int)pn_off;
        const int row0 = u.pm * BM + wr * 64 + fr, cin = wc * 32 + 8 * fq;
        if (u.pn < 19) {
#pragma unroll
            for (int ai = 0; ai < 2; ++ai)
#pragma unroll
                for (int m = 0; m < 4; ++m) { float* rowp = P32 + (size_t)(row0 + ai * HALF + m * 16) * P32W + u.pn * BM + cin;
#pragma unroll
                    for (int bj = 0; bj < 2; ++bj) { *(f32x4*)(rowp + bj * HALF) = acc[ai][bj][m][0]; *(f32x4*)(rowp + bj * HALF + 4) = acc[ai][bj][m][1]; } }
        } else {
            bf16_t* base; int ld, colt;
            if (u.pn < 28) { base = PA; ld = PAW; colt = (u.pn - 19) * BM; } else { base = GL; ld = GLW; colt = (u.pn - 28) * BM; }
#pragma unroll
            for (int ai = 0; ai < 2; ++ai)
#pragma unroll
                for (int m = 0; m < 4; ++m) { bf16_t* rowp = base + (size_t)(row0 + ai * HALF + m * 16) * ld + colt + cin;
#pragma unroll
                    for (int bj = 0; bj < 2; ++bj) { const f32x4 v0 = acc[ai][bj][m][0], v1 = acc[ai][bj][m][1];
                        u32x4 w; w.x = cvt_pk_bf16(v0[0], v0[1]); w.y = cvt_pk_bf16(v0[2], v0[3]); w.z = cvt_pk_bf16(v1[0], v1[1]); w.w = cvt_pk_bf16(v1[2], v1[3]);
                        *(u32x4*)(rowp + bj * HALF) = w; } }
        }
    }
};
struct EpiMerge {
    static constexpr bool PERM = true;
    const bf16_t* GL; bf16_t* PROJ;
    __device__ __forceinline__ void operator()(const f32x4 (&acc)[2][2][4][2], const Unit& u, int wr, int wc, int fr, int fq) const {
        const int row0 = u.pm * BM + wr * 64 + fr, col0 = u.pn * BM + wc * 32 + 8 * fq;
#pragma unroll
        for (int ai = 0; ai < 2; ++ai)
#pragma unroll
            for (int m = 0; m < 4; ++m) { const size_t ro = (size_t)(row0 + ai * HALF + m * 16) * GLW + col0;
#pragma unroll
                for (int bj = 0; bj < 2; ++bj) {
                    const u32x4 gw = *(const u32x4*)(GL + ro + bj * HALF);
                    const f32x4 v0 = acc[ai][bj][m][0], v1 = acc[ai][bj][m][1];
                    float o[8];
                    o[0] = v0[0] / (1.0f + __expf(-bf2f(gw.x & 0xffffu))); o[1] = v0[1] / (1.0f + __expf(-bf2f(gw.x >> 16)));
                    o[2] = v0[2] / (1.0f + __expf(-bf2f(gw.y & 0xffffu))); o[3] = v0[3] / (1.0f + __expf(-bf2f(gw.y >> 16)));
                    o[4] = v1[0] / (1.0f + __expf(-bf2f(gw.z & 0xffffu))); o[5] = v1[1] / (1.0f + __expf(-bf2f(gw.z >> 16)));
                    o[6] = v1[2] / (1.0f + __expf(-bf2f(gw.w & 0xffffu))); o[7] = v1[3] / (1.0f + __expf(-bf2f(gw.w >> 16)));
                    u32x4 w; w.x = cvt_pk_bf16(o[0], o[1]); w.y = cvt_pk_bf16(o[2], o[3]); w.z = cvt_pk_bf16(o[4], o[5]); w.w = cvt_pk_bf16(o[6], o[7]);
                    *(u32x4*)(PROJ + ro + bj * HALF) = w; } }
    }
};
}

enum { I_X = 0, I_C, I_CTX, I_CCTX, I_ADAW, I_ADAB, I_NF1, I_NMIX, I_NF2, I_F1WI, I_F1WO, I_F2WI, I_F2WO, I_WIN, I_HGLB, I_HGNORM, I_RWSHIFT, I_RWW0, I_RWW2, I_RWA0, I_RWA2,
       I_RWKK, I_RWKA, I_RWRK, I_RWLNW, I_RWLNB, I_NAQN, I_NAKN, I_NARPB, I_WAQN, I_WAKN, I_WASINK, I_WBR, I_WOUT, N_IN };
struct Args { const float* in[N_IN]; float* out; unsigned char* ws; int ph_lo, ph_hi; };
struct Ctx {
    LAS unsigned char* lds;
    int tid, lane, wave, bid, G;
    const Args __attribute__((address_space(4)))* ka; float* out; unsigned char* ws;
};
#define WSP(T, off) ((T*)(C.ws + (off)))
__device__ __forceinline__ void relaunder(Ctx& C) {
    int t = C.tid, b = C.bid, g = C.G;
    asm volatile("" : "+v"(t), "+v"(b), "+v"(g));
    C.tid = t; C.lane = t & 63; C.wave = __builtin_amdgcn_readfirstlane(t >> 6); C.bid = __builtin_amdgcn_readfirstlane(b); C.G = __builtin_amdgcn_readfirstlane(g);
}

__device__ __forceinline__ void transpose_item(const float* W, int K, int N, bf16_t* WT, int mode, LAS float* scr, int item, int lane) {
    const int nblk = N / 32, kb = item / nblk, nb = item % nblk, k0 = 64 * kb, n0 = 32 * nb;
    int drow0 = n0;
    if (mode == 1) { const int half = n0 / DFF, j0 = n0 % DFF; drow0 = 256 * (j0 / 128) + 128 * half + (j0 % 128); }
#pragma unroll 8
    for (int i = 0; i < 32; ++i) { const int kk = 2 * i + (lane >> 5); scr[kk * 33 + (lane & 31)] = W[(size_t)(k0 + kk) * N + n0 + (lane & 31)]; }
    LDS_WAIT(); asm volatile("" ::: "memory");
    const int c = lane & 7;
#pragma unroll
    for (int j = 0; j < 4; ++j) { const int n = (lane >> 3) + 8 * j; const LAS float* s = scr + (8 * c) * 33 + n;
        u32x4 o; o.x = pk2(s[0 * 33], s[1 * 33]); o.y = pk2(s[2 * 33], s[3 * 33]); o.z = pk2(s[4 * 33], s[5 * 33]); o.w = pk2(s[6 * 33], s[7 * 33]);
        *(u32x4*)(WT + (size_t)(drow0 + n) * K + k0 + 8 * c) = o; }
    LDS_WAIT(); asm volatile("" ::: "memory");
}
__device__ __forceinline__ void phase_convert(Ctx& C, int l) {
    LAS float* scr = (LAS float*)(C.lds + C.wave * 16384);
    const int gw = C.bid * NWAVES + C.wave, NGW = C.G * NWAVES;
    constexpr int I_WI = (D / 64) * (2 * DFF / 32), I_WO = (DFF / 64) * (D / 32), I_IN = (D / 64) * (PTOT / 32), I_BR = (512 / 64) * (D / 32), I_OUT = (D / 64) * (D / 32);
    constexpr int NITEMS = 2 * I_WI + 2 * I_WO + I_IN + 4 * I_BR + I_OUT;
    for (int it = gw; it < NITEMS; it += NGW) {
        int r = it;
        if (r < I_WI) { transpose_item(C.ka->in[I_F1WI] + (size_t)l * D * 2 * DFF, D, 2 * DFF, WSP(bf16_t, OFF_WI1), 1, scr, r, C.lane); continue; } r -= I_WI;
        if (r < I_WI) { transpose_item(C.ka->in[I_F2WI] + (size_t)l * D * 2 * DFF, D, 2 * DFF, WSP(bf16_t, OFF_WI2), 1, scr, r, C.lane); continue; } r -= I_WI;
        if (r < I_WO) { transpose_item(C.ka->in[I_F1WO] + (size_t)l * DFF * D, DFF, D, WSP(bf16_t, OFF_WO1), 0, scr, r, C.lane); continue; } r -= I_WO;
        if (r < I_WO) { transpose_item(C.ka->in[I_F2WO] + (size_t)l * DFF * D, DFF, D, WSP(bf16_t, OFF_WO2), 0, scr, r, C.lane); continue; } r -= I_WO;
        if (r < I_IN) { transpose_item(C.ka->in[I_WIN] + (size_t)l * D * PTOT, D, PTOT, WSP(bf16_t, OFF_WIN), 0, scr, r, C.lane); continue; } r -= I_IN;
        if (r < 4 * I_BR) { const int g = r / I_BR; transpose_item(C.ka->in[I_WBR] + ((size_t)l * 4 + g) * 512 * D, 512, D, WSP(bf16_t, OFF_WBR) + (size_t)g * D * 512, 0, scr, r % I_BR, C.lane); continue; } r -= 4 * I_BR;
        transpose_item(C.ka->in[I_WOUT] + (size_t)l * D * D, D, D, WSP(bf16_t, OFF_WOUT), 0, scr, r, C.lane);
    }
}

__device__ __forceinline__ void phase_ada_partial(Ctx& C) {
    float* modp = WSP(float, OFF_MODP);
    for (int u = C.bid; u < DEPTH * 9 * KSPLIT; u += C.G) {
        const int l = u / (9 * KSPLIT), rem = u % (9 * KSPLIT), cg = rem / KSPLIT, ks = rem % KSPLIT;
        const int col = cg * 2048 + C.tid * 4;
        const float* W = C.ka->in[I_ADAW] + (size_t)l * D * MODW;
        f32x4 a0 = {0.f, 0.f, 0.f, 0.f}, a1 = {0.f, 0.f, 0.f, 0.f};
#pragma unroll 16
        for (int i = ks * 64; i < ks * 64 + 64; ++i) {
            const float c0 = C.ka->in[I_C][i], c1 = C.ka->in[I_CCTX][i];
            const float s0 = siluf_(c0), s1 = siluf_(c1);
            const f32x4 w = *(const f32x4*)(W + (size_t)i * MODW + col);
            a0 += w * s0; a1 += w * s1;
        }
        *(f32x4*)(modp + ((size_t)(l * KSPLIT + ks) * 2 + 0) * MODW + col) = a0;
        *(f32x4*)(modp + ((size_t)(l * KSPLIT + ks) * 2 + 1) * MODW + col) = a1;
    }
    f32x4* X = WSP(f32x4, OFF_X);
    const f32x4* xs = (const f32x4*)C.ka->in[I_X]; const f32x4* cs = (const f32x4*)C.ka->in[I_CTX];
    const size_t n_lat = (size_t)SEQ * D / 4, n_all = (size_t)MT * D / 4;
    for (size_t i = (size_t)C.bid * NT + C.tid; i < n_all; i += (size_t)C.G * NT) X[i] = i < n_lat ? xs[i] : cs[i - n_lat];
}
__device__ __forceinline__ void phase_ada_reduce(Ctx& C) {
    const float* modp = WSP(float, OFF_MODP); float* mod = WSP(float, OFF_MOD);
    for (int e = C.bid * NT + C.tid; e < DEPTH * 2 * MODW; e += C.G * NT) {
        const int l = e / (2 * MODW), s = (e / MODW) % 2, j = e % MODW;
        float a = C.ka->in[I_ADAB][(size_t)l * MODW + j];
        for (int ks = 0; ks < KSPLIT; ++ks) a += modp[((size_t)(l * KSPLIT + ks) * 2 + s) * MODW + j];
        mod[e] = a;
    }
}
__device__ __forceinline__ const float* mod_ptr(Ctx& C, int l, int s, int idx) { return WSP(float, OFF_MOD) + ((size_t)(l * 2 + s) * NMOD + idx) * D; }

__device__ __forceinline__ void phase_norm(Ctx& C, int l, const float* gw  , int shift_idx, int nparts) {
    const int gwv = C.bid * NWAVES + C.wave, NGW = C.G * NWAVES;
    float* X = WSP(float, OFF_X); bf16_t* H = WSP(bf16_t, OFF_H); const float* PART = WSP(float, OFF_P32);
    for (int r = gwv; r < MT; r += NGW) {
        const int s = r >= SEQ ? 1 : 0;
        const float* sh = mod_ptr(C, l, s, shift_idx); const float* sc = mod_ptr(C, l, s, shift_idx + 1);
        f32x4* xr = (f32x4*)(X + (size_t)r * D) + C.lane;
        f32x4 v[8]; float ss = 0.f;
#pragma unroll
        for (int j = 0; j < 8; ++j) v[j] = xr[64 * j];
        if (s == 1 && nparts > 0) {
            for (int ks = 0; ks < nparts; ++ks) {
                const f32x4* pr = (const f32x4*)(PART + ((size_t)ks * 256 + (r - SEQ)) * D) + C.lane;
#pragma unroll
                for (int j = 0; j < 8; ++j) v[j] += pr[64 * j];
            }
#pragma unroll
            for (int j = 0; j < 8; ++j) xr[64 * j] = v[j];
        }
#pragma unroll
        for (int j = 0; j < 8; ++j) ss += (v[j].x * v[j].x + v[j].y * v[j].y) + (v[j].z * v[j].z + v[j].w * v[j].w);
        const float rstd = rsqrtf(wave_sum(ss) * (1.0f / D) + EPS);
        u32x2* o8 = (u32x2*)(H + (size_t)r * D) + C.lane;
#pragma unroll
        for (int j = 0; j < 8; ++j) {
            const int c = (64 * j + C.lane) * 4;
            const f32x4 g4 = *(const f32x4*)(gw + c), s4 = *(const f32x4*)(sc + c), h4 = *(const f32x4*)(sh + c);
            const f32x4 y = (v[j] * rstd) * g4 * (s4 + 1.0f) + h4;
            u32x2 w; w.x = pk2(y.x, y.y); w.y = pk2(y.z, y.w); o8[64 * j] = w;
        }
    }
}

__device__ __forceinline__ float xrow_sum(float x) {
    auto s = __builtin_amdgcn_permlane16_swap(__float_as_uint(x), __float_as_uint(x), false, false);
    x = __uint_as_float(s[0]) + __uint_as_float(s[1]);
    auto t = __builtin_amdgcn_permlane32_swap(__float_as_uint(x), __float_as_uint(x), false, false);
    return __uint_as_float(t[0]) + __uint_as_float(t[1]);
}
template <int CTRL> __device__ __forceinline__ float dppf(float x) { return __builtin_bit_cast(float, __builtin_amdgcn_mov_dpp(__builtin_bit_cast(int, x), CTRL, 0xf, 0xf, true)); }
__device__ __forceinline__ float row16_sum(float x) { x += dppf<0xB1>(x); x += dppf<0x4E>(x); x += dppf<0x124>(x); x += dppf<0x128>(x); return x; }
__device__ __forceinline__ float wave_sum_fast(float x) { return xrow_sum(row16_sum(x)); }
#define WAVE_LDS_FENCE() asm volatile("s_waitcnt lgkmcnt(0)" ::: "memory")
__device__ __forceinline__ void phase_rw_prep(Ctx& C, int l, int b0, int nb) {
    constexpr int TB = 16;
    const float* P = WSP(float, OFF_P32); float* VV = WSP(float, OFF_VV); float* GS = WSP(float, OFF_GS); float* RO = WSP(float, OFF_RO); float* BON = WSP(float, OFF_BON);
    LAS float* lin = (LAS float*)C.lds;
    LAS unsigned char* wl = C.lds + 16384 + C.wave * 14592;
    LAS unsigned char* RA = wl; LAS float* MAT = (LAS float*)(wl + 10496);
    const float* taps = C.ka->in[I_RWSHIFT] + (size_t)l * 3 * RWC;
    const int c = C.tid, h = c >> 6, e = c & 63, lane = C.lane;
    const float kkw = C.ka->in[I_RWKK][l * 512 + c], kaw = C.ka->in[I_RWKA][l * 512 + c], rkw = C.ka->in[I_RWRK][l * 512 + c];
    for (int grp = b0; grp < RW_NCK; grp += nb) {
        const int r0 = grp * TB;
        const bool hp0 = (r0 != 0 && r0 != SEQ), hnl = (r0 + TB != SEQ && r0 + TB != MT);
        __syncthreads();
        { int c_ = C.tid; asm volatile("" : "+v"(c_)); const int c = c_;
#pragma unroll
        for (int q = 3; q < 5; ++q) {
            if (q == 4 && c >= 256) break;
            const int col = q * 512 + c;
            const float t0 = taps[col], t1 = taps[RWC + col], t2 = taps[2 * RWC + col];
            const float* pc = P + (size_t)r0 * P32W + RW_OFF + col;
            float prev = hp0 ? pc[-(long)P32W] : 0.f, cur = pc[0];
#pragma unroll
            for (int t = 0; t < TB; ++t) {
                const float nxt = (t + 1 < TB || hnl) ? pc[(size_t)(t + 1) * P32W] : 0.f;
                const float v = t0 * prev + t1 * cur + t2 * nxt;
                if (q == 3) GS[(size_t)(r0 + t) * 512 + c] = sigmoidf_(v);
                else lin[t * 256 + c] = c < 128 ? tanhf(v) : v;
                prev = cur; cur = nxt;
            }
        }
        }
        __syncthreads();
#pragma unroll 1
        for (int d = 0; d < 2; ++d) {
            int ln_ = C.lane; asm volatile("" : "+v"(ln_));
            const int lane = ln_, e = ln_, c = h * 64 + ln_;
            float xr[TB], xk[TB], xv[TB], kkn[TB];
#pragma unroll
            for (int q = 0; q < 3; ++q) {
                const int col = q * 512 + c;
                const float t0 = taps[col], t1 = taps[RWC + col], t2 = taps[2 * RWC + col];
                const float* pc = P + (size_t)r0 * P32W + RW_OFF + col;
                float prev = hp0 ? pc[-(long)P32W] : 0.f, cur = pc[0];
#pragma unroll
                for (int t = 0; t < TB; ++t) {
                    const float nxt = (t + 1 < TB || hnl) ? pc[(size_t)(t + 1) * P32W] : 0.f;
                    const float v = t0 * prev + t1 * cur + t2 * nxt;
                    if (q == 0) xr[t] = v; else if (q == 1) xk[t] = v; else { xv[t] = v; if (d == 0) VV[(size_t)(r0 + t) * 512 + c] = v; }
                    prev = cur; cur = nxt;
                }
            }
#pragma unroll
            for (int t = 0; t < TB; ++t) { const float kk0 = xk[t] * kkw; kkn[t] = kk0 * rsqrtf(wave_sum_fast(kk0 * kk0) + EPS); }
            __builtin_amdgcn_sched_barrier(0);
            float At[TB], Rt[TB], Vs[TB];
            unsigned Btp[TB / 2], Ktp[TB / 2];
            float gam;
            {
                const float* w2 = C.ka->in[I_RWW2] + ((size_t)(l * 2 + d) * 64) * 512 + c;
                const float* a2 = C.ka->in[I_RWA2] + ((size_t)(l * 2 + d) * 64) * 512 + c;
                float z[TB], az[TB];
                const float zb = C.ka->in[I_RWW0][(l * 2 + d) * 512 + c], ab = C.ka->in[I_RWA0][(l * 2 + d) * 512 + c];
#pragma unroll
                for (int t = 0; t < TB; ++t) { z[t] = zb; az[t] = ab; }
#pragma unroll 1
                for (int j = 0; j < 64; j += 4) {
                    const float w0 = w2[(size_t)(j + 0) * 512], w1 = w2[(size_t)(j + 1) * 512], w2v = w2[(size_t)(j + 2) * 512], w3 = w2[(size_t)(j + 3) * 512];
                    const float b0v = a2[(size_t)(j + 0) * 512], b1 = a2[(size_t)(j + 1) * 512], b2 = a2[(size_t)(j + 2) * 512], b3 = a2[(size_t)(j + 3) * 512];
#pragma unroll
                    for (int t = 0; t < TB; ++t) {
                        const f32x4 lw = *(const LAS f32x4*)(lin + t * 256 + d * 64 + j), la = *(const LAS f32x4*)(lin + t * 256 + 128 + d * 64 + j);
                        z[t] += (lw.x * w0 + lw.y * w1) + (lw.z * w2v + lw.w * w3);
                        az[t] += (la.x * b0v + la.y * b1) + (la.z * b2 + la.w * b3);
                    }
                }
                float g = 1.0f, btp = 0.f, ktp = 0.f;
#pragma unroll
                for (int i = 0; i < TB; ++i) {
                    const int t = d ? TB - 1 - i : i;
                    const float y = -z[t]; const float sp = fmaxf(y, 0.f) + log1pf(__expf(-fabsf(y)));
                    const float decay = __expf(-__expf(-sp - 0.5f));
                    const float a = sigmoidf_(az[t]);
                    const float kd = xk[t] * (1.0f + (a - 1.0f) * kaw);
                    { const float bsum = wave_sum_fast(xr[t] * kd * rkw);
                      if (lane == 0) { float* bp = BON + (size_t)(r0 + t) * 8 + h; *bp = d == 0 ? bsum : *bp + bsum; } }
                    const float gm1 = g; g *= decay; const float ig = 1.0f / g;
                    const float at = -kkn[t] * gm1, bt = a * kkn[t] * ig, kt = kd * ig, rt = xr[t] * g;
                    At[i] = at; Rt[i] = rt; Vs[i] = xv[t];
                    *(LAS bf16_t*)(RA + 0 * 2304 + i * 144 + 2 * e) = (bf16_t)pg8::cvt_pk_bf16(at, at); *(LAS bf16_t*)(RA + 1 * 2304 + i * 144 + 2 * e) = (bf16_t)pg8::cvt_pk_bf16(bt, bt);
                    *(LAS bf16_t*)(RA + 2 * 2304 + i * 144 + 2 * e) = (bf16_t)pg8::cvt_pk_bf16(kt, kt); *(LAS bf16_t*)(RA + 3 * 2304 + i * 144 + 2 * e) = (bf16_t)pg8::cvt_pk_bf16(rt, rt);
                    if (i & 1) { Btp[i >> 1] = pg8::cvt_pk_bf16(btp, bt); Ktp[i >> 1] = pg8::cvt_pk_bf16(ktp, kt); } else { btp = bt; ktp = kt; }
                }
                gam = g;
            }
            __builtin_amdgcn_sched_barrier(0);
            WAVE_LDS_FENCE();
            {
                const int jl = lane & 15, q = lane >> 4;
                bf16x8 fa[2], fb[2], fk[2], fr[2];
#pragma unroll
                for (int s2 = 0; s2 < 2; ++s2) {
                    fa[s2] = *(const LAS bf16x8*)(RA + 0 * 2304 + jl * 144 + s2 * 64 + q * 16); fb[s2] = *(const LAS bf16x8*)(RA + 1 * 2304 + jl * 144 + s2 * 64 + q * 16);
                    fk[s2] = *(const LAS bf16x8*)(RA + 2 * 2304 + jl * 144 + s2 * 64 + q * 16); fr[s2] = *(const LAS bf16x8*)(RA + 3 * 2304 + jl * 144 + s2 * 64 + q * 16);
                }
                f32x4 gAL = {0.f, 0.f, 0.f, 0.f}, gBL = gAL, gP = gAL, gQ = gAL;
#pragma unroll
                for (int s2 = 0; s2 < 2; ++s2) { gAL = MFMA16(fa[s2], fb[s2], gAL); gBL = MFMA16(fa[s2], fk[s2], gBL); gP = MFMA16(fr[s2], fb[s2], gP); gQ = MFMA16(fr[s2], fk[s2], gQ); }
#pragma unroll
                for (int reg = 0; reg < 4; ++reg) { const int i = 4 * q + reg;
                    MAT[0 * 256 + i * 16 + jl] = jl < i ? gAL[reg] : 0.f; MAT[1 * 256 + i * 16 + jl] = jl < i ? gBL[reg] : 0.f;
                    MAT[2 * 256 + i * 16 + jl] = jl <= i ? gP[reg] : 0.f; MAT[3 * 256 + i * 16 + jl] = jl <= i ? gQ[reg] : 0.f; }
            }
            WAVE_LDS_FENCE();
            __builtin_amdgcn_sched_barrier(0);
            {
                u32x4 w0, w1;
                w0.x = Btp[0]; w0.y = Btp[1]; w0.z = Btp[2]; w0.w = Btp[3]; w1.x = Btp[4]; w1.y = Btp[5]; w1.z = Btp[6]; w1.w = Btp[7];
                *(LAS u32x4*)(RA + 0 * 2048 + e * 32) = w0; *(LAS u32x4*)(RA + 0 * 2048 + e * 32 + 16) = w1;
                w0.x = Ktp[0]; w0.y = Ktp[1]; w0.z = Ktp[2]; w0.w = Ktp[3]; w1.x = Ktp[4]; w1.y = Ktp[5]; w1.z = Ktp[6]; w1.w = Ktp[7];
                *(LAS u32x4*)(RA + 1 * 2048 + e * 32) = w0; *(LAS u32x4*)(RA + 1 * 2048 + e * 32 + 16) = w1;
#pragma unroll
                for (int i2 = 0; i2 < 4; ++i2) { w0[i2] = pg8::cvt_pk_bf16(Vs[2 * i2], Vs[2 * i2 + 1]); w1[i2] = pg8::cvt_pk_bf16(Vs[8 + 2 * i2], Vs[8 + 2 * i2 + 1]); }
                *(LAS u32x4*)(RA + 2 * 2048 + e * 32) = w0; *(LAS u32x4*)(RA + 2 * 2048 + e * 32 + 16) = w1;
                *(LAS float*)(RA + 10240 + 4 * e) = gam;
            }
            __builtin_amdgcn_sched_barrier(0);
            float Gv[TB];
            {
                float X1[TB];
#pragma unroll
                for (int i = 0; i < TB; ++i) {
                    __builtin_amdgcn_sched_barrier(0);
                    float al[16];
#pragma unroll
                    for (int g4 = 0; g4 < 4; ++g4) { const f32x4 u = *(const LAS f32x4*)(MAT + 0 * 256 + i * 16 + 4 * g4); al[4 * g4] = u.x; al[4 * g4 + 1] = u.y; al[4 * g4 + 2] = u.z; al[4 * g4 + 3] = u.w; }
                    float x1 = At[i];
#pragma unroll
                    for (int m = 0; m < TB; ++m) if (m < i) x1 = __builtin_fmaf(al[m], X1[m], x1);
                    X1[i] = x1;
                }
#pragma unroll
                for (int i = 0; i < TB; ++i) {
                    __builtin_amdgcn_sched_barrier(0);
                    float pm[16];
#pragma unroll
                    for (int g4 = 0; g4 < 4; ++g4) { const f32x4 u = *(const LAS f32x4*)(MAT + 2 * 256 + i * 16 + 4 * g4); pm[4 * g4] = u.x; pm[4 * g4 + 1] = u.y; pm[4 * g4 + 2] = u.z; pm[4 * g4 + 3] = u.w; }
                    float gv = Rt[i];
#pragma unroll
                    for (int m = 0; m < TB; ++m) if (m <= i) gv = __builtin_fmaf(pm[m], X1[m], gv);
                    Gv[i] = gv;
                }
                u32x4 w0, w1;
#pragma unroll
                for (int i2 = 0; i2 < 4; ++i2) { w0[i2] = pg8::cvt_pk_bf16(X1[2 * i2], X1[2 * i2 + 1]); w1[i2] = pg8::cvt_pk_bf16(X1[8 + 2 * i2], X1[8 + 2 * i2 + 1]); }
                *(LAS u32x4*)(RA + 3 * 2048 + e * 32) = w0; *(LAS u32x4*)(RA + 3 * 2048 + e * 32 + 16) = w1;
            }
            __builtin_amdgcn_sched_barrier(0);
            {
                float X2[TB];
#pragma unroll
                for (int i = 0; i < TB; ++i) {
                    __builtin_amdgcn_sched_barrier(0);
                    float al[16], bl[16];
#pragma unroll
                    for (int g4 = 0; g4 < 4; ++g4) { const f32x4 u = *(const LAS f32x4*)(MAT + 0 * 256 + i * 16 + 4 * g4), v = *(const LAS f32x4*)(MAT + 1 * 256 + i * 16 + 4 * g4);
                        al[4 * g4] = u.x; al[4 * g4 + 1] = u.y; al[4 * g4 + 2] = u.z; al[4 * g4 + 3] = u.w; bl[4 * g4] = v.x; bl[4 * g4 + 1] = v.y; bl[4 * g4 + 2] = v.z; bl[4 * g4 + 3] = v.w; }
                    float x2 = 0.f;
#pragma unroll
                    for (int m = 0; m < TB; ++m) if (m < i) { x2 = __builtin_fmaf(bl[m], Vs[m], x2); x2 = __builtin_fmaf(al[m], X2[m], x2); }
                    X2[i] = x2;
                }
#pragma unroll
                for (int i = 0; i < TB; ++i) {
                    __builtin_amdgcn_sched_barrier(0);
                    float pm[16], qm[16];
#pragma unroll
                    for (int g4 = 0; g4 < 4; ++g4) { const f32x4 u = *(const LAS f32x4*)(MAT + 2 * 256 + i * 16 + 4 * g4), v = *(const LAS f32x4*)(MAT + 3 * 256 + i * 16 + 4 * g4);
                        pm[4 * g4] = u.x; pm[4 * g4 + 1] = u.y; pm[4 * g4 + 2] = u.z; pm[4 * g4 + 3] = u.w; qm[4 * g4] = v.x; qm[4 * g4 + 1] = v.y; qm[4 * g4 + 2] = v.z; qm[4 * g4 + 3] = v.w; }
                    float o0 = 0.f;
#pragma unroll
                    for (int m = 0; m < TB; ++m) if (m <= i) { o0 = __builtin_fmaf(pm[m], X2[m], o0); o0 = __builtin_fmaf(qm[m], Vs[m], o0); }
                    RO[((size_t)d * MT + r0 + (d ? TB - 1 - i : i)) * 512 + c] = o0;
                }
                u32x4 w0, w1;
#pragma unroll
                for (int i2 = 0; i2 < 4; ++i2) { w0[i2] = pg8::cvt_pk_bf16(X2[2 * i2], X2[2 * i2 + 1]); w1[i2] = pg8::cvt_pk_bf16(X2[8 + 2 * i2], X2[8 + 2 * i2 + 1]); }
                *(LAS u32x4*)(RA + 4 * 2048 + e * 32) = w0; *(LAS u32x4*)(RA + 4 * 2048 + e * 32 + 16) = w1;
            }
            WAVE_LDS_FENCE();
            __builtin_amdgcn_sched_barrier(0);
            {
                LAS bf16_t* GI = (LAS bf16_t*)MAT;
                const int sg = e >> 5, jp = 4 * ((e >> 4) & 1) + (e & 3), qg = (e & 15) >> 2;
#pragma unroll
                for (int i = 0; i < TB; ++i) GI[(sg * 64 + qg * 16 + i) * 8 + jp] = (bf16_t)f2bf(Gv[i]);
            }
            __builtin_amdgcn_sched_barrier(0);
            const int seqc = d == 0 ? (grp + 16) % RW_NCK : RW_NCK - 1 - grp;
            const size_t rec = (size_t)(d * 8 + h) * RW_NCK + seqc;
            {
                const int r = lane & 31, hh = lane >> 5;
                bf16x8 fBT[2], fKT[2], fVT[2], fW1[2], fU0[2];
#pragma unroll
                for (int blk = 0; blk < 2; ++blk) {
                    fBT[blk] = *(const LAS bf16x8*)(RA + 0 * 2048 + (32 * blk + r) * 32 + hh * 16); fKT[blk] = *(const LAS bf16x8*)(RA + 1 * 2048 + (32 * blk + r) * 32 + hh * 16);
                    fVT[blk] = *(const LAS bf16x8*)(RA + 2 * 2048 + (32 * blk + r) * 32 + hh * 16); fW1[blk] = *(const LAS bf16x8*)(RA + 3 * 2048 + (32 * blk + r) * 32 + hh * 16);
                    fU0[blk] = *(const LAS bf16x8*)(RA + 4 * 2048 + (32 * blk + r) * 32 + hh * 16);
                }
                float gk[2][16];
#pragma unroll
                for (int mb = 0; mb < 2; ++mb)
#pragma unroll
                    for (int reg = 0; reg < 16; ++reg) gk[mb][reg] = *(const LAS float*)(RA + 10240 + 4 * (32 * mb + KOFF(reg) + 4 * hh));
                WAVE_LDS_FENCE();
                float* Hrec = (float*)(C.ws + OFF_RWH + rec * RWH_REC);
                LAS bf16_t* MI = (LAS bf16_t*)RA;
#pragma unroll
                for (int mb = 0; mb < 2; ++mb)
#pragma unroll
                    for (int nbk = 0; nbk < 2; ++nbk) {
                        f32x16 aM, aH;
#pragma unroll
                        for (int i = 0; i < 16; ++i) { aM[i] = 0.f; aH[i] = 0.f; }
                        aM = MFMA32(fBT[mb], fW1[nbk], aM);
                        aH = MFMA32(fBT[mb], fU0[nbk], aH); aH = MFMA32(fKT[mb], fVT[nbk], aH);
                        const int col = 32 * nbk + r;
#pragma unroll
                        for (int g4 = 0; g4 < 4; ++g4) {
                            const int kb = 2 * mb + (g4 >> 1), q2 = 2 * (g4 & 1) + hh;
                            f32x4 hv; hv.x = gk[mb][4 * g4] * aH[4 * g4]; hv.y = gk[mb][4 * g4 + 1] * aH[4 * g4 + 1]; hv.z = gk[mb][4 * g4 + 2] * aH[4 * g4 + 2]; hv.w = gk[mb][4 * g4 + 3] * aH[4 * g4 + 3];
                            *(f32x4*)(Hrec + (((col >> 4) * 4 + kb) * 64 + q2 * 16 + (col & 15)) * 4) = hv;
                        }
                        const int sm = col >> 5, jpm = 4 * ((col >> 4) & 1) + (col & 3), qm2 = (col & 15) >> 2;
#pragma unroll
                        for (int reg = 0; reg < 16; ++reg) {
                            const int kp = 32 * mb + KOFF(reg) + 4 * hh;
                            const float mv = gk[mb][reg] * ((kp == col ? 1.0f : 0.0f) + aM[reg]);
                            MI[(((kp >> 4) * 2 + sm) * 64 + qm2 * 16 + (kp & 15)) * 8 + jpm] = (bf16_t)f2bf(mv);
                        }
                    }
                WAVE_LDS_FENCE();
                unsigned char* MGrec = C.ws + OFF_RWMG + rec * RWMG_REC;
#pragma unroll
                for (int it = 0; it < 8; ++it) *(u32x4*)(MGrec + (size_t)(it * 64 + lane) * 16) = *(const LAS u32x4*)(RA + (it * 64 + lane) * 16);
#pragma unroll
                for (int it = 0; it < 2; ++it) *(u32x4*)(MGrec + 8192 + (size_t)(it * 64 + lane) * 16) = *(const LAS u32x4*)((LAS unsigned char*)MAT + (it * 64 + lane) * 16);
                WAVE_LDS_FENCE();
            }
        }
    }
}

__device__ __forceinline__ void phase_attn_prep(Ctx& C, int l, int w0, int nw) {
    bf16_t* PA = WSP(bf16_t, OFF_PA);
    const int e = C.lane;
    const float na_qn = C.ka->in[I_NAQN][l * 64 + e], na_kn = C.ka->in[I_NAKN][l * 64 + e], wa_qn = C.ka->in[I_WAQN][l * 64 + e], wa_kn = C.ka->in[I_WAKN][l * 64 + e];
    const int m16 = e & 15;
    const float inv = powf(10000.0f, -(float)m16 / 16.0f);
    for (long uidx = w0; uidx < (long)MT * 26; uidx += nw) {
        const int r = (int)(uidx / 26), v = (int)(uidx % 26);
        int col; float nwt, scl; bool rope;
        if (v < 8) { col = v * 64; nwt = na_qn; scl = 0.125f; rope = false; }
        else if (v < 16) { col = 512 + (v - 8) * 64; nwt = na_kn; scl = 1.0f; rope = false; }
        else if (v < 24) { col = 1536 + (v - 16) * 64; nwt = wa_qn; scl = 0.125f; rope = true; }
        else { col = 2048 + (v - 24) * 64; nwt = wa_kn; scl = 1.0f; rope = true; }
        bf16_t* p = PA + (size_t)r * PAW + col + e;
        const float x = bf2f(*p);
        const float ss = wave_sum(x * x);
        float y = x * rsqrtf(ss * (1.0f / 64.0f) + EPS) * nwt * scl;
        if (rope && r < SEQ) {
            const int pos = (e >> 5) ? (r & 63) : (r >> 6);
            const float ang = (float)pos * inv;
            float sn, cs; sincosf(ang, &sn, &cs);
            const bool lo = (e & 31) < 16;
            const float yp = __shfl(y, lo ? e + 16 : e - 16);
            y = lo ? (y * cs - yp * sn) : (yp * sn + y * cs);
        }
        *p = (bf16_t)f2bf(y);
    }
}

__device__ __forceinline__ float hg_lb(Ctx& C, int l, int d, int c) {
    if (l == 0) return 0.f;
    const float a0 = C.ka->in[I_HGLB][(size_t)(d * DEPTH + 0) * 512 + c], a1 = C.ka->in[I_HGLB][(size_t)(d * DEPTH + 1) * 512 + c];
    const float m = fmaxf(a0, a1); const float e0 = expf(a0 - m), e1 = expf(a1 - m);
    return e1 / (e0 + e1);
}
struct HgThread { float lc[16], kd[16]; float tot[4]; };
__device__ __forceinline__ void hg_gates(Ctx& C, int l, int d, int h, int tc, int k, int J, LAS float* TOT, HgThread& T) {
    const float* P = WSP(float, OFF_P32);
    const float lb = hg_lb(C, l, d, h * 128 + k);
    float gg[16];
#pragma unroll
    for (int i = 0; i < 16; ++i) {
        const float fr = P[(size_t)(64 * tc + 16 * J + i) * P32W + 512 + d * 512 + h * 128 + k];
        const float f = lb + (1.0f - lb) * sigmoidf_(fr);
        gg[i] = __logf(f); T.kd[i] = 1.0f - f;
    }
    if (d == 0) { float a = 0.f;
#pragma unroll
        for (int i = 0; i < 16; ++i) { a += gg[i]; T.lc[i] = a; }
        TOT[J * 128 + k] = a;
    } else { float a = 0.f;
#pragma unroll
        for (int i = 15; i >= 0; --i) { a += gg[i]; T.lc[i] = a; }
        TOT[J * 128 + k] = a;
    }
    __syncthreads();
#pragma unroll
    for (int m = 0; m < 4; ++m) T.tot[m] = TOT[m * 128 + k];
}
__device__ __forceinline__ void hg_it(Ctx& C, int h, int tc, int v, int J, LAS unsigned char* IT) {
    const float* P = WSP(float, OFF_P32);
    float x[16];
#pragma unroll
    for (int i = 0; i < 16; ++i) x[i] = P[(size_t)(64 * tc + 16 * J + i) * P32W + 1536 + h * 128 + v];
    u32x4 w0, w1;
    w0.x = pk2(x[0], x[1]); w0.y = pk2(x[2], x[3]); w0.z = pk2(x[4], x[5]); w0.w = pk2(x[6], x[7]);
    w1.x = pk2(x[8], x[9]); w1.y = pk2(x[10], x[11]); w1.z = pk2(x[12], x[13]); w1.w = pk2(x[14], x[15]);
    *(LAS u32x4*)(IT + v * 144 + J * 32) = w0; *(LAS u32x4*)(IT + v * 144 + J * 32 + 16) = w1;
}
__device__ __forceinline__ void phase_hg_A(Ctx& C, int l, int b0, int nb) {
    float* HGL = WSP(float, OFF_HGL); float* HGD = WSP(float, OFF_HGD);
    LAS unsigned char* KT = C.lds;
    LAS unsigned char* IT = C.lds + 18432;
    LAS float* TOT = (LAS float*)(C.lds + 36864);
    const int k = C.tid & 127, J = C.tid >> 7;
    for (int u = b0; u < 2 * 4 * NCH; u += nb) {
        const int d = u / (4 * NCH), h = (u / NCH) % 4, c = u % NCH;
        const int tc = d == 0 ? (c + NCH - 4) % NCH : NCH - 1 - c;
        __syncthreads();
        HgThread T; hg_gates(C, l, d, h, tc, k, J, TOT, T);
        float rest = 0.f;
#pragma unroll
        for (int m = 0; m < 4; ++m) if (d == 0 ? (m >= J) : (m <= J)) rest += T.tot[m];
        float kh[16];
#pragma unroll
        for (int i = 0; i < 16; ++i) kh[i] = T.kd[i] * __expf(rest - T.lc[i]);
        { u32x4 w0, w1;
          w0.x = pk2(kh[0], kh[1]); w0.y = pk2(kh[2], kh[3]); w0.z = pk2(kh[4], kh[5]); w0.w = pk2(kh[6], kh[7]);
          w1.x = pk2(kh[8], kh[9]); w1.y = pk2(kh[10], kh[11]); w1.z = pk2(kh[12], kh[13]); w1.w = pk2(kh[14], kh[15]);
          *(LAS u32x4*)(KT + k * 144 + J * 32) = w0; *(LAS u32x4*)(KT + k * 144 + J * 32 + 16) = w1; }
        hg_it(C, h, tc, k, J, IT);
        if (J == 0) HGD[(size_t)((d * 4 + h) * NCH + c) * 128 + k] = __expf((T.tot[0] + T.tot[1]) + (T.tot[2] + T.tot[3]));
        __syncthreads();
        const int r = C.lane & 31, hh = C.lane >> 5, vb = C.wave >> 1;
        float* outp = HGL + (size_t)((d * 4 + h) * NCH + c) * 16384;
#pragma unroll
        for (int t2 = 0; t2 < 2; ++t2) {
            const int kb = 2 * (C.wave & 1) + t2;
            f32x16 acc;
#pragma unroll
            for (int i = 0; i < 16; ++i) acc[i] = 0.f;
#pragma unroll
            for (int st = 0; st < 4; ++st) {
                const bf16x8 af = *(const LAS bf16x8*)(IT + (32 * vb + r) * 144 + st * 32 + hh * 16);
                const bf16x8 bf = *(const LAS bf16x8*)(KT + (32 * kb + r) * 144 + st * 32 + hh * 16);
                acc = MFMA32(af, bf, acc);
            }
#pragma unroll
            for (int reg = 0; reg < 16; ++reg) outp[(size_t)(32 * vb + KOFF(reg) + 4 * hh) * 128 + 32 * kb + r] = acc[reg];
        }
    }
}
__device__ __forceinline__ void phase_hg_B(Ctx& C, int b0, int nb) {
    const float* HGL = WSP(float, OFF_HGL); const float* HGD = WSP(float, OFF_HGD); bf16_t* SPT = WSP(bf16_t, OFF_SPT);
    for (int e = b0 * NT + C.tid; e < 8 * 16384; e += nb * NT) {
        const int dh = e >> 14, vk = e & 16383, k = vk & 127;
        float st = 0.f;
        const float* p = HGL + (size_t)dh * NCH * 16384 + vk; const float* dp = HGD + (size_t)dh * NCH * 128 + k; bf16_t* o = SPT + (size_t)dh * NCH * 16384 + vk;
#pragma unroll 4
        for (int c = 0; c < NCH; ++c) { const float Lc = p[(size_t)c * 16384], Dc = dp[c * 128]; o[(size_t)c * 16384] = (bf16_t)f2bf(st); st = Dc * st + Lc; }
    }
}
__device__ __forceinline__ void phase_hg_C(Ctx& C, int l, int b0, int nb) {
    const float* P = WSP(float, OFF_P32); const bf16_t* SPT = WSP(bf16_t, OFF_SPT); bf16_t* YB = WSP(bf16_t, OFF_YB);
    LAS unsigned char* KS = C.lds;
    LAS unsigned char* QJ = C.lds + 17408;
    LAS unsigned char* IT = C.lds + 17408 + 69632;
    LAS float* TOT = (LAS float*)(C.lds + 105472);
    LAS float* RED = (LAS float*)(C.lds + 107520);
    const int k = C.tid & 127, J = C.tid >> 7;
    const int tl = C.lane & 15, qd = C.lane >> 4, I = C.wave >> 1, vh = C.wave & 1;
    for (int u = b0; u < 4 * NCH; u += nb) {
        const int h = u / NCH, tc = u % NCH;
        f32x4 oT[4];
#pragma unroll
        for (int i = 0; i < 4; ++i) oT[i] = (f32x4){0.f, 0.f, 0.f, 0.f};
#pragma unroll 1
        for (int d = 0; d < 2; ++d) {
            const int cd = d == 0 ? (tc + 4) % NCH : NCH - 1 - tc;
            __syncthreads();
            {
                HgThread T; hg_gates(C, l, d, h, tc, k, J, TOT, T);
                float qv[16];
#pragma unroll
                for (int i = 0; i < 16; ++i) qv[i] = P[(size_t)(64 * tc + 16 * J + i) * P32W + h * 128 + k];
#pragma unroll
                for (int i = 0; i < 16; ++i) *(LAS bf16_t*)(KS + (16 * J + i) * 272 + 2 * k) = (bf16_t)f2bf(T.kd[i] * __expf(fminf(-T.lc[i], 80.f)));
#pragma unroll
                for (int Jp = 0; Jp < 4; ++Jp) {
                    if (d == 0 ? (Jp > J) : (Jp < J)) continue;
                    float Pj = 0.f;
#pragma unroll
                    for (int m = 0; m < 4; ++m) if (d == 0 ? (m >= Jp && m < J) : (m > J && m <= Jp)) Pj += T.tot[m];
#pragma unroll
                    for (int i = 0; i < 16; ++i) *(LAS bf16_t*)(QJ + (Jp * 64 + 16 * J + i) * 272 + 2 * k) = (bf16_t)f2bf(qv[i] * __expf(T.lc[i] + Pj));
                }
                hg_it(C, h, tc, k, J, IT);
            }
            __syncthreads();
            u32x2 att[4];
#pragma unroll
            for (int Jb = 0; Jb < 4; ++Jb) {
                att[Jb] = (u32x2){0u, 0u};
                if (d == 0 ? (Jb > I) : (Jb < I)) continue;
                f32x4 acc = {0.f, 0.f, 0.f, 0.f};
#pragma unroll
                for (int ks = 0; ks < 4; ++ks) {
                    const bf16x8 af = *(const LAS bf16x8*)(KS + (16 * Jb + tl) * 272 + ks * 64 + qd * 16);
                    const bf16x8 bf = *(const LAS bf16x8*)(QJ + (Jb * 64 + 16 * I + tl) * 272 + ks * 64 + qd * 16);
                    acc = MFMA16(af, bf, acc);
                }
                if (Jb == I) {
#pragma unroll
                    for (int reg = 0; reg < 4; ++reg) { const int sl = 4 * qd + reg; const bool valid = d == 0 ? (sl <= tl) : (sl >= tl); acc[reg] = valid ? acc[reg] : 0.f; }
                }
                att[Jb].x = pk2(acc[0], acc[1]); att[Jb].y = pk2(acc[2], acc[3]);
            }
#pragma unroll
            for (int pr = 0; pr < 2; ++pr) {
                const int Ja = 2 * pr, Jc = 2 * pr + 1;
                const bool anyv = d == 0 ? (Ja <= I) : (Jc >= I);
                if (!anyv) continue;
                u32x4 bw; bw.x = att[Ja].x; bw.y = att[Ja].y; bw.z = att[Jc].x; bw.w = att[Jc].y;
                const bf16x8 bf = __builtin_bit_cast(bf16x8, bw);
#pragma unroll
                for (int vb = 0; vb < 4; ++vb) {
                    const int v = 16 * (4 * vh + vb) + tl;
                    const u32x2 a0 = *(const LAS u32x2*)(IT + v * 144 + Ja * 32 + qd * 8), a1 = *(const LAS u32x2*)(IT + v * 144 + Jc * 32 + qd * 8);
                    u32x4 aw; aw.x = a0.x; aw.y = a0.y; aw.z = a1.x; aw.w = a1.y;
                    oT[vb] = MFMA16(__builtin_bit_cast(bf16x8, aw), bf, oT[vb]);
                }
            }
            const bf16_t* sp = SPT + (size_t)((d * 4 + h) * NCH + cd) * 16384;
            const int Je = d == 0 ? 0 : 3;
#pragma unroll
            for (int ks = 0; ks < 4; ++ks) {
                const bf16x8 bf = *(const LAS bf16x8*)(QJ + (Je * 64 + 16 * I + tl) * 272 + ks * 64 + qd * 16);
#pragma unroll
                for (int vb = 0; vb < 4; ++vb) {
                    const bf16x8 af = *(const bf16x8*)(sp + (size_t)(16 * (4 * vh + vb) + tl) * 128 + ks * 32 + qd * 8);
                    oT[vb] = MFMA16(af, bf, oT[vb]);
                }
            }
        }
        float ss = 0.f;
#pragma unroll
        for (int vb = 0; vb < 4; ++vb) ss += (oT[vb][0] * oT[vb][0] + oT[vb][1] * oT[vb][1]) + (oT[vb][2] * oT[vb][2] + oT[vb][3] * oT[vb][3]);
        ss += __shfl_xor(ss, 16); ss += __shfl_xor(ss, 32);
        __syncthreads();
        if (qd == 0) RED[C.wave * 16 + tl] = ss;
        __syncthreads();
        const float rstd = rsqrtf((RED[(2 * I) * 16 + tl] + RED[(2 * I + 1) * 16 + tl]) * (1.0f / 128.0f) + EPS);
        const int row = 64 * tc + 16 * I + tl;
#pragma unroll
        for (int vb = 0; vb < 4; ++vb) {
            const int v0 = 16 * (4 * vh + vb) + 4 * qd;
            const f32x4 nw = *(const f32x4*)(C.ka->in[I_HGNORM] + l * 512 + h * 128 + v0);
            const f32x4 gv = *(const f32x4*)(P + (size_t)row * P32W + 2048 + h * 128 + v0);
            u32x2 w; w.x = pg8::cvt_pk_bf16(oT[vb][0] * rstd * nw.x * siluf_(gv.x), oT[vb][1] * rstd * nw.y * siluf_(gv.y));
            w.y = pg8::cvt_pk_bf16(oT[vb][2] * rstd * nw.z * siluf_(gv.z), oT[vb][3] * rstd * nw.w * siluf_(gv.w));
            *(u32x2*)(YB + (size_t)row * 512 + h * 128 + v0) = w;
        }
    }
}

constexpr int RW_NJOBS = 64;
__device__ __forceinline__ void phase_rw_scan(Ctx& C, int b0, int nb) {
    float* RO = WSP(float, OFF_RO);
    LAS unsigned char* slot = C.lds;
    const int lane = C.lane, wv = C.wave;
    for (int job = b0; job < RW_NJOBS; job += nb) {
        const int d = job >> 5, h = (job >> 2) & 7, vs = job & 3;
        const unsigned char* mg = C.ws + OFF_RWMG + (size_t)(d * 8 + h) * RW_NCK * RWMG_REC;
        const unsigned char* hr = C.ws + OFF_RWH + (size_t)(d * 8 + h) * RW_NCK * RWH_REC + (size_t)vs * 4096;
        __syncthreads();
        u32x4 st[14];
#define RW_ISSUE(cc) do { _Pragma("unroll") for (int i = 0; i < 10; ++i) st[i] = *(const u32x4*)(mg + (size_t)(cc) * RWMG_REC + (size_t)(i * 64 + lane) * 16); \
                          _Pragma("unroll") for (int i = 0; i < 4; ++i) st[10 + i] = *(const u32x4*)(hr + (size_t)(cc) * RWH_REC + (size_t)(i * 64 + lane) * 16); } while (0)
#pragma unroll
        for (int i = 0; i < 14; ++i) st[i] = (u32x4){0u, 0u, 0u, 0u};
        if (wv >= 1 && wv - 1 < RW_NCK) RW_ISSUE(wv - 1);
        f32x4 acc[4];
#pragma unroll
        for (int i = 0; i < 4; ++i) acc[i] = (f32x4){0.f, 0.f, 0.f, 0.f};
        const int vl = lane & 15, q = lane >> 4;
#pragma unroll 1
        for (int cc = -1; cc < RW_NCK; ++cc) {
            if (wv >= 1) {
                const int nx = cc + 1;
                if (nx < RW_NCK && nx % 7 == wv - 1) {
                    asm volatile("s_waitcnt vmcnt(0)" ::: "memory");
#pragma unroll
                    for (int i = 0; i < 14; ++i) *(LAS u32x4*)(slot + (nx & 1) * 14336 + (i * 64 + lane) * 16) = st[i];
                    if (nx + 7 < RW_NCK) RW_ISSUE(nx + 7);
                    asm volatile("s_waitcnt lgkmcnt(0)" ::: "memory");
                }
            } else if (cc >= 0) {
                const LAS unsigned char* sl = slot + (cc & 1) * 14336;
                bf16x8 bfr[2];
#pragma unroll
                for (int s2 = 0; s2 < 2; ++s2) { u32x4 w; w.x = pk2(acc[2 * s2][0], acc[2 * s2][1]); w.y = pk2(acc[2 * s2][2], acc[2 * s2][3]); w.z = pk2(acc[2 * s2 + 1][0], acc[2 * s2 + 1][1]); w.w = pk2(acc[2 * s2 + 1][2], acc[2 * s2 + 1][3]);
                    bfr[s2] = __builtin_bit_cast(bf16x8, w); }
                const int rc = d == 0 ? (cc + RW_NCK - 16) % RW_NCK : RW_NCK - 1 - cc;
                float* rop = RO + ((size_t)d * MT + 16 * rc) * 512 + h * 64 + 16 * vs + vl;
                f32x4 oacc;
#pragma unroll
                for (int reg = 0; reg < 4; ++reg) { const int i = 4 * q + reg; oacc[reg] = rop[(size_t)(d ? 15 - i : i) * 512]; }
#pragma unroll
                for (int s2 = 0; s2 < 2; ++s2) oacc = MFMA16(*(const LAS bf16x8*)(sl + 8192 + (s2 * 64 + lane) * 16), bfr[s2], oacc);
#pragma unroll
                for (int reg = 0; reg < 4; ++reg) { const int i = 4 * q + reg; rop[(size_t)(d ? 15 - i : i) * 512] = oacc[reg]; }
#pragma unroll
                for (int kb = 0; kb < 4; ++kb) {
                    f32x4 a = *(const LAS f32x4*)(sl + 10240 + (kb * 64 + lane) * 16);
#pragma unroll
                    for (int s2 = 0; s2 < 2; ++s2) a = MFMA16(*(const LAS bf16x8*)(sl + ((kb * 2 + s2) * 64 + lane) * 16), bfr[s2], a);
                    acc[kb] = a;
                }
            }
            asm volatile("s_waitcnt lgkmcnt(0)" ::: "memory"); __builtin_amdgcn_s_barrier(); asm volatile("" ::: "memory");
        }
#undef RW_ISSUE
    }
}
__device__ __forceinline__ void phase_rw_finish(Ctx& C, int l, int w0, int nw) {
    const float* VV = WSP(float, OFF_VV); const float* GS = WSP(float, OFF_GS); const float* RO = WSP(float, OFF_RO); const float* BON = WSP(float, OFF_BON);
    bf16_t* YB = WSP(bf16_t, OFF_YB) + (size_t)1 * MT * 512;
    const int e = C.lane;
    for (int uidx = w0; uidx < MT * 8; uidx += nw) {
        const int r = uidx >> 3, h = uidx & 7, c = h * 64 + e;
        const float o = RO[(size_t)r * 512 + c] + RO[((size_t)MT + r) * 512 + c];
        const float mu = wave_sum_fast(o) * (1.0f / 64.0f);
        const float dv = o - mu;
        const float var = wave_sum_fast(dv * dv) * (1.0f / 64.0f);
        const float on = dv * rsqrtf(var + RW_GN_EPS) * C.ka->in[I_RWLNW][l * 512 + c] + C.ka->in[I_RWLNB][l * 512 + c];
        const float y = (on + BON[(size_t)r * 8 + h] * VV[(size_t)r * 512 + c]) * GS[(size_t)r * 512 + c];
        YB[(size_t)r * 512 + c] = (bf16_t)f2bf(y);
    }
}

typedef float f32x4u __attribute__((ext_vector_type(4), aligned(4)));
__device__ __forceinline__ float swap32_sum(float x) { auto t = __builtin_amdgcn_permlane32_swap(__float_as_uint(x), __float_as_uint(x), false, false); return __uint_as_float(t[0]) + __uint_as_float(t[1]); }
__device__ __forceinline__ f32x16 qk_tile(const bf16_t* Kp  , const bf16x8 (&qf)[4], int r, int h) {
    f32x16 acc;
#pragma unroll
    for (int i = 0; i < 16; ++i) acc[i] = 0.f;
    const bf16_t* p = Kp + (size_t)r * PAW + 8 * h;
#pragma unroll
    for (int s = 0; s < 4; ++s) { const bf16x8 kf = *(const bf16x8*)(p + 16 * s); acc = MFMA32(kf, qf[s], acc); }
    return acc;
}
__device__ __forceinline__ void pv_tile(f32x16 (&o)[2], const bf16_t* VTp  , const f32x16& p, int r, int h) {
#pragma unroll
    for (int s = 0; s < 2; ++s) {
        u32x4 pw; pw.x = pg8::cvt_pk_bf16(p[8 * s + 0], p[8 * s + 1]); pw.y = pg8::cvt_pk_bf16(p[8 * s + 2], p[8 * s + 3]); pw.z = pg8::cvt_pk_bf16(p[8 * s + 4], p[8 * s + 5]); pw.w = pg8::cvt_pk_bf16(p[8 * s + 6], p[8 * s + 7]);
        const bf16x8 pb = __builtin_bit_cast(bf16x8, pw);
#pragma unroll
        for (int blk = 0; blk < 2; ++blk) {
            const bf16_t* vp = VTp + (size_t)(32 * blk + r) * MT + 16 * s + 4 * h;
            const u32x2 lo = *(const u32x2*)vp, hi = *(const u32x2*)(vp + 8);
            u32x4 vw; vw.x = lo.x; vw.y = lo.y; vw.z = hi.x; vw.w = hi.y;
            o[blk] = MFMA32(__builtin_bit_cast(bf16x8, vw), pb, o[blk]);
        }
    }
}
__device__ __forceinline__ void phase_attn(Ctx& C, int l, int w0, int nw) {
    const bf16_t* PA = WSP(bf16_t, OFF_PA); bf16_t* YB = WSP(bf16_t, OFF_YB);
    const bf16_t* VTN = WSP(bf16_t, OFF_VTN); const bf16_t* VTW = WSP(bf16_t, OFF_VTW);
    const float* PB = WSP(float, OFF_PB); const float* MREF = WSP(float, OFF_MREF);
    const int r = C.lane & 31, h = C.lane >> 5;
    constexpr int NJT = 2048 + 64;
    for (int job = w0; job < 2 * NJT; job += nw) {
        const int type = __builtin_amdgcn_readfirstlane(job / NJT), jj = __builtin_amdgcn_readfirstlane(job % NJT), qt = jj >> 3, hd = jj & 7;
        const int q0 = qt * 32;
        const bool lat = qt < 256;
        const float Mr = MREF[type];
        bf16x8 qf[4];
        { const bf16_t* qp = PA + (size_t)(q0 + r) * PAW + (type == 0 ? 0 : 1536) + hd * 64 + 8 * h;
#pragma unroll
          for (int s = 0; s < 4; ++s) qf[s] = *(const bf16x8*)(qp + 16 * s); }
        f32x16 o[2];
#pragma unroll
        for (int i = 0; i < 16; ++i) { o[0][i] = 0.f; o[1][i] = 0.f; }
        float lsum = 0.f;
        const int kcol = type == 0 ? 512 + hd * 64 : 2048 + (hd >> 2) * 64;
        const bf16_t* VT = type == 0 ? VTN + (size_t)(hd * 64) * MT : VTW + (size_t)((hd >> 2) * 64) * MT;
        if (type == 0) {
            if (lat) {
                const int i = qt >> 1, j = (qt & 1) * 32 + r;
                int rs = i - 4; rs = rs < 0 ? 0 : (rs > 120 ? 120 : rs);
                int cs = j - 8; cs = cs < 0 ? 0 : (cs > 48 ? 48 : cs);
#pragma unroll 1
                for (int t = 0; t < 16; ++t) {
                    const int a = t >> 1, cc = t & 1;
                    const int key0 = (rs + a) * 64 + 32 * cc;
                    const f32x16 acc = qk_tile(PA + (size_t)key0 * PAW + kcol, qf, r, h);
                    const float* brow = PB + (size_t)(hd * 15 + (rs + a - i + 7)) * 128 + (32 * cc + 4 * h - j + 63);
                    const int lo = cs - 32 * cc - 4 * h;
                    f32x16 p;
#pragma unroll
                    for (int g = 0; g < 4; ++g) {
                        const f32x4u b4 = *(const f32x4u*)(brow + 8 * g);
#pragma unroll
                        for (int q = 0; q < 4; ++q) { const int reg = 4 * g + q; const bool valid = (unsigned)(KOFF(reg) - lo) < 16u;
                            const float e = __expf(acc[reg] + b4[q] - Mr); p[reg] = valid ? e : 0.f; lsum += p[reg]; }
                    }
                    pv_tile(o, VT + key0, p, r, h);
                }
            }
        } else {
            if (lat) {
#pragma unroll 1
                for (int dl = -4; dl <= 4; ++dl) {
                    const int kt = qt + dl;
                    if (kt < 0 || kt > 255) continue;
                    const int key0 = kt * 32;
                    const f32x16 acc = qk_tile(PA + (size_t)key0 * PAW + kcol, qf, r, h);
                    f32x16 p;
#pragma unroll
                    for (int reg = 0; reg < 16; ++reg) { const int kr = KOFF(reg) + 4 * h; const bool valid = dl == -4 ? (kr >= r) : (dl == 4 ? (kr <= r) : true);
                        const float e = __expf(acc[reg] - Mr); p[reg] = valid ? e : 0.f; lsum += p[reg]; }
                    pv_tile(o, VT + key0, p, r, h);
                }
            }
        }
#pragma unroll 1
        for (int t = 0; t < CTX / 32; ++t) {
            const int key0 = SEQ + 32 * t;
            const f32x16 acc = qk_tile(PA + (size_t)key0 * PAW + kcol, qf, r, h);
            f32x16 p;
#pragma unroll
            for (int reg = 0; reg < 16; ++reg) { p[reg] = __expf(acc[reg] - Mr); lsum += p[reg]; }
            pv_tile(o, VT + key0, p, r, h);
        }
        float ltot = swap32_sum(lsum);
        if (type == 1) ltot += __expf(C.ka->in[I_WASINK][l * 8 + hd] - Mr);
        const float inv = 1.0f / ltot;
        bf16_t* yp = YB + (size_t)(2 + type) * MT * 512 + (size_t)(q0 + r) * 512 + hd * 64 + 4 * h;
#pragma unroll
        for (int blk = 0; blk < 2; ++blk)
#pragma unroll
            for (int g = 0; g < 4; ++g) {
                u32x2 w; w.x = pg8::cvt_pk_bf16(o[blk][4 * g] * inv, o[blk][4 * g + 1] * inv); w.y = pg8::cvt_pk_bf16(o[blk][4 * g + 2] * inv, o[blk][4 * g + 3] * inv);
                *(u32x2*)(yp + 32 * blk + 8 * g) = w;
            }
    }
}
__device__ __forceinline__ void phase_attn_tables(Ctx& C, int l, int w0, int nw) {
    const bf16_t* PA = WSP(bf16_t, OFF_PA); bf16_t* VTN = WSP(bf16_t, OFF_VTN); bf16_t* VTW = WSP(bf16_t, OFF_VTW);
    LAS unsigned char* tile = C.lds + C.wave * 9216;
    const int lane = C.lane;
    for (int u = w0; u < 10 * NCH; u += nw) {
        const int hd = u / NCH, tt = u % NCH, t0 = tt * 64;
        const int vcol = hd < 8 ? 1024 + hd * 64 : 2176 + (hd - 8) * 64;
#pragma unroll
        for (int it = 0; it < 8; ++it) { const int row = 8 * it + (lane >> 3), ch = lane & 7;
            *(LAS u32x4*)(tile + row * 144 + ch * 16) = *(const u32x4*)(PA + (size_t)(t0 + row) * PAW + vcol + ch * 8); }
        LDS_WAIT(); asm volatile("" ::: "memory");
        bf16_t* dst = (hd < 8 ? VTN + (size_t)(hd * 64 + lane) * MT : VTW + (size_t)((hd - 8) * 64 + lane) * MT) + t0;
#pragma unroll
        for (int it = 0; it < 8; ++it) {
            unsigned e[8];
#pragma unroll
            for (int j = 0; j < 8; ++j) e[j] = *(const LAS bf16_t*)(tile + (8 * it + j) * 144 + 2 * lane);
            u32x4 w; w.x = e[0] | (e[1] << 16); w.y = e[2] | (e[3] << 16); w.z = e[4] | (e[5] << 16); w.w = e[6] | (e[7] << 16);
            *(u32x4*)(dst + 8 * it) = w;
        }
        LDS_WAIT(); asm volatile("" ::: "memory");
    }
    float* PB = WSP(float, OFF_PB);
    const float* rpb = C.ka->in[I_NARPB] + (size_t)l * 8 * 15 * 31;
    for (int idx = w0 * 64 + lane; idx < 8 * 15 * 128; idx += nw * 64) { const int x = idx & 127, hr = idx >> 7; PB[idx] = (x >= 48 && x < 79) ? rpb[hr * 31 + x - 48] : 0.f; }
    if (w0 == 0) {
        float mb = 0.f;
        for (int i = lane; i < 8 * 15 * 31; i += 64) mb = fmaxf(mb, fabsf(rpb[i]));
        mb = wave_max(mb);
        const float nq = wave_max(fabsf(C.ka->in[I_NAQN][l * 64 + lane])), nk = wave_max(fabsf(C.ka->in[I_NAKN][l * 64 + lane]));
        const float wq = wave_max(fabsf(C.ka->in[I_WAQN][l * 64 + lane])), wk = wave_max(fabsf(C.ka->in[I_WAKN][l * 64 + lane]));
        const float sk = wave_max(lane < 8 ? C.ka->in[I_WASINK][l * 8 + lane] : -1e30f);
        if (lane == 0) { float* M = WSP(float, OFF_MREF); M[0] = 8.08f * nq * nk + mb; M[1] = fmaxf(8.08f * wq * wk, sk); }
    }
}

__device__ __forceinline__ void phase_combine(Ctx& C) {
    const bf16_t* PROJ = WSP(bf16_t, OFF_P32); bf16_t* MG = WSP(bf16_t, OFF_H);
    const size_t n8 = (size_t)MT * D / 8;
    for (size_t i = (size_t)C.bid * NT + C.tid; i < n8; i += (size_t)C.G * NT) {
        const size_t r = i / (D / 8), c8 = i % (D / 8);
        float a[8];
#pragma unroll
        for (int j = 0; j < 8; ++j) a[j] = 0.f;
#pragma unroll
        for (int g = 0; g < 4; ++g) {
            const u32x4 w = *(const u32x4*)(PROJ + r * GLW + g * D + c8 * 8);
            a[0] += bf2f(w.x & 0xffffu); a[1] += bf2f(w.x >> 16); a[2] += bf2f(w.y & 0xffffu); a[3] += bf2f(w.y >> 16);
            a[4] += bf2f(w.z & 0xffffu); a[5] += bf2f(w.z >> 16); a[6] += bf2f(w.w & 0xffffu); a[7] += bf2f(w.w >> 16);
        }
        u32x4 o; o.x = pk2(a[0], a[1]); o.y = pk2(a[2], a[3]); o.z = pk2(a[4], a[5]); o.w = pk2(a[6], a[7]);
        *(u32x4*)(MG + r * D + c8 * 8) = o;
    }
}

constexpr int PH_PRO = 2, PH_PER_LAYER = 14, N_PHASES = PH_PRO + DEPTH * PH_PER_LAYER;

__global__ void __launch_bounds__(NT, 2) mk_fwd(Args args) {
    extern __shared__ __attribute__((aligned(16))) unsigned char lds_raw[];
    Ctx C;
    C.lds = (LAS unsigned char*)lds_raw;
    C.tid = threadIdx.x; C.lane = C.tid & 63; C.wave = __builtin_amdgcn_readfirstlane(C.tid >> 6);
    C.bid = blockIdx.x; C.G = gridDim.x;
    C.ka = (const Args __attribute__((address_space(4)))*)__builtin_amdgcn_kernarg_segment_ptr(); C.out = args.out; C.ws = args.ws;
    volatile LAS unsigned* MISC = (volatile LAS unsigned*)(C.lds + MISC_OFF);
    for (int u = C.tid; u < (LDS_BYTES - RING_BYTES) / 4; u += NT) ((LAS unsigned*)(C.lds + RING_BYTES))[u] = 0u;
    __syncthreads();
    const int lo = args.ph_lo, hi = args.ph_hi;
    XcdBarrier bar; bar.bar = WSP(unsigned, OFF_CTL) + 4096; bar.x = 0; bar.st = nullptr;
    const bool multi = (hi - lo) > 1;
    if (multi) bar = xcd_barrier_post(WSP(unsigned, OFF_CTL) + 4096, MISC + 8);
#ifndef PH_MASK
#define PH_MASK 0xFFFF
#endif
#ifndef PRO_MASK
#define PRO_MASK 3
#endif
#define IN(k) (lo <= (k) && (k) < hi)
#define LEN(j) (((PH_MASK) >> (j)) & 1)
#define SEAM(k) do { if (IN(k) && IN((k) + 1)) xcd_barrier(bar); } while (0)

    if ((PRO_MASK & 1) && IN(0)) { relaunder(C); phase_convert(C, 0); phase_ada_partial(C); } SEAM(0);
    if ((PRO_MASK & 2) && IN(1)) { relaunder(C); phase_ada_reduce(C); } SEAM(1);

#pragma unroll
    for (int l = 0; l < DEPTH; ++l) {
        const int pb = PH_PRO + l * PH_PER_LAYER;
        if (LEN(0) && IN(pb + 0)) { relaunder(C); if (l > 0) phase_convert(C, l); phase_norm(C, l, C.ka->in[I_NF1] + (size_t)l * D, 0, l > 0 ? 22 : 0); } SEAM(pb + 0);
        if (LEN(1) && IN(pb + 1)) { relaunder(C);
            pg8::Gemm g{WSP(bf16_t, OFF_H), WSP(bf16_t, OFF_WI1), 1 << 20, 0};
            pg8::StaticOrder S; S.init(MT, 2 * DFF, C.G, C.bid);
            pg8::EpiSwiGLU E{WSP(bf16_t, OFF_G)};
            pg8::gemm_phase<pg8::EpiSwiGLU, true, false, pg8::StaticOrder, D, D, D, 0>(C.lds, g, S, E, C.tid);
            if (PROBE_MODE == 3) { pg8::gemm_phase<pg8::EpiSwiGLU, true, false, pg8::StaticOrder, D, D, D, 0>(C.lds, g, S, E, C.tid); }
        } SEAM(pb + 1);
        if (LEN(2) && IN(pb + 2)) { relaunder(C);
            { pg8::Gemm g{WSP(bf16_t, OFF_G), WSP(bf16_t, OFF_WO1), 1 << 20, 0};
              pg8::StaticOrder S; S.init(SEQ, D, C.G, C.bid);
              pg8::EpiResid<true> E{WSP(float, OFF_X), mod_ptr(C, l, 0, 2), mod_ptr(C, l, 1, 2), nullptr};
              pg8::gemm_phase<pg8::EpiResid<true>, true, false, pg8::StaticOrder, DFF, DFF, DFF, 0>(C.lds, g, S, E, C.tid); }
            { relaunder(C); pg8::Gemm g{WSP(bf16_t, OFF_G), WSP(bf16_t, OFF_WO1), 1 << 20, 0};
              pg8::SplitOrder S{SEQ / 256, D / 256, 22, C.G, C.bid};
              pg8::EpiPart<true> E{WSP(float, OFF_P32), mod_ptr(C, l, 1, 2)};
              pg8::gemm_phase<pg8::EpiPart<true>, true, false, pg8::SplitOrder, 256, DFF, DFF, 256>(C.lds, g, S, E, C.tid); }
        } SEAM(pb + 2);
        if (LEN(3) && IN(pb + 3)) { relaunder(C); phase_norm(C, l, C.ka->in[I_NMIX] + (size_t)l * D, 3, 22); } SEAM(pb + 3);
        if (LEN(4) && IN(pb + 4)) { relaunder(C);
            pg8::Gemm g{WSP(bf16_t, OFF_H), WSP(bf16_t, OFF_WIN), 1 << 20, 0};
            pg8::StaticOrder S; S.init(MT, P32W + PAW, C.G, C.bid);
            pg8::EpiWin E{WSP(float, OFF_P32), WSP(bf16_t, OFF_PA), WSP(bf16_t, OFF_GL), 0};
            pg8::gemm_phase<pg8::EpiWin, true, false, pg8::StaticOrder, D, D, D, 0>(C.lds, g, S, E, C.tid);
            if (PROBE_MODE == 3) { pg8::gemm_phase<pg8::EpiWin, true, false, pg8::StaticOrder, D, D, D, 0>(C.lds, g, S, E, C.tid); }
        } SEAM(pb + 4);
        if (LEN(5) && IN(pb + 5)) { relaunder(C);
            phase_rw_prep(C, l, C.bid, C.G);
            __syncthreads();
            phase_attn_prep(C, l, C.bid * NWAVES + C.wave, C.G * NWAVES);
            phase_attn_tables(C, l, C.bid * NWAVES + C.wave, C.G * NWAVES);
            if (PROBE_MODE == 1) phase_attn_tables(C, l, C.bid * NWAVES + C.wave, C.G * NWAVES);
            __syncthreads();
            phase_hg_A(C, l, C.bid, C.G);
            if (PROBE_MODE == 1) phase_hg_A(C, l, C.bid, C.G);
        } SEAM(pb + 5);
        if (LEN(6) && IN(pb + 6)) { relaunder(C);
            if (C.G >= 256) {
                if (C.bid < RW_NJOBS) phase_rw_scan(C, C.bid, RW_NJOBS);
                else { const int b = C.bid - RW_NJOBS, n = C.G - RW_NJOBS; phase_hg_B(C, b, n); phase_attn(C, l, b * NWAVES + C.wave, n * NWAVES);
                    __syncthreads();
                    pg8::Gemm g{WSP(bf16_t, OFF_H), WSP(bf16_t, OFF_WIN) + (size_t)(P32W + PAW) * D, 1 << 20, 0};
                    pg8::StaticOrder S; S.init(MT, GLW, n, b);
                    pg8::EpiWin E{WSP(float, OFF_P32), WSP(bf16_t, OFF_PA), WSP(bf16_t, OFF_GL), 28};
                    pg8::gemm_phase<pg8::EpiWin, true, false, pg8::StaticOrder, D, D, D, 0>(C.lds, g, S, E, C.tid); }
            } else {
                phase_rw_scan(C, C.bid, C.G); phase_hg_B(C, C.bid, C.G); phase_attn(C, l, C.bid * NWAVES + C.wave, C.G * NWAVES);
                __syncthreads();
                pg8::Gemm g{WSP(bf16_t, OFF_H), WSP(bf16_t, OFF_WIN) + (size_t)(P32W + PAW) * D, 1 << 20, 0};
                pg8::StaticOrder S; S.init(MT, GLW, C.G, C.bid);
                pg8::EpiWin E{WSP(float, OFF_P32), WSP(bf16_t, OFF_PA), WSP(bf16_t, OFF_GL), 28};
                pg8::gemm_phase<pg8::EpiWin, true, false, pg8::StaticOrder, D, D, D, 0>(C.lds, g, S, E, C.tid);
            }
        } SEAM(pb + 6);
        if (LEN(7) && IN(pb + 7)) { relaunder(C); phase_hg_C(C, l, C.bid, C.G); phase_rw_finish(C, l, C.bid * NWAVES + C.wave, C.G * NWAVES);
            if (PROBE_MODE == 2) { phase_hg_C(C, l, C.bid, C.G); phase_rw_finish(C, l, C.bid * NWAVES + C.wave, C.G * NWAVES); } } SEAM(pb + 7);
        if (LEN(8) && IN(pb + 8)) { relaunder(C);
            pg8::Gemm g{WSP(bf16_t, OFF_YB), WSP(bf16_t, OFF_WBR), 8, (size_t)MT * 512};
            pg8::StaticOrder S; S.init(MT, 4 * D, C.G, C.bid);
            pg8::EpiMerge E{WSP(bf16_t, OFF_GL), WSP(bf16_t, OFF_P32)};
            pg8::gemm_phase<pg8::EpiMerge, true, false, pg8::StaticOrder, 512, 512, 512, 0>(C.lds, g, S, E, C.tid);
            if (PROBE_MODE == 3) { pg8::gemm_phase<pg8::EpiMerge, true, false, pg8::StaticOrder, 512, 512, 512, 0>(C.lds, g, S, E, C.tid); }
        } SEAM(pb + 8);
        if (LEN(9) && IN(pb + 9)) { relaunder(C); phase_combine(C); if (PROBE_MODE == 2) phase_combine(C); } SEAM(pb + 9);
        if (LEN(10) && IN(pb + 10)) { relaunder(C);
            { pg8::Gemm g{WSP(bf16_t, OFF_H), WSP(bf16_t, OFF_WOUT), 1 << 20, 0};
              pg8::StaticOrder S; S.init(SEQ, D, C.G, C.bid);
              pg8::EpiResid<false> E{WSP(float, OFF_X), mod_ptr(C, l, 0, 5), mod_ptr(C, l, 1, 5), nullptr};
              pg8::gemm_phase<pg8::EpiResid<false>, true, false, pg8::StaticOrder, D, D, D, 0>(C.lds, g, S, E, C.tid); }
            if (l < DEPTH - 1) { relaunder(C);
              pg8::Gemm g{WSP(bf16_t, OFF_H), WSP(bf16_t, OFF_WOUT), 1 << 20, 0};
              pg8::SplitOrder S{SEQ / 256, D / 256, 8, C.G, C.bid};
              pg8::EpiPart<false> E{WSP(float, OFF_P32), mod_ptr(C, l, 1, 5)};
              pg8::gemm_phase<pg8::EpiPart<false>, true, false, pg8::SplitOrder, 256, D, D, 256>(C.lds, g, S, E, C.tid); }
        } SEAM(pb + 10);
        if (LEN(11) && IN(pb + 11)) { relaunder(C); phase_norm(C, l, C.ka->in[I_NF2] + (size_t)l * D, 6, l < DEPTH - 1 ? 8 : 0); } SEAM(pb + 11);
        if (LEN(12) && IN(pb + 12)) { relaunder(C);
            pg8::Gemm g{WSP(bf16_t, OFF_H), WSP(bf16_t, OFF_WI2), 1 << 20, 0};
            pg8::StaticOrder S; S.init(MT, 2 * DFF, C.G, C.bid);
            pg8::EpiSwiGLU E{WSP(bf16_t, OFF_G)};
            pg8::gemm_phase<pg8::EpiSwiGLU, true, false, pg8::StaticOrder, D, D, D, 0>(C.lds, g, S, E, C.tid);
            if (PROBE_MODE == 3) { pg8::gemm_phase<pg8::EpiSwiGLU, true, false, pg8::StaticOrder, D, D, D, 0>(C.lds, g, S, E, C.tid); }
        } SEAM(pb + 12);
        if (LEN(13) && IN(pb + 13)) { relaunder(C);
            { pg8::Gemm g{WSP(bf16_t, OFF_G), WSP(bf16_t, OFF_WO2), 1 << 20, 0};
              pg8::StaticOrder S; S.init(SEQ, D, C.G, C.bid);
              pg8::EpiResid<true> E{WSP(float, OFF_X), mod_ptr(C, l, 0, 8), mod_ptr(C, l, 1, 8), l == DEPTH - 1 ? C.out : nullptr};
              pg8::gemm_phase<pg8::EpiResid<true>, true, false, pg8::StaticOrder, DFF, DFF, DFF, 0>(C.lds, g, S, E, C.tid); }
            if (l < DEPTH - 1) { relaunder(C);
              pg8::Gemm g{WSP(bf16_t, OFF_G), WSP(bf16_t, OFF_WO2), 1 << 20, 0};
              pg8::SplitOrder S{SEQ / 256, D / 256, 22, C.G, C.bid};
              pg8::EpiPart<true> E{WSP(float, OFF_P32), mod_ptr(C, l, 1, 8)};
              pg8::gemm_phase<pg8::EpiPart<true>, true, false, pg8::SplitOrder, 256, DFF, DFF, 256>(C.lds, g, S, E, C.tid); }
        } SEAM(pb + 13);
    }
#undef IN
#undef SEAM
}

extern "C" void kernel_launch(void* const* d_in, const int* in_sizes, int n_in, void* d_out, int out_size, void* d_ws, size_t ws_size, hipStream_t stream) {
    static int grid = 0;
    if (grid == 0) {
        if (n_in != N_IN || out_size != SEQ * D || ws_size < WS_END) { fprintf(stderr, "kernel_launch: unexpected shapes (n_in %d out %d ws %zu)\n", n_in, out_size, ws_size); grid = -1; return; }
        int dev = 0, cus = 0;
        if (hipGetDevice(&dev) != hipSuccess || hipDeviceGetAttribute(&cus, hipDeviceAttributeMultiprocessorCount, dev) != hipSuccess) { grid = -1; return; }
        if (hipFuncSetAttribute((const void*)mk_fwd, hipFuncAttributeMaxDynamicSharedMemorySize, LDS_BYTES) != hipSuccess) { fprintf(stderr, "kernel_launch: hipFuncSetAttribute failed\n"); grid = -1; return; }
        (void)hipGetLastError();
        grid = cus;
    }
    if (grid < 0) return;
    (void)hipMemsetAsync((char*)d_ws + OFF_CTL, 0, CTL_BYTES, stream);
    Args a{};
    for (int i = 0; i < N_IN; ++i) a.in[i] = (const float*)d_in[i];
    a.out = (float*)d_out; a.ws = (unsigned char*)d_ws;
#if MK_ONE_LAUNCH
    a.ph_lo = 0; a.ph_hi = N_PHASES;
    hipLaunchKernelGGL(mk_fwd, dim3(grid), dim3(NT), LDS_BYTES, stream, a);
#else
    for (int ph = 0; ph < N_PHASES; ++ph) {
        a.ph_lo = ph; a.ph_hi = ph + 1;
        hipLaunchKernelGGL(mk_fwd, dim3(grid), dim3(NT), LDS_BYTES, stream, a);
    }
#endif
}
```

```cpp
#include <hip/hip_runtime.h>
#include <cstdio>
#include <cstdint>

#ifndef PROBE_MODE
#define PROBE_MODE 0
#endif
#ifndef MK_ONE_LAUNCH
#define MK_ONE_LAUNCH 1
#endif

#define LAS __attribute__((address_space(3)))
#define GAS __attribute__((address_space(1)))
typedef unsigned short bf16_t;
typedef short bf16x8 __attribute__((ext_vector_type(8)));
typedef float f32x4 __attribute__((ext_vector_type(4)));
typedef float f32x2 __attribute__((ext_vector_type(2)));
typedef unsigned u32x4 __attribute__((ext_vector_type(4)));
typedef unsigned u32x2 __attribute__((ext_vector_type(2)));

constexpr int D = 2048, SEQ = 8192, CTX = 256, MT = SEQ + CTX, DEPTH = 2, DFF = 5632, NMOD = 9, MODW = NMOD * D;
constexpr int GRID_W = 64;
constexpr int PTOT = 15360, P32W = 4864, PAW = 2304, GLW = 8192;
constexpr int HG_OFF = 0, RW_OFF = 2560, RWC = 2304;
constexpr int NCH = MT / 64;
constexpr int NWAVES = 8, NT = 512;
constexpr float EPS = 1e-6f, RW_GN_EPS = 64e-5f;

constexpr size_t MiB = 1u << 20;
constexpr size_t OFF_CTL = 0, CTL_BYTES = 1 * MiB;
constexpr size_t OFF_W2T = 512 * 1024;
constexpr size_t OFF_MOD = 1 * MiB;
constexpr size_t OFF_MODP = 2 * MiB;
constexpr size_t OFF_WI1 = 11 * MiB, OFF_WO1 = 55 * MiB, OFF_WIN = 77 * MiB, OFF_WBR = 137 * MiB, OFF_WOUT = 145 * MiB, OFF_WI2 = 153 * MiB, OFF_WO2 = 197 * MiB;
constexpr size_t OFF_X = 219 * MiB;
constexpr size_t OFF_H = 285 * MiB;
constexpr size_t OFF_G = 318 * MiB;
constexpr size_t OFF_P32 = 409 * MiB;
constexpr size_t OFF_PA = 566 * MiB;
constexpr size_t OFF_GL = 604 * MiB;
constexpr size_t OFF_HGL = 736 * MiB;
constexpr size_t OFF_HGD = 802 * MiB;
constexpr size_t OFF_SCN = 803 * MiB;
constexpr size_t OFF_VV = 968 * MiB;
constexpr size_t OFF_GS = 985 * MiB;
constexpr size_t OFF_RO = 1002 * MiB;
constexpr size_t OFF_YB = 1035 * MiB;
constexpr size_t OFF_VTN = 1068 * MiB;
constexpr size_t OFF_VTW = 1077 * MiB;
constexpr size_t OFF_PB = 1080 * MiB;
constexpr size_t OFF_MREF = OFF_PB + 65536;
constexpr size_t OFF_SPT = 1081 * MiB;
constexpr size_t OFF_BON = 1114 * MiB;
constexpr size_t OFF_RO2 = 1115 * MiB;
constexpr size_t OFF_KTN = OFF_MODP;
constexpr size_t OFF_KTW = 1148 * MiB;
constexpr size_t WS_END = 1151 * MiB;
constexpr int RW_NCK = MT / 16;
constexpr size_t OFF_RWMG = OFF_G, RWMG_REC = 8192 + 2048;
constexpr size_t OFF_RWH = OFF_SCN, RWH_REC = 16384;
static_assert(16 * (size_t)RW_NCK * RWMG_REC <= 91 * MiB && 16 * (size_t)RW_NCK * RWH_REC <= 165 * MiB, "rwkv chunk records fit their regions");
constexpr int KSPLIT = 32;

constexpr int LDS_BYTES = 147456;
constexpr int RING_BYTES = 131072;
constexpr int MISC_OFF = RING_BYTES + 320;

__device__ __forceinline__ float bf2f(unsigned b) { return __uint_as_float(b << 16); }
__device__ __forceinline__ unsigned f2bf(float f) { unsigned u = __float_as_uint(f); return (u + 0x7fffu + ((u >> 16) & 1u)) >> 16; }
__device__ __forceinline__ unsigned pk2(float lo, float hi) { return f2bf(lo) | (f2bf(hi) << 16); }
__device__ __forceinline__ float wave_sum(float v) {
#pragma unroll
    for (int o = 1; o < 64; o <<= 1) v += __shfl_xor(v, o);
    return v;
}
__device__ __forceinline__ float wave_max(float v) {
#pragma unroll
    for (int o = 1; o < 64; o <<= 1) v = fmaxf(v, __shfl_xor(v, o));
    return v;
}
__device__ __forceinline__ float sigmoidf_(float x) { return 1.0f / (1.0f + expf(-x)); }
__device__ __forceinline__ float siluf_(float x) { return x / (1.0f + expf(-x)); }
typedef float f32x16 __attribute__((ext_vector_type(16)));
#define MFMA32(a, b, c) __builtin_amdgcn_mfma_f32_32x32x16_bf16((a), (b), (c), 0, 0, 0)
#define KOFF(reg) (((reg) & 3) + 8 * ((reg) >> 2))
#define MFMA16(a, b, c) __builtin_amdgcn_mfma_f32_16x16x32_bf16((a), (b), (c), 0, 0, 0)
#define LDS_WAIT() asm volatile("s_waitcnt lgkmcnt(0)" ::: "memory")

__device__ __forceinline__ int seq_row(int d, int j) { return d == 0 ? (j < CTX ? SEQ + j : j - CTX) : (MT - 1 - j); }
__device__ __forceinline__ int row_seq(int d, int r) { return d == 0 ? (r >= SEQ ? r - SEQ : r + CTX) : (MT - 1 - r); }

#define XB_TMO      128
#define XB_XCNT(j)  (256  + 64 * (j))
#define XB_XSUB(j)  (1280 + 64 * (j))
#define XB_XGEN(j)  (2304 + 64 * (j))
#define XB_TOP      3328
#define XB_TOPGEN   3392
#define XCD_BAR_WORDS 3456
#define XB_SPIN_CAP (1u << 18)
__device__ __forceinline__ unsigned xb_ld(unsigned* p)              { return __hip_atomic_load(p, __ATOMIC_RELAXED, __HIP_MEMORY_SCOPE_AGENT); }
__device__ __forceinline__ unsigned xb_add(unsigned* p, unsigned v) { return __hip_atomic_fetch_add(p, v, __ATOMIC_RELAXED, __HIP_MEMORY_SCOPE_AGENT); }
__device__ __forceinline__ unsigned xb_xcc_id() { return (unsigned)__builtin_amdgcn_s_getreg((3 << 11) | 20) & 0xFu; }
#define XB_SPIN(cond, bar) do { unsigned _sp = 0; while (cond) { __builtin_amdgcn_s_sleep(1); \
    if ((++_sp & 255u) == 0u) { if (xb_ld(&(bar)[XB_TMO])) break; if (_sp > XB_SPIN_CAP) { atomicAdd(&(bar)[XB_TMO], 1u); break; } } } } while (0)
struct XcdBarrier { unsigned* bar; unsigned x; volatile LAS unsigned* st; };
__device__ __forceinline__ XcdBarrier xcd_barrier_post(unsigned* bar, volatile LAS unsigned* st) {
    XcdBarrier b; b.bar = bar; b.x = xb_xcc_id(); b.st = st;
    if (threadIdx.x == 0) (void)xb_add(&bar[XB_XCNT(b.x)], 1u);
    return b;
}
__device__ __forceinline__ void xcd_barrier_complete(unsigned* bar, unsigned x, unsigned& nloc, unsigned& nx) {
    const unsigned G = gridDim.x * gridDim.y * gridDim.z;
    unsigned sum, cnt, mine, sp = 0u;
    for (;;) {
        sum = 0u; cnt = 0u; mine = 0u;
#pragma unroll
        for (unsigned j = 0; j < 16; ++j) { const unsigned c = xb_ld(&bar[XB_XCNT(j)]); sum += c; cnt += (c > 0u) ? 1u : 0u; mine = (j == x) ? c : mine; }
        if (sum == G) break;
        __builtin_amdgcn_s_sleep(1);
        if ((++sp & 255u) == 0u) { if (xb_ld(&bar[XB_TMO])) break; if (sp > XB_SPIN_CAP) { atomicAdd(&bar[XB_TMO], 1u); break; } }
    }
    nloc = mine > 0u ? mine : 1u; nx = cnt > 0u ? cnt : 1u;
}
__device__ __forceinline__ void xcd_barrier(const XcdBarrier& b) {
    asm volatile("s_waitcnt vmcnt(0)" ::: "memory");
    __syncthreads();
    if (threadIdx.x == 0) {
        unsigned* bar = b.bar;
        __builtin_amdgcn_s_waitcnt(0);
        unsigned nloc = b.st[0], nx = b.st[1];
        if (nloc == 0u) { xcd_barrier_complete(bar, b.x, nloc, nx); b.st[0] = nloc; b.st[1] = nx; }
        const unsigned old = xb_add(&bar[XB_XSUB(b.x)], 1u);
        const unsigned gen = old / nloc;
        if (old + 1u == (gen + 1u) * nloc) {
            __builtin_amdgcn_fence(__ATOMIC_RELEASE, "agent");
            asm volatile("s_waitcnt vmcnt(0)" ::: "memory");
            const unsigned og = xb_add(&bar[XB_TOP], 1u);
            const unsigned tg = og / nx;
            if (og + 1u == (tg + 1u) * nx) xb_add(&bar[XB_TOPGEN], 1u);
            else XB_SPIN(xb_ld(&bar[XB_TOPGEN]) == tg, bar);
            __builtin_amdgcn_fence(__ATOMIC_ACQUIRE, "agent");
            xb_add(&bar[XB_XGEN(b.x)], 1u);
            asm volatile("s_waitcnt vmcnt(0)" ::: "memory");
        } else {
            XB_SPIN(xb_ld(&bar[XB_XGEN(b.x)]) == gen, bar);
            __builtin_amdgcn_fence(__ATOMIC_ACQUIRE, "agent");
            asm volatile("s_waitcnt vmcnt(0)" ::: "memory");
        }
    }
    __syncthreads();
}

namespace pg8 {
constexpr int BM = 256, BK = 64, HALF = 128, HTB = HALF * BK * 2, STAGE_BYTES = 8 * HTB, NXCD = 8, WGM = 8;
__host__ __device__ __forceinline__ int lds_byte(int r, int c) { const int st = (r >> 4) * 2 + (c >> 5), rr = r & 15, cc = c & 31, ob = rr * 64 + cc * 2; return st * 1024 + (ob ^ (((ob >> 9) & 1) << 5)); }
__host__ __device__ __forceinline__ void stage_rc(int b, int& R, int& C) { const int st = b / 1024, sb = b % 1024, swz = sb ^ (((sb >> 9) & 1) << 5); R = (st >> 1) * 16 + swz / 64; C = (st & 1) * 32 + (swz % 64) / 2; }
__host__ __device__ __forceinline__ int perm32(int rho) { const int n = rho >> 4, i = rho & 15; return 8 * (i >> 2) + 4 * n + (i & 3); }
struct Unit { int pm, pn, ks; };
struct Gemm { const bf16_t* A; const bf16_t* Bt; int a_div; size_t a_gstride; };
struct StaticOrder {
    int nM, nN, nwg, G, c;
    __host__ __device__ void init(int M, int N, int G_, int c_) { nM = M / BM; nN = N / BM; nwg = nM * nN; G = G_; c = c_; }
    __host__ __device__ bool next(int i, Unit& u) const {
        const long L = (long)i * G + c; if (L >= nwg) return false;
        int wgid = (int)L; { const int q = nwg / NXCD, r = nwg % NXCD, xcd = wgid % NXCD, off = wgid / NXCD; wgid = (xcd < r ? xcd * (q + 1) : r * (q + 1) + (xcd - r) * q) + off; }
        const int nig = WGM * nN, gid = wgid / nig, fm = gid * WGM, gsz = (nM - fm) < WGM ? (nM - fm) : WGM;
        u.pm = fm + ((wgid % nig) % gsz); u.pn = (wgid % nig) / gsz; u.ks = 0; return true;
    }
};
struct SplitOrder {
    int pm, nN, KS, G, c;
    __host__ __device__ bool next(int i, Unit& u) const { const int L = i * G + c; if (L >= nN * KS) return false; u.pm = pm; u.pn = L / KS; u.ks = L % KS; return true; }
};
__device__ __forceinline__ unsigned cvt_pk_bf16(float lo, float hi) { unsigned r; asm volatile("v_cvt_pk_bf16_f32 %0, %1, %2" : "=v"(r) : "v"(lo), "v"(hi)); return r; }

template <class Epi, bool ALIGN_EPI, bool SP2, class Sched, int KE, int LDA, int LDB, int KSS>
__device__ __forceinline__ void gemm_phase(LAS unsigned char* lds, const Gemm g, const Sched& S, const Epi& E, const int tid) {
    const int wid = __builtin_amdgcn_readfirstlane(tid >> 6), lane = tid & 63, wr = wid >> 2, wc = wid & 3, fr = lane & 15, fq = lane >> 4;
    constexpr int nt = KE / BK;
    unsigned voffA[2], voffB[2];
#pragma unroll
    for (int i = 0; i < 2; ++i) { int R, C; stage_rc(tid * 16 + i * 8192, R, C); const int Rb = Epi::PERM ? ((R & ~31) + perm32(R & 31)) : R;
        voffA[i] = (unsigned)(R * LDA + C) * 2u; voffB[i] = (unsigned)(Rb * LDB + C) * 2u; }
    const size_t kstep = (size_t)(BK * 2);
    constexpr size_t hstepA = (size_t)HALF * LDA * 2, hstepB = (size_t)HALF * LDB * 2;
    const unsigned ldsw = (unsigned)wid * 1024u;
    const int aoff = lds_byte(wr * 64 + fr, fq * 8), boff = lds_byte(wc * 32 + fr, fq * 8);
#define PG8_SA(b, h) (((b) * 2 + (h)) * HTB)
#define PG8_SB(b, h) ((4 + (b) * 2 + (h)) * HTB)
#define PG8_STAGE(bufoff, gbase, voff) do { _Pragma("unroll") for (int _i = 0; _i < 2; ++_i) \
        __builtin_amdgcn_global_load_lds((const unsigned*)((const char*)(gbase) + (voff)[_i]), (LAS unsigned*)(lds + (bufoff) + ldsw + _i * 8192), 16, 0, 0); } while (0)
#define PG8_LDA(dst, b, h) do { _Pragma("unroll") for (int m = 0; m < 4; ++m) _Pragma("unroll") for (int k = 0; k < 2; ++k) dst[m][k] = *(const LAS bf16x8*)(lds + PG8_SA(b, h) + aoff + m * 2048 + k * 1024); } while (0)
#define PG8_LDB(dst, b, h) do { _Pragma("unroll") for (int n = 0; n < 2; ++n) _Pragma("unroll") for (int k = 0; k < 2; ++k) dst[n][k] = *(const LAS bf16x8*)(lds + PG8_SB(b, h) + boff + n * 2048 + k * 1024); } while (0)
#define PG8_MMA(ai, bj, At, Bt) do { __builtin_amdgcn_s_setprio(1); _Pragma("unroll") for (int m = 0; m < 4; ++m) _Pragma("unroll") for (int n = 0; n < 2; ++n) _Pragma("unroll") for (int k = 0; k < 2; ++k) \
        acc[ai][bj][m][n] = __builtin_amdgcn_mfma_f32_16x16x32_bf16(Bt[n][k], At[m][k], acc[ai][bj][m][n], 0, 0, 0); __builtin_amdgcn_s_setprio(0); } while (0)
#define PG8_WAIT_V(n) asm volatile("s_waitcnt vmcnt(" #n ")" ::: "memory")
#define PG8_WAIT_L(n) asm volatile("s_waitcnt lgkmcnt(" #n ")" ::: "memory")
#define PG8_BAR __builtin_amdgcn_s_barrier()
#define PG8_SCHED __builtin_amdgcn_sched_barrier(0)
#define PG8_ABASE(u) ((const char*)g.A + ((size_t)((u).pn / g.a_div) * g.a_gstride) * 2 + (size_t)(u).pm * 2 * hstepA + (size_t)(u).ks * KSS * 2)
#define PG8_BBASE(u) ((const char*)g.Bt + (size_t)(u).pn * 2 * hstepB + (size_t)(u).ks * KSS * 2)
    Unit cur, nxt; int ui = 0;
    if (!S.next(0, cur)) return;
    f32x4 acc[2][2][4][2];
#pragma unroll
    for (int a = 0; a < 2; ++a)
#pragma unroll
        for (int b = 0; b < 2; ++b)
#pragma unroll
            for (int m = 0; m < 4; ++m)
#pragma unroll
                for (int n = 0; n < 2; ++n) acc[a][b][m][n] = (f32x4){0.f, 0.f, 0.f, 0.f};
    bf16x8 At[4][2], B0[2][2], B1[2][2];
    const char* cA = PG8_ABASE(cur); const char* cB = PG8_BBASE(cur);
    if constexpr (SP2) {
        PG8_STAGE(PG8_SB(0, 0), cB, voffB); PG8_STAGE(PG8_SB(0, 1), cB + hstepB, voffB); PG8_STAGE(PG8_SA(0, 0), cA, voffA); PG8_STAGE(PG8_SA(0, 1), cA + hstepA, voffA);
        if (wr == 1) PG8_BAR;
        PG8_WAIT_V(2); PG8_BAR;
        PG8_STAGE(PG8_SB(1, 0), cB + kstep, voffB); PG8_STAGE(PG8_SA(1, 0), cA + kstep, voffA); PG8_STAGE(PG8_SB(1, 1), cB + hstepB + kstep, voffB);
        PG8_WAIT_V(6); PG8_BAR;
    } else {
        PG8_STAGE(PG8_SB(0, 0), cB, voffB); PG8_STAGE(PG8_SA(0, 0), cA, voffA); PG8_STAGE(PG8_SB(0, 1), cB + hstepB, voffB); PG8_STAGE(PG8_SA(0, 1), cA + hstepA, voffA);
        if (wr == 1) PG8_BAR;
        PG8_WAIT_V(4); PG8_BAR;
        PG8_STAGE(PG8_SB(1, 0), cB + kstep, voffB); PG8_STAGE(PG8_SA(1, 0), cA + kstep, voffA); PG8_STAGE(PG8_SB(1, 1), cB + hstepB + kstep, voffB);
        PG8_WAIT_V(6); PG8_BAR;
    }
    for (;;) {
        const bool has_next = S.next(ui + 1, nxt);
        const char* nA = has_next ? PG8_ABASE(nxt) : cA; const char* nB = has_next ? PG8_BBASE(nxt) : cB;
#pragma unroll 1
        for (int t = 0; t < nt; t += 2) {
            const bool last = (t == nt - 2);
            const char* a1 = cA + (size_t)(t + 1) * kstep;
            const char* a2 = last ? nA : cA + (size_t)(t + 2) * kstep; const char* b2 = last ? nB : cB + (size_t)(t + 2) * kstep;
            const char* a3 = a2 + kstep; const char* b3 = b2 + kstep;
            if constexpr (SP2) {
            PG8_LDB(B0, 0, 0); PG8_LDB(B1, 0, 1); PG8_SCHED; PG8_LDA(At, 0, 0); PG8_STAGE(PG8_SA(1, 1), a1 + hstepA, voffA);
            PG8_WAIT_V(8); PG8_WAIT_L(0); PG8_BAR; PG8_MMA(0, 0, At, B0); PG8_MMA(0, 1, At, B1); PG8_BAR; PG8_SCHED;
            PG8_LDA(At, 0, 1); PG8_STAGE(PG8_SB(0, 0), b2, voffB); PG8_STAGE(PG8_SB(0, 1), b2 + hstepB, voffB); PG8_STAGE(PG8_SA(0, 0), a2, voffA);
            PG8_WAIT_V(8); PG8_WAIT_L(0); PG8_BAR; PG8_MMA(1, 0, At, B0); PG8_MMA(1, 1, At, B1); PG8_BAR; PG8_SCHED;
            PG8_LDB(B0, 1, 0); PG8_LDB(B1, 1, 1); PG8_SCHED; PG8_LDA(At, 1, 0); PG8_STAGE(PG8_SA(0, 1), a2 + hstepA, voffA);
            PG8_WAIT_V(8); PG8_WAIT_L(0); PG8_BAR; PG8_MMA(0, 0, At, B0); PG8_MMA(0, 1, At, B1); PG8_BAR; PG8_SCHED;
            PG8_LDA(At, 1, 1); PG8_STAGE(PG8_SB(1, 0), b3, voffB); PG8_STAGE(PG8_SB(1, 1), b3 + hstepB, voffB); PG8_STAGE(PG8_SA(1, 0), a3, voffA);
            PG8_WAIT_V(8); PG8_WAIT_L(0); PG8_BAR; PG8_MMA(1, 0, At, B0); PG8_MMA(1, 1, At, B1); PG8_BAR; PG8_SCHED;
            } else {
            PG8_LDB(B0, 0, 0); PG8_SCHED; PG8_LDA(At, 0, 0); PG8_STAGE(PG8_SA(1, 1), a1 + hstepA, voffA);
            PG8_WAIT_L(8); PG8_BAR; PG8_WAIT_L(0); PG8_MMA(0, 0, At, B0); PG8_BAR; PG8_SCHED;
            PG8_LDB(B1, 0, 1); PG8_STAGE(PG8_SB(0, 0), b2, voffB);
            PG8_BAR; PG8_WAIT_L(0); PG8_MMA(0, 1, At, B1); PG8_BAR;
            PG8_LDA(At, 0, 1); PG8_STAGE(PG8_SA(0, 0), a2, voffA);
            PG8_BAR; PG8_WAIT_L(0); PG8_MMA(1, 0, At, B0); PG8_BAR; PG8_SCHED;
            PG8_STAGE(PG8_SB(0, 1), b2 + hstepB, voffB);
            PG8_WAIT_V(6); PG8_BAR; PG8_MMA(1, 1, At, B1); PG8_BAR;
            PG8_LDB(B0, 1, 0); PG8_SCHED; PG8_LDA(At, 1, 0); PG8_STAGE(PG8_SA(0, 1), a2 + hstepA, voffA);
            PG8_WAIT_L(8); PG8_BAR; PG8_WAIT_L(0); PG8_MMA(0, 0, At, B0); PG8_BAR; PG8_SCHED;
            PG8_LDB(B1, 1, 1); PG8_STAGE(PG8_SB(1, 0), b3, voffB);
            PG8_BAR; PG8_WAIT_L(0); PG8_MMA(0, 1, At, B1); PG8_BAR;
            PG8_LDA(At, 1, 1); PG8_STAGE(PG8_SA(1, 0), a3, voffA);
            PG8_BAR; PG8_WAIT_L(0); PG8_MMA(1, 0, At, B0); PG8_BAR; PG8_SCHED;
            PG8_STAGE(PG8_SB(1, 1), b3 + hstepB, voffB);
            PG8_WAIT_V(6); PG8_BAR; PG8_MMA(1, 1, At, B1); PG8_BAR;
            }
        }
        if constexpr (ALIGN_EPI) { if (wr == 0) PG8_BAR; }
        { int fr2 = fr, fq2 = fq; asm volatile("" : "+v"(fr2), "+v"(fq2));
          E(acc, cur, wr, wc, fr2, fq2); }
        if (!has_next) break;
#pragma unroll
        for (int a = 0; a < 2; ++a)
#pragma unroll
            for (int b = 0; b < 2; ++b)
#pragma unroll
                for (int m = 0; m < 4; ++m)
#pragma unroll
                    for (int n = 0; n < 2; ++n) acc[a][b][m][n] = (f32x4){0.f, 0.f, 0.f, 0.f};
        cur = nxt; cA = nA; cB = nB; ++ui;
        if constexpr (ALIGN_EPI) { if (wr == 1) PG8_BAR; }
    }
    PG8_WAIT_V(0);
    if constexpr (!ALIGN_EPI) { if (wr == 0) PG8_BAR; }
    PG8_BAR;
#undef PG8_SA
#undef PG8_SB
#undef PG8_STAGE
#undef PG8_LDA
#undef PG8_LDB
#undef PG8_MMA
#undef PG8_WAIT_V
#undef PG8_WAIT_L
#undef PG8_BAR
#undef PG8_SCHED
#undef PG8_ABASE
#undef PG8_BBASE
}

struct EpiSwiGLU {
    static constexpr bool PERM = true;
    bf16_t* O;
    __device__ __forceinline__ void operator()(const f32x4 (&acc)[2][2][4][2], const Unit& u, int wr, int wc, int fr, int fq) const {
        const int row0 = u.pm * BM + wr * 64 + fr, col0 = u.pn * HALF + wc * 32 + 8 * fq;
#pragma unroll
        for (int ai = 0; ai < 2; ++ai)
#pragma unroll
            for (int m = 0; m < 4; ++m) {
                bf16_t* rowp = O + (size_t)(row0 + ai * HALF + m * 16) * DFF + col0;
                float o[8];
#pragma unroll
                for (int n = 0; n < 2; ++n)
#pragma unroll
                    for (int j = 0; j < 4; ++j) { const float a = acc[ai][0][m][n][j], b = acc[ai][1][m][n][j]; o[n * 4 + j] = a / (1.0f + __expf(-a)) * b; }
                u32x4 w; w.x = cvt_pk_bf16(o[0], o[1]); w.y = cvt_pk_bf16(o[2], o[3]); w.z = cvt_pk_bf16(o[4], o[5]); w.w = cvt_pk_bf16(o[6], o[7]);
                *(u32x4*)rowp = w;
            }
    }
};
template <bool HALFGATE> struct EpiResid {
    static constexpr bool PERM = false;
    float* X; const float* gate_lat; const float* gate_ctx; float* out;
    __device__ __forceinline__ void operator()(const f32x4 (&acc)[2][2][4][2], const Unit& u, int wr, int wc, int fr, int fq) const {
        const int row0 = u.pm * BM + wr * 64 + fr, col0 = u.pn * BM + wc * 32 + 4 * fq;
        const float* gp = (u.pm * BM >= SEQ) ? gate_ctx : gate_lat;
#pragma unroll
        for (int bj = 0; bj < 2; ++bj)
#pragma unroll
            for (int n = 0; n < 2; ++n) {
                const f32x4 gv = *(const f32x4*)(gp + col0 + bj * HALF + n * 16) * (HALFGATE ? 0.5f : 1.0f);
#pragma unroll
                for (int ai = 0; ai < 2; ++ai)
#pragma unroll
                    for (int m = 0; m < 4; ++m) {
                        const int row = row0 + ai * HALF + m * 16;
                        float* p = X + (size_t)row * D + col0 + bj * HALF + n * 16;
                        const f32x4 v = *(const f32x4*)p + gv * acc[ai][bj][m][n];
                        *(f32x4*)p = v;
                        if (out != nullptr && row < SEQ) *(f32x4*)(out + (size_t)row * D + col0 + bj * HALF + n * 16) = v;
                    }
            }
    }
};
template <bool HALFGATE> struct EpiPart {
    static constexpr bool PERM = false;
    float* PART; const float* gate_ctx;
    __device__ __forceinline__ void operator()(const f32x4 (&acc)[2][2][4][2], const Unit& u, int wr, int wc, int fr, int fq) const {
        const int row0 = wr * 64 + fr, col0 = u.pn * BM + wc * 32 + 4 * fq;
        f32x4 gv[2][2];
#pragma unroll
        for (int bj = 0; bj < 2; ++bj)
#pragma unroll
            for (int n = 0; n < 2; ++n) gv[bj][n] = *(const f32x4*)(gate_ctx + col0 + bj * HALF + n * 16) * (HALFGATE ? 0.5f : 1.0f);
#pragma unroll
        for (int ai = 0; ai < 2; ++ai)
#pragma unroll
            for (int m = 0; m < 4; ++m) {
                float* rowp = PART + ((size_t)u.ks * BM + row0 + ai * HALF + m * 16) * D + col0;
#pragma unroll
                for (int bj = 0; bj < 2; ++bj)
#pragma unroll
                    for (int n = 0; n < 2; ++n) *(f32x4*)(rowp + bj * HALF + n * 16) = gv[bj][n] * acc[ai][bj][m][n];
            }
    }
};
struct EpiWin {
    static constexpr bool PERM = true;
    float* P32; bf16_t* PA; bf16_t* GL; long pn_off;
    __device__ __forceinline__ void operator()(const f32x4 (&acc)[2][2][4][2], const Unit& u0, int wr, int wc, int fr, int fq) const {
        Unit u; u.pm = u0.pm; u.pn = u0.pn + (int)pn_off;
        const int row0 = u.pm * BM + wr * 64 + fr, cin = wc * 32 + 8 * fq;
        if (u.pn < 19) {
#pragma unroll
            for (int ai = 0; ai < 2; ++ai)
#pragma unroll
                for (int m = 0; m < 4; ++m) { float* rowp = P32 + (size_t)(row0 + ai * HALF + m * 16) * P32W + u.pn * BM + cin;
#pragma unroll
                    for (int bj = 0; bj < 2; ++bj) { *(f32x4*)(rowp + bj * HALF) = acc[ai][bj][m][0]; *(f32x4*)(rowp + bj * HALF + 4) = acc[ai][bj][m][1]; } }
        } else {
            bf16_t* base; int ld, colt;
            if (u.pn < 28) { base = PA; ld = PAW; colt = (u.pn - 19) * BM; } else { base = GL; ld = GLW; colt = (u.pn - 28) * BM; }
#pragma unroll
            for (int ai = 0; ai < 2; ++ai)
#pragma unroll
                for (int m = 0; m < 4; ++m) { bf16_t* rowp = base + (size_t)(row0 + ai * HALF + m * 16) * ld + colt + cin;
#pragma unroll
                    for (int bj = 0; bj < 2; ++bj) { const f32x4 v0 = acc[ai][bj][m][0], v1 = acc[ai][bj][m][1];
                        u32x4 w; w.x = cvt_pk_bf16(v0[0], v0[1]); w.y = cvt_pk_bf16(v0[2], v0[3]); w.z = cvt_pk_bf16(v1[0], v1[1]); w.w = cvt_pk_bf16(v1[2], v1[3]);
                        *(u32x4*)(rowp + bj * HALF) = w; } }
        }
    }
};
struct EpiMerge {
    static constexpr bool PERM = true;
    const bf16_t* GL; bf16_t* PROJ;
    __device__ __forceinline__ void operator()(const f32x4 (&acc)[2][2][4][2], const Unit& u, int wr, int wc, int fr, int fq) const {
        const int row0 = u.pm * BM + wr * 64 + fr, col0 = u.pn * BM + wc * 32 + 8 * fq;
#pragma unroll
        for (int ai = 0; ai < 2; ++ai)
#pragma unroll
            for (int m = 0; m < 4; ++m) { const size_t ro = (size_t)(row0 + ai * HALF + m * 16) * GLW + col0;
#pragma unroll
                for (int bj = 0; bj < 2; ++bj) {
                    const u32x4 gw = *(const u32x4*)(GL + ro + bj * HALF);
                    const f32x4 v0 = acc[ai][bj][m][0], v1 = acc[ai][bj][m][1];
                    float o[8];
                    o[0] = v0[0] / (1.0f + __expf(-bf2f(gw.x & 0xffffu))); o[1] = v0[1] / (1.0f + __expf(-bf2f(gw.x >> 16)));
                    o[2] = v0[2] / (1.0f + __expf(-bf2f(gw.y & 0xffffu))); o[3] = v0[3] / (1.0f + __expf(-bf2f(gw.y >> 16)));
                    o[4] = v1[0] / (1.0f + __expf(-bf2f(gw.z & 0xffffu))); o[5] = v1[1] / (1.0f + __expf(-bf2f(gw.z >> 16)));
                    o[6] = v1[2] / (1.0f + __expf(-bf2f(gw.w & 0xffffu))); o[7] = v1[3] / (1.0f + __expf(-bf2f(gw.w >> 16)));
                    u32x4 w; w.x = cvt_pk_bf16(o[0], o[1]); w.y = cvt_pk_bf16(o[2], o[3]); w.z = cvt_pk_bf16(o[4], o[5]); w.w = cvt_pk_bf16(o[6], o[7]);
                    *(u32x4*)(PROJ + ro + bj * HALF) = w; } }
    }
};
}

enum { I_X = 0, I_C, I_CTX, I_CCTX, I_ADAW, I_ADAB, I_NF1, I_NMIX, I_NF2, I_F1WI, I_F1WO, I_F2WI, I_F2WO, I_WIN, I_HGLB, I_HGNORM, I_RWSHIFT, I_RWW0, I_RWW2, I_RWA0, I_RWA2,
       I_RWKK, I_RWKA, I_RWRK, I_RWLNW, I_RWLNB, I_NAQN, I_NAKN, I_NARPB, I_WAQN, I_WAKN, I_WASINK, I_WBR, I_WOUT, N_IN };
struct Args { const float* in[N_IN]; float* out; unsigned char* ws; int ph_lo, ph_hi; };
struct Ctx {
    LAS unsigned char* lds;
    int tid, lane, wave, bid, G;
    const Args __attribute__((address_space(4)))* ka; float* out; unsigned char* ws;
};
#define WSP(T, off) ((T*)(C.ws + (off)))
__device__ __forceinline__ void relaunder(Ctx& C) {
    int t = C.tid, b = C.bid, g = C.G;
    asm volatile("" : "+v"(t), "+v"(b), "+v"(g));
    C.tid = t; C.lane = t & 63; C.wave = __builtin_amdgcn_readfirstlane(t >> 6); C.bid = __builtin_amdgcn_readfirstlane(b); C.G = __builtin_amdgcn_readfirstlane(g);
}

__device__ __forceinline__ void transpose_item(const float* W, int K, int N, bf16_t* WT, int mode, LAS float* scr, int item, int lane) {
    const int nblk = N / 32, kb = item / nblk, nb = item % nblk, k0 = 64 * kb, n0 = 32 * nb;
    int drow0 = n0;
    if (mode == 1) { const int half = n0 / DFF, j0 = n0 % DFF; drow0 = 256 * (j0 / 128) + 128 * half + (j0 % 128); }
#pragma unroll 8
    for (int i = 0; i < 32; ++i) { const int kk = 2 * i + (lane >> 5); scr[kk * 33 + (lane & 31)] = W[(size_t)(k0 + kk) * N + n0 + (lane & 31)]; }
    LDS_WAIT(); asm volatile("" ::: "memory");
    const int c = lane & 7;
#pragma unroll
    for (int j = 0; j < 4; ++j) { const int n = (lane >> 3) + 8 * j; const LAS float* s = scr + (8 * c) * 33 + n;
        u32x4 o; o.x = pk2(s[0 * 33], s[1 * 33]); o.y = pk2(s[2 * 33], s[3 * 33]); o.z = pk2(s[4 * 33], s[5 * 33]); o.w = pk2(s[6 * 33], s[7 * 33]);
        *(u32x4*)(WT + (size_t)(drow0 + n) * K + k0 + 8 * c) = o; }
    LDS_WAIT(); asm volatile("" ::: "memory");
}
__device__ __forceinline__ void phase_convert(Ctx& C, int l) {
    LAS float* scr = (LAS float*)(C.lds + C.wave * 16384);
    const int gw = C.bid * NWAVES + C.wave, NGW = C.G * NWAVES;
    constexpr int I_WI = (D / 64) * (2 * DFF / 32), I_WO = (DFF / 64) * (D / 32), I_IN = (D / 64) * (PTOT / 32), I_BR = (512 / 64) * (D / 32), I_OUT = (D / 64) * (D / 32);
    constexpr int NITEMS = 2 * I_WI + 2 * I_WO + I_IN + 4 * I_BR + I_OUT;
    for (int it = gw; it < NITEMS; it += NGW) {
        int r = it;
        if (r < I_WI) { transpose_item(C.ka->in[I_F1WI] + (size_t)l * D * 2 * DFF, D, 2 * DFF, WSP(bf16_t, OFF_WI1), 1, scr, r, C.lane); continue; } r -= I_WI;
        if (r < I_WI) { transpose_item(C.ka->in[I_F2WI] + (size_t)l * D * 2 * DFF, D, 2 * DFF, WSP(bf16_t, OFF_WI2), 1, scr, r, C.lane); continue; } r -= I_WI;
        if (r < I_WO) { transpose_item(C.ka->in[I_F1WO] + (size_t)l * DFF * D, DFF, D, WSP(bf16_t, OFF_WO1), 0, scr, r, C.lane); continue; } r -= I_WO;
        if (r < I_WO) { transpose_item(C.ka->in[I_F2WO] + (size_t)l * DFF * D, DFF, D, WSP(bf16_t, OFF_WO2), 0, scr, r, C.lane); continue; } r -= I_WO;
        if (r < I_IN) { transpose_item(C.ka->in[I_WIN] + (size_t)l * D * PTOT, D, PTOT, WSP(bf16_t, OFF_WIN), 0, scr, r, C.lane); continue; } r -= I_IN;
        if (r < 4 * I_BR) { const int g = r / I_BR; transpose_item(C.ka->in[I_WBR] + ((size_t)l * 4 + g) * 512 * D, 512, D, WSP(bf16_t, OFF_WBR) + (size_t)g * D * 512, 0, scr, r % I_BR, C.lane); continue; } r -= 4 * I_BR;
        transpose_item(C.ka->in[I_WOUT] + (size_t)l * D * D, D, D, WSP(bf16_t, OFF_WOUT), 0, scr, r, C.lane);
    }
    bf16_t* W2T = WSP(bf16_t, OFF_W2T);
    for (int idx = C.bid * NT + C.tid; idx < 2 * 2 * 512 * 8; idx += C.G * NT) {
        const int k8 = idx & 7, col = (idx >> 3) & 511, m = (idx >> 12) & 1, d = idx >> 13;
        const float* src = (m == 0 ? C.ka->in[I_RWW2] : C.ka->in[I_RWA2]) + ((size_t)(l * 2 + d) * 64 + 8 * k8) * 512 + col;
        u32x4 w; w.x = pk2(src[0], src[512]); w.y = pk2(src[1024], src[1536]); w.z = pk2(src[2048], src[2560]); w.w = pk2(src[3072], src[3584]);
        *(u32x4*)(W2T + ((size_t)((d * 2 + m) * 512 + col) * 64 + 8 * k8)) = w;
    }
}

__device__ __forceinline__ void phase_ada_partial(Ctx& C) {
    float* modp = WSP(float, OFF_MODP);
    for (int u = C.bid; u < DEPTH * 9 * KSPLIT; u += C.G) {
        const int l = u / (9 * KSPLIT), rem = u % (9 * KSPLIT), cg = rem / KSPLIT, ks = rem % KSPLIT;
        const int col = cg * 2048 + C.tid * 4;
        const float* W = C.ka->in[I_ADAW] + (size_t)l * D * MODW;
        f32x4 a0 = {0.f, 0.f, 0.f, 0.f}, a1 = {0.f, 0.f, 0.f, 0.f};
#pragma unroll 16
        for (int i = ks * 64; i < ks * 64 + 64; ++i) {
            const float c0 = C.ka->in[I_C][i], c1 = C.ka->in[I_CCTX][i];
            const float s0 = siluf_(c0), s1 = siluf_(c1);
            const f32x4 w = *(const f32x4*)(W + (size_t)i * MODW + col);
            a0 += w * s0; a1 += w * s1;
        }
        *(f32x4*)(modp + ((size_t)(l * KSPLIT + ks) * 2 + 0) * MODW + col) = a0;
        *(f32x4*)(modp + ((size_t)(l * KSPLIT + ks) * 2 + 1) * MODW + col) = a1;
    }
    f32x4* X = WSP(f32x4, OFF_X);
    const f32x4* xs = (const f32x4*)C.ka->in[I_X]; const f32x4* cs = (const f32x4*)C.ka->in[I_CTX];
    const size_t n_lat = (size_t)SEQ * D / 4, n_all = (size_t)MT * D / 4;
    for (size_t i = (size_t)C.bid * NT + C.tid; i < n_all; i += (size_t)C.G * NT) X[i] = i < n_lat ? xs[i] : cs[i - n_lat];
}
__device__ __forceinline__ void phase_ada_reduce(Ctx& C) {
    const float* modp = WSP(float, OFF_MODP); float* mod = WSP(float, OFF_MOD);
    for (int e = C.bid * NT + C.tid; e < DEPTH * 2 * MODW; e += C.G * NT) {
        const int l = e / (2 * MODW), s = (e / MODW) % 2, j = e % MODW;
        float a = C.ka->in[I_ADAB][(size_t)l * MODW + j];
        for (int ks = 0; ks < KSPLIT; ++ks) a += modp[((size_t)(l * KSPLIT + ks) * 2 + s) * MODW + j];
        mod[e] = a;
    }
}
__device__ __forceinline__ const float* mod_ptr(Ctx& C, int l, int s, int idx) { return WSP(float, OFF_MOD) + ((size_t)(l * 2 + s) * NMOD + idx) * D; }

__device__ __forceinline__ void phase_norm(Ctx& C, int l, const float* gw  , int shift_idx, int nparts) {
    const int gwv = C.bid * NWAVES + C.wave, NGW = C.G * NWAVES;
    float* X = WSP(float, OFF_X); bf16_t* H = WSP(bf16_t, OFF_H); const float* PART = WSP(float, OFF_P32);
    for (int r = gwv; r < MT; r += NGW) {
        const int s = r >= SEQ ? 1 : 0;
        const float* sh = mod_ptr(C, l, s, shift_idx); const float* sc = mod_ptr(C, l, s, shift_idx + 1);
        f32x4* xr = (f32x4*)(X + (size_t)r * D) + C.lane;
        f32x4 v[8]; float ss = 0.f;
#pragma unroll
        for (int j = 0; j < 8; ++j) v[j] = xr[64 * j];
        if (s == 1 && nparts > 0) {
            for (int ks = 0; ks < nparts; ++ks) {
                const f32x4* pr = (const f32x4*)(PART + ((size_t)ks * 256 + (r - SEQ)) * D) + C.lane;
#pragma unroll
                for (int j = 0; j < 8; ++j) v[j] += pr[64 * j];
            }
#pragma unroll
            for (int j = 0; j < 8; ++j) xr[64 * j] = v[j];
        }
#pragma unroll
        for (int j = 0; j < 8; ++j) ss += (v[j].x * v[j].x + v[j].y * v[j].y) + (v[j].z * v[j].z + v[j].w * v[j].w);
        const float rstd = rsqrtf(wave_sum(ss) * (1.0f / D) + EPS);
        u32x2* o8 = (u32x2*)(H + (size_t)r * D) + C.lane;
#pragma unroll
        for (int j = 0; j < 8; ++j) {
            const int c = (64 * j + C.lane) * 4;
            const f32x4 g4 = *(const f32x4*)(gw + c), s4 = *(const f32x4*)(sc + c), h4 = *(const f32x4*)(sh + c);
            const f32x4 y = (v[j] * rstd) * g4 * (s4 + 1.0f) + h4;
            u32x2 w; w.x = pk2(y.x, y.y); w.y = pk2(y.z, y.w); o8[64 * j] = w;
        }
    }
}

__device__ __forceinline__ float xrow_sum(float x) {
    auto s = __builtin_amdgcn_permlane16_swap(__float_as_uint(x), __float_as_uint(x), false, false);
    x = __uint_as_float(s[0]) + __uint_as_float(s[1]);
    auto t = __builtin_amdgcn_permlane32_swap(__float_as_uint(x), __float_as_uint(x), false, false);
    return __uint_as_float(t[0]) + __uint_as_float(t[1]);
}
template <int CTRL> __device__ __forceinline__ float dppf(float x) { return __builtin_bit_cast(float, __builtin_amdgcn_mov_dpp(__builtin_bit_cast(int, x), CTRL, 0xf, 0xf, true)); }
__device__ __forceinline__ float row16_sum(float x) { x += dppf<0xB1>(x); x += dppf<0x4E>(x); x += dppf<0x124>(x); x += dppf<0x128>(x); return x; }
__device__ __forceinline__ float wave_sum_fast(float x) { return xrow_sum(row16_sum(x)); }
#define WAVE_LDS_FENCE() asm volatile("s_waitcnt lgkmcnt(0)" ::: "memory")
__device__ __forceinline__ void phase_rw_prep(Ctx& C, int l, int b0, int nb) {
    constexpr int TB = 16;
    const float* P = WSP(float, OFF_P32); float* VV = WSP(float, OFF_VV); float* GS = WSP(float, OFF_GS); float* RO = WSP(float, OFF_RO); float* BON = WSP(float, OFF_BON);
    LAS float* lin = (LAS float*)C.lds;
    LAS unsigned char* wl = C.lds + 16384 + C.wave * 14592;
    LAS unsigned char* RA = wl; LAS float* MAT = (LAS float*)(wl + 10496);
    const float* taps = C.ka->in[I_RWSHIFT] + (size_t)l * 3 * RWC;
    const int c = C.tid, h = c >> 6, e = c & 63, lane = C.lane;
    const float kkw = C.ka->in[I_RWKK][l * 512 + c], kaw = C.ka->in[I_RWKA][l * 512 + c], rkw = C.ka->in[I_RWRK][l * 512 + c];
    for (int unit = b0; unit < 2 * RW_NCK; unit += nb) {
        const int grp = unit >> 1, d = unit & 1;
        const int r0 = grp * TB;
        const bool hp0 = (r0 != 0 && r0 != SEQ), hnl = (r0 + TB != SEQ && r0 + TB != MT);
        __syncthreads();
        { int c_ = C.tid; asm volatile("" : "+v"(c_)); const int c = c_;
        if (c < 128) {
            const int col = 2048 + (c < 64 ? d * 64 + c : 128 + d * 64 + (c - 64));
            const float t0 = taps[col], t1 = taps[RWC + col], t2 = taps[2 * RWC + col];
            const float* pc = P + (size_t)r0 * P32W + RW_OFF + col;
            float prev = hp0 ? pc[-(long)P32W] : 0.f, cur = pc[0];
#pragma unroll
            for (int t = 0; t < TB; ++t) {
                const float nxt = (t + 1 < TB || hnl) ? pc[(size_t)(t + 1) * P32W] : 0.f;
                const float v = t0 * prev + t1 * cur + t2 * nxt;
                *(LAS bf16_t*)((LAS unsigned char*)lin + ((c >> 6) * 16 + t) * 144 + 2 * (c & 63)) = (bf16_t)f2bf(c < 64 ? 1.0f - 2.0f * __builtin_amdgcn_rcpf(1.0f + __expf(2.0f * v)) : v);
                prev = cur; cur = nxt;
            }
        }
        if (d == 0) {
            const int col = 3 * 512 + c;
            const float t0 = taps[col], t1 = taps[RWC + col], t2 = taps[2 * RWC + col];
            const float* pc = P + (size_t)r0 * P32W + RW_OFF + col;
            float prev = hp0 ? pc[-(long)P32W] : 0.f, cur = pc[0];
#pragma unroll
            for (int t = 0; t < TB; ++t) {
                const float nxt = (t + 1 < TB || hnl) ? pc[(size_t)(t + 1) * P32W] : 0.f;
                const float v = t0 * prev + t1 * cur + t2 * nxt;
                GS[(size_t)(r0 + t) * 512 + c] = __builtin_amdgcn_rcpf(1.0f + __expf(-v));
                prev = cur; cur = nxt;
            }
        }
        }
        __syncthreads();
        {
            int ln_ = C.lane; asm volatile("" : "+v"(ln_));
            const int lane = ln_, e = ln_, c = h * 64 + ln_;
            float xr[TB], xk[TB], xv[TB], kkn[TB];
#pragma unroll
            for (int q = 0; q < 3; ++q) {
                const int col = q * 512 + c;
                const float t0 = taps[col], t1 = taps[RWC + col], t2 = taps[2 * RWC + col];
                const float* pc = P + (size_t)r0 * P32W + RW_OFF + col;
                float prev = hp0 ? pc[-(long)P32W] : 0.f, cur = pc[0];
#pragma unroll
                for (int t = 0; t < TB; ++t) {
                    const float nxt = (t + 1 < TB || hnl) ? pc[(size_t)(t + 1) * P32W] : 0.f;
                    const float v = t0 * prev + t1 * cur + t2 * nxt;
                    if (q == 0) xr[t] = v; else if (q == 1) xk[t] = v; else { xv[t] = v; if (d == 0) VV[(size_t)(r0 + t) * 512 + c] = v; }
                    prev = cur; cur = nxt;
                }
            }
#pragma unroll
            for (int t = 0; t < TB; ++t) { const float kk0 = xk[t] * kkw; kkn[t] = kk0 * rsqrtf(wave_sum_fast(kk0 * kk0) + EPS); }
            __builtin_amdgcn_sched_barrier(0);
            float At[TB], Rt[TB], Vs[TB];
            unsigned Btp[TB / 2], Ktp[TB / 2];
            float gam;
            {
                float z[TB], az[TB];
                {
                    const bf16_t* W2T = WSP(bf16_t, OFF_W2T);
                    LAS float* ZB = (LAS float*)RA;
                    const int tl = lane & 15, q4 = lane >> 4;
#pragma unroll
                    for (int m = 0; m < 2; ++m) {
                        bf16x8 af[2];
#pragma unroll
                        for (int s2 = 0; s2 < 2; ++s2) af[s2] = *(const LAS bf16x8*)((LAS unsigned char*)lin + (m * 16 + tl) * 144 + s2 * 64 + q4 * 16);
#pragma unroll
                        for (int nt4 = 0; nt4 < 4; ++nt4) {
                            const bf16_t* bp = W2T + ((size_t)((d * 2 + m) * 512 + h * 64 + 16 * nt4 + tl) * 64 + 8 * q4);
                            f32x4 a4 = {0.f, 0.f, 0.f, 0.f};
#pragma unroll
                            for (int s2 = 0; s2 < 2; ++s2) a4 = MFMA16(af[s2], *(const bf16x8*)(bp + 32 * s2), a4);
#pragma unroll
                            for (int reg = 0; reg < 4; ++reg) ZB[(m * 16 + 4 * q4 + reg) * 64 + 16 * nt4 + tl] = a4[reg];
                        }
                    }
                    WAVE_LDS_FENCE();
                    const float zb = C.ka->in[I_RWW0][(l * 2 + d) * 512 + c], ab = C.ka->in[I_RWA0][(l * 2 + d) * 512 + c];
#pragma unroll
                    for (int t = 0; t < TB; ++t) { z[t] = zb + ZB[t * 64 + e]; az[t] = ab + ZB[(16 + t) * 64 + e]; }
                    WAVE_LDS_FENCE();
                }
                float g = 1.0f, btp = 0.f, ktp = 0.f;
#pragma unroll
                for (int i = 0; i < TB; ++i) {
                    const int t = d ? TB - 1 - i : i;
                    const float y = -z[t]; const float sp = fmaxf(y, 0.f) + __logf(1.0f + __expf(-fabsf(y)));
                    const float decay = __expf(-__expf(-sp - 0.5f));
                    const float a = __builtin_amdgcn_rcpf(1.0f + __expf(-az[t]));
                    const float kd = xk[t] * (1.0f + (a - 1.0f) * kaw);
                    { const float bsum = wave_sum_fast(xr[t] * kd * rkw);
                      if (lane == 0) BON[((size_t)d * MT + r0 + t) * 8 + h] = bsum; }
                    const float gm1 = g; g *= decay; const float ig = __builtin_amdgcn_rcpf(g);
                    const float at = -kkn[t] * gm1, bt = a * kkn[t] * ig, kt = kd * ig, rt = xr[t] * g;
                    At[i] = at; Rt[i] = rt; Vs[i] = xv[t];
                    *(LAS bf16_t*)(RA + 0 * 2304 + i * 144 + 2 * e) = (bf16_t)pg8::cvt_pk_bf16(at, at); *(LAS bf16_t*)(RA + 1 * 2304 + i * 144 + 2 * e) = (bf16_t)pg8::cvt_pk_bf16(bt, bt);
                    *(LAS bf16_t*)(RA + 2 * 2304 + i * 144 + 2 * e) = (bf16_t)pg8::cvt_pk_bf16(kt, kt); *(LAS bf16_t*)(RA + 3 * 2304 + i * 144 + 2 * e) = (bf16_t)pg8::cvt_pk_bf16(rt, rt);
                    if (i & 1) { Btp[i >> 1] = pg8::cvt_pk_bf16(btp, bt); Ktp[i >> 1] = pg8::cvt_pk_bf16(ktp, kt); } else { btp = bt; ktp = kt; }
                }
                gam = g;
            }
            __builtin_amdgcn_sched_barrier(0);
            WAVE_LDS_FENCE();
            {
                const int jl = lane & 15, q = lane >> 4;
                bf16x8 fa[2], fb[2], fk[2], fr[2];
#pragma unroll
                for (int s2 = 0; s2 < 2; ++s2) {
                    fa[s2] = *(const LAS bf16x8*)(RA + 0 * 2304 + jl * 144 + s2 * 64 + q * 16); fb[s2] = *(const LAS bf16x8*)(RA + 1 * 2304 + jl * 144 + s2 * 64 + q * 16);
                    fk[s2] = *(const LAS bf16x8*)(RA + 2 * 2304 + jl * 144 + s2 * 64 + q * 16); fr[s2] = *(const LAS bf16x8*)(RA + 3 * 2304 + jl * 144 + s2 * 64 + q * 16);
                }
                f32x4 gAL = {0.f, 0.f, 0.f, 0.f}, gBL = gAL, gP = gAL, gQ = gAL;
#pragma unroll
                for (int s2 = 0; s2 < 2; ++s2) { gAL = MFMA16(fa[s2], fb[s2], gAL); gBL = MFMA16(fa[s2], fk[s2], gBL); gP = MFMA16(fr[s2], fb[s2], gP); gQ = MFMA16(fr[s2], fk[s2], gQ); }
#pragma unroll
                for (int reg = 0; reg < 4; ++reg) { const int i = 4 * q + reg;
                    MAT[0 * 256 + i * 16 + jl] = jl < i ? gAL[reg] : 0.f; MAT[1 * 256 + i * 16 + jl] = jl < i ? gBL[reg] : 0.f;
                    MAT[2 * 256 + i * 16 + jl] = jl <= i ? gP[reg] : 0.f; MAT[3 * 256 + i * 16 + jl] = jl <= i ? gQ[reg] : 0.f; }
            }
            WAVE_LDS_FENCE();
            __builtin_amdgcn_sched_barrier(0);
            {
                u32x4 w0, w1;
                w0.x = Btp[0]; w0.y = Btp[1]; w0.z = Btp[2]; w0.w = Btp[3]; w1.x = Btp[4]; w1.y = Btp[5]; w1.z = Btp[6]; w1.w = Btp[7];
                *(LAS u32x4*)(RA + 0 * 2048 + e * 32) = w0; *(LAS u32x4*)(RA + 0 * 2048 + e * 32 + 16) = w1;
                w0.x = Ktp[0]; w0.y = Ktp[1]; w0.z = Ktp[2]; w0.w = Ktp[3]; w1.x = Ktp[4]; w1.y = Ktp[5]; w1.z = Ktp[6]; w1.w = Ktp[7];
                *(LAS u32x4*)(RA + 1 * 2048 + e * 32) = w0; *(LAS u32x4*)(RA + 1 * 2048 + e * 32 + 16) = w1;
#pragma unroll
                for (int i2 = 0; i2 < 4; ++i2) { w0[i2] = pg8::cvt_pk_bf16(Vs[2 * i2], Vs[2 * i2 + 1]); w1[i2] = pg8::cvt_pk_bf16(Vs[8 + 2 * i2], Vs[8 + 2 * i2 + 1]); }
                *(LAS u32x4*)(RA + 2 * 2048 + e * 32) = w0; *(LAS u32x4*)(RA + 2 * 2048 + e * 32 + 16) = w1;
                *(LAS float*)(RA + 10240 + 4 * e) = gam;
            }
            __builtin_amdgcn_sched_barrier(0);
            float Gv[TB];
            {
                float X1[TB];
#pragma unroll
                for (int i = 0; i < TB; ++i) {
                    __builtin_amdgcn_sched_barrier(0);
                    float al[16];
#pragma unroll
                    for (int g4 = 0; g4 < 4; ++g4) { const f32x4 u = *(const LAS f32x4*)(MAT + 0 * 256 + i * 16 + 4 * g4); al[4 * g4] = u.x; al[4 * g4 + 1] = u.y; al[4 * g4 + 2] = u.z; al[4 * g4 + 3] = u.w; }
                    float x1 = At[i];
#pragma unroll
                    for (int m = 0; m < TB; ++m) if (m < i) x1 = __builtin_fmaf(al[m], X1[m], x1);
                    X1[i] = x1;
                }
#pragma unroll
                for (int i = 0; i < TB; ++i) {
                    __builtin_amdgcn_sched_barrier(0);
                    float pm[16];
#pragma unroll
                    for (int g4 = 0; g4 < 4; ++g4) { const f32x4 u = *(const LAS f32x4*)(MAT + 2 * 256 + i * 16 + 4 * g4); pm[4 * g4] = u.x; pm[4 * g4 + 1] = u.y; pm[4 * g4 + 2] = u.z; pm[4 * g4 + 3] = u.w; }
                    float gv = Rt[i];
#pragma unroll
                    for (int m = 0; m < TB; ++m) if (m <= i) gv = __builtin_fmaf(pm[m], X1[m], gv);
                    Gv[i] = gv;
                }
                u32x4 w0, w1;
#pragma unroll
                for (int i2 = 0; i2 < 4; ++i2) { w0[i2] = pg8::cvt_pk_bf16(X1[2 * i2], X1[2 * i2 + 1]); w1[i2] = pg8::cvt_pk_bf16(X1[8 + 2 * i2], X1[8 + 2 * i2 + 1]); }
                *(LAS u32x4*)(RA + 3 * 2048 + e * 32) = w0; *(LAS u32x4*)(RA + 3 * 2048 + e * 32 + 16) = w1;
            }
            __builtin_amdgcn_sched_barrier(0);
            {
                float X2[TB];
#pragma unroll
                for (int i = 0; i < TB; ++i) {
                    __builtin_amdgcn_sched_barrier(0);
                    float al[16], bl[16];
#pragma unroll
                    for (int g4 = 0; g4 < 4; ++g4) { const f32x4 u = *(const LAS f32x4*)(MAT + 0 * 256 + i * 16 + 4 * g4), v = *(const LAS f32x4*)(MAT + 1 * 256 + i * 16 + 4 * g4);
                        al[4 * g4] = u.x; al[4 * g4 + 1] = u.y; al[4 * g4 + 2] = u.z; al[4 * g4 + 3] = u.w; bl[4 * g4] = v.x; bl[4 * g4 + 1] = v.y; bl[4 * g4 + 2] = v.z; bl[4 * g4 + 3] = v.w; }
                    float x2 = 0.f;
#pragma unroll
                    for (int m = 0; m < TB; ++m) if (m < i) { x2 = __builtin_fmaf(bl[m], Vs[m], x2); x2 = __builtin_fmaf(al[m], X2[m], x2); }
                    X2[i] = x2;
                }
#pragma unroll
                for (int i = 0; i < TB; ++i) {
                    __builtin_amdgcn_sched_barrier(0);
                    float pm[16], qm[16];
#pragma unroll
                    for (int g4 = 0; g4 < 4; ++g4) { const f32x4 u = *(const LAS f32x4*)(MAT + 2 * 256 + i * 16 + 4 * g4), v = *(const LAS f32x4*)(MAT + 3 * 256 + i * 16 + 4 * g4);
                        pm[4 * g4] = u.x; pm[4 * g4 + 1] = u.y; pm[4 * g4 + 2] = u.z; pm[4 * g4 + 3] = u.w; qm[4 * g4] = v.x; qm[4 * g4 + 1] = v.y; qm[4 * g4 + 2] = v.z; qm[4 * g4 + 3] = v.w; }
                    float o0 = 0.f;
#pragma unroll
                    for (int m = 0; m < TB; ++m) if (m <= i) { o0 = __builtin_fmaf(pm[m], X2[m], o0); o0 = __builtin_fmaf(qm[m], Vs[m], o0); }
                    RO[((size_t)d * MT + r0 + (d ? TB - 1 - i : i)) * 512 + c] = o0;
                }
                u32x4 w0, w1;
#pragma unroll
                for (int i2 = 0; i2 < 4; ++i2) { w0[i2] = pg8::cvt_pk_bf16(X2[2 * i2], X2[2 * i2 + 1]); w1[i2] = pg8::cvt_pk_bf16(X2[8 + 2 * i2], X2[8 + 2 * i2 + 1]); }
                *(LAS u32x4*)(RA + 4 * 2048 + e * 32) = w0; *(LAS u32x4*)(RA + 4 * 2048 + e * 32 + 16) = w1;
            }
            WAVE_LDS_FENCE();
            __builtin_amdgcn_sched_barrier(0);
            {
                LAS bf16_t* GI = (LAS bf16_t*)MAT;
                const int sg = e >> 5, jp = 4 * ((e >> 4) & 1) + (e & 3), qg = (e & 15) >> 2;
#pragma unroll
                for (int i = 0; i < TB; ++i) GI[(sg * 64 + qg * 16 + i) * 8 + jp] = (bf16_t)f2bf(Gv[i]);
            }
            __builtin_amdgcn_sched_barrier(0);
            const int seqc = d == 0 ? (grp + 16) % RW_NCK : RW_NCK - 1 - grp;
            const size_t rec = (size_t)(d * 8 + h) * RW_NCK + seqc;
            {
                const int r = lane & 31, hh = lane >> 5;
                bf16x8 fBT[2], fKT[2], fVT[2], fW1[2], fU0[2];
#pragma unroll
                for (int blk = 0; blk < 2; ++blk) {
                    fBT[blk] = *(const LAS bf16x8*)(RA + 0 * 2048 + (32 * blk + r) * 32 + hh * 16); fKT[blk] = *(const LAS bf16x8*)(RA + 1 * 2048 + (32 * blk + r) * 32 + hh * 16);
                    fVT[blk] = *(const LAS bf16x8*)(RA + 2 * 2048 + (32 * blk + r) * 32 + hh * 16); fW1[blk] = *(const LAS bf16x8*)(RA + 3 * 2048 + (32 * blk + r) * 32 + hh * 16);
                    fU0[blk] = *(const LAS bf16x8*)(RA + 4 * 2048 + (32 * blk + r) * 32 + hh * 16);
                }
                float gk[2][16];
#pragma unroll
                for (int mb = 0; mb < 2; ++mb)
#pragma unroll
                    for (int reg = 0; reg < 16; ++reg) gk[mb][reg] = *(const LAS float*)(RA + 10240 + 4 * (32 * mb + KOFF(reg) + 4 * hh));
                WAVE_LDS_FENCE();
                float* Hrec = (float*)(C.ws + OFF_RWH + rec * RWH_REC);
                LAS bf16_t* MI = (LAS bf16_t*)RA;
#pragma unroll
                for (int mb = 0; mb < 2; ++mb)
#pragma unroll
                    for (int nbk = 0; nbk < 2; ++nbk) {
                        f32x16 aM, aH;
#pragma unroll
                        for (int i = 0; i < 16; ++i) { aM[i] = 0.f; aH[i] = 0.f; }
                        aM = MFMA32(fBT[mb], fW1[nbk], aM);
                        aH = MFMA32(fBT[mb], fU0[nbk], aH); aH = MFMA32(fKT[mb], fVT[nbk], aH);
                        const int col = 32 * nbk + r;
#pragma unroll
                        for (int g4 = 0; g4 < 4; ++g4) {
                            const int kb = 2 * mb + (g4 >> 1), q2 = 2 * (g4 & 1) + hh;
                            f32x4 hv; hv.x = gk[mb][4 * g4] * aH[4 * g4]; hv.y = gk[mb][4 * g4 + 1] * aH[4 * g4 + 1]; hv.z = gk[mb][4 * g4 + 2] * aH[4 * g4 + 2]; hv.w = gk[mb][4 * g4 + 3] * aH[4 * g4 + 3];
                            *(f32x4*)(Hrec + (((col >> 4) * 4 + kb) * 64 + q2 * 16 + (col & 15)) * 4) = hv;
                        }
                        const int sm = col >> 5, jpm = 4 * ((col >> 4) & 1) + (col & 3), qm2 = (col & 15) >> 2;
#pragma unroll
                        for (int reg = 0; reg < 16; ++reg) {
                            const int kp = 32 * mb + KOFF(reg) + 4 * hh;
                            const float mv = gk[mb][reg] * ((kp == col ? 1.0f : 0.0f) + aM[reg]);
                            MI[(((kp >> 4) * 2 + sm) * 64 + qm2 * 16 + (kp & 15)) * 8 + jpm] = (bf16_t)f2bf(mv);
                        }
                    }
                WAVE_LDS_FENCE();
                unsigned char* MGrec = C.ws + OFF_RWMG + rec * RWMG_REC;
#pragma unroll
                for (int it = 0; it < 8; ++it) *(u32x4*)(MGrec + (size_t)(it * 64 + lane) * 16) = *(const LAS u32x4*)(RA + (it * 64 + lane) * 16);
#pragma unroll
                for (int it = 0; it < 2; ++it) *(u32x4*)(MGrec + 8192 + (size_t)(it * 64 + lane) * 16) = *(const LAS u32x4*)((LAS unsigned char*)MAT + (it * 64 + lane) * 16);
                WAVE_LDS_FENCE();
            }
        }
    }
}

__device__ __forceinline__ void phase_attn_prep(Ctx& C, int l, int w0, int nw) {
    bf16_t* PA = WSP(bf16_t, OFF_PA);
    const int e = C.lane;
    const float na_qn = C.ka->in[I_NAQN][l * 64 + e], na_kn = C.ka->in[I_NAKN][l * 64 + e], wa_qn = C.ka->in[I_WAQN][l * 64 + e], wa_kn = C.ka->in[I_WAKN][l * 64 + e];
    const int m16 = e & 15;
    const float inv = powf(10000.0f, -(float)m16 / 16.0f);
    for (long uidx = w0; uidx < (long)MT * 26; uidx += nw) {
        const int r = (int)(uidx / 26), v = (int)(uidx % 26);
        int col; float nwt, scl; bool rope;
        if (v < 8) { col = v * 64; nwt = na_qn; scl = 0.125f; rope = false; }
        else if (v < 16) { col = 512 + (v - 8) * 64; nwt = na_kn; scl = 1.0f; rope = false; }
        else if (v < 24) { col = 1536 + (v - 16) * 64; nwt = wa_qn; scl = 0.125f; rope = true; }
        else { col = 2048 + (v - 24) * 64; nwt = wa_kn; scl = 1.0f; rope = true; }
        bf16_t* p = PA + (size_t)r * PAW + col + e;
        const float x = bf2f(*p);
        const float ss = wave_sum(x * x);
        float y = x * rsqrtf(ss * (1.0f / 64.0f) + EPS) * nwt * scl;
        if (rope && r < SEQ) {
            const int pos = (e >> 5) ? (r & 63) : (r >> 6);
            const float ang = (float)pos * inv;
            float sn, cs; sincosf(ang, &sn, &cs);
            const bool lo = (e & 31) < 16;
            const float yp = __shfl(y, lo ? e + 16 : e - 16);
            y = lo ? (y * cs - yp * sn) : (yp * sn + y * cs);
        }
        if (v < 8 || (v >= 16 && v < 24)) *p = (bf16_t)f2bf(y);
        else {
            bf16_t* kt = v < 16 ? WSP(bf16_t, OFF_KTN) + (size_t)((v - 8) * (MT / 32) + (r >> 5)) * 2048 : WSP(bf16_t, OFF_KTW) + (size_t)((v - 24) * (MT / 32) + (r >> 5)) * 2048;
            kt[(((e >> 4) * 64 + ((e >> 3) & 1) * 32 + (r & 31)) << 3) + (e & 7)] = (bf16_t)f2bf(y);
        }
    }
}

__device__ __forceinline__ float hg_lb(Ctx& C, int l, int d, int c) {
    if (l == 0) return 0.f;
    const float a0 = C.ka->in[I_HGLB][(size_t)(d * DEPTH + 0) * 512 + c], a1 = C.ka->in[I_HGLB][(size_t)(d * DEPTH + 1) * 512 + c];
    const float m = fmaxf(a0, a1); const float e0 = expf(a0 - m), e1 = expf(a1 - m);
    return e1 / (e0 + e1);
}
struct HgThread { float lc[16], kd[16]; float tot[4]; };
__device__ __forceinline__ void hg_gates(Ctx& C, int l, int d, int h, int tc, int k, int J, LAS float* TOT, HgThread& T) {
    const float* P = WSP(float, OFF_P32);
    const float lb = hg_lb(C, l, d, h * 128 + k);
    float gg[16];
#pragma unroll
    for (int i = 0; i < 16; ++i) {
        const float fr = P[(size_t)(64 * tc + 16 * J + i) * P32W + 512 + d * 512 + h * 128 + k];
        const float f = lb + (1.0f - lb) * sigmoidf_(fr);
        gg[i] = __logf(f); T.kd[i] = 1.0f - f;
    }
    if (d == 0) { float a = 0.f;
#pragma unroll
        for (int i = 0; i < 16; ++i) { a += gg[i]; T.lc[i] = a; }
        TOT[J * 128 + k] = a;
    } else { float a = 0.f;
#pragma unroll
        for (int i = 15; i >= 0; --i) { a += gg[i]; T.lc[i] = a; }
        TOT[J * 128 + k] = a;
    }
    __syncthreads();
#pragma unroll
    for (int m = 0; m < 4; ++m) T.tot[m] = TOT[m * 128 + k];
}
__device__ __forceinline__ void hg_it(Ctx& C, int h, int tc, int v, int J, LAS unsigned char* IT) {
    const float* P = WSP(float, OFF_P32);
    float x[16];
#pragma unroll
    for (int i = 0; i < 16; ++i) x[i] = P[(size_t)(64 * tc + 16 * J + i) * P32W + 1536 + h * 128 + v];
    u32x4 w0, w1;
    w0.x = pk2(x[0], x[1]); w0.y = pk2(x[2], x[3]); w0.z = pk2(x[4], x[5]); w0.w = pk2(x[6], x[7]);
    w1.x = pk2(x[8], x[9]); w1.y = pk2(x[10], x[11]); w1.z = pk2(x[12], x[13]); w1.w = pk2(x[14], x[15]);
    *(LAS u32x4*)(IT + v * 144 + J * 32) = w0; *(LAS u32x4*)(IT + v * 144 + J * 32 + 16) = w1;
}
__device__ __forceinline__ void phase_hg_A(Ctx& C, int l, int b0, int nb) {
    float* HGL = WSP(float, OFF_HGL); float* HGD = WSP(float, OFF_HGD);
    LAS unsigned char* KT = C.lds;
    LAS unsigned char* IT = C.lds + 18432;
    LAS float* TOT = (LAS float*)(C.lds + 36864);
    const int k = C.tid & 127, J = C.tid >> 7;
    for (int u = b0; u < 2 * 4 * NCH; u += nb) {
        const int d = u / (4 * NCH), h = (u / NCH) % 4, c = u % NCH;
        const int tc = d == 0 ? (c + NCH - 4) % NCH : NCH - 1 - c;
        __syncthreads();
        HgThread T; hg_gates(C, l, d, h, tc, k, J, TOT, T);
        float rest = 0.f;
#pragma unroll
        for (int m = 0; m < 4; ++m) if (d == 0 ? (m >= J) : (m <= J)) rest += T.tot[m];
        float kh[16];
#pragma unroll
        for (int i = 0; i < 16; ++i) kh[i] = T.kd[i] * __expf(rest - T.lc[i]);
        { u32x4 w0, w1;
          w0.x = pk2(kh[0], kh[1]); w0.y = pk2(kh[2], kh[3]); w0.z = pk2(kh[4], kh[5]); w0.w = pk2(kh[6], kh[7]);
          w1.x = pk2(kh[8], kh[9]); w1.y = pk2(kh[10], kh[11]); w1.z = pk2(kh[12], kh[13]); w1.w = pk2(kh[14], kh[15]);
          *(LAS u32x4*)(KT + k * 144 + J * 32) = w0; *(LAS u32x4*)(KT + k * 144 + J * 32 + 16) = w1; }
        hg_it(C, h, tc, k, J, IT);
        if (J == 0) HGD[(size_t)((d * 4 + h) * NCH + c) * 128 + k] = __expf((T.tot[0] + T.tot[1]) + (T.tot[2] + T.tot[3]));
        __syncthreads();
        const int r = C.lane & 31, hh = C.lane >> 5, vb = C.wave >> 1;
        float* outp = HGL + (size_t)((d * 4 + h) * NCH + c) * 16384;
#pragma unroll
        for (int t2 = 0; t2 < 2; ++t2) {
            const int kb = 2 * (C.wave & 1) + t2;
            f32x16 acc;
#pragma unroll
            for (int i = 0; i < 16; ++i) acc[i] = 0.f;
#pragma unroll
            for (int st = 0; st < 4; ++st) {
                const bf16x8 af = *(const LAS bf16x8*)(IT + (32 * vb + r) * 144 + st * 32 + hh * 16);
                const bf16x8 bf = *(const LAS bf16x8*)(KT + (32 * kb + r) * 144 + st * 32 + hh * 16);
                acc = MFMA32(af, bf, acc);
            }
#pragma unroll
            for (int reg = 0; reg < 16; ++reg) outp[(size_t)(32 * vb + KOFF(reg) + 4 * hh) * 128 + 32 * kb + r] = acc[reg];
        }
    }
}
__device__ __forceinline__ void phase_hg_B(Ctx& C, int b0, int nb) {
    const float* HGL = WSP(float, OFF_HGL); const float* HGD = WSP(float, OFF_HGD); bf16_t* SPT = WSP(bf16_t, OFF_SPT);
    for (int e = b0 * NT + C.tid; e < 8 * 16384; e += nb * NT) {
        const int dh = e >> 14, vk = e & 16383, k = vk & 127;
        float st = 0.f;
        const float* p = HGL + (size_t)dh * NCH * 16384 + vk; const float* dp = HGD + (size_t)dh * NCH * 128 + k; bf16_t* o = SPT + (size_t)dh * NCH * 16384 + vk;
#pragma unroll 4
        for (int c = 0; c < NCH; ++c) { const float Lc = p[(size_t)c * 16384], Dc = dp[c * 128]; o[(size_t)c * 16384] = (bf16_t)f2bf(st); st = Dc * st + Lc; }
    }
}
__device__ __forceinline__ void phase_hg_C(Ctx& C, int l, int b0, int nb) {
    const float* P = WSP(float, OFF_P32); const bf16_t* SPT = WSP(bf16_t, OFF_SPT); bf16_t* YB = WSP(bf16_t, OFF_YB);
    LAS unsigned char* KS = C.lds;
    LAS unsigned char* QJ = C.lds + 17408;
    LAS unsigned char* IT = C.lds + 17408 + 69632;
    LAS float* TOT = (LAS float*)(C.lds + 105472);
    LAS float* RED = (LAS float*)(C.lds + 107520);
    const int k = C.tid & 127, J = C.tid >> 7;
    const int tl = C.lane & 15, qd = C.lane >> 4, I = C.wave >> 1, vh = C.wave & 1;
    for (int u = b0; u < 4 * NCH; u += nb) {
        const int h = u / NCH, tc = u % NCH;
        f32x4 oT[4];
#pragma unroll
        for (int i = 0; i < 4; ++i) oT[i] = (f32x4){0.f, 0.f, 0.f, 0.f};
#pragma unroll 1
        for (int d = 0; d < 2; ++d) {
            const int cd = d == 0 ? (tc + 4) % NCH : NCH - 1 - tc;
            __syncthreads();
            {
                HgThread T; hg_gates(C, l, d, h, tc, k, J, TOT, T);
                float qv[16];
#pragma unroll
                for (int i = 0; i < 16; ++i) qv[i] = P[(size_t)(64 * tc + 16 * J + i) * P32W + h * 128 + k];
#pragma unroll
                for (int i = 0; i < 16; ++i) *(LAS bf16_t*)(KS + (16 * J + i) * 272 + 2 * k) = (bf16_t)f2bf(T.kd[i] * __expf(fminf(-T.lc[i], 80.f)));
#pragma unroll
                for (int Jp = 0; Jp < 4; ++Jp) {
                    if (d == 0 ? (Jp > J) : (Jp < J)) continue;
                    float Pj = 0.f;
#pragma unroll
                    for (int m = 0; m < 4; ++m) if (d == 0 ? (m >= Jp && m < J) : (m > J && m <= Jp)) Pj += T.tot[m];
#pragma unroll
                    for (int i = 0; i < 16; ++i) *(LAS bf16_t*)(QJ + (Jp * 64 + 16 * J + i) * 272 + 2 * k) = (bf16_t)f2bf(qv[i] * __expf(T.lc[i] + Pj));
                }
                hg_it(C, h, tc, k, J, IT);
            }
            __syncthreads();
            u32x2 att[4];
#pragma unroll
            for (int Jb = 0; Jb < 4; ++Jb) {
                att[Jb] = (u32x2){0u, 0u};
                if (d == 0 ? (Jb > I) : (Jb < I)) continue;
                f32x4 acc = {0.f, 0.f, 0.f, 0.f};
#pragma unroll
                for (int ks = 0; ks < 4; ++ks) {
                    const bf16x8 af = *(const LAS bf16x8*)(KS + (16 * Jb + tl) * 272 + ks * 64 + qd * 16);
                    const bf16x8 bf = *(const LAS bf16x8*)(QJ + (Jb * 64 + 16 * I + tl) * 272 + ks * 64 + qd * 16);
                    acc = MFMA16(af, bf, acc);
                }
                if (Jb == I) {
#pragma unroll
                    for (int reg = 0; reg < 4; ++reg) { const int sl = 4 * qd + reg; const bool valid = d == 0 ? (sl <= tl) : (sl >= tl); acc[reg] = valid ? acc[reg] : 0.f; }
                }
                att[Jb].x = pk2(acc[0], acc[1]); att[Jb].y = pk2(acc[2], acc[3]);
            }
#pragma unroll
            for (int pr = 0; pr < 2; ++pr) {
                const int Ja = 2 * pr, Jc = 2 * pr + 1;
                const bool anyv = d == 0 ? (Ja <= I) : (Jc >= I);
                if (!anyv) continue;
                u32x4 bw; bw.x = att[Ja].x; bw.y = att[Ja].y; bw.z = att[Jc].x; bw.w = att[Jc].y;
                const bf16x8 bf = __builtin_bit_cast(bf16x8, bw);
#pragma unroll
                for (int vb = 0; vb < 4; ++vb) {
                    const int v = 16 * (4 * vh + vb) + tl;
                    const u32x2 a0 = *(const LAS u32x2*)(IT + v * 144 + Ja * 32 + qd * 8), a1 = *(const LAS u32x2*)(IT + v * 144 + Jc * 32 + qd * 8);
                    u32x4 aw; aw.x = a0.x; aw.y = a0.y; aw.z = a1.x; aw.w = a1.y;
                    oT[vb] = MFMA16(__builtin_bit_cast(bf16x8, aw), bf, oT[vb]);
                }
            }
            const bf16_t* sp = SPT + (size_t)((d * 4 + h) * NCH + cd) * 16384;
            const int Je = d == 0 ? 0 : 3;
#pragma unroll
            for (int ks = 0; ks < 4; ++ks) {
                const bf16x8 bf = *(const LAS bf16x8*)(QJ + (Je * 64 + 16 * I + tl) * 272 + ks * 64 + qd * 16);
#pragma unroll
                for (int vb = 0; vb < 4; ++vb) {
                    const bf16x8 af = *(const bf16x8*)(sp + (size_t)(16 * (4 * vh + vb) + tl) * 128 + ks * 32 + qd * 8);
                    oT[vb] = MFMA16(af, bf, oT[vb]);
                }
            }
        }
        float ss = 0.f;
#pragma unroll
        for (int vb = 0; vb < 4; ++vb) ss += (oT[vb][0] * oT[vb][0] + oT[vb][1] * oT[vb][1]) + (oT[vb][2] * oT[vb][2] + oT[vb][3] * oT[vb][3]);
        ss += __shfl_xor(ss, 16); ss += __shfl_xor(ss, 32);
        __syncthreads();
        if (qd == 0) RED[C.wave * 16 + tl] = ss;
        __syncthreads();
        const float rstd = rsqrtf((RED[(2 * I) * 16 + tl] + RED[(2 * I + 1) * 16 + tl]) * (1.0f / 128.0f) + EPS);
        const int row = 64 * tc + 16 * I + tl;
#pragma unroll
        for (int vb = 0; vb < 4; ++vb) {
            const int v0 = 16 * (4 * vh + vb) + 4 * qd;
            const f32x4 nw = *(const f32x4*)(C.ka->in[I_HGNORM] + l * 512 + h * 128 + v0);
            const f32x4 gv = *(const f32x4*)(P + (size_t)row * P32W + 2048 + h * 128 + v0);
            u32x2 w; w.x = pg8::cvt_pk_bf16(oT[vb][0] * rstd * nw.x * siluf_(gv.x), oT[vb][1] * rstd * nw.y * siluf_(gv.y));
            w.y = pg8::cvt_pk_bf16(oT[vb][2] * rstd * nw.z * siluf_(gv.z), oT[vb][3] * rstd * nw.w * siluf_(gv.w));
            *(u32x2*)(YB + (size_t)row * 512 + h * 128 + v0) = w;
        }
    }
}

constexpr int RW_NJOBS = 64, RW_RING = 9, RW_SLOT = 14336;
__device__ __forceinline__ void phase_rw_scan(Ctx& C, int b0, int nb) {
    float* RO2 = WSP(float, OFF_RO2);
    LAS unsigned char* slot = C.lds;
    const int lane = C.lane, wv = C.wave;
    for (int jb = b0; jb < RW_NJOBS; jb += nb) {
        const int x = jb & 7, y = jb >> 3, dh = x * 2 + (y >> 2), vs = y & 3, d = dh >> 3, h = dh & 7;
        const unsigned char* mg = C.ws + OFF_RWMG + (size_t)dh * RW_NCK * RWMG_REC;
        const unsigned char* hr = C.ws + OFF_RWH + (size_t)dh * RW_NCK * RWH_REC + (size_t)vs * 4096;
        __syncthreads();
#define RW_DMA(cc) do { LAS unsigned char* dst_ = slot + ((cc) % RW_RING) * RW_SLOT; \
            _Pragma("unroll") for (int i = 0; i < 10; ++i) __builtin_amdgcn_global_load_lds((const unsigned*)(mg + (size_t)(cc) * RWMG_REC + (size_t)(i * 64 + lane) * 16), (LAS unsigned*)(dst_ + i * 1024), 16, 0, 0); \
            _Pragma("unroll") for (int i = 0; i < 4; ++i) __builtin_amdgcn_global_load_lds((const unsigned*)(hr + (size_t)(cc) * RWH_REC + (size_t)(i * 64 + lane) * 16), (LAS unsigned*)(dst_ + (10 + i) * 1024), 16, 0, 0); } while (0)
        if (wv == 1 || wv == 2) { const int par = wv - 1;
#pragma unroll
            for (int k4 = 0; k4 < 4; ++k4) RW_DMA(2 * k4 + par); }
        f32x4 acc[4];
#pragma unroll
        for (int i = 0; i < 4; ++i) acc[i] = (f32x4){0.f, 0.f, 0.f, 0.f};
        const int vl = lane & 15, q = lane >> 4;
#pragma unroll 1
        for (int cc = -1; cc < RW_NCK; ++cc) {
            if (wv == 1 || wv == 2) {
                const int par = wv - 1, nx = cc + 1;
                if ((nx & 1) == par) {
                    asm volatile("s_waitcnt vmcnt(42)" ::: "memory");
                } else if (cc >= 0) {
                    const int nn = cc + 8 < RW_NCK ? cc + 8 : RW_NCK - 1;
                    if (cc + 8 < RW_NCK) { RW_DMA(nn); } else { LAS unsigned char* dst_ = slot + ((cc + 8) % RW_RING) * RW_SLOT;
#pragma unroll
                        for (int i = 0; i < 14; ++i) __builtin_amdgcn_global_load_lds((const unsigned*)(mg + (size_t)nn * RWMG_REC + (size_t)lane * 16), (LAS unsigned*)(dst_ + i * 1024), 16, 0, 0); }
                }
            } else if (wv == 0 && cc >= 0) {
                const LAS unsigned char* sl = slot + (cc % RW_RING) * RW_SLOT;
                bf16x8 bfr[2];
#pragma unroll
                for (int s2 = 0; s2 < 2; ++s2) { u32x4 w; w.x = pk2(acc[2 * s2][0], acc[2 * s2][1]); w.y = pk2(acc[2 * s2][2], acc[2 * s2][3]); w.z = pk2(acc[2 * s2 + 1][0], acc[2 * s2 + 1][1]); w.w = pk2(acc[2 * s2 + 1][2], acc[2 * s2 + 1][3]);
                    bfr[s2] = __builtin_bit_cast(bf16x8, w); }
                const int rc = d == 0 ? (cc + RW_NCK - 16) % RW_NCK : RW_NCK - 1 - cc;
                float* rop = RO2 + ((size_t)d * MT + 16 * rc) * 512 + h * 64 + 16 * vs + vl;
                f32x4 oacc = {0.f, 0.f, 0.f, 0.f};
#pragma unroll
                for (int s2 = 0; s2 < 2; ++s2) oacc = MFMA16(*(const LAS bf16x8*)(sl + 8192 + (s2 * 64 + lane) * 16), bfr[s2], oacc);
#pragma unroll
                for (int reg = 0; reg < 4; ++reg) { const int i = 4 * q + reg; rop[(size_t)(d ? 15 - i : i) * 512] = oacc[reg]; }
#pragma unroll
                for (int kb = 0; kb < 4; ++kb) {
                    f32x4 a = *(const LAS f32x4*)(sl + 10240 + (kb * 64 + lane) * 16);
#pragma unroll
                    for (int s2 = 0; s2 < 2; ++s2) a = MFMA16(*(const LAS bf16x8*)(sl + ((kb * 2 + s2) * 64 + lane) * 16), bfr[s2], a);
                    acc[kb] = a;
                }
            }
            asm volatile("s_waitcnt lgkmcnt(0)" ::: "memory"); __builtin_amdgcn_s_barrier(); asm volatile("" ::: "memory");
        }
        asm volatile("s_waitcnt vmcnt(0)" ::: "memory");
#undef RW_DMA
    }
}
__device__ __forceinline__ void phase_rw_finish(Ctx& C, int l, int w0, int nw) {
    const float* VV = WSP(float, OFF_VV); const float* GS = WSP(float, OFF_GS); const float* RO = WSP(float, OFF_RO); const float* BON = WSP(float, OFF_BON); const float* RO2 = WSP(float, OFF_RO2);
    bf16_t* YB = WSP(bf16_t, OFF_YB) + (size_t)1 * MT * 512;
    const int e = C.lane;
    for (int uidx = w0; uidx < MT * 8; uidx += nw) {
        const int r = uidx >> 3, h = uidx & 7, c = h * 64 + e;
        const float o = (RO[(size_t)r * 512 + c] + RO[((size_t)MT + r) * 512 + c]) + (RO2[(size_t)r * 512 + c] + RO2[((size_t)MT + r) * 512 + c]);
        const float mu = wave_sum_fast(o) * (1.0f / 64.0f);
        const float dv = o - mu;
        const float var = wave_sum_fast(dv * dv) * (1.0f / 64.0f);
        const float on = dv * rsqrtf(var + RW_GN_EPS) * C.ka->in[I_RWLNW][l * 512 + c] + C.ka->in[I_RWLNB][l * 512 + c];
        const float y = (on + (BON[(size_t)r * 8 + h] + BON[((size_t)MT + r) * 8 + h]) * VV[(size_t)r * 512 + c]) * GS[(size_t)r * 512 + c];
        YB[(size_t)r * 512 + c] = (bf16_t)f2bf(y);
    }
}

typedef float f32x4u __attribute__((ext_vector_type(4), aligned(4)));
__device__ __forceinline__ float swap32_sum(float x) { auto t = __builtin_amdgcn_permlane32_swap(__float_as_uint(x), __float_as_uint(x), false, false); return __uint_as_float(t[0]) + __uint_as_float(t[1]); }
__device__ __forceinline__ f32x16 qk_tile(const bf16_t* Kp  , const bf16x8 (&qf)[4], int r, int h) {
    f32x16 acc;
#pragma unroll
    for (int i = 0; i < 16; ++i) acc[i] = 0.f;
    const bf16_t* p = Kp + (size_t)r * PAW + 8 * h;
#pragma unroll
    for (int s = 0; s < 4; ++s) { const bf16x8 kf = *(const bf16x8*)(p + 16 * s); acc = MFMA32(kf, qf[s], acc); }
    return acc;
}
__device__ __forceinline__ void pv_tile(f32x16 (&o)[2], const bf16_t* VTp  , const f32x16& p, int r, int h) {
#pragma unroll
    for (int s = 0; s < 2; ++s) {
        u32x4 pw; pw.x = pg8::cvt_pk_bf16(p[8 * s + 0], p[8 * s + 1]); pw.y = pg8::cvt_pk_bf16(p[8 * s + 2], p[8 * s + 3]); pw.z = pg8::cvt_pk_bf16(p[8 * s + 4], p[8 * s + 5]); pw.w = pg8::cvt_pk_bf16(p[8 * s + 6], p[8 * s + 7]);
        const bf16x8 pb = __builtin_bit_cast(bf16x8, pw);
#pragma unroll
        for (int blk = 0; blk < 2; ++blk) {
            const bf16_t* vp = VTp + (size_t)(32 * blk + r) * MT + 16 * s + 4 * h;
            const u32x2 lo = *(const u32x2*)vp, hi = *(const u32x2*)(vp + 8);
            u32x4 vw; vw.x = lo.x; vw.y = lo.y; vw.z = hi.x; vw.w = hi.y;
            o[blk] = MFMA32(__builtin_bit_cast(bf16x8, vw), pb, o[blk]);
        }
    }
}
__device__ __forceinline__ void phase_attn(Ctx& C, int l, int w0, int nw) {
    const bf16_t* PA = WSP(bf16_t, OFF_PA); bf16_t* YB = WSP(bf16_t, OFF_YB);
    const bf16_t* VTN = WSP(bf16_t, OFF_VTN); const bf16_t* VTW = WSP(bf16_t, OFF_VTW);
    const float* PB = WSP(float, OFF_PB); const float* MREF = WSP(float, OFF_MREF);
    const int r = C.lane & 31, h = C.lane >> 5;
    constexpr int NJT = 2048 + 64;
    for (int job = w0; job < 2 * NJT; job += nw) {
        const int type = __builtin_amdgcn_readfirstlane(job / NJT), jj = __builtin_amdgcn_readfirstlane(job % NJT), qt = jj >> 3, hd = jj & 7;
        const int q0 = qt * 32;
        const bool lat = qt < 256;
        const float Mr = MREF[type];
        bf16x8 qf[4];
        { const bf16_t* qp = PA + (size_t)(q0 + r) * PAW + (type == 0 ? 0 : 1536) + hd * 64 + 8 * h;
#pragma unroll
          for (int s = 0; s < 4; ++s) qf[s] = *(const bf16x8*)(qp + 16 * s); }
        f32x16 o[2];
#pragma unroll
        for (int i = 0; i < 16; ++i) { o[0][i] = 0.f; o[1][i] = 0.f; }
        float lsum = 0.f;
        const int kcol = type == 0 ? 512 + hd * 64 : 2048 + (hd >> 2) * 64;
        const bf16_t* VT = type == 0 ? VTN + (size_t)(hd * (MT / 32)) * 2048 : VTW + (size_t)((hd >> 2) * (MT / 32)) * 2048;
        const bf16_t* KT = type == 0 ? WSP(bf16_t, OFF_KTN) + (size_t)(hd * (MT / 32)) * 2048 : WSP(bf16_t, OFF_KTW) + (size_t)((hd >> 2) * (MT / 32)) * 2048;
        const int i_g = qt >> 1, j_g = (qt & 1) * 32 + r;
        int rs = i_g - 4; rs = rs < 0 ? 0 : (rs > 120 ? 120 : rs);
        int cs = j_g - 8; cs = cs < 0 ? 0 : (cs > 48 ? 48 : cs);
        const int dl0 = -4 > -qt ? -4 : -qt, dl1 = 4 < 255 - qt ? 4 : 255 - qt;
        const int n_loc = !lat ? 0 : (type == 0 ? 16 : dl1 - dl0 + 1), nt = n_loc + CTX / 32;
#define ATT_KEY0(t) ((t) >= n_loc ? SEQ + 32 * ((t) - n_loc) : (type == 0 ? (rs + ((t) >> 1)) * 64 + 32 * ((t) & 1) : (qt + dl0 + (t)) * 32))
#define ATT_LOADK(kf, key0) do { const bf16_t* kp_ = KT + (size_t)((key0) >> 5) * 2048 + C.lane * 8; _Pragma("unroll") for (int s = 0; s < 4; ++s) kf[s] = *(const bf16x8*)(kp_ + s * 512); } while (0)
#define ATT_LOADV(vf, key0) do { const bf16_t* vp_ = VT + (size_t)((key0) >> 5) * 2048 + C.lane * 8; _Pragma("unroll") for (int s = 0; s < 2; ++s) _Pragma("unroll") for (int blk = 0; blk < 2; ++blk) vf[s][blk] = *(const u32x4*)(vp_ + (s * 2 + blk) * 512); } while (0)
        bf16x8 kc[4], kn[4]; u32x4 vc[2][2], vn[2][2];
        { const int k0 = ATT_KEY0(0); ATT_LOADK(kc, k0); ATT_LOADV(vc, k0); }
#pragma unroll 1
        for (int t = 0; t < nt; ++t) {
            { const int tn = t + 1 < nt ? t + 1 : t; const int k1 = ATT_KEY0(tn); ATT_LOADK(kn, k1); ATT_LOADV(vn, k1); }
            f32x16 acc;
#pragma unroll
            for (int i = 0; i < 16; ++i) acc[i] = 0.f;
#pragma unroll
            for (int s = 0; s < 4; ++s) acc = MFMA32(kc[s], qf[s], acc);
            f32x16 p;
            if (t >= n_loc) {
#pragma unroll
                for (int reg = 0; reg < 16; ++reg) { p[reg] = __expf(acc[reg] - Mr); lsum += p[reg]; }
            } else if (type == 0) {
                const int a = t >> 1, cc = t & 1;
                const float* brow = PB + (size_t)(hd * 15 + (rs + a - i_g + 7)) * 128 + (32 * cc + 4 * h - j_g + 63);
                const int lo = cs - 32 * cc - 4 * h;
#pragma unroll
                for (int g = 0; g < 4; ++g) {
                    const f32x4u b4 = *(const f32x4u*)(brow + 8 * g);
#pragma unroll
                    for (int q = 0; q < 4; ++q) { const int reg = 4 * g + q; const bool valid = (unsigned)(KOFF(reg) - lo) < 16u;
                        const float e = __expf(acc[reg] + b4[q] - Mr); p[reg] = valid ? e : 0.f; lsum += p[reg]; }
                }
            } else {
                const int dl = dl0 + t;
#pragma unroll
                for (int reg = 0; reg < 16; ++reg) { const int kr = KOFF(reg) + 4 * h; const bool valid = dl == -4 ? (kr >= r) : (dl == 4 ? (kr <= r) : true);
                    const float e = __expf(acc[reg] - Mr); p[reg] = valid ? e : 0.f; lsum += p[reg]; }
            }
#pragma unroll
            for (int s = 0; s < 2; ++s) {
                u32x4 pw; pw.x = pg8::cvt_pk_bf16(p[8 * s + 0], p[8 * s + 1]); pw.y = pg8::cvt_pk_bf16(p[8 * s + 2], p[8 * s + 3]); pw.z = pg8::cvt_pk_bf16(p[8 * s + 4], p[8 * s + 5]); pw.w = pg8::cvt_pk_bf16(p[8 * s + 6], p[8 * s + 7]);
                const bf16x8 pb = __builtin_bit_cast(bf16x8, pw);
#pragma unroll
                for (int blk = 0; blk < 2; ++blk) o[blk] = MFMA32(__builtin_bit_cast(bf16x8, vc[s][blk]), pb, o[blk]);
            }
#pragma unroll
            for (int s = 0; s < 4; ++s) kc[s] = kn[s];
#pragma unroll
            for (int s = 0; s < 2; ++s)
#pragma unroll
                for (int blk = 0; blk < 2; ++blk) vc[s][blk] = vn[s][blk];
        }
#undef ATT_KEY0
#undef ATT_LOADK
#undef ATT_LOADV
        float ltot = swap32_sum(lsum);
        if (type == 1) ltot += __expf(C.ka->in[I_WASINK][l * 8 + hd] - Mr);
        const float inv = 1.0f / ltot;
        bf16_t* yp = YB + (size_t)(2 + type) * MT * 512 + (size_t)(q0 + r) * 512 + hd * 64 + 4 * h;
#pragma unroll
        for (int blk = 0; blk < 2; ++blk)
#pragma unroll
            for (int g = 0; g < 4; ++g) {
                u32x2 w; w.x = pg8::cvt_pk_bf16(o[blk][4 * g] * inv, o[blk][4 * g + 1] * inv); w.y = pg8::cvt_pk_bf16(o[blk][4 * g + 2] * inv, o[blk][4 * g + 3] * inv);
                *(u32x2*)(yp + 32 * blk + 8 * g) = w;
            }
    }
}
__device__ __forceinline__ void phase_attn_tables(Ctx& C, int l, int w0, int nw) {
    const bf16_t* PA = WSP(bf16_t, OFF_PA); bf16_t* VTN = WSP(bf16_t, OFF_VTN); bf16_t* VTW = WSP(bf16_t, OFF_VTW);
    LAS unsigned char* tile = C.lds + C.wave * 9216;
    const int lane = C.lane;
    for (int u = w0; u < 10 * NCH; u += nw) {
        const int hd = u / NCH, tt = u % NCH, t0 = tt * 64;
        const int vcol = hd < 8 ? 1024 + hd * 64 : 2176 + (hd - 8) * 64;
#pragma unroll
        for (int it = 0; it < 8; ++it) { const int row = 8 * it + (lane >> 3), ch = lane & 7;
            *(LAS u32x4*)(tile + row * 144 + ch * 16) = *(const u32x4*)(PA + (size_t)(t0 + row) * PAW + vcol + ch * 8); }
        LDS_WAIT(); asm volatile("" ::: "memory");
        bf16_t* dst = (hd < 8 ? VTN + (size_t)(hd * (MT / 32) + 2 * tt) * 2048 : VTW + (size_t)((hd - 8) * (MT / 32) + 2 * tt) * 2048);
        { const int rr = lane & 31, hh = lane >> 5;
#pragma unroll
          for (int kt2 = 0; kt2 < 2; ++kt2)
#pragma unroll
            for (int s2 = 0; s2 < 2; ++s2)
#pragma unroll
                for (int blk = 0; blk < 2; ++blk) {
                    unsigned e[8];
#pragma unroll
                    for (int j = 0; j < 8; ++j) e[j] = *(const LAS bf16_t*)(tile + (32 * kt2 + 16 * s2 + 8 * (j >> 2) + 4 * hh + (j & 3)) * 144 + 2 * (32 * blk + rr));
                    u32x4 w; w.x = e[0] | (e[1] << 16); w.y = e[2] | (e[3] << 16); w.z = e[4] | (e[5] << 16); w.w = e[6] | (e[7] << 16);
                    *(u32x4*)(dst + (size_t)kt2 * 2048 + ((s2 * 2 + blk) * 64 + lane) * 8) = w;
                }
        }
        LDS_WAIT(); asm volatile("" ::: "memory");
    }
    float* PB = WSP(float, OFF_PB);
    const float* rpb = C.ka->in[I_NARPB] + (size_t)l * 8 * 15 * 31;
    for (int idx = w0 * 64 + lane; idx < 8 * 15 * 128; idx += nw * 64) { const int x = idx & 127, hr = idx >> 7; PB[idx] = (x >= 48 && x < 79) ? rpb[hr * 31 + x - 48] : 0.f; }
    if (w0 == 0) {
        float mb = 0.f;
        for (int i = lane; i < 8 * 15 * 31; i += 64) mb = fmaxf(mb, fabsf(rpb[i]));
        mb = wave_max(mb);
        const float nq = wave_max(fabsf(C.ka->in[I_NAQN][l * 64 + lane])), nk = wave_max(fabsf(C.ka->in[I_NAKN][l * 64 + lane]));
        const float wq = wave_max(fabsf(C.ka->in[I_WAQN][l * 64 + lane])), wk = wave_max(fabsf(C.ka->in[I_WAKN][l * 64 + lane]));
        const float sk = wave_max(lane < 8 ? C.ka->in[I_WASINK][l * 8 + lane] : -1e30f);
        if (lane == 0) { float* M = WSP(float, OFF_MREF); M[0] = 8.08f * nq * nk + mb; M[1] = fmaxf(8.08f * wq * wk, sk); }
    }
}

__device__ __forceinline__ void phase_combine(Ctx& C) {
    const bf16_t* PROJ = WSP(bf16_t, OFF_P32); bf16_t* MG = WSP(bf16_t, OFF_H);
    const size_t n8 = (size_t)MT * D / 8;
    for (size_t i = (size_t)C.bid * NT + C.tid; i < n8; i += (size_t)C.G * NT) {
        const size_t r = i / (D / 8), c8 = i % (D / 8);
        float a[8];
#pragma unroll
        for (int j = 0; j < 8; ++j) a[j] = 0.f;
#pragma unroll
        for (int g = 0; g < 4; ++g) {
            const u32x4 w = *(const u32x4*)(PROJ + r * GLW + g * D + c8 * 8);
            a[0] += bf2f(w.x & 0xffffu); a[1] += bf2f(w.x >> 16); a[2] += bf2f(w.y & 0xffffu); a[3] += bf2f(w.y >> 16);
            a[4] += bf2f(w.z & 0xffffu); a[5] += bf2f(w.z >> 16); a[6] += bf2f(w.w & 0xffffu); a[7] += bf2f(w.w >> 16);
        }
        u32x4 o; o.x = pk2(a[0], a[1]); o.y = pk2(a[2], a[3]); o.z = pk2(a[4], a[5]); o.w = pk2(a[6], a[7]);
        *(u32x4*)(MG + r * D + c8 * 8) = o;
    }
}

constexpr int PH_PRO = 2, PH_PER_LAYER = 14, N_PHASES = PH_PRO + DEPTH * PH_PER_LAYER;

__global__ void __launch_bounds__(NT, 2) mk_fwd(Args args) {
    extern __shared__ __attribute__((aligned(16))) unsigned char lds_raw[];
    Ctx C;
    C.lds = (LAS unsigned char*)lds_raw;
    C.tid = threadIdx.x; C.lane = C.tid & 63; C.wave = __builtin_amdgcn_readfirstlane(C.tid >> 6);
    C.bid = blockIdx.x; C.G = gridDim.x;
    C.ka = (const Args __attribute__((address_space(4)))*)__builtin_amdgcn_kernarg_segment_ptr(); C.out = args.out; C.ws = args.ws;
    volatile LAS unsigned* MISC = (volatile LAS unsigned*)(C.lds + MISC_OFF);
    for (int u = C.tid; u < (LDS_BYTES - RING_BYTES) / 4; u += NT) ((LAS unsigned*)(C.lds + RING_BYTES))[u] = 0u;
    __syncthreads();
    const int lo = args.ph_lo, hi = args.ph_hi;
    XcdBarrier bar; bar.bar = WSP(unsigned, OFF_CTL) + 4096; bar.x = 0; bar.st = nullptr;
    const bool multi = (hi - lo) > 1;
    if (multi) bar = xcd_barrier_post(WSP(unsigned, OFF_CTL) + 4096, MISC + 8);
#ifndef PH_MASK
#define PH_MASK 0xFFFF
#endif
#ifndef PRO_MASK
#define PRO_MASK 3
#endif
#define IN(k) (lo <= (k) && (k) < hi)
#define LEN(j) (((PH_MASK) >> (j)) & 1)
#define SEAM(k) do { if (IN(k) && IN((k) + 1)) xcd_barrier(bar); } while (0)

    if ((PRO_MASK & 1) && IN(0)) { relaunder(C); phase_convert(C, 0); phase_ada_partial(C); } SEAM(0);
    if ((PRO_MASK & 2) && IN(1)) { relaunder(C); phase_ada_reduce(C); } SEAM(1);

#pragma unroll
    for (int l = 0; l < DEPTH; ++l) {
        const int pb = PH_PRO + l * PH_PER_LAYER;
        if (LEN(0) && IN(pb + 0)) { relaunder(C); if (l > 0) phase_convert(C, l); phase_norm(C, l, C.ka->in[I_NF1] + (size_t)l * D, 0, l > 0 ? 22 : 0); } SEAM(pb + 0);
        if (LEN(1) && IN(pb + 1)) { relaunder(C);
            pg8::Gemm g{WSP(bf16_t, OFF_H), WSP(bf16_t, OFF_WI1), 1 << 20, 0};
            pg8::StaticOrder S; S.init(MT, 2 * DFF, C.G, C.bid);
            pg8::EpiSwiGLU E{WSP(bf16_t, OFF_G)};
            pg8::gemm_phase<pg8::EpiSwiGLU, true, true, pg8::StaticOrder, D, D, D, 0>(C.lds, g, S, E, C.tid);
            if (PROBE_MODE == 3) { pg8::gemm_phase<pg8::EpiSwiGLU, true, true, pg8::StaticOrder, D, D, D, 0>(C.lds, g, S, E, C.tid); }
        } SEAM(pb + 1);
        if (LEN(2) && IN(pb + 2)) { relaunder(C);
            { pg8::Gemm g{WSP(bf16_t, OFF_G), WSP(bf16_t, OFF_WO1), 1 << 20, 0};
              pg8::StaticOrder S; S.init(SEQ, D, C.G, C.bid);
              pg8::EpiResid<true> E{WSP(float, OFF_X), mod_ptr(C, l, 0, 2), mod_ptr(C, l, 1, 2), nullptr};
              pg8::gemm_phase<pg8::EpiResid<true>, true, true, pg8::StaticOrder, DFF, DFF, DFF, 0>(C.lds, g, S, E, C.tid); }
            { relaunder(C); pg8::Gemm g{WSP(bf16_t, OFF_G), WSP(bf16_t, OFF_WO1), 1 << 20, 0};
              pg8::SplitOrder S{SEQ / 256, D / 256, 22, C.G, C.bid};
              pg8::EpiPart<true> E{WSP(float, OFF_P32), mod_ptr(C, l, 1, 2)};
              pg8::gemm_phase<pg8::EpiPart<true>, true, true, pg8::SplitOrder, 256, DFF, DFF, 256>(C.lds, g, S, E, C.tid); }
        } SEAM(pb + 2);
        if (LEN(3) && IN(pb + 3)) { relaunder(C); phase_norm(C, l, C.ka->in[I_NMIX] + (size_t)l * D, 3, 22); } SEAM(pb + 3);
        if (LEN(4) && IN(pb + 4)) { relaunder(C);
            pg8::Gemm g{WSP(bf16_t, OFF_H), WSP(bf16_t, OFF_WIN), 1 << 20, 0};
            pg8::StaticOrder S; S.init(MT, PTOT, C.G, C.bid);
            pg8::EpiWin E{WSP(float, OFF_P32), WSP(bf16_t, OFF_PA), WSP(bf16_t, OFF_GL), 0};
            pg8::gemm_phase<pg8::EpiWin, true, true, pg8::StaticOrder, D, D, D, 0>(C.lds, g, S, E, C.tid);
            if (PROBE_MODE == 3) { pg8::gemm_phase<pg8::EpiWin, true, true, pg8::StaticOrder, D, D, D, 0>(C.lds, g, S, E, C.tid); }
        } SEAM(pb + 4);
        if (LEN(5) && IN(pb + 5)) { relaunder(C);
            phase_rw_prep(C, l, C.bid, C.G);
            __syncthreads();
            phase_attn_prep(C, l, C.bid * NWAVES + C.wave, C.G * NWAVES);
            phase_attn_tables(C, l, C.bid * NWAVES + C.wave, C.G * NWAVES);
            if (PROBE_MODE == 1) phase_attn_tables(C, l, C.bid * NWAVES + C.wave, C.G * NWAVES);
            __syncthreads();
            phase_hg_A(C, l, C.bid, C.G);
            if (PROBE_MODE == 1) phase_hg_A(C, l, C.bid, C.G);
        } SEAM(pb + 5);
        if (LEN(6) && IN(pb + 6)) { relaunder(C);
            if (C.G >= 256) {
                if (C.bid < RW_NJOBS) phase_rw_scan(C, C.bid, RW_NJOBS);
                else { const int b = C.bid - RW_NJOBS, n = C.G - RW_NJOBS; phase_hg_B(C, b, n); phase_attn(C, l, b * NWAVES + C.wave, n * NWAVES);
                    if (PROBE_MODE == 11) { phase_hg_B(C, b, n); phase_attn(C, l, b * NWAVES + C.wave, n * NWAVES); }
                    if (PROBE_MODE == 12) { phase_attn(C, l, b * NWAVES + C.wave, n * NWAVES); } if (PROBE_MODE == 13) { phase_hg_B(C, b, n); } }
            } else {
                phase_rw_scan(C, C.bid, C.G); phase_hg_B(C, C.bid, C.G); phase_attn(C, l, C.bid * NWAVES + C.wave, C.G * NWAVES);
            }
        } SEAM(pb + 6);
        if (LEN(7) && IN(pb + 7)) { relaunder(C); phase_hg_C(C, l, C.bid, C.G); phase_rw_finish(C, l, C.bid * NWAVES + C.wave, C.G * NWAVES);
            if (PROBE_MODE == 2) { phase_hg_C(C, l, C.bid, C.G); phase_rw_finish(C, l, C.bid * NWAVES + C.wave, C.G * NWAVES); } } SEAM(pb + 7);
        if (LEN(8) && IN(pb + 8)) { relaunder(C);
            pg8::Gemm g{WSP(bf16_t, OFF_YB), WSP(bf16_t, OFF_WBR), 8, (size_t)MT * 512};
            pg8::StaticOrder S; S.init(MT, 4 * D, C.G, C.bid);
            pg8::EpiMerge E{WSP(bf16_t, OFF_GL), WSP(bf16_t, OFF_P32)};
            pg8::gemm_phase<pg8::EpiMerge, true, true, pg8::StaticOrder, 512, 512, 512, 0>(C.lds, g, S, E, C.tid);
            if (PROBE_MODE == 3) { pg8::gemm_phase<pg8::EpiMerge, true, true, pg8::StaticOrder, 512, 512, 512, 0>(C.lds, g, S, E, C.tid); }
        } SEAM(pb + 8);
        if (LEN(9) && IN(pb + 9)) { relaunder(C); phase_combine(C); if (PROBE_MODE == 2) phase_combine(C); } SEAM(pb + 9);
        if (LEN(10) && IN(pb + 10)) { relaunder(C);
            { pg8::Gemm g{WSP(bf16_t, OFF_H), WSP(bf16_t, OFF_WOUT), 1 << 20, 0};
              pg8::StaticOrder S; S.init(SEQ, D, C.G, C.bid);
              pg8::EpiResid<false> E{WSP(float, OFF_X), mod_ptr(C, l, 0, 5), mod_ptr(C, l, 1, 5), nullptr};
              pg8::gemm_phase<pg8::EpiResid<false>, true, true, pg8::StaticOrder, D, D, D, 0>(C.lds, g, S, E, C.tid); }
            if (l < DEPTH - 1) { relaunder(C);
              pg8::Gemm g{WSP(bf16_t, OFF_H), WSP(bf16_t, OFF_WOUT), 1 << 20, 0};
              pg8::SplitOrder S{SEQ / 256, D / 256, 8, C.G, C.bid};
              pg8::EpiPart<false> E{WSP(float, OFF_P32), mod_ptr(C, l, 1, 5)};
              pg8::gemm_phase<pg8::EpiPart<false>, true, true, pg8::SplitOrder, 256, D, D, 256>(C.lds, g, S, E, C.tid); }
        } SEAM(pb + 10);
        if (LEN(11) && IN(pb + 11)) { relaunder(C); phase_norm(C, l, C.ka->in[I_NF2] + (size_t)l * D, 6, l < DEPTH - 1 ? 8 : 0); } SEAM(pb + 11);
        if (LEN(12) && IN(pb + 12)) { relaunder(C);
            pg8::Gemm g{WSP(bf16_t, OFF_H), WSP(bf16_t, OFF_WI2), 1 << 20, 0};
            pg8::StaticOrder S; S.init(MT, 2 * DFF, C.G, C.bid);
            pg8::EpiSwiGLU E{WSP(bf16_t, OFF_G)};
            pg8::gemm_phase<pg8::EpiSwiGLU, true, true, pg8::StaticOrder, D, D, D, 0>(C.lds, g, S, E, C.tid);
            if (PROBE_MODE == 3) { pg8::gemm_phase<pg8::EpiSwiGLU, true, true, pg8::StaticOrder, D, D, D, 0>(C.lds, g, S, E, C.tid); }
        } SEAM(pb + 12);
        if (LEN(13) && IN(pb + 13)) { relaunder(C);
            { pg8::Gemm g{WSP(bf16_t, OFF_G), WSP(bf16_t, OFF_WO2), 1 << 20, 0};
              pg8::StaticOrder S; S.init(SEQ, D, C.G, C.bid);
              pg8::EpiResid<true> E{WSP(float, OFF_X), mod_ptr(C, l, 0, 8), mod_ptr(C, l, 1, 8), l == DEPTH - 1 ? C.out : nullptr};
              pg8::gemm_phase<pg8::EpiResid<true>, true, true, pg8::StaticOrder, DFF, DFF, DFF, 0>(C.lds, g, S, E, C.tid); }
            if (l < DEPTH - 1) { relaunder(C);
              pg8::Gemm g{WSP(bf16_t, OFF_G), WSP(bf16_t, OFF_WO2), 1 << 20, 0};
              pg8::SplitOrder S{SEQ / 256, D / 256, 22, C.G, C.bid};
              pg8::EpiPart<true> E{WSP(float, OFF_P32), mod_ptr(C, l, 1, 8)};
              pg8::gemm_phase<pg8::EpiPart<true>, true, true, pg8::SplitOrder, 256, DFF, DFF, 256>(C.lds, g, S, E, C.tid); }
        } SEAM(pb + 13);
    }
#undef IN
#undef SEAM
}

extern "C" void kernel_launch(void* const* d_in, const int* in_sizes, int n_in, void* d_out, int out_size, void* d_ws, size_t ws_size, hipStream_t stream) {
    static int grid = 0;
    if (grid == 0) {
        if (n_in != N_IN || out_size != SEQ * D || ws_size < WS_END) { fprintf(stderr, "kernel_launch: unexpected shapes (n_in %d out %d ws %zu)\n", n_in, out_size, ws_size); grid = -1; return; }
        int dev = 0, cus = 0;
        if (hipGetDevice(&dev) != hipSuccess || hipDeviceGetAttribute(&cus, hipDeviceAttributeMultiprocessorCount, dev) != hipSuccess) { grid = -1; return; }
        if (hipFuncSetAttribute((const void*)mk_fwd, hipFuncAttributeMaxDynamicSharedMemorySize, LDS_BYTES) != hipSuccess) { fprintf(stderr, "kernel_launch: hipFuncSetAttribute failed\n"); grid = -1; return; }
        (void)hipGetLastError();
        grid = cus;
    }
    if (grid < 0) return;
    (void)hipMemsetAsync((char*)d_ws + OFF_CTL, 0, CTL_BYTES, stream);
    Args a{};
    for (int i = 0; i < N_IN; ++i) a.in[i] = (const float*)d_in[i];
    a.out = (float*)d_out; a.ws = (unsigned char*)d_ws;
#if MK_ONE_LAUNCH
    a.ph_lo = 0; a.ph_hi = N_PHASES;
    hipLaunchKernelGGL(mk_fwd, dim3(grid), dim3(NT), LDS_BYTES, stream, a);
#else
    for (int ph = 0; ph < N_PHASES; ++ph) {
        a.ph_lo = ph; a.ph_hi = ph + 1;
        hipLaunchKernelGGL(mk_fwd, dim3(grid), dim3(NT), LDS_BYTES, stream, a);
    }
#endif
}
```

```cpp
#include <hip/hip_runtime.h>
#include <cstdio>
#include <cstdint>

#ifndef PROBE_MODE
#define PROBE_MODE 0
#endif
#ifndef MK_ONE_LAUNCH
#define MK_ONE_LAUNCH 1
#endif

#define LAS __attribute__((address_space(3)))
#define GAS __attribute__((address_space(1)))
typedef unsigned short bf16_t;
typedef short bf16x8 __attribute__((ext_vector_type(8)));
typedef float f32x4 __attribute__((ext_vector_type(4)));
typedef float f32x2 __attribute__((ext_vector_type(2)));
typedef unsigned u32x4 __attribute__((ext_vector_type(4)));
typedef unsigned u32x2 __attribute__((ext_vector_type(2)));

constexpr int D = 2048, SEQ = 8192, CTX = 256, MT = SEQ + CTX, DEPTH = 2, DFF = 5632, NMOD = 9, MODW = NMOD * D;
constexpr int GRID_W = 64;
constexpr int PTOT = 15360, P32W = 4864, PAW = 2304, GLW = 8192;
constexpr int HG_OFF = 0, RW_OFF = 2560, RWC = 2304;
constexpr int NCH = MT / 64;
constexpr int NWAVES = 8, NT = 512;
constexpr float EPS = 1e-6f, RW_GN_EPS = 64e-5f;

constexpr size_t MiB = 1u << 20;
constexpr size_t OFF_CTL = 0, CTL_BYTES = 1 * MiB;
constexpr size_t OFF_W2T = 512 * 1024;
constexpr size_t OFF_MOD = 1 * MiB;
constexpr size_t OFF_MODP = 2 * MiB;
constexpr size_t OFF_WI1 = 11 * MiB, OFF_WO1 = 55 * MiB, OFF_WIN = 77 * MiB, OFF_WBR = 137 * MiB, OFF_WOUT = 145 * MiB, OFF_WI2 = 153 * MiB, OFF_WO2 = 197 * MiB;
constexpr size_t OFF_X = 219 * MiB;
constexpr size_t OFF_H = 285 * MiB;
constexpr size_t OFF_G = 318 * MiB;
constexpr size_t OFF_P32 = 409 * MiB;
constexpr size_t OFF_PA = 566 * MiB;
constexpr size_t OFF_GL = 604 * MiB;
constexpr size_t OFF_HGL = 736 * MiB;
constexpr size_t OFF_HGD = 802 * MiB;
constexpr size_t OFF_SCN = 803 * MiB;
constexpr size_t OFF_VV = 968 * MiB;
constexpr size_t OFF_GS = 985 * MiB;
constexpr size_t OFF_RO = 1002 * MiB;
constexpr size_t OFF_YB = 1035 * MiB;
constexpr size_t OFF_VTN = 1068 * MiB;
constexpr size_t OFF_VTW = 1077 * MiB;
constexpr size_t OFF_PB = 1080 * MiB;
constexpr size_t OFF_MREF = OFF_PB + 65536;
constexpr size_t OFF_SPT = 1081 * MiB;
constexpr size_t OFF_BON = 1114 * MiB;
constexpr size_t OFF_RO2 = 1115 * MiB;
constexpr size_t OFF_KTN = OFF_MODP;
constexpr size_t OFF_KTW = 1148 * MiB;
constexpr size_t WS_END = 1151 * MiB;
constexpr int RW_NCK = MT / 16;
constexpr size_t OFF_RWMG = OFF_G, RWMG_REC = 8192 + 2048;
constexpr size_t OFF_RWH = OFF_SCN, RWH_REC = 16384;
static_assert(16 * (size_t)RW_NCK * RWMG_REC <= 91 * MiB && 16 * (size_t)RW_NCK * RWH_REC <= 165 * MiB, "rwkv chunk records fit their regions");
constexpr int KSPLIT = 32;

constexpr int LDS_BYTES = 147456;
constexpr int RING_BYTES = 131072;
constexpr int MISC_OFF = RING_BYTES + 320;

__device__ __forceinline__ float bf2f(unsigned b) { return __uint_as_float(b << 16); }
__device__ __forceinline__ unsigned f2bf(float f) { unsigned u = __float_as_uint(f); return (u + 0x7fffu + ((u >> 16) & 1u)) >> 16; }
__device__ __forceinline__ unsigned pk2(float lo, float hi) { return f2bf(lo) | (f2bf(hi) << 16); }
__device__ __forceinline__ float wave_sum(float v) {
#pragma unroll
    for (int o = 1; o < 64; o <<= 1) v += __shfl_xor(v, o);
    return v;
}
__device__ __forceinline__ float wave_max(float v) {
#pragma unroll
    for (int o = 1; o < 64; o <<= 1) v = fmaxf(v, __shfl_xor(v, o));
    return v;
}
__device__ __forceinline__ float sigmoidf_(float x) { return 1.0f / (1.0f + expf(-x)); }
__device__ __forceinline__ float siluf_(float x) { return x / (1.0f + expf(-x)); }
typedef float f32x16 __attribute__((ext_vector_type(16)));
#define MFMA32(a, b, c) __builtin_amdgcn_mfma_f32_32x32x16_bf16((a), (b), (c), 0, 0, 0)
#define KOFF(reg) (((reg) & 3) + 8 * ((reg) >> 2))
#define MFMA16(a, b, c) __builtin_amdgcn_mfma_f32_16x16x32_bf16((a), (b), (c), 0, 0, 0)
#define LDS_WAIT() asm volatile("s_waitcnt lgkmcnt(0)" ::: "memory")

__device__ __forceinline__ int seq_row(int d, int j) { return d == 0 ? (j < CTX ? SEQ + j : j - CTX) : (MT - 1 - j); }
__device__ __forceinline__ int row_seq(int d, int r) { return d == 0 ? (r >= SEQ ? r - SEQ : r + CTX) : (MT - 1 - r); }

#define XB_TMO      128
#define XB_XCNT(j)  (256  + 64 * (j))
#define XB_XSUB(j)  (1280 + 64 * (j))
#define XB_XGEN(j)  (2304 + 64 * (j))
#define XB_TOP      3328
#define XB_TOPGEN   3392
#define XCD_BAR_WORDS 3456
#define XB_SPIN_CAP (1u << 18)
__device__ __forceinline__ unsigned xb_ld(unsigned* p)              { return __hip_atomic_load(p, __ATOMIC_RELAXED, __HIP_MEMORY_SCOPE_AGENT); }
__device__ __forceinline__ unsigned xb_add(unsigned* p, unsigned v) { return __hip_atomic_fetch_add(p, v, __ATOMIC_RELAXED, __HIP_MEMORY_SCOPE_AGENT); }
__device__ __forceinline__ unsigned xb_xcc_id() { return (unsigned)__builtin_amdgcn_s_getreg((3 << 11) | 20) & 0xFu; }
#define XB_SPIN(cond, bar) do { unsigned _sp = 0; while (cond) { __builtin_amdgcn_s_sleep(1); \
    if ((++_sp & 255u) == 0u) { if (xb_ld(&(bar)[XB_TMO])) break; if (_sp > XB_SPIN_CAP) { atomicAdd(&(bar)[XB_TMO], 1u); break; } } } } while (0)
struct XcdBarrier { unsigned* bar; unsigned x; volatile LAS unsigned* st; };
__device__ __forceinline__ XcdBarrier xcd_barrier_post(unsigned* bar, volatile LAS unsigned* st) {
    XcdBarrier b; b.bar = bar; b.x = xb_xcc_id(); b.st = st;
    if (threadIdx.x == 0) (void)xb_add(&bar[XB_XCNT(b.x)], 1u);
    return b;
}
__device__ __forceinline__ void xcd_barrier_complete(unsigned* bar, unsigned x, unsigned& nloc, unsigned& nx) {
    const unsigned G = gridDim.x * gridDim.y * gridDim.z;
    unsigned sum, cnt, mine, sp = 0u;
    for (;;) {
        sum = 0u; cnt = 0u; mine = 0u;
#pragma unroll
        for (unsigned j = 0; j < 16; ++j) { const unsigned c = xb_ld(&bar[XB_XCNT(j)]); sum += c; cnt += (c > 0u) ? 1u : 0u; mine = (j == x) ? c : mine; }
        if (sum == G) break;
        __builtin_amdgcn_s_sleep(1);
        if ((++sp & 255u) == 0u) { if (xb_ld(&bar[XB_TMO])) break; if (sp > XB_SPIN_CAP) { atomicAdd(&bar[XB_TMO], 1u); break; } }
    }
    nloc = mine > 0u ? mine : 1u; nx = cnt > 0u ? cnt : 1u;
}
__device__ __forceinline__ void xcd_barrier(const XcdBarrier& b) {
    asm volatile("s_waitcnt vmcnt(0)" ::: "memory");
    __syncthreads();
    if (threadIdx.x == 0) {
        unsigned* bar = b.bar;
        __builtin_amdgcn_s_waitcnt(0);
        unsigned nloc = b.st[0], nx = b.st[1];
        if (nloc == 0u) { xcd_barrier_complete(bar, b.x, nloc, nx); b.st[0] = nloc; b.st[1] = nx; }
        const unsigned old = xb_add(&bar[XB_XSUB(b.x)], 1u);
        const unsigned gen = old / nloc;
        if (old + 1u == (gen + 1u) * nloc) {
            __builtin_amdgcn_fence(__ATOMIC_RELEASE, "agent");
            asm volatile("s_waitcnt vmcnt(0)" ::: "memory");
            const unsigned og = xb_add(&bar[XB_TOP], 1u);
            const unsigned tg = og / nx;
            if (og + 1u == (tg + 1u) * nx) xb_add(&bar[XB_TOPGEN], 1u);
            else XB_SPIN(xb_ld(&bar[XB_TOPGEN]) == tg, bar);
            __builtin_amdgcn_fence(__ATOMIC_ACQUIRE, "agent");
            xb_add(&bar[XB_XGEN(b.x)], 1u);
            asm volatile("s_waitcnt vmcnt(0)" ::: "memory");
        } else {
            XB_SPIN(xb_ld(&bar[XB_XGEN(b.x)]) == gen, bar);
            __builtin_amdgcn_fence(__ATOMIC_ACQUIRE, "agent");
            asm volatile("s_waitcnt vmcnt(0)" ::: "memory");
        }
    }
    __syncthreads();
}

namespace pg8 {
constexpr int BM = 256, BK = 64, HALF = 128, HTB = HALF * BK * 2, STAGE_BYTES = 8 * HTB, NXCD = 8, WGM = 8;
__host__ __device__ __forceinline__ int lds_byte(int r, int c) { const int st = (r >> 4) * 2 + (c >> 5), rr = r & 15, cc = c & 31, ob = rr * 64 + cc * 2; return st * 1024 + (ob ^ (((ob >> 9) & 1) << 5)); }
__host__ __device__ __forceinline__ void stage_rc(int b, int& R, int& C) { const int st = b / 1024, sb = b % 1024, swz = sb ^ (((sb >> 9) & 1) << 5); R = (st >> 1) * 16 + swz / 64; C = (st & 1) * 32 + (swz % 64) / 2; }
__host__ __device__ __forceinline__ int perm32(int rho) { const int n = rho >> 4, i = rho & 15; return 8 * (i >> 2) + 4 * n + (i & 3); }
struct Unit { int pm, pn, ks; };
struct Gemm { const bf16_t* A; const bf16_t* Bt; int a_div; size_t a_gstride; };
struct StaticOrder {
    int nM, nN, nwg, G, c;
    __host__ __device__ void init(int M, int N, int G_, int c_) { nM = M / BM; nN = N / BM; nwg = nM * nN; G = G_; c = c_; }
    __host__ __device__ bool next(int i, Unit& u) const {
        const long L = (long)i * G + c; if (L >= nwg) return false;
        int wgid = (int)L; { const int q = nwg / NXCD, r = nwg % NXCD, xcd = wgid % NXCD, off = wgid / NXCD; wgid = (xcd < r ? xcd * (q + 1) : r * (q + 1) + (xcd - r) * q) + off; }
        const int nig = WGM * nN, gid = wgid / nig, fm = gid * WGM, gsz = (nM - fm) < WGM ? (nM - fm) : WGM;
        u.pm = fm + ((wgid % nig) % gsz); u.pn = (wgid % nig) / gsz; u.ks = 0; return true;
    }
};
struct SplitOrder {
    int pm, nN, KS, G, c;
    __host__ __device__ bool next(int i, Unit& u) const { const int L = i * G + c; if (L >= nN * KS) return false; u.pm = pm; u.pn = L / KS; u.ks = L % KS; return true; }
};
__device__ __forceinline__ unsigned cvt_pk_bf16(float lo, float hi) { unsigned r; asm volatile("v_cvt_pk_bf16_f32 %0, %1, %2" : "=v"(r) : "v"(lo), "v"(hi)); return r; }

template <class Epi, bool ALIGN_EPI, bool SP2, class Sched, int KE, int LDA, int LDB, int KSS>
__device__ __forceinline__ void gemm_phase(LAS unsigned char* lds, const Gemm g, const Sched& S, const Epi& E, const int tid) {
    const int wid = __builtin_amdgcn_readfirstlane(tid >> 6), lane = tid & 63, wr = wid >> 2, wc = wid & 3, fr = lane & 15, fq = lane >> 4;
    constexpr int nt = KE / BK;
    unsigned voffA[2], voffB[2];
#pragma unroll
    for (int i = 0; i < 2; ++i) { int R, C; stage_rc(tid * 16 + i * 8192, R, C); const int Rb = Epi::PERM ? ((R & ~31) + perm32(R & 31)) : R;
        voffA[i] = (unsigned)(R * LDA + C) * 2u; voffB[i] = (unsigned)(Rb * LDB + C) * 2u; }
    const size_t kstep = (size_t)(BK * 2);
    constexpr size_t hstepA = (size_t)HALF * LDA * 2, hstepB = (size_t)HALF * LDB * 2;
    const unsigned ldsw = (unsigned)wid * 1024u;
    const int aoff = lds_byte(wr * 64 + fr, fq * 8), boff = lds_byte(wc * 32 + fr, fq * 8);
#define PG8_SA(b, h) (((b) * 2 + (h)) * HTB)
#define PG8_SB(b, h) ((4 + (b) * 2 + (h)) * HTB)
#define PG8_STAGE(bufoff, gbase, voff) do { _Pragma("unroll") for (int _i = 0; _i < 2; ++_i) \
        __builtin_amdgcn_global_load_lds((const unsigned*)((const char*)(gbase) + (voff)[_i]), (LAS unsigned*)(lds + (bufoff) + ldsw + _i * 8192), 16, 0, 0); } while (0)
#define PG8_LDA(dst, b, h) do { _Pragma("unroll") for (int m = 0; m < 4; ++m) _Pragma("unroll") for (int k = 0; k < 2; ++k) dst[m][k] = *(const LAS bf16x8*)(lds + PG8_SA(b, h) + aoff + m * 2048 + k * 1024); } while (0)
#define PG8_LDB(dst, b, h) do { _Pragma("unroll") for (int n = 0; n < 2; ++n) _Pragma("unroll") for (int k = 0; k < 2; ++k) dst[n][k] = *(const LAS bf16x8*)(lds + PG8_SB(b, h) + boff + n * 2048 + k * 1024); } while (0)
#define PG8_MMA(ai, bj, At, Bt) do { __builtin_amdgcn_s_setprio(1); _Pragma("unroll") for (int m = 0; m < 4; ++m) _Pragma("unroll") for (int n = 0; n < 2; ++n) _Pragma("unroll") for (int k = 0; k < 2; ++k) \
        acc[ai][bj][m][n] = __builtin_amdgcn_mfma_f32_16x16x32_bf16(Bt[n][k], At[m][k], acc[ai][bj][m][n], 0, 0, 0); __builtin_amdgcn_s_setprio(0); } while (0)
#define PG8_WAIT_V(n) asm volatile("s_waitcnt vmcnt(" #n ")" ::: "memory")
#define PG8_WAIT_L(n) asm volatile("s_waitcnt lgkmcnt(" #n ")" ::: "memory")
#define PG8_BAR __builtin_amdgcn_s_barrier()
#define PG8_SCHED __builtin_amdgcn_sched_barrier(0)
#define PG8_ABASE(u) ((const char*)g.A + ((size_t)((u).pn / g.a_div) * g.a_gstride) * 2 + (size_t)(u).pm * 2 * hstepA + (size_t)(u).ks * KSS * 2)
#define PG8_BBASE(u) ((const char*)g.Bt + (size_t)(u).pn * 2 * hstepB + (size_t)(u).ks * KSS * 2)
    Unit cur, nxt; int ui = 0;
    if (!S.next(0, cur)) return;
    f32x4 acc[2][2][4][2];
#pragma unroll
    for (int a = 0; a < 2; ++a)
#pragma unroll
        for (int b = 0; b < 2; ++b)
#pragma unroll
            for (int m = 0; m < 4; ++m)
#pragma unroll
                for (int n = 0; n < 2; ++n) acc[a][b][m][n] = (f32x4){0.f, 0.f, 0.f, 0.f};
    bf16x8 At[4][2], B0[2][2], B1[2][2];
    const char* cA = PG8_ABASE(cur); const char* cB = PG8_BBASE(cur);
    if constexpr (SP2) {
        PG8_STAGE(PG8_SB(0, 0), cB, voffB); PG8_STAGE(PG8_SB(0, 1), cB + hstepB, voffB); PG8_STAGE(PG8_SA(0, 0), cA, voffA); PG8_STAGE(PG8_SA(0, 1), cA + hstepA, voffA);
        if (wr == 1) PG8_BAR;
        PG8_WAIT_V(2); PG8_BAR;
        PG8_STAGE(PG8_SB(1, 0), cB + kstep, voffB); PG8_STAGE(PG8_SA(1, 0), cA + kstep, voffA); PG8_STAGE(PG8_SB(1, 1), cB + hstepB + kstep, voffB);
        PG8_WAIT_V(6); PG8_BAR;
    } else {
        PG8_STAGE(PG8_SB(0, 0), cB, voffB); PG8_STAGE(PG8_SA(0, 0), cA, voffA); PG8_STAGE(PG8_SB(0, 1), cB + hstepB, voffB); PG8_STAGE(PG8_SA(0, 1), cA + hstepA, voffA);
        if (wr == 1) PG8_BAR;
        PG8_WAIT_V(4); PG8_BAR;
        PG8_STAGE(PG8_SB(1, 0), cB + kstep, voffB); PG8_STAGE(PG8_SA(1, 0), cA + kstep, voffA); PG8_STAGE(PG8_SB(1, 1), cB + hstepB + kstep, voffB);
        PG8_WAIT_V(6); PG8_BAR;
    }
    for (;;) {
        const bool has_next = S.next(ui + 1, nxt);
        const char* nA = has_next ? PG8_ABASE(nxt) : cA; const char* nB = has_next ? PG8_BBASE(nxt) : cB;
#pragma unroll 1
        for (int t = 0; t < nt; t += 2) {
            const bool last = (t == nt - 2);
            const char* a1 = cA + (size_t)(t + 1) * kstep;
            const char* a2 = last ? nA : cA + (size_t)(t + 2) * kstep; const char* b2 = last ? nB : cB + (size_t)(t + 2) * kstep;
            const char* a3 = a2 + kstep; const char* b3 = b2 + kstep;
            if constexpr (SP2) {
            PG8_LDB(B0, 0, 0); PG8_LDB(B1, 0, 1); PG8_SCHED; PG8_LDA(At, 0, 0); PG8_STAGE(PG8_SA(1, 1), a1 + hstepA, voffA);
            PG8_WAIT_V(8); PG8_WAIT_L(0); PG8_BAR; PG8_MMA(0, 0, At, B0); PG8_MMA(0, 1, At, B1); PG8_BAR; PG8_SCHED;
            PG8_LDA(At, 0, 1); PG8_STAGE(PG8_SB(0, 0), b2, voffB); PG8_STAGE(PG8_SB(0, 1), b2 + hstepB, voffB); PG8_STAGE(PG8_SA(0, 0), a2, voffA);
            PG8_WAIT_V(8); PG8_WAIT_L(0); PG8_BAR; PG8_MMA(1, 0, At, B0); PG8_MMA(1, 1, At, B1); PG8_BAR; PG8_SCHED;
            PG8_LDB(B0, 1, 0); PG8_LDB(B1, 1, 1); PG8_SCHED; PG8_LDA(At, 1, 0); PG8_STAGE(PG8_SA(0, 1), a2 + hstepA, voffA);
            PG8_WAIT_V(8); PG8_WAIT_L(0); PG8_BAR; PG8_MMA(0, 0, At, B0); PG8_MMA(0, 1, At, B1); PG8_BAR; PG8_SCHED;
            PG8_LDA(At, 1, 1); PG8_STAGE(PG8_SB(1, 0), b3, voffB); PG8_STAGE(PG8_SB(1, 1), b3 + hstepB, voffB); PG8_STAGE(PG8_SA(1, 0), a3, voffA);
            PG8_WAIT_V(8); PG8_WAIT_L(0); PG8_BAR; PG8_MMA(1, 0, At, B0); PG8_MMA(1, 1, At, B1); PG8_BAR; PG8_SCHED;
            } else {
            PG8_LDB(B0, 0, 0); PG8_SCHED; PG8_LDA(At, 0, 0); PG8_STAGE(PG8_SA(1, 1), a1 + hstepA, voffA);
            PG8_WAIT_L(8); PG8_BAR; PG8_WAIT_L(0); PG8_MMA(0, 0, At, B0); PG8_BAR; PG8_SCHED;
            PG8_LDB(B1, 0, 1); PG8_STAGE(PG8_SB(0, 0), b2, voffB);
            PG8_BAR; PG8_WAIT_L(0); PG8_MMA(0, 1, At, B1); PG8_BAR;
            PG8_LDA(At, 0, 1); PG8_STAGE(PG8_SA(0, 0), a2, voffA);
            PG8_BAR; PG8_WAIT_L(0); PG8_MMA(1, 0, At, B0); PG8_BAR; PG8_SCHED;
            PG8_STAGE(PG8_SB(0, 1), b2 + hstepB, voffB);
            PG8_WAIT_V(6); PG8_BAR; PG8_MMA(1, 1, At, B1); PG8_BAR;
            PG8_LDB(B0, 1, 0); PG8_SCHED; PG8_LDA(At, 1, 0); PG8_STAGE(PG8_SA(0, 1), a2 + hstepA, voffA);
            PG8_WAIT_L(8); PG8_BAR; PG8_WAIT_L(0); PG8_MMA(0, 0, At, B0); PG8_BAR; PG8_SCHED;
            PG8_LDB(B1, 1, 1); PG8_STAGE(PG8_SB(1, 0), b3, voffB);
            PG8_BAR; PG8_WAIT_L(0); PG8_MMA(0, 1, At, B1); PG8_BAR;
            PG8_LDA(At, 1, 1); PG8_STAGE(PG8_SA(1, 0), a3, voffA);
            PG8_BAR; PG8_WAIT_L(0); PG8_MMA(1, 0, At, B0); PG8_BAR; PG8_SCHED;
            PG8_STAGE(PG8_SB(1, 1), b3 + hstepB, voffB);
            PG8_WAIT_V(6); PG8_BAR; PG8_MMA(1, 1, At, B1); PG8_BAR;
            }
        }
        if constexpr (ALIGN_EPI) { if (wr == 0) PG8_BAR; }
        { int fr2 = fr, fq2 = fq; asm volatile("" : "+v"(fr2), "+v"(fq2));
          E(acc, cur, wr, wc, fr2, fq2); }
        if (!has_next) break;
#pragma unroll
        for (int a = 0; a < 2; ++a)
#pragma unroll
            for (int b = 0; b < 2; ++b)
#pragma unroll
                for (int m = 0; m < 4; ++m)
#pragma unroll
                    for (int n = 0; n < 2; ++n) acc[a][b][m][n] = (f32x4){0.f, 0.f, 0.f, 0.f};
        cur = nxt; cA = nA; cB = nB; ++ui;
        if constexpr (ALIGN_EPI) { if (wr == 1) PG8_BAR; }
    }
    PG8_WAIT_V(0);
    if constexpr (!ALIGN_EPI) { if (wr == 0) PG8_BAR; }
    PG8_BAR;
#undef PG8_SA
#undef PG8_SB
#undef PG8_STAGE
#undef PG8_LDA
#undef PG8_LDB
#undef PG8_MMA
#undef PG8_WAIT_V
#undef PG8_WAIT_L
#undef PG8_BAR
#undef PG8_SCHED
#undef PG8_ABASE
#undef PG8_BBASE
}

struct EpiSwiGLU {
    static constexpr bool PERM = true;
    bf16_t* O;
    __device__ __forceinline__ void operator()(const f32x4 (&acc)[2][2][4][2], const Unit& u, int wr, int wc, int fr, int fq) const {
        const int row0 = u.pm * BM + wr * 64 + fr, col0 = u.pn * HALF + wc * 32 + 8 * fq;
#pragma unroll
        for (int ai = 0; ai < 2; ++ai)
#pragma unroll
            for (int m = 0; m < 4; ++m) {
                bf16_t* rowp = O + (size_t)(row0 + ai * HALF + m * 16) * DFF + col0;
                float o[8];
#pragma unroll
                for (int n = 0; n < 2; ++n)
#pragma unroll
                    for (int j = 0; j < 4; ++j) { const float a = acc[ai][0][m][n][j], b = acc[ai][1][m][n][j]; o[n * 4 + j] = a / (1.0f + __expf(-a)) * b; }
                u32x4 w; w.x = cvt_pk_bf16(o[0], o[1]); w.y = cvt_pk_bf16(o[2], o[3]); w.z = cvt_pk_bf16(o[4], o[5]); w.w = cvt_pk_bf16(o[6], o[7]);
                *(u32x4*)rowp = w;
            }
    }
};
template <bool HALFGATE> struct EpiResid {
    static constexpr bool PERM = false;
    float* X; const float* gate_lat; const float* gate_ctx; float* out; const float* base;
    __device__ __forceinline__ void operator()(const f32x4 (&acc)[2][2][4][2], const Unit& u, int wr, int wc, int fr, int fq) const {
        const int row0 = u.pm * BM + wr * 64 + fr, col0 = u.pn * BM + wc * 32 + 4 * fq;
        const float* gp = (u.pm * BM >= SEQ) ? gate_ctx : gate_lat;
#pragma unroll
        for (int bj = 0; bj < 2; ++bj)
#pragma unroll
            for (int n = 0; n < 2; ++n) {
                const f32x4 gv = *(const f32x4*)(gp + col0 + bj * HALF + n * 16) * (HALFGATE ? 0.5f : 1.0f);
#pragma unroll
                for (int ai = 0; ai < 2; ++ai)
#pragma unroll
                    for (int m = 0; m < 4; ++m) {
                        const int row = row0 + ai * HALF + m * 16;
                        float* p = X + (size_t)row * D + col0 + bj * HALF + n * 16;
                        const f32x4 v = *(const f32x4*)(base + (size_t)row * D + col0 + bj * HALF + n * 16) + gv * acc[ai][bj][m][n];
                        *(f32x4*)p = v;
                        if (out != nullptr && row < SEQ) *(f32x4*)(out + (size_t)row * D + col0 + bj * HALF + n * 16) = v;
                    }
            }
    }
};
template <bool HALFGATE> struct EpiPart {
    static constexpr bool PERM = false;
    float* PART; const float* gate_ctx;
    __device__ __forceinline__ void operator()(const f32x4 (&acc)[2][2][4][2], const Unit& u, int wr, int wc, int fr, int fq) const {
        const int row0 = wr * 64 + fr, col0 = u.pn * BM + wc * 32 + 4 * fq;
        f32x4 gv[2][2];
#pragma unroll
        for (int bj = 0; bj < 2; ++bj)
#pragma unroll
            for (int n = 0; n < 2; ++n) gv[bj][n] = *(const f32x4*)(gate_ctx + col0 + bj * HALF + n * 16) * (HALFGATE ? 0.5f : 1.0f);
#pragma unroll
        for (int ai = 0; ai < 2; ++ai)
#pragma unroll
            for (int m = 0; m < 4; ++m) {
                float* rowp = PART + ((size_t)u.ks * BM + row0 + ai * HALF + m * 16) * D + col0;
#pragma unroll
                for (int bj = 0; bj < 2; ++bj)
#pragma unroll
                    for (int n = 0; n < 2; ++n) *(f32x4*)(rowp + bj * HALF + n * 16) = gv[bj][n] * acc[ai][bj][m][n];
            }
    }
};
struct EpiWin {
    static constexpr bool PERM = true;
    float* P32; bf16_t* PA; bf16_t* GL; long pn_off;
    __device__ __forceinline__ void operator()(const f32x4 (&acc)[2][2][4][2], const Unit& u0, int wr, int wc, int fr, int fq) const {
        Unit u; u.pm = u0.pm; u.pn = u0.pn + (int)pn_off;
        const int row0 = u.pm * BM + wr * 64 + fr, cin = wc * 32 + 8 * fq;
        if (u.pn < 19) {
#pragma unroll
            for (int ai = 0; ai < 2; ++ai)
#pragma unroll
                for (int m = 0; m < 4; ++m) { float* rowp = P32 + (size_t)(row0 + ai * HALF + m * 16) * P32W + u.pn * BM + cin;
#pragma unroll
                    for (int bj = 0; bj < 2; ++bj) { *(f32x4*)(rowp + bj * HALF) = acc[ai][bj][m][0]; *(f32x4*)(rowp + bj * HALF + 4) = acc[ai][bj][m][1]; } }
        } else {
            bf16_t* base; int ld, colt;
            if (u.pn < 28) { base = PA; ld = PAW; colt = (u.pn - 19) * BM; } else { base = GL; ld = GLW; colt = (u.pn - 28) * BM; }
#pragma unroll
            for (int ai = 0; ai < 2; ++ai)
#pragma unroll
                for (int m = 0; m < 4; ++m) { bf16_t* rowp = base + (size_t)(row0 + ai * HALF + m * 16) * ld + colt + cin;
#pragma unroll
                    for (int bj = 0; bj < 2; ++bj) { const f32x4 v0 = acc[ai][bj][m][0], v1 = acc[ai][bj][m][1];
                        u32x4 w; w.x = cvt_pk_bf16(v0[0], v0[1]); w.y = cvt_pk_bf16(v0[2], v0[3]); w.z = cvt_pk_bf16(v1[0], v1[1]); w.w = cvt_pk_bf16(v1[2], v1[3]);
                        *(u32x4*)(rowp + bj * HALF) = w; } }
        }
    }
};
struct EpiMerge {
    static constexpr bool PERM = true;
    const bf16_t* GL; bf16_t* PROJ;
    __device__ __forceinline__ void operator()(const f32x4 (&acc)[2][2][4][2], const Unit& u, int wr, int wc, int fr, int fq) const {
        const int row0 = u.pm * BM + wr * 64 + fr, col0 = u.pn * BM + wc * 32 + 8 * fq;
#pragma unroll
        for (int ai = 0; ai < 2; ++ai)
#pragma unroll
            for (int m = 0; m < 4; ++m) { const size_t ro = (size_t)(row0 + ai * HALF + m * 16) * GLW + col0;
#pragma unroll
                for (int bj = 0; bj < 2; ++bj) {
                    const u32x4 gw = *(const u32x4*)(GL + ro + bj * HALF);
                    const f32x4 v0 = acc[ai][bj][m][0], v1 = acc[ai][bj][m][1];
                    float o[8];
                    o[0] = v0[0] / (1.0f + __expf(-bf2f(gw.x & 0xffffu))); o[1] = v0[1] / (1.0f + __expf(-bf2f(gw.x >> 16)));
                    o[2] = v0[2] / (1.0f + __expf(-bf2f(gw.y & 0xffffu))); o[3] = v0[3] / (1.0f + __expf(-bf2f(gw.y >> 16)));
                    o[4] = v1[0] / (1.0f + __expf(-bf2f(gw.z & 0xffffu))); o[5] = v1[1] / (1.0f + __expf(-bf2f(gw.z >> 16)));
                    o[6] = v1[2] / (1.0f + __expf(-bf2f(gw.w & 0xffffu))); o[7] = v1[3] / (1.0f + __expf(-bf2f(gw.w >> 16)));
                    u32x4 w; w.x = cvt_pk_bf16(o[0], o[1]); w.y = cvt_pk_bf16(o[2], o[3]); w.z = cvt_pk_bf16(o[4], o[5]); w.w = cvt_pk_bf16(o[6], o[7]);
                    *(u32x4*)(PROJ + ro + bj * HALF) = w; } }
    }
};
}

enum { I_X = 0, I_C, I_CTX, I_CCTX, I_ADAW, I_ADAB, I_NF1, I_NMIX, I_NF2, I_F1WI, I_F1WO, I_F2WI, I_F2WO, I_WIN, I_HGLB, I_HGNORM, I_RWSHIFT, I_RWW0, I_RWW2, I_RWA0, I_RWA2,
       I_RWKK, I_RWKA, I_RWRK, I_RWLNW, I_RWLNB, I_NAQN, I_NAKN, I_NARPB, I_WAQN, I_WAKN, I_WASINK, I_WBR, I_WOUT, N_IN };
struct Args { const float* in[N_IN]; float* out; unsigned char* ws; int ph_lo, ph_hi; };
struct Ctx {
    LAS unsigned char* lds;
    int tid, lane, wave, bid, G;
    const Args __attribute__((address_space(4)))* ka; float* out; unsigned char* ws;
};
#define WSP(T, off) ((T*)(C.ws + (off)))
__device__ __forceinline__ void relaunder(Ctx& C) {
    int t = C.tid, b = C.bid, g = C.G;
    asm volatile("" : "+v"(t), "+v"(b), "+v"(g));
    C.tid = t; C.lane = t & 63; C.wave = __builtin_amdgcn_readfirstlane(t >> 6); C.bid = __builtin_amdgcn_readfirstlane(b); C.G = __builtin_amdgcn_readfirstlane(g);
}

__device__ __forceinline__ void transpose_item(const float* W, int K, int N, bf16_t* WT, int mode, LAS float* scr, int item, int lane) {
    const int nblk = N / 32, kb = item / nblk, nb = item % nblk, k0 = 64 * kb, n0 = 32 * nb;
    int drow0 = n0;
    if (mode == 1) { const int half = n0 / DFF, j0 = n0 % DFF; drow0 = 256 * (j0 / 128) + 128 * half + (j0 % 128); }
#pragma unroll 8
    for (int i = 0; i < 32; ++i) { const int kk = 2 * i + (lane >> 5); scr[kk * 33 + (lane & 31)] = W[(size_t)(k0 + kk) * N + n0 + (lane & 31)]; }
    LDS_WAIT(); asm volatile("" ::: "memory");
    const int c = lane & 7;
#pragma unroll
    for (int j = 0; j < 4; ++j) { const int n = (lane >> 3) + 8 * j; const LAS float* s = scr + (8 * c) * 33 + n;
        u32x4 o; o.x = pk2(s[0 * 33], s[1 * 33]); o.y = pk2(s[2 * 33], s[3 * 33]); o.z = pk2(s[4 * 33], s[5 * 33]); o.w = pk2(s[6 * 33], s[7 * 33]);
        *(u32x4*)(WT + (size_t)(drow0 + n) * K + k0 + 8 * c) = o; }
    LDS_WAIT(); asm volatile("" ::: "memory");
}
__device__ __forceinline__ void phase_convert(Ctx& C, int l, int mask, int b0, int nbk) {
    LAS float* scr = (LAS float*)(C.lds + C.wave * 16384);
    const int gw = b0 * NWAVES + C.wave, NGW = nbk * NWAVES;
    constexpr int I_WI = (D / 64) * (2 * DFF / 32), I_WO = (DFF / 64) * (D / 32), I_IN = (D / 64) * (PTOT / 32), I_BR = (512 / 64) * (D / 32), I_OUT = (D / 64) * (D / 32);
    constexpr int NITEMS = 2 * I_WI + 2 * I_WO + I_IN + 4 * I_BR + I_OUT;
    for (int it = gw; it < NITEMS; it += NGW) {
        int r = it;
        if (r < I_WI) { if (mask & 1) transpose_item(C.ka->in[I_F1WI] + (size_t)l * D * 2 * DFF, D, 2 * DFF, WSP(bf16_t, OFF_WI1), 1, scr, r, C.lane); continue; } r -= I_WI;
        if (r < I_WI) { if (mask & 2) transpose_item(C.ka->in[I_F2WI] + (size_t)l * D * 2 * DFF, D, 2 * DFF, WSP(bf16_t, OFF_WI2), 1, scr, r, C.lane); continue; } r -= I_WI;
        if (r < I_WO) { if (mask & 4) transpose_item(C.ka->in[I_F1WO] + (size_t)l * DFF * D, DFF, D, WSP(bf16_t, OFF_WO1), 0, scr, r, C.lane); continue; } r -= I_WO;
        if (r < I_WO) { if (mask & 8) transpose_item(C.ka->in[I_F2WO] + (size_t)l * DFF * D, DFF, D, WSP(bf16_t, OFF_WO2), 0, scr, r, C.lane); continue; } r -= I_WO;
        if (r < I_IN) { if (mask & 16) transpose_item(C.ka->in[I_WIN] + (size_t)l * D * PTOT, D, PTOT, WSP(bf16_t, OFF_WIN), 0, scr, r, C.lane); continue; } r -= I_IN;
        if (r < 4 * I_BR) { const int g = r / I_BR; if (mask & 32) transpose_item(C.ka->in[I_WBR] + ((size_t)l * 4 + g) * 512 * D, 512, D, WSP(bf16_t, OFF_WBR) + (size_t)g * D * 512, 0, scr, r % I_BR, C.lane); continue; } r -= 4 * I_BR;
        if (mask & 64) transpose_item(C.ka->in[I_WOUT] + (size_t)l * D * D, D, D, WSP(bf16_t, OFF_WOUT), 0, scr, r, C.lane);
    }
    if (!(mask & 64)) return;
    bf16_t* W2T = WSP(bf16_t, OFF_W2T);
    for (int idx = b0 * NT + C.tid; idx < 2 * 2 * 512 * 8; idx += nbk * NT) {
        const int k8 = idx & 7, col = (idx >> 3) & 511, m = (idx >> 12) & 1, d = idx >> 13;
        const float* src = (m == 0 ? C.ka->in[I_RWW2] : C.ka->in[I_RWA2]) + ((size_t)(l * 2 + d) * 64 + 8 * k8) * 512 + col;
        u32x4 w; w.x = pk2(src[0], src[512]); w.y = pk2(src[1024], src[1536]); w.z = pk2(src[2048], src[2560]); w.w = pk2(src[3072], src[3584]);
        *(u32x4*)(W2T + ((size_t)((d * 2 + m) * 512 + col) * 64 + 8 * k8)) = w;
    }
}

__device__ __forceinline__ void phase_ada_partial(Ctx& C) {
    float* modp = WSP(float, OFF_MODP);
    for (int u = C.bid; u < DEPTH * 9 * KSPLIT; u += C.G) {
        const int l = u / (9 * KSPLIT), rem = u % (9 * KSPLIT), cg = rem / KSPLIT, ks = rem % KSPLIT;
        const int col = cg * 2048 + C.tid * 4;
        const float* W = C.ka->in[I_ADAW] + (size_t)l * D * MODW;
        f32x4 a0 = {0.f, 0.f, 0.f, 0.f}, a1 = {0.f, 0.f, 0.f, 0.f};
#pragma unroll 16
        for (int i = ks * 64; i < ks * 64 + 64; ++i) {
            const float c0 = C.ka->in[I_C][i], c1 = C.ka->in[I_CCTX][i];
            const float s0 = siluf_(c0), s1 = siluf_(c1);
            const f32x4 w = *(const f32x4*)(W + (size_t)i * MODW + col);
            a0 += w * s0; a1 += w * s1;
        }
        *(f32x4*)(modp + ((size_t)(l * KSPLIT + ks) * 2 + 0) * MODW + col) = a0;
        *(f32x4*)(modp + ((size_t)(l * KSPLIT + ks) * 2 + 1) * MODW + col) = a1;
    }
}
__device__ __forceinline__ void phase_ada_reduce(Ctx& C) {
    const float* modp = WSP(float, OFF_MODP); float* mod = WSP(float, OFF_MOD);
    for (int e = C.bid * NT + C.tid; e < DEPTH * 2 * MODW; e += C.G * NT) {
        const int l = e / (2 * MODW), s = (e / MODW) % 2, j = e % MODW;
        float a = C.ka->in[I_ADAB][(size_t)l * MODW + j];
        for (int ks = 0; ks < KSPLIT; ++ks) a += modp[((size_t)(l * KSPLIT + ks) * 2 + s) * MODW + j];
        mod[e] = a;
    }
}
__device__ __forceinline__ const float* mod_ptr(Ctx& C, int l, int s, int idx) { return WSP(float, OFF_MOD) + ((size_t)(l * 2 + s) * NMOD + idx) * D; }

__device__ __forceinline__ void phase_norm(Ctx& C, int l, const float* gw  , int shift_idx, int nparts, int rows, int src) {
    const int gwv = C.bid * NWAVES + C.wave, NGW = C.G * NWAVES;
    float* X = WSP(float, OFF_X); bf16_t* H = WSP(bf16_t, OFF_H); const float* PART = WSP(float, OFF_P32);
    for (int r = gwv; r < rows; r += NGW) {
        const int s = r >= SEQ ? 1 : 0;
        const float* sh = mod_ptr(C, l, s, shift_idx); const float* sc = mod_ptr(C, l, s, shift_idx + 1);
        f32x4* xr = (f32x4*)(X + (size_t)r * D) + C.lane;
        const f32x4* xin = (src == 0 || (src == 2 && s == 0)) ? (const f32x4*)xr : (s == 0 ? (const f32x4*)(C.ka->in[I_X] + (size_t)r * D) + C.lane : (const f32x4*)(C.ka->in[I_CTX] + (size_t)(r - SEQ) * D) + C.lane);
        f32x4 v[8]; float ss = 0.f;
#pragma unroll
        for (int j = 0; j < 8; ++j) v[j] = xin[64 * j];
        if (s == 1 && nparts > 0) {
            for (int ks = 0; ks < nparts; ++ks) {
                const f32x4* pr = (const f32x4*)(PART + ((size_t)ks * 256 + (r - SEQ)) * D) + C.lane;
#pragma unroll
                for (int j = 0; j < 8; ++j) v[j] += pr[64 * j];
            }
#pragma unroll
            for (int j = 0; j < 8; ++j) xr[64 * j] = v[j];
        }
#pragma unroll
        for (int j = 0; j < 8; ++j) ss += (v[j].x * v[j].x + v[j].y * v[j].y) + (v[j].z * v[j].z + v[j].w * v[j].w);
        const float rstd = rsqrtf(wave_sum(ss) * (1.0f / D) + EPS);
        u32x2* o8 = (u32x2*)(H + (size_t)r * D) + C.lane;
#pragma unroll
        for (int j = 0; j < 8; ++j) {
            const int c = (64 * j + C.lane) * 4;
            const f32x4 g4 = *(const f32x4*)(gw + c), s4 = *(const f32x4*)(sc + c), h4 = *(const f32x4*)(sh + c);
            const f32x4 y = (v[j] * rstd) * g4 * (s4 + 1.0f) + h4;
            u32x2 w; w.x = pk2(y.x, y.y); w.y = pk2(y.z, y.w); o8[64 * j] = w;
        }
    }
}

__device__ __forceinline__ float xrow_sum(float x) {
    auto s = __builtin_amdgcn_permlane16_swap(__float_as_uint(x), __float_as_uint(x), false, false);
    x = __uint_as_float(s[0]) + __uint_as_float(s[1]);
    auto t = __builtin_amdgcn_permlane32_swap(__float_as_uint(x), __float_as_uint(x), false, false);
    return __uint_as_float(t[0]) + __uint_as_float(t[1]);
}
template <int CTRL> __device__ __forceinline__ float dppf(float x) { return __builtin_bit_cast(float, __builtin_amdgcn_mov_dpp(__builtin_bit_cast(int, x), CTRL, 0xf, 0xf, true)); }
__device__ __forceinline__ float row16_sum(float x) { x += dppf<0xB1>(x); x += dppf<0x4E>(x); x += dppf<0x124>(x); x += dppf<0x128>(x); return x; }
__device__ __forceinline__ float wave_sum_fast(float x) { return xrow_sum(row16_sum(x)); }
#define WAVE_LDS_FENCE() asm volatile("s_waitcnt lgkmcnt(0)" ::: "memory")
__device__ __forceinline__ void phase_rw_prep(Ctx& C, int l, int b0, int nb) {
    constexpr int TB = 16;
    const float* P = WSP(float, OFF_P32); float* VV = WSP(float, OFF_VV); float* GS = WSP(float, OFF_GS); float* RO = WSP(float, OFF_RO); float* BON = WSP(float, OFF_BON);
    LAS float* lin = (LAS float*)C.lds;
    LAS unsigned char* wl = C.lds + 16384 + C.wave * 14592;
    LAS unsigned char* RA = wl; LAS float* MAT = (LAS float*)(wl + 10496);
    const float* taps = C.ka->in[I_RWSHIFT] + (size_t)l * 3 * RWC;
    const int c = C.tid, h = c >> 6, e = c & 63, lane = C.lane;
    const float kkw = C.ka->in[I_RWKK][l * 512 + c], kaw = C.ka->in[I_RWKA][l * 512 + c], rkw = C.ka->in[I_RWRK][l * 512 + c];
    for (int unit = b0; unit < 2 * RW_NCK; unit += nb) {
        const int grp = unit >> 1, d = unit & 1;
        const int r0 = grp * TB;
        const bool hp0 = (r0 != 0 && r0 != SEQ), hnl = (r0 + TB != SEQ && r0 + TB != MT);
        __syncthreads();
        { int c_ = C.tid; asm volatile("" : "+v"(c_)); const int c = c_;
        if (c < 128) {
            const int col = 2048 + (c < 64 ? d * 64 + c : 128 + d * 64 + (c - 64));
            const float t0 = taps[col], t1 = taps[RWC + col], t2 = taps[2 * RWC + col];
            const float* pc = P + (size_t)r0 * P32W + RW_OFF + col;
            float prev = hp0 ? pc[-(long)P32W] : 0.f, cur = pc[0];
#pragma unroll
            for (int t = 0; t < TB; ++t) {
                const float nxt = (t + 1 < TB || hnl) ? pc[(size_t)(t + 1) * P32W] : 0.f;
                const float v = t0 * prev + t1 * cur + t2 * nxt;
                *(LAS bf16_t*)((LAS unsigned char*)lin + ((c >> 6) * 16 + t) * 144 + 2 * (c & 63)) = (bf16_t)f2bf(c < 64 ? 1.0f - 2.0f * __builtin_amdgcn_rcpf(1.0f + __expf(2.0f * v)) : v);
                prev = cur; cur = nxt;
            }
        }
        if (d == 0) {
            const int col = 3 * 512 + c;
            const float t0 = taps[col], t1 = taps[RWC + col], t2 = taps[2 * RWC + col];
            const float* pc = P + (size_t)r0 * P32W + RW_OFF + col;
            float prev = hp0 ? pc[-(long)P32W] : 0.f, cur = pc[0];
#pragma unroll
            for (int t = 0; t < TB; ++t) {
                const float nxt = (t + 1 < TB || hnl) ? pc[(size_t)(t + 1) * P32W] : 0.f;
                const float v = t0 * prev + t1 * cur + t2 * nxt;
                GS[(size_t)(r0 + t) * 512 + c] = __builtin_amdgcn_rcpf(1.0f + __expf(-v));
                prev = cur; cur = nxt;
            }
        }
        }
        __syncthreads();
        {
            int ln_ = C.lane; asm volatile("" : "+v"(ln_));
            const int lane = ln_, e = ln_, c = h * 64 + ln_;
            float xr[TB], xk[TB], xv[TB], kkn[TB];
#pragma unroll
            for (int q = 0; q < 3; ++q) {
                const int col = q * 512 + c;
                const float t0 = taps[col], t1 = taps[RWC + col], t2 = taps[2 * RWC + col];
                const float* pc = P + (size_t)r0 * P32W + RW_OFF + col;
                float prev = hp0 ? pc[-(long)P32W] : 0.f, cur = pc[0];
#pragma unroll
                for (int t = 0; t < TB; ++t) {
                    const float nxt = (t + 1 < TB || hnl) ? pc[(size_t)(t + 1) * P32W] : 0.f;
                    const float v = t0 * prev + t1 * cur + t2 * nxt;
                    if (q == 0) xr[t] = v; else if (q == 1) xk[t] = v; else { xv[t] = v; if (d == 0) VV[(size_t)(r0 + t) * 512 + c] = v; }
                    prev = cur; cur = nxt;
                }
            }
#pragma unroll
            for (int t = 0; t < TB; ++t) { const float kk0 = xk[t] * kkw; kkn[t] = kk0 * rsqrtf(wave_sum_fast(kk0 * kk0) + EPS); }
            __builtin_amdgcn_sched_barrier(0);
            float At[TB], Rt[TB], Vs[TB];
            unsigned Btp[TB / 2], Ktp[TB / 2];
            float gam;
            {
                float z[TB], az[TB];
                {
                    const bf16_t* W2T = WSP(bf16_t, OFF_W2T);
                    LAS float* ZB = (LAS float*)RA;
                    const int tl = lane & 15, q4 = lane >> 4;
#pragma unroll
                    for (int m = 0; m < 2; ++m) {
                        bf16x8 af[2];
#pragma unroll
                        for (int s2 = 0; s2 < 2; ++s2) af[s2] = *(const LAS bf16x8*)((LAS unsigned char*)lin + (m * 16 + tl) * 144 + s2 * 64 + q4 * 16);
#pragma unroll
                        for (int nt4 = 0; nt4 < 4; ++nt4) {
                            const bf16_t* bp = W2T + ((size_t)((d * 2 + m) * 512 + h * 64 + 16 * nt4 + tl) * 64 + 8 * q4);
                            f32x4 a4 = {0.f, 0.f, 0.f, 0.f};
#pragma unroll
                            for (int s2 = 0; s2 < 2; ++s2) a4 = MFMA16(af[s2], *(const bf16x8*)(bp + 32 * s2), a4);
#pragma unroll
                            for (int reg = 0; reg < 4; ++reg) ZB[(m * 16 + 4 * q4 + reg) * 64 + 16 * nt4 + tl] = a4[reg];
                        }
                    }
                    WAVE_LDS_FENCE();
                    const float zb = C.ka->in[I_RWW0][(l * 2 + d) * 512 + c], ab = C.ka->in[I_RWA0][(l * 2 + d) * 512 + c];
#pragma unroll
                    for (int t = 0; t < TB; ++t) { z[t] = zb + ZB[t * 64 + e]; az[t] = ab + ZB[(16 + t) * 64 + e]; }
                    WAVE_LDS_FENCE();
                }
                float g = 1.0f, btp = 0.f, ktp = 0.f;
#pragma unroll
                for (int i = 0; i < TB; ++i) {
                    const int t = d ? TB - 1 - i : i;
                    const float y = -z[t]; const float sp = fmaxf(y, 0.f) + __logf(1.0f + __expf(-fabsf(y)));
                    const float decay = __expf(-__expf(-sp - 0.5f));
                    const float a = __builtin_amdgcn_rcpf(1.0f + __expf(-az[t]));
                    const float kd = xk[t] * (1.0f + (a - 1.0f) * kaw);
                    { const float bsum = wave_sum_fast(xr[t] * kd * rkw);
                      if (lane == 0) BON[((size_t)d * MT + r0 + t) * 8 + h] = bsum; }
                    const float gm1 = g; g *= decay; const float ig = __builtin_amdgcn_rcpf(g);
                    const float at = -kkn[t] * gm1, bt = a * kkn[t] * ig, kt = kd * ig, rt = xr[t] * g;
                    At[i] = at; Rt[i] = rt; Vs[i] = xv[t];
                    *(LAS bf16_t*)(RA + 0 * 2304 + i * 144 + 2 * e) = (bf16_t)pg8::cvt_pk_bf16(at, at); *(LAS bf16_t*)(RA + 1 * 2304 + i * 144 + 2 * e) = (bf16_t)pg8::cvt_pk_bf16(bt, bt);
                    *(LAS bf16_t*)(RA + 2 * 2304 + i * 144 + 2 * e) = (bf16_t)pg8::cvt_pk_bf16(kt, kt); *(LAS bf16_t*)(RA + 3 * 2304 + i * 144 + 2 * e) = (bf16_t)pg8::cvt_pk_bf16(rt, rt);
                    if (i & 1) { Btp[i >> 1] = pg8::cvt_pk_bf16(btp, bt); Ktp[i >> 1] = pg8::cvt_pk_bf16(ktp, kt); } else { btp = bt; ktp = kt; }
                }
                gam = g;
            }
            __builtin_amdgcn_sched_barrier(0);
            WAVE_LDS_FENCE();
            {
                const int jl = lane & 15, q = lane >> 4;
                bf16x8 fa[2], fb[2], fk[2], fr[2];
#pragma unroll
                for (int s2 = 0; s2 < 2; ++s2) {
                    fa[s2] = *(const LAS bf16x8*)(RA + 0 * 2304 + jl * 144 + s2 * 64 + q * 16); fb[s2] = *(const LAS bf16x8*)(RA + 1 * 2304 + jl * 144 + s2 * 64 + q * 16);
                    fk[s2] = *(const LAS bf16x8*)(RA + 2 * 2304 + jl * 144 + s2 * 64 + q * 16); fr[s2] = *(const LAS bf16x8*)(RA + 3 * 2304 + jl * 144 + s2 * 64 + q * 16);
                }
                f32x4 gAL = {0.f, 0.f, 0.f, 0.f}, gBL = gAL, gP = gAL, gQ = gAL;
#pragma unroll
                for (int s2 = 0; s2 < 2; ++s2) { gAL = MFMA16(fa[s2], fb[s2], gAL); gBL = MFMA16(fa[s2], fk[s2], gBL); gP = MFMA16(fr[s2], fb[s2], gP); gQ = MFMA16(fr[s2], fk[s2], gQ); }
#pragma unroll
                for (int reg = 0; reg < 4; ++reg) { const int i = 4 * q + reg;
                    MAT[0 * 256 + i * 16 + jl] = jl < i ? gAL[reg] : 0.f; MAT[1 * 256 + i * 16 + jl] = jl < i ? gBL[reg] : 0.f;
                    MAT[2 * 256 + i * 16 + jl] = jl <= i ? gP[reg] : 0.f; MAT[3 * 256 + i * 16 + jl] = jl <= i ? gQ[reg] : 0.f; }
            }
            WAVE_LDS_FENCE();
            __builtin_amdgcn_sched_barrier(0);
            {
                u32x4 w0, w1;
                w0.x = Btp[0]; w0.y = Btp[1]; w0.z = Btp[2]; w0.w = Btp[3]; w1.x = Btp[4]; w1.y = Btp[5]; w1.z = Btp[6]; w1.w = Btp[7];
                *(LAS u32x4*)(RA + 0 * 2048 + e * 32) = w0; *(LAS u32x4*)(RA + 0 * 2048 + e * 32 + 16) = w1;
                w0.x = Ktp[0]; w0.y = Ktp[1]; w0.z = Ktp[2]; w0.w = Ktp[3]; w1.x = Ktp[4]; w1.y = Ktp[5]; w1.z = Ktp[6]; w1.w = Ktp[7];
                *(LAS u32x4*)(RA + 1 * 2048 + e * 32) = w0; *(LAS u32x4*)(RA + 1 * 2048 + e * 32 + 16) = w1;
#pragma unroll
                for (int i2 = 0; i2 < 4; ++i2) { w0[i2] = pg8::cvt_pk_bf16(Vs[2 * i2], Vs[2 * i2 + 1]); w1[i2] = pg8::cvt_pk_bf16(Vs[8 + 2 * i2], Vs[8 + 2 * i2 + 1]); }
                *(LAS u32x4*)(RA + 2 * 2048 + e * 32) = w0; *(LAS u32x4*)(RA + 2 * 2048 + e * 32 + 16) = w1;
                *(LAS float*)(RA + 10240 + 4 * e) = gam;
            }
            __builtin_amdgcn_sched_barrier(0);
            float Gv[TB];
            {
                float X1[TB];
#pragma unroll
                for (int i = 0; i < TB; ++i) {
                    __builtin_amdgcn_sched_barrier(0);
                    float al[16];
#pragma unroll
                    for (int g4 = 0; g4 < 4; ++g4) { const f32x4 u = *(const LAS f32x4*)(MAT + 0 * 256 + i * 16 + 4 * g4); al[4 * g4] = u.x; al[4 * g4 + 1] = u.y; al[4 * g4 + 2] = u.z; al[4 * g4 + 3] = u.w; }
                    float x1 = At[i];
#pragma unroll
                    for (int m = 0; m < TB; ++m) if (m < i) x1 = __builtin_fmaf(al[m], X1[m], x1);
                    X1[i] = x1;
                }
#pragma unroll
                for (int i = 0; i < TB; ++i) {
                    __builtin_amdgcn_sched_barrier(0);
                    float pm[16];
#pragma unroll
                    for (int g4 = 0; g4 < 4; ++g4) { const f32x4 u = *(const LAS f32x4*)(MAT + 2 * 256 + i * 16 + 4 * g4); pm[4 * g4] = u.x; pm[4 * g4 + 1] = u.y; pm[4 * g4 + 2] = u.z; pm[4 * g4 + 3] = u.w; }
                    float gv = Rt[i];
#pragma unroll
                    for (int m = 0; m < TB; ++m) if (m <= i) gv = __builtin_fmaf(pm[m], X1[m], gv);
                    Gv[i] = gv;
                }
                u32x4 w0, w1;
#pragma unroll
                for (int i2 = 0; i2 < 4; ++i2) { w0[i2] = pg8::cvt_pk_bf16(X1[2 * i2], X1[2 * i2 + 1]); w1[i2] = pg8::cvt_pk_bf16(X1[8 + 2 * i2], X1[8 + 2 * i2 + 1]); }
                *(LAS u32x4*)(RA + 3 * 2048 + e * 32) = w0; *(LAS u32x4*)(RA + 3 * 2048 + e * 32 + 16) = w1;
            }
            __builtin_amdgcn_sched_barrier(0);
            {
                float X2[TB];
#pragma unroll
                for (int i = 0; i < TB; ++i) {
                    __builtin_amdgcn_sched_barrier(0);
                    float al[16], bl[16];
#pragma unroll
                    for (int g4 = 0; g4 < 4; ++g4) { const f32x4 u = *(const LAS f32x4*)(MAT + 0 * 256 + i * 16 + 4 * g4), v = *(const LAS f32x4*)(MAT + 1 * 256 + i * 16 + 4 * g4);
                        al[4 * g4] = u.x; al[4 * g4 + 1] = u.y; al[4 * g4 + 2] = u.z; al[4 * g4 + 3] = u.w; bl[4 * g4] = v.x; bl[4 * g4 + 1] = v.y; bl[4 * g4 + 2] = v.z; bl[4 * g4 + 3] = v.w; }
                    float x2 = 0.f;
#pragma unroll
                    for (int m = 0; m < TB; ++m) if (m < i) { x2 = __builtin_fmaf(bl[m], Vs[m], x2); x2 = __builtin_fmaf(al[m], X2[m], x2); }
                    X2[i] = x2;
                }
#pragma unroll
                for (int i = 0; i < TB; ++i) {
                    __builtin_amdgcn_sched_barrier(0);
                    float pm[16], qm[16];
#pragma unroll
                    for (int g4 = 0; g4 < 4; ++g4) { const f32x4 u = *(const LAS f32x4*)(MAT + 2 * 256 + i * 16 + 4 * g4), v = *(const LAS f32x4*)(MAT + 3 * 256 + i * 16 + 4 * g4);
                        pm[4 * g4] = u.x; pm[4 * g4 + 1] = u.y; pm[4 * g4 + 2] = u.z; pm[4 * g4 + 3] = u.w; qm[4 * g4] = v.x; qm[4 * g4 + 1] = v.y; qm[4 * g4 + 2] = v.z; qm[4 * g4 + 3] = v.w; }
                    float o0 = 0.f;
#pragma unroll
                    for (int m = 0; m < TB; ++m) if (m <= i) { o0 = __builtin_fmaf(pm[m], X2[m], o0); o0 = __builtin_fmaf(qm[m], Vs[m], o0); }
                    RO[((size_t)d * MT + r0 + (d ? TB - 1 - i : i)) * 512 + c] = o0;
                }
                u32x4 w0, w1;
#pragma unroll
                for (int i2 = 0; i2 < 4; ++i2) { w0[i2] = pg8::cvt_pk_bf16(X2[2 * i2], X2[2 * i2 + 1]); w1[i2] = pg8::cvt_pk_bf16(X2[8 + 2 * i2], X2[8 + 2 * i2 + 1]); }
                *(LAS u32x4*)(RA + 4 * 2048 + e * 32) = w0; *(LAS u32x4*)(RA + 4 * 2048 + e * 32 + 16) = w1;
            }
            WAVE_LDS_FENCE();
            __builtin_amdgcn_sched_barrier(0);
            {
                LAS bf16_t* GI = (LAS bf16_t*)MAT;
                const int sg = e >> 5, jp = 4 * ((e >> 4) & 1) + (e & 3), qg = (e & 15) >> 2;
#pragma unroll
                for (int i = 0; i < TB; ++i) GI[(sg * 64 + qg * 16 + i) * 8 + jp] = (bf16_t)f2bf(Gv[i]);
            }
            __builtin_amdgcn_sched_barrier(0);
            const int seqc = d == 0 ? (grp + 16) % RW_NCK : RW_NCK - 1 - grp;
            const size_t rec = (size_t)(d * 8 + h) * RW_NCK + seqc;
            {
                const int r = lane & 31, hh = lane >> 5;
                bf16x8 fBT[2], fKT[2], fVT[2], fW1[2], fU0[2];
#pragma unroll
                for (int blk = 0; blk < 2; ++blk) {
                    fBT[blk] = *(const LAS bf16x8*)(RA + 0 * 2048 + (32 * blk + r) * 32 + hh * 16); fKT[blk] = *(const LAS bf16x8*)(RA + 1 * 2048 + (32 * blk + r) * 32 + hh * 16);
                    fVT[blk] = *(const LAS bf16x8*)(RA + 2 * 2048 + (32 * blk + r) * 32 + hh * 16); fW1[blk] = *(const LAS bf16x8*)(RA + 3 * 2048 + (32 * blk + r) * 32 + hh * 16);
                    fU0[blk] = *(const LAS bf16x8*)(RA + 4 * 2048 + (32 * blk + r) * 32 + hh * 16);
                }
                float gk[2][16];
#pragma unroll
                for (int mb = 0; mb < 2; ++mb)
#pragma unroll
                    for (int reg = 0; reg < 16; ++reg) gk[mb][reg] = *(const LAS float*)(RA + 10240 + 4 * (32 * mb + KOFF(reg) + 4 * hh));
                WAVE_LDS_FENCE();
                float* Hrec = (float*)(C.ws + OFF_RWH + rec * RWH_REC);
                LAS bf16_t* MI = (LAS bf16_t*)RA;
#pragma unroll
                for (int mb = 0; mb < 2; ++mb)
#pragma unroll
                    for (int nbk = 0; nbk < 2; ++nbk) {
                        f32x16 aM, aH;
#pragma unroll
                        for (int i = 0; i < 16; ++i) { aM[i] = 0.f; aH[i] = 0.f; }
                        aM = MFMA32(fBT[mb], fW1[nbk], aM);
                        aH = MFMA32(fBT[mb], fU0[nbk], aH); aH = MFMA32(fKT[mb], fVT[nbk], aH);
                        const int col = 32 * nbk + r;
#pragma unroll
                        for (int g4 = 0; g4 < 4; ++g4) {
                            const int kb = 2 * mb + (g4 >> 1), q2 = 2 * (g4 & 1) + hh;
                            f32x4 hv; hv.x = gk[mb][4 * g4] * aH[4 * g4]; hv.y = gk[mb][4 * g4 + 1] * aH[4 * g4 + 1]; hv.z = gk[mb][4 * g4 + 2] * aH[4 * g4 + 2]; hv.w = gk[mb][4 * g4 + 3] * aH[4 * g4 + 3];
                            *(f32x4*)(Hrec + (((col >> 4) * 4 + kb) * 64 + q2 * 16 + (col & 15)) * 4) = hv;
                        }
                        const int sm = col >> 5, jpm = 4 * ((col >> 4) & 1) + (col & 3), qm2 = (col & 15) >> 2;
#pragma unroll
                        for (int reg = 0; reg < 16; ++reg) {
                            const int kp = 32 * mb + KOFF(reg) + 4 * hh;
                            const float mv = gk[mb][reg] * ((kp == col ? 1.0f : 0.0f) + aM[reg]);
                            MI[(((kp >> 4) * 2 + sm) * 64 + qm2 * 16 + (kp & 15)) * 8 + jpm] = (bf16_t)f2bf(mv);
                        }
                    }
                WAVE_LDS_FENCE();
                unsigned char* MGrec = C.ws + OFF_RWMG + rec * RWMG_REC;
#pragma unroll
                for (int it = 0; it < 8; ++it) *(u32x4*)(MGrec + (size_t)(it * 64 + lane) * 16) = *(const LAS u32x4*)(RA + (it * 64 + lane) * 16);
#pragma unroll
                for (int it = 0; it < 2; ++it) *(u32x4*)(MGrec + 8192 + (size_t)(it * 64 + lane) * 16) = *(const LAS u32x4*)((LAS unsigned char*)MAT + (it * 64 + lane) * 16);
                WAVE_LDS_FENCE();
            }
        }
    }
}

__device__ __forceinline__ void phase_attn_prep(Ctx& C, int l, int w0, int nw) {
    bf16_t* PA = WSP(bf16_t, OFF_PA);
    const int e = C.lane;
    const float na_qn = C.ka->in[I_NAQN][l * 64 + e], na_kn = C.ka->in[I_NAKN][l * 64 + e], wa_qn = C.ka->in[I_WAQN][l * 64 + e], wa_kn = C.ka->in[I_WAKN][l * 64 + e];
    const int m16 = e & 15;
    const float inv = powf(10000.0f, -(float)m16 / 16.0f);
    for (long uidx = w0; uidx < (long)MT * 26; uidx += nw) {
        const int r = (int)(uidx / 26), v = (int)(uidx % 26);
        int col; float nwt, scl; bool rope;
        if (v < 8) { col = v * 64; nwt = na_qn; scl = 0.125f; rope = false; }
        else if (v < 16) { col = 512 + (v - 8) * 64; nwt = na_kn; scl = 1.0f; rope = false; }
        else if (v < 24) { col = 1536 + (v - 16) * 64; nwt = wa_qn; scl = 0.125f; rope = true; }
        else { col = 2048 + (v - 24) * 64; nwt = wa_kn; scl = 1.0f; rope = true; }
        bf16_t* p = PA + (size_t)r * PAW + col + e;
        const float x = bf2f(*p);
        const float ss = wave_sum(x * x);
        float y = x * rsqrtf(ss * (1.0f / 64.0f) + EPS) * nwt * scl;
        if (rope && r < SEQ) {
            const int pos = (e >> 5) ? (r & 63) : (r >> 6);
            const float ang = (float)pos * inv;
            float sn, cs; sincosf(ang, &sn, &cs);
            const bool lo = (e & 31) < 16;
            const float yp = __shfl(y, lo ? e + 16 : e - 16);
            y = lo ? (y * cs - yp * sn) : (yp * sn + y * cs);
        }
        if (v < 8 || (v >= 16 && v < 24)) *p = (bf16_t)f2bf(y);
        else {
            bf16_t* kt = v < 16 ? WSP(bf16_t, OFF_KTN) + (size_t)((v - 8) * (MT / 32) + (r >> 5)) * 2048 : WSP(bf16_t, OFF_KTW) + (size_t)((v - 24) * (MT / 32) + (r >> 5)) * 2048;
            kt[(((e >> 4) * 64 + ((e >> 3) & 1) * 32 + (r & 31)) << 3) + (e & 7)] = (bf16_t)f2bf(y);
        }
    }
}

__device__ __forceinline__ float hg_lb(Ctx& C, int l, int d, int c) {
    if (l == 0) return 0.f;
    const float a0 = C.ka->in[I_HGLB][(size_t)(d * DEPTH + 0) * 512 + c], a1 = C.ka->in[I_HGLB][(size_t)(d * DEPTH + 1) * 512 + c];
    const float m = fmaxf(a0, a1); const float e0 = expf(a0 - m), e1 = expf(a1 - m);
    return e1 / (e0 + e1);
}
struct HgThread { float lc[16], kd[16]; float tot[4]; };
__device__ __forceinline__ void hg_gates(Ctx& C, int l, int d, int h, int tc, int k, int J, LAS float* TOT, HgThread& T) {
    const float* P = WSP(float, OFF_P32);
    const float lb = hg_lb(C, l, d, h * 128 + k);
    float gg[16];
#pragma unroll
    for (int i = 0; i < 16; ++i) {
        const float fr = P[(size_t)(64 * tc + 16 * J + i) * P32W + 512 + d * 512 + h * 128 + k];
        const float f = lb + (1.0f - lb) * sigmoidf_(fr);
        gg[i] = __logf(f); T.kd[i] = 1.0f - f;
    }
    if (d == 0) { float a = 0.f;
#pragma unroll
        for (int i = 0; i < 16; ++i) { a += gg[i]; T.lc[i] = a; }
        TOT[J * 128 + k] = a;
    } else { float a = 0.f;
#pragma unroll
        for (int i = 15; i >= 0; --i) { a += gg[i]; T.lc[i] = a; }
        TOT[J * 128 + k] = a;
    }
    __syncthreads();
#pragma unroll
    for (int m = 0; m < 4; ++m) T.tot[m] = TOT[m * 128 + k];
}
__device__ __forceinline__ void hg_it(Ctx& C, int h, int tc, int v, int J, LAS unsigned char* IT) {
    const float* P = WSP(float, OFF_P32);
    float x[16];
#pragma unroll
    for (int i = 0; i < 16; ++i) x[i] = P[(size_t)(64 * tc + 16 * J + i) * P32W + 1536 + h * 128 + v];
    u32x4 w0, w1;
    w0.x = pk2(x[0], x[1]); w0.y = pk2(x[2], x[3]); w0.z = pk2(x[4], x[5]); w0.w = pk2(x[6], x[7]);
    w1.x = pk2(x[8], x[9]); w1.y = pk2(x[10], x[11]); w1.z = pk2(x[12], x[13]); w1.w = pk2(x[14], x[15]);
    *(LAS u32x4*)(IT + v * 144 + J * 32) = w0; *(LAS u32x4*)(IT + v * 144 + J * 32 + 16) = w1;
}
__device__ __forceinline__ void phase_hg_A(Ctx& C, int l, int b0, int nb) {
    float* HGL = WSP(float, OFF_HGL); float* HGD = WSP(float, OFF_HGD);
    LAS unsigned char* KT = C.lds;
    LAS unsigned char* IT = C.lds + 18432;
    LAS float* TOT = (LAS float*)(C.lds + 36864);
    const int k = C.tid & 127, J = C.tid >> 7;
    for (int u = b0; u < 2 * 4 * NCH; u += nb) {
        const int d = u / (4 * NCH), h = (u / NCH) % 4, c = u % NCH;
        const int tc = d == 0 ? (c + NCH - 4) % NCH : NCH - 1 - c;
        __syncthreads();
        HgThread T; hg_gates(C, l, d, h, tc, k, J, TOT, T);
        float rest = 0.f;
#pragma unroll
        for (int m = 0; m < 4; ++m) if (d == 0 ? (m >= J) : (m <= J)) rest += T.tot[m];
        float kh[16];
#pragma unroll
        for (int i = 0; i < 16; ++i) kh[i] = T.kd[i] * __expf(rest - T.lc[i]);
        { u32x4 w0, w1;
          w0.x = pk2(kh[0], kh[1]); w0.y = pk2(kh[2], kh[3]); w0.z = pk2(kh[4], kh[5]); w0.w = pk2(kh[6], kh[7]);
          w1.x = pk2(kh[8], kh[9]); w1.y = pk2(kh[10], kh[11]); w1.z = pk2(kh[12], kh[13]); w1.w = pk2(kh[14], kh[15]);
          *(LAS u32x4*)(KT + k * 144 + J * 32) = w0; *(LAS u32x4*)(KT + k * 144 + J * 32 + 16) = w1; }
        hg_it(C, h, tc, k, J, IT);
        if (J == 0) HGD[(size_t)((d * 4 + h) * NCH + c) * 128 + k] = __expf((T.tot[0] + T.tot[1]) + (T.tot[2] + T.tot[3]));
        __syncthreads();
        const int r = C.lane & 31, hh = C.lane >> 5, vb = C.wave >> 1;
        float* outp = HGL + (size_t)((d * 4 + h) * NCH + c) * 16384;
#pragma unroll
        for (int t2 = 0; t2 < 2; ++t2) {
            const int kb = 2 * (C.wave & 1) + t2;
            f32x16 acc;
#pragma unroll
            for (int i = 0; i < 16; ++i) acc[i] = 0.f;
#pragma unroll
            for (int st = 0; st < 4; ++st) {
                const bf16x8 af = *(const LAS bf16x8*)(IT + (32 * vb + r) * 144 + st * 32 + hh * 16);
                const bf16x8 bf = *(const LAS bf16x8*)(KT + (32 * kb + r) * 144 + st * 32 + hh * 16);
                acc = MFMA32(af, bf, acc);
            }
#pragma unroll
            for (int reg = 0; reg < 16; ++reg) outp[(size_t)(32 * vb + KOFF(reg) + 4 * hh) * 128 + 32 * kb + r] = acc[reg];
        }
    }
}
__device__ __forceinline__ void phase_hg_B(Ctx& C, int b0, int nb) {
    const float* HGL = WSP(float, OFF_HGL); const float* HGD = WSP(float, OFF_HGD); bf16_t* SPT = WSP(bf16_t, OFF_SPT);
    for (int e = b0 * NT + C.tid; e < 8 * 16384; e += nb * NT) {
        const int dh = e >> 14, vk = e & 16383, k = vk & 127;
        float st = 0.f;
        const float* p = HGL + (size_t)dh * NCH * 16384 + vk; const float* dp = HGD + (size_t)dh * NCH * 128 + k; bf16_t* o = SPT + (size_t)dh * NCH * 16384 + vk;
#pragma unroll 4
        for (int c = 0; c < NCH; ++c) { const float Lc = p[(size_t)c * 16384], Dc = dp[c * 128]; o[(size_t)c * 16384] = (bf16_t)f2bf(st); st = Dc * st + Lc; }
    }
}
__device__ __forceinline__ void phase_hg_C(Ctx& C, int l, int b0, int nb, int nch  ) {
    const float* P = WSP(float, OFF_P32); const bf16_t* SPT = WSP(bf16_t, OFF_SPT); bf16_t* YB = WSP(bf16_t, OFF_YB);
    LAS unsigned char* KS = C.lds;
    LAS unsigned char* QJ = C.lds + 17408;
    LAS unsigned char* IT = C.lds + 17408 + 69632;
    LAS float* TOT = (LAS float*)(C.lds + 105472);
    LAS float* RED = (LAS float*)(C.lds + 107520);
    const int k = C.tid & 127, J = C.tid >> 7;
    const int tl = C.lane & 15, qd = C.lane >> 4, I = C.wave >> 1, vh = C.wave & 1;
    for (int u = b0; u < 4 * nch; u += nb) {
        const int h = u / nch, tc = u % nch;
        f32x4 oT[4];
#pragma unroll
        for (int i = 0; i < 4; ++i) oT[i] = (f32x4){0.f, 0.f, 0.f, 0.f};
#pragma unroll 1
        for (int d = 0; d < 2; ++d) {
            const int cd = d == 0 ? (tc + 4) % NCH : NCH - 1 - tc;
            __syncthreads();
            {
                HgThread T; hg_gates(C, l, d, h, tc, k, J, TOT, T);
                float qv[16];
#pragma unroll
                for (int i = 0; i < 16; ++i) qv[i] = P[(size_t)(64 * tc + 16 * J + i) * P32W + h * 128 + k];
#pragma unroll
                for (int i = 0; i < 16; ++i) *(LAS bf16_t*)(KS + (16 * J + i) * 272 + 2 * k) = (bf16_t)f2bf(T.kd[i] * __expf(fminf(-T.lc[i], 80.f)));
#pragma unroll
                for (int Jp = 0; Jp < 4; ++Jp) {
                    if (d == 0 ? (Jp > J) : (Jp < J)) continue;
                    float Pj = 0.f;
#pragma unroll
                    for (int m = 0; m < 4; ++m) if (d == 0 ? (m >= Jp && m < J) : (m > J && m <= Jp)) Pj += T.tot[m];
#pragma unroll
                    for (int i = 0; i < 16; ++i) *(LAS bf16_t*)(QJ + (Jp * 64 + 16 * J + i) * 272 + 2 * k) = (bf16_t)f2bf(qv[i] * __expf(T.lc[i] + Pj));
                }
                hg_it(C, h, tc, k, J, IT);
            }
            __syncthreads();
            u32x2 att[4];
#pragma unroll
            for (int Jb = 0; Jb < 4; ++Jb) {
                att[Jb] = (u32x2){0u, 0u};
                if (d == 0 ? (Jb > I) : (Jb < I)) continue;
                f32x4 acc = {0.f, 0.f, 0.f, 0.f};
#pragma unroll
                for (int ks = 0; ks < 4; ++ks) {
                    const bf16x8 af = *(const LAS bf16x8*)(KS + (16 * Jb + tl) * 272 + ks * 64 + qd * 16);
                    const bf16x8 bf = *(const LAS bf16x8*)(QJ + (Jb * 64 + 16 * I + tl) * 272 + ks * 64 + qd * 16);
                    acc = MFMA16(af, bf, acc);
                }
                if (Jb == I) {
#pragma unroll
                    for (int reg = 0; reg < 4; ++reg) { const int sl = 4 * qd + reg; const bool valid = d == 0 ? (sl <= tl) : (sl >= tl); acc[reg] = valid ? acc[reg] : 0.f; }
                }
                att[Jb].x = pk2(acc[0], acc[1]); att[Jb].y = pk2(acc[2], acc[3]);
            }
#pragma unroll
            for (int pr = 0; pr < 2; ++pr) {
                const int Ja = 2 * pr, Jc = 2 * pr + 1;
                const bool anyv = d == 0 ? (Ja <= I) : (Jc >= I);
                if (!anyv) continue;
                u32x4 bw; bw.x = att[Ja].x; bw.y = att[Ja].y; bw.z = att[Jc].x; bw.w = att[Jc].y;
                const bf16x8 bf = __builtin_bit_cast(bf16x8, bw);
#pragma unroll
                for (int vb = 0; vb < 4; ++vb) {
                    const int v = 16 * (4 * vh + vb) + tl;
                    const u32x2 a0 = *(const LAS u32x2*)(IT + v * 144 + Ja * 32 + qd * 8), a1 = *(const LAS u32x2*)(IT + v * 144 + Jc * 32 + qd * 8);
                    u32x4 aw; aw.x = a0.x; aw.y = a0.y; aw.z = a1.x; aw.w = a1.y;
                    oT[vb] = MFMA16(__builtin_bit_cast(bf16x8, aw), bf, oT[vb]);
                }
            }
            const bf16_t* sp = SPT + (size_t)((d * 4 + h) * NCH + cd) * 16384;
            const int Je = d == 0 ? 0 : 3;
#pragma unroll
            for (int ks = 0; ks < 4; ++ks) {
                const bf16x8 bf = *(const LAS bf16x8*)(QJ + (Je * 64 + 16 * I + tl) * 272 + ks * 64 + qd * 16);
#pragma unroll
                for (int vb = 0; vb < 4; ++vb) {
                    const bf16x8 af = *(const bf16x8*)(sp + (size_t)(16 * (4 * vh + vb) + tl) * 128 + ks * 32 + qd * 8);
                    oT[vb] = MFMA16(af, bf, oT[vb]);
                }
            }
        }
        float ss = 0.f;
#pragma unroll
        for (int vb = 0; vb < 4; ++vb) ss += (oT[vb][0] * oT[vb][0] + oT[vb][1] * oT[vb][1]) + (oT[vb][2] * oT[vb][2] + oT[vb][3] * oT[vb][3]);
        ss += __shfl_xor(ss, 16); ss += __shfl_xor(ss, 32);
        __syncthreads();
        if (qd == 0) RED[C.wave * 16 + tl] = ss;
        __syncthreads();
        const float rstd = rsqrtf((RED[(2 * I) * 16 + tl] + RED[(2 * I + 1) * 16 + tl]) * (1.0f / 128.0f) + EPS);
        const int row = 64 * tc + 16 * I + tl;
#pragma unroll
        for (int vb = 0; vb < 4; ++vb) {
            const int v0 = 16 * (4 * vh + vb) + 4 * qd;
            const f32x4 nw = *(const f32x4*)(C.ka->in[I_HGNORM] + l * 512 + h * 128 + v0);
            const f32x4 gv = *(const f32x4*)(P + (size_t)row * P32W + 2048 + h * 128 + v0);
            u32x2 w; w.x = pg8::cvt_pk_bf16(oT[vb][0] * rstd * nw.x * siluf_(gv.x), oT[vb][1] * rstd * nw.y * siluf_(gv.y));
            w.y = pg8::cvt_pk_bf16(oT[vb][2] * rstd * nw.z * siluf_(gv.z), oT[vb][3] * rstd * nw.w * siluf_(gv.w));
            *(u32x2*)(YB + (size_t)row * 512 + h * 128 + v0) = w;
        }
    }
}

constexpr int RW_NJOBS = 64, RW_RING = 9, RW_SLOT = 14336;
__device__ __forceinline__ void phase_rw_scan(Ctx& C, int b0, int nb) {
    float* RO2 = WSP(float, OFF_RO2);
    LAS unsigned char* slot = C.lds;
    const int lane = C.lane, wv = C.wave;
    for (int jb = b0; jb < RW_NJOBS; jb += nb) {
        const int x = jb & 7, y = jb >> 3, dh = x * 2 + (y >> 2), vs = y & 3, d = dh >> 3, h = dh & 7;
        const unsigned char* mg = C.ws + OFF_RWMG + (size_t)dh * RW_NCK * RWMG_REC;
        const unsigned char* hr = C.ws + OFF_RWH + (size_t)dh * RW_NCK * RWH_REC + (size_t)vs * 4096;
        __syncthreads();
#define RW_DMA(cc) do { LAS unsigned char* dst_ = slot + ((cc) % RW_RING) * RW_SLOT; \
            _Pragma("unroll") for (int i = 0; i < 10; ++i) __builtin_amdgcn_global_load_lds((const unsigned*)(mg + (size_t)(cc) * RWMG_REC + (size_t)(i * 64 + lane) * 16), (LAS unsigned*)(dst_ + i * 1024), 16, 0, 0); \
            _Pragma("unroll") for (int i = 0; i < 4; ++i) __builtin_amdgcn_global_load_lds((const unsigned*)(hr + (size_t)(cc) * RWH_REC + (size_t)(i * 64 + lane) * 16), (LAS unsigned*)(dst_ + (10 + i) * 1024), 16, 0, 0); } while (0)
        if (wv == 1 || wv == 2) { const int par = wv - 1;
#pragma unroll
            for (int k4 = 0; k4 < 4; ++k4) RW_DMA(2 * k4 + par); }
        f32x4 acc[4];
#pragma unroll
        for (int i = 0; i < 4; ++i) acc[i] = (f32x4){0.f, 0.f, 0.f, 0.f};
        const int vl = lane & 15, q = lane >> 4;
#pragma unroll 1
        for (int cc = -1; cc < RW_NCK; ++cc) {
            if (wv == 1 || wv == 2) {
                const int par = wv - 1, nx = cc + 1;
                if ((nx & 1) == par) {
                    asm volatile("s_waitcnt vmcnt(42)" ::: "memory");
                } else if (cc >= 0) {
                    const int nn = cc + 8 < RW_NCK ? cc + 8 : RW_NCK - 1;
                    if (cc + 8 < RW_NCK) { RW_DMA(nn); } else { LAS unsigned char* dst_ = slot + ((cc + 8) % RW_RING) * RW_SLOT;
#pragma unroll
                        for (int i = 0; i < 14; ++i) __builtin_amdgcn_global_load_lds((const unsigned*)(mg + (size_t)nn * RWMG_REC + (size_t)lane * 16), (LAS unsigned*)(dst_ + i * 1024), 16, 0, 0); }
                }
            } else if (wv == 0 && cc >= 0) {
                const LAS unsigned char* sl = slot + (cc % RW_RING) * RW_SLOT;
                bf16x8 bfr[2];
                asm volatile("s_nop 7\n\ts_nop 7" ::: "memory");
#pragma unroll
                for (int s2 = 0; s2 < 2; ++s2) { u32x4 w; w.x = pg8::cvt_pk_bf16(acc[2 * s2][0], acc[2 * s2][1]); w.y = pg8::cvt_pk_bf16(acc[2 * s2][2], acc[2 * s2][3]); w.z = pg8::cvt_pk_bf16(acc[2 * s2 + 1][0], acc[2 * s2 + 1][1]); w.w = pg8::cvt_pk_bf16(acc[2 * s2 + 1][2], acc[2 * s2 + 1][3]);
                    bfr[s2] = __builtin_bit_cast(bf16x8, w); }
                const int rc = d == 0 ? (cc + RW_NCK - 16) % RW_NCK : RW_NCK - 1 - cc;
                float* rop = RO2 + ((size_t)d * MT + 16 * rc) * 512 + h * 64 + 16 * vs + vl;
                f32x4 oacc = {0.f, 0.f, 0.f, 0.f};
#pragma unroll
                for (int s2 = 0; s2 < 2; ++s2) oacc = MFMA16(*(const LAS bf16x8*)(sl + 8192 + (s2 * 64 + lane) * 16), bfr[s2], oacc);
#pragma unroll
                for (int reg = 0; reg < 4; ++reg) { const int i = 4 * q + reg; rop[(size_t)(d ? 15 - i : i) * 512] = oacc[reg]; }
#pragma unroll
                for (int kb = 0; kb < 4; ++kb) {
                    f32x4 a = *(const LAS f32x4*)(sl + 10240 + (kb * 64 + lane) * 16);
#pragma unroll
                    for (int s2 = 0; s2 < 2; ++s2) a = MFMA16(*(const LAS bf16x8*)(sl + ((kb * 2 + s2) * 64 + lane) * 16), bfr[s2], a);
                    acc[kb] = a;
                }
            }
            asm volatile("s_waitcnt lgkmcnt(0)" ::: "memory"); __builtin_amdgcn_s_barrier(); asm volatile("" ::: "memory");
        }
        asm volatile("s_waitcnt vmcnt(0)" ::: "memory");
#undef RW_DMA
    }
}
__device__ __forceinline__ void phase_rw_finish(Ctx& C, int l, int w0, int nw, int rows) {
    const float* VV = WSP(float, OFF_VV); const float* GS = WSP(float, OFF_GS); const float* RO = WSP(float, OFF_RO); const float* BON = WSP(float, OFF_BON); const float* RO2 = WSP(float, OFF_RO2);
    bf16_t* YB = WSP(bf16_t, OFF_YB) + (size_t)1 * MT * 512;
    const int e = C.lane;
    for (int uidx = w0; uidx < rows * 8; uidx += nw) {
        const int r = uidx >> 3, h = uidx & 7, c = h * 64 + e;
        const float o = (RO[(size_t)r * 512 + c] + RO[((size_t)MT + r) * 512 + c]) + (RO2[(size_t)r * 512 + c] + RO2[((size_t)MT + r) * 512 + c]);
        const float mu = wave_sum_fast(o) * (1.0f / 64.0f);
        const float dv = o - mu;
        const float var = wave_sum_fast(dv * dv) * (1.0f / 64.0f);
        const float on = dv * rsqrtf(var + RW_GN_EPS) * C.ka->in[I_RWLNW][l * 512 + c] + C.ka->in[I_RWLNB][l * 512 + c];
        const float y = (on + (BON[(size_t)r * 8 + h] + BON[((size_t)MT + r) * 8 + h]) * VV[(size_t)r * 512 + c]) * GS[(size_t)r * 512 + c];
        YB[(size_t)r * 512 + c] = (bf16_t)f2bf(y);
    }
}

typedef float f32x4u __attribute__((ext_vector_type(4), aligned(4)));
__device__ __forceinline__ float swap32_sum(float x) { auto t = __builtin_amdgcn_permlane32_swap(__float_as_uint(x), __float_as_uint(x), false, false); return __uint_as_float(t[0]) + __uint_as_float(t[1]); }
__device__ __forceinline__ f32x16 qk_tile(const bf16_t* Kp  , const bf16x8 (&qf)[4], int r, int h) {
    f32x16 acc;
#pragma unroll
    for (int i = 0; i < 16; ++i) acc[i] = 0.f;
    const bf16_t* p = Kp + (size_t)r * PAW + 8 * h;
#pragma unroll
    for (int s = 0; s < 4; ++s) { const bf16x8 kf = *(const bf16x8*)(p + 16 * s); acc = MFMA32(kf, qf[s], acc); }
    return acc;
}
__device__ __forceinline__ void pv_tile(f32x16 (&o)[2], const bf16_t* VTp  , const f32x16& p, int r, int h) {
#pragma unroll
    for (int s = 0; s < 2; ++s) {
        u32x4 pw; pw.x = pg8::cvt_pk_bf16(p[8 * s + 0], p[8 * s + 1]); pw.y = pg8::cvt_pk_bf16(p[8 * s + 2], p[8 * s + 3]); pw.z = pg8::cvt_pk_bf16(p[8 * s + 4], p[8 * s + 5]); pw.w = pg8::cvt_pk_bf16(p[8 * s + 6], p[8 * s + 7]);
        const bf16x8 pb = __builtin_bit_cast(bf16x8, pw);
#pragma unroll
        for (int blk = 0; blk < 2; ++blk) {
            const bf16_t* vp = VTp + (size_t)(32 * blk + r) * MT + 16 * s + 4 * h;
            const u32x2 lo = *(const u32x2*)vp, hi = *(const u32x2*)(vp + 8);
            u32x4 vw; vw.x = lo.x; vw.y = lo.y; vw.z = hi.x; vw.w = hi.y;
            o[blk] = MFMA32(__builtin_bit_cast(bf16x8, vw), pb, o[blk]);
        }
    }
}
__device__ __forceinline__ void phase_attn(Ctx& C, int l, int w0, int nw) {
    const bf16_t* PA = WSP(bf16_t, OFF_PA); bf16_t* YB = WSP(bf16_t, OFF_YB);
    const bf16_t* VTN = WSP(bf16_t, OFF_VTN); const bf16_t* VTW = WSP(bf16_t, OFF_VTW);
    const float* PB = WSP(float, OFF_PB); const float* MREF = WSP(float, OFF_MREF);
    const int r = C.lane & 31, h = C.lane >> 5;
    constexpr int NJT = 2048 + 64;
    for (int job = w0; job < 2 * NJT; job += nw) {
        const int type = __builtin_amdgcn_readfirstlane(job / NJT), jj = __builtin_amdgcn_readfirstlane(job % NJT), qt = jj >> 3, hd = jj & 7;
        const int q0 = qt * 32;
        const bool lat = qt < 256;
        if (!lat && l == DEPTH - 1) continue;
        const float Mr = MREF[type];
        bf16x8 qf[4];
        { const bf16_t* qp = PA + (size_t)(q0 + r) * PAW + (type == 0 ? 0 : 1536) + hd * 64 + 8 * h;
#pragma unroll
          for (int s = 0; s < 4; ++s) qf[s] = *(const bf16x8*)(qp + 16 * s); }
        f32x16 o[2];
#pragma unroll
        for (int i = 0; i < 16; ++i) { o[0][i] = 0.f; o[1][i] = 0.f; }
        float lsum = 0.f;
        const int kcol = type == 0 ? 512 + hd * 64 : 2048 + (hd >> 2) * 64;
        const bf16_t* VT = type == 0 ? VTN + (size_t)(hd * (MT / 32)) * 2048 : VTW + (size_t)((hd >> 2) * (MT / 32)) * 2048;
        const bf16_t* KT = type == 0 ? WSP(bf16_t, OFF_KTN) + (size_t)(hd * (MT / 32)) * 2048 : WSP(bf16_t, OFF_KTW) + (size_t)((hd >> 2) * (MT / 32)) * 2048;
        const int i_g = qt >> 1, j_g = (qt & 1) * 32 + r;
        int rs = i_g - 4; rs = rs < 0 ? 0 : (rs > 120 ? 120 : rs);
        int cs = j_g - 8; cs = cs < 0 ? 0 : (cs > 48 ? 48 : cs);
        const int dl0 = -4 > -qt ? -4 : -qt, dl1 = 4 < 255 - qt ? 4 : 255 - qt;
        const int n_loc = !lat ? 0 : (type == 0 ? 16 : dl1 - dl0 + 1), nt = n_loc + CTX / 32;
#define ATT_KEY0(t) ((t) >= n_loc ? SEQ + 32 * ((t) - n_loc) : (type == 0 ? (rs + ((t) >> 1)) * 64 + 32 * ((t) & 1) : (qt + dl0 + (t)) * 32))
#define ATT_LOADK(kf, key0) do { const bf16_t* kp_ = KT + (size_t)((key0) >> 5) * 2048 + C.lane * 8; _Pragma("unroll") for (int s = 0; s < 4; ++s) kf[s] = *(const bf16x8*)(kp_ + s * 512); } while (0)
#define ATT_LOADV(vf, key0) do { const bf16_t* vp_ = VT + (size_t)((key0) >> 5) * 2048 + C.lane * 8; _Pragma("unroll") for (int s = 0; s < 2; ++s) _Pragma("unroll") for (int blk = 0; blk < 2; ++blk) vf[s][blk] = *(const u32x4*)(vp_ + (s * 2 + blk) * 512); } while (0)
        bf16x8 kc[4], kn[4]; u32x4 vc[2][2], vn[2][2];
        { const int k0 = ATT_KEY0(0); ATT_LOADK(kc, k0); ATT_LOADV(vc, k0); }
#pragma unroll 1
        for (int t = 0; t < nt; ++t) {
            { const int tn = t + 1 < nt ? t + 1 : t; const int k1 = ATT_KEY0(tn); ATT_LOADK(kn, k1); ATT_LOADV(vn, k1); }
            f32x16 acc;
#pragma unroll
            for (int i = 0; i < 16; ++i) acc[i] = 0.f;
#pragma unroll
            for (int s = 0; s < 4; ++s) acc = MFMA32(kc[s], qf[s], acc);
            f32x16 p;
            if (t >= n_loc) {
#pragma unroll
                for (int reg = 0; reg < 16; ++reg) { p[reg] = __expf(acc[reg] - Mr); lsum += p[reg]; }
            } else if (type == 0) {
                const int a = t >> 1, cc = t & 1;
                const float* brow = PB + (size_t)(hd * 15 + (rs + a - i_g + 7)) * 128 + (32 * cc + 4 * h - j_g + 63);
                const int lo = cs - 32 * cc - 4 * h;
#pragma unroll
                for (int g = 0; g < 4; ++g) {
                    const f32x4u b4 = *(const f32x4u*)(brow + 8 * g);
#pragma unroll
                    for (int q = 0; q < 4; ++q) { const int reg = 4 * g + q; const bool valid = (unsigned)(KOFF(reg) - lo) < 16u;
                        const float e = __expf(acc[reg] + b4[q] - Mr); p[reg] = valid ? e : 0.f; lsum += p[reg]; }
                }
            } else {
                const int dl = dl0 + t;
#pragma unroll
                for (int reg = 0; reg < 16; ++reg) { const int kr = KOFF(reg) + 4 * h; const bool valid = dl == -4 ? (kr >= r) : (dl == 4 ? (kr <= r) : true);
                    const float e = __expf(acc[reg] - Mr); p[reg] = valid ? e : 0.f; lsum += p[reg]; }
            }
#pragma unroll
            for (int s = 0; s < 2; ++s) {
                u32x4 pw; pw.x = pg8::cvt_pk_bf16(p[8 * s + 0], p[8 * s + 1]); pw.y = pg8::cvt_pk_bf16(p[8 * s + 2], p[8 * s + 3]); pw.z = pg8::cvt_pk_bf16(p[8 * s + 4], p[8 * s + 5]); pw.w = pg8::cvt_pk_bf16(p[8 * s + 6], p[8 * s + 7]);
                const bf16x8 pb = __builtin_bit_cast(bf16x8, pw);
#pragma unroll
                for (int blk = 0; blk < 2; ++blk) o[blk] = MFMA32(__builtin_bit_cast(bf16x8, vc[s][blk]), pb, o[blk]);
            }
#pragma unroll
            for (int s = 0; s < 4; ++s) kc[s] = kn[s];
#pragma unroll
            for (int s = 0; s < 2; ++s)
#pragma unroll
                for (int blk = 0; blk < 2; ++blk) vc[s][blk] = vn[s][blk];
        }
#undef ATT_KEY0
#undef ATT_LOADK
#undef ATT_LOADV
        float ltot = swap32_sum(lsum);
        if (type == 1) ltot += __expf(C.ka->in[I_WASINK][l * 8 + hd] - Mr);
        const float inv = 1.0f / ltot;
        bf16_t* yp = YB + (size_t)(2 + type) * MT * 512 + (size_t)(q0 + r) * 512 + hd * 64 + 4 * h;
#pragma unroll
        for (int blk = 0; blk < 2; ++blk)
#pragma unroll
            for (int g = 0; g < 4; ++g) {
                u32x2 w; w.x = pg8::cvt_pk_bf16(o[blk][4 * g] * inv, o[blk][4 * g + 1] * inv); w.y = pg8::cvt_pk_bf16(o[blk][4 * g + 2] * inv, o[blk][4 * g + 3] * inv);
                *(u32x2*)(yp + 32 * blk + 8 * g) = w;
            }
    }
}
__device__ __forceinline__ void phase_attn_tables(Ctx& C, int l, int w0, int nw) {
    const bf16_t* PA = WSP(bf16_t, OFF_PA); bf16_t* VTN = WSP(bf16_t, OFF_VTN); bf16_t* VTW = WSP(bf16_t, OFF_VTW);
    LAS unsigned char* tile = C.lds + C.wave * 9216;
    const int lane = C.lane;
    for (int u = w0; u < 10 * NCH; u += nw) {
        const int hd = u / NCH, tt = u % NCH, t0 = tt * 64;
        const int vcol = hd < 8 ? 1024 + hd * 64 : 2176 + (hd - 8) * 64;
#pragma unroll
        for (int it = 0; it < 8; ++it) { const int row = 8 * it + (lane >> 3), ch = lane & 7;
            *(LAS u32x4*)(tile + row * 144 + ch * 16) = *(const u32x4*)(PA + (size_t)(t0 + row) * PAW + vcol + ch * 8); }
        LDS_WAIT(); asm volatile("" ::: "memory");
        bf16_t* dst = (hd < 8 ? VTN + (size_t)(hd * (MT / 32) + 2 * tt) * 2048 : VTW + (size_t)((hd - 8) * (MT / 32) + 2 * tt) * 2048);
        { const int rr = lane & 31, hh = lane >> 5;
#pragma unroll
          for (int kt2 = 0; kt2 < 2; ++kt2)
#pragma unroll
            for (int s2 = 0; s2 < 2; ++s2)
#pragma unroll
                for (int blk = 0; blk < 2; ++blk) {
                    unsigned e[8];
#pragma unroll
                    for (int j = 0; j < 8; ++j) e[j] = *(const LAS bf16_t*)(tile + (32 * kt2 + 16 * s2 + 8 * (j >> 2) + 4 * hh + (j & 3)) * 144 + 2 * (32 * blk + rr));
                    u32x4 w; w.x = e[0] | (e[1] << 16); w.y = e[2] | (e[3] << 16); w.z = e[4] | (e[5] << 16); w.w = e[6] | (e[7] << 16);
                    *(u32x4*)(dst + (size_t)kt2 * 2048 + ((s2 * 2 + blk) * 64 + lane) * 8) = w;
                }
        }
        LDS_WAIT(); asm volatile("" ::: "memory");
    }
    float* PB = WSP(float, OFF_PB);
    const float* rpb = C.ka->in[I_NARPB] + (size_t)l * 8 * 15 * 31;
    for (int idx = w0 * 64 + lane; idx < 8 * 15 * 128; idx += nw * 64) { const int x = idx & 127, hr = idx >> 7; PB[idx] = (x >= 48 && x < 79) ? rpb[hr * 31 + x - 48] : 0.f; }
    if (w0 == 0) {
        float mb = 0.f;
        for (int i = lane; i < 8 * 15 * 31; i += 64) mb = fmaxf(mb, fabsf(rpb[i]));
        mb = wave_max(mb);
        const float nq = wave_max(fabsf(C.ka->in[I_NAQN][l * 64 + lane])), nk = wave_max(fabsf(C.ka->in[I_NAKN][l * 64 + lane]));
        const float wq = wave_max(fabsf(C.ka->in[I_WAQN][l * 64 + lane])), wk = wave_max(fabsf(C.ka->in[I_WAKN][l * 64 + lane]));
        const float sk = wave_max(lane < 8 ? C.ka->in[I_WASINK][l * 8 + lane] : -1e30f);
        if (lane == 0) { float* M = WSP(float, OFF_MREF); M[0] = 8.08f * nq * nk + mb; M[1] = fmaxf(8.08f * wq * wk, sk); }
    }
}

__device__ __forceinline__ void phase_combine(Ctx& C, int rows) {
    const bf16_t* PROJ = WSP(bf16_t, OFF_P32); bf16_t* MG = WSP(bf16_t, OFF_H);
    const size_t n8 = (size_t)rows * D / 8;
    for (size_t i = (size_t)C.bid * NT + C.tid; i < n8; i += (size_t)C.G * NT) {
        const size_t r = i / (D / 8), c8 = i % (D / 8);
        float a[8];
#pragma unroll
        for (int j = 0; j < 8; ++j) a[j] = 0.f;
#pragma unroll
        for (int g = 0; g < 4; ++g) {
            const u32x4 w = *(const u32x4*)(PROJ + r * GLW + g * D + c8 * 8);
            a[0] += bf2f(w.x & 0xffffu); a[1] += bf2f(w.x >> 16); a[2] += bf2f(w.y & 0xffffu); a[3] += bf2f(w.y >> 16);
            a[4] += bf2f(w.z & 0xffffu); a[5] += bf2f(w.z >> 16); a[6] += bf2f(w.w & 0xffffu); a[7] += bf2f(w.w >> 16);
        }
        u32x4 o; o.x = pk2(a[0], a[1]); o.y = pk2(a[2], a[3]); o.z = pk2(a[4], a[5]); o.w = pk2(a[6], a[7]);
        *(u32x4*)(MG + r * D + c8 * 8) = o;
    }
}

constexpr int PH_PRO = 2, PH_PER_LAYER = 14, N_PHASES = PH_PRO + DEPTH * PH_PER_LAYER;

__global__ void __launch_bounds__(NT, 2) mk_fwd(Args args) {
    extern __shared__ __attribute__((aligned(16))) unsigned char lds_raw[];
    Ctx C;
    C.lds = (LAS unsigned char*)lds_raw;
    C.tid = threadIdx.x; C.lane = C.tid & 63; C.wave = __builtin_amdgcn_readfirstlane(C.tid >> 6);
    C.bid = blockIdx.x; C.G = gridDim.x;
    C.ka = (const Args __attribute__((address_space(4)))*)__builtin_amdgcn_kernarg_segment_ptr(); C.out = args.out; C.ws = args.ws;
    volatile LAS unsigned* MISC = (volatile LAS unsigned*)(C.lds + MISC_OFF);
    for (int u = C.tid; u < (LDS_BYTES - RING_BYTES) / 4; u += NT) ((LAS unsigned*)(C.lds + RING_BYTES))[u] = 0u;
    __syncthreads();
    const int lo = args.ph_lo, hi = args.ph_hi;
    XcdBarrier bar; bar.bar = WSP(unsigned, OFF_CTL) + 4096; bar.x = 0; bar.st = nullptr;
    const bool multi = (hi - lo) > 1;
    if (multi) bar = xcd_barrier_post(WSP(unsigned, OFF_CTL) + 4096, MISC + 8);
#ifndef PH_MASK
#define PH_MASK 0xFFFF
#endif
#ifndef PRO_MASK
#define PRO_MASK 3
#endif
#define IN(k) (lo <= (k) && (k) < hi)
#define LEN(j) (((PH_MASK) >> (j)) & 1)
#define SEAM(k) do { if (IN(k) && IN((k) + 1)) xcd_barrier(bar); } while (0)

    if ((PRO_MASK & 1) && IN(0)) { relaunder(C); phase_convert(C, 0, 127, C.bid, C.G); phase_ada_partial(C); } SEAM(0);
    if ((PRO_MASK & 2) && IN(1)) { relaunder(C); phase_ada_reduce(C); } SEAM(1);

#pragma unroll
    for (int l = 0; l < DEPTH; ++l) {
        const int pb = PH_PRO + l * PH_PER_LAYER;
        if (LEN(0) && IN(pb + 0)) { relaunder(C); if (l > 0) phase_convert(C, l, 127 - 21, C.bid, C.G); phase_norm(C, l, C.ka->in[I_NF1] + (size_t)l * D, 0, l > 0 ? 22 : 0, MT, l == 0 ? 1 : 0); } SEAM(pb + 0);
        if (LEN(1) && IN(pb + 1)) { relaunder(C);
            pg8::Gemm g{WSP(bf16_t, OFF_H), WSP(bf16_t, OFF_WI1), 1 << 20, 0};
            pg8::StaticOrder S; S.init(MT, 2 * DFF, C.G, C.bid);
            pg8::EpiSwiGLU E{WSP(bf16_t, OFF_G)};
            pg8::gemm_phase<pg8::EpiSwiGLU, true, true, pg8::StaticOrder, D, D, D, 0>(C.lds, g, S, E, C.tid);
            if (PROBE_MODE == 3) { pg8::gemm_phase<pg8::EpiSwiGLU, true, true, pg8::StaticOrder, D, D, D, 0>(C.lds, g, S, E, C.tid); }
        } SEAM(pb + 1);
        if (LEN(2) && IN(pb + 2)) { relaunder(C);
            { pg8::Gemm g{WSP(bf16_t, OFF_G), WSP(bf16_t, OFF_WO1), 1 << 20, 0};
              pg8::StaticOrder S; S.init(SEQ, D, C.G, C.bid);
              pg8::EpiResid<true> E{WSP(float, OFF_X), mod_ptr(C, l, 0, 2), mod_ptr(C, l, 1, 2), nullptr, l == 0 ? C.ka->in[I_X] : WSP(float, OFF_X)};
              pg8::gemm_phase<pg8::EpiResid<true>, true, true, pg8::StaticOrder, DFF, DFF, DFF, 0>(C.lds, g, S, E, C.tid); }
            { relaunder(C); pg8::Gemm g{WSP(bf16_t, OFF_G), WSP(bf16_t, OFF_WO1), 1 << 20, 0};
              pg8::SplitOrder S{SEQ / 256, D / 256, 22, C.G, C.bid};
              pg8::EpiPart<true> E{WSP(float, OFF_P32), mod_ptr(C, l, 1, 2)};
              pg8::gemm_phase<pg8::EpiPart<true>, true, true, pg8::SplitOrder, 256, DFF, DFF, 256>(C.lds, g, S, E, C.tid); }
        } SEAM(pb + 2);
        if (LEN(3) && IN(pb + 3)) { relaunder(C); phase_norm(C, l, C.ka->in[I_NMIX] + (size_t)l * D, 3, 22, MT, l == 0 ? 2 : 0); } SEAM(pb + 3);
        if (LEN(4) && IN(pb + 4)) { relaunder(C);
            pg8::Gemm g{WSP(bf16_t, OFF_H), WSP(bf16_t, OFF_WIN), 1 << 20, 0};
            pg8::StaticOrder S; S.init(MT, PTOT, C.G, C.bid);
            pg8::EpiWin E{WSP(float, OFF_P32), WSP(bf16_t, OFF_PA), WSP(bf16_t, OFF_GL), 0};
            pg8::gemm_phase<pg8::EpiWin, true, true, pg8::StaticOrder, D, D, D, 0>(C.lds, g, S, E, C.tid);
            if (PROBE_MODE == 3) { pg8::gemm_phase<pg8::EpiWin, true, true, pg8::StaticOrder, D, D, D, 0>(C.lds, g, S, E, C.tid); }
        } SEAM(pb + 4);
        if (LEN(5) && IN(pb + 5)) { relaunder(C);
            phase_rw_prep(C, l, C.bid, C.G);
            __syncthreads();
            phase_attn_prep(C, l, C.bid * NWAVES + C.wave, C.G * NWAVES);
            phase_attn_tables(C, l, C.bid * NWAVES + C.wave, C.G * NWAVES);
            if (PROBE_MODE == 1) phase_attn_tables(C, l, C.bid * NWAVES + C.wave, C.G * NWAVES);
            __syncthreads();
            phase_hg_A(C, l, C.bid, C.G);
            if (PROBE_MODE == 1) phase_hg_A(C, l, C.bid, C.G);
        } SEAM(pb + 5);
        if (LEN(6) && IN(pb + 6)) { relaunder(C);
            if (C.G >= 256) {
                if (C.bid < RW_NJOBS) phase_rw_scan(C, C.bid, RW_NJOBS);
                else { const int b = C.bid - RW_NJOBS, n = C.G - RW_NJOBS; phase_hg_B(C, b, n); phase_attn(C, l, b * NWAVES + C.wave, n * NWAVES);
                    if (l + 1 < DEPTH) { __syncthreads(); phase_convert(C, l + 1, 21, b, n); }
                    if (PROBE_MODE == 11) { phase_hg_B(C, b, n); phase_attn(C, l, b * NWAVES + C.wave, n * NWAVES); }
                    if (PROBE_MODE == 12) { phase_attn(C, l, b * NWAVES + C.wave, n * NWAVES); } if (PROBE_MODE == 13) { phase_hg_B(C, b, n); } }
            } else {
                phase_rw_scan(C, C.bid, C.G); phase_hg_B(C, C.bid, C.G); phase_attn(C, l, C.bid * NWAVES + C.wave, C.G * NWAVES);
                if (l + 1 < DEPTH) { __syncthreads(); phase_convert(C, l + 1, 21, C.bid, C.G); }
            }
        } SEAM(pb + 6);
        if (LEN(7) && IN(pb + 7)) { relaunder(C); phase_hg_C(C, l, C.bid, C.G, l == DEPTH - 1 ? SEQ / 64 : NCH); phase_rw_finish(C, l, C.bid * NWAVES + C.wave, C.G * NWAVES, l == DEPTH - 1 ? SEQ : MT);
        } SEAM(pb + 7);
        if (LEN(8) && IN(pb + 8)) { relaunder(C);
            pg8::Gemm g{WSP(bf16_t, OFF_YB), WSP(bf16_t, OFF_WBR), 8, (size_t)MT * 512};
            pg8::StaticOrder S; S.init(l == DEPTH - 1 ? SEQ : MT, 4 * D, C.G, C.bid);
            pg8::EpiMerge E{WSP(bf16_t, OFF_GL), WSP(bf16_t, OFF_P32)};
            pg8::gemm_phase<pg8::EpiMerge, true, true, pg8::StaticOrder, 512, 512, 512, 0>(C.lds, g, S, E, C.tid);
            if (PROBE_MODE == 3) { pg8::gemm_phase<pg8::EpiMerge, true, true, pg8::StaticOrder, 512, 512, 512, 0>(C.lds, g, S, E, C.tid); }
        } SEAM(pb + 8);
        if (LEN(9) && IN(pb + 9)) { relaunder(C); phase_combine(C, l == DEPTH - 1 ? SEQ : MT); } SEAM(pb + 9);
        if (LEN(10) && IN(pb + 10)) { relaunder(C);
            { pg8::Gemm g{WSP(bf16_t, OFF_H), WSP(bf16_t, OFF_WOUT), 1 << 20, 0};
              pg8::StaticOrder S; S.init(SEQ, D, C.G, C.bid);
              pg8::EpiResid<false> E{WSP(float, OFF_X), mod_ptr(C, l, 0, 5), mod_ptr(C, l, 1, 5), nullptr, WSP(float, OFF_X)};
              pg8::gemm_phase<pg8::EpiResid<false>, true, true, pg8::StaticOrder, D, D, D, 0>(C.lds, g, S, E, C.tid); }
            if (l < DEPTH - 1) { relaunder(C);
              pg8::Gemm g{WSP(bf16_t, OFF_H), WSP(bf16_t, OFF_WOUT), 1 << 20, 0};
              pg8::SplitOrder S{SEQ / 256, D / 256, 8, C.G, C.bid};
              pg8::EpiPart<false> E{WSP(float, OFF_P32), mod_ptr(C, l, 1, 5)};
              pg8::gemm_phase<pg8::EpiPart<false>, true, true, pg8::SplitOrder, 256, D, D, 256>(C.lds, g, S, E, C.tid); }
        } SEAM(pb + 10);
        if (LEN(11) && IN(pb + 11)) { relaunder(C); phase_norm(C, l, C.ka->in[I_NF2] + (size_t)l * D, 6, l < DEPTH - 1 ? 8 : 0, l == DEPTH - 1 ? SEQ : MT, 0); } SEAM(pb + 11);
        if (LEN(12) && IN(pb + 12)) { relaunder(C);
            pg8::Gemm g{WSP(bf16_t, OFF_H), WSP(bf16_t, OFF_WI2), 1 << 20, 0};
            pg8::StaticOrder S; S.init(l == DEPTH - 1 ? SEQ : MT, 2 * DFF, C.G, C.bid);
            pg8::EpiSwiGLU E{WSP(bf16_t, OFF_G)};
            pg8::gemm_phase<pg8::EpiSwiGLU, true, true, pg8::StaticOrder, D, D, D, 0>(C.lds, g, S, E, C.tid);
            if (PROBE_MODE == 3) { pg8::gemm_phase<pg8::EpiSwiGLU, true, true, pg8::StaticOrder, D, D, D, 0>(C.lds, g, S, E, C.tid); }
        } SEAM(pb + 12);
        if (LEN(13) && IN(pb + 13)) { relaunder(C);
            { pg8::Gemm g{WSP(bf16_t, OFF_G), WSP(bf16_t, OFF_WO2), 1 << 20, 0};
              pg8::StaticOrder S; S.init(SEQ, D, C.G, C.bid);
              pg8::EpiResid<true> E{WSP(float, OFF_X), mod_ptr(C, l, 0, 8), mod_ptr(C, l, 1, 8), l == DEPTH - 1 ? C.out : nullptr, WSP(float, OFF_X)};
              pg8::gemm_phase<pg8::EpiResid<true>, true, true, pg8::StaticOrder, DFF, DFF, DFF, 0>(C.lds, g, S, E, C.tid); }
            if (l < DEPTH - 1) { relaunder(C);
              pg8::Gemm g{WSP(bf16_t, OFF_G), WSP(bf16_t, OFF_WO2), 1 << 20, 0};
              pg8::SplitOrder S{SEQ / 256, D / 256, 22, C.G, C.bid};
              pg8::EpiPart<true> E{WSP(float, OFF_P32), mod_ptr(C, l, 1, 8)};
              pg8::gemm_phase<pg8::EpiPart<true>, true, true, pg8::SplitOrder, 256, DFF, DFF, 256>(C.lds, g, S, E, C.tid); }
        } SEAM(pb + 13);
    }
#undef IN
#undef SEAM
}

extern "C" void kernel_launch(void* const* d_in, const int* in_sizes, int n_in, void* d_out, int out_size, void* d_ws, size_t ws_size, hipStream_t stream) {
    static int grid = 0;
    if (grid == 0) {
        if (n_in != N_IN || out_size != SEQ * D || ws_size < WS_END) { fprintf(stderr, "kernel_launch: unexpected shapes (n_in %d out %d ws %zu)\n", n_in, out_size, ws_size); grid = -1; return; }
        int dev = 0, cus = 0;
        if (hipGetDevice(&dev) != hipSuccess || hipDeviceGetAttribute(&cus, hipDeviceAttributeMultiprocessorCount, dev) != hipSuccess) { grid = -1; return; }
        if (hipFuncSetAttribute((const void*)mk_fwd, hipFuncAttributeMaxDynamicSharedMemorySize, LDS_BYTES) != hipSuccess) { fprintf(stderr, "kernel_launch: hipFuncSetAttribute failed\n"); grid = -1; return; }
        (void)hipGetLastError();
        grid = cus;
    }
    if (grid < 0) return;
    (void)hipMemsetAsync((char*)d_ws + OFF_CTL, 0, CTL_BYTES, stream);
    Args a{};
    for (int i = 0; i < N_IN; ++i) a.in[i] = (const float*)d_in[i];
    a.out = (float*)d_out; a.ws = (unsigned char*)d_ws;
#if MK_ONE_LAUNCH
    a.ph_lo = 0; a.ph_hi = N_PHASES;
    hipLaunchKernelGGL(mk_fwd, dim3(grid), dim3(NT), LDS_BYTES, stream, a);
#else
    for (int ph = 0; ph < N_PHASES; ++ph) {
        a.ph_lo = ph; a.ph_hi = ph + 1;
        hipLaunchKernelGGL(mk_fwd, dim3(grid), dim3(NT), LDS_BYTES, stream, a);
    }
#endif
}
```

```cpp
#include <hip/hip_runtime.h>
#include <cstdio>
#include <cstdint>

#ifndef PROBE_MODE
#define PROBE_MODE 0
#endif
#ifndef MK_ONE_LAUNCH
#define MK_ONE_LAUNCH 1
#endif

#define LAS __attribute__((address_space(3)))
#define GAS __attribute__((address_space(1)))
typedef unsigned short bf16_t;
typedef short bf16x8 __attribute__((ext_vector_type(8)));
typedef float f32x4 __attribute__((ext_vector_type(4)));
typedef float f32x2 __attribute__((ext_vector_type(2)));
typedef unsigned u32x4 __attribute__((ext_vector_type(4)));
typedef unsigned u32x2 __attribute__((ext_vector_type(2)));

constexpr int D = 2048, SEQ = 8192, CTX = 256, MT = SEQ + CTX, DEPTH = 2, DFF = 5632, NMOD = 9, MODW = NMOD * D;
constexpr int GRID_W = 64;
constexpr int PTOT = 15360, P32W = 4864, PAW = 2304, GLW = 8192;
constexpr int HG_OFF = 0, RW_OFF = 2560, RWC = 2304;
constexpr int NCH = MT / 64;
constexpr int NWAVES = 8, NT = 512;
constexpr float EPS = 1e-6f, RW_GN_EPS = 64e-5f;

constexpr size_t MiB = 1u << 20;
constexpr size_t OFF_CTL = 0, CTL_BYTES = 1 * MiB;
constexpr size_t OFF_W2T = 512 * 1024;
constexpr size_t OFF_MOD = 1 * MiB;
constexpr size_t OFF_MODP = 2 * MiB;
constexpr size_t OFF_WI1 = 11 * MiB, OFF_WO1 = 55 * MiB, OFF_WIN = 77 * MiB, OFF_WBR = 137 * MiB, OFF_WOUT = 145 * MiB, OFF_WI2 = 153 * MiB, OFF_WO2 = 197 * MiB;
constexpr size_t OFF_X = 219 * MiB;
constexpr size_t OFF_H = 285 * MiB;
constexpr size_t OFF_G = 318 * MiB;
constexpr size_t OFF_P32 = 409 * MiB;
constexpr size_t OFF_PA = 566 * MiB;
constexpr size_t OFF_GL = 604 * MiB;
constexpr size_t OFF_HGL = 736 * MiB;
constexpr size_t OFF_HGD = 802 * MiB;
constexpr size_t OFF_SCN = 803 * MiB;
constexpr size_t OFF_VV = 968 * MiB;
constexpr size_t OFF_GS = 985 * MiB;
constexpr size_t OFF_RO = 1002 * MiB;
constexpr size_t OFF_YB = 1035 * MiB;
constexpr size_t OFF_VTN = 1068 * MiB;
constexpr size_t OFF_VTW = 1077 * MiB;
constexpr size_t OFF_PB = 1080 * MiB;
constexpr size_t OFF_MREF = OFF_PB + 65536;
constexpr size_t OFF_SPT = 1081 * MiB;
constexpr size_t OFF_BON = 1114 * MiB;
constexpr size_t OFF_RO2 = 1115 * MiB;
constexpr size_t OFF_KTN = OFF_MODP;
constexpr size_t OFF_KTW = 1148 * MiB;
constexpr size_t WS_END = 1151 * MiB;
constexpr int RW_NCK = MT / 16;
constexpr size_t OFF_RWMG = OFF_G, RWMG_REC = 8192 + 2048;
constexpr size_t OFF_RWH = OFF_SCN, RWH_REC = 16384;
static_assert(16 * (size_t)RW_NCK * RWMG_REC <= 91 * MiB && 16 * (size_t)RW_NCK * RWH_REC <= 165 * MiB, "rwkv chunk records fit their regions");
constexpr int KSPLIT = 32;

constexpr int LDS_BYTES = 147456;
constexpr int RING_BYTES = 131072;
constexpr int MISC_OFF = RING_BYTES + 320;

__device__ __forceinline__ float bf2f(unsigned b) { return __uint_as_float(b << 16); }
__device__ __forceinline__ unsigned f2bf(float f) { unsigned u = __float_as_uint(f); return (u + 0x7fffu + ((u >> 16) & 1u)) >> 16; }
__device__ __forceinline__ unsigned pk2(float lo, float hi) { return f2bf(lo) | (f2bf(hi) << 16); }
__device__ __forceinline__ float wave_sum(float v) {
#pragma unroll
    for (int o = 1; o < 64; o <<= 1) v += __shfl_xor(v, o);
    return v;
}
__device__ __forceinline__ float wave_max(float v) {
#pragma unroll
    for (int o = 1; o < 64; o <<= 1) v = fmaxf(v, __shfl_xor(v, o));
    return v;
}
__device__ __forceinline__ float sigmoidf_(float x) { return 1.0f / (1.0f + expf(-x)); }
__device__ __forceinline__ float siluf_(float x) { return x / (1.0f + expf(-x)); }
typedef float f32x16 __attribute__((ext_vector_type(16)));
#define MFMA32(a, b, c) __builtin_amdgcn_mfma_f32_32x32x16_bf16((a), (b), (c), 0, 0, 0)
#define KOFF(reg) (((reg) & 3) + 8 * ((reg) >> 2))
#define MFMA16(a, b, c) __builtin_amdgcn_mfma_f32_16x16x32_bf16((a), (b), (c), 0, 0, 0)
#define LDS_WAIT() asm volatile("s_waitcnt lgkmcnt(0)" ::: "memory")

__device__ __forceinline__ int seq_row(int d, int j) { return d == 0 ? (j < CTX ? SEQ + j : j - CTX) : (MT - 1 - j); }
__device__ __forceinline__ int row_seq(int d, int r) { return d == 0 ? (r >= SEQ ? r - SEQ : r + CTX) : (MT - 1 - r); }

#define XB_TMO      128
#define XB_XCNT(j)  (256  + 64 * (j))
#define XB_XSUB(j)  (1280 + 64 * (j))
#define XB_XGEN(j)  (2304 + 64 * (j))
#define XB_TOP      3328
#define XB_TOPGEN   3392
#define XCD_BAR_WORDS 3456
#define XB_SPIN_CAP (1u << 18)
__device__ __forceinline__ unsigned xb_ld(unsigned* p)              { return __hip_atomic_load(p, __ATOMIC_RELAXED, __HIP_MEMORY_SCOPE_AGENT); }
__device__ __forceinline__ unsigned xb_add(unsigned* p, unsigned v) { return __hip_atomic_fetch_add(p, v, __ATOMIC_RELAXED, __HIP_MEMORY_SCOPE_AGENT); }
__device__ __forceinline__ unsigned xb_xcc_id() { return (unsigned)__builtin_amdgcn_s_getreg((3 << 11) | 20) & 0xFu; }
#define XB_SPIN(cond, bar) do { unsigned _sp = 0; while (cond) { __builtin_amdgcn_s_sleep(1); \
    if ((++_sp & 255u) == 0u) { if (xb_ld(&(bar)[XB_TMO])) break; if (_sp > XB_SPIN_CAP) { atomicAdd(&(bar)[XB_TMO], 1u); break; } } } } while (0)
struct XcdBarrier { unsigned* bar; unsigned x; volatile LAS unsigned* st; };
__device__ __forceinline__ XcdBarrier xcd_barrier_post(unsigned* bar, volatile LAS unsigned* st) {
    XcdBarrier b; b.bar = bar; b.x = xb_xcc_id(); b.st = st;
    if (threadIdx.x == 0) (void)xb_add(&bar[XB_XCNT(b.x)], 1u);
    return b;
}
__device__ __forceinline__ void xcd_barrier_complete(unsigned* bar, unsigned x, unsigned& nloc, unsigned& nx) {
    const unsigned G = gridDim.x * gridDim.y * gridDim.z;
    unsigned sum, cnt, mine, sp = 0u;
    for (;;) {
        sum = 0u; cnt = 0u; mine = 0u;
#pragma unroll
        for (unsigned j = 0; j < 16; ++j) { const unsigned c = xb_ld(&bar[XB_XCNT(j)]); sum += c; cnt += (c > 0u) ? 1u : 0u; mine = (j == x) ? c : mine; }
        if (sum == G) break;
        __builtin_amdgcn_s_sleep(1);
        if ((++sp & 255u) == 0u) { if (xb_ld(&bar[XB_TMO])) break; if (sp > XB_SPIN_CAP) { atomicAdd(&bar[XB_TMO], 1u); break; } }
    }
    nloc = mine > 0u ? mine : 1u; nx = cnt > 0u ? cnt : 1u;
}
__device__ __forceinline__ void xcd_barrier(const XcdBarrier& b) {
    asm volatile("s_waitcnt vmcnt(0)" ::: "memory");
    __syncthreads();
    if (threadIdx.x == 0) {
        unsigned* bar = b.bar;
        __builtin_amdgcn_s_waitcnt(0);
        unsigned nloc = b.st[0], nx = b.st[1];
        if (nloc == 0u) { xcd_barrier_complete(bar, b.x, nloc, nx); b.st[0] = nloc; b.st[1] = nx; }
        const unsigned old = xb_add(&bar[XB_XSUB(b.x)], 1u);
        const unsigned gen = old / nloc;
        if (old + 1u == (gen + 1u) * nloc) {
            __builtin_amdgcn_fence(__ATOMIC_RELEASE, "agent");
            asm volatile("s_waitcnt vmcnt(0)" ::: "memory");
            const unsigned og = xb_add(&bar[XB_TOP], 1u);
            const unsigned tg = og / nx;
            if (og + 1u == (tg + 1u) * nx) xb_add(&bar[XB_TOPGEN], 1u);
            else XB_SPIN(xb_ld(&bar[XB_TOPGEN]) == tg, bar);
            __builtin_amdgcn_fence(__ATOMIC_ACQUIRE, "agent");
            xb_add(&bar[XB_XGEN(b.x)], 1u);
            asm volatile("s_waitcnt vmcnt(0)" ::: "memory");
        } else {
            XB_SPIN(xb_ld(&bar[XB_XGEN(b.x)]) == gen, bar);
            __builtin_amdgcn_fence(__ATOMIC_ACQUIRE, "agent");
            asm volatile("s_waitcnt vmcnt(0)" ::: "memory");
        }
    }
    __syncthreads();
}

namespace pg8 {
constexpr int BM = 256, BK = 64, HALF = 128, HTB = HALF * BK * 2, STAGE_BYTES = 8 * HTB, NXCD = 8, WGM = 8;
__host__ __device__ __forceinline__ int lds_byte(int r, int c) { const int st = (r >> 4) * 2 + (c >> 5), rr = r & 15, cc = c & 31, ob = rr * 64 + cc * 2; return st * 1024 + (ob ^ (((ob >> 9) & 1) << 5)); }
__host__ __device__ __forceinline__ void stage_rc(int b, int& R, int& C) { const int st = b / 1024, sb = b % 1024, swz = sb ^ (((sb >> 9) & 1) << 5); R = (st >> 1) * 16 + swz / 64; C = (st & 1) * 32 + (swz % 64) / 2; }
__host__ __device__ __forceinline__ int perm32(int rho) { const int n = rho >> 4, i = rho & 15; return 8 * (i >> 2) + 4 * n + (i & 3); }
struct Unit { int pm, pn, ks; };
struct Gemm { const bf16_t* A; const bf16_t* Bt; size_t a_gstride; size_t a_kgs; int a_div, b_mod, b_gcol, pad; };
__device__ __forceinline__ Gemm mkgemm(const bf16_t* A, const bf16_t* Bt) { Gemm g; g.A = A; g.Bt = Bt; g.a_gstride = 0; g.a_kgs = 0; g.a_div = 1 << 20; g.b_mod = 1 << 20; g.b_gcol = 0; g.pad = 0; return g; }
struct StaticOrder {
    int nM, nN, nwg, G, c;
    __host__ __device__ void init(int M, int N, int G_, int c_) { nM = M / BM; nN = N / BM; nwg = nM * nN; G = G_; c = c_; }
    __host__ __device__ bool next(int i, Unit& u) const {
        const long L = (long)i * G + c; if (L >= nwg) return false;
        int wgid = (int)L; { const int q = nwg / NXCD, r = nwg % NXCD, xcd = wgid % NXCD, off = wgid / NXCD; wgid = (xcd < r ? xcd * (q + 1) : r * (q + 1) + (xcd - r) * q) + off; }
        const int nig = WGM * nN, gid = wgid / nig, fm = gid * WGM, gsz = (nM - fm) < WGM ? (nM - fm) : WGM;
        u.pm = fm + ((wgid % nig) % gsz); u.pn = (wgid % nig) / gsz; u.ks = 0; return true;
    }
};
struct SplitOrder {
    int pm, nN, KS, G, c;
    __host__ __device__ bool next(int i, Unit& u) const { const int L = i * G + c; if (L >= nN * KS) return false; u.pm = pm; u.pn = L / KS; u.ks = L % KS; return true; }
};
__device__ __forceinline__ unsigned cvt_pk_bf16(float lo, float hi) { unsigned r; asm volatile("v_cvt_pk_bf16_f32 %0, %1, %2" : "=v"(r) : "v"(lo), "v"(hi)); return r; }

template <class Epi, bool ALIGN_EPI, bool SP2, class Sched, int KE, int LDA, int LDB, int KSS, int AGRP = 0>
__device__ __forceinline__ void gemm_phase(LAS unsigned char* lds, const Gemm g, const Sched& S, const Epi& E, const int tid) {
    const int wid = __builtin_amdgcn_readfirstlane(tid >> 6), lane = tid & 63, wr = wid >> 2, wc = wid & 3, fr = lane & 15, fq = lane >> 4;
    constexpr int nt = KE / BK;
    static_assert(!Epi::MIDK || SP2, "the mid-K hook sits in the SP2 loop only");
    unsigned voffA[2], voffB[2];
#pragma unroll
    for (int i = 0; i < 2; ++i) { int R, C; stage_rc(tid * 16 + i * 8192, R, C); const int Rb = Epi::PERM ? ((R & ~31) + perm32(R & 31)) : R;
        voffA[i] = (unsigned)(R * LDA + C) * 2u; voffB[i] = (unsigned)(Rb * LDB + C) * 2u; }
    const size_t kstep = (size_t)(BK * 2);
    constexpr size_t hstepA = (size_t)HALF * LDA * 2, hstepB = (size_t)HALF * LDB * 2;
    const unsigned ldsw = (unsigned)wid * 1024u;
    const int aoff = lds_byte(wr * 64 + fr, fq * 8), boff = lds_byte(wc * 32 + fr, fq * 8);
#define PG8_SA(b, h) (((b) * 2 + (h)) * HTB)
#define PG8_SB(b, h) ((4 + (b) * 2 + (h)) * HTB)
#define PG8_STAGE(bufoff, gbase, voff) do { _Pragma("unroll") for (int _i = 0; _i < 2; ++_i) \
        __builtin_amdgcn_global_load_lds((const unsigned*)((const char*)(gbase) + (voff)[_i]), (LAS unsigned*)(lds + (bufoff) + ldsw + _i * 8192), 16, 0, 0); } while (0)
#define PG8_LDA(dst, b, h) do { _Pragma("unroll") for (int m = 0; m < 4; ++m) _Pragma("unroll") for (int k = 0; k < 2; ++k) dst[m][k] = *(const LAS bf16x8*)(lds + PG8_SA(b, h) + aoff + m * 2048 + k * 1024); } while (0)
#define PG8_LDB(dst, b, h) do { _Pragma("unroll") for (int n = 0; n < 2; ++n) _Pragma("unroll") for (int k = 0; k < 2; ++k) dst[n][k] = *(const LAS bf16x8*)(lds + PG8_SB(b, h) + boff + n * 2048 + k * 1024); } while (0)
#define PG8_MMA(ai, bj, At, Bt) do { __builtin_amdgcn_s_setprio(1); _Pragma("unroll") for (int m = 0; m < 4; ++m) _Pragma("unroll") for (int n = 0; n < 2; ++n) _Pragma("unroll") for (int k = 0; k < 2; ++k) \
        acc[ai][bj][m][n] = __builtin_amdgcn_mfma_f32_16x16x32_bf16(Bt[n][k], At[m][k], acc[ai][bj][m][n], 0, 0, 0); __builtin_amdgcn_s_setprio(0); } while (0)
#define PG8_WAIT_V(n) asm volatile("s_waitcnt vmcnt(" #n ")" ::: "memory")
#define PG8_WAIT_L(n) asm volatile("s_waitcnt lgkmcnt(" #n ")" ::: "memory")
#define PG8_BAR __builtin_amdgcn_s_barrier()
#define PG8_SCHED __builtin_amdgcn_sched_barrier(0)
#define PG8_ABASE(u) ((const char*)g.A + ((size_t)((u).pn / g.a_div) * g.a_gstride) * 2 + (size_t)(u).pm * 2 * hstepA + (size_t)(u).ks * KSS * 2)
#define PG8_BBASE(u) ((const char*)g.Bt + (size_t)((u).pn % g.b_mod) * 2 * hstepB + ((size_t)((u).pn / g.b_mod) * g.b_gcol + (size_t)(u).ks * KSS) * 2)
#define PG8_AT(tt) (AGRP ? (size_t)((tt) / (AGRP ? AGRP : 1)) * g.a_kgs + (size_t)((tt) % (AGRP ? AGRP : 1)) * kstep : (size_t)(tt) * kstep)
    Unit cur, nxt; int ui = 0;
    if (!S.next(0, cur)) return;
    f32x4 acc[2][2][4][2];
#pragma unroll
    for (int a = 0; a < 2; ++a)
#pragma unroll
        for (int b = 0; b < 2; ++b)
#pragma unroll
            for (int m = 0; m < 4; ++m)
#pragma unroll
                for (int n = 0; n < 2; ++n) acc[a][b][m][n] = (f32x4){0.f, 0.f, 0.f, 0.f};
    bf16x8 At[4][2], B0[2][2], B1[2][2];
    const char* cA = PG8_ABASE(cur); const char* cB = PG8_BBASE(cur);
    if constexpr (SP2) {
        PG8_STAGE(PG8_SB(0, 0), cB, voffB); PG8_STAGE(PG8_SB(0, 1), cB + hstepB, voffB); PG8_STAGE(PG8_SA(0, 0), cA, voffA); PG8_STAGE(PG8_SA(0, 1), cA + hstepA, voffA);
        if (wr == 1) PG8_BAR;
        PG8_WAIT_V(2); PG8_BAR;
        PG8_STAGE(PG8_SB(1, 0), cB + kstep, voffB); PG8_STAGE(PG8_SA(1, 0), cA + kstep, voffA); PG8_STAGE(PG8_SB(1, 1), cB + hstepB + kstep, voffB);
        PG8_WAIT_V(6); PG8_BAR;
    } else {
        PG8_STAGE(PG8_SB(0, 0), cB, voffB); PG8_STAGE(PG8_SA(0, 0), cA, voffA); PG8_STAGE(PG8_SB(0, 1), cB + hstepB, voffB); PG8_STAGE(PG8_SA(0, 1), cA + hstepA, voffA);
        if (wr == 1) PG8_BAR;
        PG8_WAIT_V(4); PG8_BAR;
        PG8_STAGE(PG8_SB(1, 0), cB + kstep, voffB); PG8_STAGE(PG8_SA(1, 0), cA + kstep, voffA); PG8_STAGE(PG8_SB(1, 1), cB + hstepB + kstep, voffB);
        PG8_WAIT_V(6); PG8_BAR;
    }
    for (;;) {
        const bool has_next = S.next(ui + 1, nxt);
        const char* nA = has_next ? PG8_ABASE(nxt) : cA; const char* nB = has_next ? PG8_BBASE(nxt) : cB;
#pragma unroll 1
        for (int t = 0; t < nt; t += 2) {
            const bool last = (t == nt - 2);
            const char* a1 = cA + PG8_AT(t + 1);
            const char* a2 = last ? nA : cA + PG8_AT(t + 2); const char* b2 = last ? nB : cB + (size_t)(t + 2) * kstep;
            const char* a3 = last ? nA + kstep : cA + PG8_AT(t + 3); const char* b3 = b2 + kstep;
            if constexpr (SP2) {
            PG8_LDB(B0, 0, 0); PG8_LDB(B1, 0, 1); PG8_SCHED; PG8_LDA(At, 0, 0); PG8_STAGE(PG8_SA(1, 1), a1 + hstepA, voffA);
            PG8_WAIT_V(8); PG8_WAIT_L(0); PG8_BAR;
            if constexpr (Epi::MIDK) { if (t > 0 && (t % (AGRP ? AGRP : 1)) == 0) { int fr3 = fr, fq3 = fq; asm volatile("" : "+v"(fr3), "+v"(fq3)); E.mid(acc, cur, t / (AGRP ? AGRP : 1), wr, wc, fr3, fq3); } }
            PG8_MMA(0, 0, At, B0); PG8_MMA(0, 1, At, B1); PG8_BAR; PG8_SCHED;
            PG8_LDA(At, 0, 1); PG8_STAGE(PG8_SB(0, 0), b2, voffB); PG8_STAGE(PG8_SB(0, 1), b2 + hstepB, voffB); PG8_STAGE(PG8_SA(0, 0), a2, voffA);
            PG8_WAIT_V(8); PG8_WAIT_L(0); PG8_BAR; PG8_MMA(1, 0, At, B0); PG8_MMA(1, 1, At, B1); PG8_BAR; PG8_SCHED;
            PG8_LDB(B0, 1, 0); PG8_LDB(B1, 1, 1); PG8_SCHED; PG8_LDA(At, 1, 0); PG8_STAGE(PG8_SA(0, 1), a2 + hstepA, voffA);
            PG8_WAIT_V(8); PG8_WAIT_L(0); PG8_BAR; PG8_MMA(0, 0, At, B0); PG8_MMA(0, 1, At, B1); PG8_BAR; PG8_SCHED;
            PG8_LDA(At, 1, 1); PG8_STAGE(PG8_SB(1, 0), b3, voffB); PG8_STAGE(PG8_SB(1, 1), b3 + hstepB, voffB); PG8_STAGE(PG8_SA(1, 0), a3, voffA);
            PG8_WAIT_V(8); PG8_WAIT_L(0); PG8_BAR; PG8_MMA(1, 0, At, B0); PG8_MMA(1, 1, At, B1); PG8_BAR; PG8_SCHED;
            } else {
            PG8_LDB(B0, 0, 0); PG8_SCHED; PG8_LDA(At, 0, 0); PG8_STAGE(PG8_SA(1, 1), a1 + hstepA, voffA);
            PG8_WAIT_L(8); PG8_BAR; PG8_WAIT_L(0); PG8_MMA(0, 0, At, B0); PG8_BAR; PG8_SCHED;
            PG8_LDB(B1, 0, 1); PG8_STAGE(PG8_SB(0, 0), b2, voffB);
            PG8_BAR; PG8_WAIT_L(0); PG8_MMA(0, 1, At, B1); PG8_BAR;
            PG8_LDA(At, 0, 1); PG8_STAGE(PG8_SA(0, 0), a2, voffA);
            PG8_BAR; PG8_WAIT_L(0); PG8_MMA(1, 0, At, B0); PG8_BAR; PG8_SCHED;
            PG8_STAGE(PG8_SB(0, 1), b2 + hstepB, voffB);
            PG8_WAIT_V(6); PG8_BAR; PG8_MMA(1, 1, At, B1); PG8_BAR;
            PG8_LDB(B0, 1, 0); PG8_SCHED; PG8_LDA(At, 1, 0); PG8_STAGE(PG8_SA(0, 1), a2 + hstepA, voffA);
            PG8_WAIT_L(8); PG8_BAR; PG8_WAIT_L(0); PG8_MMA(0, 0, At, B0); PG8_BAR; PG8_SCHED;
            PG8_LDB(B1, 1, 1); PG8_STAGE(PG8_SB(1, 0), b3, voffB);
            PG8_BAR; PG8_WAIT_L(0); PG8_MMA(0, 1, At, B1); PG8_BAR;
            PG8_LDA(At, 1, 1); PG8_STAGE(PG8_SA(1, 0), a3, voffA);
            PG8_BAR; PG8_WAIT_L(0); PG8_MMA(1, 0, At, B0); PG8_BAR; PG8_SCHED;
            PG8_STAGE(PG8_SB(1, 1), b3 + hstepB, voffB);
            PG8_WAIT_V(6); PG8_BAR; PG8_MMA(1, 1, At, B1); PG8_BAR;
            }
        }
        if constexpr (ALIGN_EPI) { if (wr == 0) PG8_BAR; }
        { int fr2 = fr, fq2 = fq; asm volatile("" : "+v"(fr2), "+v"(fq2));
          E(acc, cur, wr, wc, fr2, fq2); }
        if (!has_next) break;
#pragma unroll
        for (int a = 0; a < 2; ++a)
#pragma unroll
            for (int b = 0; b < 2; ++b)
#pragma unroll
                for (int m = 0; m < 4; ++m)
#pragma unroll
                    for (int n = 0; n < 2; ++n) acc[a][b][m][n] = (f32x4){0.f, 0.f, 0.f, 0.f};
        cur = nxt; cA = nA; cB = nB; ++ui;
        if constexpr (ALIGN_EPI) { if (wr == 1) PG8_BAR; }
    }
    PG8_WAIT_V(0);
    if constexpr (!ALIGN_EPI) { if (wr == 0) PG8_BAR; }
    PG8_BAR;
#undef PG8_SA
#undef PG8_SB
#undef PG8_STAGE
#undef PG8_LDA
#undef PG8_LDB
#undef PG8_MMA
#undef PG8_WAIT_V
#undef PG8_WAIT_L
#undef PG8_BAR
#undef PG8_SCHED
#undef PG8_ABASE
#undef PG8_BBASE
#undef PG8_AT
}

struct EpiSwiGLU {
    static constexpr bool PERM = true, MIDK = false;
    bf16_t* O;
    __device__ __forceinline__ void operator()(const f32x4 (&acc)[2][2][4][2], const Unit& u, int wr, int wc, int fr, int fq) const {
        const int row0 = u.pm * BM + wr * 64 + fr, col0 = u.pn * HALF + wc * 32 + 8 * fq;
#pragma unroll
        for (int ai = 0; ai < 2; ++ai)
#pragma unroll
            for (int m = 0; m < 4; ++m) {
                bf16_t* rowp = O + (size_t)(row0 + ai * HALF + m * 16) * DFF + col0;
                float o[8];
#pragma unroll
                for (int n = 0; n < 2; ++n)
#pragma unroll
                    for (int j = 0; j < 4; ++j) { const float a = acc[ai][0][m][n][j], b = acc[ai][1][m][n][j]; o[n * 4 + j] = a / (1.0f + __expf(-a)) * b; }
                u32x4 w; w.x = cvt_pk_bf16(o[0], o[1]); w.y = cvt_pk_bf16(o[2], o[3]); w.z = cvt_pk_bf16(o[4], o[5]); w.w = cvt_pk_bf16(o[6], o[7]);
                *(u32x4*)rowp = w;
            }
    }
};
template <bool HALFGATE> struct EpiResid {
    static constexpr bool PERM = false, MIDK = false;
    float* X; const float* gate_lat; const float* gate_ctx; float* out; const float* base;
    __device__ __forceinline__ void operator()(const f32x4 (&acc)[2][2][4][2], const Unit& u, int wr, int wc, int fr, int fq) const {
        const int row0 = u.pm * BM + wr * 64 + fr, col0 = u.pn * BM + wc * 32 + 4 * fq;
        const float* gp = (u.pm * BM >= SEQ) ? gate_ctx : gate_lat;
#pragma unroll
        for (int bj = 0; bj < 2; ++bj)
#pragma unroll
            for (int n = 0; n < 2; ++n) {
                const f32x4 gv = *(const f32x4*)(gp + col0 + bj * HALF + n * 16) * (HALFGATE ? 0.5f : 1.0f);
#pragma unroll
                for (int ai = 0; ai < 2; ++ai)
#pragma unroll
                    for (int m = 0; m < 4; ++m) {
                        const int row = row0 + ai * HALF + m * 16;
                        float* p = X + (size_t)row * D + col0 + bj * HALF + n * 16;
                        const f32x4 v = *(const f32x4*)(base + (size_t)row * D + col0 + bj * HALF + n * 16) + gv * acc[ai][bj][m][n];
                        *(f32x4*)p = v;
                        if (out != nullptr && row < SEQ) *(f32x4*)(out + (size_t)row * D + col0 + bj * HALF + n * 16) = v;
                    }
            }
    }
};
template <bool HALFGATE> struct EpiPart {
    static constexpr bool PERM = false, MIDK = false;
    float* PART; const float* gate_ctx;
    __device__ __forceinline__ void operator()(const f32x4 (&acc)[2][2][4][2], const Unit& u, int wr, int wc, int fr, int fq) const {
        const int row0 = wr * 64 + fr, col0 = u.pn * BM + wc * 32 + 4 * fq;
        f32x4 gv[2][2];
#pragma unroll
        for (int bj = 0; bj < 2; ++bj)
#pragma unroll
            for (int n = 0; n < 2; ++n) gv[bj][n] = *(const f32x4*)(gate_ctx + col0 + bj * HALF + n * 16) * (HALFGATE ? 0.5f : 1.0f);
#pragma unroll
        for (int ai = 0; ai < 2; ++ai)
#pragma unroll
            for (int m = 0; m < 4; ++m) {
                float* rowp = PART + ((size_t)u.ks * BM + row0 + ai * HALF + m * 16) * D + col0;
#pragma unroll
                for (int bj = 0; bj < 2; ++bj)
#pragma unroll
                    for (int n = 0; n < 2; ++n) *(f32x4*)(rowp + bj * HALF + n * 16) = gv[bj][n] * acc[ai][bj][m][n];
            }
    }
};
struct EpiWin {
    static constexpr bool PERM = true, MIDK = false;
    float* P32; bf16_t* PA; bf16_t* GL; long pn_off;
    __device__ __forceinline__ void operator()(const f32x4 (&acc)[2][2][4][2], const Unit& u0, int wr, int wc, int fr, int fq) const {
        Unit u; u.pm = u0.pm; u.pn = u0.pn + (int)pn_off;
        const int row0 = u.pm * BM + wr * 64 + fr, cin = wc * 32 + 8 * fq;
        if (u.pn < 19) {
#pragma unroll
            for (int ai = 0; ai < 2; ++ai)
#pragma unroll
                for (int m = 0; m < 4; ++m) { float* rowp = P32 + (size_t)(row0 + ai * HALF + m * 16) * P32W + u.pn * BM + cin;
#pragma unroll
                    for (int bj = 0; bj < 2; ++bj) { *(f32x4*)(rowp + bj * HALF) = acc[ai][bj][m][0]; *(f32x4*)(rowp + bj * HALF + 4) = acc[ai][bj][m][1]; } }
        } else {
            bf16_t* base; int ld, colt;
            if (u.pn < 28) { base = PA; ld = PAW; colt = (u.pn - 19) * BM; } else { base = GL; ld = GLW; colt = (u.pn - 28) * BM; }
#pragma unroll
            for (int ai = 0; ai < 2; ++ai)
#pragma unroll
                for (int m = 0; m < 4; ++m) { bf16_t* rowp = base + (size_t)(row0 + ai * HALF + m * 16) * ld + colt + cin;
#pragma unroll
                    for (int bj = 0; bj < 2; ++bj) { const f32x4 v0 = acc[ai][bj][m][0], v1 = acc[ai][bj][m][1];
                        u32x4 w; w.x = cvt_pk_bf16(v0[0], v0[1]); w.y = cvt_pk_bf16(v0[2], v0[3]); w.z = cvt_pk_bf16(v1[0], v1[1]); w.w = cvt_pk_bf16(v1[2], v1[3]);
                        *(u32x4*)(rowp + bj * HALF) = w; } }
        }
    }
};
struct EpiMerge {
    static constexpr bool PERM = true, MIDK = false;
    const bf16_t* GL; bf16_t* PROJ;
    __device__ __forceinline__ void operator()(const f32x4 (&acc)[2][2][4][2], const Unit& u, int wr, int wc, int fr, int fq) const {
        const int row0 = u.pm * BM + wr * 64 + fr, col0 = u.pn * BM + wc * 32 + 8 * fq;
#pragma unroll
        for (int ai = 0; ai < 2; ++ai)
#pragma unroll
            for (int m = 0; m < 4; ++m) { const size_t ro = (size_t)(row0 + ai * HALF + m * 16) * GLW + col0;
#pragma unroll
                for (int bj = 0; bj < 2; ++bj) {
                    const u32x4 gw = *(const u32x4*)(GL + ro + bj * HALF);
                    const f32x4 v0 = acc[ai][bj][m][0], v1 = acc[ai][bj][m][1];
                    float o[8];
                    o[0] = v0[0] / (1.0f + __expf(-bf2f(gw.x & 0xffffu))); o[1] = v0[1] / (1.0f + __expf(-bf2f(gw.x >> 16)));
                    o[2] = v0[2] / (1.0f + __expf(-bf2f(gw.y & 0xffffu))); o[3] = v0[3] / (1.0f + __expf(-bf2f(gw.y >> 16)));
                    o[4] = v1[0] / (1.0f + __expf(-bf2f(gw.z & 0xffffu))); o[5] = v1[1] / (1.0f + __expf(-bf2f(gw.z >> 16)));
                    o[6] = v1[2] / (1.0f + __expf(-bf2f(gw.w & 0xffffu))); o[7] = v1[3] / (1.0f + __expf(-bf2f(gw.w >> 16)));
                    u32x4 w; w.x = cvt_pk_bf16(o[0], o[1]); w.y = cvt_pk_bf16(o[2], o[3]); w.z = cvt_pk_bf16(o[4], o[5]); w.w = cvt_pk_bf16(o[6], o[7]);
                    *(u32x4*)(PROJ + ro + bj * HALF) = w; } }
    }
};
struct EpiMergeF {
    static constexpr bool PERM = true, MIDK = true;
    const bf16_t* GL; bf16_t* MG;
    __device__ __forceinline__ void mid(f32x4 (&acc)[2][2][4][2], const Unit& u, int g, int wr, int wc, int fr, int fq) const {
        const int row0 = u.pm * BM + wr * 64 + fr, col0 = u.pn * BM + wc * 32 + 8 * fq;
#pragma unroll
        for (int ai = 0; ai < 2; ++ai)
#pragma unroll
            for (int m = 0; m < 4; ++m) { const bf16_t* gp = GL + (size_t)(row0 + ai * HALF + m * 16) * GLW + (size_t)(g - 1) * D + col0;
#pragma unroll
                for (int bj = 0; bj < 2; ++bj) {
                    const u32x4 ga = *(const u32x4*)(gp + bj * HALF), gb = *(const u32x4*)(gp + D + bj * HALF);
                    const unsigned wa[4] = {ga.x, ga.y, ga.z, ga.w}, wb[4] = {gb.x, gb.y, gb.z, gb.w};
#pragma unroll
                    for (int j = 0; j < 4; ++j) {
                        const float r0 = (1.0f + __expf(-bf2f(wb[j] & 0xffffu))) * __builtin_amdgcn_rcpf(1.0f + __expf(-bf2f(wa[j] & 0xffffu)));
                        const float r1 = (1.0f + __expf(-bf2f(wb[j] >> 16))) * __builtin_amdgcn_rcpf(1.0f + __expf(-bf2f(wa[j] >> 16)));
                        acc[ai][bj][m][j >> 1][(j & 1) * 2] *= r0; acc[ai][bj][m][j >> 1][(j & 1) * 2 + 1] *= r1;
                    }
                }
            }
    }
    __device__ __forceinline__ void operator()(const f32x4 (&acc)[2][2][4][2], const Unit& u, int wr, int wc, int fr, int fq) const {
        const int row0 = u.pm * BM + wr * 64 + fr, col0 = u.pn * BM + wc * 32 + 8 * fq;
#pragma unroll
        for (int ai = 0; ai < 2; ++ai)
#pragma unroll
            for (int m = 0; m < 4; ++m) { const int row = row0 + ai * HALF + m * 16;
#pragma unroll
                for (int bj = 0; bj < 2; ++bj) {
                    const u32x4 gw = *(const u32x4*)(GL + (size_t)row * GLW + 3 * D + col0 + bj * HALF);
                    const unsigned wg[4] = {gw.x, gw.y, gw.z, gw.w};
                    float o[8];
#pragma unroll
                    for (int j = 0; j < 4; ++j) {
                        o[2 * j] = acc[ai][bj][m][j >> 1][(j & 1) * 2] * __builtin_amdgcn_rcpf(1.0f + __expf(-bf2f(wg[j] & 0xffffu)));
                        o[2 * j + 1] = acc[ai][bj][m][j >> 1][(j & 1) * 2 + 1] * __builtin_amdgcn_rcpf(1.0f + __expf(-bf2f(wg[j] >> 16)));
                    }
                    u32x4 w; w.x = cvt_pk_bf16(o[0], o[1]); w.y = cvt_pk_bf16(o[2], o[3]); w.z = cvt_pk_bf16(o[4], o[5]); w.w = cvt_pk_bf16(o[6], o[7]);
                    *(u32x4*)(MG + (size_t)row * D + col0 + bj * HALF) = w; } }
    }
};
}

enum { I_X = 0, I_C, I_CTX, I_CCTX, I_ADAW, I_ADAB, I_NF1, I_NMIX, I_NF2, I_F1WI, I_F1WO, I_F2WI, I_F2WO, I_WIN, I_HGLB, I_HGNORM, I_RWSHIFT, I_RWW0, I_RWW2, I_RWA0, I_RWA2,
       I_RWKK, I_RWKA, I_RWRK, I_RWLNW, I_RWLNB, I_NAQN, I_NAKN, I_NARPB, I_WAQN, I_WAKN, I_WASINK, I_WBR, I_WOUT, N_IN };
struct Args { const float* in[N_IN]; float* out; unsigned char* ws; int ph_lo, ph_hi; };
struct Ctx {
    LAS unsigned char* lds;
    int tid, lane, wave, bid, G;
    const Args __attribute__((address_space(4)))* ka; float* out; unsigned char* ws;
};
#define WSP(T, off) ((T*)(C.ws + (off)))
__device__ __forceinline__ void relaunder(Ctx& C) {
    int t = C.tid, b = C.bid, g = C.G;
    asm volatile("" : "+v"(t), "+v"(b), "+v"(g));
    C.tid = t; C.lane = t & 63; C.wave = __builtin_amdgcn_readfirstlane(t >> 6); C.bid = __builtin_amdgcn_readfirstlane(b); C.G = __builtin_amdgcn_readfirstlane(g);
}

__device__ __forceinline__ void transpose_item(const float* W, int K, int N, bf16_t* WT, int mode, LAS float* scr, int item, int lane, int ldw = 0, int coff = 0) {
    if (ldw == 0) ldw = K;
    const int nblk = N / 32, kb = item / nblk, nb = item % nblk, k0 = 64 * kb, n0 = 32 * nb;
    int drow0 = n0;
    if (mode == 1) { const int half = n0 / DFF, j0 = n0 % DFF; drow0 = 256 * (j0 / 128) + 128 * half + (j0 % 128); }
    { const int kr = lane >> 3, n4 = lane & 7;
      f32x4 v[8];
#pragma unroll
      for (int i = 0; i < 8; ++i) v[i] = *(const f32x4*)(W + (size_t)(k0 + 8 * i + kr) * N + n0 + 4 * n4);
#pragma unroll
      for (int i = 0; i < 8; ++i)
#pragma unroll
          for (int j = 0; j < 4; ++j) scr[(8 * i + kr) * 33 + 4 * n4 + j] = v[i][j]; }
    LDS_WAIT(); asm volatile("" ::: "memory");
    const int c = lane & 7;
#pragma unroll
    for (int j = 0; j < 4; ++j) { const int n = (lane >> 3) + 8 * j; const LAS float* s = scr + (8 * c) * 33 + n;
        u32x4 o; o.x = pk2(s[0 * 33], s[1 * 33]); o.y = pk2(s[2 * 33], s[3 * 33]); o.z = pk2(s[4 * 33], s[5 * 33]); o.w = pk2(s[6 * 33], s[7 * 33]);
        *(u32x4*)(WT + (size_t)(drow0 + n) * ldw + coff + k0 + 8 * c) = o; }
    LDS_WAIT(); asm volatile("" ::: "memory");
}
__device__ __forceinline__ void phase_convert(Ctx& C, int l, int mask, int b0, int nbk) {
    LAS float* scr = (LAS float*)(C.lds + C.wave * 16384);
    const int gw = b0 * NWAVES + C.wave, NGW = nbk * NWAVES;
    constexpr int I_WI = (D / 64) * (2 * DFF / 32), I_WO = (DFF / 64) * (D / 32), I_IN = (D / 64) * (PTOT / 32), I_BR = (512 / 64) * (D / 32), I_OUT = (D / 64) * (D / 32);
    constexpr int NITEMS = 2 * I_WI + 2 * I_WO + I_IN + 4 * I_BR + I_OUT;
    for (int it = gw; it < NITEMS; it += NGW) {
        int r = it;
        if (r < I_WI) { if (mask & 1) transpose_item(C.ka->in[I_F1WI] + (size_t)l * D * 2 * DFF, D, 2 * DFF, WSP(bf16_t, OFF_WI1), 1, scr, r, C.lane); continue; } r -= I_WI;
        if (r < I_WI) { if (mask & 2) transpose_item(C.ka->in[I_F2WI] + (size_t)l * D * 2 * DFF, D, 2 * DFF, WSP(bf16_t, OFF_WI2), 1, scr, r, C.lane); continue; } r -= I_WI;
        if (r < I_WO) { if (mask & 4) transpose_item(C.ka->in[I_F1WO] + (size_t)l * DFF * D, DFF, D, WSP(bf16_t, OFF_WO1), 0, scr, r, C.lane); continue; } r -= I_WO;
        if (r < I_WO) { if (mask & 8) transpose_item(C.ka->in[I_F2WO] + (size_t)l * DFF * D, DFF, D, WSP(bf16_t, OFF_WO2), 0, scr, r, C.lane); continue; } r -= I_WO;
        if (r < I_IN) { if (mask & 16) transpose_item(C.ka->in[I_WIN] + (size_t)l * D * PTOT, D, PTOT, WSP(bf16_t, OFF_WIN), 0, scr, r, C.lane); continue; } r -= I_IN;
        if (r < 4 * I_BR) { const int g = r / I_BR; if (mask & 32) transpose_item(C.ka->in[I_WBR] + ((size_t)l * 4 + g) * 512 * D, 512, D, WSP(bf16_t, OFF_WBR), 0, scr, r % I_BR, C.lane, 4 * 512, g * 512); continue; } r -= 4 * I_BR;
        if (mask & 64) transpose_item(C.ka->in[I_WOUT] + (size_t)l * D * D, D, D, WSP(bf16_t, OFF_WOUT), 0, scr, r, C.lane);
    }
    if (!(mask & 64)) return;
    bf16_t* W2T = WSP(bf16_t, OFF_W2T);
    for (int idx = b0 * NT + C.tid; idx < 2 * 2 * 512 * 8; idx += nbk * NT) {
        const int k8 = idx & 7, col = (idx >> 3) & 511, m = (idx >> 12) & 1, d = idx >> 13;
        const float* src = (m == 0 ? C.ka->in[I_RWW2] : C.ka->in[I_RWA2]) + ((size_t)(l * 2 + d) * 64 + 8 * k8) * 512 + col;
        u32x4 w; w.x = pk2(src[0], src[512]); w.y = pk2(src[1024], src[1536]); w.z = pk2(src[2048], src[2560]); w.w = pk2(src[3072], src[3584]);
        *(u32x4*)(W2T + ((size_t)((d * 2 + m) * 512 + col) * 64 + 8 * k8)) = w;
    }
}

__device__ __forceinline__ void phase_ada_partial(Ctx& C) {
    float* modp = WSP(float, OFF_MODP);
    for (int u = C.bid; u < DEPTH * 9 * KSPLIT; u += C.G) {
        const int l = u / (9 * KSPLIT), rem = u % (9 * KSPLIT), cg = rem / KSPLIT, ks = rem % KSPLIT;
        const int col = cg * 2048 + C.tid * 4;
        const float* W = C.ka->in[I_ADAW] + (size_t)l * D * MODW;
        f32x4 a0 = {0.f, 0.f, 0.f, 0.f}, a1 = {0.f, 0.f, 0.f, 0.f};
#pragma unroll 16
        for (int i = ks * 64; i < ks * 64 + 64; ++i) {
            const float c0 = C.ka->in[I_C][i], c1 = C.ka->in[I_CCTX][i];
            const float s0 = siluf_(c0), s1 = siluf_(c1);
            const f32x4 w = *(const f32x4*)(W + (size_t)i * MODW + col);
            a0 += w * s0; a1 += w * s1;
        }
        *(f32x4*)(modp + ((size_t)(l * KSPLIT + ks) * 2 + 0) * MODW + col) = a0;
        *(f32x4*)(modp + ((size_t)(l * KSPLIT + ks) * 2 + 1) * MODW + col) = a1;
    }
}
__device__ __forceinline__ void phase_ada_reduce(Ctx& C) {
    const float* modp = WSP(float, OFF_MODP); float* mod = WSP(float, OFF_MOD);
    for (int e = C.bid * NT + C.tid; e < DEPTH * 2 * MODW; e += C.G * NT) {
        const int l = e / (2 * MODW), s = (e / MODW) % 2, j = e % MODW;
        float a = C.ka->in[I_ADAB][(size_t)l * MODW + j];
        for (int ks = 0; ks < KSPLIT; ++ks) a += modp[((size_t)(l * KSPLIT + ks) * 2 + s) * MODW + j];
        mod[e] = a;
    }
}
__device__ __forceinline__ const float* mod_ptr(Ctx& C, int l, int s, int idx) { return WSP(float, OFF_MOD) + ((size_t)(l * 2 + s) * NMOD + idx) * D; }

__device__ __forceinline__ void phase_norm(Ctx& C, int l, const float* gw  , int shift_idx, int nparts, int rows, int src) {
    const int gwv = C.bid * NWAVES + C.wave, NGW = C.G * NWAVES;
    float* X = WSP(float, OFF_X); bf16_t* H = WSP(bf16_t, OFF_H); const float* PART = WSP(float, OFF_P32);
    for (int r = gwv; r < rows; r += NGW) {
        const int s = r >= SEQ ? 1 : 0;
        const float* sh = mod_ptr(C, l, s, shift_idx); const float* sc = mod_ptr(C, l, s, shift_idx + 1);
        f32x4* xr = (f32x4*)(X + (size_t)r * D) + C.lane;
        const f32x4* xin = (src == 0 || (src == 2 && s == 0)) ? (const f32x4*)xr : (s == 0 ? (const f32x4*)(C.ka->in[I_X] + (size_t)r * D) + C.lane : (const f32x4*)(C.ka->in[I_CTX] + (size_t)(r - SEQ) * D) + C.lane);
        f32x4 v[8]; float ss = 0.f;
#pragma unroll
        for (int j = 0; j < 8; ++j) v[j] = xin[64 * j];
        if (s == 1 && nparts > 0) {
            for (int ks = 0; ks < nparts; ++ks) {
                const f32x4* pr = (const f32x4*)(PART + ((size_t)ks * 256 + (r - SEQ)) * D) + C.lane;
#pragma unroll
                for (int j = 0; j < 8; ++j) v[j] += pr[64 * j];
            }
#pragma unroll
            for (int j = 0; j < 8; ++j) xr[64 * j] = v[j];
        }
#pragma unroll
        for (int j = 0; j < 8; ++j) ss += (v[j].x * v[j].x + v[j].y * v[j].y) + (v[j].z * v[j].z + v[j].w * v[j].w);
        const float rstd = rsqrtf(wave_sum(ss) * (1.0f / D) + EPS);
        u32x2* o8 = (u32x2*)(H + (size_t)r * D) + C.lane;
#pragma unroll
        for (int j = 0; j < 8; ++j) {
            const int c = (64 * j + C.lane) * 4;
            const f32x4 g4 = *(const f32x4*)(gw + c), s4 = *(const f32x4*)(sc + c), h4 = *(const f32x4*)(sh + c);
            const f32x4 y = (v[j] * rstd) * g4 * (s4 + 1.0f) + h4;
            u32x2 w; w.x = pk2(y.x, y.y); w.y = pk2(y.z, y.w); o8[64 * j] = w;
        }
    }
}

__device__ __forceinline__ float xrow_sum(float x) {
    auto s = __builtin_amdgcn_permlane16_swap(__float_as_uint(x), __float_as_uint(x), false, false);
    x = __uint_as_float(s[0]) + __uint_as_float(s[1]);
    auto t = __builtin_amdgcn_permlane32_swap(__float_as_uint(x), __float_as_uint(x), false, false);
    return __uint_as_float(t[0]) + __uint_as_float(t[1]);
}
template <int CTRL> __device__ __forceinline__ float dppf(float x) { return __builtin_bit_cast(float, __builtin_amdgcn_mov_dpp(__builtin_bit_cast(int, x), CTRL, 0xf, 0xf, true)); }
__device__ __forceinline__ float row16_sum(float x) { x += dppf<0xB1>(x); x += dppf<0x4E>(x); x += dppf<0x124>(x); x += dppf<0x128>(x); return x; }
__device__ __forceinline__ float wave_sum_fast(float x) { return xrow_sum(row16_sum(x)); }
#define WAVE_LDS_FENCE() asm volatile("s_waitcnt lgkmcnt(0)" ::: "memory")
__device__ __forceinline__ void phase_rw_prep(Ctx& C, int l, int b0, int nb) {
    constexpr int TB = 16;
    const float* P = WSP(float, OFF_P32); float* VV = WSP(float, OFF_VV); float* GS = WSP(float, OFF_GS); float* RO = WSP(float, OFF_RO); float* BON = WSP(float, OFF_BON);
    LAS float* lin = (LAS float*)C.lds;
    LAS unsigned char* wl = C.lds + 16384 + C.wave * 14592;
    LAS unsigned char* RA = wl; LAS float* MAT = (LAS float*)(wl + 10496);
    const float* taps = C.ka->in[I_RWSHIFT] + (size_t)l * 3 * RWC;
    const int c = C.tid, h = c >> 6, e = c & 63, lane = C.lane;
    const float kkw = C.ka->in[I_RWKK][l * 512 + c], kaw = C.ka->in[I_RWKA][l * 512 + c], rkw = C.ka->in[I_RWRK][l * 512 + c];
    for (int unit = b0; unit < 2 * RW_NCK; unit += nb) {
        const int d = unit & 1, sq_ = RW_NCK - 1 - (unit >> 1), grp = d == 0 ? (sq_ + RW_NCK - 16) % RW_NCK : RW_NCK - 1 - sq_;
        const int r0 = grp * TB;
        const bool hp0 = (r0 != 0 && r0 != SEQ), hnl = (r0 + TB != SEQ && r0 + TB != MT);
        __syncthreads();
        { int c_ = C.tid; asm volatile("" : "+v"(c_)); const int c = c_;
        if (c < 128) {
            const int col = 2048 + (c < 64 ? d * 64 + c : 128 + d * 64 + (c - 64));
            const float t0 = taps[col], t1 = taps[RWC + col], t2 = taps[2 * RWC + col];
            const float* pc = P + (size_t)r0 * P32W + RW_OFF + col;
            float prev = hp0 ? pc[-(long)P32W] : 0.f, cur = pc[0];
#pragma unroll
            for (int t = 0; t < TB; ++t) {
                const float nxt = (t + 1 < TB || hnl) ? pc[(size_t)(t + 1) * P32W] : 0.f;
                const float v = t0 * prev + t1 * cur + t2 * nxt;
                *(LAS bf16_t*)((LAS unsigned char*)lin + ((c >> 6) * 16 + t) * 144 + 2 * (c & 63)) = (bf16_t)f2bf(c < 64 ? 1.0f - 2.0f * __builtin_amdgcn_rcpf(1.0f + __expf(2.0f * v)) : v);
                prev = cur; cur = nxt;
            }
        }
        if (d == 0) {
            const int col = 3 * 512 + c;
            const float t0 = taps[col], t1 = taps[RWC + col], t2 = taps[2 * RWC + col];
            const float* pc = P + (size_t)r0 * P32W + RW_OFF + col;
            float prev = hp0 ? pc[-(long)P32W] : 0.f, cur = pc[0];
#pragma unroll
            for (int t = 0; t < TB; ++t) {
                const float nxt = (t + 1 < TB || hnl) ? pc[(size_t)(t + 1) * P32W] : 0.f;
                const float v = t0 * prev + t1 * cur + t2 * nxt;
                GS[(size_t)(r0 + t) * 512 + c] = __builtin_amdgcn_rcpf(1.0f + __expf(-v));
                prev = cur; cur = nxt;
            }
        }
        }
        __syncthreads();
        {
            int ln_ = C.lane; asm volatile("" : "+v"(ln_));
            const int lane = ln_, e = ln_, c = h * 64 + ln_;
            float xr[TB], xk[TB], xv[TB], kkn[TB];
#pragma unroll
            for (int q = 0; q < 3; ++q) {
                const int col = q * 512 + c;
                const float t0 = taps[col], t1 = taps[RWC + col], t2 = taps[2 * RWC + col];
                const float* pc = P + (size_t)r0 * P32W + RW_OFF + col;
                float prev = hp0 ? pc[-(long)P32W] : 0.f, cur = pc[0];
#pragma unroll
                for (int t = 0; t < TB; ++t) {
                    const float nxt = (t + 1 < TB || hnl) ? pc[(size_t)(t + 1) * P32W] : 0.f;
                    const float v = t0 * prev + t1 * cur + t2 * nxt;
                    if (q == 0) xr[t] = v; else if (q == 1) xk[t] = v; else { xv[t] = v; if (d == 0) VV[(size_t)(r0 + t) * 512 + c] = v; }
                    prev = cur; cur = nxt;
                }
            }
#pragma unroll
            for (int t = 0; t < TB; ++t) { const float kk0 = xk[t] * kkw; kkn[t] = kk0 * rsqrtf(wave_sum_fast(kk0 * kk0) + EPS); }
            __builtin_amdgcn_sched_barrier(0);
            float At[TB], Rt[TB], Vs[TB];
            unsigned Btp[TB / 2], Ktp[TB / 2];
            float gam;
            {
                float z[TB], az[TB];
                {
                    const bf16_t* W2T = WSP(bf16_t, OFF_W2T);
                    LAS float* ZB = (LAS float*)RA;
                    const int tl = lane & 15, q4 = lane >> 4;
#pragma unroll
                    for (int m = 0; m < 2; ++m) {
                        bf16x8 af[2];
#pragma unroll
                        for (int s2 = 0; s2 < 2; ++s2) af[s2] = *(const LAS bf16x8*)((LAS unsigned char*)lin + (m * 16 + tl) * 144 + s2 * 64 + q4 * 16);
#pragma unroll
                        for (int nt4 = 0; nt4 < 4; ++nt4) {
                            const bf16_t* bp = W2T + ((size_t)((d * 2 + m) * 512 + h * 64 + 16 * nt4 + tl) * 64 + 8 * q4);
                            f32x4 a4 = {0.f, 0.f, 0.f, 0.f};
#pragma unroll
                            for (int s2 = 0; s2 < 2; ++s2) a4 = MFMA16(af[s2], *(const bf16x8*)(bp + 32 * s2), a4);
#pragma unroll
                            for (int reg = 0; reg < 4; ++reg) ZB[(m * 16 + 4 * q4 + reg) * 64 + 16 * nt4 + tl] = a4[reg];
                        }
                    }
                    WAVE_LDS_FENCE();
                    const float zb = C.ka->in[I_RWW0][(l * 2 + d) * 512 + c], ab = C.ka->in[I_RWA0][(l * 2 + d) * 512 + c];
#pragma unroll
                    for (int t = 0; t < TB; ++t) { z[t] = zb + ZB[t * 64 + e]; az[t] = ab + ZB[(16 + t) * 64 + e]; }
                    WAVE_LDS_FENCE();
                }
                float g = 1.0f, btp = 0.f, ktp = 0.f;
#pragma unroll
                for (int i = 0; i < TB; ++i) {
                    const int t = d ? TB - 1 - i : i;
                    const float y = -z[t]; const float sp = fmaxf(y, 0.f) + __logf(1.0f + __expf(-fabsf(y)));
                    const float decay = __expf(-__expf(-sp - 0.5f));
                    const float a = __builtin_amdgcn_rcpf(1.0f + __expf(-az[t]));
                    const float kd = xk[t] * (1.0f + (a - 1.0f) * kaw);
                    { const float bsum = wave_sum_fast(xr[t] * kd * rkw);
                      if (lane == 0) BON[((size_t)d * MT + r0 + t) * 8 + h] = bsum; }
                    const float gm1 = g; g *= decay; const float ig = __builtin_amdgcn_rcpf(g);
                    const float at = -kkn[t] * gm1, bt = a * kkn[t] * ig, kt = kd * ig, rt = xr[t] * g;
                    At[i] = at; Rt[i] = rt; Vs[i] = xv[t];
                    *(LAS bf16_t*)(RA + 0 * 2304 + i * 144 + 2 * e) = (bf16_t)pg8::cvt_pk_bf16(at, at); *(LAS bf16_t*)(RA + 1 * 2304 + i * 144 + 2 * e) = (bf16_t)pg8::cvt_pk_bf16(bt, bt);
                    *(LAS bf16_t*)(RA + 2 * 2304 + i * 144 + 2 * e) = (bf16_t)pg8::cvt_pk_bf16(kt, kt); *(LAS bf16_t*)(RA + 3 * 2304 + i * 144 + 2 * e) = (bf16_t)pg8::cvt_pk_bf16(rt, rt);
                    if (i & 1) { Btp[i >> 1] = pg8::cvt_pk_bf16(btp, bt); Ktp[i >> 1] = pg8::cvt_pk_bf16(ktp, kt); } else { btp = bt; ktp = kt; }
                }
                gam = g;
            }
            __builtin_amdgcn_sched_barrier(0);
            WAVE_LDS_FENCE();
            {
                const int jl = lane & 15, q = lane >> 4;
                bf16x8 fa[2], fb[2], fk[2], fr[2];
#pragma unroll
                for (int s2 = 0; s2 < 2; ++s2) {
                    fa[s2] = *(const LAS bf16x8*)(RA + 0 * 2304 + jl * 144 + s2 * 64 + q * 16); fb[s2] = *(const LAS bf16x8*)(RA + 1 * 2304 + jl * 144 + s2 * 64 + q * 16);
                    fk[s2] = *(const LAS bf16x8*)(RA + 2 * 2304 + jl * 144 + s2 * 64 + q * 16); fr[s2] = *(const LAS bf16x8*)(RA + 3 * 2304 + jl * 144 + s2 * 64 + q * 16);
                }
                f32x4 gAL = {0.f, 0.f, 0.f, 0.f}, gBL = gAL, gP = gAL, gQ = gAL;
#pragma unroll
                for (int s2 = 0; s2 < 2; ++s2) { gAL = MFMA16(fa[s2], fb[s2], gAL); gBL = MFMA16(fa[s2], fk[s2], gBL); gP = MFMA16(fr[s2], fb[s2], gP); gQ = MFMA16(fr[s2], fk[s2], gQ); }
#pragma unroll
                for (int reg = 0; reg < 4; ++reg) { const int i = 4 * q + reg;
                    MAT[0 * 256 + i * 16 + jl] = jl < i ? gAL[reg] : 0.f; MAT[1 * 256 + i * 16 + jl] = jl < i ? gBL[reg] : 0.f;
                    MAT[2 * 256 + i * 16 + jl] = jl <= i ? gP[reg] : 0.f; MAT[3 * 256 + i * 16 + jl] = jl <= i ? gQ[reg] : 0.f; }
            }
            WAVE_LDS_FENCE();
            __builtin_amdgcn_sched_barrier(0);
            {
                u32x4 w0, w1;
                w0.x = Btp[0]; w0.y = Btp[1]; w0.z = Btp[2]; w0.w = Btp[3]; w1.x = Btp[4]; w1.y = Btp[5]; w1.z = Btp[6]; w1.w = Btp[7];
                *(LAS u32x4*)(RA + 0 * 2048 + e * 32) = w0; *(LAS u32x4*)(RA + 0 * 2048 + e * 32 + 16) = w1;
                w0.x = Ktp[0]; w0.y = Ktp[1]; w0.z = Ktp[2]; w0.w = Ktp[3]; w1.x = Ktp[4]; w1.y = Ktp[5]; w1.z = Ktp[6]; w1.w = Ktp[7];
                *(LAS u32x4*)(RA + 1 * 2048 + e * 32) = w0; *(LAS u32x4*)(RA + 1 * 2048 + e * 32 + 16) = w1;
#pragma unroll
                for (int i2 = 0; i2 < 4; ++i2) { w0[i2] = pg8::cvt_pk_bf16(Vs[2 * i2], Vs[2 * i2 + 1]); w1[i2] = pg8::cvt_pk_bf16(Vs[8 + 2 * i2], Vs[8 + 2 * i2 + 1]); }
                *(LAS u32x4*)(RA + 2 * 2048 + e * 32) = w0; *(LAS u32x4*)(RA + 2 * 2048 + e * 32 + 16) = w1;
                *(LAS float*)(RA + 10240 + 4 * e) = gam;
            }
            __builtin_amdgcn_sched_barrier(0);
            float Gv[TB];
            {
                float X1[TB];
#pragma unroll
                for (int i = 0; i < TB; ++i) {
                    __builtin_amdgcn_sched_barrier(0);
                    float al[16];
#pragma unroll
                    for (int g4 = 0; g4 < 4; ++g4) { const f32x4 u = *(const LAS f32x4*)(MAT + 0 * 256 + i * 16 + 4 * g4); al[4 * g4] = u.x; al[4 * g4 + 1] = u.y; al[4 * g4 + 2] = u.z; al[4 * g4 + 3] = u.w; }
                    float x1 = At[i];
#pragma unroll
                    for (int m = 0; m < TB; ++m) if (m < i) x1 = __builtin_fmaf(al[m], X1[m], x1);
                    X1[i] = x1;
                }
#pragma unroll
                for (int i = 0; i < TB; ++i) {
                    __builtin_amdgcn_sched_barrier(0);
                    float pm[16];
#pragma unroll
                    for (int g4 = 0; g4 < 4; ++g4) { const f32x4 u = *(const LAS f32x4*)(MAT + 2 * 256 + i * 16 + 4 * g4); pm[4 * g4] = u.x; pm[4 * g4 + 1] = u.y; pm[4 * g4 + 2] = u.z; pm[4 * g4 + 3] = u.w; }
                    float gv = Rt[i];
#pragma unroll
                    for (int m = 0; m < TB; ++m) if (m <= i) gv = __builtin_fmaf(pm[m], X1[m], gv);
                    Gv[i] = gv;
                }
                u32x4 w0, w1;
#pragma unroll
                for (int i2 = 0; i2 < 4; ++i2) { w0[i2] = pg8::cvt_pk_bf16(X1[2 * i2], X1[2 * i2 + 1]); w1[i2] = pg8::cvt_pk_bf16(X1[8 + 2 * i2], X1[8 + 2 * i2 + 1]); }
                *(LAS u32x4*)(RA + 3 * 2048 + e * 32) = w0; *(LAS u32x4*)(RA + 3 * 2048 + e * 32 + 16) = w1;
            }
            __builtin_amdgcn_sched_barrier(0);
            {
                float X2[TB];
#pragma unroll
                for (int i = 0; i < TB; ++i) {
                    __builtin_amdgcn_sched_barrier(0);
                    float al[16], bl[16];
#pragma unroll
                    for (int g4 = 0; g4 < 4; ++g4) { const f32x4 u = *(const LAS f32x4*)(MAT + 0 * 256 + i * 16 + 4 * g4), v = *(const LAS f32x4*)(MAT + 1 * 256 + i * 16 + 4 * g4);
                        al[4 * g4] = u.x; al[4 * g4 + 1] = u.y; al[4 * g4 + 2] = u.z; al[4 * g4 + 3] = u.w; bl[4 * g4] = v.x; bl[4 * g4 + 1] = v.y; bl[4 * g4 + 2] = v.z; bl[4 * g4 + 3] = v.w; }
                    float x2 = 0.f;
#pragma unroll
                    for (int m = 0; m < TB; ++m) if (m < i) { x2 = __builtin_fmaf(bl[m], Vs[m], x2); x2 = __builtin_fmaf(al[m], X2[m], x2); }
                    X2[i] = x2;
                }
#pragma unroll
                for (int i = 0; i < TB; ++i) {
                    __builtin_amdgcn_sched_barrier(0);
                    float pm[16], qm[16];
#pragma unroll
                    for (int g4 = 0; g4 < 4; ++g4) { const f32x4 u = *(const LAS f32x4*)(MAT + 2 * 256 + i * 16 + 4 * g4), v = *(const LAS f32x4*)(MAT + 3 * 256 + i * 16 + 4 * g4);
                        pm[4 * g4] = u.x; pm[4 * g4 + 1] = u.y; pm[4 * g4 + 2] = u.z; pm[4 * g4 + 3] = u.w; qm[4 * g4] = v.x; qm[4 * g4 + 1] = v.y; qm[4 * g4 + 2] = v.z; qm[4 * g4 + 3] = v.w; }
                    float o0 = 0.f;
#pragma unroll
                    for (int m = 0; m < TB; ++m) if (m <= i) { o0 = __builtin_fmaf(pm[m], X2[m], o0); o0 = __builtin_fmaf(qm[m], Vs[m], o0); }
                    RO[((size_t)d * MT + r0 + (d ? TB - 1 - i : i)) * 512 + c] = o0;
                }
                u32x4 w0, w1;
#pragma unroll
                for (int i2 = 0; i2 < 4; ++i2) { w0[i2] = pg8::cvt_pk_bf16(X2[2 * i2], X2[2 * i2 + 1]); w1[i2] = pg8::cvt_pk_bf16(X2[8 + 2 * i2], X2[8 + 2 * i2 + 1]); }
                *(LAS u32x4*)(RA + 4 * 2048 + e * 32) = w0; *(LAS u32x4*)(RA + 4 * 2048 + e * 32 + 16) = w1;
            }
            WAVE_LDS_FENCE();
            __builtin_amdgcn_sched_barrier(0);
            {
                LAS bf16_t* GI = (LAS bf16_t*)MAT;
                const int sg = e >> 5, jp = 4 * ((e >> 4) & 1) + (e & 3), qg = (e & 15) >> 2;
#pragma unroll
                for (int i = 0; i < TB; ++i) GI[(sg * 64 + qg * 16 + i) * 8 + jp] = (bf16_t)f2bf(Gv[i]);
            }
            __builtin_amdgcn_sched_barrier(0);
            const int seqc = d == 0 ? (grp + 16) % RW_NCK : RW_NCK - 1 - grp;
            const size_t rec = (size_t)(d * 8 + h) * RW_NCK + seqc;
            {
                const int r = lane & 31, hh = lane >> 5;
                bf16x8 fBT[2], fKT[2], fVT[2], fW1[2], fU0[2];
#pragma unroll
                for (int blk = 0; blk < 2; ++blk) {
                    fBT[blk] = *(const LAS bf16x8*)(RA + 0 * 2048 + (32 * blk + r) * 32 + hh * 16); fKT[blk] = *(const LAS bf16x8*)(RA + 1 * 2048 + (32 * blk + r) * 32 + hh * 16);
                    fVT[blk] = *(const LAS bf16x8*)(RA + 2 * 2048 + (32 * blk + r) * 32 + hh * 16); fW1[blk] = *(const LAS bf16x8*)(RA + 3 * 2048 + (32 * blk + r) * 32 + hh * 16);
                    fU0[blk] = *(const LAS bf16x8*)(RA + 4 * 2048 + (32 * blk + r) * 32 + hh * 16);
                }
                float gk[2][16];
#pragma unroll
                for (int mb = 0; mb < 2; ++mb)
#pragma unroll
                    for (int reg = 0; reg < 16; ++reg) gk[mb][reg] = *(const LAS float*)(RA + 10240 + 4 * (32 * mb + KOFF(reg) + 4 * hh));
                WAVE_LDS_FENCE();
                float* Hrec = (float*)(C.ws + OFF_RWH + rec * RWH_REC);
                LAS bf16_t* MI = (LAS bf16_t*)RA;
#pragma unroll
                for (int mb = 0; mb < 2; ++mb)
#pragma unroll
                    for (int nbk = 0; nbk < 2; ++nbk) {
                        f32x16 aM, aH;
#pragma unroll
                        for (int i = 0; i < 16; ++i) { aM[i] = 0.f; aH[i] = 0.f; }
                        aM = MFMA32(fBT[mb], fW1[nbk], aM);
                        aH = MFMA32(fBT[mb], fU0[nbk], aH); aH = MFMA32(fKT[mb], fVT[nbk], aH);
                        const int col = 32 * nbk + r;
#pragma unroll
                        for (int g4 = 0; g4 < 4; ++g4) {
                            const int kb = 2 * mb + (g4 >> 1), q2 = 2 * (g4 & 1) + hh;
                            f32x4 hv; hv.x = gk[mb][4 * g4] * aH[4 * g4]; hv.y = gk[mb][4 * g4 + 1] * aH[4 * g4 + 1]; hv.z = gk[mb][4 * g4 + 2] * aH[4 * g4 + 2]; hv.w = gk[mb][4 * g4 + 3] * aH[4 * g4 + 3];
                            *(f32x4*)(Hrec + (((col >> 4) * 4 + kb) * 64 + q2 * 16 + (col & 15)) * 4) = hv;
                        }
                        const int sm = col >> 5, jpm = 4 * ((col >> 4) & 1) + (col & 3), qm2 = (col & 15) >> 2;
#pragma unroll
                        for (int reg = 0; reg < 16; ++reg) {
                            const int kp = 32 * mb + KOFF(reg) + 4 * hh;
                            const float mv = gk[mb][reg] * ((kp == col ? 1.0f : 0.0f) + aM[reg]);
                            MI[(((kp >> 4) * 2 + sm) * 64 + qm2 * 16 + (kp & 15)) * 8 + jpm] = (bf16_t)f2bf(mv);
                        }
                    }
                WAVE_LDS_FENCE();
                unsigned char* MGrec = C.ws + OFF_RWMG + rec * RWMG_REC;
#pragma unroll
                for (int it = 0; it < 8; ++it) *(u32x4*)(MGrec + (size_t)(it * 64 + lane) * 16) = *(const LAS u32x4*)(RA + (it * 64 + lane) * 16);
#pragma unroll
                for (int it = 0; it < 2; ++it) *(u32x4*)(MGrec + 8192 + (size_t)(it * 64 + lane) * 16) = *(const LAS u32x4*)((LAS unsigned char*)MAT + (it * 64 + lane) * 16);
                WAVE_LDS_FENCE();
            }
        }
    }
}

struct PrepW { float nw[4][4]; float inv[4]; };
__device__ __forceinline__ void attn_prep_unit(Ctx& C, const PrepW& W, bf16_t* PA, int u, int lane) {
    const int li = lane & 15, g = lane >> 4;
    const int rp = u / 13, v = u - rp * 13;
    int r, col, kind;
    if (v < 12) { const int k6 = v % 6; r = 2 * rp + v / 6; kind = k6 >> 1; col = (kind == 0 ? 0 : kind == 1 ? 512 : 1536) + 256 * (k6 & 1) + 64 * g; }
    else { r = 2 * rp + (g >> 1); kind = 3; col = 2048 + 64 * (g & 1); }
    bf16_t* p = PA + (size_t)r * PAW + col + 4 * li;
    const uint2 raw = *(const uint2*)p;
    float x[4] = {bf2f(raw.x & 0xffffu), bf2f(raw.x >> 16), bf2f(raw.y & 0xffffu), bf2f(raw.y >> 16)};
    const float ss = row16_sum(x[0] * x[0] + x[1] * x[1] + x[2] * x[2] + x[3] * x[3]);
    const float rs = rsqrtf(ss * (1.0f / 64.0f) + EPS) * ((kind & 1) ? 1.0f : 0.125f);
    float y[4];
#pragma unroll
    for (int j = 0; j < 4; ++j) y[j] = x[j] * rs * (kind == 0 ? W.nw[0][j] : kind == 1 ? W.nw[1][j] : kind == 2 ? W.nw[2][j] : W.nw[3][j]);
    if (kind >= 2 && r < SEQ) {
        const int pos = (li >> 3) ? (r & 63) : (r >> 6);
        const bool lo = (li & 7) < 4;
        const int src = lane + (lo ? 4 : -4);
#pragma unroll
        for (int j = 0; j < 4; ++j) {
            const float ang = (float)pos * W.inv[j];
            const float sn = __sinf(ang), cs = __cosf(ang);
            const float yp = __shfl(y[j], src);
            y[j] = lo ? (y[j] * cs - yp * sn) : (yp * sn + y[j] * cs);
        }
    }
    uint2 o; o.x = pk2(y[0], y[1]); o.y = pk2(y[2], y[3]);
    if (!(kind & 1)) *(uint2*)p = o;
    else {
        const int hd = (col - (kind == 1 ? 512 : 2048)) >> 6;
        bf16_t* kt = (kind == 1 ? WSP(bf16_t, OFF_KTN) : WSP(bf16_t, OFF_KTW)) + (size_t)(hd * (MT / 32) + (r >> 5)) * 2048;
        *(uint2*)(kt + ((((li >> 2) * 64 + ((li >> 1) & 1) * 32 + (r & 31)) << 3) + 4 * (li & 1))) = o;
    }
}
__device__ __forceinline__ void phase_attn_prep(Ctx& C, int l, int w0, int nw) {
    bf16_t* PA = WSP(bf16_t, OFF_PA);
    const int lane = C.lane, li = lane & 15;
    PrepW W;
#pragma unroll
    for (int j = 0; j < 4; ++j) {
        W.nw[0][j] = C.ka->in[I_NAQN][l * 64 + 4 * li + j]; W.nw[1][j] = C.ka->in[I_NAKN][l * 64 + 4 * li + j];
        W.nw[2][j] = C.ka->in[I_WAQN][l * 64 + 4 * li + j]; W.nw[3][j] = C.ka->in[I_WAKN][l * 64 + 4 * li + j];
        W.inv[j] = powf(10000.0f, -(float)(4 * (li & 3) + j) / 16.0f);
    }
    for (int u = w0; u < (MT / 2) * 13; u += nw) attn_prep_unit(C, W, PA, u, lane);
}

__device__ __forceinline__ float hg_lb(Ctx& C, int l, int d, int c) {
    if (l == 0) return 0.f;
    const float a0 = C.ka->in[I_HGLB][(size_t)(d * DEPTH + 0) * 512 + c], a1 = C.ka->in[I_HGLB][(size_t)(d * DEPTH + 1) * 512 + c];
    const float m = fmaxf(a0, a1); const float e0 = expf(a0 - m), e1 = expf(a1 - m);
    return e1 / (e0 + e1);
}
struct HgThread { float lc[16], kd[16]; float tot[4]; };
__device__ __forceinline__ void hg_gates(Ctx& C, int l, int d, int h, int tc, int k, int J, LAS float* TOT, HgThread& T) {
    const float* P = WSP(float, OFF_P32);
    const float lb = hg_lb(C, l, d, h * 128 + k);
    float gg[16];
#pragma unroll
    for (int i = 0; i < 16; ++i) {
        const float fr = P[(size_t)(64 * tc + 16 * J + i) * P32W + 512 + d * 512 + h * 128 + k];
        const float f = lb + (1.0f - lb) * sigmoidf_(fr);
        gg[i] = __logf(f); T.kd[i] = 1.0f - f;
    }
    if (d == 0) { float a = 0.f;
#pragma unroll
        for (int i = 0; i < 16; ++i) { a += gg[i]; T.lc[i] = a; }
        TOT[J * 128 + k] = a;
    } else { float a = 0.f;
#pragma unroll
        for (int i = 15; i >= 0; --i) { a += gg[i]; T.lc[i] = a; }
        TOT[J * 128 + k] = a;
    }
    __syncthreads();
#pragma unroll
    for (int m = 0; m < 4; ++m) T.tot[m] = TOT[m * 128 + k];
}
__device__ __forceinline__ void hg_it(Ctx& C, int h, int tc, int v, int J, LAS unsigned char* IT) {
    const float* P = WSP(float, OFF_P32);
    float x[16];
#pragma unroll
    for (int i = 0; i < 16; ++i) x[i] = P[(size_t)(64 * tc + 16 * J + i) * P32W + 1536 + h * 128 + v];
    u32x4 w0, w1;
    w0.x = pk2(x[0], x[1]); w0.y = pk2(x[2], x[3]); w0.z = pk2(x[4], x[5]); w0.w = pk2(x[6], x[7]);
    w1.x = pk2(x[8], x[9]); w1.y = pk2(x[10], x[11]); w1.z = pk2(x[12], x[13]); w1.w = pk2(x[14], x[15]);
    *(LAS u32x4*)(IT + v * 144 + J * 32) = w0; *(LAS u32x4*)(IT + v * 144 + J * 32 + 16) = w1;
}
__device__ __forceinline__ void phase_hg_A(Ctx& C, int l, int b0, int nb) {
    float* HGL = WSP(float, OFF_HGL); float* HGD = WSP(float, OFF_HGD);
    LAS unsigned char* KT = C.lds;
    LAS unsigned char* IT = C.lds + 18432;
    LAS float* TOT = (LAS float*)(C.lds + 36864);
    const int k = C.tid & 127, J = C.tid >> 7;
    unsigned* ctr = WSP(unsigned, OFF_CTL) + 71680 + l;
    LAS int* su = (LAS int*)(C.lds + 40960);
    int nxt = 0;
    if (C.tid == 0) nxt = (int)atomicAdd(ctr, 1u);
    for (;;) {
        __syncthreads();
        if (C.tid == 0) *su = nxt;
        __syncthreads();
        const int u = *su;
        if (u >= 2 * 4 * NCH) break;
        if (C.tid == 0) nxt = (int)atomicAdd(ctr, 1u);
        const int d = u / (4 * NCH), h = (u / NCH) % 4, c = u % NCH;
        const int tc = d == 0 ? (c + NCH - 4) % NCH : NCH - 1 - c;
        HgThread T; hg_gates(C, l, d, h, tc, k, J, TOT, T);
        float rest = 0.f;
#pragma unroll
        for (int m = 0; m < 4; ++m) if (d == 0 ? (m >= J) : (m <= J)) rest += T.tot[m];
        float kh[16];
#pragma unroll
        for (int i = 0; i < 16; ++i) kh[i] = T.kd[i] * __expf(rest - T.lc[i]);
        { u32x4 w0, w1;
          w0.x = pk2(kh[0], kh[1]); w0.y = pk2(kh[2], kh[3]); w0.z = pk2(kh[4], kh[5]); w0.w = pk2(kh[6], kh[7]);
          w1.x = pk2(kh[8], kh[9]); w1.y = pk2(kh[10], kh[11]); w1.z = pk2(kh[12], kh[13]); w1.w = pk2(kh[14], kh[15]);
          *(LAS u32x4*)(KT + k * 144 + J * 32) = w0; *(LAS u32x4*)(KT + k * 144 + J * 32 + 16) = w1; }
        hg_it(C, h, tc, k, J, IT);
        if (J == 0) HGD[(size_t)((d * 4 + h) * NCH + c) * 128 + k] = __expf((T.tot[0] + T.tot[1]) + (T.tot[2] + T.tot[3]));
        __syncthreads();
        const int r = C.lane & 31, hh = C.lane >> 5, vb = C.wave >> 1;
        float* outp = HGL + (size_t)((d * 4 + h) * NCH + c) * 16384;
#pragma unroll
        for (int t2 = 0; t2 < 2; ++t2) {
            const int kb = 2 * (C.wave & 1) + t2;
            f32x16 acc;
#pragma unroll
            for (int i = 0; i < 16; ++i) acc[i] = 0.f;
#pragma unroll
            for (int st = 0; st < 4; ++st) {
                const bf16x8 af = *(const LAS bf16x8*)(IT + (32 * vb + r) * 144 + st * 32 + hh * 16);
                const bf16x8 bf = *(const LAS bf16x8*)(KT + (32 * kb + r) * 144 + st * 32 + hh * 16);
                acc = MFMA32(af, bf, acc);
            }
#pragma unroll
            for (int reg = 0; reg < 16; ++reg) outp[(size_t)(32 * vb + KOFF(reg) + 4 * hh) * 128 + 32 * kb + r] = acc[reg];
        }
    }
}
__device__ __forceinline__ void phase_hg_B(Ctx& C, int b0, int nb) {
    const float* HGL = WSP(float, OFF_HGL); const float* HGD = WSP(float, OFF_HGD); bf16_t* SPT = WSP(bf16_t, OFF_SPT);
    for (int e = b0 * NT + C.tid; e < 8 * 8192; e += nb * NT) {
        const int dh = e >> 13, vk = (e & 8191) * 2, k = vk & 127;
        float s0 = 0.f, s1 = 0.f;
        const float* p = HGL + (size_t)dh * NCH * 16384 + vk; const float* dp = HGD + (size_t)dh * NCH * 128 + k; bf16_t* o = SPT + (size_t)dh * NCH * 16384 + vk;
        static_assert(NCH % 12 == 0, "twelve chunks per batch");
#pragma unroll 1
        for (int c0 = 0; c0 < NCH; c0 += 12) {
            float2 Lc[12], Dc[12];
#pragma unroll
            for (int i = 0; i < 12; ++i) { Lc[i] = *(const float2*)(p + (size_t)(c0 + i) * 16384); Dc[i] = *(const float2*)(dp + (c0 + i) * 128); }
#pragma unroll
            for (int i = 0; i < 12; ++i) { *(unsigned*)(o + (size_t)(c0 + i) * 16384) = pk2(s0, s1); s0 = Dc[i].x * s0 + Lc[i].x; s1 = Dc[i].y * s1 + Lc[i].y; }
        }
    }
}
__device__ __forceinline__ void phase_hg_C(Ctx& C, int l, int b0, int nb, int nch  ) {
    const float* P = WSP(float, OFF_P32); const bf16_t* SPT = WSP(bf16_t, OFF_SPT); bf16_t* YB = WSP(bf16_t, OFF_YB);
    LAS unsigned char* KS = C.lds;
    LAS unsigned char* QJ = C.lds + 17408;
    LAS unsigned char* IT = C.lds + 17408 + 69632;
    LAS float* TOT = (LAS float*)(C.lds + 105472);
    LAS float* RED = (LAS float*)(C.lds + 107520);
    const int k = C.tid & 127, J = C.tid >> 7;
    const int tl = C.lane & 15, qd = C.lane >> 4, I = C.wave >> 1, vh = C.wave & 1;
    for (int u = b0; u < 4 * nch; u += nb) {
        const int h = u / nch, tc = u % nch;
        f32x4 oT[4];
#pragma unroll
        for (int i = 0; i < 4; ++i) oT[i] = (f32x4){0.f, 0.f, 0.f, 0.f};
#pragma unroll 1
        for (int d = 0; d < 2; ++d) {
            const int cd = d == 0 ? (tc + 4) % NCH : NCH - 1 - tc;
            __syncthreads();
            {
                HgThread T; hg_gates(C, l, d, h, tc, k, J, TOT, T);
                float qv[16];
#pragma unroll
                for (int i = 0; i < 16; ++i) qv[i] = P[(size_t)(64 * tc + 16 * J + i) * P32W + h * 128 + k];
#pragma unroll
                for (int i = 0; i < 16; ++i) *(LAS bf16_t*)(KS + (16 * J + i) * 272 + 2 * k) = (bf16_t)f2bf(T.kd[i] * __expf(fminf(-T.lc[i], 80.f)));
#pragma unroll
                for (int Jp = 0; Jp < 4; ++Jp) {
                    if (d == 0 ? (Jp > J) : (Jp < J)) continue;
                    float Pj = 0.f;
#pragma unroll
                    for (int m = 0; m < 4; ++m) if (d == 0 ? (m >= Jp && m < J) : (m > J && m <= Jp)) Pj += T.tot[m];
#pragma unroll
                    for (int i = 0; i < 16; ++i) *(LAS bf16_t*)(QJ + (Jp * 64 + 16 * J + i) * 272 + 2 * k) = (bf16_t)f2bf(qv[i] * __expf(T.lc[i] + Pj));
                }
                hg_it(C, h, tc, k, J, IT);
            }
            __syncthreads();
            u32x2 att[4];
#pragma unroll
            for (int Jb = 0; Jb < 4; ++Jb) {
                att[Jb] = (u32x2){0u, 0u};
                if (d == 0 ? (Jb > I) : (Jb < I)) continue;
                f32x4 acc = {0.f, 0.f, 0.f, 0.f};
#pragma unroll
                for (int ks = 0; ks < 4; ++ks) {
                    const bf16x8 af = *(const LAS bf16x8*)(KS + (16 * Jb + tl) * 272 + ks * 64 + qd * 16);
                    const bf16x8 bf = *(const LAS bf16x8*)(QJ + (Jb * 64 + 16 * I + tl) * 272 + ks * 64 + qd * 16);
                    acc = MFMA16(af, bf, acc);
                }
                if (Jb == I) {
#pragma unroll
                    for (int reg = 0; reg < 4; ++reg) { const int sl = 4 * qd + reg; const bool valid = d == 0 ? (sl <= tl) : (sl >= tl); acc[reg] = valid ? acc[reg] : 0.f; }
                }
                att[Jb].x = pk2(acc[0], acc[1]); att[Jb].y = pk2(acc[2], acc[3]);
            }
#pragma unroll
            for (int pr = 0; pr < 2; ++pr) {
                const int Ja = 2 * pr, Jc = 2 * pr + 1;
                const bool anyv = d == 0 ? (Ja <= I) : (Jc >= I);
                if (!anyv) continue;
                u32x4 bw; bw.x = att[Ja].x; bw.y = att[Ja].y; bw.z = att[Jc].x; bw.w = att[Jc].y;
                const bf16x8 bf = __builtin_bit_cast(bf16x8, bw);
#pragma unroll
                for (int vb = 0; vb < 4; ++vb) {
                    const int v = 16 * (4 * vh + vb) + tl;
                    const u32x2 a0 = *(const LAS u32x2*)(IT + v * 144 + Ja * 32 + qd * 8), a1 = *(const LAS u32x2*)(IT + v * 144 + Jc * 32 + qd * 8);
                    u32x4 aw; aw.x = a0.x; aw.y = a0.y; aw.z = a1.x; aw.w = a1.y;
                    oT[vb] = MFMA16(__builtin_bit_cast(bf16x8, aw), bf, oT[vb]);
                }
            }
            const bf16_t* sp = SPT + (size_t)((d * 4 + h) * NCH + cd) * 16384;
            const int Je = d == 0 ? 0 : 3;
#pragma unroll
            for (int ks = 0; ks < 4; ++ks) {
                const bf16x8 bf = *(const LAS bf16x8*)(QJ + (Je * 64 + 16 * I + tl) * 272 + ks * 64 + qd * 16);
#pragma unroll
                for (int vb = 0; vb < 4; ++vb) {
                    const bf16x8 af = *(const bf16x8*)(sp + (size_t)(16 * (4 * vh + vb) + tl) * 128 + ks * 32 + qd * 8);
                    oT[vb] = MFMA16(af, bf, oT[vb]);
                }
            }
        }
        float ss = 0.f;
#pragma unroll
        for (int vb = 0; vb < 4; ++vb) ss += (oT[vb][0] * oT[vb][0] + oT[vb][1] * oT[vb][1]) + (oT[vb][2] * oT[vb][2] + oT[vb][3] * oT[vb][3]);
        ss += __shfl_xor(ss, 16); ss += __shfl_xor(ss, 32);
        __syncthreads();
        if (qd == 0) RED[C.wave * 16 + tl] = ss;
        __syncthreads();
        const float rstd = rsqrtf((RED[(2 * I) * 16 + tl] + RED[(2 * I + 1) * 16 + tl]) * (1.0f / 128.0f) + EPS);
        const int row = 64 * tc + 16 * I + tl;
#pragma unroll
        for (int vb = 0; vb < 4; ++vb) {
            const int v0 = 16 * (4 * vh + vb) + 4 * qd;
            const f32x4 nw = *(const f32x4*)(C.ka->in[I_HGNORM] + l * 512 + h * 128 + v0);
            const f32x4 gv = *(const f32x4*)(P + (size_t)row * P32W + 2048 + h * 128 + v0);
            u32x2 w; w.x = pg8::cvt_pk_bf16(oT[vb][0] * rstd * nw.x * siluf_(gv.x), oT[vb][1] * rstd * nw.y * siluf_(gv.y));
            w.y = pg8::cvt_pk_bf16(oT[vb][2] * rstd * nw.z * siluf_(gv.z), oT[vb][3] * rstd * nw.w * siluf_(gv.w));
            *(u32x2*)(YB + (size_t)row * 512 + h * 128 + v0) = w;
        }
    }
}

constexpr int RW_NJOBS = 64, RW_RING = 9, RW_SLOT = 14336;
__device__ __forceinline__ void phase_rw_scan(Ctx& C, int b0, int nb) {
    float* RO2 = WSP(float, OFF_RO2);
    LAS unsigned char* slot = C.lds;
    const int lane = C.lane, wv = C.wave;
    for (int jb = b0; jb < RW_NJOBS; jb += nb) {
        const int x = jb & 7, y = jb >> 3, dh = x * 2 + (y >> 2), vs = y & 3, d = dh >> 3, h = dh & 7;
        const unsigned char* mg = C.ws + OFF_RWMG + (size_t)dh * RW_NCK * RWMG_REC;
        const unsigned char* hr = C.ws + OFF_RWH + (size_t)dh * RW_NCK * RWH_REC + (size_t)vs * 4096;
        __syncthreads();
#define RW_PIECE(cc, i) __builtin_amdgcn_global_load_lds((const unsigned*)(((i) < 10 ? mg + (size_t)(cc) * RWMG_REC + (size_t)((i) * 64 + lane) * 16 : hr + (size_t)(cc) * RWH_REC + (size_t)(((i) - 10) * 64 + lane) * 16)), \
            (LAS unsigned*)(slot + ((cc) % RW_RING) * RW_SLOT + (i) * 1024), 16, 0, 0)
        if (wv >= 1) {
#pragma unroll 1
            for (int k8 = 0; k8 < 8; ++k8) { RW_PIECE(k8, wv - 1); RW_PIECE(k8, wv + 6); } }
        f32x4 acc[4];
#pragma unroll
        for (int i = 0; i < 4; ++i) acc[i] = (f32x4){0.f, 0.f, 0.f, 0.f};
        const int vl = lane & 15, q = lane >> 4;
        struct Ops { bf16x8 g[2], m[4][2]; f32x4 h[4]; };
#define RW_LDS_LOAD(R, ck) do { const LAS unsigned char* sl_ = slot + ((ck) % RW_RING) * RW_SLOT; \
            _Pragma("unroll") for (int s2 = 0; s2 < 2; ++s2) R.g[s2] = *(const LAS bf16x8*)(sl_ + 8192 + (s2 * 64 + lane) * 16); \
            _Pragma("unroll") for (int kb = 0; kb < 4; ++kb) { R.h[kb] = *(const LAS f32x4*)(sl_ + 10240 + (kb * 64 + lane) * 16); \
                _Pragma("unroll") for (int s2 = 0; s2 < 2; ++s2) R.m[kb][s2] = *(const LAS bf16x8*)(sl_ + ((kb * 2 + s2) * 64 + lane) * 16); } } while (0)
#define RW_LOADER_STEP(ck) do { if ((ck) >= 0) { const int nn = (ck) + 8 < RW_NCK ? (ck) + 8 : RW_NCK - 1; \
                __builtin_amdgcn_global_load_lds((const unsigned*)(mg + (size_t)nn * RWMG_REC + (size_t)((wv - 1) * 64 + lane) * 16), (LAS unsigned*)(slot + (((ck) + 8) % RW_RING) * RW_SLOT + (wv - 1) * 1024), 16, 0, 0); \
                __builtin_amdgcn_global_load_lds((const unsigned*)((wv + 6) < 10 ? mg + (size_t)nn * RWMG_REC + (size_t)((wv + 6) * 64 + lane) * 16 : hr + (size_t)nn * RWH_REC + (size_t)((wv + 6 - 10) * 64 + lane) * 16), (LAS unsigned*)(slot + (((ck) + 8) % RW_RING) * RW_SLOT + (wv + 6) * 1024), 16, 0, 0); } \
            asm volatile("s_waitcnt vmcnt(12)" ::: "memory"); } while (0)
#define RW_BAR() do { asm volatile("s_waitcnt lgkmcnt(0)" ::: "memory"); __builtin_amdgcn_s_barrier(); asm volatile("" ::: "memory"); } while (0)
        if (wv >= 1) {
            RW_LOADER_STEP(-2);
            asm volatile("" ::: "memory"); __builtin_amdgcn_s_barrier(); asm volatile("" ::: "memory");
            RW_LOADER_STEP(-1);
            RW_BAR();
#pragma unroll 1
            for (int cc = 0; cc < RW_NCK; ++cc) {
                int lane = C.lane; asm volatile("" : "+v"(lane));
                RW_LOADER_STEP(cc);
                RW_BAR();
            }
        } else {
            asm volatile("" ::: "memory"); __builtin_amdgcn_s_barrier(); asm volatile("" ::: "memory");
            Ops R;
            RW_LDS_LOAD(R, 0);
            RW_BAR();
#pragma unroll 1
            for (int cc = 0; cc < RW_NCK; ++cc) {
                int lane = C.lane; asm volatile("" : "+v"(lane)); const int vl = lane & 15, q = lane >> 4;
                bf16x8 bfr[2];
                asm volatile("s_nop 7\n\ts_nop 7" ::: "memory");
#pragma unroll
                for (int s2 = 0; s2 < 2; ++s2) { u32x4 w; w.x = pg8::cvt_pk_bf16(acc[2 * s2][0], acc[2 * s2][1]); w.y = pg8::cvt_pk_bf16(acc[2 * s2][2], acc[2 * s2][3]); w.z = pg8::cvt_pk_bf16(acc[2 * s2 + 1][0], acc[2 * s2 + 1][1]); w.w = pg8::cvt_pk_bf16(acc[2 * s2 + 1][2], acc[2 * s2 + 1][3]);
                    bfr[s2] = __builtin_bit_cast(bf16x8, w); }
                const int rc = d == 0 ? (cc + RW_NCK - 16) % RW_NCK : RW_NCK - 1 - cc;
                float* rop = RO2 + ((size_t)d * MT + 16 * rc) * 512 + h * 64 + 16 * vs + vl;
                f32x4 oacc = {0.f, 0.f, 0.f, 0.f};
#pragma unroll
                for (int s2 = 0; s2 < 2; ++s2) oacc = MFMA16(R.g[s2], bfr[s2], oacc);
#pragma unroll
                for (int kb = 0; kb < 4; ++kb) acc[kb] = R.h[kb];
#pragma unroll
                for (int s2 = 0; s2 < 2; ++s2)
#pragma unroll
                    for (int kb = 0; kb < 4; ++kb) acc[kb] = MFMA16(R.m[kb][s2], bfr[s2], acc[kb]);
                __builtin_amdgcn_sched_barrier(0);
                { const int c1 = cc + 1 < RW_NCK ? cc + 1 : RW_NCK - 1; RW_LDS_LOAD(R, c1); }
#pragma unroll
                for (int reg = 0; reg < 4; ++reg) { const int i = 4 * q + reg; rop[(size_t)(d ? 15 - i : i) * 512] = oacc[reg]; }
                RW_BAR();
            }
        }
#undef RW_LDS_LOAD
#undef RW_LOADER_STEP
#undef RW_BAR
        asm volatile("s_waitcnt vmcnt(0)" ::: "memory");
#undef RW_PIECE
    }
}
__device__ __forceinline__ void phase_rw_finish(Ctx& C, int l, int w0, int nw, int rows) {
    const float* VV = WSP(float, OFF_VV); const float* GS = WSP(float, OFF_GS); const float* RO = WSP(float, OFF_RO); const float* BON = WSP(float, OFF_BON); const float* RO2 = WSP(float, OFF_RO2);
    bf16_t* YB = WSP(bf16_t, OFF_YB) + (size_t)1 * MT * 512;
    const int li = C.lane & 15, g = C.lane >> 4;
    for (int uidx = w0; uidx < rows * 2; uidx += nw) {
        const int r = uidx >> 1, h = (uidx & 1) * 4 + g, c = h * 64 + 4 * li;
        const f32x4 a0 = *(const f32x4*)(RO + (size_t)r * 512 + c), a1 = *(const f32x4*)(RO + ((size_t)MT + r) * 512 + c);
        const f32x4 b0 = *(const f32x4*)(RO2 + (size_t)r * 512 + c), b1 = *(const f32x4*)(RO2 + ((size_t)MT + r) * 512 + c);
        const f32x4 vv = *(const f32x4*)(VV + (size_t)r * 512 + c), gs = *(const f32x4*)(GS + (size_t)r * 512 + c);
        const f32x4 lw = *(const f32x4*)(C.ka->in[I_RWLNW] + l * 512 + c), lb = *(const f32x4*)(C.ka->in[I_RWLNB] + l * 512 + c);
        const float bon = BON[(size_t)r * 8 + h] + BON[((size_t)MT + r) * 8 + h];
        const f32x4 o = (a0 + a1) + (b0 + b1);
        const float mu = row16_sum((o.x + o.y) + (o.z + o.w)) * (1.0f / 64.0f);
        const f32x4 dv = o - mu;
        const float var = row16_sum((dv.x * dv.x + dv.y * dv.y) + (dv.z * dv.z + dv.w * dv.w)) * (1.0f / 64.0f);
        const float rs = rsqrtf(var + RW_GN_EPS);
        const f32x4 y = ((dv * rs) * lw + lb + vv * bon) * gs;
        uint2 w; w.x = pk2(y.x, y.y); w.y = pk2(y.z, y.w);
        *(uint2*)(YB + (size_t)r * 512 + c) = w;
    }
}

typedef float f32x4u __attribute__((ext_vector_type(4), aligned(4)));
__device__ __forceinline__ float swap32_sum(float x) { auto t = __builtin_amdgcn_permlane32_swap(__float_as_uint(x), __float_as_uint(x), false, false); return __uint_as_float(t[0]) + __uint_as_float(t[1]); }
__device__ __forceinline__ f32x16 qk_tile(const bf16_t* Kp  , const bf16x8 (&qf)[4], int r, int h) {
    f32x16 acc;
#pragma unroll
    for (int i = 0; i < 16; ++i) acc[i] = 0.f;
    const bf16_t* p = Kp + (size_t)r * PAW + 8 * h;
#pragma unroll
    for (int s = 0; s < 4; ++s) { const bf16x8 kf = *(const bf16x8*)(p + 16 * s); acc = MFMA32(kf, qf[s], acc); }
    return acc;
}
__device__ __forceinline__ void pv_tile(f32x16 (&o)[2], const bf16_t* VTp  , const f32x16& p, int r, int h) {
#pragma unroll
    for (int s = 0; s < 2; ++s) {
        u32x4 pw; pw.x = pg8::cvt_pk_bf16(p[8 * s + 0], p[8 * s + 1]); pw.y = pg8::cvt_pk_bf16(p[8 * s + 2], p[8 * s + 3]); pw.z = pg8::cvt_pk_bf16(p[8 * s + 4], p[8 * s + 5]); pw.w = pg8::cvt_pk_bf16(p[8 * s + 6], p[8 * s + 7]);
        const bf16x8 pb = __builtin_bit_cast(bf16x8, pw);
#pragma unroll
        for (int blk = 0; blk < 2; ++blk) {
            const bf16_t* vp = VTp + (size_t)(32 * blk + r) * MT + 16 * s + 4 * h;
            const u32x2 lo = *(const u32x2*)vp, hi = *(const u32x2*)(vp + 8);
            u32x4 vw; vw.x = lo.x; vw.y = lo.y; vw.z = hi.x; vw.w = hi.y;
            o[blk] = MFMA32(__builtin_bit_cast(bf16x8, vw), pb, o[blk]);
        }
    }
}
__device__ __forceinline__ void phase_attn(Ctx& C, int l, int w0, int nw) {
    const bf16_t* PA = WSP(bf16_t, OFF_PA); bf16_t* YB = WSP(bf16_t, OFF_YB);
    const bf16_t* VTN = WSP(bf16_t, OFF_VTN); const bf16_t* VTW = WSP(bf16_t, OFF_VTW);
    const float* PB = WSP(float, OFF_PB); const float* MREF = WSP(float, OFF_MREF);
    const int r = C.lane & 31, h = C.lane >> 5;
    constexpr int NJT = 2048 + 64;
    for (int job = w0; job < 2 * NJT; job += nw) {
        const int type = __builtin_amdgcn_readfirstlane(job / NJT), jj = __builtin_amdgcn_readfirstlane(job % NJT), qt = jj >> 3, hd = jj & 7;
        const int q0 = qt * 32;
        const bool lat = qt < 256;
        if (!lat && l == DEPTH - 1) continue;
        const float Mr = MREF[type];
        bf16x8 qf[4];
        { const bf16_t* qp = PA + (size_t)(q0 + r) * PAW + (type == 0 ? 0 : 1536) + hd * 64 + 8 * h;
#pragma unroll
          for (int s = 0; s < 4; ++s) qf[s] = *(const bf16x8*)(qp + 16 * s); }
        f32x16 o[2];
#pragma unroll
        for (int i = 0; i < 16; ++i) { o[0][i] = 0.f; o[1][i] = 0.f; }
        float lsum = 0.f;
        const int kcol = type == 0 ? 512 + hd * 64 : 2048 + (hd >> 2) * 64;
        const bf16_t* VT = type == 0 ? VTN + (size_t)(hd * (MT / 32)) * 2048 : VTW + (size_t)((hd >> 2) * (MT / 32)) * 2048;
        const bf16_t* KT = type == 0 ? WSP(bf16_t, OFF_KTN) + (size_t)(hd * (MT / 32)) * 2048 : WSP(bf16_t, OFF_KTW) + (size_t)((hd >> 2) * (MT / 32)) * 2048;
        const int i_g = qt >> 1, j_g = (qt & 1) * 32 + r;
        int rs = i_g - 4; rs = rs < 0 ? 0 : (rs > 120 ? 120 : rs);
        int cs = j_g - 8; cs = cs < 0 ? 0 : (cs > 48 ? 48 : cs);
        const int dl0 = -4 > -qt ? -4 : -qt, dl1 = 4 < 255 - qt ? 4 : 255 - qt;
        const int n_loc = !lat ? 0 : (type == 0 ? 16 : dl1 - dl0 + 1), nt = n_loc + CTX / 32;
#define ATT_KEY0(t) ((t) >= n_loc ? SEQ + 32 * ((t) - n_loc) : (type == 0 ? (rs + ((t) >> 1)) * 64 + 32 * ((t) & 1) : (qt + dl0 + (t)) * 32))
#define ATT_LOADK(kf, key0) do { const bf16_t* kp_ = KT + (size_t)((key0) >> 5) * 2048 + C.lane * 8; _Pragma("unroll") for (int s = 0; s < 4; ++s) kf[s] = *(const bf16x8*)(kp_ + s * 512); } while (0)
#define ATT_LOADV(vf, key0) do { const bf16_t* vp_ = VT + (size_t)((key0) >> 5) * 2048 + C.lane * 8; _Pragma("unroll") for (int s = 0; s < 2; ++s) _Pragma("unroll") for (int blk = 0; blk < 2; ++blk) vf[s][blk] = *(const u32x4*)(vp_ + (s * 2 + blk) * 512); } while (0)
        bf16x8 kc[4], kn[4]; u32x4 vc[2][2], vn[2][2];
        { const int k0 = ATT_KEY0(0); ATT_LOADK(kc, k0); ATT_LOADV(vc, k0); }
#pragma unroll 1
        for (int t = 0; t < nt; ++t) {
            { const int tn = t + 1 < nt ? t + 1 : t; const int k1 = ATT_KEY0(tn); ATT_LOADK(kn, k1); ATT_LOADV(vn, k1); }
            f32x16 acc;
#pragma unroll
            for (int i = 0; i < 16; ++i) acc[i] = 0.f;
#pragma unroll
            for (int s = 0; s < 4; ++s) acc = MFMA32(kc[s], qf[s], acc);
            f32x16 p;
            if (t >= n_loc) {
#pragma unroll
                for (int reg = 0; reg < 16; ++reg) { p[reg] = __expf(acc[reg] - Mr); lsum += p[reg]; }
            } else if (type == 0) {
                const int a = t >> 1, cc = t & 1;
                const float* brow = PB + (size_t)(hd * 15 + (rs + a - i_g + 7)) * 128 + (32 * cc + 4 * h - j_g + 63);
                const int lo = cs - 32 * cc - 4 * h;
#pragma unroll
                for (int g = 0; g < 4; ++g) {
                    const f32x4u b4 = *(const f32x4u*)(brow + 8 * g);
#pragma unroll
                    for (int q = 0; q < 4; ++q) { const int reg = 4 * g + q; const bool valid = (unsigned)(KOFF(reg) - lo) < 16u;
                        const float e = __expf(acc[reg] + b4[q] - Mr); p[reg] = valid ? e : 0.f; lsum += p[reg]; }
                }
            } else {
                const int dl = dl0 + t;
#pragma unroll
                for (int reg = 0; reg < 16; ++reg) { const int kr = KOFF(reg) + 4 * h; const bool valid = dl == -4 ? (kr >= r) : (dl == 4 ? (kr <= r) : true);
                    const float e = __expf(acc[reg] - Mr); p[reg] = valid ? e : 0.f; lsum += p[reg]; }
            }
#pragma unroll
            for (int s = 0; s < 2; ++s) {
                u32x4 pw; pw.x = pg8::cvt_pk_bf16(p[8 * s + 0], p[8 * s + 1]); pw.y = pg8::cvt_pk_bf16(p[8 * s + 2], p[8 * s + 3]); pw.z = pg8::cvt_pk_bf16(p[8 * s + 4], p[8 * s + 5]); pw.w = pg8::cvt_pk_bf16(p[8 * s + 6], p[8 * s + 7]);
                const bf16x8 pb = __builtin_bit_cast(bf16x8, pw);
#pragma unroll
                for (int blk = 0; blk < 2; ++blk) o[blk] = MFMA32(__builtin_bit_cast(bf16x8, vc[s][blk]), pb, o[blk]);
            }
#pragma unroll
            for (int s = 0; s < 4; ++s) kc[s] = kn[s];
#pragma unroll
            for (int s = 0; s < 2; ++s)
#pragma unroll
                for (int blk = 0; blk < 2; ++blk) vc[s][blk] = vn[s][blk];
        }
#undef ATT_KEY0
#undef ATT_LOADK
#undef ATT_LOADV
        float ltot = swap32_sum(lsum);
        if (type == 1) ltot += __expf(C.ka->in[I_WASINK][l * 8 + hd] - Mr);
        const float inv = 1.0f / ltot;
        bf16_t* yp = YB + (size_t)(2 + type) * MT * 512 + (size_t)(q0 + r) * 512 + hd * 64 + 4 * h;
#pragma unroll
        for (int blk = 0; blk < 2; ++blk)
#pragma unroll
            for (int g = 0; g < 4; ++g) {
                u32x2 w; w.x = pg8::cvt_pk_bf16(o[blk][4 * g] * inv, o[blk][4 * g + 1] * inv); w.y = pg8::cvt_pk_bf16(o[blk][4 * g + 2] * inv, o[blk][4 * g + 3] * inv);
                *(u32x2*)(yp + 32 * blk + 8 * g) = w;
            }
    }
}
__device__ __forceinline__ void phase_attn_tables(Ctx& C, int l, int w0, int nw) {
    const bf16_t* PA = WSP(bf16_t, OFF_PA); bf16_t* VTN = WSP(bf16_t, OFF_VTN); bf16_t* VTW = WSP(bf16_t, OFF_VTW);
    LAS unsigned char* tile = C.lds + C.wave * 9216;
    const int lane = C.lane;
    for (int u = w0; u < 10 * NCH; u += nw) {
        const int hd = u / NCH, tt = u % NCH, t0 = tt * 64;
        const int vcol = hd < 8 ? 1024 + hd * 64 : 2176 + (hd - 8) * 64;
#pragma unroll
        for (int it = 0; it < 8; ++it) { const int row = 8 * it + (lane >> 3), ch = lane & 7;
            *(LAS u32x4*)(tile + row * 144 + ch * 16) = *(const u32x4*)(PA + (size_t)(t0 + row) * PAW + vcol + ch * 8); }
        LDS_WAIT(); asm volatile("" ::: "memory");
        bf16_t* dst = (hd < 8 ? VTN + (size_t)(hd * (MT / 32) + 2 * tt) * 2048 : VTW + (size_t)((hd - 8) * (MT / 32) + 2 * tt) * 2048);
        { const int rr = lane & 31, hh = lane >> 5;
#pragma unroll
          for (int kt2 = 0; kt2 < 2; ++kt2)
#pragma unroll
            for (int s2 = 0; s2 < 2; ++s2)
#pragma unroll
                for (int blk = 0; blk < 2; ++blk) {
                    unsigned e[8];
#pragma unroll
                    for (int j = 0; j < 8; ++j) e[j] = *(const LAS bf16_t*)(tile + (32 * kt2 + 16 * s2 + 8 * (j >> 2) + 4 * hh + (j & 3)) * 144 + 2 * (32 * blk + rr));
                    u32x4 w; w.x = e[0] | (e[1] << 16); w.y = e[2] | (e[3] << 16); w.z = e[4] | (e[5] << 16); w.w = e[6] | (e[7] << 16);
                    *(u32x4*)(dst + (size_t)kt2 * 2048 + ((s2 * 2 + blk) * 64 + lane) * 8) = w;
                }
        }
        LDS_WAIT(); asm volatile("" ::: "memory");
    }
    float* PB = WSP(float, OFF_PB);
    const float* rpb = C.ka->in[I_NARPB] + (size_t)l * 8 * 15 * 31;
    for (int idx = w0 * 64 + lane; idx < 8 * 15 * 128; idx += nw * 64) { const int x = idx & 127, hr = idx >> 7; PB[idx] = (x >= 48 && x < 79) ? rpb[hr * 31 + x - 48] : 0.f; }
    if (w0 == 0) {
        float mb = 0.f;
        for (int i = lane; i < 8 * 15 * 31; i += 64) mb = fmaxf(mb, fabsf(rpb[i]));
        mb = wave_max(mb);
        const float nq = wave_max(fabsf(C.ka->in[I_NAQN][l * 64 + lane])), nk = wave_max(fabsf(C.ka->in[I_NAKN][l * 64 + lane]));
        const float wq = wave_max(fabsf(C.ka->in[I_WAQN][l * 64 + lane])), wk = wave_max(fabsf(C.ka->in[I_WAKN][l * 64 + lane]));
        const float sk = wave_max(lane < 8 ? C.ka->in[I_WASINK][l * 8 + lane] : -1e30f);
        if (lane == 0) { float* M = WSP(float, OFF_MREF); M[0] = 8.08f * nq * nk + mb; M[1] = fmaxf(8.08f * wq * wk, sk); }
    }
}

__device__ __forceinline__ void phase_combine(Ctx& C, int row_lo, int row_hi) {
    const bf16_t* PROJ = WSP(bf16_t, OFF_P32); bf16_t* MG = WSP(bf16_t, OFF_H);
    const size_t n8 = (size_t)(row_hi - row_lo) * D / 8;
    for (size_t i = (size_t)C.bid * NT + C.tid; i < n8; i += (size_t)C.G * NT) {
        const size_t r = row_lo + i / (D / 8), c8 = i % (D / 8);
        float a[8];
#pragma unroll
        for (int j = 0; j < 8; ++j) a[j] = 0.f;
#pragma unroll
        for (int g = 0; g < 4; ++g) {
            const u32x4 w = *(const u32x4*)(PROJ + r * GLW + g * D + c8 * 8);
            a[0] += bf2f(w.x & 0xffffu); a[1] += bf2f(w.x >> 16); a[2] += bf2f(w.y & 0xffffu); a[3] += bf2f(w.y >> 16);
            a[4] += bf2f(w.z & 0xffffu); a[5] += bf2f(w.z >> 16); a[6] += bf2f(w.w & 0xffffu); a[7] += bf2f(w.w >> 16);
        }
        u32x4 o; o.x = pk2(a[0], a[1]); o.y = pk2(a[2], a[3]); o.z = pk2(a[4], a[5]); o.w = pk2(a[6], a[7]);
        *(u32x4*)(MG + r * D + c8 * 8) = o;
    }
}

constexpr int PH_PRO = 2, PH_PER_LAYER = 14, N_PHASES = PH_PRO + DEPTH * PH_PER_LAYER;

__global__ void __launch_bounds__(NT, 2) mk_fwd(Args args) {
    extern __shared__ __attribute__((aligned(16))) unsigned char lds_raw[];
    Ctx C;
    C.lds = (LAS unsigned char*)lds_raw;
    C.tid = threadIdx.x; C.lane = C.tid & 63; C.wave = __builtin_amdgcn_readfirstlane(C.tid >> 6);
    C.bid = blockIdx.x; C.G = gridDim.x;
    C.ka = (const Args __attribute__((address_space(4)))*)__builtin_amdgcn_kernarg_segment_ptr(); C.out = args.out; C.ws = args.ws;
    volatile LAS unsigned* MISC = (volatile LAS unsigned*)(C.lds + MISC_OFF);
    for (int u = C.tid; u < (LDS_BYTES - RING_BYTES) / 4; u += NT) ((LAS unsigned*)(C.lds + RING_BYTES))[u] = 0u;
    __syncthreads();
    const int lo = args.ph_lo, hi = args.ph_hi;
    XcdBarrier bar; bar.bar = WSP(unsigned, OFF_CTL) + 4096; bar.x = 0; bar.st = nullptr;
    const bool multi = (hi - lo) > 1;
    if (multi) bar = xcd_barrier_post(WSP(unsigned, OFF_CTL) + 4096, MISC + 8);
#ifndef PH_MASK
#define PH_MASK 0xFFFF
#endif
#ifndef PRO_MASK
#define PRO_MASK 3
#endif
#define IN(k) (lo <= (k) && (k) < hi)
#define LEN(j) (((PH_MASK) >> (j)) & 1)
#define SEAM(k) do { if (IN(k) && IN((k) + 1)) xcd_barrier(bar); } while (0)

    if ((PRO_MASK & 1) && IN(0)) { relaunder(C); phase_convert(C, 0, 127, C.bid, C.G); phase_ada_partial(C); } SEAM(0);
    if ((PRO_MASK & 2) && IN(1)) { relaunder(C); phase_ada_reduce(C); } SEAM(1);

#pragma unroll
    for (int l = 0; l < DEPTH; ++l) {
        const int pb = PH_PRO + l * PH_PER_LAYER;
        if (LEN(0) && IN(pb + 0)) { relaunder(C); if (l > 0) phase_convert(C, l, 127 - 21, C.bid, C.G); phase_norm(C, l, C.ka->in[I_NF1] + (size_t)l * D, 0, l > 0 ? 22 : 0, MT, l == 0 ? 1 : 0); } SEAM(pb + 0);
        if (LEN(1) && IN(pb + 1)) { relaunder(C);
            pg8::Gemm g = pg8::mkgemm(WSP(bf16_t, OFF_H), WSP(bf16_t, OFF_WI1));
            pg8::StaticOrder S; S.init(MT, 2 * DFF, C.G, C.bid);
            pg8::EpiSwiGLU E{WSP(bf16_t, OFF_G)};
            pg8::gemm_phase<pg8::EpiSwiGLU, true, true, pg8::StaticOrder, D, D, D, 0>(C.lds, g, S, E, C.tid);
            if (PROBE_MODE == 3) { pg8::gemm_phase<pg8::EpiSwiGLU, true, true, pg8::StaticOrder, D, D, D, 0>(C.lds, g, S, E, C.tid); }
        } SEAM(pb + 1);
        if (LEN(2) && IN(pb + 2)) { relaunder(C);
            { pg8::Gemm g = pg8::mkgemm(WSP(bf16_t, OFF_G), WSP(bf16_t, OFF_WO1));
              pg8::StaticOrder S; S.init(SEQ, D, C.G, C.bid);
              pg8::EpiResid<true> E{WSP(float, OFF_X), mod_ptr(C, l, 0, 2), mod_ptr(C, l, 1, 2), nullptr, l == 0 ? C.ka->in[I_X] : WSP(float, OFF_X)};
              pg8::gemm_phase<pg8::EpiResid<true>, true, true, pg8::StaticOrder, DFF, DFF, DFF, 0>(C.lds, g, S, E, C.tid); }
            { relaunder(C); pg8::Gemm g = pg8::mkgemm(WSP(bf16_t, OFF_G), WSP(bf16_t, OFF_WO1));
              pg8::SplitOrder S{SEQ / 256, D / 256, 22, C.G, C.bid};
              pg8::EpiPart<true> E{WSP(float, OFF_P32), mod_ptr(C, l, 1, 2)};
              pg8::gemm_phase<pg8::EpiPart<true>, true, true, pg8::SplitOrder, 256, DFF, DFF, 256>(C.lds, g, S, E, C.tid); }
        } SEAM(pb + 2);
        if (LEN(3) && IN(pb + 3)) { relaunder(C); phase_norm(C, l, C.ka->in[I_NMIX] + (size_t)l * D, 3, 22, MT, l == 0 ? 2 : 0); } SEAM(pb + 3);
        if (LEN(4) && IN(pb + 4)) { relaunder(C);
            pg8::Gemm g = pg8::mkgemm(WSP(bf16_t, OFF_H), WSP(bf16_t, OFF_WIN));
            pg8::StaticOrder S; S.init(MT, PTOT, C.G, C.bid);
            pg8::EpiWin E{WSP(float, OFF_P32), WSP(bf16_t, OFF_PA), WSP(bf16_t, OFF_GL), 0};
            pg8::gemm_phase<pg8::EpiWin, true, true, pg8::StaticOrder, D, D, D, 0>(C.lds, g, S, E, C.tid);
            if (PROBE_MODE == 3) { pg8::gemm_phase<pg8::EpiWin, true, true, pg8::StaticOrder, D, D, D, 0>(C.lds, g, S, E, C.tid); }
        } SEAM(pb + 4);
        if (LEN(5) && IN(pb + 5)) { relaunder(C);
            phase_rw_prep(C, l, C.bid, C.G);
            __syncthreads();
            phase_attn_prep(C, l, C.bid * NWAVES + C.wave, C.G * NWAVES);
            phase_attn_tables(C, l, C.bid * NWAVES + C.wave, C.G * NWAVES);
            if (PROBE_MODE == 1) phase_attn_tables(C, l, C.bid * NWAVES + C.wave, C.G * NWAVES);
            __syncthreads();
            phase_hg_A(C, l, C.bid, C.G);
            if (PROBE_MODE == 1) phase_hg_A(C, l, C.bid, C.G);
        } SEAM(pb + 5);
        if (LEN(6) && IN(pb + 6)) { relaunder(C);
            if (C.G >= 256) {
                if (C.bid < RW_NJOBS) phase_rw_scan(C, C.bid, RW_NJOBS);
                else { const int b = C.bid - RW_NJOBS, n = C.G - RW_NJOBS; phase_hg_B(C, b, n); phase_attn(C, l, b * NWAVES + C.wave, n * NWAVES);
                    if (l + 1 < DEPTH) { __syncthreads(); phase_convert(C, l + 1, 21, b, n); }
                    if (PROBE_MODE == 11) { phase_hg_B(C, b, n); phase_attn(C, l, b * NWAVES + C.wave, n * NWAVES); }
                    if (PROBE_MODE == 12) { phase_attn(C, l, b * NWAVES + C.wave, n * NWAVES); } if (PROBE_MODE == 13) { phase_hg_B(C, b, n); } }
            } else {
                phase_rw_scan(C, C.bid, C.G); phase_hg_B(C, C.bid, C.G); phase_attn(C, l, C.bid * NWAVES + C.wave, C.G * NWAVES);
                if (l + 1 < DEPTH) { __syncthreads(); phase_convert(C, l + 1, 21, C.bid, C.G); }
            }
        } SEAM(pb + 6);
        if (LEN(7) && IN(pb + 7)) { relaunder(C); phase_hg_C(C, l, C.bid, C.G, l == DEPTH - 1 ? SEQ / 64 : NCH); phase_rw_finish(C, l, C.bid * NWAVES + C.wave, C.G * NWAVES, l == DEPTH - 1 ? SEQ : MT);
        } SEAM(pb + 7);
        if (LEN(8) && IN(pb + 8)) { relaunder(C);
            { pg8::Gemm g = pg8::mkgemm(WSP(bf16_t, OFF_YB), WSP(bf16_t, OFF_WBR)); g.a_kgs = (size_t)MT * 512 * 2;
              pg8::StaticOrder S; S.init(SEQ, D, C.G, C.bid);
              pg8::EpiMergeF E{WSP(bf16_t, OFF_GL), WSP(bf16_t, OFF_H)};
              pg8::gemm_phase<pg8::EpiMergeF, true, true, pg8::StaticOrder, 4 * 512, 512, 4 * 512, 0, 8>(C.lds, g, S, E, C.tid);
              if (PROBE_MODE == 4) { pg8::gemm_phase<pg8::EpiMergeF, true, true, pg8::StaticOrder, 4 * 512, 512, 4 * 512, 0, 8>(C.lds, g, S, E, C.tid); } }
            if (l < DEPTH - 1) { relaunder(C);
              pg8::Gemm g = pg8::mkgemm(WSP(bf16_t, OFF_YB), WSP(bf16_t, OFF_WBR)); g.a_div = 8; g.a_gstride = (size_t)MT * 512; g.b_mod = 8; g.b_gcol = 512;
              pg8::SplitOrder S{SEQ / 256, 32, 1, C.G, C.bid};
              pg8::EpiMerge E{WSP(bf16_t, OFF_GL), WSP(bf16_t, OFF_P32)};
              pg8::gemm_phase<pg8::EpiMerge, true, true, pg8::SplitOrder, 512, 512, 4 * 512, 0>(C.lds, g, S, E, C.tid); }
        }
        if (l < DEPTH - 1) { SEAM(pb + 8); }
        if (l < DEPTH - 1) { if (LEN(9) && IN(pb + 9)) { relaunder(C); phase_combine(C, SEQ, MT); } }
        SEAM(pb + 9);
        if (LEN(10) && IN(pb + 10)) { relaunder(C);
            { pg8::Gemm g = pg8::mkgemm(WSP(bf16_t, OFF_H), WSP(bf16_t, OFF_WOUT));
              pg8::StaticOrder S; S.init(SEQ, D, C.G, C.bid);
              pg8::EpiResid<false> E{WSP(float, OFF_X), mod_ptr(C, l, 0, 5), mod_ptr(C, l, 1, 5), nullptr, WSP(float, OFF_X)};
              pg8::gemm_phase<pg8::EpiResid<false>, true, true, pg8::StaticOrder, D, D, D, 0>(C.lds, g, S, E, C.tid); }
            if (l < DEPTH - 1) { relaunder(C);
              pg8::Gemm g = pg8::mkgemm(WSP(bf16_t, OFF_H), WSP(bf16_t, OFF_WOUT));
              pg8::SplitOrder S{SEQ / 256, D / 256, 8, C.G, C.bid};
              pg8::EpiPart<false> E{WSP(float, OFF_P32), mod_ptr(C, l, 1, 5)};
              pg8::gemm_phase<pg8::EpiPart<false>, true, true, pg8::SplitOrder, 256, D, D, 256>(C.lds, g, S, E, C.tid); }
        } SEAM(pb + 10);
        if (LEN(11) && IN(pb + 11)) { relaunder(C); phase_norm(C, l, C.ka->in[I_NF2] + (size_t)l * D, 6, l < DEPTH - 1 ? 8 : 0, l == DEPTH - 1 ? SEQ : MT, 0); } SEAM(pb + 11);
        if (LEN(12) && IN(pb + 12)) { relaunder(C);
            pg8::Gemm g = pg8::mkgemm(WSP(bf16_t, OFF_H), WSP(bf16_t, OFF_WI2));
            pg8::StaticOrder S; S.init(l == DEPTH - 1 ? SEQ : MT, 2 * DFF, C.G, C.bid);
            pg8::EpiSwiGLU E{WSP(bf16_t, OFF_G)};
            pg8::gemm_phase<pg8::EpiSwiGLU, true, true, pg8::StaticOrder, D, D, D, 0>(C.lds, g, S, E, C.tid);
            if (PROBE_MODE == 3) { pg8::gemm_phase<pg8::EpiSwiGLU, true, true, pg8::StaticOrder, D, D, D, 0>(C.lds, g, S, E, C.tid); }
        } SEAM(pb + 12);
        if (LEN(13) && IN(pb + 13)) { relaunder(C);
            { pg8::Gemm g = pg8::mkgemm(WSP(bf16_t, OFF_G), WSP(bf16_t, OFF_WO2));
              pg8::StaticOrder S; S.init(SEQ, D, C.G, C.bid);
              pg8::EpiResid<true> E{WSP(float, OFF_X), mod_ptr(C, l, 0, 8), mod_ptr(C, l, 1, 8), l == DEPTH - 1 ? C.out : nullptr, WSP(float, OFF_X)};
              pg8::gemm_phase<pg8::EpiResid<true>, true, true, pg8::StaticOrder, DFF, DFF, DFF, 0>(C.lds, g, S, E, C.tid); }
            if (l < DEPTH - 1) { relaunder(C);
              pg8::Gemm g = pg8::mkgemm(WSP(bf16_t, OFF_G), WSP(bf16_t, OFF_WO2));
              pg8::SplitOrder S{SEQ / 256, D / 256, 22, C.G, C.bid};
              pg8::EpiPart<true> E{WSP(float, OFF_P32), mod_ptr(C, l, 1, 8)};
              pg8::gemm_phase<pg8::EpiPart<true>, true, true, pg8::SplitOrder, 256, DFF, DFF, 256>(C.lds, g, S, E, C.tid); }
        } SEAM(pb + 13);
    }
#undef IN
#undef SEAM
}

extern "C" void kernel_launch(void* const* d_in, const int* in_sizes, int n_in, void* d_out, int out_size, void* d_ws, size_t ws_size, hipStream_t stream) {
    static int grid = 0;
    if (grid == 0) {
        if (n_in != N_IN || out_size != SEQ * D || ws_size < WS_END) { fprintf(stderr, "kernel_launch: unexpected shapes (n_in %d out %d ws %zu)\n", n_in, out_size, ws_size); grid = -1; return; }
        int dev = 0, cus = 0;
        if (hipGetDevice(&dev) != hipSuccess || hipDeviceGetAttribute(&cus, hipDeviceAttributeMultiprocessorCount, dev) != hipSuccess) { grid = -1; return; }
        if (hipFuncSetAttribute((const void*)mk_fwd, hipFuncAttributeMaxDynamicSharedMemorySize, LDS_BYTES) != hipSuccess) { fprintf(stderr, "kernel_launch: hipFuncSetAttribute failed\n"); grid = -1; return; }
        (void)hipGetLastError();
        grid = cus;
    }
    if (grid < 0) return;
    (void)hipMemsetAsync((char*)d_ws + OFF_CTL, 0, CTL_BYTES, stream);
    Args a{};
    for (int i = 0; i < N_IN; ++i) a.in[i] = (const float*)d_in[i];
    a.out = (float*)d_out; a.ws = (unsigned char*)d_ws;
#if MK_ONE_LAUNCH
    a.ph_lo = 0; a.ph_hi = N_PHASES;
    hipLaunchKernelGGL(mk_fwd, dim3(grid), dim3(NT), LDS_BYTES, stream, a);
#else
    for (int ph = 0; ph < N_PHASES; ++ph) {
        a.ph_lo = ph; a.ph_hi = ph + 1;
        hipLaunchKernelGGL(mk_fwd, dim3(grid), dim3(NT), LDS_BYTES, stream, a);
    }
#endif
}
```

```cpp
#include <hip/hip_runtime.h>
#include <cstdio>
#include <cstdint>

#ifndef PROBE_MODE
#define PROBE_MODE 0
#endif
#ifndef MK_ONE_LAUNCH
#define MK_ONE_LAUNCH 1
#endif

#define LAS __attribute__((address_space(3)))
#define GAS __attribute__((address_space(1)))
typedef unsigned short bf16_t;
typedef short bf16x8 __attribute__((ext_vector_type(8)));
typedef float f32x4 __attribute__((ext_vector_type(4)));
typedef float f32x2 __attribute__((ext_vector_type(2)));
typedef unsigned u32x4 __attribute__((ext_vector_type(4)));
typedef unsigned u32x2 __attribute__((ext_vector_type(2)));

constexpr int D = 2048, SEQ = 8192, CTX = 256, MT = SEQ + CTX, DEPTH = 2, DFF = 5632, NMOD = 9, MODW = NMOD * D;
constexpr int GRID_W = 64;
constexpr int PTOT = 15360, P32W = 4864, PAW = 2304, GLW = 8192;
constexpr int HG_OFF = 0, RW_OFF = 2560, RWC = 2304;
constexpr int NCH = MT / 64;
constexpr int NWAVES = 8, NT = 512;
constexpr float EPS = 1e-6f, RW_GN_EPS = 64e-5f;

constexpr size_t MiB = 1u << 20;
constexpr size_t OFF_CTL = 0, CTL_BYTES = 1 * MiB;
constexpr size_t OFF_W2T = 512 * 1024;
constexpr size_t OFF_MOD = 1 * MiB;
constexpr size_t OFF_MODP = 2 * MiB;
constexpr size_t OFF_WI1 = 11 * MiB, OFF_WO1 = 55 * MiB, OFF_WIN = 77 * MiB, OFF_WBR = 137 * MiB, OFF_WOUT = 145 * MiB, OFF_WI2 = 153 * MiB, OFF_WO2 = 197 * MiB;
constexpr size_t OFF_X = 219 * MiB;
constexpr size_t OFF_H = 285 * MiB;
constexpr size_t OFF_G = 318 * MiB;
constexpr size_t OFF_P32 = 409 * MiB;
constexpr size_t OFF_PA = 566 * MiB;
constexpr size_t OFF_GL = 604 * MiB;
constexpr size_t OFF_HGL = 736 * MiB;
constexpr size_t OFF_HGD = 802 * MiB;
constexpr size_t OFF_SCN = 803 * MiB;
constexpr size_t OFF_VV = 968 * MiB;
constexpr size_t OFF_GS = 985 * MiB;
constexpr size_t OFF_RO = 1002 * MiB;
constexpr size_t OFF_YB = 1035 * MiB;
constexpr size_t OFF_VTN = 1068 * MiB;
constexpr size_t OFF_VTW = 1077 * MiB;
constexpr size_t OFF_PB = 1080 * MiB;
constexpr size_t OFF_MREF = OFF_PB + 65536;
constexpr size_t OFF_SPT = 1081 * MiB;
constexpr size_t OFF_BON = 1114 * MiB;
constexpr size_t OFF_RO2 = 1115 * MiB;
constexpr size_t OFF_KTN = OFF_MODP;
constexpr size_t OFF_KTW = 1148 * MiB;
constexpr size_t WS_END = 1151 * MiB;
constexpr int RW_NCK = MT / 16;
constexpr size_t OFF_RWMG = OFF_G, RWMG_REC = 8192 + 2048;
constexpr size_t OFF_RWH = OFF_SCN, RWH_REC = 16384;
static_assert(16 * (size_t)RW_NCK * RWMG_REC <= 91 * MiB && 16 * (size_t)RW_NCK * RWH_REC <= 165 * MiB, "rwkv chunk records fit their regions");
constexpr int KSPLIT = 32;

constexpr int LDS_BYTES = 147456;
constexpr int RING_BYTES = 131072;
constexpr int MISC_OFF = RING_BYTES + 320;

__device__ __forceinline__ float bf2f(unsigned b) { return __uint_as_float(b << 16); }
__device__ __forceinline__ unsigned f2bf(float f) { unsigned u = __float_as_uint(f); return (u + 0x7fffu + ((u >> 16) & 1u)) >> 16; }
__device__ __forceinline__ unsigned pk2(float lo, float hi) { return f2bf(lo) | (f2bf(hi) << 16); }
__device__ __forceinline__ float wave_sum(float v) {
#pragma unroll
    for (int o = 1; o < 64; o <<= 1) v += __shfl_xor(v, o);
    return v;
}
__device__ __forceinline__ float wave_max(float v) {
#pragma unroll
    for (int o = 1; o < 64; o <<= 1) v = fmaxf(v, __shfl_xor(v, o));
    return v;
}
__device__ __forceinline__ float sigmoidf_(float x) { return 1.0f / (1.0f + expf(-x)); }
__device__ __forceinline__ float siluf_(float x) { return x / (1.0f + expf(-x)); }
typedef float f32x16 __attribute__((ext_vector_type(16)));
#define MFMA32(a, b, c) __builtin_amdgcn_mfma_f32_32x32x16_bf16((a), (b), (c), 0, 0, 0)
#define KOFF(reg) (((reg) & 3) + 8 * ((reg) >> 2))
#define MFMA16(a, b, c) __builtin_amdgcn_mfma_f32_16x16x32_bf16((a), (b), (c), 0, 0, 0)
#define LDS_WAIT() asm volatile("s_waitcnt lgkmcnt(0)" ::: "memory")

__device__ __forceinline__ int seq_row(int d, int j) { return d == 0 ? (j < CTX ? SEQ + j : j - CTX) : (MT - 1 - j); }
__device__ __forceinline__ int row_seq(int d, int r) { return d == 0 ? (r >= SEQ ? r - SEQ : r + CTX) : (MT - 1 - r); }

#define XB_TMO      128
#define XB_XCNT(j)  (256  + 64 * (j))
#define XB_XSUB(j)  (1280 + 64 * (j))
#define XB_XGEN(j)  (2304 + 64 * (j))
#define XB_TOP      3328
#define XB_TOPGEN   3392
#define XCD_BAR_WORDS 3456
#define XB_SPIN_CAP (1u << 18)
__device__ __forceinline__ unsigned xb_ld(unsigned* p)              { return __hip_atomic_load(p, __ATOMIC_RELAXED, __HIP_MEMORY_SCOPE_AGENT); }
__device__ __forceinline__ unsigned xb_add(unsigned* p, unsigned v) { return __hip_atomic_fetch_add(p, v, __ATOMIC_RELAXED, __HIP_MEMORY_SCOPE_AGENT); }
__device__ __forceinline__ unsigned xb_xcc_id() { return (unsigned)__builtin_amdgcn_s_getreg((3 << 11) | 20) & 0xFu; }
#define XB_SPIN(cond, bar) do { unsigned _sp = 0; while (cond) { __builtin_amdgcn_s_sleep(1); \
    if ((++_sp & 255u) == 0u) { if (xb_ld(&(bar)[XB_TMO])) break; if (_sp > XB_SPIN_CAP) { atomicAdd(&(bar)[XB_TMO], 1u); break; } } } } while (0)
struct XcdBarrier { unsigned* bar; unsigned x; volatile LAS unsigned* st; };
__device__ __forceinline__ XcdBarrier xcd_barrier_post(unsigned* bar, volatile LAS unsigned* st) {
    XcdBarrier b; b.bar = bar; b.x = xb_xcc_id(); b.st = st;
    if (threadIdx.x == 0) (void)xb_add(&bar[XB_XCNT(b.x)], 1u);
    return b;
}
__device__ __forceinline__ void xcd_barrier_complete(unsigned* bar, unsigned x, unsigned& nloc, unsigned& nx) {
    const unsigned G = gridDim.x * gridDim.y * gridDim.z;
    unsigned sum, cnt, mine, sp = 0u;
    for (;;) {
        sum = 0u; cnt = 0u; mine = 0u;
#pragma unroll
        for (unsigned j = 0; j < 16; ++j) { const unsigned c = xb_ld(&bar[XB_XCNT(j)]); sum += c; cnt += (c > 0u) ? 1u : 0u; mine = (j == x) ? c : mine; }
        if (sum == G) break;
        __builtin_amdgcn_s_sleep(1);
        if ((++sp & 255u) == 0u) { if (xb_ld(&bar[XB_TMO])) break; if (sp > XB_SPIN_CAP) { atomicAdd(&bar[XB_TMO], 1u); break; } }
    }
    nloc = mine > 0u ? mine : 1u; nx = cnt > 0u ? cnt : 1u;
}
__device__ __forceinline__ void xcd_barrier(const XcdBarrier& b) {
    asm volatile("s_waitcnt vmcnt(0)" ::: "memory");
    __syncthreads();
    if (threadIdx.x == 0) {
        unsigned* bar = b.bar;
        __builtin_amdgcn_s_waitcnt(0);
        unsigned nloc = b.st[0], nx = b.st[1];
        if (nloc == 0u) { xcd_barrier_complete(bar, b.x, nloc, nx); b.st[0] = nloc; b.st[1] = nx; }
        const unsigned old = xb_add(&bar[XB_XSUB(b.x)], 1u);
        const unsigned gen = old / nloc;
        if (old + 1u == (gen + 1u) * nloc) {
            __builtin_amdgcn_fence(__ATOMIC_RELEASE, "agent");
            asm volatile("s_waitcnt vmcnt(0)" ::: "memory");
            const unsigned og = xb_add(&bar[XB_TOP], 1u);
            const unsigned tg = og / nx;
            if (og + 1u == (tg + 1u) * nx) xb_add(&bar[XB_TOPGEN], 1u);
            else XB_SPIN(xb_ld(&bar[XB_TOPGEN]) == tg, bar);
            __builtin_amdgcn_fence(__ATOMIC_ACQUIRE, "agent");
            xb_add(&bar[XB_XGEN(b.x)], 1u);
            asm volatile("s_waitcnt vmcnt(0)" ::: "memory");
        } else {
            XB_SPIN(xb_ld(&bar[XB_XGEN(b.x)]) == gen, bar);
            __builtin_amdgcn_fence(__ATOMIC_ACQUIRE, "agent");
            asm volatile("s_waitcnt vmcnt(0)" ::: "memory");
        }
    }
    __syncthreads();
}

namespace pg8 {
constexpr int BM = 256, BK = 64, HALF = 128, HTB = HALF * BK * 2, STAGE_BYTES = 8 * HTB, NXCD = 8, WGM = 8;
__host__ __device__ __forceinline__ int lds_byte(int r, int c) { const int st = (r >> 4) * 2 + (c >> 5), rr = r & 15, cc = c & 31, ob = rr * 64 + cc * 2; return st * 1024 + (ob ^ (((ob >> 9) & 1) << 5)); }
__host__ __device__ __forceinline__ void stage_rc(int b, int& R, int& C) { const int st = b / 1024, sb = b % 1024, swz = sb ^ (((sb >> 9) & 1) << 5); R = (st >> 1) * 16 + swz / 64; C = (st & 1) * 32 + (swz % 64) / 2; }
__host__ __device__ __forceinline__ int perm32(int rho) { const int n = rho >> 4, i = rho & 15; return 8 * (i >> 2) + 4 * n + (i & 3); }
struct Unit { int pm, pn, ks; };
struct Gemm { const bf16_t* A; const bf16_t* Bt; size_t a_gstride; size_t a_kgs; int a_div, b_mod, b_gcol, pad; };
__device__ __forceinline__ Gemm mkgemm(const bf16_t* A, const bf16_t* Bt) { Gemm g; g.A = A; g.Bt = Bt; g.a_gstride = 0; g.a_kgs = 0; g.a_div = 1 << 20; g.b_mod = 1 << 20; g.b_gcol = 0; g.pad = 0; return g; }
struct StaticOrder {
    int nM, nN, nwg, G, c;
    __host__ __device__ void init(int M, int N, int G_, int c_) { nM = M / BM; nN = N / BM; nwg = nM * nN; G = G_; c = c_; }
    __host__ __device__ bool next(int i, Unit& u) const {
        const long L = (long)i * G + c; if (L >= nwg) return false;
        int wgid = (int)L; { const int q = nwg / NXCD, r = nwg % NXCD, xcd = wgid % NXCD, off = wgid / NXCD; wgid = (xcd < r ? xcd * (q + 1) : r * (q + 1) + (xcd - r) * q) + off; }
        const int nig = WGM * nN, gid = wgid / nig, fm = gid * WGM, gsz = (nM - fm) < WGM ? (nM - fm) : WGM;
        u.pm = fm + ((wgid % nig) % gsz); u.pn = (wgid % nig) / gsz; u.ks = 0; return true;
    }
};
struct SplitOrder {
    int pm, nN, KS, G, c;
    __host__ __device__ bool next(int i, Unit& u) const { const int L = i * G + c; if (L >= nN * KS) return false; u.pm = pm; u.pn = L / KS; u.ks = L % KS; return true; }
};
__device__ __forceinline__ unsigned cvt_pk_bf16(float lo, float hi) { unsigned r; asm volatile("v_cvt_pk_bf16_f32 %0, %1, %2" : "=v"(r) : "v"(lo), "v"(hi)); return r; }

template <class Epi, bool ALIGN_EPI, bool SP2, class Sched, int KE, int LDA, int LDB, int KSS, int AGRP = 0>
__device__ __forceinline__ void gemm_phase(LAS unsigned char* lds, const Gemm g, const Sched& S, const Epi& E, const int tid) {
    const int wid = __builtin_amdgcn_readfirstlane(tid >> 6), lane = tid & 63, wr = wid >> 2, wc = wid & 3, fr = lane & 15, fq = lane >> 4;
    constexpr int nt = KE / BK;
    static_assert(!Epi::MIDK || SP2, "the mid-K hook sits in the SP2 loop only");
    unsigned voffA[2], voffB[2];
#pragma unroll
    for (int i = 0; i < 2; ++i) { int R, C; stage_rc(tid * 16 + i * 8192, R, C); const int Rb = Epi::PERM ? ((R & ~31) + perm32(R & 31)) : R;
        voffA[i] = (unsigned)(R * LDA + C) * 2u; voffB[i] = (unsigned)(Rb * LDB + C) * 2u; }
    const size_t kstep = (size_t)(BK * 2);
    constexpr size_t hstepA = (size_t)HALF * LDA * 2, hstepB = (size_t)HALF * LDB * 2;
    const unsigned ldsw = (unsigned)wid * 1024u;
    const int aoff = lds_byte(wr * 64 + fr, fq * 8), boff = lds_byte(wc * 32 + fr, fq * 8);
#define PG8_SA(b, h) (((b) * 2 + (h)) * HTB)
#define PG8_SB(b, h) ((4 + (b) * 2 + (h)) * HTB)
#define PG8_STAGE(bufoff, gbase, voff) do { _Pragma("unroll") for (int _i = 0; _i < 2; ++_i) \
        __builtin_amdgcn_global_load_lds((const unsigned*)((const char*)(gbase) + (voff)[_i]), (LAS unsigned*)(lds + (bufoff) + ldsw + _i * 8192), 16, 0, 0); } while (0)
#define PG8_LDA(dst, b, h) do { _Pragma("unroll") for (int m = 0; m < 4; ++m) _Pragma("unroll") for (int k = 0; k < 2; ++k) dst[m][k] = *(const LAS bf16x8*)(lds + PG8_SA(b, h) + aoff + m * 2048 + k * 1024); } while (0)
#define PG8_LDB(dst, b, h) do { _Pragma("unroll") for (int n = 0; n < 2; ++n) _Pragma("unroll") for (int k = 0; k < 2; ++k) dst[n][k] = *(const LAS bf16x8*)(lds + PG8_SB(b, h) + boff + n * 2048 + k * 1024); } while (0)
#define PG8_MMA(ai, bj, At, Bt) do { __builtin_amdgcn_s_setprio(1); _Pragma("unroll") for (int m = 0; m < 4; ++m) _Pragma("unroll") for (int n = 0; n < 2; ++n) _Pragma("unroll") for (int k = 0; k < 2; ++k) \
        acc[ai][bj][m][n] = __builtin_amdgcn_mfma_f32_16x16x32_bf16(Bt[n][k], At[m][k], acc[ai][bj][m][n], 0, 0, 0); __builtin_amdgcn_s_setprio(0); } while (0)
#define PG8_WAIT_V(n) asm volatile("s_waitcnt vmcnt(" #n ")" ::: "memory")
#define PG8_WAIT_L(n) asm volatile("s_waitcnt lgkmcnt(" #n ")" ::: "memory")
#define PG8_BAR __builtin_amdgcn_s_barrier()
#define PG8_SCHED __builtin_amdgcn_sched_barrier(0)
#define PG8_ABASE(u) ((const char*)g.A + ((size_t)((u).pn / g.a_div) * g.a_gstride) * 2 + (size_t)(u).pm * 2 * hstepA + (size_t)(u).ks * KSS * 2)
#define PG8_BBASE(u) ((const char*)g.Bt + (size_t)((u).pn % g.b_mod) * 2 * hstepB + ((size_t)((u).pn / g.b_mod) * g.b_gcol + (size_t)(u).ks * KSS) * 2)
#define PG8_AT(tt) (AGRP ? (size_t)((tt) / (AGRP ? AGRP : 1)) * g.a_kgs + (size_t)((tt) % (AGRP ? AGRP : 1)) * kstep : (size_t)(tt) * kstep)
    Unit cur, nxt; int ui = 0;
    if (!S.next(0, cur)) return;
    f32x4 acc[2][2][4][2];
#pragma unroll
    for (int a = 0; a < 2; ++a)
#pragma unroll
        for (int b = 0; b < 2; ++b)
#pragma unroll
            for (int m = 0; m < 4; ++m)
#pragma unroll
                for (int n = 0; n < 2; ++n) acc[a][b][m][n] = (f32x4){0.f, 0.f, 0.f, 0.f};
    bf16x8 At[4][2], B0[2][2], B1[2][2];
    const char* cA = PG8_ABASE(cur); const char* cB = PG8_BBASE(cur);
    if constexpr (SP2) {
        PG8_STAGE(PG8_SB(0, 0), cB, voffB); PG8_STAGE(PG8_SB(0, 1), cB + hstepB, voffB); PG8_STAGE(PG8_SA(0, 0), cA, voffA); PG8_STAGE(PG8_SA(0, 1), cA + hstepA, voffA);
        if (wr == 1) PG8_BAR;
        PG8_WAIT_V(2); PG8_BAR;
        PG8_STAGE(PG8_SB(1, 0), cB + kstep, voffB); PG8_STAGE(PG8_SA(1, 0), cA + kstep, voffA); PG8_STAGE(PG8_SB(1, 1), cB + hstepB + kstep, voffB);
        PG8_WAIT_V(6); PG8_BAR;
    } else {
        PG8_STAGE(PG8_SB(0, 0), cB, voffB); PG8_STAGE(PG8_SA(0, 0), cA, voffA); PG8_STAGE(PG8_SB(0, 1), cB + hstepB, voffB); PG8_STAGE(PG8_SA(0, 1), cA + hstepA, voffA);
        if (wr == 1) PG8_BAR;
        PG8_WAIT_V(4); PG8_BAR;
        PG8_STAGE(PG8_SB(1, 0), cB + kstep, voffB); PG8_STAGE(PG8_SA(1, 0), cA + kstep, voffA); PG8_STAGE(PG8_SB(1, 1), cB + hstepB + kstep, voffB);
        PG8_WAIT_V(6); PG8_BAR;
    }
    for (;;) {
        const bool has_next = S.next(ui + 1, nxt);
        const char* nA = has_next ? PG8_ABASE(nxt) : cA; const char* nB = has_next ? PG8_BBASE(nxt) : cB;
#pragma unroll 1
        for (int t = 0; t < nt; t += 2) {
            const bool last = (t == nt - 2);
            const char* a1 = cA + PG8_AT(t + 1);
            const char* a2 = last ? nA : cA + PG8_AT(t + 2); const char* b2 = last ? nB : cB + (size_t)(t + 2) * kstep;
            const char* a3 = last ? nA + kstep : cA + PG8_AT(t + 3); const char* b3 = b2 + kstep;
            if constexpr (SP2) {
            PG8_LDB(B0, 0, 0); PG8_LDB(B1, 0, 1); PG8_SCHED; PG8_LDA(At, 0, 0); PG8_STAGE(PG8_SA(1, 1), a1 + hstepA, voffA);
            PG8_WAIT_V(8); PG8_WAIT_L(0); PG8_BAR;
            if constexpr (Epi::MIDK) { if (t > 0 && (t % (AGRP ? AGRP : 1)) == 0) { int fr3 = fr, fq3 = fq; asm volatile("" : "+v"(fr3), "+v"(fq3)); E.mid(acc, cur, t / (AGRP ? AGRP : 1), wr, wc, fr3, fq3); } }
            PG8_MMA(0, 0, At, B0); PG8_MMA(0, 1, At, B1); PG8_BAR; PG8_SCHED;
            PG8_LDA(At, 0, 1); PG8_STAGE(PG8_SB(0, 0), b2, voffB); PG8_STAGE(PG8_SB(0, 1), b2 + hstepB, voffB); PG8_STAGE(PG8_SA(0, 0), a2, voffA);
            PG8_WAIT_V(8); PG8_WAIT_L(0); PG8_BAR; PG8_MMA(1, 0, At, B0); PG8_MMA(1, 1, At, B1); PG8_BAR; PG8_SCHED;
            PG8_LDB(B0, 1, 0); PG8_LDB(B1, 1, 1); PG8_SCHED; PG8_LDA(At, 1, 0); PG8_STAGE(PG8_SA(0, 1), a2 + hstepA, voffA);
            PG8_WAIT_V(8); PG8_WAIT_L(0); PG8_BAR; PG8_MMA(0, 0, At, B0); PG8_MMA(0, 1, At, B1); PG8_BAR; PG8_SCHED;
            PG8_LDA(At, 1, 1); PG8_STAGE(PG8_SB(1, 0), b3, voffB); PG8_STAGE(PG8_SB(1, 1), b3 + hstepB, voffB); PG8_STAGE(PG8_SA(1, 0), a3, voffA);
            PG8_WAIT_V(8); PG8_WAIT_L(0); PG8_BAR; PG8_MMA(1, 0, At, B0); PG8_MMA(1, 1, At, B1); PG8_BAR; PG8_SCHED;
            } else {
            PG8_LDB(B0, 0, 0); PG8_SCHED; PG8_LDA(At, 0, 0); PG8_STAGE(PG8_SA(1, 1), a1 + hstepA, voffA);
            PG8_WAIT_L(8); PG8_BAR; PG8_WAIT_L(0); PG8_MMA(0, 0, At, B0); PG8_BAR; PG8_SCHED;
            PG8_LDB(B1, 0, 1); PG8_STAGE(PG8_SB(0, 0), b2, voffB);
            PG8_BAR; PG8_WAIT_L(0); PG8_MMA(0, 1, At, B1); PG8_BAR;
            PG8_LDA(At, 0, 1); PG8_STAGE(PG8_SA(0, 0), a2, voffA);
            PG8_BAR; PG8_WAIT_L(0); PG8_MMA(1, 0, At, B0); PG8_BAR; PG8_SCHED;
            PG8_STAGE(PG8_SB(0, 1), b2 + hstepB, voffB);
            PG8_WAIT_V(6); PG8_BAR; PG8_MMA(1, 1, At, B1); PG8_BAR;
            PG8_LDB(B0, 1, 0); PG8_SCHED; PG8_LDA(At, 1, 0); PG8_STAGE(PG8_SA(0, 1), a2 + hstepA, voffA);
            PG8_WAIT_L(8); PG8_BAR; PG8_WAIT_L(0); PG8_MMA(0, 0, At, B0); PG8_BAR; PG8_SCHED;
            PG8_LDB(B1, 1, 1); PG8_STAGE(PG8_SB(1, 0), b3, voffB);
            PG8_BAR; PG8_WAIT_L(0); PG8_MMA(0, 1, At, B1); PG8_BAR;
            PG8_LDA(At, 1, 1); PG8_STAGE(PG8_SA(1, 0), a3, voffA);
            PG8_BAR; PG8_WAIT_L(0); PG8_MMA(1, 0, At, B0); PG8_BAR; PG8_SCHED;
            PG8_STAGE(PG8_SB(1, 1), b3 + hstepB, voffB);
            PG8_WAIT_V(6); PG8_BAR; PG8_MMA(1, 1, At, B1); PG8_BAR;
            }
        }
        if constexpr (ALIGN_EPI) { if (wr == 0) PG8_BAR; }
        { int fr2 = fr, fq2 = fq; asm volatile("" : "+v"(fr2), "+v"(fq2));
          E(acc, cur, wr, wc, fr2, fq2); }
        if (!has_next) break;
#pragma unroll
        for (int a = 0; a < 2; ++a)
#pragma unroll
            for (int b = 0; b < 2; ++b)
#pragma unroll
                for (int m = 0; m < 4; ++m)
#pragma unroll
                    for (int n = 0; n < 2; ++n) acc[a][b][m][n] = (f32x4){0.f, 0.f, 0.f, 0.f};
        cur = nxt; cA = nA; cB = nB; ++ui;
        if constexpr (ALIGN_EPI) { if (wr == 1) PG8_BAR; }
    }
    PG8_WAIT_V(0);
    if constexpr (!ALIGN_EPI) { if (wr == 0) PG8_BAR; }
    PG8_BAR;
#undef PG8_SA
#undef PG8_SB
#undef PG8_STAGE
#undef PG8_LDA
#undef PG8_LDB
#undef PG8_MMA
#undef PG8_WAIT_V
#undef PG8_WAIT_L
#undef PG8_BAR
#undef PG8_SCHED
#undef PG8_ABASE
#undef PG8_BBASE
#undef PG8_AT
}

struct EpiSwiGLU {
    static constexpr bool PERM = true, MIDK = false;
    bf16_t* O;
    __device__ __forceinline__ void operator()(const f32x4 (&acc)[2][2][4][2], const Unit& u, int wr, int wc, int fr, int fq) const {
        const int row0 = u.pm * BM + wr * 64 + fr, col0 = u.pn * HALF + wc * 32 + 8 * fq;
#pragma unroll
        for (int ai = 0; ai < 2; ++ai)
#pragma unroll
            for (int m = 0; m < 4; ++m) {
                bf16_t* rowp = O + (size_t)(row0 + ai * HALF + m * 16) * DFF + col0;
                float o[8];
#pragma unroll
                for (int n = 0; n < 2; ++n)
#pragma unroll
                    for (int j = 0; j < 4; ++j) { const float a = acc[ai][0][m][n][j], b = acc[ai][1][m][n][j]; o[n * 4 + j] = a / (1.0f + __expf(-a)) * b; }
                u32x4 w; w.x = cvt_pk_bf16(o[0], o[1]); w.y = cvt_pk_bf16(o[2], o[3]); w.z = cvt_pk_bf16(o[4], o[5]); w.w = cvt_pk_bf16(o[6], o[7]);
                *(u32x4*)rowp = w;
            }
    }
};
template <bool HALFGATE> struct EpiResid {
    static constexpr bool PERM = false, MIDK = false;
    float* X; const float* gate_lat; const float* gate_ctx; float* out; const float* base;
    __device__ __forceinline__ void operator()(const f32x4 (&acc)[2][2][4][2], const Unit& u, int wr, int wc, int fr, int fq) const {
        const int row0 = u.pm * BM + wr * 64 + fr, col0 = u.pn * BM + wc * 32 + 4 * fq;
        const float* gp = (u.pm * BM >= SEQ) ? gate_ctx : gate_lat;
#pragma unroll
        for (int bj = 0; bj < 2; ++bj)
#pragma unroll
            for (int n = 0; n < 2; ++n) {
                const f32x4 gv = *(const f32x4*)(gp + col0 + bj * HALF + n * 16) * (HALFGATE ? 0.5f : 1.0f);
#pragma unroll
                for (int ai = 0; ai < 2; ++ai)
#pragma unroll
                    for (int m = 0; m < 4; ++m) {
                        const int row = row0 + ai * HALF + m * 16;
                        float* p = X + (size_t)row * D + col0 + bj * HALF + n * 16;
                        const f32x4 v = *(const f32x4*)(base + (size_t)row * D + col0 + bj * HALF + n * 16) + gv * acc[ai][bj][m][n];
                        *(f32x4*)p = v;
                        if (out != nullptr && row < SEQ) *(f32x4*)(out + (size_t)row * D + col0 + bj * HALF + n * 16) = v;
                    }
            }
    }
};
template <bool HALFGATE> struct EpiPart {
    static constexpr bool PERM = false, MIDK = false;
    float* PART; const float* gate_ctx;
    __device__ __forceinline__ void operator()(const f32x4 (&acc)[2][2][4][2], const Unit& u, int wr, int wc, int fr, int fq) const {
        const int row0 = wr * 64 + fr, col0 = u.pn * BM + wc * 32 + 4 * fq;
        f32x4 gv[2][2];
#pragma unroll
        for (int bj = 0; bj < 2; ++bj)
#pragma unroll
            for (int n = 0; n < 2; ++n) gv[bj][n] = *(const f32x4*)(gate_ctx + col0 + bj * HALF + n * 16) * (HALFGATE ? 0.5f : 1.0f);
#pragma unroll
        for (int ai = 0; ai < 2; ++ai)
#pragma unroll
            for (int m = 0; m < 4; ++m) {
                float* rowp = PART + ((size_t)u.ks * BM + row0 + ai * HALF + m * 16) * D + col0;
#pragma unroll
                for (int bj = 0; bj < 2; ++bj)
#pragma unroll
                    for (int n = 0; n < 2; ++n) *(f32x4*)(rowp + bj * HALF + n * 16) = gv[bj][n] * acc[ai][bj][m][n];
            }
    }
};
struct EpiWin {
    static constexpr bool PERM = true, MIDK = false;
    float* P32; bf16_t* PA; bf16_t* GL; long pn_off;
    __device__ __forceinline__ void operator()(const f32x4 (&acc)[2][2][4][2], const Unit& u0, int wr, int wc, int fr, int fq) const {
        Unit u; u.pm = u0.pm; u.pn = u0.pn + (int)pn_off;
        const int row0 = u.pm * BM + wr * 64 + fr, cin = wc * 32 + 8 * fq;
        if (u.pn < 19) {
#pragma unroll
            for (int ai = 0; ai < 2; ++ai)
#pragma unroll
                for (int m = 0; m < 4; ++m) { float* rowp = P32 + (size_t)(row0 + ai * HALF + m * 16) * P32W + u.pn * BM + cin;
#pragma unroll
                    for (int bj = 0; bj < 2; ++bj) { *(f32x4*)(rowp + bj * HALF) = acc[ai][bj][m][0]; *(f32x4*)(rowp + bj * HALF + 4) = acc[ai][bj][m][1]; } }
        } else {
            bf16_t* base; int ld, colt;
            if (u.pn < 28) { base = PA; ld = PAW; colt = (u.pn - 19) * BM; } else { base = GL; ld = GLW; colt = (u.pn - 28) * BM; }
#pragma unroll
            for (int ai = 0; ai < 2; ++ai)
#pragma unroll
                for (int m = 0; m < 4; ++m) { bf16_t* rowp = base + (size_t)(row0 + ai * HALF + m * 16) * ld + colt + cin;
#pragma unroll
                    for (int bj = 0; bj < 2; ++bj) { const f32x4 v0 = acc[ai][bj][m][0], v1 = acc[ai][bj][m][1];
                        u32x4 w; w.x = cvt_pk_bf16(v0[0], v0[1]); w.y = cvt_pk_bf16(v0[2], v0[3]); w.z = cvt_pk_bf16(v1[0], v1[1]); w.w = cvt_pk_bf16(v1[2], v1[3]);
                        *(u32x4*)(rowp + bj * HALF) = w; } }
        }
    }
};
struct EpiMerge {
    static constexpr bool PERM = true, MIDK = false;
    const bf16_t* GL; bf16_t* PROJ;
    __device__ __forceinline__ void operator()(const f32x4 (&acc)[2][2][4][2], const Unit& u, int wr, int wc, int fr, int fq) const {
        const int row0 = u.pm * BM + wr * 64 + fr, col0 = u.pn * BM + wc * 32 + 8 * fq;
#pragma unroll
        for (int ai = 0; ai < 2; ++ai)
#pragma unroll
            for (int m = 0; m < 4; ++m) { const size_t ro = (size_t)(row0 + ai * HALF + m * 16) * GLW + col0;
#pragma unroll
                for (int bj = 0; bj < 2; ++bj) {
                    const u32x4 gw = *(const u32x4*)(GL + ro + bj * HALF);
                    const f32x4 v0 = acc[ai][bj][m][0], v1 = acc[ai][bj][m][1];
                    float o[8];
                    o[0] = v0[0] / (1.0f + __expf(-bf2f(gw.x & 0xffffu))); o[1] = v0[1] / (1.0f + __expf(-bf2f(gw.x >> 16)));
                    o[2] = v0[2] / (1.0f + __expf(-bf2f(gw.y & 0xffffu))); o[3] = v0[3] / (1.0f + __expf(-bf2f(gw.y >> 16)));
                    o[4] = v1[0] / (1.0f + __expf(-bf2f(gw.z & 0xffffu))); o[5] = v1[1] / (1.0f + __expf(-bf2f(gw.z >> 16)));
                    o[6] = v1[2] / (1.0f + __expf(-bf2f(gw.w & 0xffffu))); o[7] = v1[3] / (1.0f + __expf(-bf2f(gw.w >> 16)));
                    u32x4 w; w.x = cvt_pk_bf16(o[0], o[1]); w.y = cvt_pk_bf16(o[2], o[3]); w.z = cvt_pk_bf16(o[4], o[5]); w.w = cvt_pk_bf16(o[6], o[7]);
                    *(u32x4*)(PROJ + ro + bj * HALF) = w; } }
    }
};
struct EpiMergeF {
    static constexpr bool PERM = true, MIDK = true;
    const bf16_t* GL; bf16_t* MG;
    __device__ __forceinline__ void mid(f32x4 (&acc)[2][2][4][2], const Unit& u, int g, int wr, int wc, int fr, int fq) const {
        const int row0 = u.pm * BM + wr * 64 + fr, col0 = u.pn * BM + wc * 32 + 8 * fq;
#pragma unroll
        for (int ai = 0; ai < 2; ++ai)
#pragma unroll
            for (int m = 0; m < 4; ++m) { const bf16_t* gp = GL + (size_t)(row0 + ai * HALF + m * 16) * GLW + (size_t)(g - 1) * D + col0;
#pragma unroll
                for (int bj = 0; bj < 2; ++bj) {
                    const u32x4 ga = *(const u32x4*)(gp + bj * HALF), gb = *(const u32x4*)(gp + D + bj * HALF);
                    const unsigned wa[4] = {ga.x, ga.y, ga.z, ga.w}, wb[4] = {gb.x, gb.y, gb.z, gb.w};
#pragma unroll
                    for (int j = 0; j < 4; ++j) {
                        const float r0 = (1.0f + __expf(-bf2f(wb[j] & 0xffffu))) * __builtin_amdgcn_rcpf(1.0f + __expf(-bf2f(wa[j] & 0xffffu)));
                        const float r1 = (1.0f + __expf(-bf2f(wb[j] >> 16))) * __builtin_amdgcn_rcpf(1.0f + __expf(-bf2f(wa[j] >> 16)));
                        acc[ai][bj][m][j >> 1][(j & 1) * 2] *= r0; acc[ai][bj][m][j >> 1][(j & 1) * 2 + 1] *= r1;
                    }
                }
            }
    }
    __device__ __forceinline__ void operator()(const f32x4 (&acc)[2][2][4][2], const Unit& u, int wr, int wc, int fr, int fq) const {
        const int row0 = u.pm * BM + wr * 64 + fr, col0 = u.pn * BM + wc * 32 + 8 * fq;
#pragma unroll
        for (int ai = 0; ai < 2; ++ai)
#pragma unroll
            for (int m = 0; m < 4; ++m) { const int row = row0 + ai * HALF + m * 16;
#pragma unroll
                for (int bj = 0; bj < 2; ++bj) {
                    const u32x4 gw = *(const u32x4*)(GL + (size_t)row * GLW + 3 * D + col0 + bj * HALF);
                    const unsigned wg[4] = {gw.x, gw.y, gw.z, gw.w};
                    float o[8];
#pragma unroll
                    for (int j = 0; j < 4; ++j) {
                        o[2 * j] = acc[ai][bj][m][j >> 1][(j & 1) * 2] * __builtin_amdgcn_rcpf(1.0f + __expf(-bf2f(wg[j] & 0xffffu)));
                        o[2 * j + 1] = acc[ai][bj][m][j >> 1][(j & 1) * 2 + 1] * __builtin_amdgcn_rcpf(1.0f + __expf(-bf2f(wg[j] >> 16)));
                    }
                    u32x4 w; w.x = cvt_pk_bf16(o[0], o[1]); w.y = cvt_pk_bf16(o[2], o[3]); w.z = cvt_pk_bf16(o[4], o[5]); w.w = cvt_pk_bf16(o[6], o[7]);
                    *(u32x4*)(MG + (size_t)row * D + col0 + bj * HALF) = w; } }
    }
};
}

enum { I_X = 0, I_C, I_CTX, I_CCTX, I_ADAW, I_ADAB, I_NF1, I_NMIX, I_NF2, I_F1WI, I_F1WO, I_F2WI, I_F2WO, I_WIN, I_HGLB, I_HGNORM, I_RWSHIFT, I_RWW0, I_RWW2, I_RWA0, I_RWA2,
       I_RWKK, I_RWKA, I_RWRK, I_RWLNW, I_RWLNB, I_NAQN, I_NAKN, I_NARPB, I_WAQN, I_WAKN, I_WASINK, I_WBR, I_WOUT, N_IN };
struct Args { const float* in[N_IN]; float* out; unsigned char* ws; int ph_lo, ph_hi; };
struct Ctx {
    LAS unsigned char* lds;
    int tid, lane, wave, bid, G;
    const Args __attribute__((address_space(4)))* ka; float* out; unsigned char* ws;
};
#define WSP(T, off) ((T*)(C.ws + (off)))
__device__ __forceinline__ void relaunder(Ctx& C) {
    int t = C.tid, b = C.bid, g = C.G;
    asm volatile("" : "+v"(t), "+v"(b), "+v"(g));
    C.tid = t; C.lane = t & 63; C.wave = __builtin_amdgcn_readfirstlane(t >> 6); C.bid = __builtin_amdgcn_readfirstlane(b); C.G = __builtin_amdgcn_readfirstlane(g);
}

__device__ __forceinline__ void transpose_item(const float* W, int K, int N, bf16_t* WT, int mode, LAS float* scr, int item, int lane, int ldw = 0, int coff = 0) {
    if (ldw == 0) ldw = K;
    const int nblk = N / 32, kb = item / nblk, nb = item % nblk, k0 = 64 * kb, n0 = 32 * nb;
    int drow0 = n0;
    if (mode == 1) { const int half = n0 / DFF, j0 = n0 % DFF; drow0 = 256 * (j0 / 128) + 128 * half + (j0 % 128); }
    { const int kr = lane >> 3, n4 = lane & 7;
      f32x4 v[8];
#pragma unroll
      for (int i = 0; i < 8; ++i) v[i] = *(const f32x4*)(W + (size_t)(k0 + 8 * i + kr) * N + n0 + 4 * n4);
#pragma unroll
      for (int i = 0; i < 8; ++i)
#pragma unroll
          for (int j = 0; j < 4; ++j) scr[(8 * i + kr) * 33 + 4 * n4 + j] = v[i][j]; }
    LDS_WAIT(); asm volatile("" ::: "memory");
    const int c = lane & 7;
#pragma unroll
    for (int j = 0; j < 4; ++j) { const int n = (lane >> 3) + 8 * j; const LAS float* s = scr + (8 * c) * 33 + n;
        u32x4 o; o.x = pk2(s[0 * 33], s[1 * 33]); o.y = pk2(s[2 * 33], s[3 * 33]); o.z = pk2(s[4 * 33], s[5 * 33]); o.w = pk2(s[6 * 33], s[7 * 33]);
        *(u32x4*)(WT + (size_t)(drow0 + n) * ldw + coff + k0 + 8 * c) = o; }
    LDS_WAIT(); asm volatile("" ::: "memory");
}
constexpr int CV_WI = (D / 64) * (2 * DFF / 32), CV_WO = (DFF / 64) * (D / 32), CV_IN = (D / 64) * (PTOT / 32), CV_BR = (512 / 64) * (D / 32), CV_OUT = (D / 64) * (D / 32);
constexpr int CV_O_WI1 = 0, CV_O_WI2 = CV_WI, CV_O_WO1 = 2 * CV_WI, CV_O_WO2 = CV_O_WO1 + CV_WO, CV_O_IN = CV_O_WO2 + CV_WO, CV_O_BR = CV_O_IN + CV_IN, CV_O_OUT = CV_O_BR + 4 * CV_BR, CV_N = CV_O_OUT + CV_OUT;
constexpr int CV_Q_WI1 = 68 * 8 * 16, CV_Q_IN = 84 * 8 * 16, CV_Q_WI2 = 84 * 8 * 16;
static_assert(CV_Q_WI1 <= CV_WI && CV_Q_IN <= CV_IN && CV_Q_WI2 <= CV_WI, "quotas");
__device__ __forceinline__ void phase_convert(Ctx& C, int l, int mask, int b0, int nbk, int it_lo = 0, int it_hi = CV_N) {
    LAS float* scr = (LAS float*)(C.lds + C.wave * 16384);
    const int gw = b0 * NWAVES + C.wave, NGW = nbk * NWAVES;
    constexpr int I_WI = (D / 64) * (2 * DFF / 32), I_WO = (DFF / 64) * (D / 32), I_IN = (D / 64) * (PTOT / 32), I_BR = (512 / 64) * (D / 32), I_OUT = (D / 64) * (D / 32);
    constexpr int NITEMS = 2 * I_WI + 2 * I_WO + I_IN + 4 * I_BR + I_OUT;
    static_assert(NITEMS == CV_N && I_WI == CV_WI && I_WO == CV_WO && I_IN == CV_IN && I_BR == CV_BR, "item enumeration");
    for (int it = it_lo + gw; it < it_hi; it += NGW) {
        int r = it;
        if (r < I_WI) { if (mask & 1) transpose_item(C.ka->in[I_F1WI] + (size_t)l * D * 2 * DFF, D, 2 * DFF, WSP(bf16_t, OFF_WI1), 1, scr, r, C.lane); continue; } r -= I_WI;
        if (r < I_WI) { if (mask & 2) transpose_item(C.ka->in[I_F2WI] + (size_t)l * D * 2 * DFF, D, 2 * DFF, WSP(bf16_t, OFF_WI2), 1, scr, r, C.lane); continue; } r -= I_WI;
        if (r < I_WO) { if (mask & 4) transpose_item(C.ka->in[I_F1WO] + (size_t)l * DFF * D, DFF, D, WSP(bf16_t, OFF_WO1), 0, scr, r, C.lane); continue; } r -= I_WO;
        if (r < I_WO) { if (mask & 8) transpose_item(C.ka->in[I_F2WO] + (size_t)l * DFF * D, DFF, D, WSP(bf16_t, OFF_WO2), 0, scr, r, C.lane); continue; } r -= I_WO;
        if (r < I_IN) { if (mask & 16) transpose_item(C.ka->in[I_WIN] + (size_t)l * D * PTOT, D, PTOT, WSP(bf16_t, OFF_WIN), 0, scr, r, C.lane); continue; } r -= I_IN;
        if (r < 4 * I_BR) { const int g = r / I_BR; if (mask & 32) transpose_item(C.ka->in[I_WBR] + ((size_t)l * 4 + g) * 512 * D, 512, D, WSP(bf16_t, OFF_WBR), 0, scr, r % I_BR, C.lane, 4 * 512, g * 512); continue; } r -= 4 * I_BR;
        if (mask & 64) transpose_item(C.ka->in[I_WOUT] + (size_t)l * D * D, D, D, WSP(bf16_t, OFF_WOUT), 0, scr, r, C.lane);
    }
    if (!(mask & 64)) return;
    bf16_t* W2T = WSP(bf16_t, OFF_W2T);
    for (int idx = b0 * NT + C.tid; idx < 2 * 2 * 512 * 8; idx += nbk * NT) {
        const int k8 = idx & 7, col = (idx >> 3) & 511, m = (idx >> 12) & 1, d = idx >> 13;
        const float* src = (m == 0 ? C.ka->in[I_RWW2] : C.ka->in[I_RWA2]) + ((size_t)(l * 2 + d) * 64 + 8 * k8) * 512 + col;
        u32x4 w; w.x = pk2(src[0], src[512]); w.y = pk2(src[1024], src[1536]); w.z = pk2(src[2048], src[2560]); w.w = pk2(src[3072], src[3584]);
        *(u32x4*)(W2T + ((size_t)((d * 2 + m) * 512 + col) * 64 + 8 * k8)) = w;
    }
}

__device__ __forceinline__ void phase_ada_partial(Ctx& C) {
    float* modp = WSP(float, OFF_MODP);
    for (int u = C.bid; u < DEPTH * 9 * KSPLIT; u += C.G) {
        const int l = u / (9 * KSPLIT), rem = u % (9 * KSPLIT), cg = rem / KSPLIT, ks = rem % KSPLIT;
        const int col = cg * 2048 + C.tid * 4;
        const float* W = C.ka->in[I_ADAW] + (size_t)l * D * MODW;
        f32x4 a0 = {0.f, 0.f, 0.f, 0.f}, a1 = {0.f, 0.f, 0.f, 0.f};
#pragma unroll 16
        for (int i = ks * 64; i < ks * 64 + 64; ++i) {
            const float c0 = C.ka->in[I_C][i], c1 = C.ka->in[I_CCTX][i];
            const float s0 = siluf_(c0), s1 = siluf_(c1);
            const f32x4 w = *(const f32x4*)(W + (size_t)i * MODW + col);
            a0 += w * s0; a1 += w * s1;
        }
        *(f32x4*)(modp + ((size_t)(l * KSPLIT + ks) * 2 + 0) * MODW + col) = a0;
        *(f32x4*)(modp + ((size_t)(l * KSPLIT + ks) * 2 + 1) * MODW + col) = a1;
    }
}
__device__ __forceinline__ void phase_ada_reduce(Ctx& C) {
    const float* modp = WSP(float, OFF_MODP); float* mod = WSP(float, OFF_MOD);
    for (int e = C.bid * NT + C.tid; e < DEPTH * 2 * MODW; e += C.G * NT) {
        const int l = e / (2 * MODW), s = (e / MODW) % 2, j = e % MODW;
        float a = C.ka->in[I_ADAB][(size_t)l * MODW + j];
        for (int ks = 0; ks < KSPLIT; ++ks) a += modp[((size_t)(l * KSPLIT + ks) * 2 + s) * MODW + j];
        mod[e] = a;
    }
}
__device__ __forceinline__ const float* mod_ptr(Ctx& C, int l, int s, int idx) { return WSP(float, OFF_MOD) + ((size_t)(l * 2 + s) * NMOD + idx) * D; }

__device__ __forceinline__ void phase_norm(Ctx& C, int l, const float* gw  , int shift_idx, int nparts, int rows, int src) {
    const int gwv = C.bid * NWAVES + C.wave, NGW = C.G * NWAVES;
    float* X = WSP(float, OFF_X); bf16_t* H = WSP(bf16_t, OFF_H); const float* PART = WSP(float, OFF_P32);
    for (int r = gwv; r < rows; r += NGW) {
        const int s = r >= SEQ ? 1 : 0;
        const float* sh = mod_ptr(C, l, s, shift_idx); const float* sc = mod_ptr(C, l, s, shift_idx + 1);
        f32x4* xr = (f32x4*)(X + (size_t)r * D) + C.lane;
        const f32x4* xin = (src == 0 || (src == 2 && s == 0)) ? (const f32x4*)xr : (s == 0 ? (const f32x4*)(C.ka->in[I_X] + (size_t)r * D) + C.lane : (const f32x4*)(C.ka->in[I_CTX] + (size_t)(r - SEQ) * D) + C.lane);
        f32x4 v[8]; float ss = 0.f;
#pragma unroll
        for (int j = 0; j < 8; ++j) v[j] = xin[64 * j];
        if (s == 1 && nparts > 0) {
            for (int ks = 0; ks < nparts; ++ks) {
                const f32x4* pr = (const f32x4*)(PART + ((size_t)ks * 256 + (r - SEQ)) * D) + C.lane;
#pragma unroll
                for (int j = 0; j < 8; ++j) v[j] += pr[64 * j];
            }
#pragma unroll
            for (int j = 0; j < 8; ++j) xr[64 * j] = v[j];
        }
#pragma unroll
        for (int j = 0; j < 8; ++j) ss += (v[j].x * v[j].x + v[j].y * v[j].y) + (v[j].z * v[j].z + v[j].w * v[j].w);
        const float rstd = rsqrtf(wave_sum(ss) * (1.0f / D) + EPS);
        u32x2* o8 = (u32x2*)(H + (size_t)r * D) + C.lane;
#pragma unroll
        for (int j = 0; j < 8; ++j) {
            const int c = (64 * j + C.lane) * 4;
            const f32x4 g4 = *(const f32x4*)(gw + c), s4 = *(const f32x4*)(sc + c), h4 = *(const f32x4*)(sh + c);
            const f32x4 y = (v[j] * rstd) * g4 * (s4 + 1.0f) + h4;
            u32x2 w; w.x = pk2(y.x, y.y); w.y = pk2(y.z, y.w); o8[64 * j] = w;
        }
    }
}

__device__ __forceinline__ float xrow_sum(float x) {
    auto s = __builtin_amdgcn_permlane16_swap(__float_as_uint(x), __float_as_uint(x), false, false);
    x = __uint_as_float(s[0]) + __uint_as_float(s[1]);
    auto t = __builtin_amdgcn_permlane32_swap(__float_as_uint(x), __float_as_uint(x), false, false);
    return __uint_as_float(t[0]) + __uint_as_float(t[1]);
}
template <int CTRL> __device__ __forceinline__ float dppf(float x) { return __builtin_bit_cast(float, __builtin_amdgcn_mov_dpp(__builtin_bit_cast(int, x), CTRL, 0xf, 0xf, true)); }
__device__ __forceinline__ float row16_sum(float x) { x += dppf<0xB1>(x); x += dppf<0x4E>(x); x += dppf<0x124>(x); x += dppf<0x128>(x); return x; }
__device__ __forceinline__ float wave_sum_fast(float x) { return xrow_sum(row16_sum(x)); }
#define WAVE_LDS_FENCE() asm volatile("s_waitcnt lgkmcnt(0)" ::: "memory")
__device__ __forceinline__ void phase_rw_prep(Ctx& C, int l, int b0, int nb) {
    constexpr int TB = 16;
    const float* P = WSP(float, OFF_P32); float* VV = WSP(float, OFF_VV); float* GS = WSP(float, OFF_GS); float* RO = WSP(float, OFF_RO); float* BON = WSP(float, OFF_BON);
    LAS float* lin = (LAS float*)C.lds;
    LAS unsigned char* wl = C.lds + 16384 + C.wave * 14592;
    LAS unsigned char* RA = wl; LAS float* MAT = (LAS float*)(wl + 10496);
    const float* taps = C.ka->in[I_RWSHIFT] + (size_t)l * 3 * RWC;
    const int c = C.tid, h = c >> 6, e = c & 63, lane = C.lane;
    const float kkw = C.ka->in[I_RWKK][l * 512 + c], kaw = C.ka->in[I_RWKA][l * 512 + c], rkw = C.ka->in[I_RWRK][l * 512 + c];
    for (int unit = b0; unit < 2 * RW_NCK; unit += nb) {
        const int d = unit & 1, sq_ = RW_NCK - 1 - (unit >> 1), grp = d == 0 ? (sq_ + RW_NCK - 16) % RW_NCK : RW_NCK - 1 - sq_;
        const int r0 = grp * TB;
        const bool hp0 = (r0 != 0 && r0 != SEQ), hnl = (r0 + TB != SEQ && r0 + TB != MT);
        __syncthreads();
        { int c_ = C.tid; asm volatile("" : "+v"(c_)); const int c = c_;
        if (c < 128) {
            const int col = 2048 + (c < 64 ? d * 64 + c : 128 + d * 64 + (c - 64));
            const float t0 = taps[col], t1 = taps[RWC + col], t2 = taps[2 * RWC + col];
            const float* pc = P + (size_t)r0 * P32W + RW_OFF + col;
            float prev = hp0 ? pc[-(long)P32W] : 0.f, cur = pc[0];
#pragma unroll
            for (int t = 0; t < TB; ++t) {
                const float nxt = (t + 1 < TB || hnl) ? pc[(size_t)(t + 1) * P32W] : 0.f;
                const float v = t0 * prev + t1 * cur + t2 * nxt;
                *(LAS bf16_t*)((LAS unsigned char*)lin + ((c >> 6) * 16 + t) * 144 + 2 * (c & 63)) = (bf16_t)f2bf(c < 64 ? 1.0f - 2.0f * __builtin_amdgcn_rcpf(1.0f + __expf(2.0f * v)) : v);
                prev = cur; cur = nxt;
            }
        }
        if (d == 0) {
            const int col = 3 * 512 + c;
            const float t0 = taps[col], t1 = taps[RWC + col], t2 = taps[2 * RWC + col];
            const float* pc = P + (size_t)r0 * P32W + RW_OFF + col;
            float prev = hp0 ? pc[-(long)P32W] : 0.f, cur = pc[0];
#pragma unroll
            for (int t = 0; t < TB; ++t) {
                const float nxt = (t + 1 < TB || hnl) ? pc[(size_t)(t + 1) * P32W] : 0.f;
                const float v = t0 * prev + t1 * cur + t2 * nxt;
                GS[(size_t)(r0 + t) * 512 + c] = __builtin_amdgcn_rcpf(1.0f + __expf(-v));
                prev = cur; cur = nxt;
            }
        }
        }
        __syncthreads();
        {
            int ln_ = C.lane; asm volatile("" : "+v"(ln_));
            const int lane = ln_, e = ln_, c = h * 64 + ln_;
            float xr[TB], xk[TB], xv[TB], kkn[TB];
#pragma unroll
            for (int q = 0; q < 3; ++q) {
                const int col = q * 512 + c;
                const float t0 = taps[col], t1 = taps[RWC + col], t2 = taps[2 * RWC + col];
                const float* pc = P + (size_t)r0 * P32W + RW_OFF + col;
                float prev = hp0 ? pc[-(long)P32W] : 0.f, cur = pc[0];
#pragma unroll
                for (int t = 0; t < TB; ++t) {
                    const float nxt = (t + 1 < TB || hnl) ? pc[(size_t)(t + 1) * P32W] : 0.f;
                    const float v = t0 * prev + t1 * cur + t2 * nxt;
                    if (q == 0) xr[t] = v; else if (q == 1) xk[t] = v; else { xv[t] = v; if (d == 0) VV[(size_t)(r0 + t) * 512 + c] = v; }
                    prev = cur; cur = nxt;
                }
            }
#pragma unroll
            for (int t = 0; t < TB; ++t) { const float kk0 = xk[t] * kkw; kkn[t] = kk0 * rsqrtf(wave_sum_fast(kk0 * kk0) + EPS); }
            __builtin_amdgcn_sched_barrier(0);
            float At[TB], Rt[TB], Vs[TB];
            unsigned Btp[TB / 2], Ktp[TB / 2];
            float gam;
            {
                float z[TB], az[TB];
                {
                    const bf16_t* W2T = WSP(bf16_t, OFF_W2T);
                    LAS float* ZB = (LAS float*)RA;
                    const int tl = lane & 15, q4 = lane >> 4;
#pragma unroll
                    for (int m = 0; m < 2; ++m) {
                        bf16x8 af[2];
#pragma unroll
                        for (int s2 = 0; s2 < 2; ++s2) af[s2] = *(const LAS bf16x8*)((LAS unsigned char*)lin + (m * 16 + tl) * 144 + s2 * 64 + q4 * 16);
#pragma unroll
                        for (int nt4 = 0; nt4 < 4; ++nt4) {
                            const bf16_t* bp = W2T + ((size_t)((d * 2 + m) * 512 + h * 64 + 16 * nt4 + tl) * 64 + 8 * q4);
                            f32x4 a4 = {0.f, 0.f, 0.f, 0.f};
#pragma unroll
                            for (int s2 = 0; s2 < 2; ++s2) a4 = MFMA16(af[s2], *(const bf16x8*)(bp + 32 * s2), a4);
#pragma unroll
                            for (int reg = 0; reg < 4; ++reg) ZB[(m * 16 + 4 * q4 + reg) * 64 + 16 * nt4 + tl] = a4[reg];
                        }
                    }
                    WAVE_LDS_FENCE();
                    const float zb = C.ka->in[I_RWW0][(l * 2 + d) * 512 + c], ab = C.ka->in[I_RWA0][(l * 2 + d) * 512 + c];
#pragma unroll
                    for (int t = 0; t < TB; ++t) { z[t] = zb + ZB[t * 64 + e]; az[t] = ab + ZB[(16 + t) * 64 + e]; }
                    WAVE_LDS_FENCE();
                }
                float g = 1.0f, btp = 0.f, ktp = 0.f;
#pragma unroll
                for (int i = 0; i < TB; ++i) {
                    const int t = d ? TB - 1 - i : i;
                    const float y = -z[t]; const float sp = fmaxf(y, 0.f) + __logf(1.0f + __expf(-fabsf(y)));
                    const float decay = __expf(-__expf(-sp - 0.5f));
                    const float a = __builtin_amdgcn_rcpf(1.0f + __expf(-az[t]));
                    const float kd = xk[t] * (1.0f + (a - 1.0f) * kaw);
                    { const float bsum = wave_sum_fast(xr[t] * kd * rkw);
                      if (lane == 0) BON[((size_t)d * MT + r0 + t) * 8 + h] = bsum; }
                    const float gm1 = g; g *= decay; const float ig = __builtin_amdgcn_rcpf(g);
                    const float at = -kkn[t] * gm1, bt = a * kkn[t] * ig, kt = kd * ig, rt = xr[t] * g;
                    At[i] = at; Rt[i] = rt; Vs[i] = xv[t];
                    *(LAS bf16_t*)(RA + 0 * 2304 + i * 144 + 2 * e) = (bf16_t)pg8::cvt_pk_bf16(at, at); *(LAS bf16_t*)(RA + 1 * 2304 + i * 144 + 2 * e) = (bf16_t)pg8::cvt_pk_bf16(bt, bt);
                    *(LAS bf16_t*)(RA + 2 * 2304 + i * 144 + 2 * e) = (bf16_t)pg8::cvt_pk_bf16(kt, kt); *(LAS bf16_t*)(RA + 3 * 2304 + i * 144 + 2 * e) = (bf16_t)pg8::cvt_pk_bf16(rt, rt);
                    if (i & 1) { Btp[i >> 1] = pg8::cvt_pk_bf16(btp, bt); Ktp[i >> 1] = pg8::cvt_pk_bf16(ktp, kt); } else { btp = bt; ktp = kt; }
                }
                gam = g;
            }
            __builtin_amdgcn_sched_barrier(0);
            WAVE_LDS_FENCE();
            {
                const int jl = lane & 15, q = lane >> 4;
                bf16x8 fa[2], fb[2], fk[2], fr[2];
#pragma unroll
                for (int s2 = 0; s2 < 2; ++s2) {
                    fa[s2] = *(const LAS bf16x8*)(RA + 0 * 2304 + jl * 144 + s2 * 64 + q * 16); fb[s2] = *(const LAS bf16x8*)(RA + 1 * 2304 + jl * 144 + s2 * 64 + q * 16);
                    fk[s2] = *(const LAS bf16x8*)(RA + 2 * 2304 + jl * 144 + s2 * 64 + q * 16); fr[s2] = *(const LAS bf16x8*)(RA + 3 * 2304 + jl * 144 + s2 * 64 + q * 16);
                }
                f32x4 gAL = {0.f, 0.f, 0.f, 0.f}, gBL = gAL, gP = gAL, gQ = gAL;
#pragma unroll
                for (int s2 = 0; s2 < 2; ++s2) { gAL = MFMA16(fa[s2], fb[s2], gAL); gBL = MFMA16(fa[s2], fk[s2], gBL); gP = MFMA16(fr[s2], fb[s2], gP); gQ = MFMA16(fr[s2], fk[s2], gQ); }
#pragma unroll
                for (int reg = 0; reg < 4; ++reg) { const int i = 4 * q + reg;
                    MAT[0 * 256 + i * 16 + jl] = jl < i ? gAL[reg] : 0.f; MAT[1 * 256 + i * 16 + jl] = jl < i ? gBL[reg] : 0.f;
                    MAT[2 * 256 + i * 16 + jl] = jl <= i ? gP[reg] : 0.f; MAT[3 * 256 + i * 16 + jl] = jl <= i ? gQ[reg] : 0.f; }
            }
            WAVE_LDS_FENCE();
            __builtin_amdgcn_sched_barrier(0);
            {
                u32x4 w0, w1;
                w0.x = Btp[0]; w0.y = Btp[1]; w0.z = Btp[2]; w0.w = Btp[3]; w1.x = Btp[4]; w1.y = Btp[5]; w1.z = Btp[6]; w1.w = Btp[7];
                *(LAS u32x4*)(RA + 0 * 2048 + e * 32) = w0; *(LAS u32x4*)(RA + 0 * 2048 + e * 32 + 16) = w1;
                w0.x = Ktp[0]; w0.y = Ktp[1]; w0.z = Ktp[2]; w0.w = Ktp[3]; w1.x = Ktp[4]; w1.y = Ktp[5]; w1.z = Ktp[6]; w1.w = Ktp[7];
                *(LAS u32x4*)(RA + 1 * 2048 + e * 32) = w0; *(LAS u32x4*)(RA + 1 * 2048 + e * 32 + 16) = w1;
#pragma unroll
                for (int i2 = 0; i2 < 4; ++i2) { w0[i2] = pg8::cvt_pk_bf16(Vs[2 * i2], Vs[2 * i2 + 1]); w1[i2] = pg8::cvt_pk_bf16(Vs[8 + 2 * i2], Vs[8 + 2 * i2 + 1]); }
                *(LAS u32x4*)(RA + 2 * 2048 + e * 32) = w0; *(LAS u32x4*)(RA + 2 * 2048 + e * 32 + 16) = w1;
                *(LAS float*)(RA + 10240 + 4 * e) = gam;
            }
            __builtin_amdgcn_sched_barrier(0);
            float Gv[TB];
            {
                float X1[TB];
#pragma unroll
                for (int i = 0; i < TB; ++i) {
                    __builtin_amdgcn_sched_barrier(0);
                    float al[16];
#pragma unroll
                    for (int g4 = 0; g4 < 4; ++g4) { const f32x4 u = *(const LAS f32x4*)(MAT + 0 * 256 + i * 16 + 4 * g4); al[4 * g4] = u.x; al[4 * g4 + 1] = u.y; al[4 * g4 + 2] = u.z; al[4 * g4 + 3] = u.w; }
                    float x1 = At[i];
#pragma unroll
                    for (int m = 0; m < TB; ++m) if (m < i) x1 = __builtin_fmaf(al[m], X1[m], x1);
                    X1[i] = x1;
                }
#pragma unroll
                for (int i = 0; i < TB; ++i) {
                    __builtin_amdgcn_sched_barrier(0);
                    float pm[16];
#pragma unroll
                    for (int g4 = 0; g4 < 4; ++g4) { const f32x4 u = *(const LAS f32x4*)(MAT + 2 * 256 + i * 16 + 4 * g4); pm[4 * g4] = u.x; pm[4 * g4 + 1] = u.y; pm[4 * g4 + 2] = u.z; pm[4 * g4 + 3] = u.w; }
                    float gv = Rt[i];
#pragma unroll
                    for (int m = 0; m < TB; ++m) if (m <= i) gv = __builtin_fmaf(pm[m], X1[m], gv);
                    Gv[i] = gv;
                }
                u32x4 w0, w1;
#pragma unroll
                for (int i2 = 0; i2 < 4; ++i2) { w0[i2] = pg8::cvt_pk_bf16(X1[2 * i2], X1[2 * i2 + 1]); w1[i2] = pg8::cvt_pk_bf16(X1[8 + 2 * i2], X1[8 + 2 * i2 + 1]); }
                *(LAS u32x4*)(RA + 3 * 2048 + e * 32) = w0; *(LAS u32x4*)(RA + 3 * 2048 + e * 32 + 16) = w1;
            }
            __builtin_amdgcn_sched_barrier(0);
            {
                float X2[TB];
#pragma unroll
                for (int i = 0; i < TB; ++i) {
                    __builtin_amdgcn_sched_barrier(0);
                    float al[16], bl[16];
#pragma unroll
                    for (int g4 = 0; g4 < 4; ++g4) { const f32x4 u = *(const LAS f32x4*)(MAT + 0 * 256 + i * 16 + 4 * g4), v = *(const LAS f32x4*)(MAT + 1 * 256 + i * 16 + 4 * g4);
                        al[4 * g4] = u.x; al[4 * g4 + 1] = u.y; al[4 * g4 + 2] = u.z; al[4 * g4 + 3] = u.w; bl[4 * g4] = v.x; bl[4 * g4 + 1] = v.y; bl[4 * g4 + 2] = v.z; bl[4 * g4 + 3] = v.w; }
                    float x2 = 0.f;
#pragma unroll
                    for (int m = 0; m < TB; ++m) if (m < i) { x2 = __builtin_fmaf(bl[m], Vs[m], x2); x2 = __builtin_fmaf(al[m], X2[m], x2); }
                    X2[i] = x2;
                }
#pragma unroll
                for (int i = 0; i < TB; ++i) {
                    __builtin_amdgcn_sched_barrier(0);
                    float pm[16], qm[16];
#pragma unroll
                    for (int g4 = 0; g4 < 4; ++g4) { const f32x4 u = *(const LAS f32x4*)(MAT + 2 * 256 + i * 16 + 4 * g4), v = *(const LAS f32x4*)(MAT + 3 * 256 + i * 16 + 4 * g4);
                        pm[4 * g4] = u.x; pm[4 * g4 + 1] = u.y; pm[4 * g4 + 2] = u.z; pm[4 * g4 + 3] = u.w; qm[4 * g4] = v.x; qm[4 * g4 + 1] = v.y; qm[4 * g4 + 2] = v.z; qm[4 * g4 + 3] = v.w; }
                    float o0 = 0.f;
#pragma unroll
                    for (int m = 0; m < TB; ++m) if (m <= i) { o0 = __builtin_fmaf(pm[m], X2[m], o0); o0 = __builtin_fmaf(qm[m], Vs[m], o0); }
                    RO[((size_t)d * MT + r0 + (d ? TB - 1 - i : i)) * 512 + c] = o0;
                }
                u32x4 w0, w1;
#pragma unroll
                for (int i2 = 0; i2 < 4; ++i2) { w0[i2] = pg8::cvt_pk_bf16(X2[2 * i2], X2[2 * i2 + 1]); w1[i2] = pg8::cvt_pk_bf16(X2[8 + 2 * i2], X2[8 + 2 * i2 + 1]); }
                *(LAS u32x4*)(RA + 4 * 2048 + e * 32) = w0; *(LAS u32x4*)(RA + 4 * 2048 + e * 32 + 16) = w1;
            }
            WAVE_LDS_FENCE();
            __builtin_amdgcn_sched_barrier(0);
            {
                LAS bf16_t* GI = (LAS bf16_t*)MAT;
                const int sg = e >> 5, jp = 4 * ((e >> 4) & 1) + (e & 3), qg = (e & 15) >> 2;
#pragma unroll
                for (int i = 0; i < TB; ++i) GI[(sg * 64 + qg * 16 + i) * 8 + jp] = (bf16_t)f2bf(Gv[i]);
            }
            __builtin_amdgcn_sched_barrier(0);
            const int seqc = d == 0 ? (grp + 16) % RW_NCK : RW_NCK - 1 - grp;
            const size_t rec = (size_t)(d * 8 + h) * RW_NCK + seqc;
            {
                const int r = lane & 31, hh = lane >> 5;
                bf16x8 fBT[2], fKT[2], fVT[2], fW1[2], fU0[2];
#pragma unroll
                for (int blk = 0; blk < 2; ++blk) {
                    fBT[blk] = *(const LAS bf16x8*)(RA + 0 * 2048 + (32 * blk + r) * 32 + hh * 16); fKT[blk] = *(const LAS bf16x8*)(RA + 1 * 2048 + (32 * blk + r) * 32 + hh * 16);
                    fVT[blk] = *(const LAS bf16x8*)(RA + 2 * 2048 + (32 * blk + r) * 32 + hh * 16); fW1[blk] = *(const LAS bf16x8*)(RA + 3 * 2048 + (32 * blk + r) * 32 + hh * 16);
                    fU0[blk] = *(const LAS bf16x8*)(RA + 4 * 2048 + (32 * blk + r) * 32 + hh * 16);
                }
                float gk[2][16];
#pragma unroll
                for (int mb = 0; mb < 2; ++mb)
#pragma unroll
                    for (int reg = 0; reg < 16; ++reg) gk[mb][reg] = *(const LAS float*)(RA + 10240 + 4 * (32 * mb + KOFF(reg) + 4 * hh));
                WAVE_LDS_FENCE();
                float* Hrec = (float*)(C.ws + OFF_RWH + rec * RWH_REC);
                LAS bf16_t* MI = (LAS bf16_t*)RA;
#pragma unroll
                for (int mb = 0; mb < 2; ++mb)
#pragma unroll
                    for (int nbk = 0; nbk < 2; ++nbk) {
                        f32x16 aM, aH;
#pragma unroll
                        for (int i = 0; i < 16; ++i) { aM[i] = 0.f; aH[i] = 0.f; }
                        aM = MFMA32(fBT[mb], fW1[nbk], aM);
                        aH = MFMA32(fBT[mb], fU0[nbk], aH); aH = MFMA32(fKT[mb], fVT[nbk], aH);
                        const int col = 32 * nbk + r;
#pragma unroll
                        for (int g4 = 0; g4 < 4; ++g4) {
                            const int kb = 2 * mb + (g4 >> 1), q2 = 2 * (g4 & 1) + hh;
                            f32x4 hv; hv.x = gk[mb][4 * g4] * aH[4 * g4]; hv.y = gk[mb][4 * g4 + 1] * aH[4 * g4 + 1]; hv.z = gk[mb][4 * g4 + 2] * aH[4 * g4 + 2]; hv.w = gk[mb][4 * g4 + 3] * aH[4 * g4 + 3];
                            *(f32x4*)(Hrec + (((col >> 4) * 4 + kb) * 64 + q2 * 16 + (col & 15)) * 4) = hv;
                        }
                        const int sm = col >> 5, jpm = 4 * ((col >> 4) & 1) + (col & 3), qm2 = (col & 15) >> 2;
#pragma unroll
                        for (int reg = 0; reg < 16; ++reg) {
                            const int kp = 32 * mb + KOFF(reg) + 4 * hh;
                            const float mv = gk[mb][reg] * ((kp == col ? 1.0f : 0.0f) + aM[reg]);
                            MI[(((kp >> 4) * 2 + sm) * 64 + qm2 * 16 + (kp & 15)) * 8 + jpm] = (bf16_t)f2bf(mv);
                        }
                    }
                WAVE_LDS_FENCE();
                unsigned char* MGrec = C.ws + OFF_RWMG + rec * RWMG_REC;
#pragma unroll
                for (int it = 0; it < 8; ++it) *(u32x4*)(MGrec + (size_t)(it * 64 + lane) * 16) = *(const LAS u32x4*)(RA + (it * 64 + lane) * 16);
#pragma unroll
                for (int it = 0; it < 2; ++it) *(u32x4*)(MGrec + 8192 + (size_t)(it * 64 + lane) * 16) = *(const LAS u32x4*)((LAS unsigned char*)MAT + (it * 64 + lane) * 16);
                WAVE_LDS_FENCE();
            }
        }
    }
}

struct PrepW { float nw[4][4]; float inv[4]; };
__device__ __forceinline__ void attn_prep_unit(Ctx& C, const PrepW& W, bf16_t* PA, int u, int lane) {
    const int li = lane & 15, g = lane >> 4;
    const int rp = u / 13, v = u - rp * 13;
    int r, col, kind;
    if (v < 12) { const int k6 = v % 6; r = 2 * rp + v / 6; kind = k6 >> 1; col = (kind == 0 ? 0 : kind == 1 ? 512 : 1536) + 256 * (k6 & 1) + 64 * g; }
    else { r = 2 * rp + (g >> 1); kind = 3; col = 2048 + 64 * (g & 1); }
    bf16_t* p = PA + (size_t)r * PAW + col + 4 * li;
    const uint2 raw = *(const uint2*)p;
    float x[4] = {bf2f(raw.x & 0xffffu), bf2f(raw.x >> 16), bf2f(raw.y & 0xffffu), bf2f(raw.y >> 16)};
    const float ss = row16_sum(x[0] * x[0] + x[1] * x[1] + x[2] * x[2] + x[3] * x[3]);
    const float rs = rsqrtf(ss * (1.0f / 64.0f) + EPS) * ((kind & 1) ? 1.0f : 0.125f);
    float y[4];
#pragma unroll
    for (int j = 0; j < 4; ++j) y[j] = x[j] * rs * (kind == 0 ? W.nw[0][j] : kind == 1 ? W.nw[1][j] : kind == 2 ? W.nw[2][j] : W.nw[3][j]);
    if (kind >= 2 && r < SEQ) {
        const int pos = (li >> 3) ? (r & 63) : (r >> 6);
        const bool lo = (li & 7) < 4;
        const int src = lane + (lo ? 4 : -4);
#pragma unroll
        for (int j = 0; j < 4; ++j) {
            const float ang = (float)pos * W.inv[j];
            const float sn = __sinf(ang), cs = __cosf(ang);
            const float yp = __shfl(y[j], src);
            y[j] = lo ? (y[j] * cs - yp * sn) : (yp * sn + y[j] * cs);
        }
    }
    uint2 o; o.x = pk2(y[0], y[1]); o.y = pk2(y[2], y[3]);
    if (!(kind & 1)) *(uint2*)p = o;
    else {
        const int hd = (col - (kind == 1 ? 512 : 2048)) >> 6;
        bf16_t* kt = (kind == 1 ? WSP(bf16_t, OFF_KTN) : WSP(bf16_t, OFF_KTW)) + (size_t)(hd * (MT / 32) + (r >> 5)) * 2048;
        *(uint2*)(kt + ((((li >> 2) * 64 + ((li >> 1) & 1) * 32 + (r & 31)) << 3) + 4 * (li & 1))) = o;
    }
}
__device__ __forceinline__ void phase_attn_prep(Ctx& C, int l, int w0, int nw) {
    bf16_t* PA = WSP(bf16_t, OFF_PA);
    const int lane = C.lane, li = lane & 15;
    PrepW W;
#pragma unroll
    for (int j = 0; j < 4; ++j) {
        W.nw[0][j] = C.ka->in[I_NAQN][l * 64 + 4 * li + j]; W.nw[1][j] = C.ka->in[I_NAKN][l * 64 + 4 * li + j];
        W.nw[2][j] = C.ka->in[I_WAQN][l * 64 + 4 * li + j]; W.nw[3][j] = C.ka->in[I_WAKN][l * 64 + 4 * li + j];
        W.inv[j] = powf(10000.0f, -(float)(4 * (li & 3) + j) / 16.0f);
    }
    for (int u = w0; u < (MT / 2) * 13; u += nw) attn_prep_unit(C, W, PA, u, lane);
}

__device__ __forceinline__ float hg_lb(Ctx& C, int l, int d, int c) {
    if (l == 0) return 0.f;
    const float a0 = C.ka->in[I_HGLB][(size_t)(d * DEPTH + 0) * 512 + c], a1 = C.ka->in[I_HGLB][(size_t)(d * DEPTH + 1) * 512 + c];
    const float m = fmaxf(a0, a1); const float e0 = expf(a0 - m), e1 = expf(a1 - m);
    return e1 / (e0 + e1);
}
struct HgThread { float lc[16], kd[16]; float tot[4]; };
__device__ __forceinline__ void hg_gates(Ctx& C, int l, int d, int h, int tc, int k, int J, LAS float* TOT, HgThread& T) {
    const float* P = WSP(float, OFF_P32);
    const float lb = hg_lb(C, l, d, h * 128 + k);
    float gg[16];
#pragma unroll
    for (int i = 0; i < 16; ++i) {
        const float fr = P[(size_t)(64 * tc + 16 * J + i) * P32W + 512 + d * 512 + h * 128 + k];
        const float f = lb + (1.0f - lb) * sigmoidf_(fr);
        gg[i] = __logf(f); T.kd[i] = 1.0f - f;
    }
    if (d == 0) { float a = 0.f;
#pragma unroll
        for (int i = 0; i < 16; ++i) { a += gg[i]; T.lc[i] = a; }
        TOT[J * 128 + k] = a;
    } else { float a = 0.f;
#pragma unroll
        for (int i = 15; i >= 0; --i) { a += gg[i]; T.lc[i] = a; }
        TOT[J * 128 + k] = a;
    }
    __syncthreads();
#pragma unroll
    for (int m = 0; m < 4; ++m) T.tot[m] = TOT[m * 128 + k];
}
__device__ __forceinline__ void hg_it(Ctx& C, int h, int tc, int v, int J, LAS unsigned char* IT) {
    const float* P = WSP(float, OFF_P32);
    float x[16];
#pragma unroll
    for (int i = 0; i < 16; ++i) x[i] = P[(size_t)(64 * tc + 16 * J + i) * P32W + 1536 + h * 128 + v];
    u32x4 w0, w1;
    w0.x = pk2(x[0], x[1]); w0.y = pk2(x[2], x[3]); w0.z = pk2(x[4], x[5]); w0.w = pk2(x[6], x[7]);
    w1.x = pk2(x[8], x[9]); w1.y = pk2(x[10], x[11]); w1.z = pk2(x[12], x[13]); w1.w = pk2(x[14], x[15]);
    *(LAS u32x4*)(IT + v * 144 + J * 32) = w0; *(LAS u32x4*)(IT + v * 144 + J * 32 + 16) = w1;
}
__device__ __forceinline__ void phase_hg_A(Ctx& C, int l, int b0, int nb) {
    float* HGL = WSP(float, OFF_HGL); float* HGD = WSP(float, OFF_HGD);
    LAS unsigned char* KT = C.lds;
    LAS unsigned char* IT = C.lds + 18432;
    LAS float* TOT = (LAS float*)(C.lds + 36864);
    const int k = C.tid & 127, J = C.tid >> 7;
    unsigned* ctr = WSP(unsigned, OFF_CTL) + 71680 + l;
    LAS int* su = (LAS int*)(C.lds + 40960);
    int nxt = 0;
    if (C.tid == 0) nxt = (int)atomicAdd(ctr, 1u);
    for (;;) {
        __syncthreads();
        if (C.tid == 0) *su = nxt;
        __syncthreads();
        const int u = *su;
        if (u >= 2 * 4 * NCH) break;
        if (C.tid == 0) nxt = (int)atomicAdd(ctr, 1u);
        const int d = u / (4 * NCH), h = (u / NCH) % 4, c = u % NCH;
        const int tc = d == 0 ? (c + NCH - 4) % NCH : NCH - 1 - c;
        HgThread T; hg_gates(C, l, d, h, tc, k, J, TOT, T);
        float rest = 0.f;
#pragma unroll
        for (int m = 0; m < 4; ++m) if (d == 0 ? (m >= J) : (m <= J)) rest += T.tot[m];
        float kh[16];
#pragma unroll
        for (int i = 0; i < 16; ++i) kh[i] = T.kd[i] * __expf(rest - T.lc[i]);
        { u32x4 w0, w1;
          w0.x = pk2(kh[0], kh[1]); w0.y = pk2(kh[2], kh[3]); w0.z = pk2(kh[4], kh[5]); w0.w = pk2(kh[6], kh[7]);
          w1.x = pk2(kh[8], kh[9]); w1.y = pk2(kh[10], kh[11]); w1.z = pk2(kh[12], kh[13]); w1.w = pk2(kh[14], kh[15]);
          *(LAS u32x4*)(KT + k * 144 + J * 32) = w0; *(LAS u32x4*)(KT + k * 144 + J * 32 + 16) = w1; }
        hg_it(C, h, tc, k, J, IT);
        if (J == 0) HGD[(size_t)((d * 4 + h) * NCH + c) * 128 + k] = __expf((T.tot[0] + T.tot[1]) + (T.tot[2] + T.tot[3]));
        __syncthreads();
        const int r = C.lane & 31, hh = C.lane >> 5, vb = C.wave >> 1;
        float* outp = HGL + (size_t)((d * 4 + h) * NCH + c) * 16384;
#pragma unroll
        for (int t2 = 0; t2 < 2; ++t2) {
            const int kb = 2 * (C.wave & 1) + t2;
            f32x16 acc;
#pragma unroll
            for (int i = 0; i < 16; ++i) acc[i] = 0.f;
#pragma unroll
            for (int st = 0; st < 4; ++st) {
                const bf16x8 af = *(const LAS bf16x8*)(IT + (32 * vb + r) * 144 + st * 32 + hh * 16);
                const bf16x8 bf = *(const LAS bf16x8*)(KT + (32 * kb + r) * 144 + st * 32 + hh * 16);
                acc = MFMA32(af, bf, acc);
            }
#pragma unroll
            for (int reg = 0; reg < 16; ++reg) outp[(size_t)(32 * vb + KOFF(reg) + 4 * hh) * 128 + 32 * kb + r] = acc[reg];
        }
    }
}
__device__ __forceinline__ void phase_hg_B(Ctx& C, int b0, int nb) {
    const float* HGL = WSP(float, OFF_HGL); const float* HGD = WSP(float, OFF_HGD); bf16_t* SPT = WSP(bf16_t, OFF_SPT);
    for (int e = b0 * NT + C.tid; e < 8 * 8192; e += nb * NT) {
        const int dh = e >> 13, vk = (e & 8191) * 2, k = vk & 127;
        float s0 = 0.f, s1 = 0.f;
        const float* p = HGL + (size_t)dh * NCH * 16384 + vk; const float* dp = HGD + (size_t)dh * NCH * 128 + k; bf16_t* o = SPT + (size_t)dh * NCH * 16384 + vk;
        static_assert(NCH % 12 == 0, "twelve chunks per batch");
#pragma unroll 1
        for (int c0 = 0; c0 < NCH; c0 += 12) {
            float2 Lc[12], Dc[12];
#pragma unroll
            for (int i = 0; i < 12; ++i) { Lc[i] = *(const float2*)(p + (size_t)(c0 + i) * 16384); Dc[i] = *(const float2*)(dp + (c0 + i) * 128); }
#pragma unroll
            for (int i = 0; i < 12; ++i) { *(unsigned*)(o + (size_t)(c0 + i) * 16384) = pk2(s0, s1); s0 = Dc[i].x * s0 + Lc[i].x; s1 = Dc[i].y * s1 + Lc[i].y; }
        }
    }
}
__device__ __forceinline__ void phase_hg_C(Ctx& C, int l, int b0, int nb, int nch  ) {
    const float* P = WSP(float, OFF_P32); const bf16_t* SPT = WSP(bf16_t, OFF_SPT); bf16_t* YB = WSP(bf16_t, OFF_YB);
    LAS unsigned char* KS = C.lds;
    LAS unsigned char* QJ = C.lds + 17408;
    LAS unsigned char* IT = C.lds + 17408 + 69632;
    LAS float* TOT = (LAS float*)(C.lds + 105472);
    LAS float* RED = (LAS float*)(C.lds + 107520);
    const int k = C.tid & 127, J = C.tid >> 7;
    const int tl = C.lane & 15, qd = C.lane >> 4, I = C.wave >> 1, vh = C.wave & 1;
    for (int u = b0; u < 4 * nch; u += nb) {
        const int h = u / nch, tc = u % nch;
        f32x4 oT[4];
#pragma unroll
        for (int i = 0; i < 4; ++i) oT[i] = (f32x4){0.f, 0.f, 0.f, 0.f};
#pragma unroll 1
        for (int d = 0; d < 2; ++d) {
            const int cd = d == 0 ? (tc + 4) % NCH : NCH - 1 - tc;
            __syncthreads();
            {
                HgThread T; hg_gates(C, l, d, h, tc, k, J, TOT, T);
                float qv[16];
#pragma unroll
                for (int i = 0; i < 16; ++i) qv[i] = P[(size_t)(64 * tc + 16 * J + i) * P32W + h * 128 + k];
#pragma unroll
                for (int i = 0; i < 16; ++i) *(LAS bf16_t*)(KS + (16 * J + i) * 272 + 2 * k) = (bf16_t)f2bf(T.kd[i] * __expf(fminf(-T.lc[i], 80.f)));
#pragma unroll
                for (int Jp = 0; Jp < 4; ++Jp) {
                    if (d == 0 ? (Jp > J) : (Jp < J)) continue;
                    float Pj = 0.f;
#pragma unroll
                    for (int m = 0; m < 4; ++m) if (d == 0 ? (m >= Jp && m < J) : (m > J && m <= Jp)) Pj += T.tot[m];
#pragma unroll
                    for (int i = 0; i < 16; ++i) *(LAS bf16_t*)(QJ + (Jp * 64 + 16 * J + i) * 272 + 2 * k) = (bf16_t)f2bf(qv[i] * __expf(T.lc[i] + Pj));
                }
                hg_it(C, h, tc, k, J, IT);
            }
            __syncthreads();
            u32x2 att[4];
#pragma unroll
            for (int Jb = 0; Jb < 4; ++Jb) {
                att[Jb] = (u32x2){0u, 0u};
                if (d == 0 ? (Jb > I) : (Jb < I)) continue;
                f32x4 acc = {0.f, 0.f, 0.f, 0.f};
#pragma unroll
                for (int ks = 0; ks < 4; ++ks) {
                    const bf16x8 af = *(const LAS bf16x8*)(KS + (16 * Jb + tl) * 272 + ks * 64 + qd * 16);
                    const bf16x8 bf = *(const LAS bf16x8*)(QJ + (Jb * 64 + 16 * I + tl) * 272 + ks * 64 + qd * 16);
                    acc = MFMA16(af, bf, acc);
                }
                if (Jb == I) {
#pragma unroll
                    for (int reg = 0; reg < 4; ++reg) { const int sl = 4 * qd + reg; const bool valid = d == 0 ? (sl <= tl) : (sl >= tl); acc[reg] = valid ? acc[reg] : 0.f; }
                }
                att[Jb].x = pk2(acc[0], acc[1]); att[Jb].y = pk2(acc[2], acc[3]);
            }
#pragma unroll
            for (int pr = 0; pr < 2; ++pr) {
                const int Ja = 2 * pr, Jc = 2 * pr + 1;
                const bool anyv = d == 0 ? (Ja <= I) : (Jc >= I);
                if (!anyv) continue;
                u32x4 bw; bw.x = att[Ja].x; bw.y = att[Ja].y; bw.z = att[Jc].x; bw.w = att[Jc].y;
                const bf16x8 bf = __builtin_bit_cast(bf16x8, bw);
#pragma unroll
                for (int vb = 0; vb < 4; ++vb) {
                    const int v = 16 * (4 * vh + vb) + tl;
                    const u32x2 a0 = *(const LAS u32x2*)(IT + v * 144 + Ja * 32 + qd * 8), a1 = *(const LAS u32x2*)(IT + v * 144 + Jc * 32 + qd * 8);
                    u32x4 aw; aw.x = a0.x; aw.y = a0.y; aw.z = a1.x; aw.w = a1.y;
                    oT[vb] = MFMA16(__builtin_bit_cast(bf16x8, aw), bf, oT[vb]);
                }
            }
            const bf16_t* sp = SPT + (size_t)((d * 4 + h) * NCH + cd) * 16384;
            const int Je = d == 0 ? 0 : 3;
#pragma unroll
            for (int ks = 0; ks < 4; ++ks) {
                const bf16x8 bf = *(const LAS bf16x8*)(QJ + (Je * 64 + 16 * I + tl) * 272 + ks * 64 + qd * 16);
#pragma unroll
                for (int vb = 0; vb < 4; ++vb) {
                    const bf16x8 af = *(const bf16x8*)(sp + (size_t)(16 * (4 * vh + vb) + tl) * 128 + ks * 32 + qd * 8);
                    oT[vb] = MFMA16(af, bf, oT[vb]);
                }
            }
        }
        float ss = 0.f;
#pragma unroll
        for (int vb = 0; vb < 4; ++vb) ss += (oT[vb][0] * oT[vb][0] + oT[vb][1] * oT[vb][1]) + (oT[vb][2] * oT[vb][2] + oT[vb][3] * oT[vb][3]);
        ss += __shfl_xor(ss, 16); ss += __shfl_xor(ss, 32);
        __syncthreads();
        if (qd == 0) RED[C.wave * 16 + tl] = ss;
        __syncthreads();
        const float rstd = rsqrtf((RED[(2 * I) * 16 + tl] + RED[(2 * I + 1) * 16 + tl]) * (1.0f / 128.0f) + EPS);
        const int row = 64 * tc + 16 * I + tl;
#pragma unroll
        for (int vb = 0; vb < 4; ++vb) {
            const int v0 = 16 * (4 * vh + vb) + 4 * qd;
            const f32x4 nw = *(const f32x4*)(C.ka->in[I_HGNORM] + l * 512 + h * 128 + v0);
            const f32x4 gv = *(const f32x4*)(P + (size_t)row * P32W + 2048 + h * 128 + v0);
            u32x2 w; w.x = pg8::cvt_pk_bf16(oT[vb][0] * rstd * nw.x * siluf_(gv.x), oT[vb][1] * rstd * nw.y * siluf_(gv.y));
            w.y = pg8::cvt_pk_bf16(oT[vb][2] * rstd * nw.z * siluf_(gv.z), oT[vb][3] * rstd * nw.w * siluf_(gv.w));
            *(u32x2*)(YB + (size_t)row * 512 + h * 128 + v0) = w;
        }
    }
}

constexpr int RW_NJOBS = 64, RW_RING = 9, RW_SLOT = 14336;
__device__ __forceinline__ void phase_rw_scan(Ctx& C, int b0, int nb) {
    float* RO2 = WSP(float, OFF_RO2);
    LAS unsigned char* slot = C.lds;
    const int lane = C.lane, wv = C.wave;
    for (int jb = b0; jb < RW_NJOBS; jb += nb) {
        const int x = jb & 7, y = jb >> 3, dh = x * 2 + (y >> 2), vs = y & 3, d = dh >> 3, h = dh & 7;
        const unsigned char* mg = C.ws + OFF_RWMG + (size_t)dh * RW_NCK * RWMG_REC;
        const unsigned char* hr = C.ws + OFF_RWH + (size_t)dh * RW_NCK * RWH_REC + (size_t)vs * 4096;
        __syncthreads();
#define RW_PIECE(cc, i) __builtin_amdgcn_global_load_lds((const unsigned*)(((i) < 10 ? mg + (size_t)(cc) * RWMG_REC + (size_t)((i) * 64 + lane) * 16 : hr + (size_t)(cc) * RWH_REC + (size_t)(((i) - 10) * 64 + lane) * 16)), \
            (LAS unsigned*)(slot + ((cc) % RW_RING) * RW_SLOT + (i) * 1024), 16, 0, 0)
        if (wv >= 1) {
#pragma unroll 1
            for (int k8 = 0; k8 < 8; ++k8) { RW_PIECE(k8, wv - 1); RW_PIECE(k8, wv + 6); } }
        f32x4 acc[4];
#pragma unroll
        for (int i = 0; i < 4; ++i) acc[i] = (f32x4){0.f, 0.f, 0.f, 0.f};
        const int vl = lane & 15, q = lane >> 4;
        struct Ops { bf16x8 g[2], m[4][2]; f32x4 h[4]; };
#define RW_LDS_LOAD(R, ck) do { const LAS unsigned char* sl_ = slot + ((ck) % RW_RING) * RW_SLOT; \
            _Pragma("unroll") for (int s2 = 0; s2 < 2; ++s2) R.g[s2] = *(const LAS bf16x8*)(sl_ + 8192 + (s2 * 64 + lane) * 16); \
            _Pragma("unroll") for (int kb = 0; kb < 4; ++kb) { R.h[kb] = *(const LAS f32x4*)(sl_ + 10240 + (kb * 64 + lane) * 16); \
                _Pragma("unroll") for (int s2 = 0; s2 < 2; ++s2) R.m[kb][s2] = *(const LAS bf16x8*)(sl_ + ((kb * 2 + s2) * 64 + lane) * 16); } } while (0)
#define RW_LOADER_STEP(ck) do { if ((ck) >= 0) { const int nn = (ck) + 8 < RW_NCK ? (ck) + 8 : RW_NCK - 1; \
                __builtin_amdgcn_global_load_lds((const unsigned*)(mg + (size_t)nn * RWMG_REC + (size_t)((wv - 1) * 64 + lane) * 16), (LAS unsigned*)(slot + (((ck) + 8) % RW_RING) * RW_SLOT + (wv - 1) * 1024), 16, 0, 0); \
                __builtin_amdgcn_global_load_lds((const unsigned*)((wv + 6) < 10 ? mg + (size_t)nn * RWMG_REC + (size_t)((wv + 6) * 64 + lane) * 16 : hr + (size_t)nn * RWH_REC + (size_t)((wv + 6 - 10) * 64 + lane) * 16), (LAS unsigned*)(slot + (((ck) + 8) % RW_RING) * RW_SLOT + (wv + 6) * 1024), 16, 0, 0); } \
            asm volatile("s_waitcnt vmcnt(12)" ::: "memory"); } while (0)
#define RW_BAR() do { asm volatile("s_waitcnt lgkmcnt(0)" ::: "memory"); __builtin_amdgcn_s_barrier(); asm volatile("" ::: "memory"); } while (0)
        if (wv >= 1) {
            RW_LOADER_STEP(-2);
            asm volatile("" ::: "memory"); __builtin_amdgcn_s_barrier(); asm volatile("" ::: "memory");
            RW_LOADER_STEP(-1);
            RW_BAR();
#pragma unroll 1
            for (int cc = 0; cc < RW_NCK; ++cc) {
                int lane = C.lane; asm volatile("" : "+v"(lane));
                RW_LOADER_STEP(cc);
                RW_BAR();
            }
        } else {
            asm volatile("" ::: "memory"); __builtin_amdgcn_s_barrier(); asm volatile("" ::: "memory");
            Ops RA, RB;
            RW_LDS_LOAD(RA, 0);
            RW_BAR();
#define RW_SB() __builtin_amdgcn_sched_barrier(0)
#define RW_LG(s2_) *(const LAS bf16x8*)(sln_ + 8192 + ((s2_) * 64 + lane) * 16)
#define RW_LH(kb_) *(const LAS f32x4*)(sln_ + 10240 + ((kb_) * 64 + lane) * 16)
#define RW_LM(kb_, s2_) *(const LAS bf16x8*)(sln_ + (((kb_) * 2 + (s2_)) * 64 + lane) * 16)
#define RW_COMPUTE(R, RN, cc_) do { \
                bf16x8 bfr[2]; \
                asm volatile("s_nop 7\n\ts_nop 7" ::: "memory"); \
                _Pragma("unroll") for (int s2 = 0; s2 < 2; ++s2) { u32x4 w; w.x = pg8::cvt_pk_bf16(acc[2 * s2][0], acc[2 * s2][1]); w.y = pg8::cvt_pk_bf16(acc[2 * s2][2], acc[2 * s2][3]); w.z = pg8::cvt_pk_bf16(acc[2 * s2 + 1][0], acc[2 * s2 + 1][1]); w.w = pg8::cvt_pk_bf16(acc[2 * s2 + 1][2], acc[2 * s2 + 1][3]); \
                    bfr[s2] = __builtin_bit_cast(bf16x8, w); } \
                const int rc = d == 0 ? ((cc_) + RW_NCK - 16) % RW_NCK : RW_NCK - 1 - (cc_); \
                float* rop = rop0 + (size_t)rc * (16 * 512); \
                const LAS unsigned char* sln_ = slot + (((cc_) + 1 < RW_NCK ? (cc_) + 1 : RW_NCK - 1) % RW_RING) * RW_SLOT; \
                f32x4 oacc = {0.f, 0.f, 0.f, 0.f}; \
                RW_SB(); \
                oacc = MFMA16(R.g[0], bfr[0], oacc);           RN.g[0] = RW_LG(0);    RN.g[1] = RW_LG(1);    RW_SB(); \
                oacc = MFMA16(R.g[1], bfr[1], oacc);           RN.m[0][0] = RW_LM(0, 0); RN.m[0][1] = RW_LM(0, 1); RW_SB(); \
                acc[0] = MFMA16(R.m[0][0], bfr[0], R.h[0]);    RN.h[0] = RW_LH(0);    RN.m[1][0] = RW_LM(1, 0); RW_SB(); \
                acc[1] = MFMA16(R.m[1][0], bfr[0], R.h[1]);    RN.m[1][1] = RW_LM(1, 1); RN.h[1] = RW_LH(1);    RW_SB(); \
                acc[2] = MFMA16(R.m[2][0], bfr[0], R.h[2]);    RN.m[2][0] = RW_LM(2, 0); RN.m[2][1] = RW_LM(2, 1); RW_SB(); \
                acc[3] = MFMA16(R.m[3][0], bfr[0], R.h[3]);    RN.h[2] = RW_LH(2);    RN.m[3][0] = RW_LM(3, 0); RW_SB(); \
                acc[0] = MFMA16(R.m[0][1], bfr[1], acc[0]);    RN.m[3][1] = RW_LM(3, 1); RN.h[3] = RW_LH(3);    RW_SB(); \
                acc[1] = MFMA16(R.m[1][1], bfr[1], acc[1]);    rop[0] = oacc[0]; rop[rstep] = oacc[1];           RW_SB(); \
                acc[2] = MFMA16(R.m[2][1], bfr[1], acc[2]);    rop[2 * rstep] = oacc[2]; rop[3 * rstep] = oacc[3]; RW_SB(); \
                acc[3] = MFMA16(R.m[3][1], bfr[1], acc[3]); \
                RW_SB(); \
                RW_BAR(); } while (0)
            static_assert(RW_NCK % 2 == 0, "two chunks per trip");
            float* const rop0 = RO2 + (size_t)d * MT * 512 + (size_t)(d ? 15 - 4 * q : 4 * q) * 512 + h * 64 + 16 * vs + vl;
            const long rstep = d ? -512 : 512;
#pragma unroll 1
            for (int cc = 0; cc < RW_NCK; cc += 2) { RW_COMPUTE(RA, RB, cc); RW_COMPUTE(RB, RA, cc + 1); }
#undef RW_COMPUTE
#undef RW_SB
#undef RW_LG
#undef RW_LH
#undef RW_LM
        }
#undef RW_LDS_LOAD
#undef RW_LOADER_STEP
#undef RW_BAR
        asm volatile("s_waitcnt vmcnt(0)" ::: "memory");
#undef RW_PIECE
    }
}
__device__ __forceinline__ void phase_rw_finish(Ctx& C, int l, int w0, int nw, int rows) {
    const float* VV = WSP(float, OFF_VV); const float* GS = WSP(float, OFF_GS); const float* RO = WSP(float, OFF_RO); const float* BON = WSP(float, OFF_BON); const float* RO2 = WSP(float, OFF_RO2);
    bf16_t* YB = WSP(bf16_t, OFF_YB) + (size_t)1 * MT * 512;
    const int li = C.lane & 15, g = C.lane >> 4;
    for (int uidx = w0; uidx < rows * 2; uidx += nw) {
        const int r = uidx >> 1, h = (uidx & 1) * 4 + g, c = h * 64 + 4 * li;
        const f32x4 a0 = *(const f32x4*)(RO + (size_t)r * 512 + c), a1 = *(const f32x4*)(RO + ((size_t)MT + r) * 512 + c);
        const f32x4 b0 = *(const f32x4*)(RO2 + (size_t)r * 512 + c), b1 = *(const f32x4*)(RO2 + ((size_t)MT + r) * 512 + c);
        const f32x4 vv = *(const f32x4*)(VV + (size_t)r * 512 + c), gs = *(const f32x4*)(GS + (size_t)r * 512 + c);
        const f32x4 lw = *(const f32x4*)(C.ka->in[I_RWLNW] + l * 512 + c), lb = *(const f32x4*)(C.ka->in[I_RWLNB] + l * 512 + c);
        const float bon = BON[(size_t)r * 8 + h] + BON[((size_t)MT + r) * 8 + h];
        const f32x4 o = (a0 + a1) + (b0 + b1);
        const float mu = row16_sum((o.x + o.y) + (o.z + o.w)) * (1.0f / 64.0f);
        const f32x4 dv = o - mu;
        const float var = row16_sum((dv.x * dv.x + dv.y * dv.y) + (dv.z * dv.z + dv.w * dv.w)) * (1.0f / 64.0f);
        const float rs = rsqrtf(var + RW_GN_EPS);
        const f32x4 y = ((dv * rs) * lw + lb + vv * bon) * gs;
        uint2 w; w.x = pk2(y.x, y.y); w.y = pk2(y.z, y.w);
        *(uint2*)(YB + (size_t)r * 512 + c) = w;
    }
}

typedef float f32x4u __attribute__((ext_vector_type(4), aligned(4)));
__device__ __forceinline__ float swap32_sum(float x) { auto t = __builtin_amdgcn_permlane32_swap(__float_as_uint(x), __float_as_uint(x), false, false); return __uint_as_float(t[0]) + __uint_as_float(t[1]); }
__device__ __forceinline__ f32x16 qk_tile(const bf16_t* Kp  , const bf16x8 (&qf)[4], int r, int h) {
    f32x16 acc;
#pragma unroll
    for (int i = 0; i < 16; ++i) acc[i] = 0.f;
    const bf16_t* p = Kp + (size_t)r * PAW + 8 * h;
#pragma unroll
    for (int s = 0; s < 4; ++s) { const bf16x8 kf = *(const bf16x8*)(p + 16 * s); acc = MFMA32(kf, qf[s], acc); }
    return acc;
}
__device__ __forceinline__ void pv_tile(f32x16 (&o)[2], const bf16_t* VTp  , const f32x16& p, int r, int h) {
#pragma unroll
    for (int s = 0; s < 2; ++s) {
        u32x4 pw; pw.x = pg8::cvt_pk_bf16(p[8 * s + 0], p[8 * s + 1]); pw.y = pg8::cvt_pk_bf16(p[8 * s + 2], p[8 * s + 3]); pw.z = pg8::cvt_pk_bf16(p[8 * s + 4], p[8 * s + 5]); pw.w = pg8::cvt_pk_bf16(p[8 * s + 6], p[8 * s + 7]);
        const bf16x8 pb = __builtin_bit_cast(bf16x8, pw);
#pragma unroll
        for (int blk = 0; blk < 2; ++blk) {
            const bf16_t* vp = VTp + (size_t)(32 * blk + r) * MT + 16 * s + 4 * h;
            const u32x2 lo = *(const u32x2*)vp, hi = *(const u32x2*)(vp + 8);
            u32x4 vw; vw.x = lo.x; vw.y = lo.y; vw.z = hi.x; vw.w = hi.y;
            o[blk] = MFMA32(__builtin_bit_cast(bf16x8, vw), pb, o[blk]);
        }
    }
}
__device__ __forceinline__ void phase_attn(Ctx& C, int l, int w0, int nw) {
    const bf16_t* PA = WSP(bf16_t, OFF_PA); bf16_t* YB = WSP(bf16_t, OFF_YB);
    const bf16_t* VTN = WSP(bf16_t, OFF_VTN); const bf16_t* VTW = WSP(bf16_t, OFF_VTW);
    const float* PB = WSP(float, OFF_PB); const float* MREF = WSP(float, OFF_MREF);
    const int r = C.lane & 31, h = C.lane >> 5;
    constexpr int NJT = 2048 + 64;
    for (int job = w0; job < 2 * NJT; job += nw) {
        const int type = __builtin_amdgcn_readfirstlane(job / NJT), jj = __builtin_amdgcn_readfirstlane(job % NJT), qt = jj >> 3, hd = jj & 7;
        const int q0 = qt * 32;
        const bool lat = qt < 256;
        if (!lat && l == DEPTH - 1) continue;
        const float Mr = MREF[type];
        bf16x8 qf[4];
        { const bf16_t* qp = PA + (size_t)(q0 + r) * PAW + (type == 0 ? 0 : 1536) + hd * 64 + 8 * h;
#pragma unroll
          for (int s = 0; s < 4; ++s) qf[s] = *(const bf16x8*)(qp + 16 * s); }
        f32x16 o[2];
#pragma unroll
        for (int i = 0; i < 16; ++i) { o[0][i] = 0.f; o[1][i] = 0.f; }
        float lsum = 0.f;
        const int kcol = type == 0 ? 512 + hd * 64 : 2048 + (hd >> 2) * 64;
        const bf16_t* VT = type == 0 ? VTN + (size_t)(hd * (MT / 32)) * 2048 : VTW + (size_t)((hd >> 2) * (MT / 32)) * 2048;
        const bf16_t* KT = type == 0 ? WSP(bf16_t, OFF_KTN) + (size_t)(hd * (MT / 32)) * 2048 : WSP(bf16_t, OFF_KTW) + (size_t)((hd >> 2) * (MT / 32)) * 2048;
        const int i_g = qt >> 1, j_g = (qt & 1) * 32 + r;
        int rs = i_g - 4; rs = rs < 0 ? 0 : (rs > 120 ? 120 : rs);
        int cs = j_g - 8; cs = cs < 0 ? 0 : (cs > 48 ? 48 : cs);
        const int dl0 = -4 > -qt ? -4 : -qt, dl1 = 4 < 255 - qt ? 4 : 255 - qt;
        const int n_loc = !lat ? 0 : (type == 0 ? 16 : dl1 - dl0 + 1), nt = n_loc + CTX / 32;
#define ATT_KEY0(t) ((t) >= n_loc ? SEQ + 32 * ((t) - n_loc) : (type == 0 ? (rs + ((t) >> 1)) * 64 + 32 * ((t) & 1) : (qt + dl0 + (t)) * 32))
#define ATT_LOADK(kf, key0) do { const bf16_t* kp_ = KT + (size_t)((key0) >> 5) * 2048 + C.lane * 8; _Pragma("unroll") for (int s = 0; s < 4; ++s) kf[s] = *(const bf16x8*)(kp_ + s * 512); } while (0)
#define ATT_LOADV(vf, key0) do { const bf16_t* vp_ = VT + (size_t)((key0) >> 5) * 2048 + C.lane * 8; _Pragma("unroll") for (int s = 0; s < 2; ++s) _Pragma("unroll") for (int blk = 0; blk < 2; ++blk) vf[s][blk] = *(const u32x4*)(vp_ + (s * 2 + blk) * 512); } while (0)
        bf16x8 kc[4], kn[4]; u32x4 vc[2][2], vn[2][2];
        { const int k0 = ATT_KEY0(0); ATT_LOADK(kc, k0); ATT_LOADV(vc, k0); }
#pragma unroll 1
        for (int t = 0; t < nt; ++t) {
            { const int tn = t + 1 < nt ? t + 1 : t; const int k1 = ATT_KEY0(tn); ATT_LOADK(kn, k1); ATT_LOADV(vn, k1); }
            f32x16 acc;
#pragma unroll
            for (int i = 0; i < 16; ++i) acc[i] = 0.f;
#pragma unroll
            for (int s = 0; s < 4; ++s) acc = MFMA32(kc[s], qf[s], acc);
            f32x16 p;
            if (t >= n_loc) {
#pragma unroll
                for (int reg = 0; reg < 16; ++reg) { p[reg] = __expf(acc[reg] - Mr); lsum += p[reg]; }
            } else if (type == 0) {
                const int a = t >> 1, cc = t & 1;
                const float* brow = PB + (size_t)(hd * 15 + (rs + a - i_g + 7)) * 128 + (32 * cc + 4 * h - j_g + 63);
                const int lo = cs - 32 * cc - 4 * h;
#pragma unroll
                for (int g = 0; g < 4; ++g) {
                    const f32x4u b4 = *(const f32x4u*)(brow + 8 * g);
#pragma unroll
                    for (int q = 0; q < 4; ++q) { const int reg = 4 * g + q; const bool valid = (unsigned)(KOFF(reg) - lo) < 16u;
                        const float e = __expf(acc[reg] + b4[q] - Mr); p[reg] = valid ? e : 0.f; lsum += p[reg]; }
                }
            } else {
                const int dl = dl0 + t;
#pragma unroll
                for (int reg = 0; reg < 16; ++reg) { const int kr = KOFF(reg) + 4 * h; const bool valid = dl == -4 ? (kr >= r) : (dl == 4 ? (kr <= r) : true);
                    const float e = __expf(acc[reg] - Mr); p[reg] = valid ? e : 0.f; lsum += p[reg]; }
            }
#pragma unroll
            for (int s = 0; s < 2; ++s) {
                u32x4 pw; pw.x = pg8::cvt_pk_bf16(p[8 * s + 0], p[8 * s + 1]); pw.y = pg8::cvt_pk_bf16(p[8 * s + 2], p[8 * s + 3]); pw.z = pg8::cvt_pk_bf16(p[8 * s + 4], p[8 * s + 5]); pw.w = pg8::cvt_pk_bf16(p[8 * s + 6], p[8 * s + 7]);
                const bf16x8 pb = __builtin_bit_cast(bf16x8, pw);
#pragma unroll
                for (int blk = 0; blk < 2; ++blk) o[blk] = MFMA32(__builtin_bit_cast(bf16x8, vc[s][blk]), pb, o[blk]);
            }
#pragma unroll
            for (int s = 0; s < 4; ++s) kc[s] = kn[s];
#pragma unroll
            for (int s = 0; s < 2; ++s)
#pragma unroll
                for (int blk = 0; blk < 2; ++blk) vc[s][blk] = vn[s][blk];
        }
#undef ATT_KEY0
#undef ATT_LOADK
#undef ATT_LOADV
        float ltot = swap32_sum(lsum);
        if (type == 1) ltot += __expf(C.ka->in[I_WASINK][l * 8 + hd] - Mr);
        const float inv = 1.0f / ltot;
        bf16_t* yp = YB + (size_t)(2 + type) * MT * 512 + (size_t)(q0 + r) * 512 + hd * 64 + 4 * h;
#pragma unroll
        for (int blk = 0; blk < 2; ++blk)
#pragma unroll
            for (int g = 0; g < 4; ++g) {
                u32x2 w; w.x = pg8::cvt_pk_bf16(o[blk][4 * g] * inv, o[blk][4 * g + 1] * inv); w.y = pg8::cvt_pk_bf16(o[blk][4 * g + 2] * inv, o[blk][4 * g + 3] * inv);
                *(u32x2*)(yp + 32 * blk + 8 * g) = w;
            }
    }
}
__device__ __forceinline__ void phase_attn_tables(Ctx& C, int l, int w0, int nw) {
    const bf16_t* PA = WSP(bf16_t, OFF_PA); bf16_t* VTN = WSP(bf16_t, OFF_VTN); bf16_t* VTW = WSP(bf16_t, OFF_VTW);
    LAS unsigned char* tile = C.lds + C.wave * 9216;
    const int lane = C.lane;
    for (int u = w0; u < 10 * NCH; u += nw) {
        const int hd = u / NCH, tt = u % NCH, t0 = tt * 64;
        const int vcol = hd < 8 ? 1024 + hd * 64 : 2176 + (hd - 8) * 64;
#pragma unroll
        for (int it = 0; it < 8; ++it) { const int row = 8 * it + (lane >> 3), ch = lane & 7;
            *(LAS u32x4*)(tile + row * 144 + ch * 16) = *(const u32x4*)(PA + (size_t)(t0 + row) * PAW + vcol + ch * 8); }
        LDS_WAIT(); asm volatile("" ::: "memory");
        bf16_t* dst = (hd < 8 ? VTN + (size_t)(hd * (MT / 32) + 2 * tt) * 2048 : VTW + (size_t)((hd - 8) * (MT / 32) + 2 * tt) * 2048);
        { const int rr = lane & 31, hh = lane >> 5;
#pragma unroll
          for (int kt2 = 0; kt2 < 2; ++kt2)
#pragma unroll
            for (int s2 = 0; s2 < 2; ++s2)
#pragma unroll
                for (int blk = 0; blk < 2; ++blk) {
                    unsigned e[8];
#pragma unroll
                    for (int j = 0; j < 8; ++j) e[j] = *(const LAS bf16_t*)(tile + (32 * kt2 + 16 * s2 + 8 * (j >> 2) + 4 * hh + (j & 3)) * 144 + 2 * (32 * blk + rr));
                    u32x4 w; w.x = e[0] | (e[1] << 16); w.y = e[2] | (e[3] << 16); w.z = e[4] | (e[5] << 16); w.w = e[6] | (e[7] << 16);
                    *(u32x4*)(dst + (size_t)kt2 * 2048 + ((s2 * 2 + blk) * 64 + lane) * 8) = w;
                }
        }
        LDS_WAIT(); asm volatile("" ::: "memory");
    }
    float* PB = WSP(float, OFF_PB);
    const float* rpb = C.ka->in[I_NARPB] + (size_t)l * 8 * 15 * 31;
    for (int idx = w0 * 64 + lane; idx < 8 * 15 * 128; idx += nw * 64) { const int x = idx & 127, hr = idx >> 7; PB[idx] = (x >= 48 && x < 79) ? rpb[hr * 31 + x - 48] : 0.f; }
    if (w0 == 0) {
        float mb = 0.f;
        for (int i = lane; i < 8 * 15 * 31; i += 64) mb = fmaxf(mb, fabsf(rpb[i]));
        mb = wave_max(mb);
        const float nq = wave_max(fabsf(C.ka->in[I_NAQN][l * 64 + lane])), nk = wave_max(fabsf(C.ka->in[I_NAKN][l * 64 + lane]));
        const float wq = wave_max(fabsf(C.ka->in[I_WAQN][l * 64 + lane])), wk = wave_max(fabsf(C.ka->in[I_WAKN][l * 64 + lane]));
        const float sk = wave_max(lane < 8 ? C.ka->in[I_WASINK][l * 8 + lane] : -1e30f);
        if (lane == 0) { float* M = WSP(float, OFF_MREF); M[0] = 8.08f * nq * nk + mb; M[1] = fmaxf(8.08f * wq * wk, sk); }
    }
}

__device__ __forceinline__ void phase_combine(Ctx& C, int row_lo, int row_hi) {
    const bf16_t* PROJ = WSP(bf16_t, OFF_P32); bf16_t* MG = WSP(bf16_t, OFF_H);
    const size_t n8 = (size_t)(row_hi - row_lo) * D / 8;
    for (size_t i = (size_t)C.bid * NT + C.tid; i < n8; i += (size_t)C.G * NT) {
        const size_t r = row_lo + i / (D / 8), c8 = i % (D / 8);
        float a[8];
#pragma unroll
        for (int j = 0; j < 8; ++j) a[j] = 0.f;
#pragma unroll
        for (int g = 0; g < 4; ++g) {
            const u32x4 w = *(const u32x4*)(PROJ + r * GLW + g * D + c8 * 8);
            a[0] += bf2f(w.x & 0xffffu); a[1] += bf2f(w.x >> 16); a[2] += bf2f(w.y & 0xffffu); a[3] += bf2f(w.y >> 16);
            a[4] += bf2f(w.z & 0xffffu); a[5] += bf2f(w.z >> 16); a[6] += bf2f(w.w & 0xffffu); a[7] += bf2f(w.w >> 16);
        }
        u32x4 o; o.x = pk2(a[0], a[1]); o.y = pk2(a[2], a[3]); o.z = pk2(a[4], a[5]); o.w = pk2(a[6], a[7]);
        *(u32x4*)(MG + r * D + c8 * 8) = o;
    }
}

constexpr int PH_PRO = 2, PH_PER_LAYER = 14, N_PHASES = PH_PRO + DEPTH * PH_PER_LAYER;

__global__ void __launch_bounds__(NT, 2) mk_fwd(Args args) {
    extern __shared__ __attribute__((aligned(16))) unsigned char lds_raw[];
    Ctx C;
    C.lds = (LAS unsigned char*)lds_raw;
    C.tid = threadIdx.x; C.lane = C.tid & 63; C.wave = __builtin_amdgcn_readfirstlane(C.tid >> 6);
    C.bid = blockIdx.x; C.G = gridDim.x;
    C.ka = (const Args __attribute__((address_space(4)))*)__builtin_amdgcn_kernarg_segment_ptr(); C.out = args.out; C.ws = args.ws;
    volatile LAS unsigned* MISC = (volatile LAS unsigned*)(C.lds + MISC_OFF);
    for (int u = C.tid; u < (LDS_BYTES - RING_BYTES) / 4; u += NT) ((LAS unsigned*)(C.lds + RING_BYTES))[u] = 0u;
    __syncthreads();
    const int lo = args.ph_lo, hi = args.ph_hi;
    XcdBarrier bar; bar.bar = WSP(unsigned, OFF_CTL) + 4096; bar.x = 0; bar.st = nullptr;
    const bool multi = (hi - lo) > 1;
    if (multi) bar = xcd_barrier_post(WSP(unsigned, OFF_CTL) + 4096, MISC + 8);
#ifndef PH_MASK
#define PH_MASK 0xFFFF
#endif
#ifndef PRO_MASK
#define PRO_MASK 3
#endif
#define IN(k) (lo <= (k) && (k) < hi)
#define LEN(j) (((PH_MASK) >> (j)) & 1)
#define SEAM(k) do { if (IN(k) && IN((k) + 1)) xcd_barrier(bar); } while (0)

    if ((PRO_MASK & 1) && IN(0)) { relaunder(C); phase_convert(C, 0, 127, C.bid, C.G); phase_ada_partial(C); } SEAM(0);
    if ((PRO_MASK & 2) && IN(1)) { relaunder(C); phase_ada_reduce(C); } SEAM(1);

    const bool TS = (DEPTH == 2) && (C.G == 256) && multi;
#pragma unroll
    for (int l = 0; l < DEPTH; ++l) {
        const int pb = PH_PRO + l * PH_PER_LAYER;
        if (LEN(0) && IN(pb + 0)) { relaunder(C); if (l > 0) { if (TS) phase_convert(C, l, 16 | 32 | 64, C.bid, C.G, CV_O_IN + CV_Q_IN, CV_N); else phase_convert(C, l, 127 - 21, C.bid, C.G); } phase_norm(C, l, C.ka->in[I_NF1] + (size_t)l * D, 0, l > 0 ? 22 : 0, MT, l == 0 ? 1 : 0); } SEAM(pb + 0);
        if (LEN(1) && IN(pb + 1)) { relaunder(C);
            pg8::Gemm g = pg8::mkgemm(WSP(bf16_t, OFF_H), WSP(bf16_t, OFF_WI1));
            pg8::StaticOrder S; S.init(MT, 2 * DFF, C.G, C.bid);
            pg8::EpiSwiGLU E{WSP(bf16_t, OFF_G)};
            pg8::gemm_phase<pg8::EpiSwiGLU, true, true, pg8::StaticOrder, D, D, D, 0>(C.lds, g, S, E, C.tid);
            if (PROBE_MODE == 3) { pg8::gemm_phase<pg8::EpiSwiGLU, true, true, pg8::StaticOrder, D, D, D, 0>(C.lds, g, S, E, C.tid); }
            if (TS && l == 1 && C.bid >= 172) { relaunder(C); __syncthreads(); phase_convert(C, l, 2, C.bid - 172, 84, CV_O_WI2, CV_O_WI2 + CV_Q_WI2); }
        } SEAM(pb + 1);
        if (LEN(2) && IN(pb + 2)) { relaunder(C);
            { pg8::Gemm g = pg8::mkgemm(WSP(bf16_t, OFF_G), WSP(bf16_t, OFF_WO1));
              pg8::StaticOrder S; S.init(SEQ, D, C.G, C.bid);
              pg8::EpiResid<true> E{WSP(float, OFF_X), mod_ptr(C, l, 0, 2), mod_ptr(C, l, 1, 2), nullptr, l == 0 ? C.ka->in[I_X] : WSP(float, OFF_X)};
              pg8::gemm_phase<pg8::EpiResid<true>, true, true, pg8::StaticOrder, DFF, DFF, DFF, 0>(C.lds, g, S, E, C.tid); }
            { relaunder(C); pg8::Gemm g = pg8::mkgemm(WSP(bf16_t, OFF_G), WSP(bf16_t, OFF_WO1));
              pg8::SplitOrder S{SEQ / 256, D / 256, 22, C.G, C.bid};
              pg8::EpiPart<true> E{WSP(float, OFF_P32), mod_ptr(C, l, 1, 2)};
              pg8::gemm_phase<pg8::EpiPart<true>, true, true, pg8::SplitOrder, 256, DFF, DFF, 256>(C.lds, g, S, E, C.tid); }
        } SEAM(pb + 2);
        if (LEN(3) && IN(pb + 3)) { relaunder(C); phase_norm(C, l, C.ka->in[I_NMIX] + (size_t)l * D, 3, 22, MT, l == 0 ? 2 : 0); } SEAM(pb + 3);
        if (LEN(4) && IN(pb + 4)) { relaunder(C);
            pg8::Gemm g = pg8::mkgemm(WSP(bf16_t, OFF_H), WSP(bf16_t, OFF_WIN));
            pg8::StaticOrder S; S.init(MT, PTOT, C.G, C.bid);
            pg8::EpiWin E{WSP(float, OFF_P32), WSP(bf16_t, OFF_PA), WSP(bf16_t, OFF_GL), 0};
            pg8::gemm_phase<pg8::EpiWin, true, true, pg8::StaticOrder, D, D, D, 0>(C.lds, g, S, E, C.tid);
            if (PROBE_MODE == 3) { pg8::gemm_phase<pg8::EpiWin, true, true, pg8::StaticOrder, D, D, D, 0>(C.lds, g, S, E, C.tid); }
            if (TS && C.bid >= 188) { relaunder(C); __syncthreads();
                if (l == 0) phase_convert(C, 1, 1, C.bid - 188, 68, CV_O_WI1, CV_O_WI1 + CV_Q_WI1);
                else { phase_convert(C, 1, 2, C.bid - 188, 68, CV_O_WI2 + CV_Q_WI2, CV_O_WI2 + CV_WI); phase_convert(C, 1, 8, C.bid - 188, 68, CV_O_WO2, CV_O_WO2 + CV_WO); } }
        } SEAM(pb + 4);
        if (LEN(5) && IN(pb + 5)) { relaunder(C);
            phase_rw_prep(C, l, C.bid, C.G);
            __syncthreads();
            phase_attn_prep(C, l, C.bid * NWAVES + C.wave, C.G * NWAVES);
            phase_attn_tables(C, l, C.bid * NWAVES + C.wave, C.G * NWAVES);
            if (PROBE_MODE == 1) phase_attn_tables(C, l, C.bid * NWAVES + C.wave, C.G * NWAVES);
            __syncthreads();
            phase_hg_A(C, l, C.bid, C.G);
            if (PROBE_MODE == 1) phase_hg_A(C, l, C.bid, C.G);
        } SEAM(pb + 5);
        if (LEN(6) && IN(pb + 6)) { relaunder(C);
            if (C.G >= 256) {
                if (C.bid < RW_NJOBS) phase_rw_scan(C, C.bid, RW_NJOBS);
                else { const int b = C.bid - RW_NJOBS, n = C.G - RW_NJOBS; phase_hg_B(C, b, n); phase_attn(C, l, b * NWAVES + C.wave, n * NWAVES);
                    if (l + 1 < DEPTH) { __syncthreads();
                        if (TS) { phase_convert(C, l + 1, 1, b, n, CV_O_WI1 + CV_Q_WI1, CV_O_WI1 + CV_WI); phase_convert(C, l + 1, 4, b, n, CV_O_WO1, CV_O_WO1 + CV_WO); }
                        else phase_convert(C, l + 1, 21, b, n); }
                    if (PROBE_MODE == 11) { phase_hg_B(C, b, n); phase_attn(C, l, b * NWAVES + C.wave, n * NWAVES); }
                    if (PROBE_MODE == 12) { phase_attn(C, l, b * NWAVES + C.wave, n * NWAVES); } if (PROBE_MODE == 13) { phase_hg_B(C, b, n); } }
            } else {
                phase_rw_scan(C, C.bid, C.G); phase_hg_B(C, C.bid, C.G); phase_attn(C, l, C.bid * NWAVES + C.wave, C.G * NWAVES);
                if (l + 1 < DEPTH) { __syncthreads(); phase_convert(C, l + 1, 21, C.bid, C.G); }
            }
        } SEAM(pb + 6);
        if (LEN(7) && IN(pb + 7)) { relaunder(C); phase_hg_C(C, l, C.bid, C.G, l == DEPTH - 1 ? SEQ / 64 : NCH);
            if (l < DEPTH - 1 && C.G == 256) { if (C.bid >= 16) phase_rw_finish(C, l, (C.bid - 16) * NWAVES + C.wave, (C.G - 16) * NWAVES, MT); }
            else phase_rw_finish(C, l, C.bid * NWAVES + C.wave, C.G * NWAVES, l == DEPTH - 1 ? SEQ : MT);
        } SEAM(pb + 7);
        if (LEN(8) && IN(pb + 8)) { relaunder(C);
            { pg8::Gemm g = pg8::mkgemm(WSP(bf16_t, OFF_YB), WSP(bf16_t, OFF_WBR)); g.a_kgs = (size_t)MT * 512 * 2;
              pg8::StaticOrder S; S.init(SEQ, D, C.G, C.bid);
              pg8::EpiMergeF E{WSP(bf16_t, OFF_GL), WSP(bf16_t, OFF_H)};
              pg8::gemm_phase<pg8::EpiMergeF, true, true, pg8::StaticOrder, 4 * 512, 512, 4 * 512, 0, 8>(C.lds, g, S, E, C.tid);
              if (PROBE_MODE == 4) { pg8::gemm_phase<pg8::EpiMergeF, true, true, pg8::StaticOrder, 4 * 512, 512, 4 * 512, 0, 8>(C.lds, g, S, E, C.tid); } }
            if (l < DEPTH - 1) { relaunder(C);
              pg8::Gemm g = pg8::mkgemm(WSP(bf16_t, OFF_YB), WSP(bf16_t, OFF_WBR)); g.a_div = 8; g.a_gstride = (size_t)MT * 512; g.b_mod = 8; g.b_gcol = 512;
              pg8::SplitOrder S{SEQ / 256, 32, 1, C.G, C.bid};
              pg8::EpiMerge E{WSP(bf16_t, OFF_GL), WSP(bf16_t, OFF_P32)};
              pg8::gemm_phase<pg8::EpiMerge, true, true, pg8::SplitOrder, 512, 512, 4 * 512, 0>(C.lds, g, S, E, C.tid); }
        }
        if (l < DEPTH - 1) { SEAM(pb + 8); }
        if (l < DEPTH - 1) { if (LEN(9) && IN(pb + 9)) { relaunder(C); phase_combine(C, SEQ, MT); } }
        SEAM(pb + 9);
        if (LEN(10) && IN(pb + 10)) { relaunder(C);
            { pg8::Gemm g = pg8::mkgemm(WSP(bf16_t, OFF_H), WSP(bf16_t, OFF_WOUT));
              pg8::StaticOrder S; S.init(SEQ, D, C.G, C.bid);
              pg8::EpiResid<false> E{WSP(float, OFF_X), mod_ptr(C, l, 0, 5), mod_ptr(C, l, 1, 5), nullptr, WSP(float, OFF_X)};
              pg8::gemm_phase<pg8::EpiResid<false>, true, true, pg8::StaticOrder, D, D, D, 0>(C.lds, g, S, E, C.tid); }
            if (l < DEPTH - 1) { relaunder(C);
              pg8::Gemm g = pg8::mkgemm(WSP(bf16_t, OFF_H), WSP(bf16_t, OFF_WOUT));
              pg8::SplitOrder S{SEQ / 256, D / 256, 8, C.G, C.bid};
              pg8::EpiPart<false> E{WSP(float, OFF_P32), mod_ptr(C, l, 1, 5)};
              pg8::gemm_phase<pg8::EpiPart<false>, true, true, pg8::SplitOrder, 256, D, D, 256>(C.lds, g, S, E, C.tid); }
        } SEAM(pb + 10);
        if (LEN(11) && IN(pb + 11)) { relaunder(C); phase_norm(C, l, C.ka->in[I_NF2] + (size_t)l * D, 6, l < DEPTH - 1 ? 8 : 0, l == DEPTH - 1 ? SEQ : MT, 0); } SEAM(pb + 11);
        if (LEN(12) && IN(pb + 12)) { relaunder(C);
            pg8::Gemm g = pg8::mkgemm(WSP(bf16_t, OFF_H), WSP(bf16_t, OFF_WI2));
            pg8::StaticOrder S; S.init(l == DEPTH - 1 ? SEQ : MT, 2 * DFF, C.G, C.bid);
            pg8::EpiSwiGLU E{WSP(bf16_t, OFF_G)};
            pg8::gemm_phase<pg8::EpiSwiGLU, true, true, pg8::StaticOrder, D, D, D, 0>(C.lds, g, S, E, C.tid);
            if (PROBE_MODE == 3) { pg8::gemm_phase<pg8::EpiSwiGLU, true, true, pg8::StaticOrder, D, D, D, 0>(C.lds, g, S, E, C.tid); }
            if (TS && l == 0 && C.bid >= 172) { relaunder(C); __syncthreads(); phase_convert(C, 1, 16, C.bid - 172, 84, CV_O_IN, CV_O_IN + CV_Q_IN); }
        } SEAM(pb + 12);
        if (LEN(13) && IN(pb + 13)) { relaunder(C);
            { pg8::Gemm g = pg8::mkgemm(WSP(bf16_t, OFF_G), WSP(bf16_t, OFF_WO2));
              pg8::StaticOrder S; S.init(SEQ, D, C.G, C.bid);
              pg8::EpiResid<true> E{WSP(float, OFF_X), mod_ptr(C, l, 0, 8), mod_ptr(C, l, 1, 8), l == DEPTH - 1 ? C.out : nullptr, WSP(float, OFF_X)};
              pg8::gemm_phase<pg8::EpiResid<true>, true, true, pg8::StaticOrder, DFF, DFF, DFF, 0>(C.lds, g, S, E, C.tid); }
            if (l < DEPTH - 1) { relaunder(C);
              pg8::Gemm g = pg8::mkgemm(WSP(bf16_t, OFF_G), WSP(bf16_t, OFF_WO2));
              pg8::SplitOrder S{SEQ / 256, D / 256, 22, C.G, C.bid};
              pg8::EpiPart<true> E{WSP(float, OFF_P32), mod_ptr(C, l, 1, 8)};
              pg8::gemm_phase<pg8::EpiPart<true>, true, true, pg8::SplitOrder, 256, DFF, DFF, 256>(C.lds, g, S, E, C.tid); }
        } SEAM(pb + 13);
    }
#undef IN
#undef SEAM
}

extern "C" void kernel_launch(void* const* d_in, const int* in_sizes, int n_in, void* d_out, int out_size, void* d_ws, size_t ws_size, hipStream_t stream) {
    static int grid = 0;
    if (grid == 0) {
        if (n_in != N_IN || out_size != SEQ * D || ws_size < WS_END) { fprintf(stderr, "kernel_launch: unexpected shapes (n_in %d out %d ws %zu)\n", n_in, out_size, ws_size); grid = -1; return; }
        int dev = 0, cus = 0;
        if (hipGetDevice(&dev) != hipSuccess || hipDeviceGetAttribute(&cus, hipDeviceAttributeMultiprocessorCount, dev) != hipSuccess) { grid = -1; return; }
        if (hipFuncSetAttribute((const void*)mk_fwd, hipFuncAttributeMaxDynamicSharedMemorySize, LDS_BYTES) != hipSuccess) { fprintf(stderr, "kernel_launch: hipFuncSetAttribute failed\n"); grid = -1; return; }
        (void)hipGetLastError();
        grid = cus;
    }
    if (grid < 0) return;
    (void)hipMemsetAsync((char*)d_ws + OFF_CTL, 0, CTL_BYTES, stream);
    Args a{};
    for (int i = 0; i < N_IN; ++i) a.in[i] = (const float*)d_in[i];
    a.out = (float*)d_out; a.ws = (unsigned char*)d_ws;
#if MK_ONE_LAUNCH
    a.ph_lo = 0; a.ph_hi = N_PHASES;
    hipLaunchKernelGGL(mk_fwd, dim3(grid), dim3(NT), LDS_BYTES, stream, a);
#else
    for (int ph = 0; ph < N_PHASES; ++ph) {
        a.ph_lo = ph; a.ph_hi = ph + 1;
        hipLaunchKernelGGL(mk_fwd, dim3(grid), dim3(NT), LDS_BYTES, stream, a);
    }
#endif
}
```

```cpp
#include <hip/hip_runtime.h>
#include <cstdio>
#include <cstdint>

#ifndef PROBE_MODE
#define PROBE_MODE 0
#endif
#ifndef MK_ONE_LAUNCH
#define MK_ONE_LAUNCH 1
#endif

#define LAS __attribute__((address_space(3)))
#define GAS __attribute__((address_space(1)))
typedef unsigned short bf16_t;
typedef short bf16x8 __attribute__((ext_vector_type(8)));
typedef float f32x4 __attribute__((ext_vector_type(4)));
typedef float f32x2 __attribute__((ext_vector_type(2)));
typedef unsigned u32x4 __attribute__((ext_vector_type(4)));
typedef unsigned u32x2 __attribute__((ext_vector_type(2)));

constexpr int D = 2048, SEQ = 8192, CTX = 256, MT = SEQ + CTX, DEPTH = 2, DFF = 5632, NMOD = 9, MODW = NMOD * D;
constexpr int GRID_W = 64;
constexpr int PTOT = 15360, P32W = 4864, PAW = 2304, GLW = 8192;
constexpr int HG_OFF = 0, RW_OFF = 2560, RWC = 2304;
constexpr int NCH = MT / 64;
constexpr int NWAVES = 8, NT = 512;
constexpr float EPS = 1e-6f, RW_GN_EPS = 64e-5f;

constexpr size_t MiB = 1u << 20;
constexpr size_t OFF_CTL = 0, CTL_BYTES = 1 * MiB;
constexpr size_t OFF_W2T = 512 * 1024;
constexpr size_t OFF_MOD = 1 * MiB;
constexpr size_t OFF_MODP = 2 * MiB;
constexpr size_t OFF_WI1 = 11 * MiB, OFF_WO1 = 55 * MiB, OFF_WIN = 77 * MiB, OFF_WBR = 137 * MiB, OFF_WOUT = 145 * MiB, OFF_WI2 = 153 * MiB, OFF_WO2 = 197 * MiB;
constexpr size_t OFF_X = 219 * MiB;
constexpr size_t OFF_H = 285 * MiB;
constexpr size_t OFF_G = 318 * MiB;
constexpr size_t OFF_P32 = 409 * MiB;
constexpr size_t OFF_PA = 566 * MiB;
constexpr size_t OFF_GL = 604 * MiB;
constexpr size_t OFF_HGL = 736 * MiB;
constexpr size_t OFF_HGD = 802 * MiB;
constexpr size_t OFF_SCN = 803 * MiB;
constexpr size_t OFF_VV = 968 * MiB;
constexpr size_t OFF_GS = 985 * MiB;
constexpr size_t OFF_RO = 1002 * MiB;
constexpr size_t OFF_YB = 1035 * MiB;
constexpr size_t OFF_VTN = 1068 * MiB;
constexpr size_t OFF_VTW = 1077 * MiB;
constexpr size_t OFF_PB = 1080 * MiB;
constexpr size_t OFF_MREF = OFF_PB + 65536;
constexpr size_t OFF_SPT = 1081 * MiB;
constexpr size_t OFF_BON = 1114 * MiB;
constexpr size_t OFF_RO2 = 1115 * MiB;
constexpr size_t OFF_KTN = OFF_MODP;
constexpr size_t OFF_KTW = 1148 * MiB;
constexpr size_t WS_END = 1151 * MiB;
constexpr int RW_NCK = MT / 16;
constexpr size_t OFF_RWMG = OFF_G, RWMG_REC = 8192 + 2048;
constexpr size_t OFF_RWH = OFF_SCN, RWH_REC = 16384;
static_assert(16 * (size_t)RW_NCK * RWMG_REC <= 91 * MiB && 16 * (size_t)RW_NCK * RWH_REC <= 165 * MiB, "rwkv chunk records fit their regions");
constexpr int KSPLIT = 32;

constexpr int LDS_BYTES = 147456;
constexpr int RING_BYTES = 131072;
constexpr int MISC_OFF = RING_BYTES + 320;

__device__ __forceinline__ float bf2f(unsigned b) { return __uint_as_float(b << 16); }
__device__ __forceinline__ unsigned f2bf(float f) { unsigned u = __float_as_uint(f); return (u + 0x7fffu + ((u >> 16) & 1u)) >> 16; }
__device__ __forceinline__ unsigned pk2(float lo, float hi) { return f2bf(lo) | (f2bf(hi) << 16); }
typedef __bf16 bf16x2v __attribute__((ext_vector_type(2)));
typedef float f32x2v __attribute__((ext_vector_type(2)));
__device__ __forceinline__ unsigned cvt_pk_v(float lo, float hi) { const f32x2v v = {lo, hi}; return __builtin_bit_cast(unsigned, __builtin_convertvector(v, bf16x2v)); }
__device__ __forceinline__ float wave_sum(float v) {
#pragma unroll
    for (int o = 1; o < 64; o <<= 1) v += __shfl_xor(v, o);
    return v;
}
__device__ __forceinline__ float wave_max(float v) {
#pragma unroll
    for (int o = 1; o < 64; o <<= 1) v = fmaxf(v, __shfl_xor(v, o));
    return v;
}
__device__ __forceinline__ float sigmoidf_(float x) { return 1.0f / (1.0f + expf(-x)); }
__device__ __forceinline__ float siluf_(float x) { return x / (1.0f + expf(-x)); }
typedef float f32x16 __attribute__((ext_vector_type(16)));
#define MFMA32(a, b, c) __builtin_amdgcn_mfma_f32_32x32x16_bf16((a), (b), (c), 0, 0, 0)
#define KOFF(reg) (((reg) & 3) + 8 * ((reg) >> 2))
#define MFMA16(a, b, c) __builtin_amdgcn_mfma_f32_16x16x32_bf16((a), (b), (c), 0, 0, 0)
#define LDS_WAIT() asm volatile("s_waitcnt lgkmcnt(0)" ::: "memory")

__device__ __forceinline__ int seq_row(int d, int j) { return d == 0 ? (j < CTX ? SEQ + j : j - CTX) : (MT - 1 - j); }
__device__ __forceinline__ int row_seq(int d, int r) { return d == 0 ? (r >= SEQ ? r - SEQ : r + CTX) : (MT - 1 - r); }

#define XB_TMO      128
#define XB_XCNT(j)  (256  + 64 * (j))
#define XB_XSUB(j)  (1280 + 64 * (j))
#define XB_XGEN(j)  (2304 + 64 * (j))
#define XB_TOP      3328
#define XB_TOPGEN   3392
#define XCD_BAR_WORDS 3456
#define XB_SPIN_CAP (1u << 18)
__device__ __forceinline__ unsigned xb_ld(unsigned* p)              { return __hip_atomic_load(p, __ATOMIC_RELAXED, __HIP_MEMORY_SCOPE_AGENT); }
__device__ __forceinline__ unsigned xb_add(unsigned* p, unsigned v) { return __hip_atomic_fetch_add(p, v, __ATOMIC_RELAXED, __HIP_MEMORY_SCOPE_AGENT); }
__device__ __forceinline__ unsigned xb_xcc_id() { return (unsigned)__builtin_amdgcn_s_getreg((3 << 11) | 20) & 0xFu; }
#define XB_SPIN(cond, bar) do { unsigned _sp = 0; while (cond) { __builtin_amdgcn_s_sleep(1); \
    if ((++_sp & 255u) == 0u) { if (xb_ld(&(bar)[XB_TMO])) break; if (_sp > XB_SPIN_CAP) { atomicAdd(&(bar)[XB_TMO], 1u); break; } } } } while (0)
struct XcdBarrier { unsigned* bar; unsigned x; volatile LAS unsigned* st; };
__device__ __forceinline__ XcdBarrier xcd_barrier_post(unsigned* bar, volatile LAS unsigned* st) {
    XcdBarrier b; b.bar = bar; b.x = xb_xcc_id(); b.st = st;
    if (threadIdx.x == 0) (void)xb_add(&bar[XB_XCNT(b.x)], 1u);
    return b;
}
__device__ __forceinline__ void xcd_barrier_complete(unsigned* bar, unsigned x, unsigned& nloc, unsigned& nx) {
    const unsigned G = gridDim.x * gridDim.y * gridDim.z;
    unsigned sum, cnt, mine, sp = 0u;
    for (;;) {
        sum = 0u; cnt = 0u; mine = 0u;
#pragma unroll
        for (unsigned j = 0; j < 16; ++j) { const unsigned c = xb_ld(&bar[XB_XCNT(j)]); sum += c; cnt += (c > 0u) ? 1u : 0u; mine = (j == x) ? c : mine; }
        if (sum == G) break;
        __builtin_amdgcn_s_sleep(1);
        if ((++sp & 255u) == 0u) { if (xb_ld(&bar[XB_TMO])) break; if (sp > XB_SPIN_CAP) { atomicAdd(&bar[XB_TMO], 1u); break; } }
    }
    nloc = mine > 0u ? mine : 1u; nx = cnt > 0u ? cnt : 1u;
}
__device__ __forceinline__ void xcd_barrier(const XcdBarrier& b) {
    asm volatile("s_waitcnt vmcnt(0)" ::: "memory");
    __syncthreads();
    if (threadIdx.x == 0) {
        unsigned* bar = b.bar;
        __builtin_amdgcn_s_waitcnt(0);
        unsigned nloc = b.st[0], nx = b.st[1];
        if (nloc == 0u) { xcd_barrier_complete(bar, b.x, nloc, nx); b.st[0] = nloc; b.st[1] = nx; }
        const unsigned old = xb_add(&bar[XB_XSUB(b.x)], 1u);
        const unsigned gen = old / nloc;
        if (old + 1u == (gen + 1u) * nloc) {
            __builtin_amdgcn_fence(__ATOMIC_RELEASE, "agent");
            asm volatile("s_waitcnt vmcnt(0)" ::: "memory");
            const unsigned og = xb_add(&bar[XB_TOP], 1u);
            const unsigned tg = og / nx;
            if (og + 1u == (tg + 1u) * nx) xb_add(&bar[XB_TOPGEN], 1u);
            else XB_SPIN(xb_ld(&bar[XB_TOPGEN]) == tg, bar);
            __builtin_amdgcn_fence(__ATOMIC_ACQUIRE, "agent");
            xb_add(&bar[XB_XGEN(b.x)], 1u);
            asm volatile("s_waitcnt vmcnt(0)" ::: "memory");
        } else {
            XB_SPIN(xb_ld(&bar[XB_XGEN(b.x)]) == gen, bar);
            __builtin_amdgcn_fence(__ATOMIC_ACQUIRE, "agent");
            asm volatile("s_waitcnt vmcnt(0)" ::: "memory");
        }
    }
    __syncthreads();
}

namespace pg8 {
constexpr int BM = 256, BK = 64, HALF = 128, HTB = HALF * BK * 2, STAGE_BYTES = 8 * HTB, NXCD = 8, WGM = 8;
__host__ __device__ __forceinline__ int lds_byte(int r, int c) { const int st = (r >> 4) * 2 + (c >> 5), rr = r & 15, cc = c & 31, ob = rr * 64 + cc * 2; return st * 1024 + (ob ^ (((ob >> 9) & 1) << 5)); }
__host__ __device__ __forceinline__ void stage_rc(int b, int& R, int& C) { const int st = b / 1024, sb = b % 1024, swz = sb ^ (((sb >> 9) & 1) << 5); R = (st >> 1) * 16 + swz / 64; C = (st & 1) * 32 + (swz % 64) / 2; }
__host__ __device__ __forceinline__ int perm32(int rho) { const int n = rho >> 4, i = rho & 15; return 8 * (i >> 2) + 4 * n + (i & 3); }
struct Unit { int pm, pn, ks; };
struct Gemm { const bf16_t* A; const bf16_t* Bt; size_t a_gstride; size_t a_kgs; int a_div, b_mod, b_gcol, pad; };
__device__ __forceinline__ Gemm mkgemm(const bf16_t* A, const bf16_t* Bt) { Gemm g; g.A = A; g.Bt = Bt; g.a_gstride = 0; g.a_kgs = 0; g.a_div = 1 << 20; g.b_mod = 1 << 20; g.b_gcol = 0; g.pad = 0; return g; }
struct StaticOrder {
    int nM, nN, nwg, G, c;
    __host__ __device__ void init(int M, int N, int G_, int c_) { nM = M / BM; nN = N / BM; nwg = nM * nN; G = G_; c = c_; }
    __host__ __device__ bool next(int i, Unit& u) const {
        const long L = (long)i * G + c; if (L >= nwg) return false;
        int wgid = (int)L; { const int q = nwg / NXCD, r = nwg % NXCD, xcd = wgid % NXCD, off = wgid / NXCD; wgid = (xcd < r ? xcd * (q + 1) : r * (q + 1) + (xcd - r) * q) + off; }
        const int nig = WGM * nN, gid = wgid / nig, fm = gid * WGM, gsz = (nM - fm) < WGM ? (nM - fm) : WGM;
        u.pm = fm + ((wgid % nig) % gsz); u.pn = (wgid % nig) / gsz; u.ks = 0; return true;
    }
};
struct SplitOrder {
    int pm, nN, KS, G, c;
    __host__ __device__ bool next(int i, Unit& u) const { const int L = i * G + c; if (L >= nN * KS) return false; u.pm = pm; u.pn = L / KS; u.ks = L % KS; return true; }
};
__device__ __forceinline__ unsigned cvt_pk_bf16(float lo, float hi) { unsigned r; asm volatile("v_cvt_pk_bf16_f32 %0, %1, %2" : "=v"(r) : "v"(lo), "v"(hi)); return r; }

template <class Epi, bool ALIGN_EPI, bool SP2, class Sched, int KE, int LDA, int LDB, int KSS, int AGRP = 0>
__device__ __forceinline__ void gemm_phase(LAS unsigned char* lds, const Gemm g, const Sched& S, const Epi& E, const int tid) {
    const int wid = __builtin_amdgcn_readfirstlane(tid >> 6), lane = tid & 63, wr = wid >> 2, wc = wid & 3, fr = lane & 15, fq = lane >> 4;
    constexpr int nt = KE / BK;
    static_assert(!Epi::MIDK || SP2, "the mid-K hook sits in the SP2 loop only");
    unsigned voffA[2], voffB[2];
#pragma unroll
    for (int i = 0; i < 2; ++i) { int R, C; stage_rc(tid * 16 + i * 8192, R, C); const int Rb = Epi::PERM ? ((R & ~31) + perm32(R & 31)) : R;
        voffA[i] = (unsigned)(R * LDA + C) * 2u; voffB[i] = (unsigned)(Rb * LDB + C) * 2u; }
    const size_t kstep = (size_t)(BK * 2);
    constexpr size_t hstepA = (size_t)HALF * LDA * 2, hstepB = (size_t)HALF * LDB * 2;
    const unsigned ldsw = (unsigned)wid * 1024u;
    const int aoff = lds_byte(wr * 64 + fr, fq * 8), boff = lds_byte(wc * 32 + fr, fq * 8);
#define PG8_SA(b, h) (((b) * 2 + (h)) * HTB)
#define PG8_SB(b, h) ((4 + (b) * 2 + (h)) * HTB)
#define PG8_STAGE(bufoff, gbase, voff) do { _Pragma("unroll") for (int _i = 0; _i < 2; ++_i) \
        __builtin_amdgcn_global_load_lds((const unsigned*)((const char*)(gbase) + (voff)[_i]), (LAS unsigned*)(lds + (bufoff) + ldsw + _i * 8192), 16, 0, 0); } while (0)
#define PG8_LDA(dst, b, h) do { _Pragma("unroll") for (int m = 0; m < 4; ++m) _Pragma("unroll") for (int k = 0; k < 2; ++k) dst[m][k] = *(const LAS bf16x8*)(lds + PG8_SA(b, h) + aoff + m * 2048 + k * 1024); } while (0)
#define PG8_LDB(dst, b, h) do { _Pragma("unroll") for (int n = 0; n < 2; ++n) _Pragma("unroll") for (int k = 0; k < 2; ++k) dst[n][k] = *(const LAS bf16x8*)(lds + PG8_SB(b, h) + boff + n * 2048 + k * 1024); } while (0)
#define PG8_MMA(ai, bj, At, Bt) do { __builtin_amdgcn_s_setprio(1); _Pragma("unroll") for (int m = 0; m < 4; ++m) _Pragma("unroll") for (int n = 0; n < 2; ++n) _Pragma("unroll") for (int k = 0; k < 2; ++k) \
        acc[ai][bj][m][n] = __builtin_amdgcn_mfma_f32_16x16x32_bf16(Bt[n][k], At[m][k], acc[ai][bj][m][n], 0, 0, 0); __builtin_amdgcn_s_setprio(0); } while (0)
#define PG8_WAIT_V(n) asm volatile("s_waitcnt vmcnt(" #n ")" ::: "memory")
#define PG8_WAIT_L(n) asm volatile("s_waitcnt lgkmcnt(" #n ")" ::: "memory")
#define PG8_BAR __builtin_amdgcn_s_barrier()
#define PG8_SCHED __builtin_amdgcn_sched_barrier(0)
#define PG8_ABASE(u) ((const char*)g.A + ((size_t)((u).pn / g.a_div) * g.a_gstride) * 2 + (size_t)(u).pm * 2 * hstepA + (size_t)(u).ks * KSS * 2)
#define PG8_BBASE(u) ((const char*)g.Bt + (size_t)((u).pn % g.b_mod) * 2 * hstepB + ((size_t)((u).pn / g.b_mod) * g.b_gcol + (size_t)(u).ks * KSS) * 2)
#define PG8_AT(tt) (AGRP ? (size_t)((tt) / (AGRP ? AGRP : 1)) * g.a_kgs + (size_t)((tt) % (AGRP ? AGRP : 1)) * kstep : (size_t)(tt) * kstep)
    Unit cur, nxt; int ui = 0;
    if (!S.next(0, cur)) return;
    f32x4 acc[2][2][4][2];
#pragma unroll
    for (int a = 0; a < 2; ++a)
#pragma unroll
        for (int b = 0; b < 2; ++b)
#pragma unroll
            for (int m = 0; m < 4; ++m)
#pragma unroll
                for (int n = 0; n < 2; ++n) acc[a][b][m][n] = (f32x4){0.f, 0.f, 0.f, 0.f};
    bf16x8 At[4][2], B0[2][2], B1[2][2];
    const char* cA = PG8_ABASE(cur); const char* cB = PG8_BBASE(cur);
    if constexpr (SP2) {
        PG8_STAGE(PG8_SB(0, 0), cB, voffB); PG8_STAGE(PG8_SB(0, 1), cB + hstepB, voffB); PG8_STAGE(PG8_SA(0, 0), cA, voffA); PG8_STAGE(PG8_SA(0, 1), cA + hstepA, voffA);
        if (wr == 1) PG8_BAR;
        PG8_WAIT_V(2); PG8_BAR;
        PG8_STAGE(PG8_SB(1, 0), cB + kstep, voffB); PG8_STAGE(PG8_SA(1, 0), cA + kstep, voffA); PG8_STAGE(PG8_SB(1, 1), cB + hstepB + kstep, voffB);
        PG8_WAIT_V(6); PG8_BAR;
    } else {
        PG8_STAGE(PG8_SB(0, 0), cB, voffB); PG8_STAGE(PG8_SA(0, 0), cA, voffA); PG8_STAGE(PG8_SB(0, 1), cB + hstepB, voffB); PG8_STAGE(PG8_SA(0, 1), cA + hstepA, voffA);
        if (wr == 1) PG8_BAR;
        PG8_WAIT_V(4); PG8_BAR;
        PG8_STAGE(PG8_SB(1, 0), cB + kstep, voffB); PG8_STAGE(PG8_SA(1, 0), cA + kstep, voffA); PG8_STAGE(PG8_SB(1, 1), cB + hstepB + kstep, voffB);
        PG8_WAIT_V(6); PG8_BAR;
    }
    for (;;) {
        const bool has_next = S.next(ui + 1, nxt);
        const char* nA = has_next ? PG8_ABASE(nxt) : cA; const char* nB = has_next ? PG8_BBASE(nxt) : cB;
#pragma unroll 1
        for (int t = 0; t < nt; t += 2) {
            const bool last = (t == nt - 2);
            const char* a1 = cA + PG8_AT(t + 1);
            const char* a2 = last ? nA : cA + PG8_AT(t + 2); const char* b2 = last ? nB : cB + (size_t)(t + 2) * kstep;
            const char* a3 = last ? nA + kstep : cA + PG8_AT(t + 3); const char* b3 = b2 + kstep;
            if constexpr (SP2) {
            PG8_LDB(B0, 0, 0); PG8_LDB(B1, 0, 1); PG8_SCHED; PG8_LDA(At, 0, 0); PG8_STAGE(PG8_SA(1, 1), a1 + hstepA, voffA);
            PG8_WAIT_V(8); PG8_WAIT_L(0); PG8_BAR;
            if constexpr (Epi::MIDK) { if (t > 0 && (t % (AGRP ? AGRP : 1)) == 0) { int fr3 = fr, fq3 = fq; asm volatile("" : "+v"(fr3), "+v"(fq3)); E.mid(acc, cur, t / (AGRP ? AGRP : 1), wr, wc, fr3, fq3); } }
            PG8_MMA(0, 0, At, B0); PG8_MMA(0, 1, At, B1); PG8_BAR; PG8_SCHED;
            PG8_LDA(At, 0, 1); PG8_STAGE(PG8_SB(0, 0), b2, voffB); PG8_STAGE(PG8_SB(0, 1), b2 + hstepB, voffB); PG8_STAGE(PG8_SA(0, 0), a2, voffA);
            PG8_WAIT_V(8); PG8_WAIT_L(0); PG8_BAR; PG8_MMA(1, 0, At, B0); PG8_MMA(1, 1, At, B1); PG8_BAR; PG8_SCHED;
            PG8_LDB(B0, 1, 0); PG8_LDB(B1, 1, 1); PG8_SCHED; PG8_LDA(At, 1, 0); PG8_STAGE(PG8_SA(0, 1), a2 + hstepA, voffA);
            PG8_WAIT_V(8); PG8_WAIT_L(0); PG8_BAR; PG8_MMA(0, 0, At, B0); PG8_MMA(0, 1, At, B1); PG8_BAR; PG8_SCHED;
            PG8_LDA(At, 1, 1); PG8_STAGE(PG8_SB(1, 0), b3, voffB); PG8_STAGE(PG8_SB(1, 1), b3 + hstepB, voffB); PG8_STAGE(PG8_SA(1, 0), a3, voffA);
            PG8_WAIT_V(8); PG8_WAIT_L(0); PG8_BAR; PG8_MMA(1, 0, At, B0); PG8_MMA(1, 1, At, B1); PG8_BAR; PG8_SCHED;
            } else {
            PG8_LDB(B0, 0, 0); PG8_SCHED; PG8_LDA(At, 0, 0); PG8_STAGE(PG8_SA(1, 1), a1 + hstepA, voffA);
            PG8_WAIT_L(8); PG8_BAR; PG8_WAIT_L(0); PG8_MMA(0, 0, At, B0); PG8_BAR; PG8_SCHED;
            PG8_LDB(B1, 0, 1); PG8_STAGE(PG8_SB(0, 0), b2, voffB);
            PG8_BAR; PG8_WAIT_L(0); PG8_MMA(0, 1, At, B1); PG8_BAR;
            PG8_LDA(At, 0, 1); PG8_STAGE(PG8_SA(0, 0), a2, voffA);
            PG8_BAR; PG8_WAIT_L(0); PG8_MMA(1, 0, At, B0); PG8_BAR; PG8_SCHED;
            PG8_STAGE(PG8_SB(0, 1), b2 + hstepB, voffB);
            PG8_WAIT_V(6); PG8_BAR; PG8_MMA(1, 1, At, B1); PG8_BAR;
            PG8_LDB(B0, 1, 0); PG8_SCHED; PG8_LDA(At, 1, 0); PG8_STAGE(PG8_SA(0, 1), a2 + hstepA, voffA);
            PG8_WAIT_L(8); PG8_BAR; PG8_WAIT_L(0); PG8_MMA(0, 0, At, B0); PG8_BAR; PG8_SCHED;
            PG8_LDB(B1, 1, 1); PG8_STAGE(PG8_SB(1, 0), b3, voffB);
            PG8_BAR; PG8_WAIT_L(0); PG8_MMA(0, 1, At, B1); PG8_BAR;
            PG8_LDA(At, 1, 1); PG8_STAGE(PG8_SA(1, 0), a3, voffA);
            PG8_BAR; PG8_WAIT_L(0); PG8_MMA(1, 0, At, B0); PG8_BAR; PG8_SCHED;
            PG8_STAGE(PG8_SB(1, 1), b3 + hstepB, voffB);
            PG8_WAIT_V(6); PG8_BAR; PG8_MMA(1, 1, At, B1); PG8_BAR;
            }
        }
        if constexpr (ALIGN_EPI) { if (wr == 0) PG8_BAR; }
        { int fr2 = fr, fq2 = fq; asm volatile("" : "+v"(fr2), "+v"(fq2));
          E(acc, cur, wr, wc, fr2, fq2); }
        if (!has_next) break;
#pragma unroll
        for (int a = 0; a < 2; ++a)
#pragma unroll
            for (int b = 0; b < 2; ++b)
#pragma unroll
                for (int m = 0; m < 4; ++m)
#pragma unroll
                    for (int n = 0; n < 2; ++n) acc[a][b][m][n] = (f32x4){0.f, 0.f, 0.f, 0.f};
        cur = nxt; cA = nA; cB = nB; ++ui;
        if constexpr (ALIGN_EPI) { if (wr == 1) PG8_BAR; }
    }
    PG8_WAIT_V(0);
    if constexpr (!ALIGN_EPI) { if (wr == 0) PG8_BAR; }
    PG8_BAR;
#undef PG8_SA
#undef PG8_SB
#undef PG8_STAGE
#undef PG8_LDA
#undef PG8_LDB
#undef PG8_MMA
#undef PG8_WAIT_V
#undef PG8_WAIT_L
#undef PG8_BAR
#undef PG8_SCHED
#undef PG8_ABASE
#undef PG8_BBASE
#undef PG8_AT
}

struct EpiSwiGLU {
    static constexpr bool PERM = true, MIDK = false;
    bf16_t* O;
    __device__ __forceinline__ void operator()(const f32x4 (&acc)[2][2][4][2], const Unit& u, int wr, int wc, int fr, int fq) const {
        const int row0 = u.pm * BM + wr * 64 + fr, col0 = u.pn * HALF + wc * 32 + 8 * fq;
#pragma unroll
        for (int ai = 0; ai < 2; ++ai)
#pragma unroll
            for (int m = 0; m < 4; ++m) {
                bf16_t* rowp = O + (size_t)(row0 + ai * HALF + m * 16) * DFF + col0;
                float o[8];
#pragma unroll
                for (int n = 0; n < 2; ++n)
#pragma unroll
                    for (int j = 0; j < 4; ++j) { const float a = acc[ai][0][m][n][j], b = acc[ai][1][m][n][j]; o[n * 4 + j] = a / (1.0f + __expf(-a)) * b; }
                u32x4 w; w.x = cvt_pk_bf16(o[0], o[1]); w.y = cvt_pk_bf16(o[2], o[3]); w.z = cvt_pk_bf16(o[4], o[5]); w.w = cvt_pk_bf16(o[6], o[7]);
                *(u32x4*)rowp = w;
            }
    }
};
template <bool HALFGATE> struct EpiResid {
    static constexpr bool PERM = false, MIDK = false;
    float* X; const float* gate_lat; const float* gate_ctx; float* out; const float* base;
    __device__ __forceinline__ void operator()(const f32x4 (&acc)[2][2][4][2], const Unit& u, int wr, int wc, int fr, int fq) const {
        const int row0 = u.pm * BM + wr * 64 + fr, col0 = u.pn * BM + wc * 32 + 4 * fq;
        const float* gp = (u.pm * BM >= SEQ) ? gate_ctx : gate_lat;
#pragma unroll
        for (int bj = 0; bj < 2; ++bj)
#pragma unroll
            for (int n = 0; n < 2; ++n) {
                const f32x4 gv = *(const f32x4*)(gp + col0 + bj * HALF + n * 16) * (HALFGATE ? 0.5f : 1.0f);
#pragma unroll
                for (int ai = 0; ai < 2; ++ai)
#pragma unroll
                    for (int m = 0; m < 4; ++m) {
                        const int row = row0 + ai * HALF + m * 16;
                        float* p = X + (size_t)row * D + col0 + bj * HALF + n * 16;
                        const f32x4 v = *(const f32x4*)(base + (size_t)row * D + col0 + bj * HALF + n * 16) + gv * acc[ai][bj][m][n];
                        *(f32x4*)p = v;
                        if (out != nullptr && row < SEQ) *(f32x4*)(out + (size_t)row * D + col0 + bj * HALF + n * 16) = v;
                    }
            }
    }
};
template <bool HALFGATE> struct EpiPart {
    static constexpr bool PERM = false, MIDK = false;
    float* PART; const float* gate_ctx;
    __device__ __forceinline__ void operator()(const f32x4 (&acc)[2][2][4][2], const Unit& u, int wr, int wc, int fr, int fq) const {
        const int row0 = wr * 64 + fr, col0 = u.pn * BM + wc * 32 + 4 * fq;
        f32x4 gv[2][2];
#pragma unroll
        for (int bj = 0; bj < 2; ++bj)
#pragma unroll
            for (int n = 0; n < 2; ++n) gv[bj][n] = *(const f32x4*)(gate_ctx + col0 + bj * HALF + n * 16) * (HALFGATE ? 0.5f : 1.0f);
#pragma unroll
        for (int ai = 0; ai < 2; ++ai)
#pragma unroll
            for (int m = 0; m < 4; ++m) {
                float* rowp = PART + ((size_t)u.ks * BM + row0 + ai * HALF + m * 16) * D + col0;
#pragma unroll
                for (int bj = 0; bj < 2; ++bj)
#pragma unroll
                    for (int n = 0; n < 2; ++n) *(f32x4*)(rowp + bj * HALF + n * 16) = gv[bj][n] * acc[ai][bj][m][n];
            }
    }
};
struct EpiWin {
    static constexpr bool PERM = true, MIDK = false;
    float* P32; bf16_t* PA; bf16_t* GL; long pn_off;
    __device__ __forceinline__ void operator()(const f32x4 (&acc)[2][2][4][2], const Unit& u0, int wr, int wc, int fr, int fq) const {
        Unit u; u.pm = u0.pm; u.pn = u0.pn + (int)pn_off;
        const int row0 = u.pm * BM + wr * 64 + fr, cin = wc * 32 + 8 * fq;
        if (u.pn < 19) {
#pragma unroll
            for (int ai = 0; ai < 2; ++ai)
#pragma unroll
                for (int m = 0; m < 4; ++m) { float* rowp = P32 + (size_t)(row0 + ai * HALF + m * 16) * P32W + u.pn * BM + cin;
#pragma unroll
                    for (int bj = 0; bj < 2; ++bj) { *(f32x4*)(rowp + bj * HALF) = acc[ai][bj][m][0]; *(f32x4*)(rowp + bj * HALF + 4) = acc[ai][bj][m][1]; } }
        } else {
            bf16_t* base; int ld, colt;
            if (u.pn < 28) { base = PA; ld = PAW; colt = (u.pn - 19) * BM; } else { base = GL; ld = GLW; colt = (u.pn - 28) * BM; }
#pragma unroll
            for (int ai = 0; ai < 2; ++ai)
#pragma unroll
                for (int m = 0; m < 4; ++m) { bf16_t* rowp = base + (size_t)(row0 + ai * HALF + m * 16) * ld + colt + cin;
#pragma unroll
                    for (int bj = 0; bj < 2; ++bj) { const f32x4 v0 = acc[ai][bj][m][0], v1 = acc[ai][bj][m][1];
                        u32x4 w; w.x = cvt_pk_bf16(v0[0], v0[1]); w.y = cvt_pk_bf16(v0[2], v0[3]); w.z = cvt_pk_bf16(v1[0], v1[1]); w.w = cvt_pk_bf16(v1[2], v1[3]);
                        *(u32x4*)(rowp + bj * HALF) = w; } }
        }
    }
};
struct EpiMerge {
    static constexpr bool PERM = true, MIDK = false;
    const bf16_t* GL; bf16_t* PROJ;
    __device__ __forceinline__ void operator()(const f32x4 (&acc)[2][2][4][2], const Unit& u, int wr, int wc, int fr, int fq) const {
        const int row0 = u.pm * BM + wr * 64 + fr, col0 = u.pn * BM + wc * 32 + 8 * fq;
#pragma unroll
        for (int ai = 0; ai < 2; ++ai)
#pragma unroll
            for (int m = 0; m < 4; ++m) { const size_t ro = (size_t)(row0 + ai * HALF + m * 16) * GLW + col0;
#pragma unroll
                for (int bj = 0; bj < 2; ++bj) {
                    const u32x4 gw = *(const u32x4*)(GL + ro + bj * HALF);
                    const f32x4 v0 = acc[ai][bj][m][0], v1 = acc[ai][bj][m][1];
                    float o[8];
                    o[0] = v0[0] / (1.0f + __expf(-bf2f(gw.x & 0xffffu))); o[1] = v0[1] / (1.0f + __expf(-bf2f(gw.x >> 16)));
                    o[2] = v0[2] / (1.0f + __expf(-bf2f(gw.y & 0xffffu))); o[3] = v0[3] / (1.0f + __expf(-bf2f(gw.y >> 16)));
                    o[4] = v1[0] / (1.0f + __expf(-bf2f(gw.z & 0xffffu))); o[5] = v1[1] / (1.0f + __expf(-bf2f(gw.z >> 16)));
                    o[6] = v1[2] / (1.0f + __expf(-bf2f(gw.w & 0xffffu))); o[7] = v1[3] / (1.0f + __expf(-bf2f(gw.w >> 16)));
                    u32x4 w; w.x = cvt_pk_bf16(o[0], o[1]); w.y = cvt_pk_bf16(o[2], o[3]); w.z = cvt_pk_bf16(o[4], o[5]); w.w = cvt_pk_bf16(o[6], o[7]);
                    *(u32x4*)(PROJ + ro + bj * HALF) = w; } }
    }
};
struct EpiMergeF {
    static constexpr bool PERM = true, MIDK = true;
    const bf16_t* GL; bf16_t* MG;
    __device__ __forceinline__ void mid(f32x4 (&acc)[2][2][4][2], const Unit& u, int g, int wr, int wc, int fr, int fq) const {
        const int row0 = u.pm * BM + wr * 64 + fr, col0 = u.pn * BM + wc * 32 + 8 * fq;
#pragma unroll
        for (int ai = 0; ai < 2; ++ai)
#pragma unroll
            for (int m = 0; m < 4; ++m) { const bf16_t* gp = GL + (size_t)(row0 + ai * HALF + m * 16) * GLW + (size_t)(g - 1) * D + col0;
#pragma unroll
                for (int bj = 0; bj < 2; ++bj) {
                    const u32x4 ga = *(const u32x4*)(gp + bj * HALF), gb = *(const u32x4*)(gp + D + bj * HALF);
                    const unsigned wa[4] = {ga.x, ga.y, ga.z, ga.w}, wb[4] = {gb.x, gb.y, gb.z, gb.w};
#pragma unroll
                    for (int j = 0; j < 4; ++j) {
                        const float r0 = (1.0f + __expf(-bf2f(wb[j] & 0xffffu))) * __builtin_amdgcn_rcpf(1.0f + __expf(-bf2f(wa[j] & 0xffffu)));
                        const float r1 = (1.0f + __expf(-bf2f(wb[j] >> 16))) * __builtin_amdgcn_rcpf(1.0f + __expf(-bf2f(wa[j] >> 16)));
                        acc[ai][bj][m][j >> 1][(j & 1) * 2] *= r0; acc[ai][bj][m][j >> 1][(j & 1) * 2 + 1] *= r1;
                    }
                }
            }
    }
    __device__ __forceinline__ void operator()(const f32x4 (&acc)[2][2][4][2], const Unit& u, int wr, int wc, int fr, int fq) const {
        const int row0 = u.pm * BM + wr * 64 + fr, col0 = u.pn * BM + wc * 32 + 8 * fq;
#pragma unroll
        for (int ai = 0; ai < 2; ++ai)
#pragma unroll
            for (int m = 0; m < 4; ++m) { const int row = row0 + ai * HALF + m * 16;
#pragma unroll
                for (int bj = 0; bj < 2; ++bj) {
                    const u32x4 gw = *(const u32x4*)(GL + (size_t)row * GLW + 3 * D + col0 + bj * HALF);
                    const unsigned wg[4] = {gw.x, gw.y, gw.z, gw.w};
                    float o[8];
#pragma unroll
                    for (int j = 0; j < 4; ++j) {
                        o[2 * j] = acc[ai][bj][m][j >> 1][(j & 1) * 2] * __builtin_amdgcn_rcpf(1.0f + __expf(-bf2f(wg[j] & 0xffffu)));
                        o[2 * j + 1] = acc[ai][bj][m][j >> 1][(j & 1) * 2 + 1] * __builtin_amdgcn_rcpf(1.0f + __expf(-bf2f(wg[j] >> 16)));
                    }
                    u32x4 w; w.x = cvt_pk_bf16(o[0], o[1]); w.y = cvt_pk_bf16(o[2], o[3]); w.z = cvt_pk_bf16(o[4], o[5]); w.w = cvt_pk_bf16(o[6], o[7]);
                    *(u32x4*)(MG + (size_t)row * D + col0 + bj * HALF) = w; } }
    }
};
}

enum { I_X = 0, I_C, I_CTX, I_CCTX, I_ADAW, I_ADAB, I_NF1, I_NMIX, I_NF2, I_F1WI, I_F1WO, I_F2WI, I_F2WO, I_WIN, I_HGLB, I_HGNORM, I_RWSHIFT, I_RWW0, I_RWW2, I_RWA0, I_RWA2,
       I_RWKK, I_RWKA, I_RWRK, I_RWLNW, I_RWLNB, I_NAQN, I_NAKN, I_NARPB, I_WAQN, I_WAKN, I_WASINK, I_WBR, I_WOUT, N_IN };
struct Args { const float* in[N_IN]; float* out; unsigned char* ws; int ph_lo, ph_hi; };
struct Ctx {
    LAS unsigned char* lds;
    int tid, lane, wave, bid, G;
    const Args __attribute__((address_space(4)))* ka; float* out; unsigned char* ws;
};
#define WSP(T, off) ((T*)(C.ws + (off)))
__device__ __forceinline__ void relaunder(Ctx& C) {
    int t = C.tid, b = C.bid, g = C.G;
    asm volatile("" : "+v"(t), "+v"(b), "+v"(g));
    C.tid = t; C.lane = t & 63; C.wave = __builtin_amdgcn_readfirstlane(t >> 6); C.bid = __builtin_amdgcn_readfirstlane(b); C.G = __builtin_amdgcn_readfirstlane(g);
}

__device__ __forceinline__ void transpose_item(const float* W, int K, int N, bf16_t* WT, int mode, LAS float* scr, int item, int lane, int ldw = 0, int coff = 0) {
    if (ldw == 0) ldw = K;
    const int nblk = N / 32, kb = item / nblk, nb = item % nblk, k0 = 64 * kb, n0 = 32 * nb;
    int drow0 = n0;
    if (mode == 1) { const int half = n0 / DFF, j0 = n0 % DFF; drow0 = 256 * (j0 / 128) + 128 * half + (j0 % 128); }
    { const int kr = lane >> 3, n4 = lane & 7;
      f32x4 v[8];
#pragma unroll
      for (int i = 0; i < 8; ++i) v[i] = *(const f32x4*)(W + (size_t)(k0 + 8 * i + kr) * N + n0 + 4 * n4);
#pragma unroll
      for (int i = 0; i < 8; ++i)
#pragma unroll
          for (int j = 0; j < 4; ++j) scr[(8 * i + kr) * 33 + 4 * n4 + j] = v[i][j]; }
    LDS_WAIT(); asm volatile("" ::: "memory");
    const int c = lane & 7;
#pragma unroll
    for (int j = 0; j < 4; ++j) { const int n = (lane >> 3) + 8 * j; const LAS float* s = scr + (8 * c) * 33 + n;
        u32x4 o; o.x = pk2(s[0 * 33], s[1 * 33]); o.y = pk2(s[2 * 33], s[3 * 33]); o.z = pk2(s[4 * 33], s[5 * 33]); o.w = pk2(s[6 * 33], s[7 * 33]);
        *(u32x4*)(WT + (size_t)(drow0 + n) * ldw + coff + k0 + 8 * c) = o; }
    LDS_WAIT(); asm volatile("" ::: "memory");
}
constexpr int CV_WI = (D / 64) * (2 * DFF / 32), CV_WO = (DFF / 64) * (D / 32), CV_IN = (D / 64) * (PTOT / 32), CV_BR = (512 / 64) * (D / 32), CV_OUT = (D / 64) * (D / 32);
constexpr int CV_O_WI1 = 0, CV_O_WI2 = CV_WI, CV_O_WO1 = 2 * CV_WI, CV_O_WO2 = CV_O_WO1 + CV_WO, CV_O_IN = CV_O_WO2 + CV_WO, CV_O_BR = CV_O_IN + CV_IN, CV_O_OUT = CV_O_BR + 4 * CV_BR, CV_N = CV_O_OUT + CV_OUT;
constexpr int CV_Q_WI1 = 68 * 8 * 16, CV_Q_IN = 84 * 8 * 16, CV_Q_WI2 = 84 * 8 * 16;
static_assert(CV_Q_WI1 <= CV_WI && CV_Q_IN <= CV_IN && CV_Q_WI2 <= CV_WI, "quotas");
__device__ __forceinline__ void phase_convert(Ctx& C, int l, int mask, int b0, int nbk, int it_lo = 0, int it_hi = CV_N) {
    LAS float* scr = (LAS float*)(C.lds + C.wave * 16384);
    const int gw = b0 * NWAVES + C.wave, NGW = nbk * NWAVES;
    constexpr int I_WI = (D / 64) * (2 * DFF / 32), I_WO = (DFF / 64) * (D / 32), I_IN = (D / 64) * (PTOT / 32), I_BR = (512 / 64) * (D / 32), I_OUT = (D / 64) * (D / 32);
    constexpr int NITEMS = 2 * I_WI + 2 * I_WO + I_IN + 4 * I_BR + I_OUT;
    static_assert(NITEMS == CV_N && I_WI == CV_WI && I_WO == CV_WO && I_IN == CV_IN && I_BR == CV_BR, "item enumeration");
    for (int it = it_lo + gw; it < it_hi; it += NGW) {
        int r = it;
        if (r < I_WI) { if (mask & 1) transpose_item(C.ka->in[I_F1WI] + (size_t)l * D * 2 * DFF, D, 2 * DFF, WSP(bf16_t, OFF_WI1), 1, scr, r, C.lane); continue; } r -= I_WI;
        if (r < I_WI) { if (mask & 2) transpose_item(C.ka->in[I_F2WI] + (size_t)l * D * 2 * DFF, D, 2 * DFF, WSP(bf16_t, OFF_WI2), 1, scr, r, C.lane); continue; } r -= I_WI;
        if (r < I_WO) { if (mask & 4) transpose_item(C.ka->in[I_F1WO] + (size_t)l * DFF * D, DFF, D, WSP(bf16_t, OFF_WO1), 0, scr, r, C.lane); continue; } r -= I_WO;
        if (r < I_WO) { if (mask & 8) transpose_item(C.ka->in[I_F2WO] + (size_t)l * DFF * D, DFF, D, WSP(bf16_t, OFF_WO2), 0, scr, r, C.lane); continue; } r -= I_WO;
        if (r < I_IN) { if (mask & 16) transpose_item(C.ka->in[I_WIN] + (size_t)l * D * PTOT, D, PTOT, WSP(bf16_t, OFF_WIN), 0, scr, r, C.lane); continue; } r -= I_IN;
        if (r < 4 * I_BR) { const int g = r / I_BR; if (mask & 32) transpose_item(C.ka->in[I_WBR] + ((size_t)l * 4 + g) * 512 * D, 512, D, WSP(bf16_t, OFF_WBR), 0, scr, r % I_BR, C.lane, 4 * 512, g * 512); continue; } r -= 4 * I_BR;
        if (mask & 64) transpose_item(C.ka->in[I_WOUT] + (size_t)l * D * D, D, D, WSP(bf16_t, OFF_WOUT), 0, scr, r, C.lane);
    }
    if (!(mask & 64)) return;
    bf16_t* W2T = WSP(bf16_t, OFF_W2T);
    for (int idx = b0 * NT + C.tid; idx < 2 * 2 * 512 * 8; idx += nbk * NT) {
        const int k8 = idx & 7, col = (idx >> 3) & 511, m = (idx >> 12) & 1, d = idx >> 13;
        const float* src = (m == 0 ? C.ka->in[I_RWW2] : C.ka->in[I_RWA2]) + ((size_t)(l * 2 + d) * 64 + 8 * k8) * 512 + col;
        u32x4 w; w.x = pk2(src[0], src[512]); w.y = pk2(src[1024], src[1536]); w.z = pk2(src[2048], src[2560]); w.w = pk2(src[3072], src[3584]);
        *(u32x4*)(W2T + ((size_t)((d * 2 + m) * 512 + col) * 64 + 8 * k8)) = w;
    }
}

__device__ __forceinline__ void phase_ada_partial(Ctx& C) {
    float* modp = WSP(float, OFF_MODP);
    for (int u = C.bid; u < DEPTH * 9 * KSPLIT; u += C.G) {
        const int l = u / (9 * KSPLIT), rem = u % (9 * KSPLIT), cg = rem / KSPLIT, ks = rem % KSPLIT;
        const int col = cg * 2048 + C.tid * 4;
        const float* W = C.ka->in[I_ADAW] + (size_t)l * D * MODW;
        f32x4 a0 = {0.f, 0.f, 0.f, 0.f}, a1 = {0.f, 0.f, 0.f, 0.f};
#pragma unroll 16
        for (int i = ks * 64; i < ks * 64 + 64; ++i) {
            const float c0 = C.ka->in[I_C][i], c1 = C.ka->in[I_CCTX][i];
            const float s0 = siluf_(c0), s1 = siluf_(c1);
            const f32x4 w = *(const f32x4*)(W + (size_t)i * MODW + col);
            a0 += w * s0; a1 += w * s1;
        }
        *(f32x4*)(modp + ((size_t)(l * KSPLIT + ks) * 2 + 0) * MODW + col) = a0;
        *(f32x4*)(modp + ((size_t)(l * KSPLIT + ks) * 2 + 1) * MODW + col) = a1;
    }
}
__device__ __forceinline__ void phase_ada_reduce(Ctx& C) {
    const float* modp = WSP(float, OFF_MODP); float* mod = WSP(float, OFF_MOD);
    for (int e = C.bid * NT + C.tid; e < DEPTH * 2 * MODW; e += C.G * NT) {
        const int l = e / (2 * MODW), s = (e / MODW) % 2, j = e % MODW;
        float a = C.ka->in[I_ADAB][(size_t)l * MODW + j];
        for (int ks = 0; ks < KSPLIT; ++ks) a += modp[((size_t)(l * KSPLIT + ks) * 2 + s) * MODW + j];
        mod[e] = a;
    }
}
__device__ __forceinline__ const float* mod_ptr(Ctx& C, int l, int s, int idx) { return WSP(float, OFF_MOD) + ((size_t)(l * 2 + s) * NMOD + idx) * D; }

__device__ __forceinline__ void phase_norm(Ctx& C, int l, const float* gw  , int shift_idx, int nparts, int rows, int src) {
    const int gwv = C.bid * NWAVES + C.wave, NGW = C.G * NWAVES;
    float* X = WSP(float, OFF_X); bf16_t* H = WSP(bf16_t, OFF_H); const float* PART = WSP(float, OFF_P32);
    for (int r = gwv; r < rows; r += NGW) {
        const int s = r >= SEQ ? 1 : 0;
        const float* sh = mod_ptr(C, l, s, shift_idx); const float* sc = mod_ptr(C, l, s, shift_idx + 1);
        f32x4* xr = (f32x4*)(X + (size_t)r * D) + C.lane;
        const f32x4* xin = (src == 0 || (src == 2 && s == 0)) ? (const f32x4*)xr : (s == 0 ? (const f32x4*)(C.ka->in[I_X] + (size_t)r * D) + C.lane : (const f32x4*)(C.ka->in[I_CTX] + (size_t)(r - SEQ) * D) + C.lane);
        f32x4 v[8]; float ss = 0.f;
#pragma unroll
        for (int j = 0; j < 8; ++j) v[j] = xin[64 * j];
        if (s == 1 && nparts > 0) {
            for (int ks = 0; ks < nparts; ++ks) {
                const f32x4* pr = (const f32x4*)(PART + ((size_t)ks * 256 + (r - SEQ)) * D) + C.lane;
#pragma unroll
                for (int j = 0; j < 8; ++j) v[j] += pr[64 * j];
            }
#pragma unroll
            for (int j = 0; j < 8; ++j) xr[64 * j] = v[j];
        }
#pragma unroll
        for (int j = 0; j < 8; ++j) ss += (v[j].x * v[j].x + v[j].y * v[j].y) + (v[j].z * v[j].z + v[j].w * v[j].w);
        const float rstd = rsqrtf(wave_sum(ss) * (1.0f / D) + EPS);
        u32x2* o8 = (u32x2*)(H + (size_t)r * D) + C.lane;
#pragma unroll
        for (int j = 0; j < 8; ++j) {
            const int c = (64 * j + C.lane) * 4;
            const f32x4 g4 = *(const f32x4*)(gw + c), s4 = *(const f32x4*)(sc + c), h4 = *(const f32x4*)(sh + c);
            const f32x4 y = (v[j] * rstd) * g4 * (s4 + 1.0f) + h4;
            u32x2 w; w.x = pk2(y.x, y.y); w.y = pk2(y.z, y.w); o8[64 * j] = w;
        }
    }
}

__device__ __forceinline__ float wave_sum_fast(float x);
__device__ __forceinline__ void phase_norm_ctx(Ctx& C, int l, const float* gw, int shift_idx, int nparts, int src) {
    float* X = WSP(float, OFF_X); bf16_t* H = WSP(bf16_t, OFF_H); const float* PART = WSP(float, OFF_P32);
    LAS float* red = (LAS float*)(C.lds + 135168);
    const float* sh = mod_ptr(C, l, 1, shift_idx); const float* sc = mod_ptr(C, l, 1, shift_idx + 1);
    for (int rr = C.bid; rr < CTX; rr += C.G) {
        const int r = SEQ + rr, col = C.wave * 256 + C.lane * 4;
        f32x4 v = src == 0 ? *(const f32x4*)(X + (size_t)r * D + col) : *(const f32x4*)(C.ka->in[I_CTX] + (size_t)rr * D + col);
        if (nparts > 0) {
            for (int k0 = 0; k0 < nparts; k0 += 11) {
                f32x4 p[11];
#pragma unroll
                for (int j = 0; j < 11; ++j) { const int ks = k0 + j < nparts ? k0 + j : k0; p[j] = *(const f32x4*)(PART + ((size_t)ks * 256 + rr) * D + col); }
#pragma unroll
                for (int j = 0; j < 11; ++j) if (k0 + j < nparts) v += p[j];
            }
            *(f32x4*)(X + (size_t)r * D + col) = v;
        }
        const float ss = wave_sum_fast((v.x * v.x + v.y * v.y) + (v.z * v.z + v.w * v.w));
        __syncthreads();
        if (C.lane == 0) red[C.wave] = ss;
        __syncthreads();
        float tot = 0.f;
#pragma unroll
        for (int w = 0; w < 8; ++w) tot += red[w];
        const float rstd = rsqrtf(tot * (1.0f / D) + EPS);
        const f32x4 y = (v * rstd) * (*(const f32x4*)(gw + col)) * (*(const f32x4*)(sc + col) + 1.0f) + *(const f32x4*)(sh + col);
        u32x2 w; w.x = pk2(y.x, y.y); w.y = pk2(y.z, y.w);
        *(u32x2*)(H + (size_t)r * D + col) = w;
    }
}

__device__ __forceinline__ float xrow_sum(float x) {
    auto s = __builtin_amdgcn_permlane16_swap(__float_as_uint(x), __float_as_uint(x), false, false);
    x = __uint_as_float(s[0]) + __uint_as_float(s[1]);
    auto t = __builtin_amdgcn_permlane32_swap(__float_as_uint(x), __float_as_uint(x), false, false);
    return __uint_as_float(t[0]) + __uint_as_float(t[1]);
}
template <int CTRL> __device__ __forceinline__ float dppf(float x) { return __builtin_bit_cast(float, __builtin_amdgcn_mov_dpp(__builtin_bit_cast(int, x), CTRL, 0xf, 0xf, true)); }
__device__ __forceinline__ float row16_sum(float x) { x += dppf<0xB1>(x); x += dppf<0x4E>(x); x += dppf<0x124>(x); x += dppf<0x128>(x); return x; }
__device__ __forceinline__ float wave_sum_fast(float x) { return xrow_sum(row16_sum(x)); }
#define WAVE_LDS_FENCE() asm volatile("s_waitcnt lgkmcnt(0)" ::: "memory")
__device__ __forceinline__ void phase_rw_prep(Ctx& C, int l, int b0, int nb) {
    constexpr int TB = 16;
    const float* P = WSP(float, OFF_P32); float* VV = WSP(float, OFF_VV); float* GS = WSP(float, OFF_GS); float* RO = WSP(float, OFF_RO); float* BON = WSP(float, OFF_BON);
    LAS float* lin = (LAS float*)C.lds;
    LAS unsigned char* wl = C.lds + 16384 + C.wave * 14592;
    LAS unsigned char* RA = wl; LAS float* MAT = (LAS float*)(wl + 10496);
    const float* taps = C.ka->in[I_RWSHIFT] + (size_t)l * 3 * RWC;
    const int c = C.tid, h = c >> 6, e = c & 63, lane = C.lane;
    const float kkw = C.ka->in[I_RWKK][l * 512 + c], kaw = C.ka->in[I_RWKA][l * 512 + c], rkw = C.ka->in[I_RWRK][l * 512 + c];
    for (int unit = b0; unit < 2 * RW_NCK; unit += nb) {
        const int d = unit & 1, sq_ = RW_NCK - 1 - (unit >> 1), grp = d == 0 ? (sq_ + RW_NCK - 16) % RW_NCK : RW_NCK - 1 - sq_;
        const int r0 = grp * TB;
        const bool hp0 = (r0 != 0 && r0 != SEQ), hnl = (r0 + TB != SEQ && r0 + TB != MT);
        __syncthreads();
        float raw[3][TB + 2];
        { int c_ = C.tid; asm volatile("" : "+v"(c_));
#pragma unroll
          for (int q = 0; q < 3; ++q) { const float* pc = P + (size_t)r0 * P32W + RW_OFF + q * 512 + c_;
              raw[q][0] = hp0 ? pc[-(long)P32W] : 0.f;
#pragma unroll
              for (int t = 0; t < TB; ++t) raw[q][t + 1] = pc[(size_t)t * P32W];
              raw[q][TB + 1] = hnl ? pc[(size_t)TB * P32W] : 0.f; } }
        { int c_ = C.tid; asm volatile("" : "+v"(c_)); const int c = c_;
        if (c < 128) {
            const int col = 2048 + (c < 64 ? d * 64 + c : 128 + d * 64 + (c - 64));
            const float t0 = taps[col], t1 = taps[RWC + col], t2 = taps[2 * RWC + col];
            const float* pc = P + (size_t)r0 * P32W + RW_OFF + col;
            float prev = hp0 ? pc[-(long)P32W] : 0.f, cur = pc[0];
#pragma unroll
            for (int t = 0; t < TB; ++t) {
                const float nxt = (t + 1 < TB || hnl) ? pc[(size_t)(t + 1) * P32W] : 0.f;
                const float v = t0 * prev + t1 * cur + t2 * nxt;
                *(LAS bf16_t*)((LAS unsigned char*)lin + ((c >> 6) * 16 + t) * 144 + 2 * (c & 63)) = (bf16_t)f2bf(c < 64 ? 1.0f - 2.0f * __builtin_amdgcn_rcpf(1.0f + __expf(2.0f * v)) : v);
                prev = cur; cur = nxt;
            }
        }
        if (d == 0) {
            const int col = 3 * 512 + c;
            const float t0 = taps[col], t1 = taps[RWC + col], t2 = taps[2 * RWC + col];
            const float* pc = P + (size_t)r0 * P32W + RW_OFF + col;
            float prev = hp0 ? pc[-(long)P32W] : 0.f, cur = pc[0];
#pragma unroll
            for (int t = 0; t < TB; ++t) {
                const float nxt = (t + 1 < TB || hnl) ? pc[(size_t)(t + 1) * P32W] : 0.f;
                const float v = t0 * prev + t1 * cur + t2 * nxt;
                GS[(size_t)(r0 + t) * 512 + c] = __builtin_amdgcn_rcpf(1.0f + __expf(-v));
                prev = cur; cur = nxt;
            }
        }
        }
        __syncthreads();
        {
            int ln_ = C.lane; asm volatile("" : "+v"(ln_));
            const int lane = ln_, e = ln_, c = h * 64 + ln_;
            const float zb = C.ka->in[I_RWW0][(l * 2 + d) * 512 + c], ab = C.ka->in[I_RWA0][(l * 2 + d) * 512 + c];
            float xr[TB], xk[TB], xv[TB], kkn[TB];
#pragma unroll
            for (int q = 0; q < 3; ++q) {
                const int col = q * 512 + c;
                const float t0 = taps[col], t1 = taps[RWC + col], t2 = taps[2 * RWC + col];
#pragma unroll
                for (int t = 0; t < TB; ++t) {
                    const float v = t0 * raw[q][t] + t1 * raw[q][t + 1] + t2 * raw[q][t + 2];
                    if (q == 0) xr[t] = v; else if (q == 1) xk[t] = v; else { xv[t] = v; if (d == 0) VV[(size_t)(r0 + t) * 512 + c] = v; }
                }
            }
#pragma unroll
            for (int t = 0; t < TB; ++t) { const float kk0 = xk[t] * kkw; kkn[t] = kk0 * rsqrtf(wave_sum_fast(kk0 * kk0) + EPS); }
            __builtin_amdgcn_sched_barrier(0);
            float At[TB], Rt[TB], Vs[TB];
            unsigned Btp[TB / 2], Ktp[TB / 2];
            float gam;
            {
                float z[TB], az[TB];
                {
                    const bf16_t* W2T = WSP(bf16_t, OFF_W2T);
                    LAS float* ZB = (LAS float*)RA;
                    const int tl = lane & 15, q4 = lane >> 4;
#pragma unroll
                    for (int m = 0; m < 2; ++m) {
                        bf16x8 af[2];
#pragma unroll
                        for (int s2 = 0; s2 < 2; ++s2) af[s2] = *(const LAS bf16x8*)((LAS unsigned char*)lin + (m * 16 + tl) * 144 + s2 * 64 + q4 * 16);
#pragma unroll
                        for (int nt4 = 0; nt4 < 4; ++nt4) {
                            const bf16_t* bp = W2T + ((size_t)((d * 2 + m) * 512 + h * 64 + 16 * nt4 + tl) * 64 + 8 * q4);
                            f32x4 a4 = {0.f, 0.f, 0.f, 0.f};
#pragma unroll
                            for (int s2 = 0; s2 < 2; ++s2) a4 = MFMA16(af[s2], *(const bf16x8*)(bp + 32 * s2), a4);
#pragma unroll
                            for (int reg = 0; reg < 4; ++reg) ZB[(m * 16 + 4 * q4 + reg) * 64 + 16 * nt4 + tl] = a4[reg];
                        }
                    }
                    WAVE_LDS_FENCE();
#pragma unroll
                    for (int t = 0; t < TB; ++t) { z[t] = zb + ZB[t * 64 + e]; az[t] = ab + ZB[(16 + t) * 64 + e]; }
                    WAVE_LDS_FENCE();
                }
                float g = 1.0f, btp = 0.f, ktp = 0.f;
#pragma unroll
                for (int i = 0; i < TB; ++i) {
                    const int t = d ? TB - 1 - i : i;
                    const float y = -z[t]; const float sp = fmaxf(y, 0.f) + __logf(1.0f + __expf(-fabsf(y)));
                    const float decay = __expf(-__expf(-sp - 0.5f));
                    const float a = __builtin_amdgcn_rcpf(1.0f + __expf(-az[t]));
                    const float kd = xk[t] * (1.0f + (a - 1.0f) * kaw);
                    { const float bsum = wave_sum_fast(xr[t] * kd * rkw);
                      if (lane == 0) BON[((size_t)d * MT + r0 + t) * 8 + h] = bsum; }
                    const float gm1 = g; g *= decay; const float ig = __builtin_amdgcn_rcpf(g);
                    const float at = -kkn[t] * gm1, bt = a * kkn[t] * ig, kt = kd * ig, rt = xr[t] * g;
                    At[i] = at; Rt[i] = rt; Vs[i] = xv[t];
                    *(LAS bf16_t*)(RA + 0 * 2304 + i * 144 + 2 * e) = (bf16_t)pg8::cvt_pk_bf16(at, at); *(LAS bf16_t*)(RA + 1 * 2304 + i * 144 + 2 * e) = (bf16_t)pg8::cvt_pk_bf16(bt, bt);
                    *(LAS bf16_t*)(RA + 2 * 2304 + i * 144 + 2 * e) = (bf16_t)pg8::cvt_pk_bf16(kt, kt); *(LAS bf16_t*)(RA + 3 * 2304 + i * 144 + 2 * e) = (bf16_t)pg8::cvt_pk_bf16(rt, rt);
                    if (i & 1) { Btp[i >> 1] = pg8::cvt_pk_bf16(btp, bt); Ktp[i >> 1] = pg8::cvt_pk_bf16(ktp, kt); } else { btp = bt; ktp = kt; }
                }
                gam = g;
            }
            __builtin_amdgcn_sched_barrier(0);
            WAVE_LDS_FENCE();
            {
                const int jl = lane & 15, q = lane >> 4;
                bf16x8 fa[2], fb[2], fk[2], fr[2];
#pragma unroll
                for (int s2 = 0; s2 < 2; ++s2) {
                    fa[s2] = *(const LAS bf16x8*)(RA + 0 * 2304 + jl * 144 + s2 * 64 + q * 16); fb[s2] = *(const LAS bf16x8*)(RA + 1 * 2304 + jl * 144 + s2 * 64 + q * 16);
                    fk[s2] = *(const LAS bf16x8*)(RA + 2 * 2304 + jl * 144 + s2 * 64 + q * 16); fr[s2] = *(const LAS bf16x8*)(RA + 3 * 2304 + jl * 144 + s2 * 64 + q * 16);
                }
                f32x4 gAL = {0.f, 0.f, 0.f, 0.f}, gBL = gAL, gP = gAL, gQ = gAL;
#pragma unroll
                for (int s2 = 0; s2 < 2; ++s2) { gAL = MFMA16(fa[s2], fb[s2], gAL); gBL = MFMA16(fa[s2], fk[s2], gBL); gP = MFMA16(fr[s2], fb[s2], gP); gQ = MFMA16(fr[s2], fk[s2], gQ); }
#pragma unroll
                for (int reg = 0; reg < 4; ++reg) { const int i = 4 * q + reg;
                    MAT[0 * 256 + i * 16 + jl] = jl < i ? gAL[reg] : 0.f; MAT[1 * 256 + i * 16 + jl] = jl < i ? gBL[reg] : 0.f;
                    MAT[2 * 256 + i * 16 + jl] = jl <= i ? gP[reg] : 0.f; MAT[3 * 256 + i * 16 + jl] = jl <= i ? gQ[reg] : 0.f; }
            }
            WAVE_LDS_FENCE();
            __builtin_amdgcn_sched_barrier(0);
            {
                u32x4 w0, w1;
                w0.x = Btp[0]; w0.y = Btp[1]; w0.z = Btp[2]; w0.w = Btp[3]; w1.x = Btp[4]; w1.y = Btp[5]; w1.z = Btp[6]; w1.w = Btp[7];
                *(LAS u32x4*)(RA + 0 * 2048 + e * 32) = w0; *(LAS u32x4*)(RA + 0 * 2048 + e * 32 + 16) = w1;
                w0.x = Ktp[0]; w0.y = Ktp[1]; w0.z = Ktp[2]; w0.w = Ktp[3]; w1.x = Ktp[4]; w1.y = Ktp[5]; w1.z = Ktp[6]; w1.w = Ktp[7];
                *(LAS u32x4*)(RA + 1 * 2048 + e * 32) = w0; *(LAS u32x4*)(RA + 1 * 2048 + e * 32 + 16) = w1;
#pragma unroll
                for (int i2 = 0; i2 < 4; ++i2) { w0[i2] = pg8::cvt_pk_bf16(Vs[2 * i2], Vs[2 * i2 + 1]); w1[i2] = pg8::cvt_pk_bf16(Vs[8 + 2 * i2], Vs[8 + 2 * i2 + 1]); }
                *(LAS u32x4*)(RA + 2 * 2048 + e * 32) = w0; *(LAS u32x4*)(RA + 2 * 2048 + e * 32 + 16) = w1;
                *(LAS float*)(RA + 10240 + 4 * e) = gam;
            }
            __builtin_amdgcn_sched_barrier(0);
            float Gv[TB];
            {
                float X1[TB];
#pragma unroll
                for (int i = 0; i < TB; ++i) {
                    __builtin_amdgcn_sched_barrier(0);
                    float al[16];
#pragma unroll
                    for (int g4 = 0; g4 < 4; ++g4) { const f32x4 u = *(const LAS f32x4*)(MAT + 0 * 256 + i * 16 + 4 * g4); al[4 * g4] = u.x; al[4 * g4 + 1] = u.y; al[4 * g4 + 2] = u.z; al[4 * g4 + 3] = u.w; }
                    float x1 = At[i];
#pragma unroll
                    for (int m = 0; m < TB; ++m) if (m < i) x1 = __builtin_fmaf(al[m], X1[m], x1);
                    X1[i] = x1;
                }
#pragma unroll
                for (int i = 0; i < TB; ++i) {
                    __builtin_amdgcn_sched_barrier(0);
                    float pm[16];
#pragma unroll
                    for (int g4 = 0; g4 < 4; ++g4) { const f32x4 u = *(const LAS f32x4*)(MAT + 2 * 256 + i * 16 + 4 * g4); pm[4 * g4] = u.x; pm[4 * g4 + 1] = u.y; pm[4 * g4 + 2] = u.z; pm[4 * g4 + 3] = u.w; }
                    float gv = Rt[i];
#pragma unroll
                    for (int m = 0; m < TB; ++m) if (m <= i) gv = __builtin_fmaf(pm[m], X1[m], gv);
                    Gv[i] = gv;
                }
                u32x4 w0, w1;
#pragma unroll
                for (int i2 = 0; i2 < 4; ++i2) { w0[i2] = pg8::cvt_pk_bf16(X1[2 * i2], X1[2 * i2 + 1]); w1[i2] = pg8::cvt_pk_bf16(X1[8 + 2 * i2], X1[8 + 2 * i2 + 1]); }
                *(LAS u32x4*)(RA + 3 * 2048 + e * 32) = w0; *(LAS u32x4*)(RA + 3 * 2048 + e * 32 + 16) = w1;
            }
            __builtin_amdgcn_sched_barrier(0);
            {
                float X2[TB];
#pragma unroll
                for (int i = 0; i < TB; ++i) {
                    __builtin_amdgcn_sched_barrier(0);
                    float al[16], bl[16];
#pragma unroll
                    for (int g4 = 0; g4 < 4; ++g4) { const f32x4 u = *(const LAS f32x4*)(MAT + 0 * 256 + i * 16 + 4 * g4), v = *(const LAS f32x4*)(MAT + 1 * 256 + i * 16 + 4 * g4);
                        al[4 * g4] = u.x; al[4 * g4 + 1] = u.y; al[4 * g4 + 2] = u.z; al[4 * g4 + 3] = u.w; bl[4 * g4] = v.x; bl[4 * g4 + 1] = v.y; bl[4 * g4 + 2] = v.z; bl[4 * g4 + 3] = v.w; }
                    float x2 = 0.f;
#pragma unroll
                    for (int m = 0; m < TB; ++m) if (m < i) { x2 = __builtin_fmaf(bl[m], Vs[m], x2); x2 = __builtin_fmaf(al[m], X2[m], x2); }
                    X2[i] = x2;
                }
#pragma unroll
                for (int i = 0; i < TB; ++i) {
                    __builtin_amdgcn_sched_barrier(0);
                    float pm[16], qm[16];
#pragma unroll
                    for (int g4 = 0; g4 < 4; ++g4) { const f32x4 u = *(const LAS f32x4*)(MAT + 2 * 256 + i * 16 + 4 * g4), v = *(const LAS f32x4*)(MAT + 3 * 256 + i * 16 + 4 * g4);
                        pm[4 * g4] = u.x; pm[4 * g4 + 1] = u.y; pm[4 * g4 + 2] = u.z; pm[4 * g4 + 3] = u.w; qm[4 * g4] = v.x; qm[4 * g4 + 1] = v.y; qm[4 * g4 + 2] = v.z; qm[4 * g4 + 3] = v.w; }
                    float o0 = 0.f;
#pragma unroll
                    for (int m = 0; m < TB; ++m) if (m <= i) { o0 = __builtin_fmaf(pm[m], X2[m], o0); o0 = __builtin_fmaf(qm[m], Vs[m], o0); }
                    RO[((size_t)d * MT + r0 + (d ? TB - 1 - i : i)) * 512 + c] = o0;
                }
                u32x4 w0, w1;
#pragma unroll
                for (int i2 = 0; i2 < 4; ++i2) { w0[i2] = pg8::cvt_pk_bf16(X2[2 * i2], X2[2 * i2 + 1]); w1[i2] = pg8::cvt_pk_bf16(X2[8 + 2 * i2], X2[8 + 2 * i2 + 1]); }
                *(LAS u32x4*)(RA + 4 * 2048 + e * 32) = w0; *(LAS u32x4*)(RA + 4 * 2048 + e * 32 + 16) = w1;
            }
            WAVE_LDS_FENCE();
            __builtin_amdgcn_sched_barrier(0);
            {
                LAS bf16_t* GI = (LAS bf16_t*)MAT;
                const int sg = e >> 5, jp = 4 * ((e >> 4) & 1) + (e & 3), qg = (e & 15) >> 2;
#pragma unroll
                for (int i = 0; i < TB; ++i) GI[(sg * 64 + qg * 16 + i) * 8 + jp] = (bf16_t)f2bf(Gv[i]);
            }
            __builtin_amdgcn_sched_barrier(0);
            const int seqc = d == 0 ? (grp + 16) % RW_NCK : RW_NCK - 1 - grp;
            const size_t rec = (size_t)(d * 8 + h) * RW_NCK + seqc;
            {
                const int r = lane & 31, hh = lane >> 5;
                bf16x8 fBT[2], fKT[2], fVT[2], fW1[2], fU0[2];
#pragma unroll
                for (int blk = 0; blk < 2; ++blk) {
                    fBT[blk] = *(const LAS bf16x8*)(RA + 0 * 2048 + (32 * blk + r) * 32 + hh * 16); fKT[blk] = *(const LAS bf16x8*)(RA + 1 * 2048 + (32 * blk + r) * 32 + hh * 16);
                    fVT[blk] = *(const LAS bf16x8*)(RA + 2 * 2048 + (32 * blk + r) * 32 + hh * 16); fW1[blk] = *(const LAS bf16x8*)(RA + 3 * 2048 + (32 * blk + r) * 32 + hh * 16);
                    fU0[blk] = *(const LAS bf16x8*)(RA + 4 * 2048 + (32 * blk + r) * 32 + hh * 16);
                }
                float gk[2][16];
#pragma unroll
                for (int mb = 0; mb < 2; ++mb)
#pragma unroll
                    for (int reg = 0; reg < 16; ++reg) gk[mb][reg] = *(const LAS float*)(RA + 10240 + 4 * (32 * mb + KOFF(reg) + 4 * hh));
                WAVE_LDS_FENCE();
                float* Hrec = (float*)(C.ws + OFF_RWH + rec * RWH_REC);
                LAS bf16_t* MI = (LAS bf16_t*)RA;
#pragma unroll
                for (int mb = 0; mb < 2; ++mb)
#pragma unroll
                    for (int nbk = 0; nbk < 2; ++nbk) {
                        f32x16 aM, aH;
#pragma unroll
                        for (int i = 0; i < 16; ++i) { aM[i] = 0.f; aH[i] = 0.f; }
                        aM = MFMA32(fBT[mb], fW1[nbk], aM);
                        aH = MFMA32(fBT[mb], fU0[nbk], aH); aH = MFMA32(fKT[mb], fVT[nbk], aH);
                        const int col = 32 * nbk + r;
#pragma unroll
                        for (int g4 = 0; g4 < 4; ++g4) {
                            const int kb = 2 * mb + (g4 >> 1), q2 = 2 * (g4 & 1) + hh;
                            f32x4 hv; hv.x = gk[mb][4 * g4] * aH[4 * g4]; hv.y = gk[mb][4 * g4 + 1] * aH[4 * g4 + 1]; hv.z = gk[mb][4 * g4 + 2] * aH[4 * g4 + 2]; hv.w = gk[mb][4 * g4 + 3] * aH[4 * g4 + 3];
                            *(f32x4*)(Hrec + (((col >> 4) * 4 + kb) * 64 + q2 * 16 + (col & 15)) * 4) = hv;
                        }
                        const int sm = col >> 5, jpm = 4 * ((col >> 4) & 1) + (col & 3), qm2 = (col & 15) >> 2;
#pragma unroll
                        for (int reg = 0; reg < 16; ++reg) {
                            const int kp = 32 * mb + KOFF(reg) + 4 * hh;
                            const float mv = gk[mb][reg] * ((kp == col ? 1.0f : 0.0f) + aM[reg]);
                            MI[(((kp >> 4) * 2 + sm) * 64 + qm2 * 16 + (kp & 15)) * 8 + jpm] = (bf16_t)f2bf(mv);
                        }
                    }
                WAVE_LDS_FENCE();
                unsigned char* MGrec = C.ws + OFF_RWMG + rec * RWMG_REC;
#pragma unroll
                for (int it = 0; it < 8; ++it) *(u32x4*)(MGrec + (size_t)(it * 64 + lane) * 16) = *(const LAS u32x4*)(RA + (it * 64 + lane) * 16);
#pragma unroll
                for (int it = 0; it < 2; ++it) *(u32x4*)(MGrec + 8192 + (size_t)(it * 64 + lane) * 16) = *(const LAS u32x4*)((LAS unsigned char*)MAT + (it * 64 + lane) * 16);
                WAVE_LDS_FENCE();
            }
        }
    }
}

struct PrepW { float nw[4][4]; float inv[4]; };
__device__ __forceinline__ void attn_prep_unit(Ctx& C, const PrepW& W, bf16_t* PA, int u, int lane) {
    const int li = lane & 15, g = lane >> 4;
    const int rp = u / 13, v = u - rp * 13;
    int r, col, kind;
    if (v < 12) { const int k6 = v % 6; r = 2 * rp + v / 6; kind = k6 >> 1; col = (kind == 0 ? 0 : kind == 1 ? 512 : 1536) + 256 * (k6 & 1) + 64 * g; }
    else { r = 2 * rp + (g >> 1); kind = 3; col = 2048 + 64 * (g & 1); }
    bf16_t* p = PA + (size_t)r * PAW + col + 4 * li;
    const uint2 raw = *(const uint2*)p;
    float x[4] = {bf2f(raw.x & 0xffffu), bf2f(raw.x >> 16), bf2f(raw.y & 0xffffu), bf2f(raw.y >> 16)};
    const float ss = row16_sum(x[0] * x[0] + x[1] * x[1] + x[2] * x[2] + x[3] * x[3]);
    const float rs = rsqrtf(ss * (1.0f / 64.0f) + EPS) * ((kind & 1) ? 1.0f : 0.125f);
    float y[4];
#pragma unroll
    for (int j = 0; j < 4; ++j) y[j] = x[j] * rs * (kind == 0 ? W.nw[0][j] : kind == 1 ? W.nw[1][j] : kind == 2 ? W.nw[2][j] : W.nw[3][j]);
    if (kind >= 2 && r < SEQ) {
        const int pos = (li >> 3) ? (r & 63) : (r >> 6);
        const bool lo = (li & 7) < 4;
        const int src = lane + (lo ? 4 : -4);
#pragma unroll
        for (int j = 0; j < 4; ++j) {
            const float ang = (float)pos * W.inv[j];
            const float sn = __sinf(ang), cs = __cosf(ang);
            const float yp = __shfl(y[j], src);
            y[j] = lo ? (y[j] * cs - yp * sn) : (yp * sn + y[j] * cs);
        }
    }
    uint2 o; o.x = pk2(y[0], y[1]); o.y = pk2(y[2], y[3]);
    if (!(kind & 1)) *(uint2*)p = o;
    else {
        const int hd = (col - (kind == 1 ? 512 : 2048)) >> 6;
        bf16_t* kt = (kind == 1 ? WSP(bf16_t, OFF_KTN) : WSP(bf16_t, OFF_KTW)) + (size_t)(hd * (MT / 32) + (r >> 5)) * 2048;
        *(uint2*)(kt + ((((li >> 2) * 64 + ((li >> 1) & 1) * 32 + (r & 31)) << 3) + 4 * (li & 1))) = o;
    }
}
__device__ __forceinline__ void phase_attn_prep(Ctx& C, int l, int w0, int nw) {
    bf16_t* PA = WSP(bf16_t, OFF_PA);
    const int lane = C.lane, li = lane & 15;
    PrepW W;
#pragma unroll
    for (int j = 0; j < 4; ++j) {
        W.nw[0][j] = C.ka->in[I_NAQN][l * 64 + 4 * li + j]; W.nw[1][j] = C.ka->in[I_NAKN][l * 64 + 4 * li + j];
        W.nw[2][j] = C.ka->in[I_WAQN][l * 64 + 4 * li + j]; W.nw[3][j] = C.ka->in[I_WAKN][l * 64 + 4 * li + j];
        W.inv[j] = powf(10000.0f, -(float)(4 * (li & 3) + j) / 16.0f);
    }
    for (int u = w0; u < (MT / 2) * 13; u += nw) attn_prep_unit(C, W, PA, u, lane);
}

__device__ __forceinline__ float hg_lb(Ctx& C, int l, int d, int c) {
    if (l == 0) return 0.f;
    const float a0 = C.ka->in[I_HGLB][(size_t)(d * DEPTH + 0) * 512 + c], a1 = C.ka->in[I_HGLB][(size_t)(d * DEPTH + 1) * 512 + c];
    const float m = fmaxf(a0, a1); const float e0 = expf(a0 - m), e1 = expf(a1 - m);
    return e1 / (e0 + e1);
}
struct HgThread { float lc[16], kd[16]; float tot[4]; };
__device__ __forceinline__ void hg_gate_loads(Ctx& C, int d, int h, int tc, int k, int J, float (&fr)[16]) {
    const float* P = WSP(float, OFF_P32);
#pragma unroll
    for (int i = 0; i < 16; ++i) fr[i] = P[(size_t)(64 * tc + 16 * J + i) * P32W + 512 + d * 512 + h * 128 + k];
}
__device__ __forceinline__ void hg_gates(Ctx& C, int l, int d, int h, int tc, int k, int J, LAS float* TOT, HgThread& T, const float (&frv)[16]) {
    const float lb = hg_lb(C, l, d, h * 128 + k);
    float gg[16];
#pragma unroll
    for (int i = 0; i < 16; ++i) {
        const float fr = frv[i];
        const float f = lb + (1.0f - lb) * sigmoidf_(fr);
        gg[i] = __logf(f); T.kd[i] = 1.0f - f;
    }
    if (d == 0) { float a = 0.f;
#pragma unroll
        for (int i = 0; i < 16; ++i) { a += gg[i]; T.lc[i] = a; }
        TOT[J * 128 + k] = a;
    } else { float a = 0.f;
#pragma unroll
        for (int i = 15; i >= 0; --i) { a += gg[i]; T.lc[i] = a; }
        TOT[J * 128 + k] = a;
    }
    __syncthreads();
#pragma unroll
    for (int m = 0; m < 4; ++m) T.tot[m] = TOT[m * 128 + k];
}
__device__ __forceinline__ void hg_it(Ctx& C, int h, int tc, int v, int J, LAS unsigned char* IT) {
    const float* P = WSP(float, OFF_P32);
    float x[16];
#pragma unroll
    for (int i = 0; i < 16; ++i) x[i] = P[(size_t)(64 * tc + 16 * J + i) * P32W + 1536 + h * 128 + v];
    u32x4 w0, w1;
    w0.x = pk2(x[0], x[1]); w0.y = pk2(x[2], x[3]); w0.z = pk2(x[4], x[5]); w0.w = pk2(x[6], x[7]);
    w1.x = pk2(x[8], x[9]); w1.y = pk2(x[10], x[11]); w1.z = pk2(x[12], x[13]); w1.w = pk2(x[14], x[15]);
    *(LAS u32x4*)(IT + v * 144 + J * 32) = w0; *(LAS u32x4*)(IT + v * 144 + J * 32 + 16) = w1;
}
__device__ __forceinline__ void phase_hg_A(Ctx& C, int l, int b0, int nb) {
    float* HGL = WSP(float, OFF_HGL); float* HGD = WSP(float, OFF_HGD);
    LAS unsigned char* KT = C.lds;
    LAS unsigned char* IT = C.lds + 18432;
    LAS float* TOT = (LAS float*)(C.lds + 36864);
    const int k = C.tid & 127, J = C.tid >> 7;
    unsigned* ctr = WSP(unsigned, OFF_CTL) + 71680 + l;
    LAS int* su = (LAS int*)(C.lds + 40960);
    int nxt = 0;
    if (C.tid == 0) nxt = (int)atomicAdd(ctr, 1u);
    for (;;) {
        __syncthreads();
        if (C.tid == 0) *su = nxt;
        __syncthreads();
        const int u = *su;
        if (u >= 2 * 4 * NCH) break;
        if (C.tid == 0) nxt = (int)atomicAdd(ctr, 1u);
        const int d = u / (4 * NCH), h = (u / NCH) % 4, c = u % NCH;
        const int tc = d == 0 ? (c + NCH - 4) % NCH : NCH - 1 - c;
        float xi[16];
        { const float* P = WSP(float, OFF_P32);
#pragma unroll
          for (int i = 0; i < 16; ++i) xi[i] = P[(size_t)(64 * tc + 16 * J + i) * P32W + 1536 + h * 128 + k]; }
        float frv[16]; hg_gate_loads(C, d, h, tc, k, J, frv);
        HgThread T; hg_gates(C, l, d, h, tc, k, J, TOT, T, frv);
        float rest = 0.f;
#pragma unroll
        for (int m = 0; m < 4; ++m) if (d == 0 ? (m >= J) : (m <= J)) rest += T.tot[m];
        float kh[16];
#pragma unroll
        for (int i = 0; i < 16; ++i) kh[i] = T.kd[i] * __expf(rest - T.lc[i]);
        { u32x4 w0, w1;
          w0.x = pk2(kh[0], kh[1]); w0.y = pk2(kh[2], kh[3]); w0.z = pk2(kh[4], kh[5]); w0.w = pk2(kh[6], kh[7]);
          w1.x = pk2(kh[8], kh[9]); w1.y = pk2(kh[10], kh[11]); w1.z = pk2(kh[12], kh[13]); w1.w = pk2(kh[14], kh[15]);
          *(LAS u32x4*)(KT + k * 144 + J * 32) = w0; *(LAS u32x4*)(KT + k * 144 + J * 32 + 16) = w1; }
        { u32x4 w0, w1;
          w0.x = pk2(xi[0], xi[1]); w0.y = pk2(xi[2], xi[3]); w0.z = pk2(xi[4], xi[5]); w0.w = pk2(xi[6], xi[7]);
          w1.x = pk2(xi[8], xi[9]); w1.y = pk2(xi[10], xi[11]); w1.z = pk2(xi[12], xi[13]); w1.w = pk2(xi[14], xi[15]);
          *(LAS u32x4*)(IT + k * 144 + J * 32) = w0; *(LAS u32x4*)(IT + k * 144 + J * 32 + 16) = w1; }
        if (J == 0) HGD[(size_t)((d * 4 + h) * NCH + c) * 128 + k] = __expf((T.tot[0] + T.tot[1]) + (T.tot[2] + T.tot[3]));
        __syncthreads();
        const int r = C.lane & 31, hh = C.lane >> 5, vb = C.wave >> 1;
        float* outp = HGL + (size_t)((d * 4 + h) * NCH + c) * 16384;
#pragma unroll
        for (int t2 = 0; t2 < 2; ++t2) {
            const int kb = 2 * (C.wave & 1) + t2;
            f32x16 acc;
#pragma unroll
            for (int i = 0; i < 16; ++i) acc[i] = 0.f;
#pragma unroll
            for (int st = 0; st < 4; ++st) {
                const bf16x8 af = *(const LAS bf16x8*)(IT + (32 * vb + r) * 144 + st * 32 + hh * 16);
                const bf16x8 bf = *(const LAS bf16x8*)(KT + (32 * kb + r) * 144 + st * 32 + hh * 16);
                acc = MFMA32(af, bf, acc);
            }
#pragma unroll
            for (int reg = 0; reg < 16; ++reg) outp[(size_t)(32 * vb + KOFF(reg) + 4 * hh) * 128 + 32 * kb + r] = acc[reg];
        }
    }
}
__device__ __forceinline__ void phase_hg_B(Ctx& C, int b0, int nb) {
    const float* HGL = WSP(float, OFF_HGL); const float* HGD = WSP(float, OFF_HGD); bf16_t* SPT = WSP(bf16_t, OFF_SPT);
    for (int e = b0 * NT + C.tid; e < 8 * 8192; e += nb * NT) {
        const int dh = e >> 13, vk = (e & 8191) * 2, k = vk & 127;
        float s0 = 0.f, s1 = 0.f;
        const float* p = HGL + (size_t)dh * NCH * 16384 + vk; const float* dp = HGD + (size_t)dh * NCH * 128 + k; bf16_t* o = SPT + (size_t)dh * NCH * 16384 + vk;
        static_assert(NCH % 12 == 0, "twelve chunks per batch");
#pragma unroll 1
        for (int c0 = 0; c0 < NCH; c0 += 12) {
            float2 Lc[12], Dc[12];
#pragma unroll
            for (int i = 0; i < 12; ++i) { Lc[i] = *(const float2*)(p + (size_t)(c0 + i) * 16384); Dc[i] = *(const float2*)(dp + (c0 + i) * 128); }
#pragma unroll
            for (int i = 0; i < 12; ++i) { *(unsigned*)(o + (size_t)(c0 + i) * 16384) = pk2(s0, s1); s0 = Dc[i].x * s0 + Lc[i].x; s1 = Dc[i].y * s1 + Lc[i].y; }
        }
    }
}
__device__ __forceinline__ void phase_hg_C(Ctx& C, int l, int b0, int nb, int nch  ) {
    const float* P = WSP(float, OFF_P32); const bf16_t* SPT = WSP(bf16_t, OFF_SPT); bf16_t* YB = WSP(bf16_t, OFF_YB);
    LAS unsigned char* KS = C.lds;
    LAS unsigned char* QJ = C.lds + 17408;
    LAS unsigned char* IT = C.lds + 17408 + 69632;
    LAS float* TOT = (LAS float*)(C.lds + 105472);
    LAS float* RED = (LAS float*)(C.lds + 107520);
    const int k = C.tid & 127, J = C.tid >> 7;
    const int tl = C.lane & 15, qd = C.lane >> 4, I = C.wave >> 1, vh = C.wave & 1;
    for (int u = b0; u < 4 * nch; u += nb) {
        const int h = u / nch, tc = u % nch;
        f32x4 oT[4];
#pragma unroll
        for (int i = 0; i < 4; ++i) oT[i] = (f32x4){0.f, 0.f, 0.f, 0.f};
        hg_it(C, h, tc, k, J, IT);
        f32x4 gvp[4];
#pragma unroll
        for (int vb = 0; vb < 4; ++vb) gvp[vb] = *(const f32x4*)(P + (size_t)(64 * tc + 16 * I + tl) * P32W + 2048 + h * 128 + 16 * (4 * vh + vb) + 4 * qd);
        float fr0[16], fr1[16];
        hg_gate_loads(C, 0, h, tc, k, J, fr0); hg_gate_loads(C, 1, h, tc, k, J, fr1);
        float qv[16];
#pragma unroll
        for (int i = 0; i < 16; ++i) qv[i] = P[(size_t)(64 * tc + 16 * J + i) * P32W + h * 128 + k];
#pragma unroll 1
        for (int d = 0; d < 2; ++d) {
            const int cd = d == 0 ? (tc + 4) % NCH : NCH - 1 - tc;
            bf16x8 spf[4][4];
            { const bf16_t* sp0 = SPT + (size_t)((d * 4 + h) * NCH + cd) * 16384;
#pragma unroll
              for (int ks = 0; ks < 4; ++ks)
#pragma unroll
                  for (int vb = 0; vb < 4; ++vb) spf[ks][vb] = *(const bf16x8*)(sp0 + (size_t)(16 * (4 * vh + vb) + tl) * 128 + ks * 32 + qd * 8); }
            __syncthreads();
            {
                HgThread T;
                if (d == 0) hg_gates(C, l, 0, h, tc, k, J, TOT, T, fr0); else hg_gates(C, l, 1, h, tc, k, J, TOT, T, fr1);
#pragma unroll
                for (int i = 0; i < 16; ++i) *(LAS bf16_t*)(KS + (16 * J + i) * 272 + 2 * k) = (bf16_t)f2bf(T.kd[i] * __expf(fminf(-T.lc[i], 80.f)));
#pragma unroll
                for (int Jp = 0; Jp < 4; ++Jp) {
                    if (d == 0 ? (Jp > J) : (Jp < J)) continue;
                    float Pj = 0.f;
#pragma unroll
                    for (int m = 0; m < 4; ++m) if (d == 0 ? (m >= Jp && m < J) : (m > J && m <= Jp)) Pj += T.tot[m];
#pragma unroll
                    for (int i = 0; i < 16; ++i) *(LAS bf16_t*)(QJ + (Jp * 64 + 16 * J + i) * 272 + 2 * k) = (bf16_t)f2bf(qv[i] * __expf(T.lc[i] + Pj));
                }
            }
            __syncthreads();
            u32x2 att[4];
#pragma unroll
            for (int Jb = 0; Jb < 4; ++Jb) {
                att[Jb] = (u32x2){0u, 0u};
                if (d == 0 ? (Jb > I) : (Jb < I)) continue;
                f32x4 acc = {0.f, 0.f, 0.f, 0.f};
#pragma unroll
                for (int ks = 0; ks < 4; ++ks) {
                    const bf16x8 af = *(const LAS bf16x8*)(KS + (16 * Jb + tl) * 272 + ks * 64 + qd * 16);
                    const bf16x8 bf = *(const LAS bf16x8*)(QJ + (Jb * 64 + 16 * I + tl) * 272 + ks * 64 + qd * 16);
                    acc = MFMA16(af, bf, acc);
                }
                if (Jb == I) {
#pragma unroll
                    for (int reg = 0; reg < 4; ++reg) { const int sl = 4 * qd + reg; const bool valid = d == 0 ? (sl <= tl) : (sl >= tl); acc[reg] = valid ? acc[reg] : 0.f; }
                }
                att[Jb].x = pk2(acc[0], acc[1]); att[Jb].y = pk2(acc[2], acc[3]);
            }
#pragma unroll
            for (int pr = 0; pr < 2; ++pr) {
                const int Ja = 2 * pr, Jc = 2 * pr + 1;
                const bool anyv = d == 0 ? (Ja <= I) : (Jc >= I);
                if (!anyv) continue;
                u32x4 bw; bw.x = att[Ja].x; bw.y = att[Ja].y; bw.z = att[Jc].x; bw.w = att[Jc].y;
                const bf16x8 bf = __builtin_bit_cast(bf16x8, bw);
#pragma unroll
                for (int vb = 0; vb < 4; ++vb) {
                    const int v = 16 * (4 * vh + vb) + tl;
                    const u32x2 a0 = *(const LAS u32x2*)(IT + v * 144 + Ja * 32 + qd * 8), a1 = *(const LAS u32x2*)(IT + v * 144 + Jc * 32 + qd * 8);
                    u32x4 aw; aw.x = a0.x; aw.y = a0.y; aw.z = a1.x; aw.w = a1.y;
                    oT[vb] = MFMA16(__builtin_bit_cast(bf16x8, aw), bf, oT[vb]);
                }
            }
            const int Je = d == 0 ? 0 : 3;
#pragma unroll
            for (int ks = 0; ks < 4; ++ks) {
                const bf16x8 bf = *(const LAS bf16x8*)(QJ + (Je * 64 + 16 * I + tl) * 272 + ks * 64 + qd * 16);
#pragma unroll
                for (int vb = 0; vb < 4; ++vb) oT[vb] = MFMA16(spf[ks][vb], bf, oT[vb]);
            }
        }
        float ss = 0.f;
#pragma unroll
        for (int vb = 0; vb < 4; ++vb) ss += (oT[vb][0] * oT[vb][0] + oT[vb][1] * oT[vb][1]) + (oT[vb][2] * oT[vb][2] + oT[vb][3] * oT[vb][3]);
        ss += __shfl_xor(ss, 16); ss += __shfl_xor(ss, 32);
        __syncthreads();
        if (qd == 0) RED[C.wave * 16 + tl] = ss;
        __syncthreads();
        const float rstd = rsqrtf((RED[(2 * I) * 16 + tl] + RED[(2 * I + 1) * 16 + tl]) * (1.0f / 128.0f) + EPS);
        const int row = 64 * tc + 16 * I + tl;
#pragma unroll
        for (int vb = 0; vb < 4; ++vb) {
            const int v0 = 16 * (4 * vh + vb) + 4 * qd;
            const f32x4 nw = *(const f32x4*)(C.ka->in[I_HGNORM] + l * 512 + h * 128 + v0);
            const f32x4 gv = gvp[vb];
            u32x2 w; w.x = pg8::cvt_pk_bf16(oT[vb][0] * rstd * nw.x * siluf_(gv.x), oT[vb][1] * rstd * nw.y * siluf_(gv.y));
            w.y = pg8::cvt_pk_bf16(oT[vb][2] * rstd * nw.z * siluf_(gv.z), oT[vb][3] * rstd * nw.w * siluf_(gv.w));
            *(u32x2*)(YB + (size_t)row * 512 + h * 128 + v0) = w;
        }
    }
}

constexpr int RW_NJOBS = 64, RW_RING = 9, RW_SLOT = 14336;
__device__ __forceinline__ void phase_rw_scan(Ctx& C, int b0, int nb) {
    float* RO2 = WSP(float, OFF_RO2);
    LAS unsigned char* slot = C.lds;
    const int lane = C.lane, wv = C.wave;
    for (int jb = b0; jb < RW_NJOBS; jb += nb) {
        const int x = jb & 7, y = jb >> 3, dh = x * 2 + (y >> 2), vs = y & 3, d = dh >> 3, h = dh & 7;
        const unsigned char* mg = C.ws + OFF_RWMG + (size_t)dh * RW_NCK * RWMG_REC;
        const unsigned char* hr = C.ws + OFF_RWH + (size_t)dh * RW_NCK * RWH_REC + (size_t)vs * 4096;
        __syncthreads();
#define RW_PIECE(cc, i) __builtin_amdgcn_global_load_lds((const unsigned*)(((i) < 10 ? mg + (size_t)(cc) * RWMG_REC + (size_t)((i) * 64 + lane) * 16 : hr + (size_t)(cc) * RWH_REC + (size_t)(((i) - 10) * 64 + lane) * 16)), \
            (LAS unsigned*)(slot + ((cc) % RW_RING) * RW_SLOT + (i) * 1024), 16, 0, 0)
        if (wv >= 1) {
#pragma unroll 1
            for (int k8 = 0; k8 < 8; ++k8) { RW_PIECE(k8, wv - 1); RW_PIECE(k8, wv + 6); } }
        f32x4 acc[4];
#pragma unroll
        for (int i = 0; i < 4; ++i) acc[i] = (f32x4){0.f, 0.f, 0.f, 0.f};
        const int vl = lane & 15, q = lane >> 4;
        struct Ops { bf16x8 g[2], m[4][2]; f32x4 h[4]; };
#define RW_LDS_LOAD(R, ck) do { const LAS unsigned char* sl_ = slot + ((ck) % RW_RING) * RW_SLOT; \
            _Pragma("unroll") for (int s2 = 0; s2 < 2; ++s2) R.g[s2] = *(const LAS bf16x8*)(sl_ + 8192 + (s2 * 64 + lane) * 16); \
            _Pragma("unroll") for (int kb = 0; kb < 4; ++kb) { R.h[kb] = *(const LAS f32x4*)(sl_ + 10240 + (kb * 64 + lane) * 16); \
                _Pragma("unroll") for (int s2 = 0; s2 < 2; ++s2) R.m[kb][s2] = *(const LAS bf16x8*)(sl_ + ((kb * 2 + s2) * 64 + lane) * 16); } } while (0)
#define RW_LOADER_STEP(ck) do { if ((ck) >= 0) { const int nn = (ck) + 8 < RW_NCK ? (ck) + 8 : RW_NCK - 1; \
                __builtin_amdgcn_global_load_lds((const unsigned*)(mg + (size_t)nn * RWMG_REC + (size_t)((wv - 1) * 64 + lane) * 16), (LAS unsigned*)(slot + (((ck) + 8) % RW_RING) * RW_SLOT + (wv - 1) * 1024), 16, 0, 0); \
                __builtin_amdgcn_global_load_lds((const unsigned*)((wv + 6) < 10 ? mg + (size_t)nn * RWMG_REC + (size_t)((wv + 6) * 64 + lane) * 16 : hr + (size_t)nn * RWH_REC + (size_t)((wv + 6 - 10) * 64 + lane) * 16), (LAS unsigned*)(slot + (((ck) + 8) % RW_RING) * RW_SLOT + (wv + 6) * 1024), 16, 0, 0); } \
            asm volatile("s_waitcnt vmcnt(12)" ::: "memory"); } while (0)
#define RW_BAR() do { asm volatile("s_waitcnt lgkmcnt(0)" ::: "memory"); __builtin_amdgcn_s_barrier(); asm volatile("" ::: "memory"); } while (0)
        if (wv >= 1) {
            RW_LOADER_STEP(-2);
            asm volatile("" ::: "memory"); __builtin_amdgcn_s_barrier(); asm volatile("" ::: "memory");
            RW_LOADER_STEP(-1);
            RW_BAR();
#pragma unroll 1
            for (int cc = 0; cc < RW_NCK; ++cc) {
                int lane = C.lane; asm volatile("" : "+v"(lane));
                RW_LOADER_STEP(cc);
                RW_BAR();
            }
        } else {
            asm volatile("" ::: "memory"); __builtin_amdgcn_s_barrier(); asm volatile("" ::: "memory");
            Ops RA, RB;
            RW_LDS_LOAD(RA, 0);
            RW_BAR();
#define RW_SB() __builtin_amdgcn_sched_barrier(0)
#define RW_LG(s2_) *(const LAS bf16x8*)(sln_ + 8192 + ((s2_) * 64 + lane) * 16)
#define RW_LH(kb_) *(const LAS f32x4*)(sln_ + 10240 + ((kb_) * 64 + lane) * 16)
#define RW_LM(kb_, s2_) *(const LAS bf16x8*)(sln_ + (((kb_) * 2 + (s2_)) * 64 + lane) * 16)
#define RW_CVT(s2_) do { u32x4 w; w.x = cvt_pk_v(acc[2 * (s2_)][0], acc[2 * (s2_)][1]); w.y = cvt_pk_v(acc[2 * (s2_)][2], acc[2 * (s2_)][3]); w.z = cvt_pk_v(acc[2 * (s2_) + 1][0], acc[2 * (s2_) + 1][1]); w.w = cvt_pk_v(acc[2 * (s2_) + 1][2], acc[2 * (s2_) + 1][3]); bfr[s2_] = __builtin_bit_cast(bf16x8, w); } while (0)
#define RW_COMPUTE(R, RN, cc_) do { \
                bf16x8 bfr[2]; \
                RW_CVT(0); \
                const int rc = d == 0 ? ((cc_) + RW_NCK - 16) % RW_NCK : RW_NCK - 1 - (cc_); \
                float* rop = rop0 + (size_t)rc * (16 * 512); \
                const LAS unsigned char* sln_ = slot + (((cc_) + 1 < RW_NCK ? (cc_) + 1 : RW_NCK - 1) % RW_RING) * RW_SLOT; \
                f32x4 oacc = {0.f, 0.f, 0.f, 0.f}; f32x4 a0, a1, a2, a3; \
                RW_SB(); \
                oacc = MFMA16(R.g[0], bfr[0], oacc);           RW_CVT(1);                                        RW_SB(); \
                a0 = MFMA16(R.m[0][0], bfr[0], R.h[0]);        RN.g[0] = RW_LG(0);    RN.g[1] = RW_LG(1);    RW_SB(); \
                a1 = MFMA16(R.m[1][0], bfr[0], R.h[1]);        RN.m[0][0] = RW_LM(0, 0); RN.m[0][1] = RW_LM(0, 1); RW_SB(); \
                a2 = MFMA16(R.m[2][0], bfr[0], R.h[2]);        RN.h[0] = RW_LH(0);    RN.m[1][0] = RW_LM(1, 0); RW_SB(); \
                a3 = MFMA16(R.m[3][0], bfr[0], R.h[3]);        RN.m[1][1] = RW_LM(1, 1); RN.h[1] = RW_LH(1);    RW_SB(); \
                oacc = MFMA16(R.g[1], bfr[1], oacc);           RN.m[2][0] = RW_LM(2, 0); RN.m[2][1] = RW_LM(2, 1); RW_SB(); \
                acc[0] = MFMA16(R.m[0][1], bfr[1], a0);        RN.h[2] = RW_LH(2);    RN.m[3][0] = RW_LM(3, 0); RW_SB(); \
                acc[1] = MFMA16(R.m[1][1], bfr[1], a1);        RN.m[3][1] = RW_LM(3, 1); RN.h[3] = RW_LH(3);    RW_SB(); \
                acc[2] = MFMA16(R.m[2][1], bfr[1], a2);        rop[0] = oacc[0]; rop[rstep] = oacc[1];           RW_SB(); \
                acc[3] = MFMA16(R.m[3][1], bfr[1], a3);        rop[2 * rstep] = oacc[2]; rop[3 * rstep] = oacc[3]; \
                RW_SB(); \
                RW_BAR(); } while (0)
            static_assert(RW_NCK % 2 == 0, "two chunks per trip");
            float* const rop0 = RO2 + (size_t)d * MT * 512 + (size_t)(d ? 15 - 4 * q : 4 * q) * 512 + h * 64 + 16 * vs + vl;
            const long rstep = d ? -512 : 512;
#pragma unroll 1
            for (int cc = 0; cc < RW_NCK; cc += 2) { RW_COMPUTE(RA, RB, cc); RW_COMPUTE(RB, RA, cc + 1); }
#undef RW_COMPUTE
#undef RW_CVT
#undef RW_SB
#undef RW_LG
#undef RW_LH
#undef RW_LM
        }
#undef RW_LDS_LOAD
#undef RW_LOADER_STEP
#undef RW_BAR
        asm volatile("s_waitcnt vmcnt(0)" ::: "memory");
#undef RW_PIECE
    }
}
struct FinIn { f32x4 a0, a1, b0, b1, vv, gs; float bon; };
__device__ __forceinline__ void rw_finish_load(FinIn& F, const float* RO, const float* RO2, const float* VV, const float* GS, const float* BON, int uidx, int g, int li) {
    const int r = uidx >> 1, h = (uidx & 1) * 4 + g, c = h * 64 + 4 * li;
    F.a0 = *(const f32x4*)(RO + (size_t)r * 512 + c); F.a1 = *(const f32x4*)(RO + ((size_t)MT + r) * 512 + c);
    F.b0 = *(const f32x4*)(RO2 + (size_t)r * 512 + c); F.b1 = *(const f32x4*)(RO2 + ((size_t)MT + r) * 512 + c);
    F.vv = *(const f32x4*)(VV + (size_t)r * 512 + c); F.gs = *(const f32x4*)(GS + (size_t)r * 512 + c);
    F.bon = BON[(size_t)r * 8 + h] + BON[((size_t)MT + r) * 8 + h];
}
__device__ __forceinline__ void phase_rw_finish(Ctx& C, int l, int w0, int nw, int rows) {
    const float* VV = WSP(float, OFF_VV); const float* GS = WSP(float, OFF_GS); const float* RO = WSP(float, OFF_RO); const float* BON = WSP(float, OFF_BON); const float* RO2 = WSP(float, OFF_RO2);
    bf16_t* YB = WSP(bf16_t, OFF_YB) + (size_t)1 * MT * 512;
    const int li = C.lane & 15, g = C.lane >> 4;
    const int nu = rows * 2;
    int uidx = w0;
    FinIn F;
    if (uidx < nu) rw_finish_load(F, RO, RO2, VV, GS, BON, uidx, g, li);
    while (uidx < nu) {
        const int un = uidx + nw;
        FinIn Fn = F;
        if (un < nu) rw_finish_load(Fn, RO, RO2, VV, GS, BON, un, g, li);
        const int r = uidx >> 1, h = (uidx & 1) * 4 + g, c = h * 64 + 4 * li;
        const f32x4 lw = *(const f32x4*)(C.ka->in[I_RWLNW] + l * 512 + c), lb = *(const f32x4*)(C.ka->in[I_RWLNB] + l * 512 + c);
        const f32x4 o = (F.a0 + F.a1) + (F.b0 + F.b1);
        const float mu = row16_sum((o.x + o.y) + (o.z + o.w)) * (1.0f / 64.0f);
        const f32x4 dv = o - mu;
        const float var = row16_sum((dv.x * dv.x + dv.y * dv.y) + (dv.z * dv.z + dv.w * dv.w)) * (1.0f / 64.0f);
        const float rs = rsqrtf(var + RW_GN_EPS);
        const f32x4 y = ((dv * rs) * lw + lb + F.vv * F.bon) * F.gs;
        uint2 w; w.x = pk2(y.x, y.y); w.y = pk2(y.z, y.w);
        *(uint2*)(YB + (size_t)r * 512 + c) = w;
        F = Fn; uidx = un;
    }
}

typedef float f32x4u __attribute__((ext_vector_type(4), aligned(4)));
__device__ __forceinline__ float swap32_sum(float x) { auto t = __builtin_amdgcn_permlane32_swap(__float_as_uint(x), __float_as_uint(x), false, false); return __uint_as_float(t[0]) + __uint_as_float(t[1]); }
__device__ __forceinline__ f32x16 qk_tile(const bf16_t* Kp  , const bf16x8 (&qf)[4], int r, int h) {
    f32x16 acc;
#pragma unroll
    for (int i = 0; i < 16; ++i) acc[i] = 0.f;
    const bf16_t* p = Kp + (size_t)r * PAW + 8 * h;
#pragma unroll
    for (int s = 0; s < 4; ++s) { const bf16x8 kf = *(const bf16x8*)(p + 16 * s); acc = MFMA32(kf, qf[s], acc); }
    return acc;
}
__device__ __forceinline__ void pv_tile(f32x16 (&o)[2], const bf16_t* VTp  , const f32x16& p, int r, int h) {
#pragma unroll
    for (int s = 0; s < 2; ++s) {
        u32x4 pw; pw.x = pg8::cvt_pk_bf16(p[8 * s + 0], p[8 * s + 1]); pw.y = pg8::cvt_pk_bf16(p[8 * s + 2], p[8 * s + 3]); pw.z = pg8::cvt_pk_bf16(p[8 * s + 4], p[8 * s + 5]); pw.w = pg8::cvt_pk_bf16(p[8 * s + 6], p[8 * s + 7]);
        const bf16x8 pb = __builtin_bit_cast(bf16x8, pw);
#pragma unroll
        for (int blk = 0; blk < 2; ++blk) {
            const bf16_t* vp = VTp + (size_t)(32 * blk + r) * MT + 16 * s + 4 * h;
            const u32x2 lo = *(const u32x2*)vp, hi = *(const u32x2*)(vp + 8);
            u32x4 vw; vw.x = lo.x; vw.y = lo.y; vw.z = hi.x; vw.w = hi.y;
            o[blk] = MFMA32(__builtin_bit_cast(bf16x8, vw), pb, o[blk]);
        }
    }
}
__device__ __forceinline__ void phase_attn(Ctx& C, int l, int w0, int nw) {
    const bf16_t* PA = WSP(bf16_t, OFF_PA); bf16_t* YB = WSP(bf16_t, OFF_YB);
    const bf16_t* VTN = WSP(bf16_t, OFF_VTN); const bf16_t* VTW = WSP(bf16_t, OFF_VTW);
    const float* PB = WSP(float, OFF_PB); const float* MREF = WSP(float, OFF_MREF);
    const int r = C.lane & 31, h = C.lane >> 5;
    constexpr int NJT = 2048 + 64;
    for (int job = w0; job < 2 * NJT; job += nw) {
        const int type = __builtin_amdgcn_readfirstlane(job / NJT), jj = __builtin_amdgcn_readfirstlane(job % NJT), qt = jj >> 3, hd = jj & 7;
        const int q0 = qt * 32;
        const bool lat = qt < 256;
        if (!lat && l == DEPTH - 1) continue;
        const float Mr = MREF[type];
        bf16x8 qf[4];
        { const bf16_t* qp = PA + (size_t)(q0 + r) * PAW + (type == 0 ? 0 : 1536) + hd * 64 + 8 * h;
#pragma unroll
          for (int s = 0; s < 4; ++s) qf[s] = *(const bf16x8*)(qp + 16 * s); }
        f32x16 o[2];
#pragma unroll
        for (int i = 0; i < 16; ++i) { o[0][i] = 0.f; o[1][i] = 0.f; }
        float lsum = 0.f;
        const int kcol = type == 0 ? 512 + hd * 64 : 2048 + (hd >> 2) * 64;
        const bf16_t* VT = type == 0 ? VTN + (size_t)(hd * (MT / 32)) * 2048 : VTW + (size_t)((hd >> 2) * (MT / 32)) * 2048;
        const bf16_t* KT = type == 0 ? WSP(bf16_t, OFF_KTN) + (size_t)(hd * (MT / 32)) * 2048 : WSP(bf16_t, OFF_KTW) + (size_t)((hd >> 2) * (MT / 32)) * 2048;
        const int i_g = qt >> 1, j_g = (qt & 1) * 32 + r;
        int rs = i_g - 4; rs = rs < 0 ? 0 : (rs > 120 ? 120 : rs);
        int cs = j_g - 8; cs = cs < 0 ? 0 : (cs > 48 ? 48 : cs);
        const int dl0 = -4 > -qt ? -4 : -qt, dl1 = 4 < 255 - qt ? 4 : 255 - qt;
        const int n_loc = !lat ? 0 : (type == 0 ? 16 : dl1 - dl0 + 1), nt = n_loc + CTX / 32;
#define ATT_KEY0(t) ((t) >= n_loc ? SEQ + 32 * ((t) - n_loc) : (type == 0 ? (rs + ((t) >> 1)) * 64 + 32 * ((t) & 1) : (qt + dl0 + (t)) * 32))
#define ATT_LOADK(kf, key0) do { const bf16_t* kp_ = KT + (size_t)((key0) >> 5) * 2048 + C.lane * 8; _Pragma("unroll") for (int s = 0; s < 4; ++s) kf[s] = *(const bf16x8*)(kp_ + s * 512); } while (0)
#define ATT_LOADV(vf, key0) do { const bf16_t* vp_ = VT + (size_t)((key0) >> 5) * 2048 + C.lane * 8; _Pragma("unroll") for (int s = 0; s < 2; ++s) _Pragma("unroll") for (int blk = 0; blk < 2; ++blk) vf[s][blk] = *(const u32x4*)(vp_ + (s * 2 + blk) * 512); } while (0)
        bf16x8 kc[4], kn[4]; u32x4 vc[2][2], vn[2][2];
        { const int k0 = ATT_KEY0(0); ATT_LOADK(kc, k0); ATT_LOADV(vc, k0); }
#pragma unroll 1
        for (int t = 0; t < nt; ++t) {
            { const int tn = t + 1 < nt ? t + 1 : t; const int k1 = ATT_KEY0(tn); ATT_LOADK(kn, k1); ATT_LOADV(vn, k1); }
            f32x16 acc;
#pragma unroll
            for (int i = 0; i < 16; ++i) acc[i] = 0.f;
#pragma unroll
            for (int s = 0; s < 4; ++s) acc = MFMA32(kc[s], qf[s], acc);
            f32x16 p;
            if (t >= n_loc) {
#pragma unroll
                for (int reg = 0; reg < 16; ++reg) { p[reg] = __expf(acc[reg] - Mr); lsum += p[reg]; }
            } else if (type == 0) {
                const int a = t >> 1, cc = t & 1;
                const float* brow = PB + (size_t)(hd * 15 + (rs + a - i_g + 7)) * 128 + (32 * cc + 4 * h - j_g + 63);
                const int lo = cs - 32 * cc - 4 * h;
#pragma unroll
                for (int g = 0; g < 4; ++g) {
                    const f32x4u b4 = *(const f32x4u*)(brow + 8 * g);
#pragma unroll
                    for (int q = 0; q < 4; ++q) { const int reg = 4 * g + q; const bool valid = (unsigned)(KOFF(reg) - lo) < 16u;
                        const float e = __expf(acc[reg] + b4[q] - Mr); p[reg] = valid ? e : 0.f; lsum += p[reg]; }
                }
            } else {
                const int dl = dl0 + t;
#pragma unroll
                for (int reg = 0; reg < 16; ++reg) { const int kr = KOFF(reg) + 4 * h; const bool valid = dl == -4 ? (kr >= r) : (dl == 4 ? (kr <= r) : true);
                    const float e = __expf(acc[reg] - Mr); p[reg] = valid ? e : 0.f; lsum += p[reg]; }
            }
#pragma unroll
            for (int s = 0; s < 2; ++s) {
                u32x4 pw; pw.x = pg8::cvt_pk_bf16(p[8 * s + 0], p[8 * s + 1]); pw.y = pg8::cvt_pk_bf16(p[8 * s + 2], p[8 * s + 3]); pw.z = pg8::cvt_pk_bf16(p[8 * s + 4], p[8 * s + 5]); pw.w = pg8::cvt_pk_bf16(p[8 * s + 6], p[8 * s + 7]);
                const bf16x8 pb = __builtin_bit_cast(bf16x8, pw);
#pragma unroll
                for (int blk = 0; blk < 2; ++blk) o[blk] = MFMA32(__builtin_bit_cast(bf16x8, vc[s][blk]), pb, o[blk]);
            }
#pragma unroll
            for (int s = 0; s < 4; ++s) kc[s] = kn[s];
#pragma unroll
            for (int s = 0; s < 2; ++s)
#pragma unroll
                for (int blk = 0; blk < 2; ++blk) vc[s][blk] = vn[s][blk];
        }
#undef ATT_KEY0
#undef ATT_LOADK
#undef ATT_LOADV
        float ltot = swap32_sum(lsum);
        if (type == 1) ltot += __expf(C.ka->in[I_WASINK][l * 8 + hd] - Mr);
        const float inv = 1.0f / ltot;
        bf16_t* yp = YB + (size_t)(2 + type) * MT * 512 + (size_t)(q0 + r) * 512 + hd * 64 + 4 * h;
#pragma unroll
        for (int blk = 0; blk < 2; ++blk)
#pragma unroll
            for (int g = 0; g < 4; ++g) {
                u32x2 w; w.x = pg8::cvt_pk_bf16(o[blk][4 * g] * inv, o[blk][4 * g + 1] * inv); w.y = pg8::cvt_pk_bf16(o[blk][4 * g + 2] * inv, o[blk][4 * g + 3] * inv);
                *(u32x2*)(yp + 32 * blk + 8 * g) = w;
            }
    }
}
__device__ __forceinline__ void phase_attn_tables(Ctx& C, int l, int w0, int nw) {
    const bf16_t* PA = WSP(bf16_t, OFF_PA); bf16_t* VTN = WSP(bf16_t, OFF_VTN); bf16_t* VTW = WSP(bf16_t, OFF_VTW);
    LAS unsigned char* tile = C.lds + C.wave * 9216;
    const int lane = C.lane;
    for (int u = nw - 1 - w0; u < 10 * NCH; u += nw) {
        const int hd = u / NCH, tt = u % NCH, t0 = tt * 64;
        const int vcol = hd < 8 ? 1024 + hd * 64 : 2176 + (hd - 8) * 64;
#pragma unroll
        for (int it = 0; it < 8; ++it) { const int row = 8 * it + (lane >> 3), ch = lane & 7;
            *(LAS u32x4*)(tile + row * 144 + ch * 16) = *(const u32x4*)(PA + (size_t)(t0 + row) * PAW + vcol + ch * 8); }
        LDS_WAIT(); asm volatile("" ::: "memory");
        bf16_t* dst = (hd < 8 ? VTN + (size_t)(hd * (MT / 32) + 2 * tt) * 2048 : VTW + (size_t)((hd - 8) * (MT / 32) + 2 * tt) * 2048);
        { const int rr = lane & 31, hh = lane >> 5;
#pragma unroll
          for (int kt2 = 0; kt2 < 2; ++kt2)
#pragma unroll
            for (int s2 = 0; s2 < 2; ++s2)
#pragma unroll
                for (int blk = 0; blk < 2; ++blk) {
                    unsigned e[8];
#pragma unroll
                    for (int j = 0; j < 8; ++j) e[j] = *(const LAS bf16_t*)(tile + (32 * kt2 + 16 * s2 + 8 * (j >> 2) + 4 * hh + (j & 3)) * 144 + 2 * (32 * blk + rr));
                    u32x4 w; w.x = e[0] | (e[1] << 16); w.y = e[2] | (e[3] << 16); w.z = e[4] | (e[5] << 16); w.w = e[6] | (e[7] << 16);
                    *(u32x4*)(dst + (size_t)kt2 * 2048 + ((s2 * 2 + blk) * 64 + lane) * 8) = w;
                }
        }
        LDS_WAIT(); asm volatile("" ::: "memory");
    }
    float* PB = WSP(float, OFF_PB);
    const float* rpb = C.ka->in[I_NARPB] + (size_t)l * 8 * 15 * 31;
    for (int idx = (nw - 1 - w0) * 64 + lane; idx < 8 * 15 * 128; idx += nw * 64) { const int x = idx & 127, hr = idx >> 7; PB[idx] = (x >= 48 && x < 79) ? rpb[hr * 31 + x - 48] : 0.f; }
    if (w0 == nw - NWAVES) {
        float mb = 0.f;
#pragma unroll 15
        for (int i = lane; i < 8 * 15 * 31; i += 64) mb = fmaxf(mb, fabsf(rpb[i]));
        mb = wave_max(mb);
        const float nq = wave_max(fabsf(C.ka->in[I_NAQN][l * 64 + lane])), nk = wave_max(fabsf(C.ka->in[I_NAKN][l * 64 + lane]));
        const float wq = wave_max(fabsf(C.ka->in[I_WAQN][l * 64 + lane])), wk = wave_max(fabsf(C.ka->in[I_WAKN][l * 64 + lane]));
        const float sk = wave_max(lane < 8 ? C.ka->in[I_WASINK][l * 8 + lane] : -1e30f);
        if (lane == 0) { float* M = WSP(float, OFF_MREF); M[0] = 8.08f * nq * nk + mb; M[1] = fmaxf(8.08f * wq * wk, sk); }
    }
}

__device__ __forceinline__ void phase_combine(Ctx& C, int row_lo, int row_hi) {
    const bf16_t* PROJ = WSP(bf16_t, OFF_P32); bf16_t* MG = WSP(bf16_t, OFF_H);
    const size_t n8 = (size_t)(row_hi - row_lo) * D / 8;
    for (size_t i = (size_t)C.bid * NT + C.tid; i < n8; i += (size_t)C.G * NT) {
        const size_t r = row_lo + i / (D / 8), c8 = i % (D / 8);
        float a[8];
#pragma unroll
        for (int j = 0; j < 8; ++j) a[j] = 0.f;
#pragma unroll
        for (int g = 0; g < 4; ++g) {
            const u32x4 w = *(const u32x4*)(PROJ + r * GLW + g * D + c8 * 8);
            a[0] += bf2f(w.x & 0xffffu); a[1] += bf2f(w.x >> 16); a[2] += bf2f(w.y & 0xffffu); a[3] += bf2f(w.y >> 16);
            a[4] += bf2f(w.z & 0xffffu); a[5] += bf2f(w.z >> 16); a[6] += bf2f(w.w & 0xffffu); a[7] += bf2f(w.w >> 16);
        }
        u32x4 o; o.x = pk2(a[0], a[1]); o.y = pk2(a[2], a[3]); o.z = pk2(a[4], a[5]); o.w = pk2(a[6], a[7]);
        *(u32x4*)(MG + r * D + c8 * 8) = o;
    }
}

constexpr int PH_PRO = 2, PH_PER_LAYER = 14, N_PHASES = PH_PRO + DEPTH * PH_PER_LAYER;

__global__ void __launch_bounds__(NT, 2) mk_fwd(Args args) {
    extern __shared__ __attribute__((aligned(16))) unsigned char lds_raw[];
    Ctx C;
    C.lds = (LAS unsigned char*)lds_raw;
    C.tid = threadIdx.x; C.lane = C.tid & 63; C.wave = __builtin_amdgcn_readfirstlane(C.tid >> 6);
    C.bid = blockIdx.x; C.G = gridDim.x;
    C.ka = (const Args __attribute__((address_space(4)))*)__builtin_amdgcn_kernarg_segment_ptr(); C.out = args.out; C.ws = args.ws;
    volatile LAS unsigned* MISC = (volatile LAS unsigned*)(C.lds + MISC_OFF);
    for (int u = C.tid; u < (LDS_BYTES - RING_BYTES) / 4; u += NT) ((LAS unsigned*)(C.lds + RING_BYTES))[u] = 0u;
    __syncthreads();
    const int lo = args.ph_lo, hi = args.ph_hi;
    XcdBarrier bar; bar.bar = WSP(unsigned, OFF_CTL) + 4096; bar.x = 0; bar.st = nullptr;
    const bool multi = (hi - lo) > 1;
    if (multi) bar = xcd_barrier_post(WSP(unsigned, OFF_CTL) + 4096, MISC + 8);
#ifndef PH_MASK
#define PH_MASK 0xFFFF
#endif
#ifndef PRO_MASK
#define PRO_MASK 3
#endif
#define IN(k) (lo <= (k) && (k) < hi)
#define LEN(j) (((PH_MASK) >> (j)) & 1)
#define SEAM(k) do { if (IN(k) && IN((k) + 1)) xcd_barrier(bar); } while (0)

    if ((PRO_MASK & 1) && IN(0)) { relaunder(C); phase_convert(C, 0, 127, C.bid, C.G); phase_ada_partial(C); } SEAM(0);
    if ((PRO_MASK & 2) && IN(1)) { relaunder(C); phase_ada_reduce(C); } SEAM(1);

    const bool TS = (DEPTH == 2) && (C.G == 256) && multi;
#pragma unroll
    for (int l = 0; l < DEPTH; ++l) {
        const int pb = PH_PRO + l * PH_PER_LAYER;
        if (LEN(0) && IN(pb + 0)) { relaunder(C); if (l > 0) { if (TS) phase_convert(C, l, 16 | 32 | 64, C.bid, C.G, CV_O_IN + CV_Q_IN, CV_N); else phase_convert(C, l, 127 - 21, C.bid, C.G); } phase_norm(C, l, C.ka->in[I_NF1] + (size_t)l * D, 0, 0, SEQ, l == 0 ? 1 : 0); phase_norm_ctx(C, l, C.ka->in[I_NF1] + (size_t)l * D, 0, l > 0 ? 22 : 0, l == 0 ? 1 : 0); } SEAM(pb + 0);
        if (LEN(1) && IN(pb + 1)) { relaunder(C);
            pg8::Gemm g = pg8::mkgemm(WSP(bf16_t, OFF_H), WSP(bf16_t, OFF_WI1));
            pg8::StaticOrder S; S.init(MT, 2 * DFF, C.G, C.bid);
            pg8::EpiSwiGLU E{WSP(bf16_t, OFF_G)};
            pg8::gemm_phase<pg8::EpiSwiGLU, true, true, pg8::StaticOrder, D, D, D, 0>(C.lds, g, S, E, C.tid);
            if (PROBE_MODE == 3) { pg8::gemm_phase<pg8::EpiSwiGLU, true, true, pg8::StaticOrder, D, D, D, 0>(C.lds, g, S, E, C.tid); }
            if (TS && l == 1 && C.bid >= 172) { relaunder(C); __syncthreads(); phase_convert(C, l, 2, C.bid - 172, 84, CV_O_WI2, CV_O_WI2 + CV_Q_WI2); }
        } SEAM(pb + 1);
        if (LEN(2) && IN(pb + 2)) { relaunder(C);
            { pg8::Gemm g = pg8::mkgemm(WSP(bf16_t, OFF_G), WSP(bf16_t, OFF_WO1));
              pg8::StaticOrder S; S.init(SEQ, D, C.G, C.bid);
              pg8::EpiResid<true> E{WSP(float, OFF_X), mod_ptr(C, l, 0, 2), mod_ptr(C, l, 1, 2), nullptr, l == 0 ? C.ka->in[I_X] : WSP(float, OFF_X)};
              pg8::gemm_phase<pg8::EpiResid<true>, true, true, pg8::StaticOrder, DFF, DFF, DFF, 0>(C.lds, g, S, E, C.tid); }
            { relaunder(C); pg8::Gemm g = pg8::mkgemm(WSP(bf16_t, OFF_G), WSP(bf16_t, OFF_WO1));
              pg8::SplitOrder S{SEQ / 256, D / 256, 22, C.G, C.bid};
              pg8::EpiPart<true> E{WSP(float, OFF_P32), mod_ptr(C, l, 1, 2)};
              pg8::gemm_phase<pg8::EpiPart<true>, true, true, pg8::SplitOrder, 256, DFF, DFF, 256>(C.lds, g, S, E, C.tid); }
        } SEAM(pb + 2);
        if (LEN(3) && IN(pb + 3)) { relaunder(C); phase_norm(C, l, C.ka->in[I_NMIX] + (size_t)l * D, 3, 0, SEQ, 0); phase_norm_ctx(C, l, C.ka->in[I_NMIX] + (size_t)l * D, 3, 22, l == 0 ? 2 : 0); } SEAM(pb + 3);
        if (LEN(4) && IN(pb + 4)) { relaunder(C);
            pg8::Gemm g = pg8::mkgemm(WSP(bf16_t, OFF_H), WSP(bf16_t, OFF_WIN));
            pg8::StaticOrder S; S.init(MT, PTOT, C.G, C.bid);
            pg8::EpiWin E{WSP(float, OFF_P32), WSP(bf16_t, OFF_PA), WSP(bf16_t, OFF_GL), 0};
            pg8::gemm_phase<pg8::EpiWin, true, true, pg8::StaticOrder, D, D, D, 0>(C.lds, g, S, E, C.tid);
            if (PROBE_MODE == 3) { pg8::gemm_phase<pg8::EpiWin, true, true, pg8::StaticOrder, D, D, D, 0>(C.lds, g, S, E, C.tid); }
            if (TS && C.bid >= 188) { relaunder(C); __syncthreads();
                if (l == 0) phase_convert(C, 1, 1, C.bid - 188, 68, CV_O_WI1, CV_O_WI1 + CV_Q_WI1);
                else { phase_convert(C, 1, 2, C.bid - 188, 68, CV_O_WI2 + CV_Q_WI2, CV_O_WI2 + CV_WI); phase_convert(C, 1, 8, C.bid - 188, 68, CV_O_WO2, CV_O_WO2 + CV_WO); } }
        } SEAM(pb + 4);
        if (LEN(5) && IN(pb + 5)) { relaunder(C);
            phase_rw_prep(C, l, C.bid, C.G);
            __syncthreads();
            if (C.G == 256) { if (C.bid >= 32) phase_attn_prep(C, l, (C.bid - 32) * NWAVES + C.wave, (C.G - 32) * NWAVES); }
            else phase_attn_prep(C, l, C.bid * NWAVES + C.wave, C.G * NWAVES);
            phase_attn_tables(C, l, C.bid * NWAVES + C.wave, C.G * NWAVES);
            if (PROBE_MODE == 1) phase_attn_tables(C, l, C.bid * NWAVES + C.wave, C.G * NWAVES);
            __syncthreads();
            phase_hg_A(C, l, C.bid, C.G);
            if (PROBE_MODE == 1) phase_hg_A(C, l, C.bid, C.G);
        } SEAM(pb + 5);
        if (LEN(6) && IN(pb + 6)) { relaunder(C);
            if (C.G >= 256) {
                if (C.bid < RW_NJOBS) phase_rw_scan(C, C.bid, RW_NJOBS);
                else { const int b = C.bid - RW_NJOBS, n = C.G - RW_NJOBS; phase_hg_B(C, b, n); phase_attn(C, l, b * NWAVES + C.wave, n * NWAVES);
                    if (l + 1 < DEPTH) { __syncthreads();
                        if (TS) { phase_convert(C, l + 1, 1, b, n, CV_O_WI1 + CV_Q_WI1, CV_O_WI1 + CV_WI); phase_convert(C, l + 1, 4, b, n, CV_O_WO1, CV_O_WO1 + CV_WO); }
                        else phase_convert(C, l + 1, 21, b, n); }
                    if (PROBE_MODE == 11) { phase_hg_B(C, b, n); phase_attn(C, l, b * NWAVES + C.wave, n * NWAVES); }
                    if (PROBE_MODE == 12) { phase_attn(C, l, b * NWAVES + C.wave, n * NWAVES); } if (PROBE_MODE == 13) { phase_hg_B(C, b, n); } }
            } else {
                phase_rw_scan(C, C.bid, C.G); phase_hg_B(C, C.bid, C.G); phase_attn(C, l, C.bid * NWAVES + C.wave, C.G * NWAVES);
                if (l + 1 < DEPTH) { __syncthreads(); phase_convert(C, l + 1, 21, C.bid, C.G); }
            }
        } SEAM(pb + 6);
        if (LEN(7) && IN(pb + 7)) { relaunder(C); phase_hg_C(C, l, C.bid, C.G, l == DEPTH - 1 ? SEQ / 64 : NCH);
            if (l < DEPTH - 1 && C.G == 256) { if (C.bid >= 16) phase_rw_finish(C, l, (C.bid - 16) * NWAVES + C.wave, (C.G - 16) * NWAVES, MT); }
            else phase_rw_finish(C, l, C.bid * NWAVES + C.wave, C.G * NWAVES, l == DEPTH - 1 ? SEQ : MT);
        } SEAM(pb + 7);
        if (LEN(8) && IN(pb + 8)) { relaunder(C);
            { pg8::Gemm g = pg8::mkgemm(WSP(bf16_t, OFF_YB), WSP(bf16_t, OFF_WBR)); g.a_kgs = (size_t)MT * 512 * 2;
              pg8::StaticOrder S; S.init(SEQ, D, C.G, C.bid);
              pg8::EpiMergeF E{WSP(bf16_t, OFF_GL), WSP(bf16_t, OFF_H)};
              pg8::gemm_phase<pg8::EpiMergeF, true, true, pg8::StaticOrder, 4 * 512, 512, 4 * 512, 0, 8>(C.lds, g, S, E, C.tid);
              if (PROBE_MODE == 4) { pg8::gemm_phase<pg8::EpiMergeF, true, true, pg8::StaticOrder, 4 * 512, 512, 4 * 512, 0, 8>(C.lds, g, S, E, C.tid); } }
            if (l < DEPTH - 1) { relaunder(C);
              pg8::Gemm g = pg8::mkgemm(WSP(bf16_t, OFF_YB), WSP(bf16_t, OFF_WBR)); g.a_div = 8; g.a_gstride = (size_t)MT * 512; g.b_mod = 8; g.b_gcol = 512;
              pg8::SplitOrder S{SEQ / 256, 32, 1, C.G, C.bid};
              pg8::EpiMerge E{WSP(bf16_t, OFF_GL), WSP(bf16_t, OFF_P32)};
              pg8::gemm_phase<pg8::EpiMerge, true, true, pg8::SplitOrder, 512, 512, 4 * 512, 0>(C.lds, g, S, E, C.tid); }
        }
        if (l < DEPTH - 1) { SEAM(pb + 8); }
        if (l < DEPTH - 1) { if (LEN(9) && IN(pb + 9)) { relaunder(C); phase_combine(C, SEQ, MT); } }
        SEAM(pb + 9);
        if (LEN(10) && IN(pb + 10)) { relaunder(C);
            { pg8::Gemm g = pg8::mkgemm(WSP(bf16_t, OFF_H), WSP(bf16_t, OFF_WOUT));
              pg8::StaticOrder S; S.init(SEQ, D, C.G, C.bid);
              pg8::EpiResid<false> E{WSP(float, OFF_X), mod_ptr(C, l, 0, 5), mod_ptr(C, l, 1, 5), nullptr, WSP(float, OFF_X)};
              pg8::gemm_phase<pg8::EpiResid<false>, true, true, pg8::StaticOrder, D, D, D, 0>(C.lds, g, S, E, C.tid); }
            if (l < DEPTH - 1) { relaunder(C);
              pg8::Gemm g = pg8::mkgemm(WSP(bf16_t, OFF_H), WSP(bf16_t, OFF_WOUT));
              pg8::SplitOrder S{SEQ / 256, D / 256, 8, C.G, C.bid};
              pg8::EpiPart<false> E{WSP(float, OFF_P32), mod_ptr(C, l, 1, 5)};
              pg8::gemm_phase<pg8::EpiPart<false>, true, true, pg8::SplitOrder, 256, D, D, 256>(C.lds, g, S, E, C.tid); }
        } SEAM(pb + 10);
        if (LEN(11) && IN(pb + 11)) { relaunder(C); phase_norm(C, l, C.ka->in[I_NF2] + (size_t)l * D, 6, 0, SEQ, 0); if (l < DEPTH - 1) phase_norm_ctx(C, l, C.ka->in[I_NF2] + (size_t)l * D, 6, 8, 0); } SEAM(pb + 11);
        if (LEN(12) && IN(pb + 12)) { relaunder(C);
            pg8::Gemm g = pg8::mkgemm(WSP(bf16_t, OFF_H), WSP(bf16_t, OFF_WI2));
            pg8::StaticOrder S; S.init(l == DEPTH - 1 ? SEQ : MT, 2 * DFF, C.G, C.bid);
            pg8::EpiSwiGLU E{WSP(bf16_t, OFF_G)};
            pg8::gemm_phase<pg8::EpiSwiGLU, true, true, pg8::StaticOrder, D, D, D, 0>(C.lds, g, S, E, C.tid);
            if (PROBE_MODE == 3) { pg8::gemm_phase<pg8::EpiSwiGLU, true, true, pg8::StaticOrder, D, D, D, 0>(C.lds, g, S, E, C.tid); }
            if (TS && l == 0 && C.bid >= 172) { relaunder(C); __syncthreads(); phase_convert(C, 1, 16, C.bid - 172, 84, CV_O_IN, CV_O_IN + CV_Q_IN); }
        } SEAM(pb + 12);
        if (LEN(13) && IN(pb + 13)) { relaunder(C);
            { pg8::Gemm g = pg8::mkgemm(WSP(bf16_t, OFF_G), WSP(bf16_t, OFF_WO2));
              pg8::StaticOrder S; S.init(SEQ, D, C.G, C.bid);
              pg8::EpiResid<true> E{WSP(float, OFF_X), mod_ptr(C, l, 0, 8), mod_ptr(C, l, 1, 8), l == DEPTH - 1 ? C.out : nullptr, WSP(float, OFF_X)};
              pg8::gemm_phase<pg8::EpiResid<true>, true, true, pg8::StaticOrder, DFF, DFF, DFF, 0>(C.lds, g, S, E, C.tid); }
            if (l < DEPTH - 1) { relaunder(C);
              pg8::Gemm g = pg8::mkgemm(WSP(bf16_t, OFF_G), WSP(bf16_t, OFF_WO2));
              pg8::SplitOrder S{SEQ / 256, D / 256, 22, C.G, C.bid};
              pg8::EpiPart<true> E{WSP(float, OFF_P32), mod_ptr(C, l, 1, 8)};
              pg8::gemm_phase<pg8::EpiPart<true>, true, true, pg8::SplitOrder, 256, DFF, DFF, 256>(C.lds, g, S, E, C.tid); }
        } SEAM(pb + 13);
    }
#undef IN
#undef SEAM
}

extern "C" void kernel_launch(void* const* d_in, const int* in_sizes, int n_in, void* d_out, int out_size, void* d_ws, size_t ws_size, hipStream_t stream) {
    static int grid = 0;
    if (grid == 0) {
        if (n_in != N_IN || out_size != SEQ * D || ws_size < WS_END) { fprintf(stderr, "kernel_launch: unexpected shapes (n_in %d out %d ws %zu)\n", n_in, out_size, ws_size); grid = -1; return; }
        int dev = 0, cus = 0;
        if (hipGetDevice(&dev) != hipSuccess || hipDeviceGetAttribute(&cus, hipDeviceAttributeMultiprocessorCount, dev) != hipSuccess) { grid = -1; return; }
        if (hipFuncSetAttribute((const void*)mk_fwd, hipFuncAttributeMaxDynamicSharedMemorySize, LDS_BYTES) != hipSuccess) { fprintf(stderr, "kernel_launch: hipFuncSetAttribute failed\n"); grid = -1; return; }
        (void)hipGetLastError();
        grid = cus;
    }
    if (grid < 0) return;
    (void)hipMemsetAsync((char*)d_ws + OFF_CTL, 0, CTL_BYTES, stream);
    Args a{};
    for (int i = 0; i < N_IN; ++i) a.in[i] = (const float*)d_in[i];
    a.out = (float*)d_out; a.ws = (unsigned char*)d_ws;
#if MK_ONE_LAUNCH
    a.ph_lo = 0; a.ph_hi = N_PHASES;
    hipLaunchKernelGGL(mk_fwd, dim3(grid), dim3(NT), LDS_BYTES, stream, a);
#else
    for (int ph = 0; ph < N_PHASES; ++ph) {
        a.ph_lo = ph; a.ph_hi = ph + 1;
        hipLaunchKernelGGL(mk_fwd, dim3(grid), dim3(NT), LDS_BYTES, stream, a);
    }
#endif
}
```
